# Optimizing an MI355X kernel written in HIP

```python
import math
import jax, jax.numpy as jnp
from jax import lax
import numpy as np

D_MODEL = 1024
BATCH = 2
SEQ = 8192
DEPTH = 2

D_PLE = 256
GRID_W = 64
EPS = 1e-6

D_MIX = D_MODEL
D_SSM = D_MIX // 2
SSM_GROUP = 16
SSM_GROUPS = D_SSM // SSM_GROUP
SSM_STATE = 64
DT_MIN = 1e-3
DT_MAX = 1e-1

D_ATTN = D_MIX - D_SSM
HEAD_DIM = 64
N_Q_HEADS = D_ATTN // HEAD_DIM
N_KV_HEADS = 2
Q_PER_KV = N_Q_HEADS // N_KV_HEADS
D_KV = N_KV_HEADS * HEAD_DIM
D_IN = D_SSM + D_ATTN + 2 * D_KV
Q_BLOCK = 128
ROPE_THETA = 10000.0

PEER_HEADS = 8
PEER_KEY_DIM = 256
PEER_HALF = PEER_KEY_DIM // 2
N_KEYS = 128
N_EXPERTS = N_KEYS * N_KEYS
PEER_TOPK = 16
TOKEN_CHUNK = 128

kernel_name = "hybrid_s5_axialgqa_peer_encoder"


def rmsnorm(x, g):
    xf = x.astype(jnp.float32)
    y = xf * lax.rsqrt(jnp.mean(xf * xf, axis=-1, keepdims=True) + EPS)
    return (y * g.astype(jnp.float32)).astype(x.dtype)


def _scan_combine(e1, e2):
    a1r, a1i, b1r, b1i = e1
    a2r, a2i, b2r, b2i = e2
    return (a2r * a1r - a2i * a1i,
            a2r * a1i + a2i * a1r,
            a2r * b1r - a2i * b1i + b2r,
            a2r * b1i + a2i * b1r + b2i)


def s5_direction(u, lam_re, lam_im, log_dt, b_re, b_im, c_re, c_im, reverse):
    f32 = jnp.float32
    lam_re = lam_re.astype(f32)
    lam_im = lam_im.astype(f32)
    dt = jnp.exp(log_dt.astype(f32))[:, None]
    decay = jnp.exp(lam_re * dt)
    ab_re = decay * jnp.cos(lam_im * dt)
    ab_im = decay * jnp.sin(lam_im * dt)
    den = lam_re * lam_re + lam_im * lam_im
    nr = ab_re - 1.0
    f_re = (nr * lam_re + ab_im * lam_im) / den
    f_im = (ab_im * lam_re - nr * lam_im) / den
    b_re = b_re.astype(f32)
    b_im = b_im.astype(f32)
    bb_re = f_re[..., None] * b_re - f_im[..., None] * b_im
    bb_im = f_re[..., None] * b_im + f_im[..., None] * b_re
    bu_re = jnp.einsum('gnp,bsgp->bsgn', bb_re, u)
    bu_im = jnp.einsum('gnp,bsgp->bsgn', bb_im, u)
    a_re = jnp.broadcast_to(ab_re, bu_re.shape)
    a_im = jnp.broadcast_to(ab_im, bu_im.shape)
    _, _, h_re, h_im = lax.associative_scan(
        _scan_combine, (a_re, a_im, bu_re, bu_im), reverse=reverse, axis=1)
    return (jnp.einsum('gpn,bsgn->bsgp', c_re.astype(f32), h_re)
            - jnp.einsum('gpn,bsgn->bsgp', c_im.astype(f32), h_im))


def s5_mixer(u_in, lam_re, lam_im, log_dt, b_re, b_im, c_re, c_im, d_skip, w_glu, b_glu):
    f32 = jnp.float32
    B_, S_, _ = u_in.shape
    uf = u_in.astype(f32)
    u = uf.reshape(B_, S_, SSM_GROUPS, SSM_GROUP)
    y = (s5_direction(u, lam_re[0], lam_im[0], log_dt[0], b_re[0], b_im[0], c_re[0], c_im[0], False)
         + s5_direction(u, lam_re[1], lam_im[1], log_dt[1], b_re[1], b_im[1], c_re[1], c_im[1], True))
    y = y.reshape(B_, S_, D_SSM) + d_skip.astype(f32) * uf
    y = jax.nn.gelu(y)
    y = y * jax.nn.sigmoid(y @ w_glu.astype(f32) + b_glu.astype(f32))
    return y.astype(u_in.dtype)


def axial_rope_tables(n_tokens):
    f32 = jnp.float32
    n_rows = n_tokens // GRID_W
    row = jnp.repeat(jnp.arange(n_rows, dtype=jnp.int32), GRID_W).astype(f32)
    col = jnp.tile(jnp.arange(GRID_W, dtype=jnp.int32), n_rows).astype(f32)
    quarter = HEAD_DIM // 4
    inv = ROPE_THETA ** (-jnp.arange(quarter, dtype=f32) / quarter)
    ang_r = row[:, None] * inv[None, :]
    ang_c = col[:, None] * inv[None, :]
    return jnp.cos(ang_r), jnp.sin(ang_r), jnp.cos(ang_c), jnp.sin(ang_c)


def _rope_half(x, cos, sin):
    c = cos[None, :, None, :]
    s = sin[None, :, None, :]
    x1, x2 = x[..., :HEAD_DIM // 4], x[..., HEAD_DIM // 4:]
    return jnp.concatenate([x1 * c - x2 * s, x2 * c + x1 * s], axis=-1)


def apply_axial_rope(x, tables):
    cos_r, sin_r, cos_c, sin_c = tables
    xf = x.astype(jnp.float32)
    half = HEAD_DIM // 2
    out = jnp.concatenate([_rope_half(xf[..., :half], cos_r, sin_r),
                           _rope_half(xf[..., half:], cos_c, sin_c)], axis=-1)
    return out.astype(x.dtype)


def gqa_attention(q, k, v):
    B_, S_ = q.shape[:2]
    nb = S_ // Q_BLOCK
    qb = q.reshape(B_, nb, Q_BLOCK, N_KV_HEADS, Q_PER_KV, HEAD_DIM).transpose(1, 0, 3, 4, 2, 5)
    kt = k.transpose(0, 2, 1, 3)
    vt = v.transpose(0, 2, 1, 3)
    scale = HEAD_DIM ** -0.5

    def block(qblk):
        s = jnp.einsum('bkgqd,bksd->bkgqs', qblk, kt,
                       preferred_element_type=jnp.float32) * scale
        w = jax.nn.softmax(s, axis=-1)
        return jnp.einsum('bkgqs,bksd->bkgqd', w.astype(vt.dtype), vt)

    o = lax.map(block, qb)
    return o.transpose(1, 0, 4, 2, 3, 5).reshape(B_, S_, N_Q_HEADS * HEAD_DIM)


def peer_ffn(h, w_query, sub_keys1, sub_keys2, expert_u, expert_v):
    B_, S_, D_ = h.shape
    n_chunks = (B_ * S_) // TOKEN_CHUNK
    xt = h.reshape(n_chunks, TOKEN_CHUNK, D_)

    def chunk(xc):
        q = (xc @ w_query).reshape(TOKEN_CHUNK, PEER_HEADS, PEER_KEY_DIM)
        s1 = jnp.einsum('chd,hkd->chk', q[..., :PEER_HALF], sub_keys1).astype(jnp.float32)
        s2 = jnp.einsum('chd,hkd->chk', q[..., PEER_HALF:], sub_keys2).astype(jnp.float32)
        v1, i1 = lax.top_k(s1, PEER_TOPK)
        v2, i2 = lax.top_k(s2, PEER_TOPK)
        cand = (v1[..., :, None] + v2[..., None, :]).reshape(TOKEN_CHUNK, PEER_HEADS, PEER_TOPK * PEER_TOPK)
        cidx = (i1[..., :, None] * N_KEYS + i2[..., None, :]).reshape(TOKEN_CHUNK, PEER_HEADS, PEER_TOPK * PEER_TOPK)
        sc, pos = lax.top_k(cand, PEER_TOPK)
        idx = jnp.take_along_axis(cidx, pos, axis=-1)
        g = jax.nn.softmax(sc, axis=-1).astype(xc.dtype)
        u_sel = expert_u[idx]
        v_sel = expert_v[idx]
        a = jax.nn.gelu(jnp.einsum('chkd,cd->chk', u_sel, xc)) * g
        return jnp.einsum('chk,chkd->cd', a, v_sel)

    return lax.map(chunk, xt).reshape(B_, S_, D_)


def setup_inputs(seed: int = 0) -> dict:
    key = jax.random.key(seed)
    ks = jax.random.split(key, 32)
    f32 = jnp.float32
    L, G, N, P = DEPTH, SSM_GROUPS, SSM_STATE, SSM_GROUP

    def nrm(k, shape, scale):
        return jax.random.normal(k, shape, f32) * scale

    def gain(k, shape):
        return 1.0 + 0.05 * jax.random.normal(k, shape, f32)

    n_idx = jnp.arange(N, dtype=f32)
    lam_re = -0.5 + 0.01 * jax.random.normal(ks[4], (L, 2, G, N), f32)
    lam_im = math.pi * n_idx + 0.01 * jax.random.normal(ks[5], (L, 2, G, N), f32)
    u01 = jax.random.uniform(ks[6], (L, 2, G), f32)
    log_dt = math.log(DT_MIN) + u01 * (math.log(DT_MAX) - math.log(DT_MIN))

    return {
        "x": nrm(ks[0], (BATCH, SEQ, D_MODEL), 1.0),
        "p": nrm(ks[1], (DEPTH, BATCH, SEQ, D_PLE), 1.0),
        "norm_mix_g": gain(ks[2], (L, D_MODEL)),
        "w_in": nrm(ks[3], (L, D_MODEL, D_IN), D_MODEL ** -0.5),
        "lam_re": lam_re,
        "lam_im": lam_im,
        "log_dt": log_dt,
        "b_re": nrm(ks[7], (L, 2, G, N, P), (2.0 * P) ** -0.5),
        "b_im": nrm(ks[8], (L, 2, G, N, P), (2.0 * P) ** -0.5),
        "c_re": nrm(ks[9], (L, 2, G, P, N), (2.0 * N) ** -0.5),
        "c_im": nrm(ks[10], (L, 2, G, P, N), (2.0 * N) ** -0.5),
        "d_skip": nrm(ks[11], (L, D_SSM), 1.0),
        "w_glu": nrm(ks[12], (L, D_SSM, D_SSM), D_SSM ** -0.5),
        "b_glu": nrm(ks[13], (L, D_SSM), 0.01),
        "q_norm_g": gain(ks[14], (L, HEAD_DIM)),
        "k_norm_g": gain(ks[15], (L, HEAD_DIM)),
        "ssm_out_g": gain(ks[16], (L, D_SSM)),
        "attn_out_g": gain(ks[17], (L, D_ATTN)),
        "w_out": nrm(ks[18], (L, D_MIX, D_MODEL), D_MIX ** -0.5),
        "norm_ffn_g": gain(ks[19], (L, D_MODEL)),
        "w_query": nrm(ks[20], (L, D_MODEL, PEER_HEADS * PEER_KEY_DIM), D_MODEL ** -0.5),
        "sub_keys1": nrm(ks[21], (L, PEER_HEADS, N_KEYS, PEER_HALF), PEER_HALF ** -0.5),
        "sub_keys2": nrm(ks[22], (L, PEER_HEADS, N_KEYS, PEER_HALF), PEER_HALF ** -0.5),
        "expert_u": nrm(ks[23], (L, N_EXPERTS, D_MODEL), D_MODEL ** -0.5),
        "expert_v": nrm(ks[24], (L, N_EXPERTS, D_MODEL), 0.5),
        "norm_ple_g": gain(ks[25], (L, D_MODEL)),
        "w_ple_gate": nrm(ks[26], (L, D_MODEL, D_MODEL), D_MODEL ** -0.5),
        "w_ple_proj": nrm(ks[27], (L, D_PLE, D_MODEL), D_PLE ** -0.5),
        "final_norm_g": gain(ks[28], (D_MODEL,)),
    }


def reference(x, p, norm_mix_g, w_in, lam_re, lam_im, log_dt, b_re, b_im, c_re, c_im,
              d_skip, w_glu, b_glu, q_norm_g, k_norm_g, ssm_out_g, attn_out_g, w_out,
              norm_ffn_g, w_query, sub_keys1, sub_keys2, expert_u, expert_v,
              norm_ple_g, w_ple_gate, w_ple_proj, final_norm_g):
    B_, S_, _ = x.shape
    tables = axial_rope_tables(S_)
    for i in range(DEPTH):
        h = rmsnorm(x, norm_mix_g[i])
        z = h @ w_in[i]
        u_ssm = z[..., :D_SSM]
        q = z[..., D_SSM:D_SSM + D_ATTN].reshape(B_, S_, N_Q_HEADS, HEAD_DIM)
        k = z[..., D_SSM + D_ATTN:D_SSM + D_ATTN + D_KV].reshape(B_, S_, N_KV_HEADS, HEAD_DIM)
        v = z[..., D_SSM + D_ATTN + D_KV:].reshape(B_, S_, N_KV_HEADS, HEAD_DIM)

        y_ssm = s5_mixer(u_ssm, lam_re[i], lam_im[i], log_dt[i], b_re[i], b_im[i],
                         c_re[i], c_im[i], d_skip[i], w_glu[i], b_glu[i])

        q = apply_axial_rope(rmsnorm(q, q_norm_g[i]), tables)
        k = apply_axial_rope(rmsnorm(k, k_norm_g[i]), tables)
        y_attn = gqa_attention(q, k, v)

        y = jnp.concatenate([rmsnorm(y_ssm, ssm_out_g[i]), rmsnorm(y_attn, attn_out_g[i])], axis=-1)
        x = x + y @ w_out[i]

        x = x + peer_ffn(rmsnorm(x, norm_ffn_g[i]), w_query[i], sub_keys1[i], sub_keys2[i],
                         expert_u[i], expert_v[i])

        gate = jax.nn.sigmoid(rmsnorm(x, norm_ple_g[i]) @ w_ple_gate[i])
        x = x + gate * (p[i] @ w_ple_proj[i])
    return rmsnorm(x, final_norm_g)
```

```cpp
#include <hip/hip_runtime.h>
#include <cstdio>
#include <cstdint>

#ifndef MK_N_LAUNCHES
#define MK_N_LAUNCHES 20
#endif

#define LAS __attribute__((address_space(3)))
typedef unsigned short bf16_t;
typedef short bf16x8 __attribute__((ext_vector_type(8)));
typedef float f32x4 __attribute__((ext_vector_type(4)));
typedef unsigned u32x4 __attribute__((ext_vector_type(4)));
typedef unsigned u32x2 __attribute__((ext_vector_type(2)));

constexpr int NB = 2, SEQ = 8192, M = NB * SEQ, D = 1024, DIN = 1280;
constexpr int NG = 32, LCH = 32, NCH = SEQ / LCH, KCAT = 768;
constexpr float EPS = 1e-6f;
constexpr float C2 = 0.125f * 1.4426950408889634f;
constexpr int NPHASE = 20;

constexpr size_t MiB = 1u << 20;
constexpr size_t WS_CTL = 0, CTL_ZERO_BYTES = 1 * MiB;
constexpr size_t WS_EU = 1 * MiB, WS_EV = 65 * MiB;
constexpr size_t WS_LW = 129 * MiB, LW_STRIDE = 48 * MiB;
constexpr size_t LW_WIN = 0, LW_WGLU = 3 * MiB, LW_WOUT = 4 * MiB, LW_WQ = 6 * MiB, LW_SK1 = 10 * MiB, LW_SK2 = 10 * MiB + 512 * 1024,
                 LW_WGATE = 11 * MiB, LW_WPROJ = 13 * MiB, LW_AL = 13 * MiB + 512 * 1024, LW_WE = 14 * MiB, LW_WY = 22 * MiB;
constexpr size_t WS_PB = 225 * MiB, WS_ROPE = 241 * MiB, WS_XB = 242 * MiB, WS_UCAT = 274 * MiB, WS_QRAW = 300 * MiB, WS_KV = 316 * MiB,
                 WS_EBUF = 324 * MiB, WS_G = 340 * MiB, WS_Y = 356 * MiB, WS_SSQS = 388 * MiB, WS_SSQA = 389 * MiB, WS_SSQ0 = 390 * MiB, WS_SSQ1 = 391 * MiB,
                 WS_QP = 392 * MiB  , WS_SELI = 456 * MiB, WS_SELW = 464 * MiB, WS_XN2 = 472 * MiB, WS_END = 504 * MiB;
constexpr int CW_BAR = 4096;

constexpr int RING_BYTES = 131072, LDSCTL_OFF = RING_BYTES, MISC_OFF = LDSCTL_OFF + 320, LDS_BYTES = 147456;

__device__ __forceinline__ unsigned f2bf(float f) { unsigned u = __float_as_uint(f); return (u + 0x7fffu + ((u >> 16) & 1u)) >> 16; }
__device__ __forceinline__ unsigned pk2(float lo, float hi) { return f2bf(lo) | (f2bf(hi) << 16); }
__device__ __forceinline__ float bflo(unsigned w) { return __uint_as_float(w << 16); }
__device__ __forceinline__ float bfhi(unsigned w) { return __uint_as_float(w & 0xffff0000u); }
__device__ __forceinline__ float bf1(bf16_t h) { return __uint_as_float((unsigned)h << 16); }
__device__ __forceinline__ float wave_sum(float v) {
#pragma unroll
    for (int o = 1; o < 64; o <<= 1) v += __shfl_xor(v, o);
    return v;
}
__device__ __forceinline__ float wave_max(float v) {
#pragma unroll
    for (int o = 1; o < 64; o <<= 1) v = fmaxf(v, __shfl_xor(v, o));
    return v;
}
__device__ __forceinline__ float sigmoidf_(float x) { return 1.f / (1.f + __expf(-x)); }
__device__ __forceinline__ float gelu_tanh(float x) {
    const float z = 0.7978845608028654f * (x + 0.044715f * x * x * x);
    const float e = __expf(2.f * z);
    const float th = 1.f - 2.f / (e + 1.f);
    return 0.5f * x * (1.f + th);
}
__device__ __forceinline__ float sumn(const float* p, int n) { float s = 0.f; for (int i = 0; i < n; ++i) s += p[i]; return s; }
#define LDS_WAIT() asm volatile("s_waitcnt lgkmcnt(0)" ::: "memory")
#define VM_WAIT() asm volatile("s_waitcnt vmcnt(0)" ::: "memory")

#define XB_TMO      128
#define XB_XCNT(j)  (256  + 64 * (j))
#define XB_XSUB(j)  (1280 + 64 * (j))
#define XB_XGEN(j)  (2304 + 64 * (j))
#define XB_TOP      3328
#define XB_TOPGEN   3392
#define XCD_BAR_WORDS 3456
#define XB_SPIN_CAP (1u << 18)
__device__ __forceinline__ unsigned xb_ld(unsigned* p)              { return __hip_atomic_load(p, __ATOMIC_RELAXED, __HIP_MEMORY_SCOPE_AGENT); }
__device__ __forceinline__ unsigned xb_add(unsigned* p, unsigned v) { return __hip_atomic_fetch_add(p, v, __ATOMIC_RELAXED, __HIP_MEMORY_SCOPE_AGENT); }
__device__ __forceinline__ unsigned xb_xcc_id() { return (unsigned)__builtin_amdgcn_s_getreg((3 << 11) | 20) & 0xFu; }
#define XB_SPIN(cond, bar) do { unsigned _sp = 0; while (cond) { __builtin_amdgcn_s_sleep(1); \
    if ((++_sp & 255u) == 0u) { if (xb_ld(&(bar)[XB_TMO])) break; if (_sp > XB_SPIN_CAP) { atomicAdd(&(bar)[XB_TMO], 1u); break; } } } } while (0)
struct XcdBarrier { unsigned* bar; unsigned x; volatile LAS unsigned* st; };
__device__ __forceinline__ XcdBarrier xcd_barrier_post(unsigned* bar, volatile LAS unsigned* st) {
    XcdBarrier b; b.bar = bar; b.x = xb_xcc_id(); b.st = st;
    if (threadIdx.x == 0) (void)xb_add(&bar[XB_XCNT(b.x)], 1u);
    return b;
}
__device__ __forceinline__ void xcd_barrier_complete(unsigned* bar, unsigned x, unsigned& nloc, unsigned& nx) {
    const unsigned G = gridDim.x * gridDim.y * gridDim.z;
    unsigned sum, cnt, mine, sp = 0u;
    for (;;) {
        sum = 0u; cnt = 0u; mine = 0u;
#pragma unroll
        for (unsigned j = 0; j < 16; ++j) { const unsigned c = xb_ld(&bar[XB_XCNT(j)]); sum += c; cnt += (c > 0u) ? 1u : 0u; mine = (j == x) ? c : mine; }
        if (sum == G) break;
        __builtin_amdgcn_s_sleep(1);
        if ((++sp & 255u) == 0u) { if (xb_ld(&bar[XB_TMO])) break; if (sp > XB_SPIN_CAP) { atomicAdd(&bar[XB_TMO], 1u); break; } }
    }
    nloc = mine > 0u ? mine : 1u; nx = cnt > 0u ? cnt : 1u;
}
__device__ __forceinline__ void xcd_barrier(const XcdBarrier& b) {
    asm volatile("s_waitcnt vmcnt(0)" ::: "memory");
    __syncthreads();
    if (threadIdx.x == 0) {
        unsigned* bar = b.bar;
        __builtin_amdgcn_s_waitcnt(0);
        unsigned nloc = b.st[0], nx = b.st[1];
        if (nloc == 0u) { xcd_barrier_complete(bar, b.x, nloc, nx); b.st[0] = nloc; b.st[1] = nx; }
        const unsigned old = xb_add(&bar[XB_XSUB(b.x)], 1u);
        const unsigned gen = old / nloc;
        if (old + 1u == (gen + 1u) * nloc) {
            __builtin_amdgcn_fence(__ATOMIC_RELEASE, "agent");
            asm volatile("s_waitcnt vmcnt(0)" ::: "memory");
            const unsigned og = xb_add(&bar[XB_TOP], 1u);
            const unsigned tg = og / nx;
            if (og + 1u == (tg + 1u) * nx) xb_add(&bar[XB_TOPGEN], 1u);
            else XB_SPIN(xb_ld(&bar[XB_TOPGEN]) == tg, bar);
            __builtin_amdgcn_fence(__ATOMIC_ACQUIRE, "agent");
            xb_add(&bar[XB_XGEN(b.x)], 1u);
            asm volatile("s_waitcnt vmcnt(0)" ::: "memory");
        } else {
            XB_SPIN(xb_ld(&bar[XB_XGEN(b.x)]) == gen, bar);
            __builtin_amdgcn_fence(__ATOMIC_ACQUIRE, "agent");
            asm volatile("s_waitcnt vmcnt(0)" ::: "memory");
        }
    }
    __syncthreads();
}

struct Args { const float* in[29]; float* out; unsigned char* ws; int ph_lo, ph_hi; };
enum { I_X = 0, I_P, I_NMIXG, I_WIN, I_LRE, I_LIM, I_LOGDT, I_BRE, I_BIM, I_CRE, I_CIM, I_DSKIP, I_WGLU, I_BGLU, I_QNG, I_KNG, I_SSMG, I_ATTG, I_WOUT,
       I_NFFNG, I_WQ, I_SK1, I_SK2, I_EU, I_EV, I_NPLEG, I_WGATE, I_WPROJ, I_FING };

struct Ctx { int tid, lane, wave, blk, nblk; unsigned char* lds; };

struct GemmD { const bf16_t* A; long lda; const bf16_t* Bt; long ldb; int K; int kmid; };
struct Unit { int pm, pn; };

template <class Epi>
__device__ __forceinline__ void sgemm_unit(const GemmD& g, const Unit u, const Epi& E, int wave, int lane) {
    const int i = lane & 15, q = lane >> 4;
    const bf16_t* Ab = g.A + (long)(u.pm * 256 + wave * 32) * g.lda;
    const bf16_t* Bb = g.Bt + (long)(u.pn * 256) * g.ldb;
    const int row0 = u.pm * 256 + wave * 32 + i;
    float ssq[2] = {0.f, 0.f};
    float rs[2] = {1.f, 1.f};
    if constexpr (Epi::ROWSCALE) { rs[0] = E.rscale(row0); rs[1] = E.rscale(row0 + 16); }
    for (int cg = 0; cg < 4; ++cg) {
        f32x4 acc[2][4];
#pragma unroll
        for (int mi = 0; mi < 2; ++mi)
#pragma unroll
            for (int ni = 0; ni < 4; ++ni) acc[mi][ni] = (f32x4){0.f, 0.f, 0.f, 0.f};
        for (int k0 = 0; k0 < g.K; k0 += 32) {
            if constexpr (Epi::MID) { if (k0 == g.kmid) {
#pragma unroll
                for (int mi = 0; mi < 2; ++mi) { const float f = E.mid(row0 + 16 * mi);
#pragma unroll
                    for (int ni = 0; ni < 4; ++ni) acc[mi][ni] *= f; } } }
            bf16x8 a[2], b[4];
#pragma unroll
            for (int mi = 0; mi < 2; ++mi) a[mi] = *(const bf16x8*)(Ab + (long)(16 * mi + i) * g.lda + k0 + 8 * q);
#pragma unroll
            for (int ni = 0; ni < 4; ++ni) b[ni] = *(const bf16x8*)(Bb + (long)(cg * 64 + 16 * ni + i) * g.ldb + k0 + 8 * q);
#pragma unroll
            for (int mi = 0; mi < 2; ++mi)
#pragma unroll
                for (int ni = 0; ni < 4; ++ni) acc[mi][ni] = __builtin_amdgcn_mfma_f32_16x16x32_bf16(b[ni], a[mi], acc[mi][ni], 0, 0, 0);
        }
#pragma unroll
        for (int mi = 0; mi < 2; ++mi)
#pragma unroll
            for (int ni = 0; ni < 4; ++ni) {
                const f32x4 v = acc[mi][ni] * rs[mi];
                const f32x4 w = E.put(row0 + 16 * mi, u.pn * 256 + cg * 64 + 16 * ni + 4 * q, v);
                ssq[mi] += w[0] * w[0] + w[1] * w[1] + w[2] * w[2] + w[3] * w[3];
            }
    }
    if constexpr (Epi::SSQ) {
#pragma unroll
        for (int mi = 0; mi < 2; ++mi) { float s = ssq[mi]; s += __shfl_xor(s, 16); s += __shfl_xor(s, 32);
            if (q == 0) { E.ssq(row0 + 16 * mi, u.pn * 4 + 0, s); E.ssq(row0 + 16 * mi, u.pn * 4 + 1, 0.f); E.ssq(row0 + 16 * mi, u.pn * 4 + 2, 0.f); E.ssq(row0 + 16 * mi, u.pn * 4 + 3, 0.f); } }
    }
}

__device__ __forceinline__ u32x2 pack4(f32x4 v) { u32x2 w; w.x = pk2(v[0], v[1]); w.y = pk2(v[2], v[3]); return w; }

struct EpiInproj {
    static constexpr bool MID = false, ROWSCALE = true, SSQ = false;
    const float* ssq0; bf16_t* ucat; bf16_t* qraw; bf16_t* kv;
    __device__ __forceinline__ float rscale(int row) const { return rsqrtf(sumn(ssq0 + (long)row * 16, 16) * (1.f / D) + EPS); }
    __device__ __forceinline__ f32x4 put(int row, int col, f32x4 v) const {
        const u32x2 w = pack4(v);
        if (col < 512) { const int g = col >> 4, qq = col & 15, b = row >> 13, s = row & (SEQ - 1), c = s >> 5, j = s & 31;
            *(u32x2*)(ucat + ((long)((g * 2 + b) * NCH + c) * KCAT + j * 16 + qq)) = w; }
        else if (col < 1024) *(u32x2*)(qraw + (long)row * 512 + (col - 512)) = w;
        else *(u32x2*)(kv + (long)row * 256 + (col - 1024)) = w;
        return v;
    }
    __device__ __forceinline__ void ssq(int, int, float) const {}
};
struct EpiS1 {
    static constexpr bool MID = false, ROWSCALE = false, SSQ = false;
    float* ebuf;
    __device__ __forceinline__ f32x4 put(int row, int col, f32x4 v) const { *(f32x4*)(ebuf + ((long)row * 256 + (col & 255))) = v; return v; }
    __device__ __forceinline__ void ssq(int, int, float) const {}
};
struct EpiS2 {
    static constexpr bool MID = false, ROWSCALE = false, SSQ = false;
    bf16_t* G;
    __device__ __forceinline__ f32x4 put(int row, int col, f32x4 v) const {
        const int pm = row >> 8, c = row & 255, g = pm >> 1, b = pm & 1, nout = col & 511, j = nout >> 4, p = nout & 15;
        const long tok = (long)b * SEQ + c * LCH + j;
        f32x4 y; y[0] = gelu_tanh(v[0]); y[1] = gelu_tanh(v[1]); y[2] = gelu_tanh(v[2]); y[3] = gelu_tanh(v[3]);
        *(u32x2*)(G + tok * 512 + 16 * g + p) = pack4(y); return v;
    }
    __device__ __forceinline__ void ssq(int, int, float) const {}
};
struct EpiGlu {
    static constexpr bool MID = false, ROWSCALE = false, SSQ = true;
    const bf16_t* G; const float* bglu; bf16_t* Y; float* ssqs;
    __device__ __forceinline__ f32x4 put(int row, int col, f32x4 v) const {
        const u32x2 gw = *(const u32x2*)(G + (long)row * 512 + col);
        const f32x4 bb = *(const f32x4*)(bglu + col);
        f32x4 ys; ys[0] = bflo(gw.x) * sigmoidf_(v[0] + bb[0]); ys[1] = bfhi(gw.x) * sigmoidf_(v[1] + bb[1]);
        ys[2] = bflo(gw.y) * sigmoidf_(v[2] + bb[2]); ys[3] = bfhi(gw.y) * sigmoidf_(v[3] + bb[3]);
        *(u32x2*)(Y + (long)row * 1024 + col) = pack4(ys); return ys;
    }
    __device__ __forceinline__ void ssq(int row, int slot, float s) const { ssqs[(long)row * 16 + slot] = s; }
};
struct EpiOut {
    static constexpr bool MID = true, ROWSCALE = true, SSQ = true;
    const float* ssqs; const float* ssqa; const float* xin; float* xres; bf16_t* xb; float* ssq1;
    __device__ __forceinline__ float rs_s(int row) const { return rsqrtf(sumn(ssqs + (long)row * 16, 8) * (1.f / 512.f) + EPS); }
    __device__ __forceinline__ float rs_a(int row) const { return rsqrtf(sumn(ssqa + (long)row * 16, 8) * (1.f / 512.f) + EPS); }
    __device__ __forceinline__ float mid(int row) const { return rs_s(row) / rs_a(row); }
    __device__ __forceinline__ float rscale(int row) const { return rs_a(row); }
    __device__ __forceinline__ f32x4 put(int row, int col, f32x4 v) const {
        const long o = (long)row * D + col; const f32x4 x1 = *(const f32x4*)(xin + o) + v;
        *(f32x4*)(xres + o) = x1; *(u32x2*)(xb + o) = pack4(x1); return x1;
    }
    __device__ __forceinline__ void ssq(int row, int slot, float s) const { ssq1[(long)row * 16 + slot] = s; }
};
struct EpiQ {
    static constexpr bool MID = false, ROWSCALE = true, SSQ = false;
    const float* ssq1; bf16_t* qp;
    __device__ __forceinline__ float rscale(int row) const { return rsqrtf(sumn(ssq1 + (long)row * 16, 16) * (1.f / D) + EPS); }
    __device__ __forceinline__ f32x4 put(int row, int col, f32x4 v) const { *(u32x2*)(qp + (long)row * 2048 + col) = pack4(v); return v; }
    __device__ __forceinline__ void ssq(int, int, float) const {}
};
struct EpiProj {
    static constexpr bool MID = false, ROWSCALE = false, SSQ = false;
    float* pr;
    __device__ __forceinline__ f32x4 put(int row, int col, f32x4 v) const { *(f32x4*)(pr + (long)row * D + col) = v; return v; }
    __device__ __forceinline__ void ssq(int, int, float) const {}
};
struct EpiGate {
    static constexpr bool MID = false, ROWSCALE = false, SSQ = true;
    const float* pr; float* xres; bf16_t* xb; float* ssq0;
    __device__ __forceinline__ f32x4 put(int row, int col, f32x4 v) const {
        const long o = (long)row * D + col; const f32x4 pv = *(const f32x4*)(pr + o); f32x4 x3 = *(const f32x4*)(xres + o);
        x3[0] += sigmoidf_(v[0]) * pv[0]; x3[1] += sigmoidf_(v[1]) * pv[1]; x3[2] += sigmoidf_(v[2]) * pv[2]; x3[3] += sigmoidf_(v[3]) * pv[3];
        *(f32x4*)(xres + o) = x3; *(u32x2*)(xb + o) = pack4(x3); return x3;
    }
    __device__ __forceinline__ void ssq(int row, int slot, float s) const { ssq0[(long)row * 16 + slot] = s; }
};

template <class Epi>
__device__ __forceinline__ void gemm_phase_dense(const Ctx& c, const GemmD& g, int nM, int nN, const Epi& E) {
    const int nU = nM * nN;
    for (int ui = c.blk; ui < nU; ui += c.nblk) { Unit u; u.pn = ui % nN; u.pm = ui / nN; sgemm_unit(g, u, E, c.wave, c.lane); }
}

__device__ __forceinline__ void transpose_item(const float* W, int K, int N, bf16_t* WT, const float* gain, float* scr, int item, int lane) {
    const int nblk = N / 32, kb = item / nblk, nb = item % nblk, k0 = 64 * kb, n0 = 32 * nb;
#pragma unroll 8
    for (int i = 0; i < 32; ++i) { const int kk = 2 * i + (lane >> 5); float v = W[(size_t)(k0 + kk) * N + n0 + (lane & 31)]; if (gain) v *= gain[k0 + kk]; scr[kk * 33 + (lane & 31)] = v; }
    LDS_WAIT(); asm volatile("" ::: "memory");
    const int cc = lane & 7;
#pragma unroll
    for (int j = 0; j < 4; ++j) { const int n = (lane >> 3) + 8 * j; const float* s = scr + (8 * cc) * 33 + n;
        u32x4 o; o.x = pk2(s[0 * 33], s[1 * 33]); o.y = pk2(s[2 * 33], s[3 * 33]); o.z = pk2(s[4 * 33], s[5 * 33]); o.w = pk2(s[6 * 33], s[7 * 33]);
        *(u32x4*)(WT + (size_t)(n0 + n) * K + k0 + 8 * cc) = o; }
    LDS_WAIT(); asm volatile("" ::: "memory");
}
__device__ __forceinline__ void cvt_range(const Ctx& c, const float* src, bf16_t* dst, size_t n) {
    const size_t nv = n / 8, stride = (size_t)c.nblk * 512;
    for (size_t v = (size_t)c.blk * 512 + c.tid; v < nv; v += stride) {
        const f32x4 a = *(const f32x4*)(src + v * 8), b = *(const f32x4*)(src + v * 8 + 4);
        u32x4 o; o.x = pk2(a[0], a[1]); o.y = pk2(a[2], a[3]); o.z = pk2(b[0], b[1]); o.w = pk2(b[2], b[3]);
        *(u32x4*)(dst + v * 8) = o;
    }
}
__device__ __forceinline__ void ssm_tables_unit(const Ctx& c, const Args& a, int layer, int g) {
    float* Apow = (float*)c.lds;
    float* Bre = Apow + 2 * 33 * 64 * 2;
    float* Bim = Bre + 2 * 64 * 16;
    float* Cre = Bim + 2 * 64 * 16;
    float* Cim = Cre + 2 * 16 * 64;
    float* Tt = Cim + 2 * 16 * 64;
    unsigned char* lw = a.ws + WS_LW + (size_t)layer * LW_STRIDE;
    float* AL = (float*)(lw + LW_AL);
    bf16_t* WE = (bf16_t*)(lw + LW_WE) + (size_t)g * 256 * 512;
    bf16_t* WY = (bf16_t*)(lw + LW_WY) + (size_t)g * 512 * KCAT;
    const int tid = c.tid;
    __syncthreads();
    if (tid < 128) {
        const int dir = tid >> 6, n = tid & 63; const int ldg = (layer * 2 + dir) * NG + g;
        const float lre = a.in[I_LRE][ldg * 64 + n], lim = a.in[I_LIM][ldg * 64 + n];
        const float dt = expf(a.in[I_LOGDT][ldg]);
        for (int k = 0; k <= 32; ++k) { const float dec = expf(lre * dt * (float)k), ang = (lim * dt) * (float)k; float sn, cs; sincosf(ang, &sn, &cs);
            Apow[((dir * 33 + k) * 64 + n) * 2 + 0] = dec * cs; Apow[((dir * 33 + k) * 64 + n) * 2 + 1] = dec * sn; }
        const float abr = Apow[((dir * 33 + 1) * 64 + n) * 2 + 0], abi = Apow[((dir * 33 + 1) * 64 + n) * 2 + 1];
        const float den = lre * lre + lim * lim, nr = abr - 1.f;
        const float fre = (nr * lre + abi * lim) / den, fim = (abi * lre - nr * lim) / den;
        for (int q = 0; q < 16; ++q) { const float br = a.in[I_BRE][(ldg * 64 + n) * 16 + q], bi = a.in[I_BIM][(ldg * 64 + n) * 16 + q];
            Bre[(dir * 64 + n) * 16 + q] = fre * br - fim * bi; Bim[(dir * 64 + n) * 16 + q] = fre * bi + fim * br; }
        for (int p = 0; p < 16; ++p) { Cre[(dir * 16 + p) * 64 + n] = a.in[I_CRE][(ldg * 16 + p) * 64 + n]; Cim[(dir * 16 + p) * 64 + n] = a.in[I_CIM][(ldg * 16 + p) * 64 + n]; }
        AL[((dir * NG + g) * 64 + n) * 2 + 0] = Apow[((dir * 33 + 32) * 64 + n) * 2 + 0];
        AL[((dir * NG + g) * 64 + n) * 2 + 1] = Apow[((dir * 33 + 32) * 64 + n) * 2 + 1];
    }
    __syncthreads();
    for (int task = tid; task < 63 * 16; task += 512) {
        const int kk = task >> 4, p = task & 15, k = kk - 31;
        float acc[16];
#pragma unroll
        for (int q = 0; q < 16; ++q) acc[q] = 0.f;
        for (int part = 0; part < 2; ++part) {
            if ((part == 0 && k < 0) || (part == 1 && k > 0)) continue;
            const int dir = part, e = k >= 0 ? k : -k;
            for (int n = 0; n < 64; ++n) {
                const float cr = Cre[(dir * 16 + p) * 64 + n], ci = Cim[(dir * 16 + p) * 64 + n];
                const float ar = Apow[((dir * 33 + e) * 64 + n) * 2 + 0], ai = Apow[((dir * 33 + e) * 64 + n) * 2 + 1];
                const float car = cr * ar - ci * ai, cai = cr * ai + ci * ar;
#pragma unroll
                for (int q = 0; q < 16; ++q) acc[q] += car * Bre[(dir * 64 + n) * 16 + q] - cai * Bim[(dir * 64 + n) * 16 + q];
            }
        }
        const float dsk = a.in[I_DSKIP][layer * 512 + 16 * g + p];
#pragma unroll
        for (int q = 0; q < 16; ++q) Tt[(kk * 16 + p) * 16 + q] = acc[q] + ((k == 0 && q == p) ? dsk : 0.f);
    }
    __syncthreads();
    for (int it = tid; it < 512 * 96; it += 512) {
        const int nout = it / 96, kin0 = (it % 96) * 8, j = nout >> 4, p = nout & 15;
        float v[8];
        if (kin0 < 512) { const int s = kin0 >> 4, q0 = kin0 & 15, kk = j - s + 31;
#pragma unroll
            for (int i = 0; i < 8; ++i) v[i] = Tt[(kk * 16 + p) * 16 + q0 + i]; }
        else { const int comp = kin0 - 512, dir = comp >> 7, reim = (comp >> 6) & 1, n0 = comp & 63, e = dir == 0 ? j + 1 : 32 - j;
#pragma unroll
            for (int i = 0; i < 8; ++i) { const int n = n0 + i; const float cr = Cre[(dir * 16 + p) * 64 + n], ci = Cim[(dir * 16 + p) * 64 + n];
                const float ar = Apow[((dir * 33 + e) * 64 + n) * 2 + 0], ai = Apow[((dir * 33 + e) * 64 + n) * 2 + 1];
                v[i] = reim == 0 ? (cr * ar - ci * ai) : -(cr * ai + ci * ar); } }
        u32x4 o; o.x = pk2(v[0], v[1]); o.y = pk2(v[2], v[3]); o.z = pk2(v[4], v[5]); o.w = pk2(v[6], v[7]);
        *(u32x4*)(WY + (size_t)nout * KCAT + kin0) = o;
    }
    for (int it = tid; it < 256 * 64; it += 512) {
        const int comp = it >> 6, kin0 = (it & 63) * 8, j = kin0 >> 4, q0 = kin0 & 15, dir = comp >> 7, reim = (comp >> 6) & 1, n = comp & 63, e = dir == 0 ? 31 - j : j;
        const float ar = Apow[((dir * 33 + e) * 64 + n) * 2 + 0], ai = Apow[((dir * 33 + e) * 64 + n) * 2 + 1];
        float v[8];
#pragma unroll
        for (int i = 0; i < 8; ++i) { const float br = Bre[(dir * 64 + n) * 16 + q0 + i], bi = Bim[(dir * 64 + n) * 16 + q0 + i]; v[i] = reim == 0 ? (ar * br - ai * bi) : (ar * bi + ai * br); }
        u32x4 o; o.x = pk2(v[0], v[1]); o.y = pk2(v[2], v[3]); o.z = pk2(v[4], v[5]); o.w = pk2(v[6], v[7]);
        *(u32x4*)(WE + (size_t)comp * 512 + kin0) = o;
    }
    __syncthreads();
}
__device__ __forceinline__ void p0_prologue(const Ctx& c, const Args& a) {
    for (int u = c.blk; u < 2 * NG; u += c.nblk) ssm_tables_unit(c, a, u / NG, u % NG);
    float* scr = (float*)(c.lds + c.wave * 8448);
    const int gw = c.blk * 8 + c.wave, NGW = c.nblk * 8;
    constexpr int I0 = 640, I1 = 128, I2 = 512, I3 = 1024, I4 = 512, I5 = 128, IL = I0 + I1 + I2 + I3 + I4 + I5;
    for (int it = gw; it < 2 * IL; it += NGW) {
        const int L = it / IL; int r = it % IL; unsigned char* lw = a.ws + WS_LW + (size_t)L * LW_STRIDE;
        if (r < I0) { transpose_item(a.in[I_WIN] + (size_t)L * D * DIN, D, DIN, (bf16_t*)(lw + LW_WIN), a.in[I_NMIXG] + L * D, scr, r, c.lane); continue; } r -= I0;
        if (r < I1) { transpose_item(a.in[I_WGLU] + (size_t)L * 512 * 512, 512, 512, (bf16_t*)(lw + LW_WGLU), nullptr, scr, r, c.lane); continue; } r -= I1;
        if (r < I2) { const int k0 = 64 * (r / 32); const float* gn = k0 < 512 ? a.in[I_SSMG] + L * 512 : a.in[I_ATTG] + L * 512 - 512;
            transpose_item(a.in[I_WOUT] + (size_t)L * D * D, D, D, (bf16_t*)(lw + LW_WOUT), gn, scr, r, c.lane); continue; } r -= I2;
        if (r < I3) { transpose_item(a.in[I_WQ] + (size_t)L * D * 2048, D, 2048, (bf16_t*)(lw + LW_WQ), a.in[I_NFFNG] + L * D, scr, r, c.lane); continue; } r -= I3;
        if (r < I4) { transpose_item(a.in[I_WGATE] + (size_t)L * D * D, D, D, (bf16_t*)(lw + LW_WGATE), nullptr, scr, r, c.lane); continue; } r -= I4;
        transpose_item(a.in[I_WPROJ] + (size_t)L * 256 * D, 256, D, (bf16_t*)(lw + LW_WPROJ), nullptr, scr, r, c.lane);
    }
    cvt_range(c, a.in[I_EU], (bf16_t*)(a.ws + WS_EU), (size_t)2 * 16384 * 1024);
    cvt_range(c, a.in[I_EV], (bf16_t*)(a.ws + WS_EV), (size_t)2 * 16384 * 1024);
    cvt_range(c, a.in[I_P], (bf16_t*)(a.ws + WS_PB), (size_t)2 * M * 256);
    for (int L = 0; L < 2; ++L) {
        cvt_range(c, a.in[I_SK1] + (size_t)L * 8 * 128 * 128, (bf16_t*)(a.ws + WS_LW + (size_t)L * LW_STRIDE + LW_SK1), (size_t)8 * 128 * 128);
        cvt_range(c, a.in[I_SK2] + (size_t)L * 8 * 128 * 128, (bf16_t*)(a.ws + WS_LW + (size_t)L * LW_STRIDE + LW_SK2), (size_t)8 * 128 * 128);
    }
    {
        bf16_t* XB = (bf16_t*)(a.ws + WS_XB); float* SSQ0 = (float*)(a.ws + WS_SSQ0);
        for (int m = gw; m < M; m += NGW) {
            const f32x4* xr = (const f32x4*)(a.in[I_X] + (size_t)m * D) + c.lane; float s = 0.f;
#pragma unroll
            for (int j = 0; j < 4; ++j) { const f32x4 v = xr[64 * j]; s += v[0] * v[0] + v[1] * v[1] + v[2] * v[2] + v[3] * v[3];
                *(u32x2*)(XB + (size_t)m * D + 256 * j + 4 * c.lane) = pack4(v); }
            s = wave_sum(s);
            if (c.lane < 16) SSQ0[(size_t)m * 16 + c.lane] = c.lane == 0 ? s : 0.f;
        }
    }
    if (c.blk == c.nblk - 1) {
        float* R = (float*)(a.ws + WS_ROPE);
        for (int e = c.tid; e < 3072; e += 512) {
            const bool isr = e < 2048; const int pos = isr ? (e >> 4) : ((e - 2048) >> 4), f = e & 15;
            const float inv = powf(10000.f, -(float)f / 16.f), ang = (float)pos * inv; float sn, cs; sincosf(ang, &sn, &cs);
            if (isr) { R[e] = cs; R[2048 + e] = sn; } else { R[4096 + (e - 2048)] = cs; R[5120 + (e - 2048)] = sn; }
        }
    }
}

__device__ __forceinline__ void s1_unit(const Ctx& c, const Args& a, int layer, int gb  ) {
    unsigned char* lw = a.ws + WS_LW + (size_t)layer * LW_STRIDE;
    bf16_t* UC = (bf16_t*)(a.ws + WS_UCAT); float* EB = (float*)(a.ws + WS_EBUF);
    const int g = gb >> 1;
    GemmD gd; gd.A = UC; gd.lda = KCAT; gd.Bt = (const bf16_t*)(lw + LW_WE); gd.ldb = 512; gd.K = 512; gd.kmid = -1;
    EpiS1 E; E.ebuf = EB;
    Unit u; u.pm = gb; u.pn = g;
    sgemm_unit(gd, u, E, c.wave, c.lane);
    VM_WAIT(); __syncthreads();
    if (c.tid < 128) {
        const int dir = c.tid >> 6, n = c.tid & 63;
        const float* AL = (const float*)(lw + LW_AL);
        const float alr = AL[((dir * NG + g) * 64 + n) * 2 + 0], ali = AL[((dir * NG + g) * 64 + n) * 2 + 1];
        float hr = 0.f, hi = 0.f;
        const float* eb = EB + (size_t)gb * NCH * 256 + dir * 128 + n;
        bf16_t* hc = UC + (size_t)gb * NCH * KCAT + 512 + dir * 128 + n;
#pragma unroll 8
        for (int s = 0; s < NCH; ++s) {
            const int ch = dir == 0 ? s : NCH - 1 - s;
            hc[(size_t)ch * KCAT] = (bf16_t)f2bf(hr); hc[(size_t)ch * KCAT + 64] = (bf16_t)f2bf(hi);
            const float er = eb[(size_t)ch * 256], ei = eb[(size_t)ch * 256 + 64];
            const float nr = alr * hr - ali * hi + er, ni = alr * hi + ali * hr + ei; hr = nr; hi = ni;
        }
    }
    __syncthreads();
}
__device__ __forceinline__ void qkprep(const Ctx& c, const Args& a, int layer, int widx, int nw) {
    bf16_t* QR = (bf16_t*)(a.ws + WS_QRAW); bf16_t* KV = (bf16_t*)(a.ws + WS_KV); const float* R = (const float*)(a.ws + WS_ROPE);
    const int half = c.lane >> 5, i = c.lane & 31, f = i & 15;
    const int d = i < 16 ? i : 32 + (i - 16);
    for (int it = widx; it < M * 5; it += nw) {
        const int m = it / 5, hh = (it % 5) * 2 + half;
        bf16_t* p = hh < 8 ? QR + (size_t)m * 512 + hh * 64 : KV + (size_t)m * 256 + (hh - 8) * 64;
        const float* gn = hh < 8 ? a.in[I_QNG] + layer * 64 : a.in[I_KNG] + layer * 64;
        const float x1 = bf1(p[d]), x2 = bf1(p[d + 16]);
        float ss = x1 * x1 + x2 * x2;
#pragma unroll
        for (int o = 1; o < 32; o <<= 1) ss += __shfl_xor(ss, o);
        const float rstd = rsqrtf(ss * (1.f / 64.f) + EPS);
        const float y1 = x1 * rstd * gn[d], y2 = x2 * rstd * gn[d + 16];
        const int s = m & (SEQ - 1);
        float cs, sn;
        if (i < 16) { const int pos = s >> 6; cs = R[pos * 16 + f]; sn = R[2048 + pos * 16 + f]; }
        else { const int pos = s & 63; cs = R[4096 + pos * 16 + f]; sn = R[5120 + pos * 16 + f]; }
        float o1 = y1 * cs - y2 * sn, o2 = y2 * cs + y1 * sn;
        if (hh < 8) { o1 *= C2; o2 *= C2; }
        p[d] = (bf16_t)f2bf(o1); p[d + 16] = (bf16_t)f2bf(o2);
    }
}

__device__ __forceinline__ void attn_naive_unit(const Ctx& c, const Args& a, int b, int h, int qblk) {
    const bf16_t* QR = (const bf16_t*)(a.ws + WS_QRAW); const bf16_t* KV = (const bf16_t*)(a.ws + WS_KV);
    bf16_t* Y = (bf16_t*)(a.ws + WS_Y); float* SSQA = (float*)(a.ws + WS_SSQA);
    float* Ks = (float*)c.lds; float* Vs = Ks + 64 * 64;
    const long row = (long)b * SEQ + qblk * 512 + c.tid; const int kvh = h >> 2;
    float q[64], o[64];
#pragma unroll
    for (int v = 0; v < 8; ++v) { const u32x4 w = *(const u32x4*)(QR + row * 512 + h * 64 + v * 8);
        q[v * 8 + 0] = bflo(w.x); q[v * 8 + 1] = bfhi(w.x); q[v * 8 + 2] = bflo(w.y); q[v * 8 + 3] = bfhi(w.y);
        q[v * 8 + 4] = bflo(w.z); q[v * 8 + 5] = bfhi(w.z); q[v * 8 + 6] = bflo(w.w); q[v * 8 + 7] = bfhi(w.w); }
#pragma unroll
    for (int dd = 0; dd < 64; ++dd) o[dd] = 0.f;
    float mrun = -1e30f, l = 0.f;
    const int lk = c.tid >> 3, lp = c.tid & 7;
    for (int t0 = 0; t0 < SEQ; t0 += 64) {
        __syncthreads();
        { const bf16_t* kp = KV + ((long)b * SEQ + t0 + lk) * 256 + kvh * 64 + lp * 8;
          const u32x4 kw = *(const u32x4*)kp, vw = *(const u32x4*)(kp + 128);
          float* kd = Ks + lk * 64 + lp * 8; float* vd = Vs + lk * 64 + lp * 8;
          kd[0] = bflo(kw.x); kd[1] = bfhi(kw.x); kd[2] = bflo(kw.y); kd[3] = bfhi(kw.y); kd[4] = bflo(kw.z); kd[5] = bfhi(kw.z); kd[6] = bflo(kw.w); kd[7] = bfhi(kw.w);
          vd[0] = bflo(vw.x); vd[1] = bfhi(vw.x); vd[2] = bflo(vw.y); vd[3] = bfhi(vw.y); vd[4] = bflo(vw.z); vd[5] = bfhi(vw.z); vd[6] = bflo(vw.w); vd[7] = bfhi(vw.w); }
        __syncthreads();
#pragma unroll 1
        for (int j = 0; j < 64; ++j) {
            float acc = 0.f; const float* kr = Ks + j * 64;
#pragma unroll
            for (int dd = 0; dd < 64; dd += 4) { const f32x4 kk = *(const f32x4*)(kr + dd); acc += q[dd] * kk[0] + q[dd + 1] * kk[1] + q[dd + 2] * kk[2] + q[dd + 3] * kk[3];
                if ((dd & 15) == 12) __builtin_amdgcn_sched_barrier(0); }
            if (acc > mrun) { const float sc = exp2f(mrun - acc); l *= sc; mrun = acc;
#pragma unroll
                for (int dd = 0; dd < 64; ++dd) o[dd] *= sc; }
            const float p = exp2f(acc - mrun); l += p; const float* vr = Vs + j * 64;
#pragma unroll
            for (int dd = 0; dd < 64; dd += 4) { const f32x4 vv = *(const f32x4*)(vr + dd); o[dd] += p * vv[0]; o[dd + 1] += p * vv[1]; o[dd + 2] += p * vv[2]; o[dd + 3] += p * vv[3];
                if ((dd & 15) == 12) __builtin_amdgcn_sched_barrier(0); }
        }
    }
    const float il = 1.f / l; float ss = 0.f;
#pragma unroll
    for (int v = 0; v < 8; ++v) { float t[8];
#pragma unroll
        for (int e = 0; e < 8; ++e) { t[e] = o[v * 8 + e] * il; ss += t[e] * t[e]; }
        u32x4 w; w.x = pk2(t[0], t[1]); w.y = pk2(t[2], t[3]); w.z = pk2(t[4], t[5]); w.w = pk2(t[6], t[7]);
        *(u32x4*)(Y + row * 1024 + 512 + h * 64 + v * 8) = w; }
    SSQA[row * 16 + h] = ss;
    __syncthreads();
}

template <int NV> __device__ __forceinline__ float top16(float (&v)[NV], int lane) {
    float res = -INFINITY;
    for (int it = 0; it < 16; ++it) {
        float m = v[0];
#pragma unroll
        for (int i = 1; i < NV; ++i) m = fmaxf(m, v[i]);
        m = wave_max(m);
#pragma unroll
        for (int i = 0; i < NV; ++i) if (v[i] == m) v[i] = -INFINITY;
        if (lane == it) res = m;
    }
    return res;
}
__device__ __forceinline__ float dot8(const u32x4 a, const u32x4 b) {
    return bflo(a.x) * bflo(b.x) + bfhi(a.x) * bfhi(b.x) + bflo(a.y) * bflo(b.y) + bfhi(a.y) * bfhi(b.y)
         + bflo(a.z) * bflo(b.z) + bfhi(a.z) * bfhi(b.z) + bflo(a.w) * bflo(b.w) + bfhi(a.w) * bfhi(b.w);
}
__device__ __forceinline__ void peer_topk(const Ctx& c, const Args& a, int layer, int widx, int nw) {
    const bf16_t* QP = (const bf16_t*)(a.ws + WS_QP);
    const bf16_t* SK1 = (const bf16_t*)(a.ws + WS_LW + (size_t)layer * LW_STRIDE + LW_SK1);
    const bf16_t* SK2 = (const bf16_t*)(a.ws + WS_LW + (size_t)layer * LW_STRIDE + LW_SK2);
    int* SELI = (int*)(a.ws + WS_SELI); float* SELW = (float*)(a.ws + WS_SELW);
    const int lane = c.lane;
    for (int it = widx; it < M * 8; it += nw) {
        const int t = it >> 3, h = it & 7;
        const bf16_t* qrow = QP + (size_t)t * 2048 + h * 256;
        const bf16_t* k1a = SK1 + ((size_t)(h * 128 + lane)) * 128; const bf16_t* k1b = k1a + 64 * 128;
        const bf16_t* k2a = SK2 + ((size_t)(h * 128 + lane)) * 128; const bf16_t* k2b = k2a + 64 * 128;
        float s1[2] = {0.f, 0.f}, s2[2] = {0.f, 0.f};
#pragma unroll 4
        for (int kk = 0; kk < 128; kk += 8) {
            const u32x4 q1 = *(const u32x4*)(qrow + kk), q2 = *(const u32x4*)(qrow + 128 + kk);
            s1[0] += dot8(q1, *(const u32x4*)(k1a + kk)); s1[1] += dot8(q1, *(const u32x4*)(k1b + kk));
            s2[0] += dot8(q2, *(const u32x4*)(k2a + kk)); s2[1] += dot8(q2, *(const u32x4*)(k2b + kk));
        }
        s1[0] = __uint_as_float((__float_as_uint(s1[0]) & ~127u) | (unsigned)lane); s1[1] = __uint_as_float((__float_as_uint(s1[1]) & ~127u) | (unsigned)(lane + 64));
        s2[0] = __uint_as_float((__float_as_uint(s2[0]) & ~127u) | (unsigned)lane); s2[1] = __uint_as_float((__float_as_uint(s2[1]) & ~127u) | (unsigned)(lane + 64));
        const float v1 = top16<2>(s1, lane), v2 = top16<2>(s2, lane);
        float cand[4];
#pragma unroll
        for (int mm = 0; mm < 4; ++mm) {
            const float va = __shfl(v1, (lane >> 4) + 4 * mm), vb = __shfl(v2, lane & 15);
            const unsigned ua = __float_as_uint(va), ub = __float_as_uint(vb);
            const float sum = __uint_as_float(ua & ~127u) + __uint_as_float(ub & ~127u);
            cand[mm] = __uint_as_float((__float_as_uint(sum) & ~16383u) | ((ua & 127u) << 7) | (ub & 127u));
        }
        const float best = top16<4>(cand, lane);
        const unsigned ub = __float_as_uint(best);
        const float sc = __uint_as_float(ub & ~16383u);
        const float mx = __shfl(sc, 0);
        const float e = lane < 16 ? __expf(sc - mx) : 0.f;
        const float sum = wave_sum(e);
        if (lane < 16) { SELI[(size_t)t * 128 + h * 16 + lane] = (int)(ub & 16383u); SELW[(size_t)t * 128 + h * 16 + lane] = e / sum; }
    }
}

__device__ __forceinline__ void peer_gather(const Ctx& c, const Args& a, int layer, int widx, int nw) {
    float* XR = a.out; bf16_t* XN2 = (bf16_t*)(a.ws + WS_XN2);
    const bf16_t* EU = (const bf16_t*)(a.ws + WS_EU) + (size_t)layer * 16384 * 1024;
    const bf16_t* EV = (const bf16_t*)(a.ws + WS_EV) + (size_t)layer * 16384 * 1024;
    const int* SELI = (const int*)(a.ws + WS_SELI); const float* SELW = (const float*)(a.ws + WS_SELW);
    const float* gf = a.in[I_NFFNG] + layer * D; const float* gp = a.in[I_NPLEG] + layer * D;
    const int lane = c.lane;
    for (int t = widx; t < M; t += nw) {
        float x[16], hh[16], acc[16];
        float* xr = XR + (size_t)t * D + 8 * lane;
        float ss = 0.f;
#pragma unroll
        for (int j = 0; j < 2; ++j) { const f32x4 u0 = *(const f32x4*)(xr + 512 * j), u1 = *(const f32x4*)(xr + 512 * j + 4);
#pragma unroll
            for (int e = 0; e < 4; ++e) { x[8 * j + e] = u0[e]; x[8 * j + 4 + e] = u1[e]; } }
#pragma unroll
        for (int e = 0; e < 16; ++e) { ss += x[e] * x[e]; acc[e] = 0.f; }
        ss = wave_sum(ss);
        const float rstd = rsqrtf(ss * (1.f / D) + EPS);
#pragma unroll
        for (int j = 0; j < 2; ++j)
#pragma unroll
            for (int e = 0; e < 8; ++e) hh[8 * j + e] = x[8 * j + e] * rstd * gf[512 * j + 8 * lane + e];
        const int idxA = SELI[(size_t)t * 128 + lane], idxB = SELI[(size_t)t * 128 + 64 + lane];
        const float wA = SELW[(size_t)t * 128 + lane], wB = SELW[(size_t)t * 128 + 64 + lane];
#pragma unroll 1
        for (int hf = 0; hf < 2; ++hf) {
            const int idxv = hf ? idxB : idxA; const float wv = hf ? wB : wA;
#pragma unroll 1
            for (int k0 = 0; k0 < 64; k0 += 4) {
                u32x4 ur[4][2], vr[4][2]; float w[4];
#pragma unroll
                for (int r = 0; r < 4; ++r) {
                    const int e = __builtin_amdgcn_readlane(idxv, k0 + r); w[r] = __uint_as_float(__builtin_amdgcn_readlane(__float_as_uint(wv), k0 + r));
                    const bf16_t* up = EU + (size_t)e * D + 8 * lane; const bf16_t* vp = EV + (size_t)e * D + 8 * lane;
                    ur[r][0] = *(const u32x4*)up; ur[r][1] = *(const u32x4*)(up + 512); vr[r][0] = *(const u32x4*)vp; vr[r][1] = *(const u32x4*)(vp + 512);
                }
#pragma unroll
                for (int r = 0; r < 4; ++r) {
                    float d = 0.f;
#pragma unroll
                    for (int j = 0; j < 2; ++j) { const u32x4 uw = ur[r][j];
                        d += hh[8 * j + 0] * bflo(uw.x) + hh[8 * j + 1] * bfhi(uw.x) + hh[8 * j + 2] * bflo(uw.y) + hh[8 * j + 3] * bfhi(uw.y)
                           + hh[8 * j + 4] * bflo(uw.z) + hh[8 * j + 5] * bfhi(uw.z) + hh[8 * j + 6] * bflo(uw.w) + hh[8 * j + 7] * bfhi(uw.w); }
                    d = wave_sum(d);
                    const float av = gelu_tanh(d) * w[r];
#pragma unroll
                    for (int j = 0; j < 2; ++j) { const u32x4 vw = vr[r][j];
                        acc[8 * j + 0] += av * bflo(vw.x); acc[8 * j + 1] += av * bfhi(vw.x); acc[8 * j + 2] += av * bflo(vw.y); acc[8 * j + 3] += av * bfhi(vw.y);
                        acc[8 * j + 4] += av * bflo(vw.z); acc[8 * j + 5] += av * bfhi(vw.z); acc[8 * j + 6] += av * bflo(vw.w); acc[8 * j + 7] += av * bfhi(vw.w); }
                }
            }
        }
        float s2 = 0.f;
#pragma unroll
        for (int e = 0; e < 16; ++e) { x[e] += acc[e]; s2 += x[e] * x[e]; }
        s2 = wave_sum(s2);
        const float rstd2 = rsqrtf(s2 * (1.f / D) + EPS);
#pragma unroll
        for (int j = 0; j < 2; ++j) {
            *(f32x4*)(xr + 512 * j) = (f32x4){x[8 * j + 0], x[8 * j + 1], x[8 * j + 2], x[8 * j + 3]};
            *(f32x4*)(xr + 512 * j + 4) = (f32x4){x[8 * j + 4], x[8 * j + 5], x[8 * j + 6], x[8 * j + 7]};
            float y[8];
#pragma unroll
            for (int e = 0; e < 8; ++e) y[e] = x[8 * j + e] * rstd2 * gp[512 * j + 8 * lane + e];
            u32x4 o; o.x = pk2(y[0], y[1]); o.y = pk2(y[2], y[3]); o.z = pk2(y[4], y[5]); o.w = pk2(y[6], y[7]);
            *(u32x4*)(XN2 + (size_t)t * D + 512 * j + 8 * lane) = o;
        }
    }
}

__device__ __forceinline__ void final_norm(const Ctx& c, const Args& a, int widx, int nw) {
    const float* gfin = a.in[I_FING];
    for (int m = widx; m < M; m += nw) {
        f32x4* xr = (f32x4*)(a.out + (size_t)m * D) + c.lane; f32x4 v[4]; float s = 0.f;
#pragma unroll
        for (int j = 0; j < 4; ++j) { v[j] = xr[64 * j]; s += v[j][0] * v[j][0] + v[j][1] * v[j][1] + v[j][2] * v[j][2] + v[j][3] * v[j][3]; }
        s = wave_sum(s); const float rstd = rsqrtf(s * (1.f / D) + EPS);
#pragma unroll
        for (int j = 0; j < 4; ++j) { const f32x4 gg = *((const f32x4*)gfin + 64 * j + c.lane); xr[64 * j] = v[j] * rstd * gg; }
    }
}

__global__ void __launch_bounds__(512, 2) mk_fwd(Args a) {
    extern __shared__ __attribute__((aligned(16))) unsigned char lds[];
    Ctx c0; c0.tid = threadIdx.x; c0.lane = c0.tid & 63; c0.wave = __builtin_amdgcn_readfirstlane(c0.tid >> 6); c0.blk = blockIdx.x; c0.nblk = gridDim.x; c0.lds = lds;
    const Ctx& c = c0;
    volatile LAS unsigned* MISC = (volatile LAS unsigned*)((LAS unsigned char*)lds + MISC_OFF);
    for (int u = c.tid; u < (LDS_BYTES - LDSCTL_OFF) / 4; u += 512) ((LAS unsigned*)((LAS unsigned char*)lds + LDSCTL_OFF))[u] = 0u;
    __syncthreads();
    const bool multi = (a.ph_hi - a.ph_lo) > 1;
    XcdBarrier bar; bar.bar = (unsigned*)(a.ws + WS_CTL) + CW_BAR; bar.x = 0; bar.st = nullptr;
    if (multi) bar = xcd_barrier_post((unsigned*)(a.ws + WS_CTL) + CW_BAR, MISC + 8);
    const int gw = c.blk * 8 + c.wave, NGW = c.nblk * 8;

#define IN(k) (lo <= (k) && (k) < hi)
#define SEAM(k) do { if (IN(k) && IN((k) + 1)) xcd_barrier(bar); } while (0)
    const int lo = a.ph_lo, hi = a.ph_hi;
    if (IN(0)) {
#ifndef SKIP_P0
        p0_prologue(c, a);
#endif
    }
    SEAM(0);
#pragma unroll 1
    for (int layer = 0; layer < 2; ++layer) {
        const int pb = 1 + 9 * layer;
        Ctx c = c0; { int t_ = c0.tid; asm volatile("" : "+v"(t_)); c.tid = t_; c.lane = t_ & 63; }
        unsigned char* lw = a.ws + WS_LW + (size_t)layer * LW_STRIDE;
        if (IN(pb + 0)) {
            GemmD g; g.A = (const bf16_t*)(a.ws + WS_XB); g.lda = D; g.Bt = (const bf16_t*)(lw + LW_WIN); g.ldb = D; g.K = D; g.kmid = -1;
            EpiInproj E; E.ssq0 = (const float*)(a.ws + WS_SSQ0); E.ucat = (bf16_t*)(a.ws + WS_UCAT); E.qraw = (bf16_t*)(a.ws + WS_QRAW); E.kv = (bf16_t*)(a.ws + WS_KV);
            gemm_phase_dense(c, g, M / 256, DIN / 256, E);
        }
        SEAM(pb + 0);
        if (IN(pb + 1)) {
            if (c.nblk > 64) {
                if (c.blk < 64) s1_unit(c, a, layer, c.blk);
                else qkprep(c, a, layer, (c.blk - 64) * 8 + c.wave, (c.nblk - 64) * 8);
            } else {
                for (int u = c.blk; u < 64; u += c.nblk) s1_unit(c, a, layer, u);
                qkprep(c, a, layer, gw, NGW);
            }
        }
        SEAM(pb + 1);
        if (IN(pb + 2)) {
            GemmD g; g.A = (const bf16_t*)(a.ws + WS_UCAT); g.lda = KCAT; g.Bt = (const bf16_t*)(lw + LW_WY); g.ldb = KCAT; g.K = KCAT; g.kmid = -1;
            EpiS2 E; E.G = (bf16_t*)(a.ws + WS_G);
            for (int ui = c.blk; ui < 128; ui += c.nblk) { Unit u; u.pm = ui >> 1; u.pn = (ui >> 2) * 2 + (ui & 1); sgemm_unit(g, u, E, c.wave, c.lane); }
#ifndef SKIP_ATT
            for (int ui = c.blk; ui < 256; ui += c.nblk) attn_naive_unit(c, a, ui >> 7, (ui >> 4) & 7, ui & 15);
#endif
        }
        SEAM(pb + 2);
        if (IN(pb + 3)) {
            GemmD g; g.A = (const bf16_t*)(a.ws + WS_G); g.lda = 512; g.Bt = (const bf16_t*)(lw + LW_WGLU); g.ldb = 512; g.K = 512; g.kmid = -1;
            EpiGlu E; E.G = (const bf16_t*)(a.ws + WS_G); E.bglu = a.in[I_BGLU] + layer * 512; E.Y = (bf16_t*)(a.ws + WS_Y); E.ssqs = (float*)(a.ws + WS_SSQS);
            gemm_phase_dense(c, g, M / 256, 2, E);
        }
        SEAM(pb + 3);
        if (IN(pb + 4)) {
            GemmD g; g.A = (const bf16_t*)(a.ws + WS_Y); g.lda = D; g.Bt = (const bf16_t*)(lw + LW_WOUT); g.ldb = D; g.K = D; g.kmid = 512;
            EpiOut E; E.ssqs = (const float*)(a.ws + WS_SSQS); E.ssqa = (const float*)(a.ws + WS_SSQA); E.xin = layer == 0 ? a.in[I_X] : a.out; E.xres = a.out;
            E.xb = (bf16_t*)(a.ws + WS_XB); E.ssq1 = (float*)(a.ws + WS_SSQ1);
            gemm_phase_dense(c, g, M / 256, 4, E);
        }
        SEAM(pb + 4);
        if (IN(pb + 5)) {
            GemmD g; g.A = (const bf16_t*)(a.ws + WS_XB); g.lda = D; g.Bt = (const bf16_t*)(lw + LW_WQ); g.ldb = D; g.K = D; g.kmid = -1;
            EpiQ E; E.ssq1 = (const float*)(a.ws + WS_SSQ1); E.qp = (bf16_t*)(a.ws + WS_QP);
            gemm_phase_dense(c, g, M / 256, 8, E);
        }
        SEAM(pb + 5);
        if (IN(pb + 6)) {
#ifndef SKIP_TOPK
            peer_topk(c, a, layer, gw, NGW);
#endif
        }
        SEAM(pb + 6);
        if (IN(pb + 7)) {
#ifndef SKIP_GATHER
            peer_gather(c, a, layer, gw, NGW);
#endif
        }
        SEAM(pb + 7);
        if (IN(pb + 8)) {
            GemmD g1; g1.A = (const bf16_t*)(a.ws + WS_PB) + (size_t)layer * M * 256; g1.lda = 256; g1.Bt = (const bf16_t*)(lw + LW_WPROJ); g1.ldb = 256; g1.K = 256; g1.kmid = -1;
            EpiProj E1; E1.pr = (float*)(a.ws + WS_QP);
            gemm_phase_dense(c, g1, M / 256, 4, E1);
            VM_WAIT(); __syncthreads();
            GemmD g2; g2.A = (const bf16_t*)(a.ws + WS_XN2); g2.lda = D; g2.Bt = (const bf16_t*)(lw + LW_WGATE); g2.ldb = D; g2.K = D; g2.kmid = -1;
            EpiGate E2; E2.pr = (const float*)(a.ws + WS_QP); E2.xres = a.out; E2.xb = (bf16_t*)(a.ws + WS_XB); E2.ssq0 = (float*)(a.ws + WS_SSQ0);
            gemm_phase_dense(c, g2, M / 256, 4, E2);
        }
        SEAM(pb + 8);
    }
    if (IN(NPHASE - 1)) final_norm(c, a, gw, NGW);
#undef IN
#undef SEAM
}

extern "C" void kernel_launch(void* const* d_in, const int* in_sizes, int n_in, void* d_out, int out_size, void* d_ws, size_t ws_size, hipStream_t stream) {
    static int grid = 0;
    if (grid == 0) {
        if (n_in != 29 || in_sizes[0] != M * D || out_size != M * D || in_sizes[3] != 2 * D * DIN || ws_size < WS_END) {
            fprintf(stderr, "kernel_launch: unexpected problem: n_in %d in0 %d in3 %d out %d ws %zu (need %zu); nothing launched\n", n_in, n_in > 0 ? in_sizes[0] : -1, n_in > 3 ? in_sizes[3] : -1, out_size, ws_size, (size_t)WS_END);
            grid = -1; return; }
        int dev = 0, cus = 0, per_cu = 0;
        if (hipGetDevice(&dev) != hipSuccess || hipDeviceGetAttribute(&cus, hipDeviceAttributeMultiprocessorCount, dev) != hipSuccess) { grid = -1; return; }
        if (hipFuncSetAttribute((const void*)mk_fwd, hipFuncAttributeMaxDynamicSharedMemorySize, LDS_BYTES) != hipSuccess) { fprintf(stderr, "kernel_launch: hipFuncSetAttribute failed\n"); grid = -1; return; }
        if (hipOccupancyMaxActiveBlocksPerMultiprocessor(&per_cu, (const void*)mk_fwd, 512, LDS_BYTES) != hipSuccess || per_cu < 1)
            fprintf(stderr, "kernel_launch: note: occupancy query reports %d workgroups per CU\n", per_cu);
        (void)hipGetLastError();
        grid = cus;
    }
    if (grid < 0) return;
    (void)hipMemsetAsync((char*)d_ws + WS_CTL, 0, CTL_ZERO_BYTES, stream);
    Args a{};
    for (int i = 0; i < 29; ++i) a.in[i] = (const float*)d_in[i];
    a.out = (float*)d_out; a.ws = (unsigned char*)d_ws;
    constexpr int NL = MK_N_LAUNCHES;
    for (int li = 0; li < NL; ++li) {
        a.ph_lo = (NPHASE * li) / NL; a.ph_hi = (NPHASE * (li + 1)) / NL;
        hipLaunchKernelGGL(mk_fwd, dim3(grid), dim3(512), LDS_BYTES, stream, a);
    }
}
```

```cpp
#include <hip/hip_runtime.h>
#include <cstdio>
#include <cstdint>

#ifndef MK_N_LAUNCHES
#define MK_N_LAUNCHES 1
#endif

#define LAS __attribute__((address_space(3)))
typedef unsigned short bf16_t;
typedef short bf16x8 __attribute__((ext_vector_type(8)));
typedef float f32x4 __attribute__((ext_vector_type(4)));
typedef unsigned u32x4 __attribute__((ext_vector_type(4)));
typedef unsigned u32x2 __attribute__((ext_vector_type(2)));

constexpr int NB = 2, SEQ = 8192, M = NB * SEQ, D = 1024, DIN = 1280;
constexpr int NG = 32, LCH = 32, NCH = SEQ / LCH, KCAT = 768;
constexpr float EPS = 1e-6f;
constexpr float C2 = 0.125f * 1.4426950408889634f;
constexpr int NPHASE = 20;

constexpr size_t MiB = 1u << 20;
constexpr size_t WS_CTL = 0, CTL_ZERO_BYTES = 1 * MiB;
constexpr size_t WS_EU = 1 * MiB, WS_EV = 65 * MiB;
constexpr size_t WS_LW = 129 * MiB, LW_STRIDE = 48 * MiB;
constexpr size_t LW_WIN = 0, LW_WGLU = 3 * MiB, LW_WOUT = 4 * MiB, LW_WQ = 6 * MiB, LW_SK1 = 10 * MiB, LW_SK2 = 10 * MiB + 512 * 1024,
                 LW_WGATE = 11 * MiB, LW_WPROJ = 13 * MiB, LW_AL = 13 * MiB + 512 * 1024, LW_WE = 14 * MiB, LW_WY = 22 * MiB;
constexpr size_t WS_PB = 225 * MiB, WS_ROPE = 241 * MiB, WS_XB = 242 * MiB, WS_UCAT = 274 * MiB, WS_QRAW = 300 * MiB, WS_KV = 316 * MiB,
                 WS_EBUF = 324 * MiB, WS_G = 340 * MiB, WS_Y = 356 * MiB, WS_SSQS = 388 * MiB, WS_SSQA = 389 * MiB, WS_SSQ0 = 390 * MiB, WS_SSQ1 = 391 * MiB,
                 WS_QP = 392 * MiB  , WS_SELI = 456 * MiB, WS_SELW = 464 * MiB, WS_XN2 = 472 * MiB, WS_END = 504 * MiB;
constexpr int CW_BAR = 4096;

constexpr int RING_BYTES = 131072, LDSCTL_OFF = RING_BYTES, MISC_OFF = LDSCTL_OFF + 320, LDS_BYTES = 147456;

__device__ __forceinline__ unsigned f2bf(float f) { unsigned u = __float_as_uint(f); return (u + 0x7fffu + ((u >> 16) & 1u)) >> 16; }
__device__ __forceinline__ unsigned pk2(float lo, float hi) { return f2bf(lo) | (f2bf(hi) << 16); }
__device__ __forceinline__ float bflo(unsigned w) { return __uint_as_float(w << 16); }
__device__ __forceinline__ float bfhi(unsigned w) { return __uint_as_float(w & 0xffff0000u); }
__device__ __forceinline__ float bf1(bf16_t h) { return __uint_as_float((unsigned)h << 16); }
__device__ __forceinline__ float wave_sum(float v) {
#pragma unroll
    for (int o = 1; o < 64; o <<= 1) v += __shfl_xor(v, o);
    return v;
}
__device__ __forceinline__ float wave_max(float v) {
#pragma unroll
    for (int o = 1; o < 64; o <<= 1) v = fmaxf(v, __shfl_xor(v, o));
    return v;
}
__device__ __forceinline__ float sigmoidf_(float x) { return 1.f / (1.f + __expf(-x)); }
__device__ __forceinline__ float gelu_tanh(float x) {
    const float z = 0.7978845608028654f * (x + 0.044715f * x * x * x);
    const float e = __expf(2.f * z);
    const float th = 1.f - 2.f / (e + 1.f);
    return 0.5f * x * (1.f + th);
}
__device__ __forceinline__ float sumn(const float* p, int n) { float s = 0.f; for (int i = 0; i < n; ++i) s += p[i]; return s; }
#define LDS_WAIT() asm volatile("s_waitcnt lgkmcnt(0)" ::: "memory")
#define VM_WAIT() asm volatile("s_waitcnt vmcnt(0)" ::: "memory")

#define XB_TMO      128
#define XB_XCNT(j)  (256  + 64 * (j))
#define XB_XSUB(j)  (1280 + 64 * (j))
#define XB_XGEN(j)  (2304 + 64 * (j))
#define XB_TOP      3328
#define XB_TOPGEN   3392
#define XCD_BAR_WORDS 3456
#define XB_SPIN_CAP (1u << 18)
__device__ __forceinline__ unsigned xb_ld(unsigned* p)              { return __hip_atomic_load(p, __ATOMIC_RELAXED, __HIP_MEMORY_SCOPE_AGENT); }
__device__ __forceinline__ unsigned xb_add(unsigned* p, unsigned v) { return __hip_atomic_fetch_add(p, v, __ATOMIC_RELAXED, __HIP_MEMORY_SCOPE_AGENT); }
__device__ __forceinline__ unsigned xb_xcc_id() { return (unsigned)__builtin_amdgcn_s_getreg((3 << 11) | 20) & 0xFu; }
#define XB_SPIN(cond, bar) do { unsigned _sp = 0; while (cond) { __builtin_amdgcn_s_sleep(1); \
    if ((++_sp & 255u) == 0u) { if (xb_ld(&(bar)[XB_TMO])) break; if (_sp > XB_SPIN_CAP) { atomicAdd(&(bar)[XB_TMO], 1u); break; } } } } while (0)
struct XcdBarrier { unsigned* bar; unsigned x; volatile LAS unsigned* st; };
__device__ __forceinline__ XcdBarrier xcd_barrier_post(unsigned* bar, volatile LAS unsigned* st) {
    XcdBarrier b; b.bar = bar; b.x = xb_xcc_id(); b.st = st;
    if (threadIdx.x == 0) (void)xb_add(&bar[XB_XCNT(b.x)], 1u);
    return b;
}
__device__ __forceinline__ void xcd_barrier_complete(unsigned* bar, unsigned x, unsigned& nloc, unsigned& nx) {
    const unsigned G = gridDim.x * gridDim.y * gridDim.z;
    unsigned sum, cnt, mine, sp = 0u;
    for (;;) {
        sum = 0u; cnt = 0u; mine = 0u;
#pragma unroll
        for (unsigned j = 0; j < 16; ++j) { const unsigned c = xb_ld(&bar[XB_XCNT(j)]); sum += c; cnt += (c > 0u) ? 1u : 0u; mine = (j == x) ? c : mine; }
        if (sum == G) break;
        __builtin_amdgcn_s_sleep(1);
        if ((++sp & 255u) == 0u) { if (xb_ld(&bar[XB_TMO])) break; if (sp > XB_SPIN_CAP) { atomicAdd(&bar[XB_TMO], 1u); break; } }
    }
    nloc = mine > 0u ? mine : 1u; nx = cnt > 0u ? cnt : 1u;
}
__device__ __forceinline__ void xcd_barrier(const XcdBarrier& b) {
    asm volatile("s_waitcnt vmcnt(0)" ::: "memory");
    __syncthreads();
    if (threadIdx.x == 0) {
        unsigned* bar = b.bar;
        __builtin_amdgcn_s_waitcnt(0);
        unsigned nloc = b.st[0], nx = b.st[1];
        if (nloc == 0u) { xcd_barrier_complete(bar, b.x, nloc, nx); b.st[0] = nloc; b.st[1] = nx; }
        const unsigned old = xb_add(&bar[XB_XSUB(b.x)], 1u);
        const unsigned gen = old / nloc;
        if (old + 1u == (gen + 1u) * nloc) {
            __builtin_amdgcn_fence(__ATOMIC_RELEASE, "agent");
            asm volatile("s_waitcnt vmcnt(0)" ::: "memory");
            const unsigned og = xb_add(&bar[XB_TOP], 1u);
            const unsigned tg = og / nx;
            if (og + 1u == (tg + 1u) * nx) xb_add(&bar[XB_TOPGEN], 1u);
            else XB_SPIN(xb_ld(&bar[XB_TOPGEN]) == tg, bar);
            __builtin_amdgcn_fence(__ATOMIC_ACQUIRE, "agent");
            xb_add(&bar[XB_XGEN(b.x)], 1u);
            asm volatile("s_waitcnt vmcnt(0)" ::: "memory");
        } else {
            XB_SPIN(xb_ld(&bar[XB_XGEN(b.x)]) == gen, bar);
            __builtin_amdgcn_fence(__ATOMIC_ACQUIRE, "agent");
            asm volatile("s_waitcnt vmcnt(0)" ::: "memory");
        }
    }
    __syncthreads();
}

struct Args { const float* in[29]; float* out; unsigned char* ws; int ph_lo, ph_hi; };
enum { I_X = 0, I_P, I_NMIXG, I_WIN, I_LRE, I_LIM, I_LOGDT, I_BRE, I_BIM, I_CRE, I_CIM, I_DSKIP, I_WGLU, I_BGLU, I_QNG, I_KNG, I_SSMG, I_ATTG, I_WOUT,
       I_NFFNG, I_WQ, I_SK1, I_SK2, I_EU, I_EV, I_NPLEG, I_WGATE, I_WPROJ, I_FING };

struct Ctx { int tid, lane, wave, blk, nblk; unsigned char* lds; };

struct GemmD { const bf16_t* A; long lda; const bf16_t* Bt; long ldb; int K; int kmid; };
struct Unit { int pm, pn; };

template <class Epi>
__device__ __forceinline__ void sgemm_unit(const GemmD& g, const Unit u, const Epi& E, int wave, int lane) {
    const int i = lane & 15, q = lane >> 4;
    const bf16_t* Ab = g.A + (long)(u.pm * 256 + wave * 32) * g.lda;
    const bf16_t* Bb = g.Bt + (long)(u.pn * 256) * g.ldb;
    const int row0 = u.pm * 256 + wave * 32 + i;
    float ssq[2] = {0.f, 0.f};
    float rs[2] = {1.f, 1.f};
    if constexpr (Epi::ROWSCALE) { rs[0] = E.rscale(row0); rs[1] = E.rscale(row0 + 16); }
    for (int cg = 0; cg < 4; ++cg) {
        f32x4 acc[2][4];
#pragma unroll
        for (int mi = 0; mi < 2; ++mi)
#pragma unroll
            for (int ni = 0; ni < 4; ++ni) acc[mi][ni] = (f32x4){0.f, 0.f, 0.f, 0.f};
        for (int k0 = 0; k0 < g.K; k0 += 32) {
            if constexpr (Epi::MID) { if (k0 == g.kmid) {
#pragma unroll
                for (int mi = 0; mi < 2; ++mi) { const float f = E.mid(row0 + 16 * mi);
#pragma unroll
                    for (int ni = 0; ni < 4; ++ni) acc[mi][ni] *= f; } } }
            bf16x8 a[2], b[4];
#pragma unroll
            for (int mi = 0; mi < 2; ++mi) a[mi] = *(const bf16x8*)(Ab + (long)(16 * mi + i) * g.lda + k0 + 8 * q);
#pragma unroll
            for (int ni = 0; ni < 4; ++ni) b[ni] = *(const bf16x8*)(Bb + (long)(cg * 64 + 16 * ni + i) * g.ldb + k0 + 8 * q);
#pragma unroll
            for (int mi = 0; mi < 2; ++mi)
#pragma unroll
                for (int ni = 0; ni < 4; ++ni) acc[mi][ni] = __builtin_amdgcn_mfma_f32_16x16x32_bf16(b[ni], a[mi], acc[mi][ni], 0, 0, 0);
        }
#pragma unroll
        for (int mi = 0; mi < 2; ++mi)
#pragma unroll
            for (int ni = 0; ni < 4; ++ni) {
                const f32x4 v = acc[mi][ni] * rs[mi];
                const f32x4 w = E.put(row0 + 16 * mi, u.pn * 256 + cg * 64 + 16 * ni + 4 * q, v);
                ssq[mi] += w[0] * w[0] + w[1] * w[1] + w[2] * w[2] + w[3] * w[3];
            }
    }
    if constexpr (Epi::SSQ) {
#pragma unroll
        for (int mi = 0; mi < 2; ++mi) { float s = ssq[mi]; s += __shfl_xor(s, 16); s += __shfl_xor(s, 32);
            if (q == 0) { E.ssq(row0 + 16 * mi, u.pn * 4 + 0, s); E.ssq(row0 + 16 * mi, u.pn * 4 + 1, 0.f); E.ssq(row0 + 16 * mi, u.pn * 4 + 2, 0.f); E.ssq(row0 + 16 * mi, u.pn * 4 + 3, 0.f); } }
    }
}

__device__ __forceinline__ u32x2 pack4(f32x4 v) { u32x2 w; w.x = pk2(v[0], v[1]); w.y = pk2(v[2], v[3]); return w; }

struct EpiInproj {
    static constexpr bool MID = false, ROWSCALE = true, SSQ = false;
    const float* ssq0; bf16_t* ucat; bf16_t* qraw; bf16_t* kv;
    __device__ __forceinline__ float rscale(int row) const { return rsqrtf(sumn(ssq0 + (long)row * 16, 16) * (1.f / D) + EPS); }
    __device__ __forceinline__ f32x4 put(int row, int col, f32x4 v) const {
        const u32x2 w = pack4(v);
        if (col < 512) { const int g = col >> 4, qq = col & 15, b = row >> 13, s = row & (SEQ - 1), c = s >> 5, j = s & 31;
            *(u32x2*)(ucat + ((long)((g * 2 + b) * NCH + c) * KCAT + j * 16 + qq)) = w; }
        else if (col < 1024) *(u32x2*)(qraw + (long)row * 512 + (col - 512)) = w;
        else *(u32x2*)(kv + (long)row * 256 + (col - 1024)) = w;
        return v;
    }
    __device__ __forceinline__ void ssq(int, int, float) const {}
};
struct EpiS1 {
    static constexpr bool MID = false, ROWSCALE = false, SSQ = false;
    float* ebuf;
    __device__ __forceinline__ f32x4 put(int row, int col, f32x4 v) const { *(f32x4*)(ebuf + ((long)row * 256 + (col & 255))) = v; return v; }
    __device__ __forceinline__ void ssq(int, int, float) const {}
};
struct EpiS2 {
    static constexpr bool MID = false, ROWSCALE = false, SSQ = false;
    bf16_t* G;
    __device__ __forceinline__ f32x4 put(int row, int col, f32x4 v) const {
        const int pm = row >> 8, c = row & 255, g = pm >> 1, b = pm & 1, nout = col & 511, j = nout >> 4, p = nout & 15;
        const long tok = (long)b * SEQ + c * LCH + j;
        f32x4 y; y[0] = gelu_tanh(v[0]); y[1] = gelu_tanh(v[1]); y[2] = gelu_tanh(v[2]); y[3] = gelu_tanh(v[3]);
        *(u32x2*)(G + tok * 512 + 16 * g + p) = pack4(y); return v;
    }
    __device__ __forceinline__ void ssq(int, int, float) const {}
};
struct EpiGlu {
    static constexpr bool MID = false, ROWSCALE = false, SSQ = true;
    const bf16_t* G; const float* bglu; bf16_t* Y; float* ssqs;
    __device__ __forceinline__ f32x4 put(int row, int col, f32x4 v) const {
        const u32x2 gw = *(const u32x2*)(G + (long)row * 512 + col);
        const f32x4 bb = *(const f32x4*)(bglu + col);
        f32x4 ys; ys[0] = bflo(gw.x) * sigmoidf_(v[0] + bb[0]); ys[1] = bfhi(gw.x) * sigmoidf_(v[1] + bb[1]);
        ys[2] = bflo(gw.y) * sigmoidf_(v[2] + bb[2]); ys[3] = bfhi(gw.y) * sigmoidf_(v[3] + bb[3]);
        *(u32x2*)(Y + (long)row * 1024 + col) = pack4(ys); return ys;
    }
    __device__ __forceinline__ void ssq(int row, int slot, float s) const { ssqs[(long)row * 16 + slot] = s; }
};
struct EpiOut {
    static constexpr bool MID = true, ROWSCALE = true, SSQ = true;
    const float* ssqs; const float* ssqa; const float* xin; float* xres; bf16_t* xb; float* ssq1;
    __device__ __forceinline__ float rs_s(int row) const { return rsqrtf(sumn(ssqs + (long)row * 16, 8) * (1.f / 512.f) + EPS); }
    __device__ __forceinline__ float rs_a(int row) const { return rsqrtf(sumn(ssqa + (long)row * 16, 8) * (1.f / 512.f) + EPS); }
    __device__ __forceinline__ float mid(int row) const { return rs_s(row) / rs_a(row); }
    __device__ __forceinline__ float rscale(int row) const { return rs_a(row); }
    __device__ __forceinline__ f32x4 put(int row, int col, f32x4 v) const {
        const long o = (long)row * D + col; const f32x4 x1 = *(const f32x4*)(xin + o) + v;
        *(f32x4*)(xres + o) = x1; *(u32x2*)(xb + o) = pack4(x1); return x1;
    }
    __device__ __forceinline__ void ssq(int row, int slot, float s) const { ssq1[(long)row * 16 + slot] = s; }
};
struct EpiQ {
    static constexpr bool MID = false, ROWSCALE = true, SSQ = false;
    const float* ssq1; bf16_t* qp;
    __device__ __forceinline__ float rscale(int row) const { return rsqrtf(sumn(ssq1 + (long)row * 16, 16) * (1.f / D) + EPS); }
    __device__ __forceinline__ f32x4 put(int row, int col, f32x4 v) const { *(u32x2*)(qp + (long)row * 2048 + col) = pack4(v); return v; }
    __device__ __forceinline__ void ssq(int, int, float) const {}
};
struct EpiProj {
    static constexpr bool MID = false, ROWSCALE = false, SSQ = false;
    float* pr;
    __device__ __forceinline__ f32x4 put(int row, int col, f32x4 v) const { *(f32x4*)(pr + (long)row * D + col) = v; return v; }
    __device__ __forceinline__ void ssq(int, int, float) const {}
};
struct EpiGate {
    static constexpr bool MID = false, ROWSCALE = false, SSQ = true;
    const float* pr; float* xres; bf16_t* xb; float* ssq0;
    __device__ __forceinline__ f32x4 put(int row, int col, f32x4 v) const {
        const long o = (long)row * D + col; const f32x4 pv = *(const f32x4*)(pr + o); f32x4 x3 = *(const f32x4*)(xres + o);
        x3[0] += sigmoidf_(v[0]) * pv[0]; x3[1] += sigmoidf_(v[1]) * pv[1]; x3[2] += sigmoidf_(v[2]) * pv[2]; x3[3] += sigmoidf_(v[3]) * pv[3];
        *(f32x4*)(xres + o) = x3; *(u32x2*)(xb + o) = pack4(x3); return x3;
    }
    __device__ __forceinline__ void ssq(int row, int slot, float s) const { ssq0[(long)row * 16 + slot] = s; }
};

template <class Epi>
__device__ __forceinline__ void gemm_phase_dense(const Ctx& c, const GemmD& g, int nM, int nN, const Epi& E) {
    const int nU = nM * nN;
    for (int ui = c.blk; ui < nU; ui += c.nblk) { Unit u; u.pn = ui % nN; u.pm = ui / nN; sgemm_unit(g, u, E, c.wave, c.lane); }
}

__device__ __forceinline__ void transpose_item(const float* W, int K, int N, bf16_t* WT, const float* gain, float* scr, int item, int lane) {
    const int nblk = N / 32, kb = item / nblk, nb = item % nblk, k0 = 64 * kb, n0 = 32 * nb;
#pragma unroll 8
    for (int i = 0; i < 32; ++i) { const int kk = 2 * i + (lane >> 5); float v = W[(size_t)(k0 + kk) * N + n0 + (lane & 31)]; if (gain) v *= gain[k0 + kk]; scr[kk * 33 + (lane & 31)] = v; }
    LDS_WAIT(); asm volatile("" ::: "memory");
    const int cc = lane & 7;
#pragma unroll
    for (int j = 0; j < 4; ++j) { const int n = (lane >> 3) + 8 * j; const float* s = scr + (8 * cc) * 33 + n;
        u32x4 o; o.x = pk2(s[0 * 33], s[1 * 33]); o.y = pk2(s[2 * 33], s[3 * 33]); o.z = pk2(s[4 * 33], s[5 * 33]); o.w = pk2(s[6 * 33], s[7 * 33]);
        *(u32x4*)(WT + (size_t)(n0 + n) * K + k0 + 8 * cc) = o; }
    LDS_WAIT(); asm volatile("" ::: "memory");
}
__device__ __forceinline__ void cvt_range(const Ctx& c, const float* src, bf16_t* dst, size_t n) {
    const size_t nv = n / 8, stride = (size_t)c.nblk * 512;
    for (size_t v = (size_t)c.blk * 512 + c.tid; v < nv; v += stride) {
        const f32x4 a = *(const f32x4*)(src + v * 8), b = *(const f32x4*)(src + v * 8 + 4);
        u32x4 o; o.x = pk2(a[0], a[1]); o.y = pk2(a[2], a[3]); o.z = pk2(b[0], b[1]); o.w = pk2(b[2], b[3]);
        *(u32x4*)(dst + v * 8) = o;
    }
}
__device__ __forceinline__ void ssm_tables_unit(const Ctx& c, const Args& a, int layer, int g) {
    float* Apow = (float*)c.lds;
    float* Bre = Apow + 2 * 33 * 64 * 2;
    float* Bim = Bre + 2 * 64 * 16;
    float* Cre = Bim + 2 * 64 * 16;
    float* Cim = Cre + 2 * 16 * 64;
    float* Tt = Cim + 2 * 16 * 64;
    unsigned char* lw = a.ws + WS_LW + (size_t)layer * LW_STRIDE;
    float* AL = (float*)(lw + LW_AL);
    bf16_t* WE = (bf16_t*)(lw + LW_WE) + (size_t)g * 256 * 512;
    bf16_t* WY = (bf16_t*)(lw + LW_WY) + (size_t)g * 512 * KCAT;
    const int tid = c.tid;
    __syncthreads();
    if (tid < 128) {
        const int dir = tid >> 6, n = tid & 63; const int ldg = (layer * 2 + dir) * NG + g;
        const float lre = a.in[I_LRE][ldg * 64 + n], lim = a.in[I_LIM][ldg * 64 + n];
        const float dt = expf(a.in[I_LOGDT][ldg]);
        for (int k = 0; k <= 32; ++k) { const float dec = expf(lre * dt * (float)k), ang = (lim * dt) * (float)k; float sn, cs; sincosf(ang, &sn, &cs);
            Apow[((dir * 33 + k) * 64 + n) * 2 + 0] = dec * cs; Apow[((dir * 33 + k) * 64 + n) * 2 + 1] = dec * sn; }
        const float abr = Apow[((dir * 33 + 1) * 64 + n) * 2 + 0], abi = Apow[((dir * 33 + 1) * 64 + n) * 2 + 1];
        const float den = lre * lre + lim * lim, nr = abr - 1.f;
        const float fre = (nr * lre + abi * lim) / den, fim = (abi * lre - nr * lim) / den;
        for (int q = 0; q < 16; ++q) { const float br = a.in[I_BRE][(ldg * 64 + n) * 16 + q], bi = a.in[I_BIM][(ldg * 64 + n) * 16 + q];
            Bre[(dir * 64 + n) * 16 + q] = fre * br - fim * bi; Bim[(dir * 64 + n) * 16 + q] = fre * bi + fim * br; }
        for (int p = 0; p < 16; ++p) { Cre[(dir * 16 + p) * 64 + n] = a.in[I_CRE][(ldg * 16 + p) * 64 + n]; Cim[(dir * 16 + p) * 64 + n] = a.in[I_CIM][(ldg * 16 + p) * 64 + n]; }
        AL[((dir * NG + g) * 64 + n) * 2 + 0] = Apow[((dir * 33 + 32) * 64 + n) * 2 + 0];
        AL[((dir * NG + g) * 64 + n) * 2 + 1] = Apow[((dir * 33 + 32) * 64 + n) * 2 + 1];
    }
    __syncthreads();
    for (int task = tid; task < 63 * 16; task += 512) {
        const int kk = task >> 4, p = task & 15, k = kk - 31;
        float acc[16];
#pragma unroll
        for (int q = 0; q < 16; ++q) acc[q] = 0.f;
        for (int part = 0; part < 2; ++part) {
            if ((part == 0 && k < 0) || (part == 1 && k > 0)) continue;
            const int dir = part, e = k >= 0 ? k : -k;
            for (int n = 0; n < 64; ++n) {
                const float cr = Cre[(dir * 16 + p) * 64 + n], ci = Cim[(dir * 16 + p) * 64 + n];
                const float ar = Apow[((dir * 33 + e) * 64 + n) * 2 + 0], ai = Apow[((dir * 33 + e) * 64 + n) * 2 + 1];
                const float car = cr * ar - ci * ai, cai = cr * ai + ci * ar;
#pragma unroll
                for (int q = 0; q < 16; ++q) acc[q] += car * Bre[(dir * 64 + n) * 16 + q] - cai * Bim[(dir * 64 + n) * 16 + q];
            }
        }
        const float dsk = a.in[I_DSKIP][layer * 512 + 16 * g + p];
#pragma unroll
        for (int q = 0; q < 16; ++q) Tt[(kk * 16 + p) * 16 + q] = acc[q] + ((k == 0 && q == p) ? dsk : 0.f);
    }
    __syncthreads();
    for (int it = tid; it < 512 * 96; it += 512) {
        const int nout = it / 96, kin0 = (it % 96) * 8, j = nout >> 4, p = nout & 15;
        float v[8];
        if (kin0 < 512) { const int s = kin0 >> 4, q0 = kin0 & 15, kk = j - s + 31;
#pragma unroll
            for (int i = 0; i < 8; ++i) v[i] = Tt[(kk * 16 + p) * 16 + q0 + i]; }
        else { const int comp = kin0 - 512, dir = comp >> 7, reim = (comp >> 6) & 1, n0 = comp & 63, e = dir == 0 ? j + 1 : 32 - j;
#pragma unroll
            for (int i = 0; i < 8; ++i) { const int n = n0 + i; const float cr = Cre[(dir * 16 + p) * 64 + n], ci = Cim[(dir * 16 + p) * 64 + n];
                const float ar = Apow[((dir * 33 + e) * 64 + n) * 2 + 0], ai = Apow[((dir * 33 + e) * 64 + n) * 2 + 1];
                v[i] = reim == 0 ? (cr * ar - ci * ai) : -(cr * ai + ci * ar); } }
        u32x4 o; o.x = pk2(v[0], v[1]); o.y = pk2(v[2], v[3]); o.z = pk2(v[4], v[5]); o.w = pk2(v[6], v[7]);
        *(u32x4*)(WY + (size_t)nout * KCAT + kin0) = o;
    }
    for (int it = tid; it < 256 * 64; it += 512) {
        const int comp = it >> 6, kin0 = (it & 63) * 8, j = kin0 >> 4, q0 = kin0 & 15, dir = comp >> 7, reim = (comp >> 6) & 1, n = comp & 63, e = dir == 0 ? 31 - j : j;
        const float ar = Apow[((dir * 33 + e) * 64 + n) * 2 + 0], ai = Apow[((dir * 33 + e) * 64 + n) * 2 + 1];
        float v[8];
#pragma unroll
        for (int i = 0; i < 8; ++i) { const float br = Bre[(dir * 64 + n) * 16 + q0 + i], bi = Bim[(dir * 64 + n) * 16 + q0 + i]; v[i] = reim == 0 ? (ar * br - ai * bi) : (ar * bi + ai * br); }
        u32x4 o; o.x = pk2(v[0], v[1]); o.y = pk2(v[2], v[3]); o.z = pk2(v[4], v[5]); o.w = pk2(v[6], v[7]);
        *(u32x4*)(WE + (size_t)comp * 512 + kin0) = o;
    }
    __syncthreads();
}
__device__ __forceinline__ void p0_prologue(const Ctx& c, const Args& a) {
    for (int u = c.blk; u < 2 * NG; u += c.nblk) ssm_tables_unit(c, a, u / NG, u % NG);
    float* scr = (float*)(c.lds + c.wave * 8448);
    const int gw = c.blk * 8 + c.wave, NGW = c.nblk * 8;
    constexpr int I0 = 640, I1 = 128, I2 = 512, I3 = 1024, I4 = 512, I5 = 128, IL = I0 + I1 + I2 + I3 + I4 + I5;
    for (int it = gw; it < 2 * IL; it += NGW) {
        const int L = it / IL; int r = it % IL; unsigned char* lw = a.ws + WS_LW + (size_t)L * LW_STRIDE;
        if (r < I0) { transpose_item(a.in[I_WIN] + (size_t)L * D * DIN, D, DIN, (bf16_t*)(lw + LW_WIN), a.in[I_NMIXG] + L * D, scr, r, c.lane); continue; } r -= I0;
        if (r < I1) { transpose_item(a.in[I_WGLU] + (size_t)L * 512 * 512, 512, 512, (bf16_t*)(lw + LW_WGLU), nullptr, scr, r, c.lane); continue; } r -= I1;
        if (r < I2) { const int k0 = 64 * (r / 32); const float* gn = k0 < 512 ? a.in[I_SSMG] + L * 512 : a.in[I_ATTG] + L * 512 - 512;
            transpose_item(a.in[I_WOUT] + (size_t)L * D * D, D, D, (bf16_t*)(lw + LW_WOUT), gn, scr, r, c.lane); continue; } r -= I2;
        if (r < I3) { transpose_item(a.in[I_WQ] + (size_t)L * D * 2048, D, 2048, (bf16_t*)(lw + LW_WQ), a.in[I_NFFNG] + L * D, scr, r, c.lane); continue; } r -= I3;
        if (r < I4) { transpose_item(a.in[I_WGATE] + (size_t)L * D * D, D, D, (bf16_t*)(lw + LW_WGATE), nullptr, scr, r, c.lane); continue; } r -= I4;
        transpose_item(a.in[I_WPROJ] + (size_t)L * 256 * D, 256, D, (bf16_t*)(lw + LW_WPROJ), nullptr, scr, r, c.lane);
    }
    cvt_range(c, a.in[I_EU], (bf16_t*)(a.ws + WS_EU), (size_t)2 * 16384 * 1024);
    cvt_range(c, a.in[I_EV], (bf16_t*)(a.ws + WS_EV), (size_t)2 * 16384 * 1024);
    cvt_range(c, a.in[I_P], (bf16_t*)(a.ws + WS_PB), (size_t)2 * M * 256);
    for (int L = 0; L < 2; ++L) {
        cvt_range(c, a.in[I_SK1] + (size_t)L * 8 * 128 * 128, (bf16_t*)(a.ws + WS_LW + (size_t)L * LW_STRIDE + LW_SK1), (size_t)8 * 128 * 128);
        cvt_range(c, a.in[I_SK2] + (size_t)L * 8 * 128 * 128, (bf16_t*)(a.ws + WS_LW + (size_t)L * LW_STRIDE + LW_SK2), (size_t)8 * 128 * 128);
    }
    {
        bf16_t* XB = (bf16_t*)(a.ws + WS_XB); float* SSQ0 = (float*)(a.ws + WS_SSQ0);
        for (int m = gw; m < M; m += NGW) {
            const f32x4* xr = (const f32x4*)(a.in[I_X] + (size_t)m * D) + c.lane; float s = 0.f;
#pragma unroll
            for (int j = 0; j < 4; ++j) { const f32x4 v = xr[64 * j]; s += v[0] * v[0] + v[1] * v[1] + v[2] * v[2] + v[3] * v[3];
                *(u32x2*)(XB + (size_t)m * D + 256 * j + 4 * c.lane) = pack4(v); }
            s = wave_sum(s);
            if (c.lane < 16) SSQ0[(size_t)m * 16 + c.lane] = c.lane == 0 ? s : 0.f;
        }
    }
    if (c.blk == c.nblk - 1) {
        float* R = (float*)(a.ws + WS_ROPE);
        for (int e = c.tid; e < 3072; e += 512) {
            const bool isr = e < 2048; const int pos = isr ? (e >> 4) : ((e - 2048) >> 4), f = e & 15;
            const float inv = powf(10000.f, -(float)f / 16.f), ang = (float)pos * inv; float sn, cs; sincosf(ang, &sn, &cs);
            if (isr) { R[e] = cs; R[2048 + e] = sn; } else { R[4096 + (e - 2048)] = cs; R[5120 + (e - 2048)] = sn; }
        }
    }
}

__device__ __forceinline__ void s1_unit(const Ctx& c, const Args& a, int layer, int gb  ) {
    unsigned char* lw = a.ws + WS_LW + (size_t)layer * LW_STRIDE;
    bf16_t* UC = (bf16_t*)(a.ws + WS_UCAT); float* EB = (float*)(a.ws + WS_EBUF);
    const int g = gb >> 1;
    GemmD gd; gd.A = UC; gd.lda = KCAT; gd.Bt = (const bf16_t*)(lw + LW_WE); gd.ldb = 512; gd.K = 512; gd.kmid = -1;
    EpiS1 E; E.ebuf = EB;
    Unit u; u.pm = gb; u.pn = g;
    sgemm_unit(gd, u, E, c.wave, c.lane);
    VM_WAIT(); __syncthreads();
    if (c.tid < 128) {
        const int dir = c.tid >> 6, n = c.tid & 63;
        const float* AL = (const float*)(lw + LW_AL);
        const float alr = AL[((dir * NG + g) * 64 + n) * 2 + 0], ali = AL[((dir * NG + g) * 64 + n) * 2 + 1];
        float hr = 0.f, hi = 0.f;
        const float* eb = EB + (size_t)gb * NCH * 256 + dir * 128 + n;
        bf16_t* hc = UC + (size_t)gb * NCH * KCAT + 512 + dir * 128 + n;
#pragma unroll 8
        for (int s = 0; s < NCH; ++s) {
            const int ch = dir == 0 ? s : NCH - 1 - s;
            hc[(size_t)ch * KCAT] = (bf16_t)f2bf(hr); hc[(size_t)ch * KCAT + 64] = (bf16_t)f2bf(hi);
            const float er = eb[(size_t)ch * 256], ei = eb[(size_t)ch * 256 + 64];
            const float nr = alr * hr - ali * hi + er, ni = alr * hi + ali * hr + ei; hr = nr; hi = ni;
        }
    }
    __syncthreads();
}
__device__ __forceinline__ void qkprep(const Ctx& c, const Args& a, int layer, int widx, int nw) {
    bf16_t* QR = (bf16_t*)(a.ws + WS_QRAW); bf16_t* KV = (bf16_t*)(a.ws + WS_KV); const float* R = (const float*)(a.ws + WS_ROPE);
    const int half = c.lane >> 5, i = c.lane & 31, f = i & 15;
    const int d = i < 16 ? i : 32 + (i - 16);
    for (int it = widx; it < M * 5; it += nw) {
        const int m = it / 5, hh = (it % 5) * 2 + half;
        bf16_t* p = hh < 8 ? QR + (size_t)m * 512 + hh * 64 : KV + (size_t)m * 256 + (hh - 8) * 64;
        const float* gn = hh < 8 ? a.in[I_QNG] + layer * 64 : a.in[I_KNG] + layer * 64;
        const float x1 = bf1(p[d]), x2 = bf1(p[d + 16]);
        float ss = x1 * x1 + x2 * x2;
#pragma unroll
        for (int o = 1; o < 32; o <<= 1) ss += __shfl_xor(ss, o);
        const float rstd = rsqrtf(ss * (1.f / 64.f) + EPS);
        const float y1 = x1 * rstd * gn[d], y2 = x2 * rstd * gn[d + 16];
        const int s = m & (SEQ - 1);
        float cs, sn;
        if (i < 16) { const int pos = s >> 6; cs = R[pos * 16 + f]; sn = R[2048 + pos * 16 + f]; }
        else { const int pos = s & 63; cs = R[4096 + pos * 16 + f]; sn = R[5120 + pos * 16 + f]; }
        float o1 = y1 * cs - y2 * sn, o2 = y2 * cs + y1 * sn;
        if (hh < 8) { o1 *= C2; o2 *= C2; }
        p[d] = (bf16_t)f2bf(o1); p[d + 16] = (bf16_t)f2bf(o2);
    }
}

__device__ __forceinline__ void attn_naive_unit(const Ctx& c, const Args& a, int b, int h, int qblk) {
    const bf16_t* QR = (const bf16_t*)(a.ws + WS_QRAW); const bf16_t* KV = (const bf16_t*)(a.ws + WS_KV);
    bf16_t* Y = (bf16_t*)(a.ws + WS_Y); float* SSQA = (float*)(a.ws + WS_SSQA);
    float* Ks = (float*)c.lds; float* Vs = Ks + 64 * 64;
    const long row = (long)b * SEQ + qblk * 512 + c.tid; const int kvh = h >> 2;
    float q[64], o[64];
#pragma unroll
    for (int v = 0; v < 8; ++v) { const u32x4 w = *(const u32x4*)(QR + row * 512 + h * 64 + v * 8);
        q[v * 8 + 0] = bflo(w.x); q[v * 8 + 1] = bfhi(w.x); q[v * 8 + 2] = bflo(w.y); q[v * 8 + 3] = bfhi(w.y);
        q[v * 8 + 4] = bflo(w.z); q[v * 8 + 5] = bfhi(w.z); q[v * 8 + 6] = bflo(w.w); q[v * 8 + 7] = bfhi(w.w); }
#pragma unroll
    for (int dd = 0; dd < 64; ++dd) o[dd] = 0.f;
    float mrun = -1e30f, l = 0.f;
    const int lk = c.tid >> 3, lp = c.tid & 7;
    for (int t0 = 0; t0 < SEQ; t0 += 64) {
        __syncthreads();
        { const bf16_t* kp = KV + ((long)b * SEQ + t0 + lk) * 256 + kvh * 64 + lp * 8;
          const u32x4 kw = *(const u32x4*)kp, vw = *(const u32x4*)(kp + 128);
          float* kd = Ks + lk * 64 + lp * 8; float* vd = Vs + lk * 64 + lp * 8;
          kd[0] = bflo(kw.x); kd[1] = bfhi(kw.x); kd[2] = bflo(kw.y); kd[3] = bfhi(kw.y); kd[4] = bflo(kw.z); kd[5] = bfhi(kw.z); kd[6] = bflo(kw.w); kd[7] = bfhi(kw.w);
          vd[0] = bflo(vw.x); vd[1] = bfhi(vw.x); vd[2] = bflo(vw.y); vd[3] = bfhi(vw.y); vd[4] = bflo(vw.z); vd[5] = bfhi(vw.z); vd[6] = bflo(vw.w); vd[7] = bfhi(vw.w); }
        __syncthreads();
#pragma unroll 1
        for (int j = 0; j < 64; ++j) {
            float acc = 0.f; const float* kr = Ks + j * 64;
#pragma unroll
            for (int dd = 0; dd < 64; dd += 4) { const f32x4 kk = *(const f32x4*)(kr + dd); acc += q[dd] * kk[0] + q[dd + 1] * kk[1] + q[dd + 2] * kk[2] + q[dd + 3] * kk[3];
                if ((dd & 15) == 12) __builtin_amdgcn_sched_barrier(0); }
            if (acc > mrun) { const float sc = exp2f(mrun - acc); l *= sc; mrun = acc;
#pragma unroll
                for (int dd = 0; dd < 64; ++dd) o[dd] *= sc; }
            const float p = exp2f(acc - mrun); l += p; const float* vr = Vs + j * 64;
#pragma unroll
            for (int dd = 0; dd < 64; dd += 4) { const f32x4 vv = *(const f32x4*)(vr + dd); o[dd] += p * vv[0]; o[dd + 1] += p * vv[1]; o[dd + 2] += p * vv[2]; o[dd + 3] += p * vv[3];
                if ((dd & 15) == 12) __builtin_amdgcn_sched_barrier(0); }
        }
    }
    const float il = 1.f / l; float ss = 0.f;
#pragma unroll
    for (int v = 0; v < 8; ++v) { float t[8];
#pragma unroll
        for (int e = 0; e < 8; ++e) { t[e] = o[v * 8 + e] * il; ss += t[e] * t[e]; }
        u32x4 w; w.x = pk2(t[0], t[1]); w.y = pk2(t[2], t[3]); w.z = pk2(t[4], t[5]); w.w = pk2(t[6], t[7]);
        *(u32x4*)(Y + row * 1024 + 512 + h * 64 + v * 8) = w; }
    SSQA[row * 16 + h] = ss;
    __syncthreads();
}

template <int NV> __device__ __forceinline__ float top16(float (&v)[NV], int lane) {
    float res = -INFINITY;
    for (int it = 0; it < 16; ++it) {
        float m = v[0];
#pragma unroll
        for (int i = 1; i < NV; ++i) m = fmaxf(m, v[i]);
        m = wave_max(m);
#pragma unroll
        for (int i = 0; i < NV; ++i) if (v[i] == m) v[i] = -INFINITY;
        if (lane == it) res = m;
    }
    return res;
}
__device__ __forceinline__ float dot8(const u32x4 a, const u32x4 b) {
    return bflo(a.x) * bflo(b.x) + bfhi(a.x) * bfhi(b.x) + bflo(a.y) * bflo(b.y) + bfhi(a.y) * bfhi(b.y)
         + bflo(a.z) * bflo(b.z) + bfhi(a.z) * bfhi(b.z) + bflo(a.w) * bflo(b.w) + bfhi(a.w) * bfhi(b.w);
}
__device__ __forceinline__ void peer_topk(const Ctx& c, const Args& a, int layer, int widx, int nw) {
    const bf16_t* QP = (const bf16_t*)(a.ws + WS_QP);
    const bf16_t* SK1 = (const bf16_t*)(a.ws + WS_LW + (size_t)layer * LW_STRIDE + LW_SK1);
    const bf16_t* SK2 = (const bf16_t*)(a.ws + WS_LW + (size_t)layer * LW_STRIDE + LW_SK2);
    int* SELI = (int*)(a.ws + WS_SELI); float* SELW = (float*)(a.ws + WS_SELW);
    const int lane = c.lane;
    for (int it = widx; it < M * 8; it += nw) {
        const int t = it >> 3, h = it & 7;
        const bf16_t* qrow = QP + (size_t)t * 2048 + h * 256;
        const bf16_t* k1a = SK1 + ((size_t)(h * 128 + lane)) * 128; const bf16_t* k1b = k1a + 64 * 128;
        const bf16_t* k2a = SK2 + ((size_t)(h * 128 + lane)) * 128; const bf16_t* k2b = k2a + 64 * 128;
        float s1[2] = {0.f, 0.f}, s2[2] = {0.f, 0.f};
#pragma unroll 4
        for (int kk = 0; kk < 128; kk += 8) {
            const u32x4 q1 = *(const u32x4*)(qrow + kk), q2 = *(const u32x4*)(qrow + 128 + kk);
            s1[0] += dot8(q1, *(const u32x4*)(k1a + kk)); s1[1] += dot8(q1, *(const u32x4*)(k1b + kk));
            s2[0] += dot8(q2, *(const u32x4*)(k2a + kk)); s2[1] += dot8(q2, *(const u32x4*)(k2b + kk));
        }
        s1[0] = __uint_as_float((__float_as_uint(s1[0]) & ~127u) | (unsigned)lane); s1[1] = __uint_as_float((__float_as_uint(s1[1]) & ~127u) | (unsigned)(lane + 64));
        s2[0] = __uint_as_float((__float_as_uint(s2[0]) & ~127u) | (unsigned)lane); s2[1] = __uint_as_float((__float_as_uint(s2[1]) & ~127u) | (unsigned)(lane + 64));
        const float v1 = top16<2>(s1, lane), v2 = top16<2>(s2, lane);
        float cand[4];
#pragma unroll
        for (int mm = 0; mm < 4; ++mm) {
            const float va = __shfl(v1, (lane >> 4) + 4 * mm), vb = __shfl(v2, lane & 15);
            const unsigned ua = __float_as_uint(va), ub = __float_as_uint(vb);
            const float sum = __uint_as_float(ua & ~127u) + __uint_as_float(ub & ~127u);
            cand[mm] = __uint_as_float((__float_as_uint(sum) & ~16383u) | ((ua & 127u) << 7) | (ub & 127u));
        }
        const float best = top16<4>(cand, lane);
        const unsigned ub = __float_as_uint(best);
        const float sc = __uint_as_float(ub & ~16383u);
        const float mx = __shfl(sc, 0);
        const float e = lane < 16 ? __expf(sc - mx) : 0.f;
        const float sum = wave_sum(e);
        if (lane < 16) { SELI[(size_t)t * 128 + h * 16 + lane] = (int)(ub & 16383u); SELW[(size_t)t * 128 + h * 16 + lane] = e / sum; }
    }
}

__device__ __forceinline__ void peer_gather(const Ctx& c, const Args& a, int layer, int widx, int nw) {
    float* XR = a.out; bf16_t* XN2 = (bf16_t*)(a.ws + WS_XN2);
    const bf16_t* EU = (const bf16_t*)(a.ws + WS_EU) + (size_t)layer * 16384 * 1024;
    const bf16_t* EV = (const bf16_t*)(a.ws + WS_EV) + (size_t)layer * 16384 * 1024;
    const int* SELI = (const int*)(a.ws + WS_SELI); const float* SELW = (const float*)(a.ws + WS_SELW);
    const float* gf = a.in[I_NFFNG] + layer * D; const float* gp = a.in[I_NPLEG] + layer * D;
    const int lane = c.lane;
    for (int t = widx; t < M; t += nw) {
        float x[16], hh[16], acc[16];
        float* xr = XR + (size_t)t * D + 8 * lane;
        float ss = 0.f;
#pragma unroll
        for (int j = 0; j < 2; ++j) { const f32x4 u0 = *(const f32x4*)(xr + 512 * j), u1 = *(const f32x4*)(xr + 512 * j + 4);
#pragma unroll
            for (int e = 0; e < 4; ++e) { x[8 * j + e] = u0[e]; x[8 * j + 4 + e] = u1[e]; } }
#pragma unroll
        for (int e = 0; e < 16; ++e) { ss += x[e] * x[e]; acc[e] = 0.f; }
        ss = wave_sum(ss);
        const float rstd = rsqrtf(ss * (1.f / D) + EPS);
#pragma unroll
        for (int j = 0; j < 2; ++j)
#pragma unroll
            for (int e = 0; e < 8; ++e) hh[8 * j + e] = x[8 * j + e] * rstd * gf[512 * j + 8 * lane + e];
        const int idxA = SELI[(size_t)t * 128 + lane], idxB = SELI[(size_t)t * 128 + 64 + lane];
        const float wA = SELW[(size_t)t * 128 + lane], wB = SELW[(size_t)t * 128 + 64 + lane];
#pragma unroll 1
        for (int hf = 0; hf < 2; ++hf) {
            const int idxv = hf ? idxB : idxA; const float wv = hf ? wB : wA;
#pragma unroll 1
            for (int k0 = 0; k0 < 64; k0 += 4) {
                u32x4 ur[4][2], vr[4][2]; float w[4];
#pragma unroll
                for (int r = 0; r < 4; ++r) {
                    const int e = __builtin_amdgcn_readlane(idxv, k0 + r); w[r] = __uint_as_float(__builtin_amdgcn_readlane(__float_as_uint(wv), k0 + r));
                    const bf16_t* up = EU + (size_t)e * D + 8 * lane; const bf16_t* vp = EV + (size_t)e * D + 8 * lane;
                    ur[r][0] = *(const u32x4*)up; ur[r][1] = *(const u32x4*)(up + 512); vr[r][0] = *(const u32x4*)vp; vr[r][1] = *(const u32x4*)(vp + 512);
                }
#pragma unroll
                for (int r = 0; r < 4; ++r) {
                    float d = 0.f;
#pragma unroll
                    for (int j = 0; j < 2; ++j) { const u32x4 uw = ur[r][j];
                        d += hh[8 * j + 0] * bflo(uw.x) + hh[8 * j + 1] * bfhi(uw.x) + hh[8 * j + 2] * bflo(uw.y) + hh[8 * j + 3] * bfhi(uw.y)
                           + hh[8 * j + 4] * bflo(uw.z) + hh[8 * j + 5] * bfhi(uw.z) + hh[8 * j + 6] * bflo(uw.w) + hh[8 * j + 7] * bfhi(uw.w); }
                    d = wave_sum(d);
                    const float av = gelu_tanh(d) * w[r];
#pragma unroll
                    for (int j = 0; j < 2; ++j) { const u32x4 vw = vr[r][j];
                        acc[8 * j + 0] += av * bflo(vw.x); acc[8 * j + 1] += av * bfhi(vw.x); acc[8 * j + 2] += av * bflo(vw.y); acc[8 * j + 3] += av * bfhi(vw.y);
                        acc[8 * j + 4] += av * bflo(vw.z); acc[8 * j + 5] += av * bfhi(vw.z); acc[8 * j + 6] += av * bflo(vw.w); acc[8 * j + 7] += av * bfhi(vw.w); }
                }
            }
        }
        float s2 = 0.f;
#pragma unroll
        for (int e = 0; e < 16; ++e) { x[e] += acc[e]; s2 += x[e] * x[e]; }
        s2 = wave_sum(s2);
        const float rstd2 = rsqrtf(s2 * (1.f / D) + EPS);
#pragma unroll
        for (int j = 0; j < 2; ++j) {
            *(f32x4*)(xr + 512 * j) = (f32x4){x[8 * j + 0], x[8 * j + 1], x[8 * j + 2], x[8 * j + 3]};
            *(f32x4*)(xr + 512 * j + 4) = (f32x4){x[8 * j + 4], x[8 * j + 5], x[8 * j + 6], x[8 * j + 7]};
            float y[8];
#pragma unroll
            for (int e = 0; e < 8; ++e) y[e] = x[8 * j + e] * rstd2 * gp[512 * j + 8 * lane + e];
            u32x4 o; o.x = pk2(y[0], y[1]); o.y = pk2(y[2], y[3]); o.z = pk2(y[4], y[5]); o.w = pk2(y[6], y[7]);
            *(u32x4*)(XN2 + (size_t)t * D + 512 * j + 8 * lane) = o;
        }
    }
}

__device__ __forceinline__ void final_norm(const Ctx& c, const Args& a, int widx, int nw) {
    const float* gfin = a.in[I_FING];
    for (int m = widx; m < M; m += nw) {
        f32x4* xr = (f32x4*)(a.out + (size_t)m * D) + c.lane; f32x4 v[4]; float s = 0.f;
#pragma unroll
        for (int j = 0; j < 4; ++j) { v[j] = xr[64 * j]; s += v[j][0] * v[j][0] + v[j][1] * v[j][1] + v[j][2] * v[j][2] + v[j][3] * v[j][3]; }
        s = wave_sum(s); const float rstd = rsqrtf(s * (1.f / D) + EPS);
#pragma unroll
        for (int j = 0; j < 4; ++j) { const f32x4 gg = *((const f32x4*)gfin + 64 * j + c.lane); xr[64 * j] = v[j] * rstd * gg; }
    }
}

__global__ void __launch_bounds__(512, 2) mk_fwd(Args a) {
    extern __shared__ __attribute__((aligned(16))) unsigned char lds[];
    Ctx c0; c0.tid = threadIdx.x; c0.lane = c0.tid & 63; c0.wave = __builtin_amdgcn_readfirstlane(c0.tid >> 6); c0.blk = blockIdx.x; c0.nblk = gridDim.x; c0.lds = lds;
    const Ctx& c = c0;
    volatile LAS unsigned* MISC = (volatile LAS unsigned*)((LAS unsigned char*)lds + MISC_OFF);
    for (int u = c.tid; u < (LDS_BYTES - LDSCTL_OFF) / 4; u += 512) ((LAS unsigned*)((LAS unsigned char*)lds + LDSCTL_OFF))[u] = 0u;
    __syncthreads();
    const bool multi = (a.ph_hi - a.ph_lo) > 1;
    XcdBarrier bar; bar.bar = (unsigned*)(a.ws + WS_CTL) + CW_BAR; bar.x = 0; bar.st = nullptr;
    if (multi) bar = xcd_barrier_post((unsigned*)(a.ws + WS_CTL) + CW_BAR, MISC + 8);
    const int gw = c.blk * 8 + c.wave, NGW = c.nblk * 8;

#define IN(k) (lo <= (k) && (k) < hi)
#define SEAM(k) do { if (IN(k) && IN((k) + 1)) xcd_barrier(bar); } while (0)
    const int lo = a.ph_lo, hi = a.ph_hi;
    if (IN(0)) {
#ifndef SKIP_P0
        p0_prologue(c, a);
#endif
    }
    SEAM(0);
#pragma unroll 1
    for (int layer = 0; layer < 2; ++layer) {
        const int pb = 1 + 9 * layer;
        Ctx c = c0; { int t_ = c0.tid; asm volatile("" : "+v"(t_)); c.tid = t_; c.lane = t_ & 63; }
        unsigned char* lw = a.ws + WS_LW + (size_t)layer * LW_STRIDE;
        if (IN(pb + 0)) {
            GemmD g; g.A = (const bf16_t*)(a.ws + WS_XB); g.lda = D; g.Bt = (const bf16_t*)(lw + LW_WIN); g.ldb = D; g.K = D; g.kmid = -1;
            EpiInproj E; E.ssq0 = (const float*)(a.ws + WS_SSQ0); E.ucat = (bf16_t*)(a.ws + WS_UCAT); E.qraw = (bf16_t*)(a.ws + WS_QRAW); E.kv = (bf16_t*)(a.ws + WS_KV);
            gemm_phase_dense(c, g, M / 256, DIN / 256, E);
        }
        SEAM(pb + 0);
        if (IN(pb + 1)) {
            if (c.nblk > 64) {
                if (c.blk < 64) s1_unit(c, a, layer, c.blk);
                else qkprep(c, a, layer, (c.blk - 64) * 8 + c.wave, (c.nblk - 64) * 8);
            } else {
                for (int u = c.blk; u < 64; u += c.nblk) s1_unit(c, a, layer, u);
                qkprep(c, a, layer, gw, NGW);
            }
        }
        SEAM(pb + 1);
        if (IN(pb + 2)) {
            GemmD g; g.A = (const bf16_t*)(a.ws + WS_UCAT); g.lda = KCAT; g.Bt = (const bf16_t*)(lw + LW_WY); g.ldb = KCAT; g.K = KCAT; g.kmid = -1;
            EpiS2 E; E.G = (bf16_t*)(a.ws + WS_G);
            for (int ui = c.blk; ui < 128; ui += c.nblk) { Unit u; u.pm = ui >> 1; u.pn = (ui >> 2) * 2 + (ui & 1); sgemm_unit(g, u, E, c.wave, c.lane); }
#ifndef SKIP_ATT
            for (int ui = c.blk; ui < 256; ui += c.nblk) attn_naive_unit(c, a, ui >> 7, (ui >> 4) & 7, ui & 15);
#endif
        }
        SEAM(pb + 2);
        if (IN(pb + 3)) {
            GemmD g; g.A = (const bf16_t*)(a.ws + WS_G); g.lda = 512; g.Bt = (const bf16_t*)(lw + LW_WGLU); g.ldb = 512; g.K = 512; g.kmid = -1;
            EpiGlu E; E.G = (const bf16_t*)(a.ws + WS_G); E.bglu = a.in[I_BGLU] + layer * 512; E.Y = (bf16_t*)(a.ws + WS_Y); E.ssqs = (float*)(a.ws + WS_SSQS);
            gemm_phase_dense(c, g, M / 256, 2, E);
        }
        SEAM(pb + 3);
        if (IN(pb + 4)) {
            GemmD g; g.A = (const bf16_t*)(a.ws + WS_Y); g.lda = D; g.Bt = (const bf16_t*)(lw + LW_WOUT); g.ldb = D; g.K = D; g.kmid = 512;
            EpiOut E; E.ssqs = (const float*)(a.ws + WS_SSQS); E.ssqa = (const float*)(a.ws + WS_SSQA); E.xin = layer == 0 ? a.in[I_X] : a.out; E.xres = a.out;
            E.xb = (bf16_t*)(a.ws + WS_XB); E.ssq1 = (float*)(a.ws + WS_SSQ1);
            gemm_phase_dense(c, g, M / 256, 4, E);
        }
        SEAM(pb + 4);
        if (IN(pb + 5)) {
            GemmD g; g.A = (const bf16_t*)(a.ws + WS_XB); g.lda = D; g.Bt = (const bf16_t*)(lw + LW_WQ); g.ldb = D; g.K = D; g.kmid = -1;
            EpiQ E; E.ssq1 = (const float*)(a.ws + WS_SSQ1); E.qp = (bf16_t*)(a.ws + WS_QP);
            gemm_phase_dense(c, g, M / 256, 8, E);
        }
        SEAM(pb + 5);
        if (IN(pb + 6)) {
#ifndef SKIP_TOPK
            peer_topk(c, a, layer, gw, NGW);
#endif
        }
        SEAM(pb + 6);
        if (IN(pb + 7)) {
#ifndef SKIP_GATHER
            peer_gather(c, a, layer, gw, NGW);
#endif
        }
        SEAM(pb + 7);
        if (IN(pb + 8)) {
            GemmD g1; g1.A = (const bf16_t*)(a.ws + WS_PB) + (size_t)layer * M * 256; g1.lda = 256; g1.Bt = (const bf16_t*)(lw + LW_WPROJ); g1.ldb = 256; g1.K = 256; g1.kmid = -1;
            EpiProj E1; E1.pr = (float*)(a.ws + WS_QP);
            gemm_phase_dense(c, g1, M / 256, 4, E1);
            VM_WAIT(); __syncthreads();
            GemmD g2; g2.A = (const bf16_t*)(a.ws + WS_XN2); g2.lda = D; g2.Bt = (const bf16_t*)(lw + LW_WGATE); g2.ldb = D; g2.K = D; g2.kmid = -1;
            EpiGate E2; E2.pr = (const float*)(a.ws + WS_QP); E2.xres = a.out; E2.xb = (bf16_t*)(a.ws + WS_XB); E2.ssq0 = (float*)(a.ws + WS_SSQ0);
            gemm_phase_dense(c, g2, M / 256, 4, E2);
        }
        SEAM(pb + 8);
    }
    if (IN(NPHASE - 1)) final_norm(c, a, gw, NGW);
#undef IN
#undef SEAM
}

extern "C" void kernel_launch(void* const* d_in, const int* in_sizes, int n_in, void* d_out, int out_size, void* d_ws, size_t ws_size, hipStream_t stream) {
    static int grid = 0;
    if (grid == 0) {
        if (n_in != 29 || in_sizes[0] != M * D || out_size != M * D || in_sizes[3] != 2 * D * DIN || ws_size < WS_END) {
            fprintf(stderr, "kernel_launch: unexpected problem: n_in %d in0 %d in3 %d out %d ws %zu (need %zu); nothing launched\n", n_in, n_in > 0 ? in_sizes[0] : -1, n_in > 3 ? in_sizes[3] : -1, out_size, ws_size, (size_t)WS_END);
            grid = -1; return; }
        int dev = 0, cus = 0, per_cu = 0;
        if (hipGetDevice(&dev) != hipSuccess || hipDeviceGetAttribute(&cus, hipDeviceAttributeMultiprocessorCount, dev) != hipSuccess) { grid = -1; return; }
        if (hipFuncSetAttribute((const void*)mk_fwd, hipFuncAttributeMaxDynamicSharedMemorySize, LDS_BYTES) != hipSuccess) { fprintf(stderr, "kernel_launch: hipFuncSetAttribute failed\n"); grid = -1; return; }
        if (hipOccupancyMaxActiveBlocksPerMultiprocessor(&per_cu, (const void*)mk_fwd, 512, LDS_BYTES) != hipSuccess || per_cu < 1)
            fprintf(stderr, "kernel_launch: note: occupancy query reports %d workgroups per CU\n", per_cu);
        (void)hipGetLastError();
        grid = cus;
    }
    if (grid < 0) return;
    (void)hipMemsetAsync((char*)d_ws + WS_CTL, 0, CTL_ZERO_BYTES, stream);
    Args a{};
    for (int i = 0; i < 29; ++i) a.in[i] = (const float*)d_in[i];
    a.out = (float*)d_out; a.ws = (unsigned char*)d_ws;
    constexpr int NL = MK_N_LAUNCHES;
    for (int li = 0; li < NL; ++li) {
        a.ph_lo = (NPHASE * li) / NL; a.ph_hi = (NPHASE * (li + 1)) / NL;
        hipLaunchKernelGGL(mk_fwd, dim3(grid), dim3(512), LDS_BYTES, stream, a);
    }
}
```

```cpp
#include <hip/hip_runtime.h>
#include <cstdio>
#include <cstdint>

#ifndef MK_N_LAUNCHES
#define MK_N_LAUNCHES 1
#endif

#define LAS __attribute__((address_space(3)))
typedef unsigned short bf16_t;
typedef short bf16x8 __attribute__((ext_vector_type(8)));
typedef float f32x4 __attribute__((ext_vector_type(4)));
typedef unsigned u32x4 __attribute__((ext_vector_type(4)));
typedef unsigned u32x2 __attribute__((ext_vector_type(2)));

constexpr int NB = 2, SEQ = 8192, M = NB * SEQ, D = 1024, DIN = 1280;
constexpr int NG = 32, LCH = 32, NCH = SEQ / LCH, KCAT = 768;
constexpr float EPS = 1e-6f;
constexpr float C2 = 0.125f * 1.4426950408889634f;
constexpr int NPHASE = 20;

constexpr size_t MiB = 1u << 20;
constexpr size_t WS_CTL = 0, CTL_ZERO_BYTES = 1 * MiB;
constexpr size_t WS_EU = 1 * MiB, WS_EV = 65 * MiB;
constexpr size_t WS_LW = 129 * MiB, LW_STRIDE = 48 * MiB;
constexpr size_t LW_WIN = 0, LW_WGLU = 3 * MiB, LW_WOUT = 4 * MiB, LW_WQ = 6 * MiB, LW_SK1 = 10 * MiB, LW_SK2 = 10 * MiB + 512 * 1024,
                 LW_WGATE = 11 * MiB, LW_WPROJ = 13 * MiB, LW_AL = 13 * MiB + 512 * 1024, LW_WE = 14 * MiB, LW_WY = 22 * MiB;
constexpr size_t WS_PB = 225 * MiB, WS_ROPE = 241 * MiB, WS_XB = 242 * MiB, WS_UCAT = 274 * MiB, WS_QRAW = 300 * MiB, WS_KV = 316 * MiB,
                 WS_EBUF = 324 * MiB, WS_G = 340 * MiB, WS_Y = 356 * MiB, WS_SSQS = 388 * MiB, WS_SSQA = 389 * MiB, WS_SSQ0 = 390 * MiB, WS_SSQ1 = 391 * MiB,
                 WS_QP = 392 * MiB  , WS_SELI = 456 * MiB, WS_SELW = 464 * MiB, WS_XN2 = 472 * MiB, WS_END = 504 * MiB;
constexpr int CW_BAR = 4096;

constexpr int RING_BYTES = 131072, LDSCTL_OFF = RING_BYTES, MISC_OFF = LDSCTL_OFF + 320, LDS_BYTES = 147456;

__device__ __forceinline__ unsigned f2bf(float f) { unsigned u = __float_as_uint(f); return (u + 0x7fffu + ((u >> 16) & 1u)) >> 16; }
__device__ __forceinline__ unsigned pk2(float lo, float hi) { return f2bf(lo) | (f2bf(hi) << 16); }
__device__ __forceinline__ float bflo(unsigned w) { return __uint_as_float(w << 16); }
__device__ __forceinline__ float bfhi(unsigned w) { return __uint_as_float(w & 0xffff0000u); }
__device__ __forceinline__ float bf1(bf16_t h) { return __uint_as_float((unsigned)h << 16); }
__device__ __forceinline__ float wave_sum(float v) {
#pragma unroll
    for (int o = 1; o < 64; o <<= 1) v += __shfl_xor(v, o);
    return v;
}
__device__ __forceinline__ float wave_max(float v) {
#pragma unroll
    for (int o = 1; o < 64; o <<= 1) v = fmaxf(v, __shfl_xor(v, o));
    return v;
}
__device__ __forceinline__ float sigmoidf_(float x) { return 1.f / (1.f + __expf(-x)); }
__device__ __forceinline__ float gelu_tanh(float x) {
    const float z = 0.7978845608028654f * (x + 0.044715f * x * x * x);
    const float e = __expf(2.f * z);
    const float th = 1.f - 2.f / (e + 1.f);
    return 0.5f * x * (1.f + th);
}
__device__ __forceinline__ float sumn(const float* p, int n) { float s = 0.f; for (int i = 0; i < n; ++i) s += p[i]; return s; }
#define LDS_WAIT() asm volatile("s_waitcnt lgkmcnt(0)" ::: "memory")
#define VM_WAIT() asm volatile("s_waitcnt vmcnt(0)" ::: "memory")

#define XB_TMO      128
#define XB_XCNT(j)  (256  + 64 * (j))
#define XB_XSUB(j)  (1280 + 64 * (j))
#define XB_XGEN(j)  (2304 + 64 * (j))
#define XB_TOP      3328
#define XB_TOPGEN   3392
#define XCD_BAR_WORDS 3456
#define XB_SPIN_CAP (1u << 18)
__device__ __forceinline__ unsigned xb_ld(unsigned* p)              { return __hip_atomic_load(p, __ATOMIC_RELAXED, __HIP_MEMORY_SCOPE_AGENT); }
__device__ __forceinline__ unsigned xb_add(unsigned* p, unsigned v) { return __hip_atomic_fetch_add(p, v, __ATOMIC_RELAXED, __HIP_MEMORY_SCOPE_AGENT); }
__device__ __forceinline__ unsigned xb_xcc_id() { return (unsigned)__builtin_amdgcn_s_getreg((3 << 11) | 20) & 0xFu; }
#define XB_SPIN(cond, bar) do { unsigned _sp = 0; while (cond) { __builtin_amdgcn_s_sleep(1); \
    if ((++_sp & 255u) == 0u) { if (xb_ld(&(bar)[XB_TMO])) break; if (_sp > XB_SPIN_CAP) { atomicAdd(&(bar)[XB_TMO], 1u); break; } } } } while (0)
struct XcdBarrier { unsigned* bar; unsigned x; volatile LAS unsigned* st; };
__device__ __forceinline__ XcdBarrier xcd_barrier_post(unsigned* bar, volatile LAS unsigned* st) {
    XcdBarrier b; b.bar = bar; b.x = xb_xcc_id(); b.st = st;
    if (threadIdx.x == 0) (void)xb_add(&bar[XB_XCNT(b.x)], 1u);
    return b;
}
__device__ __forceinline__ void xcd_barrier_complete(unsigned* bar, unsigned x, unsigned& nloc, unsigned& nx) {
    const unsigned G = gridDim.x * gridDim.y * gridDim.z;
    unsigned sum, cnt, mine, sp = 0u;
    for (;;) {
        sum = 0u; cnt = 0u; mine = 0u;
#pragma unroll
        for (unsigned j = 0; j < 16; ++j) { const unsigned c = xb_ld(&bar[XB_XCNT(j)]); sum += c; cnt += (c > 0u) ? 1u : 0u; mine = (j == x) ? c : mine; }
        if (sum == G) break;
        __builtin_amdgcn_s_sleep(1);
        if ((++sp & 255u) == 0u) { if (xb_ld(&bar[XB_TMO])) break; if (sp > XB_SPIN_CAP) { atomicAdd(&bar[XB_TMO], 1u); break; } }
    }
    nloc = mine > 0u ? mine : 1u; nx = cnt > 0u ? cnt : 1u;
}
__device__ __forceinline__ void xcd_barrier(const XcdBarrier& b) {
    asm volatile("s_waitcnt vmcnt(0)" ::: "memory");
    __syncthreads();
    if (threadIdx.x == 0) {
        unsigned* bar = b.bar;
        __builtin_amdgcn_s_waitcnt(0);
        unsigned nloc = b.st[0], nx = b.st[1];
        if (nloc == 0u) { xcd_barrier_complete(bar, b.x, nloc, nx); b.st[0] = nloc; b.st[1] = nx; }
        const unsigned old = xb_add(&bar[XB_XSUB(b.x)], 1u);
        const unsigned gen = old / nloc;
        if (old + 1u == (gen + 1u) * nloc) {
            __builtin_amdgcn_fence(__ATOMIC_RELEASE, "agent");
            asm volatile("s_waitcnt vmcnt(0)" ::: "memory");
            const unsigned og = xb_add(&bar[XB_TOP], 1u);
            const unsigned tg = og / nx;
            if (og + 1u == (tg + 1u) * nx) xb_add(&bar[XB_TOPGEN], 1u);
            else XB_SPIN(xb_ld(&bar[XB_TOPGEN]) == tg, bar);
            __builtin_amdgcn_fence(__ATOMIC_ACQUIRE, "agent");
            xb_add(&bar[XB_XGEN(b.x)], 1u);
            asm volatile("s_waitcnt vmcnt(0)" ::: "memory");
        } else {
            XB_SPIN(xb_ld(&bar[XB_XGEN(b.x)]) == gen, bar);
            __builtin_amdgcn_fence(__ATOMIC_ACQUIRE, "agent");
            asm volatile("s_waitcnt vmcnt(0)" ::: "memory");
        }
    }
    __syncthreads();
}

struct Args { const float* in[29]; float* out; unsigned char* ws; int ph_lo, ph_hi; };
enum { I_X = 0, I_P, I_NMIXG, I_WIN, I_LRE, I_LIM, I_LOGDT, I_BRE, I_BIM, I_CRE, I_CIM, I_DSKIP, I_WGLU, I_BGLU, I_QNG, I_KNG, I_SSMG, I_ATTG, I_WOUT,
       I_NFFNG, I_WQ, I_SK1, I_SK2, I_EU, I_EV, I_NPLEG, I_WGATE, I_WPROJ, I_FING };

struct Ctx { int tid, lane, wave, blk, nblk; unsigned char* lds; };

struct GemmD { const bf16_t* A; long lda; const bf16_t* Bt; long ldb; int K; int kmid; };
struct Unit { int pm, pn; };

template <class Epi>
__device__ __forceinline__ void sgemm_unit(const GemmD& g, const Unit u, const Epi& E, int wave, int lane) {
    const int i = lane & 15, q = lane >> 4;
    const bf16_t* Ab = g.A + (long)(u.pm * 256 + wave * 32) * g.lda;
    const bf16_t* Bb = g.Bt + (long)(u.pn * 256) * g.ldb;
    const int row0 = u.pm * 256 + wave * 32 + i;
    float ssq[2] = {0.f, 0.f};
    float rs[2] = {1.f, 1.f};
    if constexpr (Epi::ROWSCALE) { rs[0] = E.rscale(row0); rs[1] = E.rscale(row0 + 16); }
    for (int cg = 0; cg < 4; ++cg) {
        f32x4 acc[2][4];
#pragma unroll
        for (int mi = 0; mi < 2; ++mi)
#pragma unroll
            for (int ni = 0; ni < 4; ++ni) acc[mi][ni] = (f32x4){0.f, 0.f, 0.f, 0.f};
        for (int k0 = 0; k0 < g.K; k0 += 32) {
            if constexpr (Epi::MID) { if (k0 == g.kmid) {
#pragma unroll
                for (int mi = 0; mi < 2; ++mi) { const float f = E.mid(row0 + 16 * mi);
#pragma unroll
                    for (int ni = 0; ni < 4; ++ni) acc[mi][ni] *= f; } } }
            bf16x8 a[2], b[4];
#pragma unroll
            for (int mi = 0; mi < 2; ++mi) a[mi] = *(const bf16x8*)(Ab + (long)(16 * mi + i) * g.lda + k0 + 8 * q);
#pragma unroll
            for (int ni = 0; ni < 4; ++ni) b[ni] = *(const bf16x8*)(Bb + (long)(cg * 64 + 16 * ni + i) * g.ldb + k0 + 8 * q);
#pragma unroll
            for (int mi = 0; mi < 2; ++mi)
#pragma unroll
                for (int ni = 0; ni < 4; ++ni) acc[mi][ni] = __builtin_amdgcn_mfma_f32_16x16x32_bf16(b[ni], a[mi], acc[mi][ni], 0, 0, 0);
        }
#pragma unroll
        for (int mi = 0; mi < 2; ++mi)
#pragma unroll
            for (int ni = 0; ni < 4; ++ni) {
                const f32x4 v = acc[mi][ni] * rs[mi];
                const f32x4 w = E.put(row0 + 16 * mi, u.pn * 256 + cg * 64 + 16 * ni + 4 * q, v);
                ssq[mi] += w[0] * w[0] + w[1] * w[1] + w[2] * w[2] + w[3] * w[3];
            }
    }
    if constexpr (Epi::SSQ) {
#pragma unroll
        for (int mi = 0; mi < 2; ++mi) { float s = ssq[mi]; s += __shfl_xor(s, 16); s += __shfl_xor(s, 32);
            if (q == 0) { E.ssq(row0 + 16 * mi, u.pn * 4 + 0, s); E.ssq(row0 + 16 * mi, u.pn * 4 + 1, 0.f); E.ssq(row0 + 16 * mi, u.pn * 4 + 2, 0.f); E.ssq(row0 + 16 * mi, u.pn * 4 + 3, 0.f); } }
    }
}

__device__ __forceinline__ u32x2 pack4(f32x4 v) { u32x2 w; w.x = pk2(v[0], v[1]); w.y = pk2(v[2], v[3]); return w; }

struct EpiInproj {
    static constexpr bool MID = false, ROWSCALE = true, SSQ = false;
    const float* ssq0; bf16_t* ucat; bf16_t* qraw; bf16_t* kv;
    __device__ __forceinline__ float rscale(int row) const { return rsqrtf(sumn(ssq0 + (long)row * 16, 16) * (1.f / D) + EPS); }
    __device__ __forceinline__ f32x4 put(int row, int col, f32x4 v) const {
        const u32x2 w = pack4(v);
        if (col < 512) { const int g = col >> 4, qq = col & 15, b = row >> 13, s = row & (SEQ - 1), c = s >> 5, j = s & 31;
            *(u32x2*)(ucat + ((long)((g * 2 + b) * NCH + c) * KCAT + j * 16 + qq)) = w; }
        else if (col < 1024) *(u32x2*)(qraw + (long)row * 512 + (col - 512)) = w;
        else *(u32x2*)(kv + (long)row * 256 + (col - 1024)) = w;
        return v;
    }
    __device__ __forceinline__ void ssq(int, int, float) const {}
};
struct EpiS1 {
    static constexpr bool MID = false, ROWSCALE = false, SSQ = false;
    float* ebuf;
    __device__ __forceinline__ f32x4 put(int row, int col, f32x4 v) const { *(f32x4*)(ebuf + ((long)row * 256 + (col & 255))) = v; return v; }
    __device__ __forceinline__ void ssq(int, int, float) const {}
};
struct EpiS2 {
    static constexpr bool MID = false, ROWSCALE = false, SSQ = false;
    bf16_t* G;
    __device__ __forceinline__ f32x4 put(int row, int col, f32x4 v) const {
        const int pm = row >> 8, c = row & 255, g = pm >> 1, b = pm & 1, nout = col & 511, j = nout >> 4, p = nout & 15;
        const long tok = (long)b * SEQ + c * LCH + j;
        f32x4 y; y[0] = gelu_tanh(v[0]); y[1] = gelu_tanh(v[1]); y[2] = gelu_tanh(v[2]); y[3] = gelu_tanh(v[3]);
        *(u32x2*)(G + tok * 512 + 16 * g + p) = pack4(y); return v;
    }
    __device__ __forceinline__ void ssq(int, int, float) const {}
};
struct EpiGlu {
    static constexpr bool MID = false, ROWSCALE = false, SSQ = true;
    const bf16_t* G; const float* bglu; bf16_t* Y; float* ssqs;
    __device__ __forceinline__ f32x4 put(int row, int col, f32x4 v) const {
        const u32x2 gw = *(const u32x2*)(G + (long)row * 512 + col);
        const f32x4 bb = *(const f32x4*)(bglu + col);
        f32x4 ys; ys[0] = bflo(gw.x) * sigmoidf_(v[0] + bb[0]); ys[1] = bfhi(gw.x) * sigmoidf_(v[1] + bb[1]);
        ys[2] = bflo(gw.y) * sigmoidf_(v[2] + bb[2]); ys[3] = bfhi(gw.y) * sigmoidf_(v[3] + bb[3]);
        *(u32x2*)(Y + (long)row * 1024 + col) = pack4(ys); return ys;
    }
    __device__ __forceinline__ void ssq(int row, int slot, float s) const { ssqs[(long)row * 16 + slot] = s; }
};
struct EpiOut {
    static constexpr bool MID = true, ROWSCALE = true, SSQ = true;
    const float* ssqs; const float* ssqa; const float* xin; float* xres; bf16_t* xb; float* ssq1;
    __device__ __forceinline__ float rs_s(int row) const { return rsqrtf(sumn(ssqs + (long)row * 16, 8) * (1.f / 512.f) + EPS); }
    __device__ __forceinline__ float rs_a(int row) const { return rsqrtf(sumn(ssqa + (long)row * 16, 8) * (1.f / 512.f) + EPS); }
    __device__ __forceinline__ float mid(int row) const { return rs_s(row) / rs_a(row); }
    __device__ __forceinline__ float rscale(int row) const { return rs_a(row); }
    __device__ __forceinline__ f32x4 put(int row, int col, f32x4 v) const {
        const long o = (long)row * D + col; const f32x4 x1 = *(const f32x4*)(xin + o) + v;
        *(f32x4*)(xres + o) = x1; *(u32x2*)(xb + o) = pack4(x1); return x1;
    }
    __device__ __forceinline__ void ssq(int row, int slot, float s) const { ssq1[(long)row * 16 + slot] = s; }
};
struct EpiQ {
    static constexpr bool MID = false, ROWSCALE = true, SSQ = false;
    const float* ssq1; bf16_t* qp;
    __device__ __forceinline__ float rscale(int row) const { return rsqrtf(sumn(ssq1 + (long)row * 16, 16) * (1.f / D) + EPS); }
    __device__ __forceinline__ f32x4 put(int row, int col, f32x4 v) const { *(u32x2*)(qp + (long)row * 2048 + col) = pack4(v); return v; }
    __device__ __forceinline__ void ssq(int, int, float) const {}
};
struct EpiProj {
    static constexpr bool MID = false, ROWSCALE = false, SSQ = false;
    float* pr;
    __device__ __forceinline__ f32x4 put(int row, int col, f32x4 v) const { *(f32x4*)(pr + (long)row * D + col) = v; return v; }
    __device__ __forceinline__ void ssq(int, int, float) const {}
};
struct EpiGate {
    static constexpr bool MID = false, ROWSCALE = false, SSQ = true;
    const float* pr; float* xres; bf16_t* xb; float* ssq0;
    __device__ __forceinline__ f32x4 put(int row, int col, f32x4 v) const {
        const long o = (long)row * D + col; const f32x4 pv = *(const f32x4*)(pr + o); f32x4 x3 = *(const f32x4*)(xres + o);
        x3[0] += sigmoidf_(v[0]) * pv[0]; x3[1] += sigmoidf_(v[1]) * pv[1]; x3[2] += sigmoidf_(v[2]) * pv[2]; x3[3] += sigmoidf_(v[3]) * pv[3];
        *(f32x4*)(xres + o) = x3; *(u32x2*)(xb + o) = pack4(x3); return x3;
    }
    __device__ __forceinline__ void ssq(int row, int slot, float s) const { ssq0[(long)row * 16 + slot] = s; }
};

template <class Epi>
__device__ __forceinline__ void gemm_phase_dense(const Ctx& c, const GemmD& g, int nM, int nN, const Epi& E) {
    const int nU = nM * nN;
    for (int ui = c.blk; ui < nU; ui += c.nblk) { Unit u; u.pn = ui % nN; u.pm = ui / nN; sgemm_unit(g, u, E, c.wave, c.lane); }
}

__device__ __forceinline__ void transpose_item(const float* W, int K, int N, bf16_t* WT, const float* gain, float* scr, int item, int lane) {
    const int nblk = N / 32, kb = item / nblk, nb = item % nblk, k0 = 64 * kb, n0 = 32 * nb;
#pragma unroll 8
    for (int i = 0; i < 32; ++i) { const int kk = 2 * i + (lane >> 5); float v = W[(size_t)(k0 + kk) * N + n0 + (lane & 31)]; if (gain) v *= gain[k0 + kk]; scr[kk * 33 + (lane & 31)] = v; }
    LDS_WAIT(); asm volatile("" ::: "memory");
    const int cc = lane & 7;
#pragma unroll
    for (int j = 0; j < 4; ++j) { const int n = (lane >> 3) + 8 * j; const float* s = scr + (8 * cc) * 33 + n;
        u32x4 o; o.x = pk2(s[0 * 33], s[1 * 33]); o.y = pk2(s[2 * 33], s[3 * 33]); o.z = pk2(s[4 * 33], s[5 * 33]); o.w = pk2(s[6 * 33], s[7 * 33]);
        *(u32x4*)(WT + (size_t)(n0 + n) * K + k0 + 8 * cc) = o; }
    LDS_WAIT(); asm volatile("" ::: "memory");
}
__device__ __forceinline__ void cvt_range(const Ctx& c, const float* src, bf16_t* dst, size_t n) {
    const size_t nv = n / 8, stride = (size_t)c.nblk * 512;
    for (size_t v = (size_t)c.blk * 512 + c.tid; v < nv; v += stride) {
        const f32x4 a = *(const f32x4*)(src + v * 8), b = *(const f32x4*)(src + v * 8 + 4);
        u32x4 o; o.x = pk2(a[0], a[1]); o.y = pk2(a[2], a[3]); o.z = pk2(b[0], b[1]); o.w = pk2(b[2], b[3]);
        *(u32x4*)(dst + v * 8) = o;
    }
}
__device__ __forceinline__ void ssm_tables_unit(const Ctx& c, const Args& a, int layer, int g) {
    float* Apow = (float*)c.lds;
    float* Bre = Apow + 2 * 33 * 64 * 2;
    float* Bim = Bre + 2 * 64 * 16;
    float* Cre = Bim + 2 * 64 * 16;
    float* Cim = Cre + 2 * 16 * 64;
    float* Tt = Cim + 2 * 16 * 64;
    unsigned char* lw = a.ws + WS_LW + (size_t)layer * LW_STRIDE;
    float* AL = (float*)(lw + LW_AL);
    bf16_t* WE = (bf16_t*)(lw + LW_WE) + (size_t)g * 256 * 512;
    bf16_t* WY = (bf16_t*)(lw + LW_WY) + (size_t)g * 512 * KCAT;
    const int tid = c.tid;
    __syncthreads();
    if (tid < 128) {
        const int dir = tid >> 6, n = tid & 63; const int ldg = (layer * 2 + dir) * NG + g;
        const float lre = a.in[I_LRE][ldg * 64 + n], lim = a.in[I_LIM][ldg * 64 + n];
        const float dt = expf(a.in[I_LOGDT][ldg]);
        for (int k = 0; k <= 32; ++k) { const float dec = expf(lre * dt * (float)k), ang = (lim * dt) * (float)k; float sn, cs; sincosf(ang, &sn, &cs);
            Apow[((dir * 33 + k) * 64 + n) * 2 + 0] = dec * cs; Apow[((dir * 33 + k) * 64 + n) * 2 + 1] = dec * sn; }
        const float abr = Apow[((dir * 33 + 1) * 64 + n) * 2 + 0], abi = Apow[((dir * 33 + 1) * 64 + n) * 2 + 1];
        const float den = lre * lre + lim * lim, nr = abr - 1.f;
        const float fre = (nr * lre + abi * lim) / den, fim = (abi * lre - nr * lim) / den;
        for (int q = 0; q < 16; ++q) { const float br = a.in[I_BRE][(ldg * 64 + n) * 16 + q], bi = a.in[I_BIM][(ldg * 64 + n) * 16 + q];
            Bre[(dir * 64 + n) * 16 + q] = fre * br - fim * bi; Bim[(dir * 64 + n) * 16 + q] = fre * bi + fim * br; }
        for (int p = 0; p < 16; ++p) { Cre[(dir * 16 + p) * 64 + n] = a.in[I_CRE][(ldg * 16 + p) * 64 + n]; Cim[(dir * 16 + p) * 64 + n] = a.in[I_CIM][(ldg * 16 + p) * 64 + n]; }
        AL[((dir * NG + g) * 64 + n) * 2 + 0] = Apow[((dir * 33 + 32) * 64 + n) * 2 + 0];
        AL[((dir * NG + g) * 64 + n) * 2 + 1] = Apow[((dir * 33 + 32) * 64 + n) * 2 + 1];
    }
    __syncthreads();
    for (int task = tid; task < 63 * 16; task += 512) {
        const int kk = task >> 4, p = task & 15, k = kk - 31;
        float acc[16];
#pragma unroll
        for (int q = 0; q < 16; ++q) acc[q] = 0.f;
        for (int part = 0; part < 2; ++part) {
            if ((part == 0 && k < 0) || (part == 1 && k > 0)) continue;
            const int dir = part, e = k >= 0 ? k : -k;
            for (int n = 0; n < 64; ++n) {
                const float cr = Cre[(dir * 16 + p) * 64 + n], ci = Cim[(dir * 16 + p) * 64 + n];
                const float ar = Apow[((dir * 33 + e) * 64 + n) * 2 + 0], ai = Apow[((dir * 33 + e) * 64 + n) * 2 + 1];
                const float car = cr * ar - ci * ai, cai = cr * ai + ci * ar;
#pragma unroll
                for (int q = 0; q < 16; ++q) acc[q] += car * Bre[(dir * 64 + n) * 16 + q] - cai * Bim[(dir * 64 + n) * 16 + q];
            }
        }
        const float dsk = a.in[I_DSKIP][layer * 512 + 16 * g + p];
#pragma unroll
        for (int q = 0; q < 16; ++q) Tt[(kk * 16 + p) * 16 + q] = acc[q] + ((k == 0 && q == p) ? dsk : 0.f);
    }
    __syncthreads();
    for (int it = tid; it < 512 * 96; it += 512) {
        const int nout = it / 96, kin0 = (it % 96) * 8, j = nout >> 4, p = nout & 15;
        float v[8];
        if (kin0 < 512) { const int s = kin0 >> 4, q0 = kin0 & 15, kk = j - s + 31;
#pragma unroll
            for (int i = 0; i < 8; ++i) v[i] = Tt[(kk * 16 + p) * 16 + q0 + i]; }
        else { const int comp = kin0 - 512, dir = comp >> 7, reim = (comp >> 6) & 1, n0 = comp & 63, e = dir == 0 ? j + 1 : 32 - j;
#pragma unroll
            for (int i = 0; i < 8; ++i) { const int n = n0 + i; const float cr = Cre[(dir * 16 + p) * 64 + n], ci = Cim[(dir * 16 + p) * 64 + n];
                const float ar = Apow[((dir * 33 + e) * 64 + n) * 2 + 0], ai = Apow[((dir * 33 + e) * 64 + n) * 2 + 1];
                v[i] = reim == 0 ? (cr * ar - ci * ai) : -(cr * ai + ci * ar); } }
        u32x4 o; o.x = pk2(v[0], v[1]); o.y = pk2(v[2], v[3]); o.z = pk2(v[4], v[5]); o.w = pk2(v[6], v[7]);
        *(u32x4*)(WY + (size_t)nout * KCAT + kin0) = o;
    }
    for (int it = tid; it < 256 * 64; it += 512) {
        const int comp = it >> 6, kin0 = (it & 63) * 8, j = kin0 >> 4, q0 = kin0 & 15, dir = comp >> 7, reim = (comp >> 6) & 1, n = comp & 63, e = dir == 0 ? 31 - j : j;
        const float ar = Apow[((dir * 33 + e) * 64 + n) * 2 + 0], ai = Apow[((dir * 33 + e) * 64 + n) * 2 + 1];
        float v[8];
#pragma unroll
        for (int i = 0; i < 8; ++i) { const float br = Bre[(dir * 64 + n) * 16 + q0 + i], bi = Bim[(dir * 64 + n) * 16 + q0 + i]; v[i] = reim == 0 ? (ar * br - ai * bi) : (ar * bi + ai * br); }
        u32x4 o; o.x = pk2(v[0], v[1]); o.y = pk2(v[2], v[3]); o.z = pk2(v[4], v[5]); o.w = pk2(v[6], v[7]);
        *(u32x4*)(WE + (size_t)comp * 512 + kin0) = o;
    }
    __syncthreads();
}
__device__ __forceinline__ void p0_prologue(const Ctx& c, const Args& a) {
    for (int u = c.blk; u < 2 * NG; u += c.nblk) ssm_tables_unit(c, a, u / NG, u % NG);
    float* scr = (float*)(c.lds + c.wave * 8448);
    const int gw = c.blk * 8 + c.wave, NGW = c.nblk * 8;
    constexpr int I0 = 640, I1 = 128, I2 = 512, I3 = 1024, I4 = 512, I5 = 128, IL = I0 + I1 + I2 + I3 + I4 + I5;
    for (int it = gw; it < 2 * IL; it += NGW) {
        const int L = it / IL; int r = it % IL; unsigned char* lw = a.ws + WS_LW + (size_t)L * LW_STRIDE;
        if (r < I0) { transpose_item(a.in[I_WIN] + (size_t)L * D * DIN, D, DIN, (bf16_t*)(lw + LW_WIN), a.in[I_NMIXG] + L * D, scr, r, c.lane); continue; } r -= I0;
        if (r < I1) { transpose_item(a.in[I_WGLU] + (size_t)L * 512 * 512, 512, 512, (bf16_t*)(lw + LW_WGLU), nullptr, scr, r, c.lane); continue; } r -= I1;
        if (r < I2) { const int k0 = 64 * (r / 32); const float* gn = k0 < 512 ? a.in[I_SSMG] + L * 512 : a.in[I_ATTG] + L * 512 - 512;
            transpose_item(a.in[I_WOUT] + (size_t)L * D * D, D, D, (bf16_t*)(lw + LW_WOUT), gn, scr, r, c.lane); continue; } r -= I2;
        if (r < I3) { transpose_item(a.in[I_WQ] + (size_t)L * D * 2048, D, 2048, (bf16_t*)(lw + LW_WQ), a.in[I_NFFNG] + L * D, scr, r, c.lane); continue; } r -= I3;
        if (r < I4) { transpose_item(a.in[I_WGATE] + (size_t)L * D * D, D, D, (bf16_t*)(lw + LW_WGATE), nullptr, scr, r, c.lane); continue; } r -= I4;
        transpose_item(a.in[I_WPROJ] + (size_t)L * 256 * D, 256, D, (bf16_t*)(lw + LW_WPROJ), nullptr, scr, r, c.lane);
    }
    cvt_range(c, a.in[I_EU], (bf16_t*)(a.ws + WS_EU), (size_t)2 * 16384 * 1024);
    cvt_range(c, a.in[I_EV], (bf16_t*)(a.ws + WS_EV), (size_t)2 * 16384 * 1024);
    cvt_range(c, a.in[I_P], (bf16_t*)(a.ws + WS_PB), (size_t)2 * M * 256);
    for (int L = 0; L < 2; ++L) {
        cvt_range(c, a.in[I_SK1] + (size_t)L * 8 * 128 * 128, (bf16_t*)(a.ws + WS_LW + (size_t)L * LW_STRIDE + LW_SK1), (size_t)8 * 128 * 128);
        cvt_range(c, a.in[I_SK2] + (size_t)L * 8 * 128 * 128, (bf16_t*)(a.ws + WS_LW + (size_t)L * LW_STRIDE + LW_SK2), (size_t)8 * 128 * 128);
    }
    {
        bf16_t* XB = (bf16_t*)(a.ws + WS_XB); float* SSQ0 = (float*)(a.ws + WS_SSQ0);
        for (int m = gw; m < M; m += NGW) {
            const f32x4* xr = (const f32x4*)(a.in[I_X] + (size_t)m * D) + c.lane; float s = 0.f;
#pragma unroll
            for (int j = 0; j < 4; ++j) { const f32x4 v = xr[64 * j]; s += v[0] * v[0] + v[1] * v[1] + v[2] * v[2] + v[3] * v[3];
                *(u32x2*)(XB + (size_t)m * D + 256 * j + 4 * c.lane) = pack4(v); }
            s = wave_sum(s);
            if (c.lane < 16) SSQ0[(size_t)m * 16 + c.lane] = c.lane == 0 ? s : 0.f;
        }
    }
    if (c.blk == c.nblk - 1) {
        float* R = (float*)(a.ws + WS_ROPE);
        for (int e = c.tid; e < 3072; e += 512) {
            const bool isr = e < 2048; const int pos = isr ? (e >> 4) : ((e - 2048) >> 4), f = e & 15;
            const float inv = powf(10000.f, -(float)f / 16.f), ang = (float)pos * inv; float sn, cs; sincosf(ang, &sn, &cs);
            if (isr) { R[e] = cs; R[2048 + e] = sn; } else { R[4096 + (e - 2048)] = cs; R[5120 + (e - 2048)] = sn; }
        }
    }
}

__device__ __forceinline__ void s1_unit(const Ctx& c, const Args& a, int layer, int gb  ) {
    unsigned char* lw = a.ws + WS_LW + (size_t)layer * LW_STRIDE;
    bf16_t* UC = (bf16_t*)(a.ws + WS_UCAT); float* EB = (float*)(a.ws + WS_EBUF);
    const int g = gb >> 1;
    GemmD gd; gd.A = UC; gd.lda = KCAT; gd.Bt = (const bf16_t*)(lw + LW_WE); gd.ldb = 512; gd.K = 512; gd.kmid = -1;
    EpiS1 E; E.ebuf = EB;
    Unit u; u.pm = gb; u.pn = g;
    sgemm_unit(gd, u, E, c.wave, c.lane);
    VM_WAIT(); __syncthreads();
    if (c.tid < 128) {
        const int dir = c.tid >> 6, n = c.tid & 63;
        const float* AL = (const float*)(lw + LW_AL);
        const float alr = AL[((dir * NG + g) * 64 + n) * 2 + 0], ali = AL[((dir * NG + g) * 64 + n) * 2 + 1];
        float hr = 0.f, hi = 0.f;
        const float* eb = EB + (size_t)gb * NCH * 256 + dir * 128 + n;
        bf16_t* hc = UC + (size_t)gb * NCH * KCAT + 512 + dir * 128 + n;
#pragma unroll 8
        for (int s = 0; s < NCH; ++s) {
            const int ch = dir == 0 ? s : NCH - 1 - s;
            hc[(size_t)ch * KCAT] = (bf16_t)f2bf(hr); hc[(size_t)ch * KCAT + 64] = (bf16_t)f2bf(hi);
            const float er = eb[(size_t)ch * 256], ei = eb[(size_t)ch * 256 + 64];
            const float nr = alr * hr - ali * hi + er, ni = alr * hi + ali * hr + ei; hr = nr; hi = ni;
        }
    }
    __syncthreads();
}
__device__ __forceinline__ void qkprep(const Ctx& c, const Args& a, int layer, int widx, int nw) {
    bf16_t* QR = (bf16_t*)(a.ws + WS_QRAW); bf16_t* KV = (bf16_t*)(a.ws + WS_KV); const float* R = (const float*)(a.ws + WS_ROPE);
    const int half = c.lane >> 5, i = c.lane & 31, f = i & 15;
    const int d = i < 16 ? i : 32 + (i - 16);
    for (int it = widx; it < M * 5; it += nw) {
        const int m = it / 5, hh = (it % 5) * 2 + half;
        bf16_t* p = hh < 8 ? QR + (size_t)m * 512 + hh * 64 : KV + (size_t)m * 256 + (hh - 8) * 64;
        const float* gn = hh < 8 ? a.in[I_QNG] + layer * 64 : a.in[I_KNG] + layer * 64;
        const float x1 = bf1(p[d]), x2 = bf1(p[d + 16]);
        float ss = x1 * x1 + x2 * x2;
#pragma unroll
        for (int o = 1; o < 32; o <<= 1) ss += __shfl_xor(ss, o);
        const float rstd = rsqrtf(ss * (1.f / 64.f) + EPS);
        const float y1 = x1 * rstd * gn[d], y2 = x2 * rstd * gn[d + 16];
        const int s = m & (SEQ - 1);
        float cs, sn;
        if (i < 16) { const int pos = s >> 6; cs = R[pos * 16 + f]; sn = R[2048 + pos * 16 + f]; }
        else { const int pos = s & 63; cs = R[4096 + pos * 16 + f]; sn = R[5120 + pos * 16 + f]; }
        float o1 = y1 * cs - y2 * sn, o2 = y2 * cs + y1 * sn;
        if (hh < 8) { o1 *= C2; o2 *= C2; }
        p[d] = (bf16_t)f2bf(o1); p[d + 16] = (bf16_t)f2bf(o2);
    }
}

#include <hip/hip_bf16.h>
#include <cmath>
namespace attn_body {
using bf16=__hip_bfloat16;
using bf16x8=__attribute__((ext_vector_type(8)))short;
using s16x4=__attribute__((ext_vector_type(4)))short;
using f32x16=__attribute__((ext_vector_type(16)))float;
using u32x4=__attribute__((ext_vector_type(4)))unsigned;
constexpr int SEQ=8192,D=64,QPITCH=512,KVPITCH=256,OPITCH=1024;
constexpr int NW=8,QBLK=32,QB=QBLK*NW,KVBLK=64,NQB=SEQ/QB;
__device__ __forceinline__ int crow(int r,int hi){return (r&3)+8*(r>>2)+4*hi;}
#define SBAR() __builtin_amdgcn_sched_barrier(0)
__device__ __forceinline__ void cmask(f32x16&p0,f32x16&p1,int jb,int qrel,int hi){
  const float NEG=-INFINITY; int kb=64*jb+4*hi;
  #pragma unroll
  for(int r=0;r<16;++r){int kv=kb+(r&3)+8*(r>>2); if(kv>qrel)p0[r]=NEG; if(kv+32>qrel)p1[r]=NEG;}
}

constexpr int NSLOT=3, SLOTB=8192;
constexpr int LDS_K=0, LDS_V=NSLOT*SLOTB, LDS_WS=2*NSLOT*SLOTB, LDS_OST=LDS_WS+NW*64*4, LDS_BYTES=LDS_OST+NW*4096;
constexpr float C2=0.125f*1.4426950408889634f;
__device__ __forceinline__ void glds16(const void*gsrc,unsigned lds_dst){unsigned keep;
  asm volatile("s_mov_b32 %0, m0\n\ts_mov_b32 m0, %2\n\ts_nop 0\n\tglobal_load_lds_dwordx4 %1, off\n\ts_mov_b32 m0, %0":"=&s"(keep):"v"(gsrc),"s"(lds_dst):"memory");}
__device__ __forceinline__ float max3f(float a,float b,float c){float r;asm("v_max3_f32 %0, %1, %2, %3":"=v"(r):"v"(a),"v"(b),"v"(c));return r;}
__device__ __forceinline__ float max2f(float a,float b){float r;asm("v_max_f32_e32 %0, %1, %2":"=v"(r):"v"(a),"v"(b));return r;}
__device__ __forceinline__ float fadd_s(float a,float b){float r;asm("v_add_f32_e32 %0, %1, %2":"=v"(r):"v"(a),"v"(b));return r;}
__device__ __forceinline__ float fsub_s(float a,float b){float r;asm("v_sub_f32_e32 %0, %1, %2":"=v"(r):"v"(a),"v"(b));return r;}
typedef float f32x2_t __attribute__((ext_vector_type(2))); typedef __bf16 bf16x2_t __attribute__((ext_vector_type(2)));
__device__ __forceinline__ unsigned cvtpk_s(float lo,float hi){f32x2_t v={lo,hi};bf16x2_t b=__builtin_convertvector(v,bf16x2_t);return __builtin_bit_cast(unsigned,b);}
#define WAIT_BAR(N) asm volatile("s_waitcnt vmcnt(" #N ") lgkmcnt(0)\n\ts_barrier":::"memory")

__device__ __forceinline__ void qkt(f32x16&p0,f32x16&p1,const char*Kslot,const bf16x8*qr,const f32x16&negm,int r32,int hi){
  const char*kb=Kslot+hi*1024+r32*16;
  #pragma unroll
  for(int d0=0;d0<4;++d0){
    const bf16x8 b0=*reinterpret_cast<const bf16x8*>(kb+d0*2048);
    const bf16x8 b1=*reinterpret_cast<const bf16x8*>(kb+d0*2048+512);
    if(d0==0){p0=__builtin_amdgcn_mfma_f32_32x32x16_bf16(b0,qr[0],negm,0,0,0);p1=__builtin_amdgcn_mfma_f32_32x32x16_bf16(b1,qr[0],negm,0,0,0);}
    else{p0=__builtin_amdgcn_mfma_f32_32x32x16_bf16(b0,qr[d0],p0,0,0,0);p1=__builtin_amdgcn_mfma_f32_32x32x16_bf16(b1,qr[d0],p1,0,0,0);}}
}
typedef __attribute__((address_space(3))) const char* lds_cptr;
typedef short v4i16_t __attribute__((ext_vector_type(4)));
__device__ __forceinline__ void kload8(bf16x8*kf,lds_cptr kp){
  kf[0]=*(const __attribute__((address_space(3))) bf16x8*)(kp);      kf[1]=*(const __attribute__((address_space(3))) bf16x8*)(kp+512);
  kf[2]=*(const __attribute__((address_space(3))) bf16x8*)(kp+2048); kf[3]=*(const __attribute__((address_space(3))) bf16x8*)(kp+2560);
  kf[4]=*(const __attribute__((address_space(3))) bf16x8*)(kp+4096); kf[5]=*(const __attribute__((address_space(3))) bf16x8*)(kp+4608);
  kf[6]=*(const __attribute__((address_space(3))) bf16x8*)(kp+6144); kf[7]=*(const __attribute__((address_space(3))) bf16x8*)(kp+6656);
}
__device__ __forceinline__ void kload2(bf16x8*kf,lds_cptr kp,int j){ kf[2*j]=*(const __attribute__((address_space(3))) bf16x8*)(kp+j*2048); kf[2*j+1]=*(const __attribute__((address_space(3))) bf16x8*)(kp+j*2048+512); }
__device__ __forceinline__ s16x4 vtr(lds_cptr p){ return __builtin_bit_cast(s16x4,__builtin_amdgcn_ds_read_tr16_b64_v4i16((__attribute__((address_space(3))) v4i16_t*)p)); }
__device__ __forceinline__ float rowmax(const f32x16&p0,const f32x16&p1){
  float a=max3f(p0[0],p0[1],p1[0]),b=max3f(p0[2],p0[3],p1[1]);a=max3f(a,p1[2],p1[3]);
  #pragma unroll
  for(int r=4;r<16;r+=4){a=max3f(a,p0[r],p0[r+1]);b=max3f(b,p0[r+2],p0[r+3]);a=max3f(a,p1[r],p1[r+1]);b=max3f(b,p1[r+2],p1[r+3]);}
  const float m=max2f(a,b);
  auto rr=__builtin_amdgcn_permlane32_swap(__float_as_uint(m),__float_as_uint(m),false,false);
  return max2f(__uint_as_float(rr[0]),__uint_as_float(rr[1]));
}
__device__ __forceinline__ void pv(f32x16*o,int vb,bf16x8 pa0,bf16x8 pa1,bf16x8 pa2,bf16x8 pa3){
  #pragma unroll
  for(int d0=0;d0<2;++d0){s16x4 lo[4],hi[4];
    #pragma unroll
    for(int ks=0;ks<4;++ks){
      asm volatile("ds_read_b64_tr_b16 %0,%1 offset:%c2":"=&v"(lo[ks]):"v"(vb),"i"(d0*4096+ks*1024):"memory");
      asm volatile("ds_read_b64_tr_b16 %0,%1 offset:%c2":"=&v"(hi[ks]):"v"(vb),"i"(d0*4096+ks*1024+512):"memory");}
    asm volatile("s_waitcnt lgkmcnt(0)":::"memory");SBAR();
    #define PK(k) (bf16x8){lo[k][0],lo[k][1],lo[k][2],lo[k][3],hi[k][0],hi[k][1],hi[k][2],hi[k][3]}
    o[d0]=__builtin_amdgcn_mfma_f32_32x32x16_bf16(pa0,PK(0),o[d0],0,0,0);
    o[d0]=__builtin_amdgcn_mfma_f32_32x32x16_bf16(pa1,PK(1),o[d0],0,0,0);
    o[d0]=__builtin_amdgcn_mfma_f32_32x32x16_bf16(pa2,PK(2),o[d0],0,0,0);
    o[d0]=__builtin_amdgcn_mfma_f32_32x32x16_bf16(pa3,PK(3),o[d0],0,0,0);
    #undef PK
  }
}

#ifndef ATTN_STORE16
#define ATTN_STORE16(p,v) (*(u32x4*)(p)=(v))
#endif
template<int THRL> __device__ __forceinline__ void attn_unit(int b,int h,int qb,const bf16*Q,const bf16*KV,bf16*O,float*SSQA,char*shm){
  const int tid=threadIdx.x,lane=tid&63,r32=lane&31,hi=lane>>5; const int wid=__builtin_amdgcn_readfirstlane(tid>>6);
  const long rowbase=(long)b*SEQ; const int q0=qb*QB;
  const bf16*Qw=Q+(rowbase+q0+wid*QBLK)*QPITCH+h*D;
  const bf16*Kh=KV+rowbase*KVPITCH+(h>>2)*D,*Vh=Kh+128;
  const unsigned lds0=(unsigned)(uintptr_t)shm;
  float*wsf=(float*)(shm+LDS_WS)+wid*64;
  const bf16*ksrc=Kh+(long)lane*KVPITCH+wid*8;
  const bf16*vsrc=Vh+(long)(16*(wid&3)+(lane>>2))*KVPITCH+(wid>>2)*32+(lane&3)*8;
  const unsigned kdst=lds0+LDS_K+wid*1024, vdst=lds0+LDS_V+wid*1024;
  #define DMA_K(t,slot) glds16(ksrc+(long)(t)*KVBLK*KVPITCH,(unsigned)__builtin_amdgcn_readfirstlane(kdst+(slot)))
  #define DMA_V(t,slot) glds16(vsrc+(long)(t)*KVBLK*KVPITCH,(unsigned)__builtin_amdgcn_readfirstlane(vdst+(slot)))
  const int vb0=(int)(lds0+LDS_V)+((lane>>4)&1)*32+(lane&3)*8+(4*hi+((lane&15)>>2))*64;
  const char*Kbase=shm+LDS_K; bf16x8 kf[8];
  const lds_cptr shm3=(lds_cptr)shm; const lds_cptr kp0=shm3+LDS_K+hi*1024+r32*16; const lds_cptr vp0=shm3+LDS_V+((lane>>4)&1)*32+(lane&3)*8+(4*hi+((lane&15)>>2))*64;
  const int NT=SEQ/KVBLK;
  DMA_K(0,0);DMA_V(0,0);DMA_K(1,SLOTB);
  bf16x8 qr[4];
  #pragma unroll
  for(int d0=0;d0<4;++d0)qr[d0]=*reinterpret_cast<const bf16x8*>(&Qw[(long)r32*QPITCH+d0*16+hi*8]);
  float mhat=0.f,l_reg=0.f;f32x16 o[2];o[0]=f32x16{};o[1]=f32x16{};f32x16 negm=f32x16{};asm volatile("":"+v"(negm));
  #define CMASK(P0,P1,t) do{}while(0)
  bool resc=false;
  #define START(P0,P1) do{ const float rm=rowmax(P0,P1); resc=false; \
    { const float dl=rm; mhat=fadd_s(mhat,dl); \
      _Pragma("unroll") for(int r=0;r<16;++r){P0[r]=fsub_s(P0[r],dl);P1[r]=fsub_s(P1[r],dl);} \
      _Pragma("unroll") for(int r=0;r<16;++r)negm[r]=-mhat; asm volatile("":"+v"(negm)); } \
    _Pragma("unroll") for(int r=0;r<16;++r)P0[r]=__builtin_amdgcn_exp2f(P0[r]); }while(0)
  #define RESC() do{ if(resc){ asm volatile("s_waitcnt lgkmcnt(0)":::"memory"); \
      _Pragma("unroll") for(int d_=0;d_<2;++d_) _Pragma("unroll") for(int r=0;r<16;++r)o[d_][r]*=wsf[crow(r,hi)]; } }while(0)
  f32x16 pA0,pA1,pB0,pB1;
  int sl_prev=0,sl_cur=0,sl_next=SLOTB;
  #define ROT() do{sl_prev=sl_cur;sl_cur=sl_next;sl_next=(sl_next==(NSLOT-1)*SLOTB)?0:sl_next+SLOTB;}while(0)
  DMA_K(2,2*SLOTB);
  WAIT_BAR(3);
  qkt(pA0,pA1,Kbase,qr,negm,r32,hi);asm volatile("s_nop 15\n\ts_nop 7":"+v"(pA0),"+v"(pA1));CMASK(pA0,pA1,0);
  START(pA0,pA1);
  _Pragma("unroll") for(int r=0;r<16;++r)pA1[r]=__builtin_amdgcn_exp2f(pA1[r]);
  WAIT_BAR(0);
  DMA_K(3,0);DMA_V(1,SLOTB);
  ROT();
  kload8(kf,kp0+sl_cur);
  WAIT_BAR(2);
  s16x4 vlo[8],vhi[8]; u32x4 pw0,pw1,pw2,pw3;
  #define PKW(P,B) cvtpk_s(P[B],P[B+1])
  #define PAF(k) __builtin_bit_cast(bf16x8,pw##k)
  #define VFR(i) (bf16x8){vlo[i][0],vlo[i][1],vlo[i][2],vlo[i][3],vhi[i][0],vhi[i][1],vhi[i][2],vhi[i][3]}
  #define PIN(x) asm volatile("":"+v"(x))
  #define MX3(a,b,c) __builtin_fmaxf(__builtin_fmaxf((a),(b)),(c))
  #define GAPA(MF,A0,A1,A2,A3,W0,W1,PW) do{ MF; sacc+=A0; sacc+=A1; sacc+=A2; sacc+=A3; PIN(sacc); W0; W1; PIN(PW); SBAR(); }while(0)
  #define EX(v) __builtin_amdgcn_exp2f(v)
  #define GAPB(MF,X,B) do{ MF; X[B]=EX(X[B]); X[B+1]=EX(X[B+1]); X[B+2]=EX(X[B+2]); X[B+3]=EX(X[B+3]); PIN(X); SBAR(); }while(0)
  #define VRD(i) do{ vlo[i]=vtr(vp_+(((i)>>2)*4096+((i)&3)*1024)); vhi[i]=vtr(vp_+(((i)>>2)*4096+((i)&3)*1024+512)); }while(0)
  #define KRD(G,j) do{ if(G){ kload2(kf,kp0+sl_next,j); SBAR(); } }while(0)
  #define STEP(C0,C1,P0,P1,t,GK,GV,GL) do{ SBAR(); \
    const lds_cptr vp_=vp0+sl_prev; \
    VRD(0); SBAR(); float sacc=(P0[0]+P0[1]); \
    GAPA(C0=__builtin_amdgcn_mfma_f32_32x32x16_bf16(kf[0],qr[0],negm,0,0,0), P0[2],P0[3],P0[4],P0[5],     pw0[0]=PKW(P0,0), pw0[1]=PKW(P0,2), pw0); \
    VRD(4); SBAR(); GAPA(C1=__builtin_amdgcn_mfma_f32_32x32x16_bf16(kf[1],qr[0],negm,0,0,0), P0[6],P0[7],P0[8],P0[9],     pw0[2]=PKW(P0,4), pw0[3]=PKW(P0,6), pw0); \
    VRD(1); SBAR(); GAPA(C0=__builtin_amdgcn_mfma_f32_32x32x16_bf16(kf[2],qr[1],C0,0,0,0),   P0[10],P0[11],P0[12],P0[13], pw1[0]=PKW(P0,8), pw1[1]=PKW(P0,10), pw1); \
    VRD(5); SBAR(); GAPA(C1=__builtin_amdgcn_mfma_f32_32x32x16_bf16(kf[3],qr[1],C1,0,0,0),   P0[14],P0[15],P1[0],P1[1],   pw1[2]=PKW(P0,12),pw1[3]=PKW(P0,14), pw1); \
    VRD(2); SBAR(); GAPA(C0=__builtin_amdgcn_mfma_f32_32x32x16_bf16(kf[4],qr[2],C0,0,0,0),   P1[2],P1[3],P1[4],P1[5],     pw2[0]=PKW(P1,0), pw2[1]=PKW(P1,2), pw2); \
    VRD(6); SBAR(); GAPA(C1=__builtin_amdgcn_mfma_f32_32x32x16_bf16(kf[5],qr[2],C1,0,0,0),   P1[6],P1[7],P1[8],P1[9],     pw2[2]=PKW(P1,4), pw2[3]=PKW(P1,6), pw2); \
    VRD(3); SBAR(); GAPA(C0=__builtin_amdgcn_mfma_f32_32x32x16_bf16(kf[6],qr[3],C0,0,0,0),   P1[10],P1[11],P1[12],P1[13], pw3[0]=PKW(P1,8), pw3[1]=PKW(P1,10), pw3); \
    VRD(7); SBAR(); GAPA(C1=__builtin_amdgcn_mfma_f32_32x32x16_bf16(kf[7],qr[3],C1,0,0,0),   P1[14],P1[15],0.f,0.f,       pw3[2]=PKW(P1,12),pw3[3]=PKW(P1,14), pw3); \
    l_reg+=sacc; \
    if(GK){DMA_K((t)+3,sl_cur);} if(GV){DMA_V((t)+1,sl_next);} \
    CMASK(C0,C1,t); \
    { float a=MX3(C0[0],C0[1],C1[0]),b=MX3(C0[2],C0[3],C1[1]); a=MX3(a,C1[2],C1[3]); \
      _Pragma("unroll") for(int r=4;r<16;r+=4){a=MX3(a,C0[r],C0[r+1]);b=MX3(b,C0[r+2],C0[r+3]);a=MX3(a,C1[r],C1[r+1]);b=MX3(b,C1[r+2],C1[r+3]);} \
      float rm=__builtin_fmaxf(a,b); { auto rr=__builtin_amdgcn_permlane32_swap(__float_as_uint(rm),__float_as_uint(rm),false,false); rm=__builtin_fmaxf(__uint_as_float(rr[0]),__uint_as_float(rr[1])); } \
      resc=false; \
      if(__builtin_expect(__any(rm>(float)THRL),0)){ const float dl=__builtin_fmaxf(rm,0.f); mhat+=dl; \
        _Pragma("unroll") for(int r=0;r<16;++r){C0[r]-=dl;C1[r]-=dl;} \
        _Pragma("unroll") for(int r=0;r<16;++r)negm[r]=-mhat; asm volatile("":"+v"(negm)); \
        const float f=__builtin_amdgcn_exp2f(-dl); l_reg*=f; if(hi==0)wsf[r32]=f; resc=true; } } \
    SBAR(); \
    GAPB(o[0]=__builtin_amdgcn_mfma_f32_32x32x16_bf16(PAF(0),VFR(0),o[0],0,0,0), C0,0); \
    GAPB(o[1]=__builtin_amdgcn_mfma_f32_32x32x16_bf16(PAF(0),VFR(4),o[1],0,0,0), C0,4); \
    KRD(GL,0); GAPB(o[0]=__builtin_amdgcn_mfma_f32_32x32x16_bf16(PAF(1),VFR(1),o[0],0,0,0), C0,8); \
    KRD(GL,1); GAPB(o[1]=__builtin_amdgcn_mfma_f32_32x32x16_bf16(PAF(1),VFR(5),o[1],0,0,0), C0,12); \
    KRD(GL,2); GAPB(o[0]=__builtin_amdgcn_mfma_f32_32x32x16_bf16(PAF(2),VFR(2),o[0],0,0,0), C1,0); \
    KRD(GL,3); GAPB(o[1]=__builtin_amdgcn_mfma_f32_32x32x16_bf16(PAF(2),VFR(6),o[1],0,0,0), C1,4); \
    GAPB(o[0]=__builtin_amdgcn_mfma_f32_32x32x16_bf16(PAF(3),VFR(3),o[0],0,0,0), C1,8); \
    GAPB(o[1]=__builtin_amdgcn_mfma_f32_32x32x16_bf16(PAF(3),VFR(7),o[1],0,0,0), C1,12); \
    }while(0)
  int t=1;
  #undef CMASK
  #define CMASK(P0,P1,t) do{}while(0)
  for(;t+5<NT;t+=2){
    STEP(pB0,pB1,pA0,pA1,t,true,true,true);     WAIT_BAR(2); RESC(); ROT();
    STEP(pA0,pA1,pB0,pB1,t+1,true,true,true);   WAIT_BAR(2); RESC(); ROT();
  }
  #undef CMASK
  #define CMASK(P0,P1,t) do{}while(0)
  #define ENDW(tt) do{ if((tt)+3<NT){WAIT_BAR(2);} else if((tt)+2<NT){WAIT_BAR(1);} else {WAIT_BAR(0);} }while(0)
  for(;t+1<NT;t+=2){
    STEP(pB0,pB1,pA0,pA1,t,(t+3<NT),(t+1<NT),(t+1<NT));       ENDW(t);   RESC(); ROT();
    STEP(pA0,pA1,pB0,pB1,t+1,(t+4<NT),(t+2<NT),(t+2<NT));     ENDW(t+1); RESC(); ROT();
  }
  STEP(pB0,pB1,pA0,pA1,NT-1,false,false,false); RESC();
  { float sacc=pB0[0]+pB0[1]; _Pragma("unroll") for(int r=2;r<16;++r)sacc+=pB0[r]; _Pragma("unroll") for(int r=0;r<16;++r)sacc+=pB1[r]; l_reg+=sacc;
    pw0=(u32x4){PKW(pB0,0),PKW(pB0,2),PKW(pB0,4),PKW(pB0,6)};pw1=(u32x4){PKW(pB0,8),PKW(pB0,10),PKW(pB0,12),PKW(pB0,14)};pw2=(u32x4){PKW(pB1,0),PKW(pB1,2),PKW(pB1,4),PKW(pB1,6)};pw3=(u32x4){PKW(pB1,8),PKW(pB1,10),PKW(pB1,12),PKW(pB1,14)};
    SBAR(); pv(o,vb0+sl_cur,PAF(0),PAF(1),PAF(2),PAF(3)); }
  #undef PKW
  #undef PAF
  #undef VFR
  #undef PIN
  #undef MX3
  #undef GAPA
  #undef GAPB
  #undef EX
  #undef VRD
  #undef KRD
  #undef STEP
  #undef ENDW
  {auto rr=__builtin_amdgcn_permlane32_swap(__float_as_uint(l_reg),__float_as_uint(l_reg),false,false);l_reg=__uint_as_float(rr[0])+__uint_as_float(rr[1]);}
  if(hi==0)wsf[32+r32]=l_reg;asm volatile("s_waitcnt lgkmcnt(0)":::"memory");
  float rli[16];
  #pragma unroll
  for(int r=0;r<16;++r)rli[r]=__builtin_amdgcn_rcpf(wsf[32+crow(r,hi)]);
  bf16*Ow=O+(rowbase+q0+wid*QBLK)*OPITCH+512+h*D; float*Sw=SSQA+(rowbase+q0+wid*QBLK)*16+h;
  { bf16*stg=(bf16*)(shm+LDS_OST)+wid*2048;
    #pragma unroll
    for(int r=0;r<16;++r){const int orow=crow(r,hi);
      #pragma unroll
      for(int d0=0;d0<2;++d0)stg[orow*64+d0*32+r32]=__float2bfloat16(o[d0][r]*rli[r]);}
    asm volatile("s_waitcnt lgkmcnt(0)":::"memory");
    #pragma unroll
    for(int i=0;i<4;++i){const int row=i*8+(lane>>3),ch=lane&7; const u32x4 v=*(const u32x4*)(stg+row*64+ch*8); ATTN_STORE16(Ow+(long)row*OPITCH+ch*8,v);
      float ss=0.f; for(int e=0;e<4;++e){const float lo_=__uint_as_float(v[e]<<16),hi_=__uint_as_float(v[e]&0xffff0000u); ss+=lo_*lo_+hi_*hi_;}
      ss+=__shfl_xor(ss,1); ss+=__shfl_xor(ss,2); ss+=__shfl_xor(ss,4); if(ch==0)Sw[(long)row*16]=ss; } }
  asm volatile("s_waitcnt lgkmcnt(0)\n\ts_barrier":::"memory");
  #undef DMA_K
  #undef DMA_V
  #undef CMASK
  #undef START
  #undef RESC
  #undef ROT
}
constexpr int ATTN_LDS_BYTES=LDS_BYTES;
#undef SBAR
#undef WAIT_BAR
}

#ifdef ATT_NAIVE
__device__ __forceinline__ void attn_naive_unit(const Ctx& c, const Args& a, int b, int h, int qblk) {
    const bf16_t* QR = (const bf16_t*)(a.ws + WS_QRAW); const bf16_t* KV = (const bf16_t*)(a.ws + WS_KV);
    bf16_t* Y = (bf16_t*)(a.ws + WS_Y); float* SSQA = (float*)(a.ws + WS_SSQA);
    float* Ks = (float*)c.lds; float* Vs = Ks + 64 * 64;
    const long row = (long)b * SEQ + qblk * 512 + c.tid; const int kvh = h >> 2;
    float q[64], o[64];
#pragma unroll
    for (int v = 0; v < 8; ++v) { const u32x4 w = *(const u32x4*)(QR + row * 512 + h * 64 + v * 8);
        q[v * 8 + 0] = bflo(w.x); q[v * 8 + 1] = bfhi(w.x); q[v * 8 + 2] = bflo(w.y); q[v * 8 + 3] = bfhi(w.y);
        q[v * 8 + 4] = bflo(w.z); q[v * 8 + 5] = bfhi(w.z); q[v * 8 + 6] = bflo(w.w); q[v * 8 + 7] = bfhi(w.w); }
#pragma unroll
    for (int dd = 0; dd < 64; ++dd) o[dd] = 0.f;
    float mrun = -1e30f, l = 0.f;
    const int lk = c.tid >> 3, lp = c.tid & 7;
    for (int t0 = 0; t0 < SEQ; t0 += 64) {
        __syncthreads();
        { const bf16_t* kp = KV + ((long)b * SEQ + t0 + lk) * 256 + kvh * 64 + lp * 8;
          const u32x4 kw = *(const u32x4*)kp, vw = *(const u32x4*)(kp + 128);
          float* kd = Ks + lk * 64 + lp * 8; float* vd = Vs + lk * 64 + lp * 8;
          kd[0] = bflo(kw.x); kd[1] = bfhi(kw.x); kd[2] = bflo(kw.y); kd[3] = bfhi(kw.y); kd[4] = bflo(kw.z); kd[5] = bfhi(kw.z); kd[6] = bflo(kw.w); kd[7] = bfhi(kw.w);
          vd[0] = bflo(vw.x); vd[1] = bfhi(vw.x); vd[2] = bflo(vw.y); vd[3] = bfhi(vw.y); vd[4] = bflo(vw.z); vd[5] = bfhi(vw.z); vd[6] = bflo(vw.w); vd[7] = bfhi(vw.w); }
        __syncthreads();
#pragma unroll 1
        for (int j = 0; j < 64; ++j) {
            float acc = 0.f; const float* kr = Ks + j * 64;
#pragma unroll
            for (int dd = 0; dd < 64; dd += 4) { const f32x4 kk = *(const f32x4*)(kr + dd); acc += q[dd] * kk[0] + q[dd + 1] * kk[1] + q[dd + 2] * kk[2] + q[dd + 3] * kk[3];
                if ((dd & 15) == 12) __builtin_amdgcn_sched_barrier(0); }
            if (acc > mrun) { const float sc = exp2f(mrun - acc); l *= sc; mrun = acc;
#pragma unroll
                for (int dd = 0; dd < 64; ++dd) o[dd] *= sc; }
            const float p = exp2f(acc - mrun); l += p; const float* vr = Vs + j * 64;
#pragma unroll
            for (int dd = 0; dd < 64; dd += 4) { const f32x4 vv = *(const f32x4*)(vr + dd); o[dd] += p * vv[0]; o[dd + 1] += p * vv[1]; o[dd + 2] += p * vv[2]; o[dd + 3] += p * vv[3];
                if ((dd & 15) == 12) __builtin_amdgcn_sched_barrier(0); }
        }
    }
    const float il = 1.f / l; float ss = 0.f;
#pragma unroll
    for (int v = 0; v < 8; ++v) { float t[8];
#pragma unroll
        for (int e = 0; e < 8; ++e) { t[e] = o[v * 8 + e] * il; ss += t[e] * t[e]; }
        u32x4 w; w.x = pk2(t[0], t[1]); w.y = pk2(t[2], t[3]); w.z = pk2(t[4], t[5]); w.w = pk2(t[6], t[7]);
        *(u32x4*)(Y + row * 1024 + 512 + h * 64 + v * 8) = w; }
    SSQA[row * 16 + h] = ss;
    __syncthreads();
}

#endif
template <int NV> __device__ __forceinline__ float top16(float (&v)[NV], int lane) {
    float res = -INFINITY;
    for (int it = 0; it < 16; ++it) {
        float m = v[0];
#pragma unroll
        for (int i = 1; i < NV; ++i) m = fmaxf(m, v[i]);
        m = wave_max(m);
#pragma unroll
        for (int i = 0; i < NV; ++i) if (v[i] == m) v[i] = -INFINITY;
        if (lane == it) res = m;
    }
    return res;
}
__device__ __forceinline__ float dot8(const u32x4 a, const u32x4 b) {
    return bflo(a.x) * bflo(b.x) + bfhi(a.x) * bfhi(b.x) + bflo(a.y) * bflo(b.y) + bfhi(a.y) * bfhi(b.y)
         + bflo(a.z) * bflo(b.z) + bfhi(a.z) * bfhi(b.z) + bflo(a.w) * bflo(b.w) + bfhi(a.w) * bfhi(b.w);
}
__device__ __forceinline__ void peer_topk(const Ctx& c, const Args& a, int layer, int widx, int nw) {
    const bf16_t* QP = (const bf16_t*)(a.ws + WS_QP);
    const bf16_t* SK1 = (const bf16_t*)(a.ws + WS_LW + (size_t)layer * LW_STRIDE + LW_SK1);
    const bf16_t* SK2 = (const bf16_t*)(a.ws + WS_LW + (size_t)layer * LW_STRIDE + LW_SK2);
    int* SELI = (int*)(a.ws + WS_SELI); float* SELW = (float*)(a.ws + WS_SELW);
    const int lane = c.lane;
    for (int it = widx; it < M * 8; it += nw) {
        const int t = it >> 3, h = it & 7;
        const bf16_t* qrow = QP + (size_t)t * 2048 + h * 256;
        const bf16_t* k1a = SK1 + ((size_t)(h * 128 + lane)) * 128; const bf16_t* k1b = k1a + 64 * 128;
        const bf16_t* k2a = SK2 + ((size_t)(h * 128 + lane)) * 128; const bf16_t* k2b = k2a + 64 * 128;
        float s1[2] = {0.f, 0.f}, s2[2] = {0.f, 0.f};
#pragma unroll 4
        for (int kk = 0; kk < 128; kk += 8) {
            const u32x4 q1 = *(const u32x4*)(qrow + kk), q2 = *(const u32x4*)(qrow + 128 + kk);
            s1[0] += dot8(q1, *(const u32x4*)(k1a + kk)); s1[1] += dot8(q1, *(const u32x4*)(k1b + kk));
            s2[0] += dot8(q2, *(const u32x4*)(k2a + kk)); s2[1] += dot8(q2, *(const u32x4*)(k2b + kk));
        }
        s1[0] = __uint_as_float((__float_as_uint(s1[0]) & ~127u) | (unsigned)lane); s1[1] = __uint_as_float((__float_as_uint(s1[1]) & ~127u) | (unsigned)(lane + 64));
        s2[0] = __uint_as_float((__float_as_uint(s2[0]) & ~127u) | (unsigned)lane); s2[1] = __uint_as_float((__float_as_uint(s2[1]) & ~127u) | (unsigned)(lane + 64));
        const float v1 = top16<2>(s1, lane), v2 = top16<2>(s2, lane);
        float cand[4];
#pragma unroll
        for (int mm = 0; mm < 4; ++mm) {
            const float va = __shfl(v1, (lane >> 4) + 4 * mm), vb = __shfl(v2, lane & 15);
            const unsigned ua = __float_as_uint(va), ub = __float_as_uint(vb);
            const float sum = __uint_as_float(ua & ~127u) + __uint_as_float(ub & ~127u);
            cand[mm] = __uint_as_float((__float_as_uint(sum) & ~16383u) | ((ua & 127u) << 7) | (ub & 127u));
        }
        const float best = top16<4>(cand, lane);
        const unsigned ub = __float_as_uint(best);
        const float sc = __uint_as_float(ub & ~16383u);
        const float mx = __shfl(sc, 0);
        const float e = lane < 16 ? __expf(sc - mx) : 0.f;
        const float sum = wave_sum(e);
        if (lane < 16) { SELI[(size_t)t * 128 + h * 16 + lane] = (int)(ub & 16383u); SELW[(size_t)t * 128 + h * 16 + lane] = e / sum; }
    }
}

__device__ __forceinline__ void peer_gather(const Ctx& c, const Args& a, int layer, int widx, int nw) {
    float* XR = a.out; bf16_t* XN2 = (bf16_t*)(a.ws + WS_XN2);
    const bf16_t* EU = (const bf16_t*)(a.ws + WS_EU) + (size_t)layer * 16384 * 1024;
    const bf16_t* EV = (const bf16_t*)(a.ws + WS_EV) + (size_t)layer * 16384 * 1024;
    const int* SELI = (const int*)(a.ws + WS_SELI); const float* SELW = (const float*)(a.ws + WS_SELW);
    const float* gf = a.in[I_NFFNG] + layer * D; const float* gp = a.in[I_NPLEG] + layer * D;
    const int lane = c.lane;
    for (int t = widx; t < M; t += nw) {
        float x[16], hh[16], acc[16];
        float* xr = XR + (size_t)t * D + 8 * lane;
        float ss = 0.f;
#pragma unroll
        for (int j = 0; j < 2; ++j) { const f32x4 u0 = *(const f32x4*)(xr + 512 * j), u1 = *(const f32x4*)(xr + 512 * j + 4);
#pragma unroll
            for (int e = 0; e < 4; ++e) { x[8 * j + e] = u0[e]; x[8 * j + 4 + e] = u1[e]; } }
#pragma unroll
        for (int e = 0; e < 16; ++e) { ss += x[e] * x[e]; acc[e] = 0.f; }
        ss = wave_sum(ss);
        const float rstd = rsqrtf(ss * (1.f / D) + EPS);
#pragma unroll
        for (int j = 0; j < 2; ++j)
#pragma unroll
            for (int e = 0; e < 8; ++e) hh[8 * j + e] = x[8 * j + e] * rstd * gf[512 * j + 8 * lane + e];
        const int idxA = SELI[(size_t)t * 128 + lane], idxB = SELI[(size_t)t * 128 + 64 + lane];
        const float wA = SELW[(size_t)t * 128 + lane], wB = SELW[(size_t)t * 128 + 64 + lane];
#pragma unroll 1
        for (int hf = 0; hf < 2; ++hf) {
            const int idxv = hf ? idxB : idxA; const float wv = hf ? wB : wA;
#pragma unroll 1
            for (int k0 = 0; k0 < 64; k0 += 4) {
                u32x4 ur[4][2], vr[4][2]; float w[4];
#pragma unroll
                for (int r = 0; r < 4; ++r) {
                    const int e = __builtin_amdgcn_readlane(idxv, k0 + r); w[r] = __uint_as_float(__builtin_amdgcn_readlane(__float_as_uint(wv), k0 + r));
                    const bf16_t* up = EU + (size_t)e * D + 8 * lane; const bf16_t* vp = EV + (size_t)e * D + 8 * lane;
                    ur[r][0] = *(const u32x4*)up; ur[r][1] = *(const u32x4*)(up + 512); vr[r][0] = *(const u32x4*)vp; vr[r][1] = *(const u32x4*)(vp + 512);
                }
#pragma unroll
                for (int r = 0; r < 4; ++r) {
                    float d = 0.f;
#pragma unroll
                    for (int j = 0; j < 2; ++j) { const u32x4 uw = ur[r][j];
                        d += hh[8 * j + 0] * bflo(uw.x) + hh[8 * j + 1] * bfhi(uw.x) + hh[8 * j + 2] * bflo(uw.y) + hh[8 * j + 3] * bfhi(uw.y)
                           + hh[8 * j + 4] * bflo(uw.z) + hh[8 * j + 5] * bfhi(uw.z) + hh[8 * j + 6] * bflo(uw.w) + hh[8 * j + 7] * bfhi(uw.w); }
                    d = wave_sum(d);
                    const float av = gelu_tanh(d) * w[r];
#pragma unroll
                    for (int j = 0; j < 2; ++j) { const u32x4 vw = vr[r][j];
                        acc[8 * j + 0] += av * bflo(vw.x); acc[8 * j + 1] += av * bfhi(vw.x); acc[8 * j + 2] += av * bflo(vw.y); acc[8 * j + 3] += av * bfhi(vw.y);
                        acc[8 * j + 4] += av * bflo(vw.z); acc[8 * j + 5] += av * bfhi(vw.z); acc[8 * j + 6] += av * bflo(vw.w); acc[8 * j + 7] += av * bfhi(vw.w); }
                }
            }
        }
        float s2 = 0.f;
#pragma unroll
        for (int e = 0; e < 16; ++e) { x[e] += acc[e]; s2 += x[e] * x[e]; }
        s2 = wave_sum(s2);
        const float rstd2 = rsqrtf(s2 * (1.f / D) + EPS);
#pragma unroll
        for (int j = 0; j < 2; ++j) {
            *(f32x4*)(xr + 512 * j) = (f32x4){x[8 * j + 0], x[8 * j + 1], x[8 * j + 2], x[8 * j + 3]};
            *(f32x4*)(xr + 512 * j + 4) = (f32x4){x[8 * j + 4], x[8 * j + 5], x[8 * j + 6], x[8 * j + 7]};
            float y[8];
#pragma unroll
            for (int e = 0; e < 8; ++e) y[e] = x[8 * j + e] * rstd2 * gp[512 * j + 8 * lane + e];
            u32x4 o; o.x = pk2(y[0], y[1]); o.y = pk2(y[2], y[3]); o.z = pk2(y[4], y[5]); o.w = pk2(y[6], y[7]);
            *(u32x4*)(XN2 + (size_t)t * D + 512 * j + 8 * lane) = o;
        }
    }
}

__device__ __forceinline__ void final_norm(const Ctx& c, const Args& a, int widx, int nw) {
    const float* gfin = a.in[I_FING];
    for (int m = widx; m < M; m += nw) {
        f32x4* xr = (f32x4*)(a.out + (size_t)m * D) + c.lane; f32x4 v[4]; float s = 0.f;
#pragma unroll
        for (int j = 0; j < 4; ++j) { v[j] = xr[64 * j]; s += v[j][0] * v[j][0] + v[j][1] * v[j][1] + v[j][2] * v[j][2] + v[j][3] * v[j][3]; }
        s = wave_sum(s); const float rstd = rsqrtf(s * (1.f / D) + EPS);
#pragma unroll
        for (int j = 0; j < 4; ++j) { const f32x4 gg = *((const f32x4*)gfin + 64 * j + c.lane); xr[64 * j] = v[j] * rstd * gg; }
    }
}

__global__ void __launch_bounds__(512, 2) mk_fwd(Args a) {
    extern __shared__ __attribute__((aligned(16))) unsigned char lds[];
    Ctx c0; c0.tid = threadIdx.x; c0.lane = c0.tid & 63; c0.wave = __builtin_amdgcn_readfirstlane(c0.tid >> 6); c0.blk = blockIdx.x; c0.nblk = gridDim.x; c0.lds = lds;
    const Ctx& c = c0;
    volatile LAS unsigned* MISC = (volatile LAS unsigned*)((LAS unsigned char*)lds + MISC_OFF);
    for (int u = c.tid; u < (LDS_BYTES - LDSCTL_OFF) / 4; u += 512) ((LAS unsigned*)((LAS unsigned char*)lds + LDSCTL_OFF))[u] = 0u;
    __syncthreads();
    const bool multi = (a.ph_hi - a.ph_lo) > 1;
    XcdBarrier bar; bar.bar = (unsigned*)(a.ws + WS_CTL) + CW_BAR; bar.x = 0; bar.st = nullptr;
    if (multi) bar = xcd_barrier_post((unsigned*)(a.ws + WS_CTL) + CW_BAR, MISC + 8);
    const int gw = c.blk * 8 + c.wave, NGW = c.nblk * 8;

#define IN(k) (lo <= (k) && (k) < hi)
#define SEAM(k) do { if (IN(k) && IN((k) + 1)) xcd_barrier(bar); } while (0)
    const int lo = a.ph_lo, hi = a.ph_hi;
    if (IN(0)) {
#ifndef SKIP_P0
        p0_prologue(c, a);
#endif
    }
    SEAM(0);
#pragma unroll 1
    for (int layer = 0; layer < 2; ++layer) {
        const int pb = 1 + 9 * layer;
        Ctx c = c0; { int t_ = c0.tid; asm volatile("" : "+v"(t_)); c.tid = t_; c.lane = t_ & 63; }
        unsigned char* lw = a.ws + WS_LW + (size_t)layer * LW_STRIDE;
        if (IN(pb + 0)) {
            GemmD g; g.A = (const bf16_t*)(a.ws + WS_XB); g.lda = D; g.Bt = (const bf16_t*)(lw + LW_WIN); g.ldb = D; g.K = D; g.kmid = -1;
            EpiInproj E; E.ssq0 = (const float*)(a.ws + WS_SSQ0); E.ucat = (bf16_t*)(a.ws + WS_UCAT); E.qraw = (bf16_t*)(a.ws + WS_QRAW); E.kv = (bf16_t*)(a.ws + WS_KV);
            gemm_phase_dense(c, g, M / 256, DIN / 256, E);
        }
        SEAM(pb + 0);
        if (IN(pb + 1)) {
            if (c.nblk > 64) {
                if (c.blk < 64) s1_unit(c, a, layer, c.blk);
                else qkprep(c, a, layer, (c.blk - 64) * 8 + c.wave, (c.nblk - 64) * 8);
            } else {
                for (int u = c.blk; u < 64; u += c.nblk) s1_unit(c, a, layer, u);
                qkprep(c, a, layer, gw, NGW);
            }
        }
        SEAM(pb + 1);
        if (IN(pb + 2)) {
            GemmD g; g.A = (const bf16_t*)(a.ws + WS_UCAT); g.lda = KCAT; g.Bt = (const bf16_t*)(lw + LW_WY); g.ldb = KCAT; g.K = KCAT; g.kmid = -1;
            EpiS2 E; E.G = (bf16_t*)(a.ws + WS_G);
            for (int ui = c.blk; ui < 128; ui += c.nblk) { Unit u; u.pm = ui >> 1; u.pn = (ui >> 2) * 2 + (ui & 1); sgemm_unit(g, u, E, c.wave, c.lane); }
#ifdef ATT_NAIVE
            for (int ui = c.blk; ui < 256; ui += c.nblk) attn_naive_unit(c, a, ui >> 7, (ui >> 4) & 7, ui & 15);
#else
            for (int ui = c.blk; ui < 512; ui += c.nblk) {
                int ab, ah, aq;
                if (c.nblk == 256) { const int bl = ui & 255, vcu = (bl & 7) * 32 + (bl >> 3), combo = (ui >> 8) * 2 + (vcu >> 7), w = vcu & 127; ab = combo >> 1; ah = (combo & 1) * 4 + (w >> 5); aq = w & 31; }
                else { ab = ui >> 8; ah = (ui >> 5) & 7; aq = ui & 31; }
                attn_body::attn_unit<8>(ab, ah, aq, (const attn_body::bf16*)(a.ws + WS_QRAW), (const attn_body::bf16*)(a.ws + WS_KV), (attn_body::bf16*)(a.ws + WS_Y), (float*)(a.ws + WS_SSQA), (char*)lds);
            }
#endif
        }
        SEAM(pb + 2);
        if (IN(pb + 3)) {
            GemmD g; g.A = (const bf16_t*)(a.ws + WS_G); g.lda = 512; g.Bt = (const bf16_t*)(lw + LW_WGLU); g.ldb = 512; g.K = 512; g.kmid = -1;
            EpiGlu E; E.G = (const bf16_t*)(a.ws + WS_G); E.bglu = a.in[I_BGLU] + layer * 512; E.Y = (bf16_t*)(a.ws + WS_Y); E.ssqs = (float*)(a.ws + WS_SSQS);
            gemm_phase_dense(c, g, M / 256, 2, E);
        }
        SEAM(pb + 3);
        if (IN(pb + 4)) {
            GemmD g; g.A = (const bf16_t*)(a.ws + WS_Y); g.lda = D; g.Bt = (const bf16_t*)(lw + LW_WOUT); g.ldb = D; g.K = D; g.kmid = 512;
            EpiOut E; E.ssqs = (const float*)(a.ws + WS_SSQS); E.ssqa = (const float*)(a.ws + WS_SSQA); E.xin = layer == 0 ? a.in[I_X] : a.out; E.xres = a.out;
            E.xb = (bf16_t*)(a.ws + WS_XB); E.ssq1 = (float*)(a.ws + WS_SSQ1);
            gemm_phase_dense(c, g, M / 256, 4, E);
        }
        SEAM(pb + 4);
        if (IN(pb + 5)) {
            GemmD g; g.A = (const bf16_t*)(a.ws + WS_XB); g.lda = D; g.Bt = (const bf16_t*)(lw + LW_WQ); g.ldb = D; g.K = D; g.kmid = -1;
            EpiQ E; E.ssq1 = (const float*)(a.ws + WS_SSQ1); E.qp = (bf16_t*)(a.ws + WS_QP);
            gemm_phase_dense(c, g, M / 256, 8, E);
        }
        SEAM(pb + 5);
        if (IN(pb + 6)) {
#ifndef SKIP_TOPK
            peer_topk(c, a, layer, gw, NGW);
#endif
        }
        SEAM(pb + 6);
        if (IN(pb + 7)) {
#ifndef SKIP_GATHER
            peer_gather(c, a, layer, gw, NGW);
#endif
        }
        SEAM(pb + 7);
        if (IN(pb + 8)) {
            GemmD g1; g1.A = (const bf16_t*)(a.ws + WS_PB) + (size_t)layer * M * 256; g1.lda = 256; g1.Bt = (const bf16_t*)(lw + LW_WPROJ); g1.ldb = 256; g1.K = 256; g1.kmid = -1;
            EpiProj E1; E1.pr = (float*)(a.ws + WS_QP);
            gemm_phase_dense(c, g1, M / 256, 4, E1);
            VM_WAIT(); __syncthreads();
            GemmD g2; g2.A = (const bf16_t*)(a.ws + WS_XN2); g2.lda = D; g2.Bt = (const bf16_t*)(lw + LW_WGATE); g2.ldb = D; g2.K = D; g2.kmid = -1;
            EpiGate E2; E2.pr = (const float*)(a.ws + WS_QP); E2.xres = a.out; E2.xb = (bf16_t*)(a.ws + WS_XB); E2.ssq0 = (float*)(a.ws + WS_SSQ0);
            gemm_phase_dense(c, g2, M / 256, 4, E2);
        }
        SEAM(pb + 8);
    }
    if (IN(NPHASE - 1)) final_norm(c, a, gw, NGW);
#undef IN
#undef SEAM
}

extern "C" void kernel_launch(void* const* d_in, const int* in_sizes, int n_in, void* d_out, int out_size, void* d_ws, size_t ws_size, hipStream_t stream) {
    static int grid = 0;
    if (grid == 0) {
        if (n_in != 29 || in_sizes[0] != M * D || out_size != M * D || in_sizes[3] != 2 * D * DIN || ws_size < WS_END) {
            fprintf(stderr, "kernel_launch: unexpected problem: n_in %d in0 %d in3 %d out %d ws %zu (need %zu); nothing launched\n", n_in, n_in > 0 ? in_sizes[0] : -1, n_in > 3 ? in_sizes[3] : -1, out_size, ws_size, (size_t)WS_END);
            grid = -1; return; }
        int dev = 0, cus = 0, per_cu = 0;
        if (hipGetDevice(&dev) != hipSuccess || hipDeviceGetAttribute(&cus, hipDeviceAttributeMultiprocessorCount, dev) != hipSuccess) { grid = -1; return; }
        if (hipFuncSetAttribute((const void*)mk_fwd, hipFuncAttributeMaxDynamicSharedMemorySize, LDS_BYTES) != hipSuccess) { fprintf(stderr, "kernel_launch: hipFuncSetAttribute failed\n"); grid = -1; return; }
        if (hipOccupancyMaxActiveBlocksPerMultiprocessor(&per_cu, (const void*)mk_fwd, 512, LDS_BYTES) != hipSuccess || per_cu < 1)
            fprintf(stderr, "kernel_launch: note: occupancy query reports %d workgroups per CU\n", per_cu);
        (void)hipGetLastError();
        grid = cus;
    }
    if (grid < 0) return;
    (void)hipMemsetAsync((char*)d_ws + WS_CTL, 0, CTL_ZERO_BYTES, stream);
    Args a{};
    for (int i = 0; i < 29; ++i) a.in[i] = (const float*)d_in[i];
    a.out = (float*)d_out; a.ws = (unsigned char*)d_ws;
    constexpr int NL = MK_N_LAUNCHES;
    for (int li = 0; li < NL; ++li) {
        a.ph_lo = (NPHASE * li) / NL; a.ph_hi = (NPHASE * (li + 1)) / NL;
        hipLaunchKernelGGL(mk_fwd, dim3(grid), dim3(512), LDS_BYTES, stream, a);
    }
}
```

```cpp
#include <hip/hip_runtime.h>
#include <cstdio>
#include <cstdint>

#ifndef MK_N_LAUNCHES
#define MK_N_LAUNCHES 1
#endif

#define LAS __attribute__((address_space(3)))
typedef unsigned short bf16_t;
typedef short bf16x8 __attribute__((ext_vector_type(8)));
typedef float f32x4 __attribute__((ext_vector_type(4)));
typedef unsigned u32x4 __attribute__((ext_vector_type(4)));
typedef unsigned u32x2 __attribute__((ext_vector_type(2)));

constexpr int NB = 2, SEQ = 8192, M = NB * SEQ, D = 1024, DIN = 1280;
constexpr int NG = 32, LCH = 32, NCH = SEQ / LCH, KCAT = 768;
constexpr float EPS = 1e-6f;
constexpr float C2 = 0.125f * 1.4426950408889634f;
constexpr int NPHASE = 20;

constexpr size_t MiB = 1u << 20;
constexpr size_t WS_CTL = 0, CTL_ZERO_BYTES = 1 * MiB;
constexpr size_t WS_EU = 1 * MiB, WS_EV = 65 * MiB;
constexpr size_t WS_LW = 129 * MiB, LW_STRIDE = 48 * MiB;
constexpr size_t LW_WIN = 0, LW_WGLU = 3 * MiB, LW_WOUT = 4 * MiB, LW_WQ = 6 * MiB, LW_SK1 = 10 * MiB, LW_SK2 = 10 * MiB + 512 * 1024,
                 LW_WGATE = 11 * MiB, LW_WPROJ = 13 * MiB, LW_AL = 13 * MiB + 512 * 1024, LW_WE = 14 * MiB, LW_WY = 22 * MiB;
constexpr size_t WS_PB = 225 * MiB, WS_ROPE = 241 * MiB, WS_XB = 242 * MiB, WS_UCAT = 274 * MiB, WS_QRAW = 300 * MiB, WS_KV = 316 * MiB,
                 WS_EBUF = 324 * MiB, WS_G = 340 * MiB, WS_Y = 356 * MiB, WS_SSQS = 388 * MiB, WS_SSQA = 389 * MiB, WS_SSQ0 = 390 * MiB, WS_SSQ1 = 391 * MiB, WS_RS = 241 * MiB + 512 * 1024,
                 WS_QP = 392 * MiB  , WS_SELI = 456 * MiB, WS_SELW = 464 * MiB, WS_XN2 = 472 * MiB, WS_END = 504 * MiB;
constexpr int CW_BAR = 4096;

constexpr int RING_BYTES = 131072, LDSCTL_OFF = RING_BYTES, MISC_OFF = LDSCTL_OFF + 320, LDS_BYTES = 147456;

__device__ __forceinline__ unsigned f2bf(float f) { unsigned u = __float_as_uint(f); return (u + 0x7fffu + ((u >> 16) & 1u)) >> 16; }
__device__ __forceinline__ unsigned pk2(float lo, float hi) { return f2bf(lo) | (f2bf(hi) << 16); }
__device__ __forceinline__ float bflo(unsigned w) { return __uint_as_float(w << 16); }
__device__ __forceinline__ float bfhi(unsigned w) { return __uint_as_float(w & 0xffff0000u); }
__device__ __forceinline__ float bf1(bf16_t h) { return __uint_as_float((unsigned)h << 16); }
__device__ __forceinline__ float wave_sum(float v) {
#pragma unroll
    for (int o = 1; o < 64; o <<= 1) v += __shfl_xor(v, o);
    return v;
}
__device__ __forceinline__ float wave_max(float v) {
#pragma unroll
    for (int o = 1; o < 64; o <<= 1) v = fmaxf(v, __shfl_xor(v, o));
    return v;
}
__device__ __forceinline__ float sigmoidf_(float x) { return 1.f / (1.f + __expf(-x)); }
__device__ __forceinline__ float gelu_tanh(float x) {
    const float z = 0.7978845608028654f * (x + 0.044715f * x * x * x);
    const float e = __expf(2.f * z);
    const float th = 1.f - 2.f / (e + 1.f);
    return 0.5f * x * (1.f + th);
}
__device__ __forceinline__ float sumn(const float* p, int n) { float s = 0.f; for (int i = 0; i < n; ++i) s += p[i]; return s; }
#define LDS_WAIT() asm volatile("s_waitcnt lgkmcnt(0)" ::: "memory")
#define VM_WAIT() asm volatile("s_waitcnt vmcnt(0)" ::: "memory")

#define XB_TMO      128
#define XB_XCNT(j)  (256  + 64 * (j))
#define XB_XSUB(j)  (1280 + 64 * (j))
#define XB_XGEN(j)  (2304 + 64 * (j))
#define XB_TOP      3328
#define XB_TOPGEN   3392
#define XCD_BAR_WORDS 3456
#define XB_SPIN_CAP (1u << 18)
__device__ __forceinline__ unsigned xb_ld(unsigned* p)              { return __hip_atomic_load(p, __ATOMIC_RELAXED, __HIP_MEMORY_SCOPE_AGENT); }
__device__ __forceinline__ unsigned xb_add(unsigned* p, unsigned v) { return __hip_atomic_fetch_add(p, v, __ATOMIC_RELAXED, __HIP_MEMORY_SCOPE_AGENT); }
__device__ __forceinline__ unsigned xb_xcc_id() { return (unsigned)__builtin_amdgcn_s_getreg((3 << 11) | 20) & 0xFu; }
#define XB_SPIN(cond, bar) do { unsigned _sp = 0; while (cond) { __builtin_amdgcn_s_sleep(1); \
    if ((++_sp & 255u) == 0u) { if (xb_ld(&(bar)[XB_TMO])) break; if (_sp > XB_SPIN_CAP) { atomicAdd(&(bar)[XB_TMO], 1u); break; } } } } while (0)
struct XcdBarrier { unsigned* bar; unsigned x; volatile LAS unsigned* st; };
__device__ __forceinline__ XcdBarrier xcd_barrier_post(unsigned* bar, volatile LAS unsigned* st) {
    XcdBarrier b; b.bar = bar; b.x = xb_xcc_id(); b.st = st;
    if (threadIdx.x == 0) (void)xb_add(&bar[XB_XCNT(b.x)], 1u);
    return b;
}
__device__ __forceinline__ void xcd_barrier_complete(unsigned* bar, unsigned x, unsigned& nloc, unsigned& nx) {
    const unsigned G = gridDim.x * gridDim.y * gridDim.z;
    unsigned sum, cnt, mine, sp = 0u;
    for (;;) {
        sum = 0u; cnt = 0u; mine = 0u;
#pragma unroll
        for (unsigned j = 0; j < 16; ++j) { const unsigned c = xb_ld(&bar[XB_XCNT(j)]); sum += c; cnt += (c > 0u) ? 1u : 0u; mine = (j == x) ? c : mine; }
        if (sum == G) break;
        __builtin_amdgcn_s_sleep(1);
        if ((++sp & 255u) == 0u) { if (xb_ld(&bar[XB_TMO])) break; if (sp > XB_SPIN_CAP) { atomicAdd(&bar[XB_TMO], 1u); break; } }
    }
    nloc = mine > 0u ? mine : 1u; nx = cnt > 0u ? cnt : 1u;
}
__device__ __forceinline__ void xcd_barrier(const XcdBarrier& b) {
    asm volatile("s_waitcnt vmcnt(0)" ::: "memory");
    __syncthreads();
    if (threadIdx.x == 0) {
        unsigned* bar = b.bar;
        __builtin_amdgcn_s_waitcnt(0);
        unsigned nloc = b.st[0], nx = b.st[1];
        if (nloc == 0u) { xcd_barrier_complete(bar, b.x, nloc, nx); b.st[0] = nloc; b.st[1] = nx; }
        const unsigned old = xb_add(&bar[XB_XSUB(b.x)], 1u);
        const unsigned gen = old / nloc;
        if (old + 1u == (gen + 1u) * nloc) {
            __builtin_amdgcn_fence(__ATOMIC_RELEASE, "agent");
            asm volatile("s_waitcnt vmcnt(0)" ::: "memory");
            const unsigned og = xb_add(&bar[XB_TOP], 1u);
            const unsigned tg = og / nx;
            if (og + 1u == (tg + 1u) * nx) xb_add(&bar[XB_TOPGEN], 1u);
            else XB_SPIN(xb_ld(&bar[XB_TOPGEN]) == tg, bar);
            __builtin_amdgcn_fence(__ATOMIC_ACQUIRE, "agent");
            xb_add(&bar[XB_XGEN(b.x)], 1u);
            asm volatile("s_waitcnt vmcnt(0)" ::: "memory");
        } else {
            XB_SPIN(xb_ld(&bar[XB_XGEN(b.x)]) == gen, bar);
            __builtin_amdgcn_fence(__ATOMIC_ACQUIRE, "agent");
            asm volatile("s_waitcnt vmcnt(0)" ::: "memory");
        }
    }
    __syncthreads();
}

struct Args { const float* in[29]; float* out; unsigned char* ws; int ph_lo, ph_hi; };
enum { I_X = 0, I_P, I_NMIXG, I_WIN, I_LRE, I_LIM, I_LOGDT, I_BRE, I_BIM, I_CRE, I_CIM, I_DSKIP, I_WGLU, I_BGLU, I_QNG, I_KNG, I_SSMG, I_ATTG, I_WOUT,
       I_NFFNG, I_WQ, I_SK1, I_SK2, I_EU, I_EV, I_NPLEG, I_WGATE, I_WPROJ, I_FING };

struct Ctx { int tid, lane, wave, blk, nblk; unsigned char* lds; };

struct GemmD { const bf16_t* A; long lda; const bf16_t* Bt; long ldb; int K; int kmid; };
struct Unit { int pm, pn; };

template <class Epi>
__device__ __forceinline__ void sgemm_unit(const GemmD& g, const Unit u, const Epi& E, int wave, int lane) {
    const int i = lane & 15, q = lane >> 4;
    const bf16_t* Ab = g.A + (long)(u.pm * 256 + wave * 32) * g.lda;
    const bf16_t* Bb = g.Bt + (long)(u.pn * 256) * g.ldb;
    const int row0 = u.pm * 256 + wave * 32 + i;
    float ssq[2] = {0.f, 0.f};
    float rs[2] = {1.f, 1.f};
    if constexpr (Epi::ROWSCALE) { rs[0] = E.rscale(row0); rs[1] = E.rscale(row0 + 16); }
    for (int cg = 0; cg < 4; ++cg) {
        f32x4 acc[2][4];
#pragma unroll
        for (int mi = 0; mi < 2; ++mi)
#pragma unroll
            for (int ni = 0; ni < 4; ++ni) acc[mi][ni] = (f32x4){0.f, 0.f, 0.f, 0.f};
        for (int k0 = 0; k0 < g.K; k0 += 32) {
            if constexpr (Epi::MID) { if (k0 == g.kmid) {
#pragma unroll
                for (int mi = 0; mi < 2; ++mi) { const float f = E.mid(row0 + 16 * mi);
#pragma unroll
                    for (int ni = 0; ni < 4; ++ni) acc[mi][ni] *= f; } } }
            bf16x8 a[2], b[4];
#pragma unroll
            for (int mi = 0; mi < 2; ++mi) a[mi] = *(const bf16x8*)(Ab + (long)(16 * mi + i) * g.lda + k0 + 8 * q);
#pragma unroll
            for (int ni = 0; ni < 4; ++ni) b[ni] = *(const bf16x8*)(Bb + (long)(cg * 64 + 16 * ni + i) * g.ldb + k0 + 8 * q);
#pragma unroll
            for (int mi = 0; mi < 2; ++mi)
#pragma unroll
                for (int ni = 0; ni < 4; ++ni) acc[mi][ni] = __builtin_amdgcn_mfma_f32_16x16x32_bf16(b[ni], a[mi], acc[mi][ni], 0, 0, 0);
        }
#pragma unroll
        for (int mi = 0; mi < 2; ++mi)
#pragma unroll
            for (int ni = 0; ni < 4; ++ni) {
                const f32x4 v = acc[mi][ni] * rs[mi];
                const f32x4 w = E.put(row0 + 16 * mi, u.pn * 256 + cg * 64 + 16 * ni + 4 * q, v);
                ssq[mi] += w[0] * w[0] + w[1] * w[1] + w[2] * w[2] + w[3] * w[3];
            }
    }
    if constexpr (Epi::SSQ) {
#pragma unroll
        for (int mi = 0; mi < 2; ++mi) { float s = ssq[mi]; s += __shfl_xor(s, 16); s += __shfl_xor(s, 32);
            if (q == 0) { E.ssq(row0 + 16 * mi, u.pn * 4 + 0, s); E.ssq(row0 + 16 * mi, u.pn * 4 + 1, 0.f); E.ssq(row0 + 16 * mi, u.pn * 4 + 2, 0.f); E.ssq(row0 + 16 * mi, u.pn * 4 + 3, 0.f); } }
    }
}

__device__ __forceinline__ u32x2 pack4(f32x4 v) { u32x2 w; w.x = pk2(v[0], v[1]); w.y = pk2(v[2], v[3]); return w; }

struct EpiInproj {
    static constexpr bool MID = false, ROWSCALE = true, SSQ = false;
    const float* ssq0; bf16_t* ucat; bf16_t* qraw; bf16_t* kv;
    __device__ __forceinline__ float rscale(int row) const { return rsqrtf(sumn(ssq0 + (long)row * 16, 16) * (1.f / D) + EPS); }
    __device__ __forceinline__ f32x4 put(int row, int col, f32x4 v) const {
        const u32x2 w = pack4(v);
        if (col < 512) { const int g = col >> 4, qq = col & 15, b = row >> 13, s = row & (SEQ - 1), c = s >> 5, j = s & 31;
            *(u32x2*)(ucat + ((long)((g * 2 + b) * NCH + c) * KCAT + j * 16 + qq)) = w; }
        else if (col < 1024) *(u32x2*)(qraw + (long)row * 512 + (col - 512)) = w;
        else *(u32x2*)(kv + (long)row * 256 + (col - 1024)) = w;
        return v;
    }
    __device__ __forceinline__ void ssq(int, int, float) const {}
};
struct EpiS1 {
    static constexpr bool MID = false, ROWSCALE = false, SSQ = false;
    float* ebuf;
    __device__ __forceinline__ f32x4 put(int row, int col, f32x4 v) const { *(f32x4*)(ebuf + ((long)row * 256 + (col & 255))) = v; return v; }
    __device__ __forceinline__ void ssq(int, int, float) const {}
};
struct EpiS2 {
    static constexpr bool MID = false, ROWSCALE = false, SSQ = false;
    bf16_t* G;
    __device__ __forceinline__ f32x4 put(int row, int col, f32x4 v) const {
        const int pm = row >> 8, c = row & 255, g = pm >> 1, b = pm & 1, nout = col & 511, j = nout >> 4, p = nout & 15;
        const long tok = (long)b * SEQ + c * LCH + j;
        f32x4 y; y[0] = gelu_tanh(v[0]); y[1] = gelu_tanh(v[1]); y[2] = gelu_tanh(v[2]); y[3] = gelu_tanh(v[3]);
        *(u32x2*)(G + tok * 512 + 16 * g + p) = pack4(y); return v;
    }
    __device__ __forceinline__ void ssq(int, int, float) const {}
};
struct EpiGlu {
    static constexpr bool MID = false, ROWSCALE = false, SSQ = true;
    const bf16_t* G; const float* bglu; bf16_t* Y; float* ssqs;
    __device__ __forceinline__ f32x4 put(int row, int col, f32x4 v) const {
        const u32x2 gw = *(const u32x2*)(G + (long)row * 512 + col);
        const f32x4 bb = *(const f32x4*)(bglu + col);
        f32x4 ys; ys[0] = bflo(gw.x) * sigmoidf_(v[0] + bb[0]); ys[1] = bfhi(gw.x) * sigmoidf_(v[1] + bb[1]);
        ys[2] = bflo(gw.y) * sigmoidf_(v[2] + bb[2]); ys[3] = bfhi(gw.y) * sigmoidf_(v[3] + bb[3]);
        *(u32x2*)(Y + (long)row * 1024 + col) = pack4(ys); return ys;
    }
    __device__ __forceinline__ void ssq(int row, int slot, float s) const { ssqs[(long)row * 16 + slot] = s; }
};
struct EpiOut {
    static constexpr bool MID = true, ROWSCALE = true, SSQ = true;
    const float* rs; const float* xin; float* xres; bf16_t* xb; float* ssq1;
    __device__ __forceinline__ float mid(int row) const { return rs[(long)row * 2]; }
    __device__ __forceinline__ float rscale(int row) const { return rs[(long)row * 2 + 1]; }
    __device__ __forceinline__ f32x4 put(int row, int col, f32x4 v) const {
        const long o = (long)row * D + col; const f32x4 x1 = *(const f32x4*)(xin + o) + v;
        *(f32x4*)(xres + o) = x1; *(u32x2*)(xb + o) = pack4(x1); return x1;
    }
    __device__ __forceinline__ void ssq(int row, int slot, float s) const { ssq1[(long)row * 16 + slot] = s; }
};
struct EpiQ {
    static constexpr bool MID = false, ROWSCALE = true, SSQ = false;
    const float* ssq1; bf16_t* qp;
    __device__ __forceinline__ float rscale(int row) const { return rsqrtf(sumn(ssq1 + (long)row * 16, 16) * (1.f / D) + EPS); }
    __device__ __forceinline__ f32x4 put(int row, int col, f32x4 v) const { *(u32x2*)(qp + (long)row * 2048 + col) = pack4(v); return v; }
    __device__ __forceinline__ void ssq(int, int, float) const {}
};
struct EpiProj {
    static constexpr bool MID = false, ROWSCALE = false, SSQ = false;
    float* pr;
    __device__ __forceinline__ f32x4 put(int row, int col, f32x4 v) const { *(f32x4*)(pr + (long)row * D + col) = v; return v; }
    __device__ __forceinline__ void ssq(int, int, float) const {}
};
struct EpiGate {
    static constexpr bool MID = false, ROWSCALE = false, SSQ = true;
    const float* pr; float* xres; bf16_t* xb; float* ssq0;
    __device__ __forceinline__ f32x4 put(int row, int col, f32x4 v) const {
        const long o = (long)row * D + col; const f32x4 pv = *(const f32x4*)(pr + o); f32x4 x3 = *(const f32x4*)(xres + o);
        x3[0] += sigmoidf_(v[0]) * pv[0]; x3[1] += sigmoidf_(v[1]) * pv[1]; x3[2] += sigmoidf_(v[2]) * pv[2]; x3[3] += sigmoidf_(v[3]) * pv[3];
        *(f32x4*)(xres + o) = x3; *(u32x2*)(xb + o) = pack4(x3); return x3;
    }
    __device__ __forceinline__ void ssq(int row, int slot, float s) const { ssq0[(long)row * 16 + slot] = s; }
};


namespace pg8 {
#define PG8_LAS __attribute__((address_space(3)))
constexpr int BM = 256, BK = 64, HALF = 128, HTB = HALF * BK * 2, STAGE_BYTES = 8 * HTB, NXCD = 8, WGM = 8;
__host__ __device__ __forceinline__ int lds_byte(int r, int c) { const int st = (r >> 4) * 2 + (c >> 5), rr = r & 15, cc = c & 31, ob = rr * 64 + cc * 2; return st * 1024 + (ob ^ (((ob >> 9) & 1) << 5)); }
__host__ __device__ __forceinline__ void stage_rc(int b, int& R, int& C) { const int st = b / 1024, sb = b % 1024, swz = sb ^ (((sb >> 9) & 1) << 5); R = (st >> 1) * 16 + swz / 64; C = (st & 1) * 32 + (swz % 64) / 2; }
__host__ __device__ __forceinline__ int perm32(int rho) { const int n = rho >> 4, i = rho & 15; return 8 * (i >> 2) + 4 * n + (i & 3); }
using ::Unit;
struct Gemm { const bf16_t* A; const bf16_t* Bt; int K, lda, ldb, kmid; };
struct StaticOrder {
    int nM, nN, nwg, G, c;
    __host__ __device__ void init(int M_, int N_, int G_, int c_) { nM = M_ / BM; nN = N_ / BM; nwg = nM * nN; G = G_; c = c_; }
    __host__ __device__ bool next(int i, Unit& u) const {
        const long L = (long)i * G + c; if (L >= nwg) return false;
        int wgid = (int)L; { const int q = nwg / NXCD, r = nwg % NXCD, xcd = wgid % NXCD, off = wgid / NXCD; wgid = (xcd < r ? xcd * (q + 1) : r * (q + 1) + (xcd - r) * q) + off; }
        const int nig = WGM * nN, gid = wgid / nig, fm = gid * WGM, gsz = (nM - fm) < WGM ? (nM - fm) : WGM;
        u.pm = fm + ((wgid % nig) % gsz); u.pn = (wgid % nig) / gsz; return true;
    }
    __device__ __forceinline__ void a_ready(const Unit&) const {}
    __device__ __forceinline__ void done(const Unit&) const {}
};
struct OneUnit { Unit u;
    __device__ __forceinline__ bool next(int i, Unit& o) const { if (i) return false; o = u; return true; }
    __device__ __forceinline__ void a_ready(const Unit&) const {}
    __device__ __forceinline__ void done(const Unit&) const {} };
struct S2Order { int blk, nblk;
    __device__ __forceinline__ bool next(int i, Unit& o) const { const int ui = blk + i * nblk; if (ui >= 128) return false; o.pm = ui >> 1; o.pn = (ui >> 2) * 2 + (ui & 1); return true; }
    __device__ __forceinline__ void a_ready(const Unit&) const {}
    __device__ __forceinline__ void done(const Unit&) const {} };
template <class F> struct Epi {
    static constexpr bool PERM = false, AFTER_DRAIN = false, MID = F::MID;
    F f;
    __device__ __forceinline__ void operator()(const f32x4 (&acc)[2][2][4][2], const Unit& u, int wr, int wc, int fr, int fq) const {
        asm volatile("" : "+v"(fr), "+v"(fq));
        const int rowb = u.pm * BM + wr * 64 + fr, colb = u.pn * BM + wc * 32 + 4 * fq;
#pragma unroll
        for (int ai = 0; ai < 2; ++ai)
#pragma unroll
            for (int m = 0; m < 4; ++m) {
                const int row = rowb + ai * HALF + m * 16; float rs = 1.f; if constexpr (F::ROWSCALE) rs = f.rscale(row);
                float ss = 0.f;
#pragma unroll
                for (int bj = 0; bj < 2; ++bj)
#pragma unroll
                    for (int n = 0; n < 2; ++n) { const f32x4 w = f.put(row, colb + bj * HALF + n * 16, acc[ai][bj][m][n] * rs); ss += w[0] * w[0] + w[1] * w[1] + w[2] * w[2] + w[3] * w[3]; }
                if constexpr (F::SSQ) { ss += __shfl_xor(ss, 16); ss += __shfl_xor(ss, 32); if (fq == 0) f.ssq(row, u.pn * 4 + wc, ss); }
                asm volatile("" ::: "memory");
            }
    }
    __device__ __forceinline__ void midscale(f32x4 (&acc)[2][2][4][2], const Unit& u, int wr, int wc, int fr, int fq) const {
        if constexpr (F::MID) {
            asm volatile("" : "+v"(fr));
            const int rowb = u.pm * BM + wr * 64 + fr;
#pragma unroll
            for (int ai = 0; ai < 2; ++ai)
#pragma unroll
                for (int m = 0; m < 4; ++m) { const float s = f.mid(rowb + ai * HALF + m * 16);
#pragma unroll
                    for (int bj = 0; bj < 2; ++bj)
#pragma unroll
                        for (int n = 0; n < 2; ++n) acc[ai][bj][m][n] *= s; }
        }
    }
};
template <class Epi, class Sched, bool ALIGN_EPI = false, bool SP2 = false>
__device__ __forceinline__ void gemm_phase(PG8_LAS unsigned char* lds, const Gemm g, const Sched& S, const Epi& E, const int tid) {
    const int wid = __builtin_amdgcn_readfirstlane(tid >> 6), lane = tid & 63, wr = wid >> 2, wc = wid & 3, fr = lane & 15, fq = lane >> 4;
    const int K = g.K, nt = K / BK;
    unsigned voffA[2], voffB[2];
#pragma unroll
    for (int i = 0; i < 2; ++i) { int R, C; stage_rc(tid * 16 + i * 8192, R, C); const int Rb = Epi::PERM ? ((R & ~31) + perm32(R & 31)) : R;
        voffA[i] = (unsigned)(R * g.lda + C) * 2u; voffB[i] = (unsigned)(Rb * g.ldb + C) * 2u; }
    const size_t kstep = (size_t)(BK * 2);
    const size_t hstepA = (size_t)HALF * g.lda * 2, hstepB = (size_t)HALF * g.ldb * 2;
    const size_t tstepA = 2 * hstepA, tstepB = 2 * hstepB;
    const unsigned ldsw = (unsigned)wid * 1024u;
    const int aoff = lds_byte(wr * 64 + fr, fq * 8), boff = lds_byte(wc * 32 + fr, fq * 8);
#define PG8_SA(b, h) (((b) * 2 + (h)) * HTB)
#define PG8_SB(b, h) ((4 + (b) * 2 + (h)) * HTB)
#define PG8_STAGE(bufoff, gbase, voff) do { _Pragma("unroll") for (int _i = 0; _i < 2; ++_i) \
        __builtin_amdgcn_global_load_lds((const unsigned*)((const char*)(gbase) + (voff)[_i]), (PG8_LAS unsigned*)(lds + (bufoff) + ldsw + _i * 8192), 16, 0, 0); } while (0)
#define PG8_LDA(dst, b, h) do { _Pragma("unroll") for (int m = 0; m < 4; ++m) _Pragma("unroll") for (int k = 0; k < 2; ++k) dst[m][k] = *(const PG8_LAS bf16x8*)(lds + PG8_SA(b, h) + aoff + m * 2048 + k * 1024); } while (0)
#define PG8_LDB(dst, b, h) do { _Pragma("unroll") for (int n = 0; n < 2; ++n) _Pragma("unroll") for (int k = 0; k < 2; ++k) dst[n][k] = *(const PG8_LAS bf16x8*)(lds + PG8_SB(b, h) + boff + n * 2048 + k * 1024); } while (0)
#define PG8_MMA(ai, bj, At, Bt) do { __builtin_amdgcn_s_setprio(1); _Pragma("unroll") for (int m = 0; m < 4; ++m) _Pragma("unroll") for (int n = 0; n < 2; ++n) _Pragma("unroll") for (int k = 0; k < 2; ++k) \
        acc[ai][bj][m][n] = __builtin_amdgcn_mfma_f32_16x16x32_bf16(Bt[n][k], At[m][k], acc[ai][bj][m][n], 0, 0, 0); __builtin_amdgcn_s_setprio(0); } while (0)
#define PG8_WAIT_V(n) asm volatile("s_waitcnt vmcnt(" #n ")" ::: "memory")
#define PG8_WAIT_L(n) asm volatile("s_waitcnt lgkmcnt(" #n ")" ::: "memory")
#define PG8_BAR __builtin_amdgcn_s_barrier()
#define PG8_SCHED __builtin_amdgcn_sched_barrier(0)
    Unit cur, nxt; int ui = 0;
    if (!S.next(0, cur)) return;
    f32x4 acc[2][2][4][2];
#pragma unroll
    for (int a = 0; a < 2; ++a)
#pragma unroll
        for (int b = 0; b < 2; ++b)
#pragma unroll
            for (int m = 0; m < 4; ++m)
#pragma unroll
                for (int n = 0; n < 2; ++n) acc[a][b][m][n] = (f32x4){0.f, 0.f, 0.f, 0.f};
    bf16x8 At[4][2], B0[2][2], B1[2][2];
    const char* cA = (const char*)g.A + (size_t)cur.pm * tstepA; const char* cB = (const char*)g.Bt + (size_t)cur.pn * tstepB;
    S.a_ready(cur);
    if constexpr (SP2) {
        PG8_STAGE(PG8_SB(0, 0), cB, voffB); PG8_STAGE(PG8_SB(0, 1), cB + hstepB, voffB); PG8_STAGE(PG8_SA(0, 0), cA, voffA); PG8_STAGE(PG8_SA(0, 1), cA + hstepA, voffA);
        if (wr == 1) PG8_BAR;
        PG8_WAIT_V(2); PG8_BAR;
        PG8_STAGE(PG8_SB(1, 0), cB + kstep, voffB); PG8_STAGE(PG8_SA(1, 0), cA + kstep, voffA); PG8_STAGE(PG8_SB(1, 1), cB + hstepB + kstep, voffB);
        PG8_WAIT_V(6); PG8_BAR;
    } else {
        PG8_STAGE(PG8_SB(0, 0), cB, voffB); PG8_STAGE(PG8_SA(0, 0), cA, voffA); PG8_STAGE(PG8_SB(0, 1), cB + hstepB, voffB); PG8_STAGE(PG8_SA(0, 1), cA + hstepA, voffA);
        if (wr == 1) PG8_BAR;
        PG8_WAIT_V(4); PG8_BAR;
        PG8_STAGE(PG8_SB(1, 0), cB + kstep, voffB); PG8_STAGE(PG8_SA(1, 0), cA + kstep, voffA); PG8_STAGE(PG8_SB(1, 1), cB + hstepB + kstep, voffB);
        PG8_WAIT_V(6); PG8_BAR;
    }
    for (;;) {
        const bool has_next = S.next(ui + 1, nxt);
        const char* nA = has_next ? (const char*)g.A + (size_t)nxt.pm * tstepA : cA; const char* nB = has_next ? (const char*)g.Bt + (size_t)nxt.pn * tstepB : cB;
        for (int t = 0; t < nt; t += 2) {
            const bool last = (t == nt - 2);
            if constexpr (Epi::MID) { if (t * BK == g.kmid) E.midscale(acc, cur, wr, wc, fr, fq); }
            const char* a1 = cA + (size_t)(t + 1) * kstep;
            const char* a2 = last ? nA : cA + (size_t)(t + 2) * kstep; const char* b2 = last ? nB : cB + (size_t)(t + 2) * kstep;
            const char* a3 = a2 + kstep; const char* b3 = b2 + kstep;
            if (last && has_next) S.a_ready(nxt);
            if constexpr (SP2) {
            PG8_LDB(B0, 0, 0); PG8_LDB(B1, 0, 1); PG8_SCHED; PG8_LDA(At, 0, 0); PG8_STAGE(PG8_SA(1, 1), a1 + hstepA, voffA);
            PG8_WAIT_V(8); PG8_WAIT_L(0); PG8_BAR; PG8_MMA(0, 0, At, B0); PG8_MMA(0, 1, At, B1); PG8_BAR; PG8_SCHED;
            PG8_LDA(At, 0, 1); PG8_STAGE(PG8_SB(0, 0), b2, voffB); PG8_STAGE(PG8_SB(0, 1), b2 + hstepB, voffB); PG8_STAGE(PG8_SA(0, 0), a2, voffA);
            PG8_WAIT_V(8); PG8_WAIT_L(0); PG8_BAR; PG8_MMA(1, 0, At, B0); PG8_MMA(1, 1, At, B1); PG8_BAR; PG8_SCHED;
            PG8_LDB(B0, 1, 0); PG8_LDB(B1, 1, 1); PG8_SCHED; PG8_LDA(At, 1, 0); PG8_STAGE(PG8_SA(0, 1), a2 + hstepA, voffA);
            PG8_WAIT_V(8); PG8_WAIT_L(0); PG8_BAR; PG8_MMA(0, 0, At, B0); PG8_MMA(0, 1, At, B1); PG8_BAR; PG8_SCHED;
            PG8_LDA(At, 1, 1); PG8_STAGE(PG8_SB(1, 0), b3, voffB); PG8_STAGE(PG8_SB(1, 1), b3 + hstepB, voffB); PG8_STAGE(PG8_SA(1, 0), a3, voffA);
            PG8_WAIT_V(8); PG8_WAIT_L(0); PG8_BAR; PG8_MMA(1, 0, At, B0); PG8_MMA(1, 1, At, B1); PG8_BAR; PG8_SCHED;
            } else {
            PG8_LDB(B0, 0, 0); PG8_SCHED; PG8_LDA(At, 0, 0); PG8_STAGE(PG8_SA(1, 1), a1 + hstepA, voffA);
            PG8_WAIT_L(8); PG8_BAR; PG8_WAIT_L(0); PG8_MMA(0, 0, At, B0); PG8_BAR; PG8_SCHED;
            PG8_LDB(B1, 0, 1); PG8_STAGE(PG8_SB(0, 0), b2, voffB);
            PG8_BAR; PG8_WAIT_L(0); PG8_MMA(0, 1, At, B1); PG8_BAR;
            PG8_LDA(At, 0, 1); PG8_STAGE(PG8_SA(0, 0), a2, voffA);
            PG8_BAR; PG8_WAIT_L(0); PG8_MMA(1, 0, At, B0); PG8_BAR; PG8_SCHED;
            PG8_STAGE(PG8_SB(0, 1), b2 + hstepB, voffB);
            PG8_WAIT_V(6); PG8_BAR; PG8_MMA(1, 1, At, B1); PG8_BAR;
            PG8_LDB(B0, 1, 0); PG8_SCHED; PG8_LDA(At, 1, 0); PG8_STAGE(PG8_SA(0, 1), a2 + hstepA, voffA);
            PG8_WAIT_L(8); PG8_BAR; PG8_WAIT_L(0); PG8_MMA(0, 0, At, B0); PG8_BAR; PG8_SCHED;
            PG8_LDB(B1, 1, 1); PG8_STAGE(PG8_SB(1, 0), b3, voffB);
            PG8_BAR; PG8_WAIT_L(0); PG8_MMA(0, 1, At, B1); PG8_BAR;
            PG8_LDA(At, 1, 1); PG8_STAGE(PG8_SA(1, 0), a3, voffA);
            PG8_BAR; PG8_WAIT_L(0); PG8_MMA(1, 0, At, B0); PG8_BAR; PG8_SCHED;
            PG8_STAGE(PG8_SB(1, 1), b3 + hstepB, voffB);
            PG8_WAIT_V(6); PG8_BAR; PG8_MMA(1, 1, At, B1); PG8_BAR;
            }
        }
        if constexpr (ALIGN_EPI) { if (wr == 0) PG8_BAR; }
        if constexpr (!Epi::AFTER_DRAIN) { E(acc, cur, wr, wc, fr, fq); S.done(cur); }
        if (!has_next) break;
#pragma unroll
        for (int a = 0; a < 2; ++a)
#pragma unroll
            for (int b = 0; b < 2; ++b)
#pragma unroll
                for (int m = 0; m < 4; ++m)
#pragma unroll
                    for (int n = 0; n < 2; ++n) acc[a][b][m][n] = (f32x4){0.f, 0.f, 0.f, 0.f};
        cur = nxt; cA = nA; cB = nB; ++ui;
        if constexpr (ALIGN_EPI) { if (wr == 1) PG8_BAR; }
    }
    PG8_WAIT_V(0);
    if constexpr (!ALIGN_EPI) { if (wr == 0) PG8_BAR; }
    PG8_BAR;
    if constexpr (Epi::AFTER_DRAIN) { E.fused(acc, cur, wr, wc, fr, fq, lds, wid, lane); S.done(cur); }
#undef PG8_SA
#undef PG8_SB
#undef PG8_STAGE
#undef PG8_LDA
#undef PG8_LDB
#undef PG8_MMA
#undef PG8_WAIT_V
#undef PG8_WAIT_L
#undef PG8_BAR
#undef PG8_SCHED
}

}

template <class F, class Sched>
__device__ __forceinline__ void run_gemm(unsigned char* lds, const GemmD& g, const Sched& S, const F& f, const int tid) {
    pg8::Gemm pg; pg.A = g.A; pg.Bt = g.Bt; pg.K = g.K; pg.lda = (int)g.lda; pg.ldb = (int)g.ldb; pg.kmid = g.kmid;
    pg8::Epi<F> E; E.f = f;
    pg8::gemm_phase<pg8::Epi<F>, Sched, true, true>((PG8_LAS unsigned char*)lds, pg, S, E, tid);
}
template <class Epi>
__device__ __forceinline__ void gemm_phase_dense(const Ctx& c, const GemmD& g, int nM, int nN, const Epi& E) {
#ifdef USE_SGEMM
    const int nU = nM * nN;
    for (int ui = c.blk; ui < nU; ui += c.nblk) { Unit u; u.pn = ui % nN; u.pm = ui / nN; sgemm_unit(g, u, E, c.wave, c.lane); }
#else
    pg8::StaticOrder S; S.init(nM * 256, nN * 256, c.nblk, c.blk);
    run_gemm(c.lds, g, S, E, c.tid);
#endif
}

__device__ __forceinline__ void transpose_item(const float* W, int K, int N, bf16_t* WT, const float* gain, float* scr, int item, int lane) {
    const int nblk = N / 32, kb = item / nblk, nb = item % nblk, k0 = 64 * kb, n0 = 32 * nb;
#pragma unroll 8
    for (int i = 0; i < 32; ++i) { const int kk = 2 * i + (lane >> 5); float v = W[(size_t)(k0 + kk) * N + n0 + (lane & 31)]; if (gain) v *= gain[k0 + kk]; scr[kk * 33 + (lane & 31)] = v; }
    LDS_WAIT(); asm volatile("" ::: "memory");
    const int cc = lane & 7;
#pragma unroll
    for (int j = 0; j < 4; ++j) { const int n = (lane >> 3) + 8 * j; const float* s = scr + (8 * cc) * 33 + n;
        u32x4 o; o.x = pk2(s[0 * 33], s[1 * 33]); o.y = pk2(s[2 * 33], s[3 * 33]); o.z = pk2(s[4 * 33], s[5 * 33]); o.w = pk2(s[6 * 33], s[7 * 33]);
        *(u32x4*)(WT + (size_t)(n0 + n) * K + k0 + 8 * cc) = o; }
    LDS_WAIT(); asm volatile("" ::: "memory");
}
__device__ __forceinline__ void cvt_range(const Ctx& c, const float* src, bf16_t* dst, size_t n) {
    const size_t nv = n / 8, stride = (size_t)c.nblk * 512;
    for (size_t v = (size_t)c.blk * 512 + c.tid; v < nv; v += stride) {
        const f32x4 a = *(const f32x4*)(src + v * 8), b = *(const f32x4*)(src + v * 8 + 4);
        u32x4 o; o.x = pk2(a[0], a[1]); o.y = pk2(a[2], a[3]); o.z = pk2(b[0], b[1]); o.w = pk2(b[2], b[3]);
        *(u32x4*)(dst + v * 8) = o;
    }
}
__device__ __forceinline__ void ssm_tables_unit(const Ctx& c, const Args& a, int layer, int g) {
    float* Apow = (float*)c.lds;
    float* Bre = Apow + 2 * 33 * 64 * 2;
    float* Bim = Bre + 2 * 64 * 16;
    float* Cre = Bim + 2 * 64 * 16;
    float* Cim = Cre + 2 * 16 * 64;
    float* Tt = Cim + 2 * 16 * 64;
    unsigned char* lw = a.ws + WS_LW + (size_t)layer * LW_STRIDE;
    float* AL = (float*)(lw + LW_AL);
    bf16_t* WE = (bf16_t*)(lw + LW_WE) + (size_t)g * 256 * 512;
    bf16_t* WY = (bf16_t*)(lw + LW_WY) + (size_t)g * 512 * KCAT;
    const int tid = c.tid;
    __syncthreads();
    if (tid < 128) {
        const int dir = tid >> 6, n = tid & 63; const int ldg = (layer * 2 + dir) * NG + g;
        const float lre = a.in[I_LRE][ldg * 64 + n], lim = a.in[I_LIM][ldg * 64 + n];
        const float dt = expf(a.in[I_LOGDT][ldg]);
        for (int k = 0; k <= 32; ++k) { const float dec = expf(lre * dt * (float)k), ang = (lim * dt) * (float)k; float sn, cs; sincosf(ang, &sn, &cs);
            Apow[((dir * 33 + k) * 64 + n) * 2 + 0] = dec * cs; Apow[((dir * 33 + k) * 64 + n) * 2 + 1] = dec * sn; }
        const float abr = Apow[((dir * 33 + 1) * 64 + n) * 2 + 0], abi = Apow[((dir * 33 + 1) * 64 + n) * 2 + 1];
        const float den = lre * lre + lim * lim, nr = abr - 1.f;
        const float fre = (nr * lre + abi * lim) / den, fim = (abi * lre - nr * lim) / den;
        for (int q = 0; q < 16; ++q) { const float br = a.in[I_BRE][(ldg * 64 + n) * 16 + q], bi = a.in[I_BIM][(ldg * 64 + n) * 16 + q];
            Bre[(dir * 64 + n) * 16 + q] = fre * br - fim * bi; Bim[(dir * 64 + n) * 16 + q] = fre * bi + fim * br; }
        for (int p = 0; p < 16; ++p) { Cre[(dir * 16 + p) * 64 + n] = a.in[I_CRE][(ldg * 16 + p) * 64 + n]; Cim[(dir * 16 + p) * 64 + n] = a.in[I_CIM][(ldg * 16 + p) * 64 + n]; }
        AL[((dir * NG + g) * 64 + n) * 2 + 0] = Apow[((dir * 33 + 32) * 64 + n) * 2 + 0];
        AL[((dir * NG + g) * 64 + n) * 2 + 1] = Apow[((dir * 33 + 32) * 64 + n) * 2 + 1];
    }
    __syncthreads();
    for (int task = tid; task < 63 * 16; task += 512) {
        const int kk = task >> 4, p = task & 15, k = kk - 31;
        float acc[16];
#pragma unroll
        for (int q = 0; q < 16; ++q) acc[q] = 0.f;
        for (int part = 0; part < 2; ++part) {
            if ((part == 0 && k < 0) || (part == 1 && k > 0)) continue;
            const int dir = part, e = k >= 0 ? k : -k;
            for (int n = 0; n < 64; ++n) {
                const float cr = Cre[(dir * 16 + p) * 64 + n], ci = Cim[(dir * 16 + p) * 64 + n];
                const float ar = Apow[((dir * 33 + e) * 64 + n) * 2 + 0], ai = Apow[((dir * 33 + e) * 64 + n) * 2 + 1];
                const float car = cr * ar - ci * ai, cai = cr * ai + ci * ar;
#pragma unroll
                for (int q = 0; q < 16; ++q) acc[q] += car * Bre[(dir * 64 + n) * 16 + q] - cai * Bim[(dir * 64 + n) * 16 + q];
            }
        }
        const float dsk = a.in[I_DSKIP][layer * 512 + 16 * g + p];
#pragma unroll
        for (int q = 0; q < 16; ++q) Tt[(kk * 16 + p) * 16 + q] = acc[q] + ((k == 0 && q == p) ? dsk : 0.f);
    }
    __syncthreads();
    for (int it = tid; it < 512 * 96; it += 512) {
        const int nout = it / 96, kin0 = (it % 96) * 8, j = nout >> 4, p = nout & 15;
        float v[8];
        if (kin0 < 512) { const int s = kin0 >> 4, q0 = kin0 & 15, kk = j - s + 31;
#pragma unroll
            for (int i = 0; i < 8; ++i) v[i] = Tt[(kk * 16 + p) * 16 + q0 + i]; }
        else { const int comp = kin0 - 512, dir = comp >> 7, reim = (comp >> 6) & 1, n0 = comp & 63, e = dir == 0 ? j + 1 : 32 - j;
#pragma unroll
            for (int i = 0; i < 8; ++i) { const int n = n0 + i; const float cr = Cre[(dir * 16 + p) * 64 + n], ci = Cim[(dir * 16 + p) * 64 + n];
                const float ar = Apow[((dir * 33 + e) * 64 + n) * 2 + 0], ai = Apow[((dir * 33 + e) * 64 + n) * 2 + 1];
                v[i] = reim == 0 ? (cr * ar - ci * ai) : -(cr * ai + ci * ar); } }
        u32x4 o; o.x = pk2(v[0], v[1]); o.y = pk2(v[2], v[3]); o.z = pk2(v[4], v[5]); o.w = pk2(v[6], v[7]);
        *(u32x4*)(WY + (size_t)nout * KCAT + kin0) = o;
    }
    for (int it = tid; it < 256 * 64; it += 512) {
        const int comp = it >> 6, kin0 = (it & 63) * 8, j = kin0 >> 4, q0 = kin0 & 15, dir = comp >> 7, reim = (comp >> 6) & 1, n = comp & 63, e = dir == 0 ? 31 - j : j;
        const float ar = Apow[((dir * 33 + e) * 64 + n) * 2 + 0], ai = Apow[((dir * 33 + e) * 64 + n) * 2 + 1];
        float v[8];
#pragma unroll
        for (int i = 0; i < 8; ++i) { const float br = Bre[(dir * 64 + n) * 16 + q0 + i], bi = Bim[(dir * 64 + n) * 16 + q0 + i]; v[i] = reim == 0 ? (ar * br - ai * bi) : (ar * bi + ai * br); }
        u32x4 o; o.x = pk2(v[0], v[1]); o.y = pk2(v[2], v[3]); o.z = pk2(v[4], v[5]); o.w = pk2(v[6], v[7]);
        *(u32x4*)(WE + (size_t)comp * 512 + kin0) = o;
    }
    __syncthreads();
}
__device__ __forceinline__ void p0_prologue(const Ctx& c, const Args& a) {
    for (int u = c.blk; u < 2 * NG; u += c.nblk) ssm_tables_unit(c, a, u / NG, u % NG);
    float* scr = (float*)(c.lds + c.wave * 8448);
    const int gw = c.blk * 8 + c.wave, NGW = c.nblk * 8;
    constexpr int I0 = 640, I1 = 128, I2 = 512, I3 = 1024, I4 = 512, I5 = 128, IL = I0 + I1 + I2 + I3 + I4 + I5;
    for (int it = gw; it < 2 * IL; it += NGW) {
        const int L = it / IL; int r = it % IL; unsigned char* lw = a.ws + WS_LW + (size_t)L * LW_STRIDE;
        if (r < I0) { transpose_item(a.in[I_WIN] + (size_t)L * D * DIN, D, DIN, (bf16_t*)(lw + LW_WIN), a.in[I_NMIXG] + L * D, scr, r, c.lane); continue; } r -= I0;
        if (r < I1) { transpose_item(a.in[I_WGLU] + (size_t)L * 512 * 512, 512, 512, (bf16_t*)(lw + LW_WGLU), nullptr, scr, r, c.lane); continue; } r -= I1;
        if (r < I2) { const int k0 = 64 * (r / 32); const float* gn = k0 < 512 ? a.in[I_SSMG] + L * 512 : a.in[I_ATTG] + L * 512 - 512;
            transpose_item(a.in[I_WOUT] + (size_t)L * D * D, D, D, (bf16_t*)(lw + LW_WOUT), gn, scr, r, c.lane); continue; } r -= I2;
        if (r < I3) { transpose_item(a.in[I_WQ] + (size_t)L * D * 2048, D, 2048, (bf16_t*)(lw + LW_WQ), a.in[I_NFFNG] + L * D, scr, r, c.lane); continue; } r -= I3;
        if (r < I4) { transpose_item(a.in[I_WGATE] + (size_t)L * D * D, D, D, (bf16_t*)(lw + LW_WGATE), nullptr, scr, r, c.lane); continue; } r -= I4;
        transpose_item(a.in[I_WPROJ] + (size_t)L * 256 * D, 256, D, (bf16_t*)(lw + LW_WPROJ), nullptr, scr, r, c.lane);
    }
    cvt_range(c, a.in[I_EU], (bf16_t*)(a.ws + WS_EU), (size_t)2 * 16384 * 1024);
    cvt_range(c, a.in[I_EV], (bf16_t*)(a.ws + WS_EV), (size_t)2 * 16384 * 1024);
    cvt_range(c, a.in[I_P], (bf16_t*)(a.ws + WS_PB), (size_t)2 * M * 256);
    for (int L = 0; L < 2; ++L) {
        cvt_range(c, a.in[I_SK1] + (size_t)L * 8 * 128 * 128, (bf16_t*)(a.ws + WS_LW + (size_t)L * LW_STRIDE + LW_SK1), (size_t)8 * 128 * 128);
        cvt_range(c, a.in[I_SK2] + (size_t)L * 8 * 128 * 128, (bf16_t*)(a.ws + WS_LW + (size_t)L * LW_STRIDE + LW_SK2), (size_t)8 * 128 * 128);
    }
    {
        bf16_t* XB = (bf16_t*)(a.ws + WS_XB); float* SSQ0 = (float*)(a.ws + WS_SSQ0);
        for (int m = gw; m < M; m += NGW) {
            const f32x4* xr = (const f32x4*)(a.in[I_X] + (size_t)m * D) + c.lane; float s = 0.f;
#pragma unroll
            for (int j = 0; j < 4; ++j) { const f32x4 v = xr[64 * j]; s += v[0] * v[0] + v[1] * v[1] + v[2] * v[2] + v[3] * v[3];
                *(u32x2*)(XB + (size_t)m * D + 256 * j + 4 * c.lane) = pack4(v); }
            s = wave_sum(s);
            if (c.lane < 16) SSQ0[(size_t)m * 16 + c.lane] = c.lane == 0 ? s : 0.f;
        }
    }
    if (c.blk == c.nblk - 1) {
        float* R = (float*)(a.ws + WS_ROPE);
        for (int e = c.tid; e < 3072; e += 512) {
            const bool isr = e < 2048; const int pos = isr ? (e >> 4) : ((e - 2048) >> 4), f = e & 15;
            const float inv = powf(10000.f, -(float)f / 16.f), ang = (float)pos * inv; float sn, cs; sincosf(ang, &sn, &cs);
            if (isr) { R[e] = cs; R[2048 + e] = sn; } else { R[4096 + (e - 2048)] = cs; R[5120 + (e - 2048)] = sn; }
        }
    }
}

__device__ __forceinline__ void s1_unit(const Ctx& c, const Args& a, int layer, int gb  ) {
    unsigned char* lw = a.ws + WS_LW + (size_t)layer * LW_STRIDE;
    bf16_t* UC = (bf16_t*)(a.ws + WS_UCAT); float* EB = (float*)(a.ws + WS_EBUF);
    const int g = gb >> 1;
    GemmD gd; gd.A = UC; gd.lda = KCAT; gd.Bt = (const bf16_t*)(lw + LW_WE); gd.ldb = 512; gd.K = 512; gd.kmid = -1;
    EpiS1 E; E.ebuf = EB;
    Unit u; u.pm = gb; u.pn = g;
#ifdef USE_SGEMM
    sgemm_unit(gd, u, E, c.wave, c.lane);
#else
    { pg8::OneUnit S; S.u = u; run_gemm(c.lds, gd, S, E, c.tid); }
#endif
    VM_WAIT(); __syncthreads();
    if (c.tid < 128) {
        const int dir = c.tid >> 6, n = c.tid & 63;
        const float* AL = (const float*)(lw + LW_AL);
        const float alr = AL[((dir * NG + g) * 64 + n) * 2 + 0], ali = AL[((dir * NG + g) * 64 + n) * 2 + 1];
        float hr = 0.f, hi = 0.f;
        const float* eb = EB + (size_t)gb * NCH * 256 + dir * 128 + n;
        bf16_t* hc = UC + (size_t)gb * NCH * KCAT + 512 + dir * 128 + n;
#pragma unroll 8
        for (int s = 0; s < NCH; ++s) {
            const int ch = dir == 0 ? s : NCH - 1 - s;
            hc[(size_t)ch * KCAT] = (bf16_t)f2bf(hr); hc[(size_t)ch * KCAT + 64] = (bf16_t)f2bf(hi);
            const float er = eb[(size_t)ch * 256], ei = eb[(size_t)ch * 256 + 64];
            const float nr = alr * hr - ali * hi + er, ni = alr * hi + ali * hr + ei; hr = nr; hi = ni;
        }
    }
    __syncthreads();
}
__device__ __forceinline__ void qkprep(const Ctx& c, const Args& a, int layer, int widx, int nw) {
    bf16_t* QR = (bf16_t*)(a.ws + WS_QRAW); bf16_t* KV = (bf16_t*)(a.ws + WS_KV); const float* R = (const float*)(a.ws + WS_ROPE);
    const int half = c.lane >> 5, i = c.lane & 31, f = i & 15;
    const int d = i < 16 ? i : 32 + (i - 16);
    for (int it = widx; it < M * 5; it += nw) {
        const int m = it / 5, hh = (it % 5) * 2 + half;
        bf16_t* p = hh < 8 ? QR + (size_t)m * 512 + hh * 64 : KV + (size_t)m * 256 + (hh - 8) * 64;
        const float* gn = hh < 8 ? a.in[I_QNG] + layer * 64 : a.in[I_KNG] + layer * 64;
        const float x1 = bf1(p[d]), x2 = bf1(p[d + 16]);
        float ss = x1 * x1 + x2 * x2;
#pragma unroll
        for (int o = 1; o < 32; o <<= 1) ss += __shfl_xor(ss, o);
        const float rstd = rsqrtf(ss * (1.f / 64.f) + EPS);
        const float y1 = x1 * rstd * gn[d], y2 = x2 * rstd * gn[d + 16];
        const int s = m & (SEQ - 1);
        float cs, sn;
        if (i < 16) { const int pos = s >> 6; cs = R[pos * 16 + f]; sn = R[2048 + pos * 16 + f]; }
        else { const int pos = s & 63; cs = R[4096 + pos * 16 + f]; sn = R[5120 + pos * 16 + f]; }
        float o1 = y1 * cs - y2 * sn, o2 = y2 * cs + y1 * sn;
        if (hh < 8) { o1 *= C2; o2 *= C2; }
        p[d] = (bf16_t)f2bf(o1); p[d + 16] = (bf16_t)f2bf(o2);
    }
}

#include <hip/hip_bf16.h>
#include <cmath>
namespace attn_body {
using bf16=__hip_bfloat16;
using bf16x8=__attribute__((ext_vector_type(8)))short;
using s16x4=__attribute__((ext_vector_type(4)))short;
using f32x16=__attribute__((ext_vector_type(16)))float;
using u32x4=__attribute__((ext_vector_type(4)))unsigned;
constexpr int SEQ=8192,D=64,QPITCH=512,KVPITCH=256,OPITCH=1024;
constexpr int NW=8,QBLK=32,QB=QBLK*NW,KVBLK=64,NQB=SEQ/QB;
__device__ __forceinline__ int crow(int r,int hi){return (r&3)+8*(r>>2)+4*hi;}
#define SBAR() __builtin_amdgcn_sched_barrier(0)
__device__ __forceinline__ void cmask(f32x16&p0,f32x16&p1,int jb,int qrel,int hi){
  const float NEG=-INFINITY; int kb=64*jb+4*hi;
  #pragma unroll
  for(int r=0;r<16;++r){int kv=kb+(r&3)+8*(r>>2); if(kv>qrel)p0[r]=NEG; if(kv+32>qrel)p1[r]=NEG;}
}

constexpr int NSLOT=3, SLOTB=8192;
constexpr int LDS_K=0, LDS_V=NSLOT*SLOTB, LDS_WS=2*NSLOT*SLOTB, LDS_OST=LDS_WS+NW*64*4, LDS_BYTES=LDS_OST+NW*4096;
constexpr float C2=0.125f*1.4426950408889634f;
__device__ __forceinline__ void glds16(const void*gsrc,unsigned lds_dst){unsigned keep;
  asm volatile("s_mov_b32 %0, m0\n\ts_mov_b32 m0, %2\n\ts_nop 0\n\tglobal_load_lds_dwordx4 %1, off\n\ts_mov_b32 m0, %0":"=&s"(keep):"v"(gsrc),"s"(lds_dst):"memory");}
__device__ __forceinline__ float max3f(float a,float b,float c){float r;asm("v_max3_f32 %0, %1, %2, %3":"=v"(r):"v"(a),"v"(b),"v"(c));return r;}
__device__ __forceinline__ float max2f(float a,float b){float r;asm("v_max_f32_e32 %0, %1, %2":"=v"(r):"v"(a),"v"(b));return r;}
__device__ __forceinline__ float fadd_s(float a,float b){float r;asm("v_add_f32_e32 %0, %1, %2":"=v"(r):"v"(a),"v"(b));return r;}
__device__ __forceinline__ float fsub_s(float a,float b){float r;asm("v_sub_f32_e32 %0, %1, %2":"=v"(r):"v"(a),"v"(b));return r;}
typedef float f32x2_t __attribute__((ext_vector_type(2))); typedef __bf16 bf16x2_t __attribute__((ext_vector_type(2)));
__device__ __forceinline__ unsigned cvtpk_s(float lo,float hi){f32x2_t v={lo,hi};bf16x2_t b=__builtin_convertvector(v,bf16x2_t);return __builtin_bit_cast(unsigned,b);}
#define WAIT_BAR(N) asm volatile("s_waitcnt vmcnt(" #N ") lgkmcnt(0)\n\ts_barrier":::"memory")

__device__ __forceinline__ void qkt(f32x16&p0,f32x16&p1,const char*Kslot,const bf16x8*qr,const f32x16&negm,int r32,int hi){
  const char*kb=Kslot+hi*1024+r32*16;
  #pragma unroll
  for(int d0=0;d0<4;++d0){
    const bf16x8 b0=*reinterpret_cast<const bf16x8*>(kb+d0*2048);
    const bf16x8 b1=*reinterpret_cast<const bf16x8*>(kb+d0*2048+512);
    if(d0==0){p0=__builtin_amdgcn_mfma_f32_32x32x16_bf16(b0,qr[0],negm,0,0,0);p1=__builtin_amdgcn_mfma_f32_32x32x16_bf16(b1,qr[0],negm,0,0,0);}
    else{p0=__builtin_amdgcn_mfma_f32_32x32x16_bf16(b0,qr[d0],p0,0,0,0);p1=__builtin_amdgcn_mfma_f32_32x32x16_bf16(b1,qr[d0],p1,0,0,0);}}
}
typedef __attribute__((address_space(3))) const char* lds_cptr;
typedef short v4i16_t __attribute__((ext_vector_type(4)));
__device__ __forceinline__ void kload8(bf16x8*kf,lds_cptr kp){
  kf[0]=*(const __attribute__((address_space(3))) bf16x8*)(kp);      kf[1]=*(const __attribute__((address_space(3))) bf16x8*)(kp+512);
  kf[2]=*(const __attribute__((address_space(3))) bf16x8*)(kp+2048); kf[3]=*(const __attribute__((address_space(3))) bf16x8*)(kp+2560);
  kf[4]=*(const __attribute__((address_space(3))) bf16x8*)(kp+4096); kf[5]=*(const __attribute__((address_space(3))) bf16x8*)(kp+4608);
  kf[6]=*(const __attribute__((address_space(3))) bf16x8*)(kp+6144); kf[7]=*(const __attribute__((address_space(3))) bf16x8*)(kp+6656);
}
__device__ __forceinline__ void kload2(bf16x8*kf,lds_cptr kp,int j){ kf[2*j]=*(const __attribute__((address_space(3))) bf16x8*)(kp+j*2048); kf[2*j+1]=*(const __attribute__((address_space(3))) bf16x8*)(kp+j*2048+512); }
__device__ __forceinline__ s16x4 vtr(lds_cptr p){ return __builtin_bit_cast(s16x4,__builtin_amdgcn_ds_read_tr16_b64_v4i16((__attribute__((address_space(3))) v4i16_t*)p)); }
__device__ __forceinline__ float rowmax(const f32x16&p0,const f32x16&p1){
  float a=max3f(p0[0],p0[1],p1[0]),b=max3f(p0[2],p0[3],p1[1]);a=max3f(a,p1[2],p1[3]);
  #pragma unroll
  for(int r=4;r<16;r+=4){a=max3f(a,p0[r],p0[r+1]);b=max3f(b,p0[r+2],p0[r+3]);a=max3f(a,p1[r],p1[r+1]);b=max3f(b,p1[r+2],p1[r+3]);}
  const float m=max2f(a,b);
  auto rr=__builtin_amdgcn_permlane32_swap(__float_as_uint(m),__float_as_uint(m),false,false);
  return max2f(__uint_as_float(rr[0]),__uint_as_float(rr[1]));
}
__device__ __forceinline__ void pv(f32x16*o,int vb,bf16x8 pa0,bf16x8 pa1,bf16x8 pa2,bf16x8 pa3){
  #pragma unroll
  for(int d0=0;d0<2;++d0){s16x4 lo[4],hi[4];
    #pragma unroll
    for(int ks=0;ks<4;++ks){
      asm volatile("ds_read_b64_tr_b16 %0,%1 offset:%c2":"=&v"(lo[ks]):"v"(vb),"i"(d0*4096+ks*1024):"memory");
      asm volatile("ds_read_b64_tr_b16 %0,%1 offset:%c2":"=&v"(hi[ks]):"v"(vb),"i"(d0*4096+ks*1024+512):"memory");}
    asm volatile("s_waitcnt lgkmcnt(0)":::"memory");SBAR();
    #define PK(k) (bf16x8){lo[k][0],lo[k][1],lo[k][2],lo[k][3],hi[k][0],hi[k][1],hi[k][2],hi[k][3]}
    o[d0]=__builtin_amdgcn_mfma_f32_32x32x16_bf16(pa0,PK(0),o[d0],0,0,0);
    o[d0]=__builtin_amdgcn_mfma_f32_32x32x16_bf16(pa1,PK(1),o[d0],0,0,0);
    o[d0]=__builtin_amdgcn_mfma_f32_32x32x16_bf16(pa2,PK(2),o[d0],0,0,0);
    o[d0]=__builtin_amdgcn_mfma_f32_32x32x16_bf16(pa3,PK(3),o[d0],0,0,0);
    #undef PK
  }
}

#ifndef ATTN_STORE16
#define ATTN_STORE16(p,v) (*(u32x4*)(p)=(v))
#endif
template<int THRL> __device__ __forceinline__ void attn_unit(int b,int h,int qb,const bf16*Q,const bf16*KV,bf16*O,float*SSQA,char*shm,const int tid){
  const int lane=tid&63,r32=lane&31,hi=lane>>5; const int wid=__builtin_amdgcn_readfirstlane(tid>>6);
  const long rowbase=(long)b*SEQ; const int q0=qb*QB;
  const bf16*Qw=Q+(rowbase+q0+wid*QBLK)*QPITCH+h*D;
  const bf16*Kh=KV+rowbase*KVPITCH+(h>>2)*D,*Vh=Kh+128;
  const unsigned lds0=(unsigned)(uintptr_t)shm;
  float*wsf=(float*)(shm+LDS_WS)+wid*64;
  const bf16*ksrc=Kh+(long)lane*KVPITCH+wid*8;
  const bf16*vsrc=Vh+(long)(16*(wid&3)+(lane>>2))*KVPITCH+(wid>>2)*32+(lane&3)*8;
  const unsigned kdst=lds0+LDS_K+wid*1024, vdst=lds0+LDS_V+wid*1024;
  #define DMA_K(t,slot) glds16(ksrc+(long)(t)*KVBLK*KVPITCH,(unsigned)__builtin_amdgcn_readfirstlane(kdst+(slot)))
  #define DMA_V(t,slot) glds16(vsrc+(long)(t)*KVBLK*KVPITCH,(unsigned)__builtin_amdgcn_readfirstlane(vdst+(slot)))
  const int vb0=(int)(lds0+LDS_V)+((lane>>4)&1)*32+(lane&3)*8+(4*hi+((lane&15)>>2))*64;
  const char*Kbase=shm+LDS_K; bf16x8 kf[8];
  const lds_cptr shm3=(lds_cptr)shm; const lds_cptr kp0=shm3+LDS_K+hi*1024+r32*16; const lds_cptr vp0=shm3+LDS_V+((lane>>4)&1)*32+(lane&3)*8+(4*hi+((lane&15)>>2))*64;
  const int NT=SEQ/KVBLK;
  DMA_K(0,0);DMA_V(0,0);DMA_K(1,SLOTB);
  bf16x8 qr[4];
  #pragma unroll
  for(int d0=0;d0<4;++d0)qr[d0]=*reinterpret_cast<const bf16x8*>(&Qw[(long)r32*QPITCH+d0*16+hi*8]);
  float mhat=0.f,l_reg=0.f;f32x16 o[2];f32x16 negm;{float z_=0.f;asm volatile("":"+v"(z_));
  #pragma unroll
  for(int r=0;r<16;++r){o[0][r]=z_;o[1][r]=z_;negm[r]=z_;}}asm volatile("":"+v"(negm));
  #define CMASK(P0,P1,t) do{}while(0)
  bool resc=false;
  #define START(P0,P1) do{ const float rm=rowmax(P0,P1); resc=false; \
    { const float dl=rm; mhat=fadd_s(mhat,dl); \
      _Pragma("unroll") for(int r=0;r<16;++r){P0[r]=fsub_s(P0[r],dl);P1[r]=fsub_s(P1[r],dl);} \
      _Pragma("unroll") for(int r=0;r<16;++r)negm[r]=-mhat; asm volatile("":"+v"(negm)); } \
    _Pragma("unroll") for(int r=0;r<16;++r)P0[r]=__builtin_amdgcn_exp2f(P0[r]); }while(0)
  #define RESC() do{ if(resc){ asm volatile("s_waitcnt lgkmcnt(0)":::"memory"); \
      _Pragma("unroll") for(int d_=0;d_<2;++d_) _Pragma("unroll") for(int r=0;r<16;++r)o[d_][r]*=wsf[crow(r,hi)]; } }while(0)
  f32x16 pA0,pA1,pB0,pB1;
  int sl_prev=0,sl_cur=0,sl_next=SLOTB;
  #define ROT() do{sl_prev=sl_cur;sl_cur=sl_next;sl_next=(sl_next==(NSLOT-1)*SLOTB)?0:sl_next+SLOTB;}while(0)
  DMA_K(2,2*SLOTB);
  WAIT_BAR(3);
  qkt(pA0,pA1,Kbase,qr,negm,r32,hi);asm volatile("s_nop 15\n\ts_nop 7":"+v"(pA0),"+v"(pA1));CMASK(pA0,pA1,0);
  START(pA0,pA1);
  _Pragma("unroll") for(int r=0;r<16;++r)pA1[r]=__builtin_amdgcn_exp2f(pA1[r]);
  WAIT_BAR(0);
  DMA_K(3,0);DMA_V(1,SLOTB);
  ROT();
  kload8(kf,kp0+sl_cur);
  WAIT_BAR(2);
  s16x4 vlo[8],vhi[8]; u32x4 pw0,pw1,pw2,pw3;
  #define PKW(P,B) cvtpk_s(P[B],P[B+1])
  #define PAF(k) __builtin_bit_cast(bf16x8,pw##k)
  #define VFR(i) (bf16x8){vlo[i][0],vlo[i][1],vlo[i][2],vlo[i][3],vhi[i][0],vhi[i][1],vhi[i][2],vhi[i][3]}
  #define PIN(x) asm volatile("":"+v"(x))
  #define MX3(a,b,c) __builtin_fmaxf(__builtin_fmaxf((a),(b)),(c))
  #define GAPA(MF,A0,A1,A2,A3,W0,W1,PW) do{ MF; sacc+=A0; sacc+=A1; sacc+=A2; sacc+=A3; PIN(sacc); W0; W1; PIN(PW); SBAR(); }while(0)
  #define EX(v) __builtin_amdgcn_exp2f(v)
  #define GAPB(MF,X,B) do{ MF; X[B]=EX(X[B]); X[B+1]=EX(X[B+1]); X[B+2]=EX(X[B+2]); X[B+3]=EX(X[B+3]); PIN(X); SBAR(); }while(0)
  #define VRD(i) do{ vlo[i]=vtr(vp_+(((i)>>2)*4096+((i)&3)*1024)); vhi[i]=vtr(vp_+(((i)>>2)*4096+((i)&3)*1024+512)); }while(0)
  #define KRD(G,j) do{ if(G){ kload2(kf,kp0+sl_next,j); SBAR(); } }while(0)
  #define STEP(C0,C1,P0,P1,t,GK,GV,GL) do{ SBAR(); \
    const lds_cptr vp_=vp0+sl_prev; \
    VRD(0); SBAR(); float sacc=(P0[0]+P0[1]); \
    GAPA(C0=__builtin_amdgcn_mfma_f32_32x32x16_bf16(kf[0],qr[0],negm,0,0,0), P0[2],P0[3],P0[4],P0[5],     pw0[0]=PKW(P0,0), pw0[1]=PKW(P0,2), pw0); \
    VRD(4); SBAR(); GAPA(C1=__builtin_amdgcn_mfma_f32_32x32x16_bf16(kf[1],qr[0],negm,0,0,0), P0[6],P0[7],P0[8],P0[9],     pw0[2]=PKW(P0,4), pw0[3]=PKW(P0,6), pw0); \
    VRD(1); SBAR(); GAPA(C0=__builtin_amdgcn_mfma_f32_32x32x16_bf16(kf[2],qr[1],C0,0,0,0),   P0[10],P0[11],P0[12],P0[13], pw1[0]=PKW(P0,8), pw1[1]=PKW(P0,10), pw1); \
    VRD(5); SBAR(); GAPA(C1=__builtin_amdgcn_mfma_f32_32x32x16_bf16(kf[3],qr[1],C1,0,0,0),   P0[14],P0[15],P1[0],P1[1],   pw1[2]=PKW(P0,12),pw1[3]=PKW(P0,14), pw1); \
    VRD(2); SBAR(); GAPA(C0=__builtin_amdgcn_mfma_f32_32x32x16_bf16(kf[4],qr[2],C0,0,0,0),   P1[2],P1[3],P1[4],P1[5],     pw2[0]=PKW(P1,0), pw2[1]=PKW(P1,2), pw2); \
    VRD(6); SBAR(); GAPA(C1=__builtin_amdgcn_mfma_f32_32x32x16_bf16(kf[5],qr[2],C1,0,0,0),   P1[6],P1[7],P1[8],P1[9],     pw2[2]=PKW(P1,4), pw2[3]=PKW(P1,6), pw2); \
    VRD(3); SBAR(); GAPA(C0=__builtin_amdgcn_mfma_f32_32x32x16_bf16(kf[6],qr[3],C0,0,0,0),   P1[10],P1[11],P1[12],P1[13], pw3[0]=PKW(P1,8), pw3[1]=PKW(P1,10), pw3); \
    VRD(7); SBAR(); GAPA(C1=__builtin_amdgcn_mfma_f32_32x32x16_bf16(kf[7],qr[3],C1,0,0,0),   P1[14],P1[15],0.f,0.f,       pw3[2]=PKW(P1,12),pw3[3]=PKW(P1,14), pw3); \
    l_reg+=sacc; \
    if(GK){DMA_K((t)+3,sl_cur);} if(GV){DMA_V((t)+1,sl_next);} \
    CMASK(C0,C1,t); \
    { float a=MX3(C0[0],C0[1],C1[0]),b=MX3(C0[2],C0[3],C1[1]); a=MX3(a,C1[2],C1[3]); \
      _Pragma("unroll") for(int r=4;r<16;r+=4){a=MX3(a,C0[r],C0[r+1]);b=MX3(b,C0[r+2],C0[r+3]);a=MX3(a,C1[r],C1[r+1]);b=MX3(b,C1[r+2],C1[r+3]);} \
      float rm=__builtin_fmaxf(a,b); { auto rr=__builtin_amdgcn_permlane32_swap(__float_as_uint(rm),__float_as_uint(rm),false,false); rm=__builtin_fmaxf(__uint_as_float(rr[0]),__uint_as_float(rr[1])); } \
      resc=false; \
      if(__builtin_expect(__any(rm>(float)THRL),0)){ const float dl=__builtin_fmaxf(rm,0.f); mhat+=dl; \
        _Pragma("unroll") for(int r=0;r<16;++r){C0[r]-=dl;C1[r]-=dl;} \
        _Pragma("unroll") for(int r=0;r<16;++r)negm[r]=-mhat; asm volatile("":"+v"(negm)); \
        const float f=__builtin_amdgcn_exp2f(-dl); l_reg*=f; if(hi==0)wsf[r32]=f; resc=true; } } \
    SBAR(); \
    GAPB(o[0]=__builtin_amdgcn_mfma_f32_32x32x16_bf16(PAF(0),VFR(0),o[0],0,0,0), C0,0); \
    GAPB(o[1]=__builtin_amdgcn_mfma_f32_32x32x16_bf16(PAF(0),VFR(4),o[1],0,0,0), C0,4); \
    KRD(GL,0); GAPB(o[0]=__builtin_amdgcn_mfma_f32_32x32x16_bf16(PAF(1),VFR(1),o[0],0,0,0), C0,8); \
    KRD(GL,1); GAPB(o[1]=__builtin_amdgcn_mfma_f32_32x32x16_bf16(PAF(1),VFR(5),o[1],0,0,0), C0,12); \
    KRD(GL,2); GAPB(o[0]=__builtin_amdgcn_mfma_f32_32x32x16_bf16(PAF(2),VFR(2),o[0],0,0,0), C1,0); \
    KRD(GL,3); GAPB(o[1]=__builtin_amdgcn_mfma_f32_32x32x16_bf16(PAF(2),VFR(6),o[1],0,0,0), C1,4); \
    GAPB(o[0]=__builtin_amdgcn_mfma_f32_32x32x16_bf16(PAF(3),VFR(3),o[0],0,0,0), C1,8); \
    GAPB(o[1]=__builtin_amdgcn_mfma_f32_32x32x16_bf16(PAF(3),VFR(7),o[1],0,0,0), C1,12); \
    }while(0)
  int t=1;
  #undef CMASK
  #define CMASK(P0,P1,t) do{}while(0)
  for(;t+5<NT;t+=2){
    STEP(pB0,pB1,pA0,pA1,t,true,true,true);     WAIT_BAR(2); RESC(); ROT();
    STEP(pA0,pA1,pB0,pB1,t+1,true,true,true);   WAIT_BAR(2); RESC(); ROT();
  }
  #undef CMASK
  #define CMASK(P0,P1,t) do{}while(0)
  #define ENDW(tt) do{ if((tt)+3<NT){WAIT_BAR(2);} else if((tt)+2<NT){WAIT_BAR(1);} else {WAIT_BAR(0);} }while(0)
  for(;t+1<NT;t+=2){
    STEP(pB0,pB1,pA0,pA1,t,(t+3<NT),(t+1<NT),(t+1<NT));       ENDW(t);   RESC(); ROT();
    STEP(pA0,pA1,pB0,pB1,t+1,(t+4<NT),(t+2<NT),(t+2<NT));     ENDW(t+1); RESC(); ROT();
  }
  STEP(pB0,pB1,pA0,pA1,NT-1,false,false,false); RESC();
  { float sacc=pB0[0]+pB0[1]; _Pragma("unroll") for(int r=2;r<16;++r)sacc+=pB0[r]; _Pragma("unroll") for(int r=0;r<16;++r)sacc+=pB1[r]; l_reg+=sacc;
    pw0=(u32x4){PKW(pB0,0),PKW(pB0,2),PKW(pB0,4),PKW(pB0,6)};pw1=(u32x4){PKW(pB0,8),PKW(pB0,10),PKW(pB0,12),PKW(pB0,14)};pw2=(u32x4){PKW(pB1,0),PKW(pB1,2),PKW(pB1,4),PKW(pB1,6)};pw3=(u32x4){PKW(pB1,8),PKW(pB1,10),PKW(pB1,12),PKW(pB1,14)};
    SBAR(); pv(o,vb0+sl_cur,PAF(0),PAF(1),PAF(2),PAF(3)); }
  #undef PKW
  #undef PAF
  #undef VFR
  #undef PIN
  #undef MX3
  #undef GAPA
  #undef GAPB
  #undef EX
  #undef VRD
  #undef KRD
  #undef STEP
  #undef ENDW
  {auto rr=__builtin_amdgcn_permlane32_swap(__float_as_uint(l_reg),__float_as_uint(l_reg),false,false);l_reg=__uint_as_float(rr[0])+__uint_as_float(rr[1]);}
  if(hi==0)wsf[32+r32]=l_reg;asm volatile("s_waitcnt lgkmcnt(0)":::"memory");
  float rli[16];
  #pragma unroll
  for(int r=0;r<16;++r)rli[r]=__builtin_amdgcn_rcpf(wsf[32+crow(r,hi)]);
  bf16*Ow=O+(rowbase+q0+wid*QBLK)*OPITCH+512+h*D; float*Sw=SSQA+(rowbase+q0+wid*QBLK)*16+h;
  { bf16*stg=(bf16*)(shm+LDS_OST)+wid*2048;
    #pragma unroll
    for(int r=0;r<16;++r){const int orow=crow(r,hi);
      #pragma unroll
      for(int d0=0;d0<2;++d0)stg[orow*64+d0*32+r32]=__float2bfloat16(o[d0][r]*rli[r]);}
    asm volatile("s_waitcnt lgkmcnt(0)":::"memory");
    #pragma unroll
    for(int i=0;i<4;++i){const int row=i*8+(lane>>3),ch=lane&7; const u32x4 v=*(const u32x4*)(stg+row*64+ch*8); ATTN_STORE16(Ow+(long)row*OPITCH+ch*8,v);
      float ss=0.f; for(int e=0;e<4;++e){const float lo_=__uint_as_float(v[e]<<16),hi_=__uint_as_float(v[e]&0xffff0000u); ss+=lo_*lo_+hi_*hi_;}
      ss+=__shfl_xor(ss,1); ss+=__shfl_xor(ss,2); ss+=__shfl_xor(ss,4); if(ch==0)Sw[(long)row*16]=ss; } }
  asm volatile("s_waitcnt lgkmcnt(0)\n\ts_barrier":::"memory");
  #undef DMA_K
  #undef DMA_V
  #undef CMASK
  #undef START
  #undef RESC
  #undef ROT
}
constexpr int ATTN_LDS_BYTES=LDS_BYTES;
#undef SBAR
#undef WAIT_BAR
}

#ifdef ATT_NAIVE
__device__ __forceinline__ void attn_naive_unit(const Ctx& c, const Args& a, int b, int h, int qblk) {
    const bf16_t* QR = (const bf16_t*)(a.ws + WS_QRAW); const bf16_t* KV = (const bf16_t*)(a.ws + WS_KV);
    bf16_t* Y = (bf16_t*)(a.ws + WS_Y); float* SSQA = (float*)(a.ws + WS_SSQA);
    float* Ks = (float*)c.lds; float* Vs = Ks + 64 * 64;
    const long row = (long)b * SEQ + qblk * 512 + c.tid; const int kvh = h >> 2;
    float q[64], o[64];
#pragma unroll
    for (int v = 0; v < 8; ++v) { const u32x4 w = *(const u32x4*)(QR + row * 512 + h * 64 + v * 8);
        q[v * 8 + 0] = bflo(w.x); q[v * 8 + 1] = bfhi(w.x); q[v * 8 + 2] = bflo(w.y); q[v * 8 + 3] = bfhi(w.y);
        q[v * 8 + 4] = bflo(w.z); q[v * 8 + 5] = bfhi(w.z); q[v * 8 + 6] = bflo(w.w); q[v * 8 + 7] = bfhi(w.w); }
#pragma unroll
    for (int dd = 0; dd < 64; ++dd) o[dd] = 0.f;
    float mrun = -1e30f, l = 0.f;
    const int lk = c.tid >> 3, lp = c.tid & 7;
    for (int t0 = 0; t0 < SEQ; t0 += 64) {
        __syncthreads();
        { const bf16_t* kp = KV + ((long)b * SEQ + t0 + lk) * 256 + kvh * 64 + lp * 8;
          const u32x4 kw = *(const u32x4*)kp, vw = *(const u32x4*)(kp + 128);
          float* kd = Ks + lk * 64 + lp * 8; float* vd = Vs + lk * 64 + lp * 8;
          kd[0] = bflo(kw.x); kd[1] = bfhi(kw.x); kd[2] = bflo(kw.y); kd[3] = bfhi(kw.y); kd[4] = bflo(kw.z); kd[5] = bfhi(kw.z); kd[6] = bflo(kw.w); kd[7] = bfhi(kw.w);
          vd[0] = bflo(vw.x); vd[1] = bfhi(vw.x); vd[2] = bflo(vw.y); vd[3] = bfhi(vw.y); vd[4] = bflo(vw.z); vd[5] = bfhi(vw.z); vd[6] = bflo(vw.w); vd[7] = bfhi(vw.w); }
        __syncthreads();
#pragma unroll 1
        for (int j = 0; j < 64; ++j) {
            float acc = 0.f; const float* kr = Ks + j * 64;
#pragma unroll
            for (int dd = 0; dd < 64; dd += 4) { const f32x4 kk = *(const f32x4*)(kr + dd); acc += q[dd] * kk[0] + q[dd + 1] * kk[1] + q[dd + 2] * kk[2] + q[dd + 3] * kk[3];
                if ((dd & 15) == 12) __builtin_amdgcn_sched_barrier(0); }
            if (acc > mrun) { const float sc = exp2f(mrun - acc); l *= sc; mrun = acc;
#pragma unroll
                for (int dd = 0; dd < 64; ++dd) o[dd] *= sc; }
            const float p = exp2f(acc - mrun); l += p; const float* vr = Vs + j * 64;
#pragma unroll
            for (int dd = 0; dd < 64; dd += 4) { const f32x4 vv = *(const f32x4*)(vr + dd); o[dd] += p * vv[0]; o[dd + 1] += p * vv[1]; o[dd + 2] += p * vv[2]; o[dd + 3] += p * vv[3];
                if ((dd & 15) == 12) __builtin_amdgcn_sched_barrier(0); }
        }
    }
    const float il = 1.f / l; float ss = 0.f;
#pragma unroll
    for (int v = 0; v < 8; ++v) { float t[8];
#pragma unroll
        for (int e = 0; e < 8; ++e) { t[e] = o[v * 8 + e] * il; ss += t[e] * t[e]; }
        u32x4 w; w.x = pk2(t[0], t[1]); w.y = pk2(t[2], t[3]); w.z = pk2(t[4], t[5]); w.w = pk2(t[6], t[7]);
        *(u32x4*)(Y + row * 1024 + 512 + h * 64 + v * 8) = w; }
    SSQA[row * 16 + h] = ss;
    __syncthreads();
}

#endif
template <int NV> __device__ __forceinline__ float top16(float (&v)[NV], int lane) {
    float res = -INFINITY;
    for (int it = 0; it < 16; ++it) {
        float m = v[0];
#pragma unroll
        for (int i = 1; i < NV; ++i) m = fmaxf(m, v[i]);
        m = wave_max(m);
#pragma unroll
        for (int i = 0; i < NV; ++i) if (v[i] == m) v[i] = -INFINITY;
        if (lane == it) res = m;
    }
    return res;
}
__device__ __forceinline__ float dot8(const u32x4 a, const u32x4 b) {
    return bflo(a.x) * bflo(b.x) + bfhi(a.x) * bfhi(b.x) + bflo(a.y) * bflo(b.y) + bfhi(a.y) * bfhi(b.y)
         + bflo(a.z) * bflo(b.z) + bfhi(a.z) * bfhi(b.z) + bflo(a.w) * bflo(b.w) + bfhi(a.w) * bfhi(b.w);
}
__device__ __forceinline__ void peer_topk(const Ctx& c, const Args& a, int layer, int widx, int nw) {
    const bf16_t* QP = (const bf16_t*)(a.ws + WS_QP);
    const bf16_t* SK1 = (const bf16_t*)(a.ws + WS_LW + (size_t)layer * LW_STRIDE + LW_SK1);
    const bf16_t* SK2 = (const bf16_t*)(a.ws + WS_LW + (size_t)layer * LW_STRIDE + LW_SK2);
    int* SELI = (int*)(a.ws + WS_SELI); float* SELW = (float*)(a.ws + WS_SELW);
    const int lane = c.lane;
    for (int it = widx; it < M * 8; it += nw) {
        const int t = it >> 3, h = it & 7;
        const bf16_t* qrow = QP + (size_t)t * 2048 + h * 256;
        const bf16_t* k1a = SK1 + ((size_t)(h * 128 + lane)) * 128; const bf16_t* k1b = k1a + 64 * 128;
        const bf16_t* k2a = SK2 + ((size_t)(h * 128 + lane)) * 128; const bf16_t* k2b = k2a + 64 * 128;
        float s1[2] = {0.f, 0.f}, s2[2] = {0.f, 0.f};
#pragma unroll 4
        for (int kk = 0; kk < 128; kk += 8) {
            const u32x4 q1 = *(const u32x4*)(qrow + kk), q2 = *(const u32x4*)(qrow + 128 + kk);
            s1[0] += dot8(q1, *(const u32x4*)(k1a + kk)); s1[1] += dot8(q1, *(const u32x4*)(k1b + kk));
            s2[0] += dot8(q2, *(const u32x4*)(k2a + kk)); s2[1] += dot8(q2, *(const u32x4*)(k2b + kk));
        }
        s1[0] = __uint_as_float((__float_as_uint(s1[0]) & ~127u) | (unsigned)lane); s1[1] = __uint_as_float((__float_as_uint(s1[1]) & ~127u) | (unsigned)(lane + 64));
        s2[0] = __uint_as_float((__float_as_uint(s2[0]) & ~127u) | (unsigned)lane); s2[1] = __uint_as_float((__float_as_uint(s2[1]) & ~127u) | (unsigned)(lane + 64));
        const float v1 = top16<2>(s1, lane), v2 = top16<2>(s2, lane);
        float cand[4];
#pragma unroll
        for (int mm = 0; mm < 4; ++mm) {
            const float va = __shfl(v1, (lane >> 4) + 4 * mm), vb = __shfl(v2, lane & 15);
            const unsigned ua = __float_as_uint(va), ub = __float_as_uint(vb);
            const float sum = __uint_as_float(ua & ~127u) + __uint_as_float(ub & ~127u);
            cand[mm] = __uint_as_float((__float_as_uint(sum) & ~16383u) | ((ua & 127u) << 7) | (ub & 127u));
        }
        const float best = top16<4>(cand, lane);
        const unsigned ub = __float_as_uint(best);
        const float sc = __uint_as_float(ub & ~16383u);
        const float mx = __shfl(sc, 0);
        const float e = lane < 16 ? __expf(sc - mx) : 0.f;
        const float sum = wave_sum(e);
        if (lane < 16) { SELI[(size_t)t * 128 + h * 16 + lane] = (int)(ub & 16383u); SELW[(size_t)t * 128 + h * 16 + lane] = e / sum; }
    }
}

__device__ __forceinline__ void peer_gather(const Ctx& c, const Args& a, int layer, int widx, int nw) {
    float* XR = a.out; bf16_t* XN2 = (bf16_t*)(a.ws + WS_XN2);
    const bf16_t* EU = (const bf16_t*)(a.ws + WS_EU) + (size_t)layer * 16384 * 1024;
    const bf16_t* EV = (const bf16_t*)(a.ws + WS_EV) + (size_t)layer * 16384 * 1024;
    const int* SELI = (const int*)(a.ws + WS_SELI); const float* SELW = (const float*)(a.ws + WS_SELW);
    const float* gf = a.in[I_NFFNG] + layer * D; const float* gp = a.in[I_NPLEG] + layer * D;
    const int lane = c.lane;
    for (int t = widx; t < M; t += nw) {
        float x[16], hh[16], acc[16];
        float* xr = XR + (size_t)t * D + 8 * lane;
        float ss = 0.f;
#pragma unroll
        for (int j = 0; j < 2; ++j) { const f32x4 u0 = *(const f32x4*)(xr + 512 * j), u1 = *(const f32x4*)(xr + 512 * j + 4);
#pragma unroll
            for (int e = 0; e < 4; ++e) { x[8 * j + e] = u0[e]; x[8 * j + 4 + e] = u1[e]; } }
#pragma unroll
        for (int e = 0; e < 16; ++e) { ss += x[e] * x[e]; acc[e] = 0.f; }
        ss = wave_sum(ss);
        const float rstd = rsqrtf(ss * (1.f / D) + EPS);
#pragma unroll
        for (int j = 0; j < 2; ++j)
#pragma unroll
            for (int e = 0; e < 8; ++e) hh[8 * j + e] = x[8 * j + e] * rstd * gf[512 * j + 8 * lane + e];
        const int idxA = SELI[(size_t)t * 128 + lane], idxB = SELI[(size_t)t * 128 + 64 + lane];
        const float wA = SELW[(size_t)t * 128 + lane], wB = SELW[(size_t)t * 128 + 64 + lane];
#pragma unroll 1
        for (int hf = 0; hf < 2; ++hf) {
            const int idxv = hf ? idxB : idxA; const float wv = hf ? wB : wA;
#pragma unroll 1
            for (int k0 = 0; k0 < 64; k0 += 4) {
                u32x4 ur[4][2], vr[4][2]; float w[4];
#pragma unroll
                for (int r = 0; r < 4; ++r) {
                    const int e = __builtin_amdgcn_readlane(idxv, k0 + r); w[r] = __uint_as_float(__builtin_amdgcn_readlane(__float_as_uint(wv), k0 + r));
                    const bf16_t* up = EU + (size_t)e * D + 8 * lane; const bf16_t* vp = EV + (size_t)e * D + 8 * lane;
                    ur[r][0] = *(const u32x4*)up; ur[r][1] = *(const u32x4*)(up + 512); vr[r][0] = *(const u32x4*)vp; vr[r][1] = *(const u32x4*)(vp + 512);
                }
#pragma unroll
                for (int r = 0; r < 4; ++r) {
                    float d = 0.f;
#pragma unroll
                    for (int j = 0; j < 2; ++j) { const u32x4 uw = ur[r][j];
                        d += hh[8 * j + 0] * bflo(uw.x) + hh[8 * j + 1] * bfhi(uw.x) + hh[8 * j + 2] * bflo(uw.y) + hh[8 * j + 3] * bfhi(uw.y)
                           + hh[8 * j + 4] * bflo(uw.z) + hh[8 * j + 5] * bfhi(uw.z) + hh[8 * j + 6] * bflo(uw.w) + hh[8 * j + 7] * bfhi(uw.w); }
                    d = wave_sum(d);
                    const float av = gelu_tanh(d) * w[r];
#pragma unroll
                    for (int j = 0; j < 2; ++j) { const u32x4 vw = vr[r][j];
                        acc[8 * j + 0] += av * bflo(vw.x); acc[8 * j + 1] += av * bfhi(vw.x); acc[8 * j + 2] += av * bflo(vw.y); acc[8 * j + 3] += av * bfhi(vw.y);
                        acc[8 * j + 4] += av * bflo(vw.z); acc[8 * j + 5] += av * bfhi(vw.z); acc[8 * j + 6] += av * bflo(vw.w); acc[8 * j + 7] += av * bfhi(vw.w); }
                }
            }
        }
        float s2 = 0.f;
#pragma unroll
        for (int e = 0; e < 16; ++e) { x[e] += acc[e]; s2 += x[e] * x[e]; }
        s2 = wave_sum(s2);
        const float rstd2 = rsqrtf(s2 * (1.f / D) + EPS);
#pragma unroll
        for (int j = 0; j < 2; ++j) {
            *(f32x4*)(xr + 512 * j) = (f32x4){x[8 * j + 0], x[8 * j + 1], x[8 * j + 2], x[8 * j + 3]};
            *(f32x4*)(xr + 512 * j + 4) = (f32x4){x[8 * j + 4], x[8 * j + 5], x[8 * j + 6], x[8 * j + 7]};
            float y[8];
#pragma unroll
            for (int e = 0; e < 8; ++e) y[e] = x[8 * j + e] * rstd2 * gp[512 * j + 8 * lane + e];
            u32x4 o; o.x = pk2(y[0], y[1]); o.y = pk2(y[2], y[3]); o.z = pk2(y[4], y[5]); o.w = pk2(y[6], y[7]);
            *(u32x4*)(XN2 + (size_t)t * D + 512 * j + 8 * lane) = o;
        }
    }
}

__device__ __forceinline__ void final_norm(const Ctx& c, const Args& a, int widx, int nw) {
    const float* gfin = a.in[I_FING];
    for (int m = widx; m < M; m += nw) {
        f32x4* xr = (f32x4*)(a.out + (size_t)m * D) + c.lane; f32x4 v[4]; float s = 0.f;
#pragma unroll
        for (int j = 0; j < 4; ++j) { v[j] = xr[64 * j]; s += v[j][0] * v[j][0] + v[j][1] * v[j][1] + v[j][2] * v[j][2] + v[j][3] * v[j][3]; }
        s = wave_sum(s); const float rstd = rsqrtf(s * (1.f / D) + EPS);
#pragma unroll
        for (int j = 0; j < 4; ++j) { const f32x4 gg = *((const f32x4*)gfin + 64 * j + c.lane); xr[64 * j] = v[j] * rstd * gg; }
    }
}

__global__ void __launch_bounds__(512, 2) mk_fwd(Args a) {
    extern __shared__ __attribute__((aligned(16))) unsigned char lds[];
    Ctx c0; c0.tid = threadIdx.x; c0.lane = c0.tid & 63; c0.wave = __builtin_amdgcn_readfirstlane(c0.tid >> 6); c0.blk = blockIdx.x; c0.nblk = gridDim.x; c0.lds = lds;
    const Ctx& c = c0;
    volatile LAS unsigned* MISC = (volatile LAS unsigned*)((LAS unsigned char*)lds + MISC_OFF);
    for (int u = c.tid; u < (LDS_BYTES - LDSCTL_OFF) / 4; u += 512) ((LAS unsigned*)((LAS unsigned char*)lds + LDSCTL_OFF))[u] = 0u;
    __syncthreads();
    const bool multi = (a.ph_hi - a.ph_lo) > 1;
    XcdBarrier bar; bar.bar = (unsigned*)(a.ws + WS_CTL) + CW_BAR; bar.x = 0; bar.st = nullptr;
    if (multi) bar = xcd_barrier_post((unsigned*)(a.ws + WS_CTL) + CW_BAR, MISC + 8);
    const int gw = c.blk * 8 + c.wave, NGW = c.nblk * 8;

#define IN(k) (lo <= (k) && (k) < hi)
#define FRESH() Ctx c = c0; { int t_ = c0.tid; asm volatile("" : "+v"(t_)); c.tid = t_; c.lane = t_ & 63; int w_ = c0.wave; asm volatile("" : "+s"(w_)); c.wave = w_; }
#define SEAM(k) do { if (IN(k) && IN((k) + 1)) xcd_barrier(bar); } while (0)
    const int lo = a.ph_lo, hi = a.ph_hi;
    if (IN(0)) {
        FRESH();
        p0_prologue(c, a);
    }
    SEAM(0);
#pragma unroll 1
    for (int layer = 0; layer < 2; ++layer) {
        const int pb = 1 + 9 * layer;
        unsigned char* lw = a.ws + WS_LW + (size_t)layer * LW_STRIDE;
        if (IN(pb + 0)) {
            FRESH();
            GemmD g; g.A = (const bf16_t*)(a.ws + WS_XB); g.lda = D; g.Bt = (const bf16_t*)(lw + LW_WIN); g.ldb = D; g.K = D; g.kmid = -1;
            EpiInproj E; E.ssq0 = (const float*)(a.ws + WS_SSQ0); E.ucat = (bf16_t*)(a.ws + WS_UCAT); E.qraw = (bf16_t*)(a.ws + WS_QRAW); E.kv = (bf16_t*)(a.ws + WS_KV);
            gemm_phase_dense(c, g, M / 256, DIN / 256, E);
        }
        SEAM(pb + 0);
        if (IN(pb + 1)) {
            FRESH();
            if (c.nblk > 64) {
                if (c.blk < 64) s1_unit(c, a, layer, c.blk);
                else qkprep(c, a, layer, (c.blk - 64) * 8 + c.wave, (c.nblk - 64) * 8);
            } else {
                for (int u = c.blk; u < 64; u += c.nblk) s1_unit(c, a, layer, u);
                qkprep(c, a, layer, gw, NGW);
            }
        }
        SEAM(pb + 1);
        if (IN(pb + 2)) {
            FRESH();
            GemmD g; g.A = (const bf16_t*)(a.ws + WS_UCAT); g.lda = KCAT; g.Bt = (const bf16_t*)(lw + LW_WY); g.ldb = KCAT; g.K = KCAT; g.kmid = -1;
            EpiS2 E; E.G = (bf16_t*)(a.ws + WS_G);
#ifdef USE_SGEMM
            for (int ui = c.blk; ui < 128; ui += c.nblk) { Unit u; u.pm = ui >> 1; u.pn = (ui >> 2) * 2 + (ui & 1); sgemm_unit(g, u, E, c.wave, c.lane); }
#else
            { pg8::S2Order S; S.blk = c.blk; S.nblk = c.nblk; run_gemm(c.lds, g, S, E, c.tid); }
#endif
#ifdef ATT_NAIVE
            for (int ui = c.blk; ui < 256; ui += c.nblk) attn_naive_unit(c, a, ui >> 7, (ui >> 4) & 7, ui & 15);
#else
            for (int ui = c.blk; ui < 512; ui += c.nblk) {
                int ab, ah, aq;
                if (c.nblk == 256) { const int bl = ui & 255, vcu = (bl & 7) * 32 + (bl >> 3), combo = (ui >> 8) * 2 + (vcu >> 7), w = vcu & 127; ab = combo >> 1; ah = (combo & 1) * 4 + (w >> 5); aq = w & 31; }
                else { ab = ui >> 8; ah = (ui >> 5) & 7; aq = ui & 31; }
                attn_body::attn_unit<8>(ab, ah, aq, (const attn_body::bf16*)(a.ws + WS_QRAW), (const attn_body::bf16*)(a.ws + WS_KV), (attn_body::bf16*)(a.ws + WS_Y), (float*)(a.ws + WS_SSQA), (char*)lds, c.tid);
            }
#endif
        }
        SEAM(pb + 2);
        if (IN(pb + 3)) {
            FRESH();
            GemmD g; g.A = (const bf16_t*)(a.ws + WS_G); g.lda = 512; g.Bt = (const bf16_t*)(lw + LW_WGLU); g.ldb = 512; g.K = 512; g.kmid = -1;
            EpiGlu E; E.G = (const bf16_t*)(a.ws + WS_G); E.bglu = a.in[I_BGLU] + layer * 512; E.Y = (bf16_t*)(a.ws + WS_Y); E.ssqs = (float*)(a.ws + WS_SSQS);
            gemm_phase_dense(c, g, M / 256, 2, E);
        }
        SEAM(pb + 3);
        if (IN(pb + 4)) {
            FRESH();
            GemmD g; g.A = (const bf16_t*)(a.ws + WS_Y); g.lda = D; g.Bt = (const bf16_t*)(lw + LW_WOUT); g.ldb = D; g.K = D; g.kmid = 512;
            float* RS = (float*)(a.ws + WS_RS);
            { const float* ssqs = (const float*)(a.ws + WS_SSQS); const float* ssqa = (const float*)(a.ws + WS_SSQA);
              pg8::StaticOrder S0; S0.init(M, D, c.nblk, c.blk); Unit u0;
              for (int i = 0; S0.next(i, u0); ++i) if (c.tid < 256) { const int row = u0.pm * 256 + c.tid;
                  const float s = rsqrtf(sumn(ssqs + (long)row * 16, 8) * (1.f / 512.f) + EPS), t = rsqrtf(sumn(ssqa + (long)row * 16, 8) * (1.f / 512.f) + EPS);
                  RS[(long)row * 2] = s / t; RS[(long)row * 2 + 1] = t; }
              VM_WAIT(); __syncthreads(); }
            EpiOut E; E.rs = RS; E.xin = layer == 0 ? a.in[I_X] : a.out; E.xres = a.out;
            E.xb = (bf16_t*)(a.ws + WS_XB); E.ssq1 = (float*)(a.ws + WS_SSQ1);
            gemm_phase_dense(c, g, M / 256, 4, E);
        }
        SEAM(pb + 4);
        if (IN(pb + 5)) {
            FRESH();
            GemmD g; g.A = (const bf16_t*)(a.ws + WS_XB); g.lda = D; g.Bt = (const bf16_t*)(lw + LW_WQ); g.ldb = D; g.K = D; g.kmid = -1;
            EpiQ E; E.ssq1 = (const float*)(a.ws + WS_SSQ1); E.qp = (bf16_t*)(a.ws + WS_QP);
            gemm_phase_dense(c, g, M / 256, 8, E);
        }
        SEAM(pb + 5);
        if (IN(pb + 6)) {
            FRESH();
#ifndef SKIP_TOPK
            peer_topk(c, a, layer, gw, NGW);
#endif
        }
        SEAM(pb + 6);
        if (IN(pb + 7)) {
            FRESH();
#ifndef SKIP_GATHER
            peer_gather(c, a, layer, gw, NGW);
#endif
        }
        SEAM(pb + 7);
        if (IN(pb + 8)) {
            FRESH();
            GemmD g1; g1.A = (const bf16_t*)(a.ws + WS_PB) + (size_t)layer * M * 256; g1.lda = 256; g1.Bt = (const bf16_t*)(lw + LW_WPROJ); g1.ldb = 256; g1.K = 256; g1.kmid = -1;
            EpiProj E1; E1.pr = (float*)(a.ws + WS_QP);
            gemm_phase_dense(c, g1, M / 256, 4, E1);
            VM_WAIT(); __syncthreads();
            GemmD g2; g2.A = (const bf16_t*)(a.ws + WS_XN2); g2.lda = D; g2.Bt = (const bf16_t*)(lw + LW_WGATE); g2.ldb = D; g2.K = D; g2.kmid = -1;
            EpiGate E2; E2.pr = (const float*)(a.ws + WS_QP); E2.xres = a.out; E2.xb = (bf16_t*)(a.ws + WS_XB); E2.ssq0 = (float*)(a.ws + WS_SSQ0);
            gemm_phase_dense(c, g2, M / 256, 4, E2);
        }
        SEAM(pb + 8);
    }
    if (IN(NPHASE - 1)) { FRESH(); final_norm(c, a, gw, NGW); }
#undef IN
#undef SEAM
}

extern "C" void kernel_launch(void* const* d_in, const int* in_sizes, int n_in, void* d_out, int out_size, void* d_ws, size_t ws_size, hipStream_t stream) {
    static int grid = 0;
    if (grid == 0) {
        if (n_in != 29 || in_sizes[0] != M * D || out_size != M * D || in_sizes[3] != 2 * D * DIN || ws_size < WS_END) {
            fprintf(stderr, "kernel_launch: unexpected problem: n_in %d in0 %d in3 %d out %d ws %zu (need %zu); nothing launched\n", n_in, n_in > 0 ? in_sizes[0] : -1, n_in > 3 ? in_sizes[3] : -1, out_size, ws_size, (size_t)WS_END);
            grid = -1; return; }
        int dev = 0, cus = 0, per_cu = 0;
        if (hipGetDevice(&dev) != hipSuccess || hipDeviceGetAttribute(&cus, hipDeviceAttributeMultiprocessorCount, dev) != hipSuccess) { grid = -1; return; }
        if (hipFuncSetAttribute((const void*)mk_fwd, hipFuncAttributeMaxDynamicSharedMemorySize, LDS_BYTES) != hipSuccess) { fprintf(stderr, "kernel_launch: hipFuncSetAttribute failed\n"); grid = -1; return; }
        if (hipOccupancyMaxActiveBlocksPerMultiprocessor(&per_cu, (const void*)mk_fwd, 512, LDS_BYTES) != hipSuccess || per_cu < 1)
            fprintf(stderr, "kernel_launch: note: occupancy query reports %d workgroups per CU\n", per_cu);
        (void)hipGetLastError();
        grid = cus;
    }
    if (grid < 0) return;
    (void)hipMemsetAsync((char*)d_ws + WS_CTL, 0, CTL_ZERO_BYTES, stream);
    Args a{};
    for (int i = 0; i < 29; ++i) a.in[i] = (const float*)d_in[i];
    a.out = (float*)d_out; a.ws = (unsigned char*)d_ws;
    constexpr int NL = MK_N_LAUNCHES;
    for (int li = 0; li < NL; ++li) {
        a.ph_lo = (NPHASE * li) / NL; a.ph_hi = (NPHASE * (li + 1)) / NL;
        hipLaunchKernelGGL(mk_fwd, dim3(grid), dim3(512), LDS_BYTES, stream, a);
    }
}
```

```cpp
#include <hip/hip_runtime.h>
#include <cstdio>
#include <cstdint>

#ifndef ATT_THRL
#define ATT_THRL -1
#endif
#ifndef MK_N_LAUNCHES
#define MK_N_LAUNCHES 1
#endif

#define LAS __attribute__((address_space(3)))
typedef unsigned short bf16_t;
typedef short bf16x8 __attribute__((ext_vector_type(8)));
typedef float f32x4 __attribute__((ext_vector_type(4)));
typedef unsigned u32x4 __attribute__((ext_vector_type(4)));
typedef unsigned u32x2 __attribute__((ext_vector_type(2)));

constexpr int NB = 2, SEQ = 8192, M = NB * SEQ, D = 1024, DIN = 1280;
constexpr int NG = 32, LCH = 32, NCH = SEQ / LCH, KCAT = 768;
constexpr float EPS = 1e-6f;
constexpr float C2 = 0.125f * 1.4426950408889634f;
constexpr int NPHASE = 24;

constexpr size_t MiB = 1u << 20;
constexpr size_t WS_CTL = 0, CTL_ZERO_BYTES = 64 * 1024;
constexpr size_t WS_EU = 1 * MiB, WS_EV = 65 * MiB;
constexpr size_t WS_ESC = 241 * MiB + 256 * 1024;
constexpr size_t WS_LW = 129 * MiB, LW_STRIDE = 48 * MiB;
constexpr size_t LW_WIN = 0, LW_WGLU = 3 * MiB, LW_WOUT = 4 * MiB, LW_WQ = 6 * MiB, LW_SK1 = 10 * MiB, LW_SK2 = 10 * MiB + 512 * 1024,
                 LW_WGATE = 11 * MiB, LW_WPROJ = 13 * MiB, LW_AL = 13 * MiB + 512 * 1024, LW_WE = 14 * MiB, LW_WY = 22 * MiB;
constexpr size_t WS_PB = 225 * MiB, WS_ROPE = 241 * MiB, WS_XB = 242 * MiB, WS_UCAT = 274 * MiB, WS_QRAW = 300 * MiB, WS_KV = 316 * MiB,
                 WS_EBUF = 324 * MiB, WS_G = 340 * MiB, WS_Y = 356 * MiB, WS_SSQS = 388 * MiB, WS_SSQA = 389 * MiB, WS_SSQ0 = 390 * MiB, WS_SSQ1 = 391 * MiB, WS_RS = 241 * MiB + 512 * 1024, WS_PRB = 33 * MiB  ,
                 WS_QP = 392 * MiB  , WS_SELI = 456 * MiB, WS_SELW = 464 * MiB, WS_XN2 = 472 * MiB, WS_AOUT = 472 * MiB  , WS_XB2 = 480 * MiB  , WS_END = 512 * MiB;
constexpr int CW_BAR = 4096;

constexpr int RING_BYTES = 131072, LDSCTL_OFF = RING_BYTES, MISC_OFF = LDSCTL_OFF + 320, LDS_BYTES = 147456;

__device__ __forceinline__ unsigned f2bf(float f) { unsigned u = __float_as_uint(f); return (u + 0x7fffu + ((u >> 16) & 1u)) >> 16; }
__device__ __forceinline__ unsigned pk2(float lo, float hi) { return f2bf(lo) | (f2bf(hi) << 16); }
__device__ __forceinline__ float bflo(unsigned w) { return __uint_as_float(w << 16); }
__device__ __forceinline__ float bfhi(unsigned w) { return __uint_as_float(w & 0xffff0000u); }
__device__ __forceinline__ float bf1(bf16_t h) { return __uint_as_float((unsigned)h << 16); }
__device__ __forceinline__ float wave_sum(float v) {
#pragma unroll
    for (int o = 1; o < 64; o <<= 1) v += __shfl_xor(v, o);
    return v;
}
__device__ __forceinline__ float wave_max(float v) {
#pragma unroll
    for (int o = 1; o < 64; o <<= 1) v = fmaxf(v, __shfl_xor(v, o));
    return v;
}
__device__ __forceinline__ float sigmoidf_(float x) { return 1.f / (1.f + __expf(-x)); }
__device__ __forceinline__ float gelu_tanh(float x) {
    const float z = 0.7978845608028654f * (x + 0.044715f * x * x * x);
    const float e = __expf(2.f * z);
    const float th = 1.f - 2.f / (e + 1.f);
    return 0.5f * x * (1.f + th);
}
__device__ __forceinline__ float sumn(const float* p, int n) { float s = 0.f; for (int i = 0; i < n; ++i) s += p[i]; return s; }
#define LDS_WAIT() asm volatile("s_waitcnt lgkmcnt(0)" ::: "memory")
#define VM_WAIT() asm volatile("s_waitcnt vmcnt(0)" ::: "memory")

#define XB_TMO      128
#define XB_XCNT(j)  (256  + 64 * (j))
#define XB_XSUB(j)  (1280 + 64 * (j))
#define XB_XGEN(j)  (2304 + 64 * (j))
#define XB_TOP      3328
#define XB_TOPGEN   3392
#define XCD_BAR_WORDS 3456
#define XB_SPIN_CAP (1u << 18)
__device__ __forceinline__ unsigned xb_ld(unsigned* p)              { return __hip_atomic_load(p, __ATOMIC_RELAXED, __HIP_MEMORY_SCOPE_AGENT); }
__device__ __forceinline__ unsigned xb_add(unsigned* p, unsigned v) { return __hip_atomic_fetch_add(p, v, __ATOMIC_RELAXED, __HIP_MEMORY_SCOPE_AGENT); }
__device__ __forceinline__ unsigned xb_xcc_id() { return (unsigned)__builtin_amdgcn_s_getreg((3 << 11) | 20) & 0xFu; }
#define XB_SPIN(cond, bar) do { unsigned _sp = 0; while (cond) { __builtin_amdgcn_s_sleep(1); \
    if ((++_sp & 255u) == 0u) { if (xb_ld(&(bar)[XB_TMO])) break; if (_sp > XB_SPIN_CAP) { atomicAdd(&(bar)[XB_TMO], 1u); break; } } } } while (0)
struct XcdBarrier { unsigned* bar; unsigned x; volatile LAS unsigned* st; };
__device__ __forceinline__ XcdBarrier xcd_barrier_post(unsigned* bar, volatile LAS unsigned* st) {
    XcdBarrier b; b.bar = bar; b.x = xb_xcc_id(); b.st = st;
    if (threadIdx.x == 0) (void)xb_add(&bar[XB_XCNT(b.x)], 1u);
    return b;
}
__device__ __forceinline__ void xcd_barrier_complete(unsigned* bar, unsigned x, unsigned& nloc, unsigned& nx) {
    const unsigned G = gridDim.x * gridDim.y * gridDim.z;
    unsigned sum, cnt, mine, sp = 0u;
    for (;;) {
        sum = 0u; cnt = 0u; mine = 0u;
#pragma unroll
        for (unsigned j = 0; j < 16; ++j) { const unsigned c = xb_ld(&bar[XB_XCNT(j)]); sum += c; cnt += (c > 0u) ? 1u : 0u; mine = (j == x) ? c : mine; }
        if (sum == G) break;
        __builtin_amdgcn_s_sleep(1);
        if ((++sp & 255u) == 0u) { if (xb_ld(&bar[XB_TMO])) break; if (sp > XB_SPIN_CAP) { atomicAdd(&bar[XB_TMO], 1u); break; } }
    }
    nloc = mine > 0u ? mine : 1u; nx = cnt > 0u ? cnt : 1u;
}
__device__ __forceinline__ void xcd_barrier(const XcdBarrier& b) {
    asm volatile("s_waitcnt vmcnt(0)" ::: "memory");
    __syncthreads();
    if (threadIdx.x == 0) {
        unsigned* bar = b.bar;
        __builtin_amdgcn_s_waitcnt(0);
        unsigned nloc = b.st[0], nx = b.st[1];
        if (nloc == 0u) { xcd_barrier_complete(bar, b.x, nloc, nx); b.st[0] = nloc; b.st[1] = nx; }
        const unsigned old = xb_add(&bar[XB_XSUB(b.x)], 1u);
        const unsigned gen = old / nloc;
        if (old + 1u == (gen + 1u) * nloc) {
            __builtin_amdgcn_fence(__ATOMIC_RELEASE, "agent");
            asm volatile("s_waitcnt vmcnt(0)" ::: "memory");
            const unsigned og = xb_add(&bar[XB_TOP], 1u);
            const unsigned tg = og / nx;
            if (og + 1u == (tg + 1u) * nx) xb_add(&bar[XB_TOPGEN], 1u);
            else XB_SPIN(xb_ld(&bar[XB_TOPGEN]) == tg, bar);
            __builtin_amdgcn_fence(__ATOMIC_ACQUIRE, "agent");
            xb_add(&bar[XB_XGEN(b.x)], 1u);
            asm volatile("s_waitcnt vmcnt(0)" ::: "memory");
        } else {
            XB_SPIN(xb_ld(&bar[XB_XGEN(b.x)]) == gen, bar);
            __builtin_amdgcn_fence(__ATOMIC_ACQUIRE, "agent");
            asm volatile("s_waitcnt vmcnt(0)" ::: "memory");
        }
    }
    __syncthreads();
}

#ifdef PROBE_RGN
#define RGN(n, e) do { if ((n) == PROBE_RGN && blockIdx.x == PROBE_BLK && threadIdx.x == 0) { asm volatile("s_waitcnt vmcnt(0) lgkmcnt(0)" ::: "memory"); ((unsigned long long*)(rgn_ws + 48 * 1024))[e] = __builtin_amdgcn_s_memrealtime(); } } while (0)
#else
#define RGN(n, e) do {} while (0)
#endif
struct Args { const float* in[29]; float* out; unsigned char* ws; int ph_lo, ph_hi; };
enum { I_X = 0, I_P, I_NMIXG, I_WIN, I_LRE, I_LIM, I_LOGDT, I_BRE, I_BIM, I_CRE, I_CIM, I_DSKIP, I_WGLU, I_BGLU, I_QNG, I_KNG, I_SSMG, I_ATTG, I_WOUT,
       I_NFFNG, I_WQ, I_SK1, I_SK2, I_EU, I_EV, I_NPLEG, I_WGATE, I_WPROJ, I_FING };

struct Ctx { int tid, lane, wave, blk, nblk; unsigned char* lds; };

struct GemmD { const bf16_t* A; long lda; const bf16_t* Bt; long ldb; int K; int kmid; };
struct Unit { int pm, pn; };

template <class Epi>
__device__ __forceinline__ void sgemm_unit(const GemmD& g, const Unit u, const Epi& E, int wave, int lane) {
    const int i = lane & 15, q = lane >> 4;
    const bf16_t* Ab = g.A + (long)(u.pm * 256 + wave * 32) * g.lda;
    const bf16_t* Bb = g.Bt + (long)(u.pn * 256) * g.ldb;
    const int row0 = u.pm * 256 + wave * 32 + i;
    float ssq[2] = {0.f, 0.f};
    float rs[2] = {1.f, 1.f};
    if constexpr (Epi::ROWSCALE) { rs[0] = E.rscale(row0); rs[1] = E.rscale(row0 + 16); }
    for (int cg = 0; cg < 4; ++cg) {
        f32x4 acc[2][4];
#pragma unroll
        for (int mi = 0; mi < 2; ++mi)
#pragma unroll
            for (int ni = 0; ni < 4; ++ni) acc[mi][ni] = (f32x4){0.f, 0.f, 0.f, 0.f};
        for (int k0 = 0; k0 < g.K; k0 += 32) {
            if constexpr (Epi::MID) { if (k0 == g.kmid) {
#pragma unroll
                for (int mi = 0; mi < 2; ++mi) { const float f = E.mid(row0 + 16 * mi);
#pragma unroll
                    for (int ni = 0; ni < 4; ++ni) acc[mi][ni] *= f; } } }
            bf16x8 a[2], b[4];
#pragma unroll
            for (int mi = 0; mi < 2; ++mi) a[mi] = *(const bf16x8*)(Ab + (long)(16 * mi + i) * g.lda + k0 + 8 * q);
#pragma unroll
            for (int ni = 0; ni < 4; ++ni) b[ni] = *(const bf16x8*)(Bb + (long)(cg * 64 + 16 * ni + i) * g.ldb + k0 + 8 * q);
#pragma unroll
            for (int mi = 0; mi < 2; ++mi)
#pragma unroll
                for (int ni = 0; ni < 4; ++ni) acc[mi][ni] = __builtin_amdgcn_mfma_f32_16x16x32_bf16(b[ni], a[mi], acc[mi][ni], 0, 0, 0);
        }
#pragma unroll
        for (int mi = 0; mi < 2; ++mi)
#pragma unroll
            for (int ni = 0; ni < 4; ++ni) {
                const f32x4 v = acc[mi][ni] * rs[mi];
                const f32x4 w = E.put(row0 + 16 * mi, u.pn * 256 + cg * 64 + 16 * ni + 4 * q, v);
                ssq[mi] += w[0] * w[0] + w[1] * w[1] + w[2] * w[2] + w[3] * w[3];
            }
    }
    if constexpr (Epi::SSQ) {
#pragma unroll
        for (int mi = 0; mi < 2; ++mi) { float s = ssq[mi]; s += __shfl_xor(s, 16); s += __shfl_xor(s, 32);
            if (q == 0) { E.ssq(row0 + 16 * mi, u.pn * 4 + 0, s); E.ssq(row0 + 16 * mi, u.pn * 4 + 1, 0.f); E.ssq(row0 + 16 * mi, u.pn * 4 + 2, 0.f); E.ssq(row0 + 16 * mi, u.pn * 4 + 3, 0.f); } }
    }
}

__device__ __forceinline__ u32x2 pack4(f32x4 v) { u32x2 w; w.x = pk2(v[0], v[1]); w.y = pk2(v[2], v[3]); return w; }
__device__ __forceinline__ u32x4 pack8(f32x4 a, f32x4 b) { u32x4 w; w.x = pk2(a[0], a[1]); w.y = pk2(a[2], a[3]); w.z = pk2(b[0], b[1]); w.w = pk2(b[2], b[3]); return w; }
__device__ __forceinline__ void unpack8(u32x4 w, f32x4& a, f32x4& b) { a = (f32x4){bflo(w.x), bfhi(w.x), bflo(w.y), bfhi(w.y)}; b = (f32x4){bflo(w.z), bfhi(w.z), bflo(w.w), bfhi(w.w)}; }

struct EpiInproj {
    static constexpr bool MID = false, ROWSCALE = true, SSQ = false;
    const float* ssq0; bf16_t* ucat; bf16_t* qraw; bf16_t* kv;
    __device__ __forceinline__ float rscale(int row) const { return rsqrtf(sumn(ssq0 + (long)row * 16, 16) * (1.f / D) + EPS); }
    __device__ __forceinline__ f32x4 put(int row, int col, f32x4 v) const {
        const u32x2 w = pack4(v);
        if (col < 512) { const int g = col >> 4, qq = col & 15, b = row >> 13, s = row & (SEQ - 1), c = s >> 5, j = s & 31;
            *(u32x2*)(ucat + ((long)((g * 2 + b) * NCH + c) * KCAT + j * 16 + qq)) = w; }
        else if (col < 1024) *(u32x2*)(qraw + (long)row * 512 + (col - 512)) = w;
        else *(u32x2*)(kv + (long)row * 256 + (col - 1024)) = w;
        return v;
    }
    __device__ __forceinline__ void put8(int row, int col, f32x4 v0, f32x4 v1, f32x4& w0, f32x4& w1) const {
        const u32x4 w = pack8(v0, v1); w0 = v0; w1 = v1;
        if (col < 512) { const int g = col >> 4, qq = col & 15, b = row >> 13, s = row & (SEQ - 1), c = s >> 5, j = s & 31;
            *(u32x4*)(ucat + ((long)((g * 2 + b) * NCH + c) * KCAT + j * 16 + qq)) = w; }
        else if (col < 1024) *(u32x4*)(qraw + (long)row * 512 + (col - 512)) = w;
        else *(u32x4*)(kv + (long)row * 256 + (col - 1024)) = w;
    }
    __device__ __forceinline__ void ssq(int, int, float) const {}
};
struct EpiS1 {
    static constexpr bool MID = false, ROWSCALE = false, SSQ = false;
    float* ebuf;
    __device__ __forceinline__ f32x4 put(int row, int col, f32x4 v) const { *(f32x4*)(ebuf + ((long)row * 256 + (col & 255))) = v; return v; }
    __device__ __forceinline__ void put8(int row, int col, f32x4 v0, f32x4 v1, f32x4& w0, f32x4& w1) const { float* p = ebuf + ((long)row * 256 + (col & 255)); *(f32x4*)p = v0; *(f32x4*)(p + 4) = v1; w0 = v0; w1 = v1; }
    __device__ __forceinline__ void ssq(int, int, float) const {}
};
struct EpiS2 {
    static constexpr bool MID = false, ROWSCALE = false, SSQ = false;
    bf16_t* G;
    __device__ __forceinline__ f32x4 put(int row, int col, f32x4 v) const {
        const int pm = row >> 8, c = row & 255, g = pm >> 1, b = pm & 1, nout = col & 511, j = nout >> 4, p = nout & 15;
        const long tok = (long)b * SEQ + c * LCH + j;
        f32x4 y; y[0] = gelu_tanh(v[0]); y[1] = gelu_tanh(v[1]); y[2] = gelu_tanh(v[2]); y[3] = gelu_tanh(v[3]);
        *(u32x2*)(G + tok * 512 + 16 * g + p) = pack4(y); return v;
    }
    __device__ __forceinline__ void put8(int row, int col, f32x4 v0, f32x4 v1, f32x4& w0, f32x4& w1) const {
        const int pm = row >> 8, c = row & 255, g = pm >> 1, b = pm & 1, nout = col & 511, j = nout >> 4, p = nout & 15;
        const long tok = (long)b * SEQ + c * LCH + j;
        f32x4 y0, y1;
#pragma unroll
        for (int e = 0; e < 4; ++e) { y0[e] = gelu_tanh(v0[e]); y1[e] = gelu_tanh(v1[e]); }
        *(u32x4*)(G + tok * 512 + 16 * g + p) = pack8(y0, y1); w0 = v0; w1 = v1;
    }
    __device__ __forceinline__ void ssq(int, int, float) const {}
};
struct EpiGlu {
    static constexpr bool MID = false, ROWSCALE = false, SSQ = true;
    const bf16_t* G; const float* bglu; bf16_t* Y; float* ssqs;
    __device__ __forceinline__ f32x4 put(int row, int col, f32x4 v) const {
        const u32x2 gw = *(const u32x2*)(G + (long)row * 512 + col);
        const f32x4 bb = *(const f32x4*)(bglu + col);
        f32x4 ys; ys[0] = bflo(gw.x) * sigmoidf_(v[0] + bb[0]); ys[1] = bfhi(gw.x) * sigmoidf_(v[1] + bb[1]);
        ys[2] = bflo(gw.y) * sigmoidf_(v[2] + bb[2]); ys[3] = bfhi(gw.y) * sigmoidf_(v[3] + bb[3]);
        *(u32x2*)(Y + (long)row * 1024 + col) = pack4(ys); return ys;
    }
    __device__ __forceinline__ void put8(int row, int col, f32x4 v0, f32x4 v1, f32x4& w0, f32x4& w1) const {
        f32x4 g0, g1; unpack8(*(const u32x4*)(G + (long)row * 512 + col), g0, g1);
        const f32x4 b0 = *(const f32x4*)(bglu + col), b1 = *(const f32x4*)(bglu + col + 4);
#pragma unroll
        for (int e = 0; e < 4; ++e) { w0[e] = g0[e] * sigmoidf_(v0[e] + b0[e]); w1[e] = g1[e] * sigmoidf_(v1[e] + b1[e]); }
        *(u32x4*)(Y + (long)row * 1024 + col) = pack8(w0, w1);
    }
    __device__ __forceinline__ void ssq(int row, int slot, float s) const { ssqs[(long)row * 16 + slot] = s; }
};
struct EpiOut {
    static constexpr bool MID = true, ROWSCALE = true, SSQ = true;
    const float* rs; bf16_t* xb; float* ssq1;
    __device__ __forceinline__ float mid(int row) const { return rs[(long)row * 2]; }
    __device__ __forceinline__ float rscale(int row) const { return rs[(long)row * 2 + 1]; }
    __device__ __forceinline__ f32x4 put(int row, int col, f32x4 v) const {
        const long o = (long)row * D + col; const u32x2 xw = *(const u32x2*)(xb + o); const f32x4 x1 = (f32x4){bflo(xw.x), bfhi(xw.x), bflo(xw.y), bfhi(xw.y)} + v;
        const u32x2 ow = pack4(x1); *(u32x2*)(xb + o) = ow; return (f32x4){bflo(ow.x), bfhi(ow.x), bflo(ow.y), bfhi(ow.y)};
    }
    __device__ __forceinline__ void put8(int row, int col, f32x4 v0, f32x4 v1, f32x4& w0, f32x4& w1) const {
        const long o = (long)row * D + col; f32x4 x0, x1; unpack8(*(const u32x4*)(xb + o), x0, x1);
        const u32x4 ow = pack8(x0 + v0, x1 + v1); *(u32x4*)(xb + o) = ow; unpack8(ow, w0, w1);
    }
    __device__ __forceinline__ void ssq(int row, int slot, float s) const { ssq1[(long)row * 16 + slot] = s; }
};
struct EpiQ {
    static constexpr bool MID = false, ROWSCALE = true, SSQ = false;
    const float* ssq1; bf16_t* qp;
    __device__ __forceinline__ float rscale(int row) const { return rsqrtf(sumn(ssq1 + (long)row * 16, 16) * (1.f / D) + EPS); }
    __device__ __forceinline__ f32x4 put(int row, int col, f32x4 v) const { *(u32x2*)(qp + (long)row * 2048 + col) = pack4(v); return v; }
    __device__ __forceinline__ void put8(int row, int col, f32x4 v0, f32x4 v1, f32x4& w0, f32x4& w1) const { *(u32x4*)(qp + (long)row * 2048 + col) = pack8(v0, v1); w0 = v0; w1 = v1; }
    __device__ __forceinline__ void ssq(int, int, float) const {}
};
struct EpiProj {
    static constexpr bool MID = false, ROWSCALE = false, SSQ = false;
    bf16_t* pr;
    __device__ __forceinline__ f32x4 put(int row, int col, f32x4 v) const { *(u32x2*)(pr + (long)row * D + col) = pack4(v); return v; }
    __device__ __forceinline__ void put8(int row, int col, f32x4 v0, f32x4 v1, f32x4& w0, f32x4& w1) const { *(u32x4*)(pr + (long)row * D + col) = pack8(v0, v1); w0 = v0; w1 = v1; }
    __device__ __forceinline__ void ssq(int, int, float) const {}
};
struct EpiGate {
    static constexpr bool MID = false, ROWSCALE = true, SSQ = true;
    const bf16_t* pr; const bf16_t* xin; bf16_t* xout; float* ssq0; const float* ssq2;
    __device__ __forceinline__ float rscale(int row) const { return rsqrtf(sumn(ssq2 + (long)row * 16, 8) * (1.f / D) + EPS); }
    __device__ __forceinline__ f32x4 put(int row, int col, f32x4 v) const {
        const long o = (long)row * D + col; const u32x2 pw = *(const u32x2*)(pr + o); const f32x4 pv = (f32x4){bflo(pw.x), bfhi(pw.x), bflo(pw.y), bfhi(pw.y)}; const u32x2 xw = *(const u32x2*)(xin + o); f32x4 x3 = (f32x4){bflo(xw.x), bfhi(xw.x), bflo(xw.y), bfhi(xw.y)};
        x3[0] += sigmoidf_(v[0]) * pv[0]; x3[1] += sigmoidf_(v[1]) * pv[1]; x3[2] += sigmoidf_(v[2]) * pv[2]; x3[3] += sigmoidf_(v[3]) * pv[3];
        const u32x2 ow = pack4(x3); *(u32x2*)(xout + o) = ow; return (f32x4){bflo(ow.x), bfhi(ow.x), bflo(ow.y), bfhi(ow.y)};
    }
    __device__ __forceinline__ void put8(int row, int col, f32x4 v0, f32x4 v1, f32x4& w0, f32x4& w1) const {
        const long o = (long)row * D + col; f32x4 p0, p1, x0, x1; unpack8(*(const u32x4*)(pr + o), p0, p1); unpack8(*(const u32x4*)(xin + o), x0, x1);
#pragma unroll
        for (int e = 0; e < 4; ++e) { x0[e] += sigmoidf_(v0[e]) * p0[e]; x1[e] += sigmoidf_(v1[e]) * p1[e]; }
        const u32x4 ow = pack8(x0, x1); *(u32x4*)(xout + o) = ow; unpack8(ow, w0, w1);
    }
    __device__ __forceinline__ void ssq(int row, int slot, float s) const { ssq0[(long)row * 16 + slot] = s; }
};


namespace pg8 {
#define PG8_LAS __attribute__((address_space(3)))
constexpr int BM = 256, BK = 64, HALF = 128, HTB = HALF * BK * 2, STAGE_BYTES = 8 * HTB, NXCD = 8, WGM = 8;
__host__ __device__ __forceinline__ int lds_byte(int r, int c) { const int st = (r >> 4) * 2 + (c >> 5), rr = r & 15, cc = c & 31, ob = rr * 64 + cc * 2; return st * 1024 + (ob ^ (((ob >> 9) & 1) << 5)); }
__host__ __device__ __forceinline__ void stage_rc(int b, int& R, int& C) { const int st = b / 1024, sb = b % 1024, swz = sb ^ (((sb >> 9) & 1) << 5); R = (st >> 1) * 16 + swz / 64; C = (st & 1) * 32 + (swz % 64) / 2; }
__host__ __device__ __forceinline__ int perm32(int rho) { const int n = rho >> 4, i = rho & 15; return 8 * (i >> 2) + 4 * n + (i & 3); }
using ::Unit;
struct Gemm { const bf16_t* A; const bf16_t* Bt; int K, lda, ldb, kmid; };
struct StaticOrder {
    int nM, nN, nwg, G, c;
    __host__ __device__ __forceinline__ void init(int M_, int N_, int G_, int c_) { nM = M_ / BM; nN = N_ / BM; nwg = nM * nN; G = G_; c = c_; }
    __host__ __device__ __forceinline__ bool next(int i, Unit& u) const {
        const long L = (long)i * G + c; if (L >= nwg) return false;
        int wgid = (int)L; { const int q = nwg / NXCD, r = nwg % NXCD, xcd = wgid % NXCD, off = wgid / NXCD; wgid = (xcd < r ? xcd * (q + 1) : r * (q + 1) + (xcd - r) * q) + off; }
        const int nig = WGM * nN, gid = wgid / nig, fm = gid * WGM, gsz = (nM - fm) < WGM ? (nM - fm) : WGM;
        u.pm = fm + ((wgid % nig) % gsz); u.pn = (wgid % nig) / gsz; return true;
    }
    __device__ __forceinline__ void a_ready(const Unit&) const {}
    __device__ __forceinline__ void done(const Unit&) const {}
};
struct OneUnit { Unit u;
    __device__ __forceinline__ bool next(int i, Unit& o) const { if (i) return false; o = u; return true; }
    __device__ __forceinline__ void a_ready(const Unit&) const {}
    __device__ __forceinline__ void done(const Unit&) const {} };
struct S2Order { int blk, nblk;
    __device__ __forceinline__ bool next(int i, Unit& o) const { const int ui = blk + i * nblk; if (ui >= 128) return false; o.pm = ui >> 1; o.pn = (ui >> 2) * 2 + (ui & 1); return true; }
    __device__ __forceinline__ void a_ready(const Unit&) const {}
    __device__ __forceinline__ void done(const Unit&) const {} };
template <class F> struct Epi {
    static constexpr bool PERM = true, AFTER_DRAIN = false, MID = F::MID;
    F f;
    __device__ __forceinline__ void operator()(const f32x4 (&acc)[2][2][4][2], const Unit& u, int wr, int wc, int fr, int fq) const {
        asm volatile("" : "+v"(fr), "+v"(fq));
        const int rowb = u.pm * BM + wr * 64 + fr, colb = u.pn * BM + wc * 32 + 8 * fq;
#pragma unroll
        for (int ai = 0; ai < 2; ++ai)
#pragma unroll
            for (int m = 0; m < 4; ++m) {
                const int row = rowb + ai * HALF + m * 16; float rs = 1.f; if constexpr (F::ROWSCALE) rs = f.rscale(row);
                float ss = 0.f;
#pragma unroll
                for (int bj = 0; bj < 2; ++bj) { f32x4 w0, w1; f.put8(row, colb + bj * HALF, acc[ai][bj][m][0] * rs, acc[ai][bj][m][1] * rs, w0, w1);
                    ss += (w0[0] * w0[0] + w0[1] * w0[1] + w0[2] * w0[2] + w0[3] * w0[3]) + (w1[0] * w1[0] + w1[1] * w1[1] + w1[2] * w1[2] + w1[3] * w1[3]); }
                if constexpr (F::SSQ) { ss += __shfl_xor(ss, 16); ss += __shfl_xor(ss, 32); if (fq == 0) f.ssq(row, u.pn * 4 + wc, ss); }
                asm volatile("" ::: "memory");
            }
    }
    __device__ __forceinline__ void midscale(f32x4 (&acc)[2][2][4][2], const Unit& u, int wr, int wc, int fr, int fq) const {
        if constexpr (F::MID) {
            asm volatile("" : "+v"(fr));
            const int rowb = u.pm * BM + wr * 64 + fr;
#pragma unroll
            for (int ai = 0; ai < 2; ++ai)
#pragma unroll
                for (int m = 0; m < 4; ++m) { const float s = f.mid(rowb + ai * HALF + m * 16);
#pragma unroll
                    for (int bj = 0; bj < 2; ++bj)
#pragma unroll
                        for (int n = 0; n < 2; ++n) acc[ai][bj][m][n] *= s; }
        }
    }
};
template <class Epi, class Sched, bool ALIGN_EPI = false, bool SP2 = false>
__device__ __forceinline__ void gemm_phase(PG8_LAS unsigned char* lds, const Gemm g, const Sched& S, const Epi& E, const int tid) {
    const int wid = __builtin_amdgcn_readfirstlane(tid >> 6), lane = tid & 63, wr = wid >> 2, wc = wid & 3, fr = lane & 15, fq = lane >> 4;
    const int K = g.K, nt = K / BK;
    unsigned voffA[2], voffB[2];
#pragma unroll
    for (int i = 0; i < 2; ++i) { int R, C; stage_rc(tid * 16 + i * 8192, R, C); const int Rb = Epi::PERM ? ((R & ~31) + perm32(R & 31)) : R;
        voffA[i] = (unsigned)(R * g.lda + C) * 2u; voffB[i] = (unsigned)(Rb * g.ldb + C) * 2u; }
    const size_t kstep = (size_t)(BK * 2);
    const size_t hstepA = (size_t)HALF * g.lda * 2, hstepB = (size_t)HALF * g.ldb * 2;
    const size_t tstepA = 2 * hstepA, tstepB = 2 * hstepB;
    const unsigned ldsw = (unsigned)wid * 1024u;
    const int aoff = lds_byte(wr * 64 + fr, fq * 8), boff = lds_byte(wc * 32 + fr, fq * 8);
#define PG8_SA(b, h) (((b) * 2 + (h)) * HTB)
#define PG8_SB(b, h) ((4 + (b) * 2 + (h)) * HTB)
#define PG8_STAGE(bufoff, gbase, voff) do { _Pragma("unroll") for (int _i = 0; _i < 2; ++_i) \
        __builtin_amdgcn_global_load_lds((const unsigned*)((const char*)(gbase) + (voff)[_i]), (PG8_LAS unsigned*)(lds + (bufoff) + ldsw + _i * 8192), 16, 0, 0); } while (0)
#define PG8_LDA(dst, b, h) do { _Pragma("unroll") for (int m = 0; m < 4; ++m) _Pragma("unroll") for (int k = 0; k < 2; ++k) dst[m][k] = *(const PG8_LAS bf16x8*)(lds + PG8_SA(b, h) + aoff + m * 2048 + k * 1024); } while (0)
#define PG8_LDB(dst, b, h) do { _Pragma("unroll") for (int n = 0; n < 2; ++n) _Pragma("unroll") for (int k = 0; k < 2; ++k) dst[n][k] = *(const PG8_LAS bf16x8*)(lds + PG8_SB(b, h) + boff + n * 2048 + k * 1024); } while (0)
#define PG8_MMA(ai, bj, At, Bt) do { __builtin_amdgcn_s_setprio(1); _Pragma("unroll") for (int m = 0; m < 4; ++m) _Pragma("unroll") for (int n = 0; n < 2; ++n) _Pragma("unroll") for (int k = 0; k < 2; ++k) \
        acc[ai][bj][m][n] = __builtin_amdgcn_mfma_f32_16x16x32_bf16(Bt[n][k], At[m][k], acc[ai][bj][m][n], 0, 0, 0); __builtin_amdgcn_s_setprio(0); } while (0)
#define PG8_WAIT_V(n) asm volatile("s_waitcnt vmcnt(" #n ")" ::: "memory")
#define PG8_WAIT_L(n) asm volatile("s_waitcnt lgkmcnt(" #n ")" ::: "memory")
#define PG8_BAR __builtin_amdgcn_s_barrier()
#define PG8_SCHED __builtin_amdgcn_sched_barrier(0)
    Unit cur, nxt; int ui = 0;
    if (!S.next(0, cur)) return;
    f32x4 acc[2][2][4][2];
#pragma unroll
    for (int a = 0; a < 2; ++a)
#pragma unroll
        for (int b = 0; b < 2; ++b)
#pragma unroll
            for (int m = 0; m < 4; ++m)
#pragma unroll
                for (int n = 0; n < 2; ++n) acc[a][b][m][n] = (f32x4){0.f, 0.f, 0.f, 0.f};
    bf16x8 At[4][2], B0[2][2], B1[2][2];
    const char* cA = (const char*)g.A + (size_t)cur.pm * tstepA; const char* cB = (const char*)g.Bt + (size_t)cur.pn * tstepB;
    S.a_ready(cur);
    if constexpr (SP2) {
        PG8_STAGE(PG8_SB(0, 0), cB, voffB); PG8_STAGE(PG8_SB(0, 1), cB + hstepB, voffB); PG8_STAGE(PG8_SA(0, 0), cA, voffA); PG8_STAGE(PG8_SA(0, 1), cA + hstepA, voffA);
        if (wr == 1) PG8_BAR;
        PG8_WAIT_V(2); PG8_BAR;
        PG8_STAGE(PG8_SB(1, 0), cB + kstep, voffB); PG8_STAGE(PG8_SA(1, 0), cA + kstep, voffA); PG8_STAGE(PG8_SB(1, 1), cB + hstepB + kstep, voffB);
        PG8_WAIT_V(6); PG8_BAR;
    } else {
        PG8_STAGE(PG8_SB(0, 0), cB, voffB); PG8_STAGE(PG8_SA(0, 0), cA, voffA); PG8_STAGE(PG8_SB(0, 1), cB + hstepB, voffB); PG8_STAGE(PG8_SA(0, 1), cA + hstepA, voffA);
        if (wr == 1) PG8_BAR;
        PG8_WAIT_V(4); PG8_BAR;
        PG8_STAGE(PG8_SB(1, 0), cB + kstep, voffB); PG8_STAGE(PG8_SA(1, 0), cA + kstep, voffA); PG8_STAGE(PG8_SB(1, 1), cB + hstepB + kstep, voffB);
        PG8_WAIT_V(6); PG8_BAR;
    }
    for (;;) {
        const bool has_next = S.next(ui + 1, nxt);
        const char* nA = has_next ? (const char*)g.A + (size_t)nxt.pm * tstepA : cA; const char* nB = has_next ? (const char*)g.Bt + (size_t)nxt.pn * tstepB : cB;
        for (int t = 0; t < nt; t += 2) {
            const bool last = (t == nt - 2);
            if constexpr (Epi::MID) { if (t * BK == g.kmid) E.midscale(acc, cur, wr, wc, fr, fq); }
            const char* a1 = cA + (size_t)(t + 1) * kstep;
            const char* a2 = last ? nA : cA + (size_t)(t + 2) * kstep; const char* b2 = last ? nB : cB + (size_t)(t + 2) * kstep;
            const char* a3 = a2 + kstep; const char* b3 = b2 + kstep;
            if (last && has_next) S.a_ready(nxt);
            if constexpr (SP2) {
            PG8_LDB(B0, 0, 0); PG8_LDB(B1, 0, 1); PG8_SCHED; PG8_LDA(At, 0, 0); PG8_STAGE(PG8_SA(1, 1), a1 + hstepA, voffA);
            PG8_WAIT_V(8); PG8_WAIT_L(0); PG8_BAR; PG8_MMA(0, 0, At, B0); PG8_MMA(0, 1, At, B1); PG8_BAR; PG8_SCHED;
            PG8_LDA(At, 0, 1); PG8_STAGE(PG8_SB(0, 0), b2, voffB); PG8_STAGE(PG8_SB(0, 1), b2 + hstepB, voffB); PG8_STAGE(PG8_SA(0, 0), a2, voffA);
            PG8_WAIT_V(8); PG8_WAIT_L(0); PG8_BAR; PG8_MMA(1, 0, At, B0); PG8_MMA(1, 1, At, B1); PG8_BAR; PG8_SCHED;
            PG8_LDB(B0, 1, 0); PG8_LDB(B1, 1, 1); PG8_SCHED; PG8_LDA(At, 1, 0); PG8_STAGE(PG8_SA(0, 1), a2 + hstepA, voffA);
            PG8_WAIT_V(8); PG8_WAIT_L(0); PG8_BAR; PG8_MMA(0, 0, At, B0); PG8_MMA(0, 1, At, B1); PG8_BAR; PG8_SCHED;
            PG8_LDA(At, 1, 1); PG8_STAGE(PG8_SB(1, 0), b3, voffB); PG8_STAGE(PG8_SB(1, 1), b3 + hstepB, voffB); PG8_STAGE(PG8_SA(1, 0), a3, voffA);
            PG8_WAIT_V(8); PG8_WAIT_L(0); PG8_BAR; PG8_MMA(1, 0, At, B0); PG8_MMA(1, 1, At, B1); PG8_BAR; PG8_SCHED;
            } else {
            PG8_LDB(B0, 0, 0); PG8_SCHED; PG8_LDA(At, 0, 0); PG8_STAGE(PG8_SA(1, 1), a1 + hstepA, voffA);
            PG8_WAIT_L(8); PG8_BAR; PG8_WAIT_L(0); PG8_MMA(0, 0, At, B0); PG8_BAR; PG8_SCHED;
            PG8_LDB(B1, 0, 1); PG8_STAGE(PG8_SB(0, 0), b2, voffB);
            PG8_BAR; PG8_WAIT_L(0); PG8_MMA(0, 1, At, B1); PG8_BAR;
            PG8_LDA(At, 0, 1); PG8_STAGE(PG8_SA(0, 0), a2, voffA);
            PG8_BAR; PG8_WAIT_L(0); PG8_MMA(1, 0, At, B0); PG8_BAR; PG8_SCHED;
            PG8_STAGE(PG8_SB(0, 1), b2 + hstepB, voffB);
            PG8_WAIT_V(6); PG8_BAR; PG8_MMA(1, 1, At, B1); PG8_BAR;
            PG8_LDB(B0, 1, 0); PG8_SCHED; PG8_LDA(At, 1, 0); PG8_STAGE(PG8_SA(0, 1), a2 + hstepA, voffA);
            PG8_WAIT_L(8); PG8_BAR; PG8_WAIT_L(0); PG8_MMA(0, 0, At, B0); PG8_BAR; PG8_SCHED;
            PG8_LDB(B1, 1, 1); PG8_STAGE(PG8_SB(1, 0), b3, voffB);
            PG8_BAR; PG8_WAIT_L(0); PG8_MMA(0, 1, At, B1); PG8_BAR;
            PG8_LDA(At, 1, 1); PG8_STAGE(PG8_SA(1, 0), a3, voffA);
            PG8_BAR; PG8_WAIT_L(0); PG8_MMA(1, 0, At, B0); PG8_BAR; PG8_SCHED;
            PG8_STAGE(PG8_SB(1, 1), b3 + hstepB, voffB);
            PG8_WAIT_V(6); PG8_BAR; PG8_MMA(1, 1, At, B1); PG8_BAR;
            }
        }
        if constexpr (ALIGN_EPI) { if (wr == 0) PG8_BAR; }
        if constexpr (!Epi::AFTER_DRAIN) { E(acc, cur, wr, wc, fr, fq); S.done(cur); }
        if (!has_next) break;
#pragma unroll
        for (int a = 0; a < 2; ++a)
#pragma unroll
            for (int b = 0; b < 2; ++b)
#pragma unroll
                for (int m = 0; m < 4; ++m)
#pragma unroll
                    for (int n = 0; n < 2; ++n) acc[a][b][m][n] = (f32x4){0.f, 0.f, 0.f, 0.f};
        cur = nxt; cA = nA; cB = nB; ++ui;
        if constexpr (ALIGN_EPI) { if (wr == 1) PG8_BAR; }
    }
    PG8_WAIT_V(0);
    if constexpr (!ALIGN_EPI) { if (wr == 0) PG8_BAR; }
    PG8_BAR;
    if constexpr (Epi::AFTER_DRAIN) { E.fused(acc, cur, wr, wc, fr, fq, lds, wid, lane); S.done(cur); }
#undef PG8_SA
#undef PG8_SB
#undef PG8_STAGE
#undef PG8_LDA
#undef PG8_LDB
#undef PG8_MMA
#undef PG8_WAIT_V
#undef PG8_WAIT_L
#undef PG8_BAR
#undef PG8_SCHED
}

}

template <class F, class Sched>
__device__ __forceinline__ void run_gemm(unsigned char* lds, const GemmD& g, const Sched& S, const F& f, const int tid) {
    pg8::Gemm pg; pg.A = g.A; pg.Bt = g.Bt; pg.K = g.K; pg.lda = (int)g.lda; pg.ldb = (int)g.ldb; pg.kmid = g.kmid;
    pg8::Epi<F> E; E.f = f;
    pg8::gemm_phase<pg8::Epi<F>, Sched, true, true>((PG8_LAS unsigned char*)lds, pg, S, E, tid);
}
template <class Epi>
__device__ __forceinline__ void gemm_phase_sub(const Ctx& c, const GemmD& g, int nM, int nN, const Epi& E, int G, int cidx) {
    pg8::StaticOrder S; S.init(nM * 256, nN * 256, G, cidx);
    run_gemm(c.lds, g, S, E, c.tid);
}
template <class Epi>
__device__ __forceinline__ void gemm_phase_dense(const Ctx& c, const GemmD& g, int nM, int nN, const Epi& E) {
#ifdef USE_SGEMM
    const int nU = nM * nN;
    for (int ui = c.blk; ui < nU; ui += c.nblk) { Unit u; u.pn = ui % nN; u.pm = ui / nN; sgemm_unit(g, u, E, c.wave, c.lane); }
#else
    pg8::StaticOrder S; S.init(nM * 256, nN * 256, c.nblk, c.blk);
    run_gemm(c.lds, g, S, E, c.tid);
#endif
}

__device__ __forceinline__ void transpose_item(const float* W, int K, int N, bf16_t* WT, const float* gain, float* scr, int item, int lane) {
    const int nblk = N / 32, kb = item / nblk, nb = item % nblk, k0 = 64 * kb, n0 = 32 * nb;
    { f32x4 v[8];
#pragma unroll
      for (int i = 0; i < 8; ++i) v[i] = *(const f32x4*)(W + (size_t)(k0 + 8 * i + (lane >> 3)) * N + n0 + 4 * (lane & 7));
#pragma unroll
      for (int i = 0; i < 8; ++i) { const int kk = 8 * i + (lane >> 3); const float gg = gain ? gain[k0 + kk] : 1.f; float* s = scr + kk * 33 + 4 * (lane & 7);
          s[0] = v[i][0] * gg; s[1] = v[i][1] * gg; s[2] = v[i][2] * gg; s[3] = v[i][3] * gg; } }
    LDS_WAIT(); asm volatile("" ::: "memory");
    const int cc = lane & 7;
#pragma unroll
    for (int j = 0; j < 4; ++j) { const int n = (lane >> 3) + 8 * j; const float* s = scr + (8 * cc) * 33 + n;
        u32x4 o; o.x = pk2(s[0 * 33], s[1 * 33]); o.y = pk2(s[2 * 33], s[3 * 33]); o.z = pk2(s[4 * 33], s[5 * 33]); o.w = pk2(s[6 * 33], s[7 * 33]);
        *(u32x4*)(WT + (size_t)(n0 + n) * K + k0 + 8 * cc) = o; }
    LDS_WAIT(); asm volatile("" ::: "memory");
}
__device__ __forceinline__ void transpose_wg_item(const Ctx& c, const float* W, int K, int N, bf16_t* WT, const float* gain, int item) {
    const int nblk = N / 256, kb = item / nblk, nb = item % nblk, k0 = 64 * kb, n0 = 256 * nb;
    float* T = (float*)c.lds;
    f32x4 v[8];
#pragma unroll
    for (int i = 0; i < 8; ++i) { const int idx = i * 512 + c.tid, row = idx >> 6, c4 = idx & 63; v[i] = *(const f32x4*)(W + (size_t)(k0 + row) * N + n0 + 4 * c4); }
#pragma unroll
    for (int i = 0; i < 8; ++i) { const int idx = i * 512 + c.tid, row = idx >> 6, c4 = idx & 63; const float gg = gain ? gain[k0 + row] : 1.f; float* s = T + row * 257 + 4 * c4;
        s[0] = v[i][0] * gg; s[1] = v[i][1] * gg; s[2] = v[i][2] * gg; s[3] = v[i][3] * gg; }
    __syncthreads();
#pragma unroll
    for (int j = 0; j < 4; ++j) { const int id = j * 512 + c.tid, n = id >> 3, cc = id & 7; const float* s = T + (8 * cc) * 257 + n;
        u32x4 o; o.x = pk2(s[0 * 257], s[1 * 257]); o.y = pk2(s[2 * 257], s[3 * 257]); o.z = pk2(s[4 * 257], s[5 * 257]); o.w = pk2(s[6 * 257], s[7 * 257]);
        *(u32x4*)(WT + (size_t)(n0 + n) * K + k0 + 8 * cc) = o; }
    __syncthreads();
}
__device__ __forceinline__ void cvt_range(const Ctx& c, const float* src, bf16_t* dst, size_t n) {
    const size_t nv = n / 8, stride = (size_t)c.nblk * 512;
    for (size_t v0 = (size_t)c.blk * 512 + c.tid; v0 < nv; v0 += 4 * stride) {
        f32x4 a[4], b[4];
#pragma unroll
        for (int u = 0; u < 4; ++u) { const size_t v = v0 + u * stride < nv ? v0 + u * stride : v0; a[u] = *(const f32x4*)(src + v * 8); b[u] = *(const f32x4*)(src + v * 8 + 4); }
#pragma unroll
        for (int u = 0; u < 4; ++u) { const size_t v = v0 + u * stride; if (v < nv) { u32x4 o; o.x = pk2(a[u][0], a[u][1]); o.y = pk2(a[u][2], a[u][3]); o.z = pk2(b[u][0], b[u][1]); o.w = pk2(b[u][2], b[u][3]);
            *(u32x4*)(dst + v * 8) = o; } }
    }
}
__device__ __forceinline__ void ssm_tables_unit(const Ctx& c, const Args& a, int layer, int g, int part, int nparts) {
    float* Apow = (float*)c.lds;
    float* Bre = Apow + 2 * 33 * 64 * 2;
    float* Bim = Bre + 2 * 64 * 16;
    float* Cre = Bim + 2 * 64 * 16;
    float* Cim = Cre + 2 * 16 * 64;
    float* Tt = Cim + 2 * 16 * 64;
    unsigned char* lw = a.ws + WS_LW + (size_t)layer * LW_STRIDE;
    float* AL = (float*)(lw + LW_AL);
    bf16_t* WE = (bf16_t*)(lw + LW_WE) + (size_t)g * 256 * 512;
    bf16_t* WY = (bf16_t*)(lw + LW_WY) + (size_t)g * 512 * KCAT;
    const int tid = c.tid;
    unsigned char* rgn_ws = a.ws; (void)rgn_ws;
    __syncthreads();
    RGN(11, 0);
    if (tid < 128) {
        const int dir = tid >> 6, n = tid & 63; const int ldg = (layer * 2 + dir) * NG + g;
        const float lre = a.in[I_LRE][ldg * 64 + n], lim = a.in[I_LIM][ldg * 64 + n];
        const float dt = expf(a.in[I_LOGDT][ldg]);
        { const float dec = expf(lre * dt); float sn, cs; sincosf(lim * dt, &sn, &cs); const float a1r = dec * cs, a1i = dec * sn;
          float pr = 1.f, pi = 0.f;
          for (int k = 0; k <= 32; ++k) { Apow[((dir * 33 + k) * 64 + n) * 2 + 0] = pr; Apow[((dir * 33 + k) * 64 + n) * 2 + 1] = pi;
              const float nr_ = pr * a1r - pi * a1i, ni_ = pr * a1i + pi * a1r; pr = nr_; pi = ni_; } }
        const float abr = Apow[((dir * 33 + 1) * 64 + n) * 2 + 0], abi = Apow[((dir * 33 + 1) * 64 + n) * 2 + 1];
        const float den = lre * lre + lim * lim, nr = abr - 1.f;
        const float fre = (nr * lre + abi * lim) / den, fim = (abi * lre - nr * lim) / den;
        for (int q = 0; q < 16; ++q) { const float br = a.in[I_BRE][(ldg * 64 + n) * 16 + q], bi = a.in[I_BIM][(ldg * 64 + n) * 16 + q];
            Bre[(dir * 64 + n) * 16 + q] = fre * br - fim * bi; Bim[(dir * 64 + n) * 16 + q] = fre * bi + fim * br; }
        for (int p = 0; p < 16; ++p) { Cre[(dir * 16 + p) * 64 + n] = a.in[I_CRE][(ldg * 16 + p) * 64 + n]; Cim[(dir * 16 + p) * 64 + n] = a.in[I_CIM][(ldg * 16 + p) * 64 + n]; }
        if (part == 0) { AL[((dir * NG + g) * 64 + n) * 2 + 0] = Apow[((dir * 33 + 32) * 64 + n) * 2 + 0];
        AL[((dir * NG + g) * 64 + n) * 2 + 1] = Apow[((dir * 33 + 32) * 64 + n) * 2 + 1]; }
    }
    __syncthreads();
    RGN(11, 1); RGN(12, 0);
    const int kk_lo = nparts == 4 ? 8 * part : 0, nkk = nparts == 4 ? 39 : 63;
    {
        const int l15 = c.lane & 15, l4 = c.lane >> 4;
      for (int kb0 = 0; kb0 < nkk; kb0 += 40) {
        f32x4 accs[5]; int ks[5]; bool val[5];
#pragma unroll
        for (int i = 0; i < 5; ++i) { const int kx = kb0 + c.wave + 8 * i; val[i] = kx < nkk; ks[i] = kk_lo + (val[i] ? kx : 0) - 31; accs[i] = (f32x4){0.f, 0.f, 0.f, 0.f}; }
#pragma unroll 2
        for (int st = 0; st < 32; ++st) {
            const int kidx = 4 * st + l4, n = kidx & 63; const bool lo = kidx < 64;
            const float cr0 = Cre[l15 * 64 + n], ci0 = Cim[l15 * 64 + n], cr1 = Cre[(16 + l15) * 64 + n], ci1 = Cim[(16 + l15) * 64 + n];
            const float b0 = lo ? Bre[n * 16 + l15] : Bim[n * 16 + l15], b1 = lo ? Bre[(64 + n) * 16 + l15] : Bim[(64 + n) * 16 + l15];
#pragma unroll
            for (int i = 0; i < 5; ++i) {
                const int dir = ks[i] < 0 ? 1 : 0, e = ks[i] < 0 ? -ks[i] : ks[i];
                const float ar = Apow[((dir * 33 + e) * 64 + n) * 2 + 0], ai = Apow[((dir * 33 + e) * 64 + n) * 2 + 1];
                const float cr = dir ? cr1 : cr0, ci = dir ? ci1 : ci0;
                const float av = lo ? (cr * ar - ci * ai) : -(cr * ai + ci * ar);
                accs[i] = __builtin_amdgcn_mfma_f32_16x16x4f32(av, dir ? b1 : b0, accs[i], 0, 0, 0);
            }
        }
#pragma unroll
        for (int i = 0; i < 5; ++i) if (val[i] && ks[i] == 0) {
#pragma unroll 4
            for (int st = 0; st < 32; ++st) {
                const int kidx = 4 * st + l4, n = kidx & 63; const bool lo = kidx < 64;
                const float cr = Cre[(16 + l15) * 64 + n], ci = Cim[(16 + l15) * 64 + n];
                const float ar = Apow[((33 + 0) * 64 + n) * 2 + 0], ai = Apow[((33 + 0) * 64 + n) * 2 + 1];
                const float av = lo ? (cr * ar - ci * ai) : -(cr * ai + ci * ar);
                const float bv = lo ? Bre[(64 + n) * 16 + l15] : Bim[(64 + n) * 16 + l15];
                accs[i] = __builtin_amdgcn_mfma_f32_16x16x4f32(av, bv, accs[i], 0, 0, 0);
            }
        }
#pragma unroll
        for (int i = 0; i < 5; ++i) if (val[i]) { const int kk = ks[i] + 31;
#pragma unroll
            for (int r = 0; r < 4; ++r) { const int p = 4 * l4 + r;
                Tt[(kk * 16 + p) * 16 + l15] = accs[i][r] + ((ks[i] == 0 && l15 == p) ? a.in[I_DSKIP][layer * 512 + 16 * g + p] : 0.f); } }
      }
    }
    __syncthreads();
    RGN(12, 1); RGN(13, 0);
    const int wy_lo = (512 * 96 / nparts) * part, wy_hi = wy_lo + 512 * 96 / nparts, we_lo = (256 * 64 / nparts) * part, we_hi = we_lo + 256 * 64 / nparts;
    for (int it = wy_lo + tid; it < wy_hi; it += 512) {
        const int nout = it / 96, kin0 = (it % 96) * 8, j = nout >> 4, p = nout & 15;
        float v[8];
        if (kin0 < 512) { const int s = kin0 >> 4, q0 = kin0 & 15, kk = j - s + 31;
#pragma unroll
            for (int i = 0; i < 8; ++i) v[i] = Tt[(kk * 16 + p) * 16 + q0 + i]; }
        else { const int comp = kin0 - 512, dir = comp >> 7, reim = (comp >> 6) & 1, n0 = comp & 63, e = dir == 0 ? j + 1 : 32 - j;
#pragma unroll
            for (int i = 0; i < 8; ++i) { const int n = n0 + i; const float cr = Cre[(dir * 16 + p) * 64 + n], ci = Cim[(dir * 16 + p) * 64 + n];
                const float ar = Apow[((dir * 33 + e) * 64 + n) * 2 + 0], ai = Apow[((dir * 33 + e) * 64 + n) * 2 + 1];
                v[i] = reim == 0 ? (cr * ar - ci * ai) : -(cr * ai + ci * ar); } }
        u32x4 o; o.x = pk2(v[0], v[1]); o.y = pk2(v[2], v[3]); o.z = pk2(v[4], v[5]); o.w = pk2(v[6], v[7]);
        *(u32x4*)(WY + (size_t)nout * KCAT + kin0) = o;
    }
    for (int it = we_lo + tid; it < we_hi; it += 512) {
        const int comp = it >> 6, kin0 = (it & 63) * 8, j = kin0 >> 4, q0 = kin0 & 15, dir = comp >> 7, reim = (comp >> 6) & 1, n = comp & 63, e = dir == 0 ? 31 - j : j;
        const float ar = Apow[((dir * 33 + e) * 64 + n) * 2 + 0], ai = Apow[((dir * 33 + e) * 64 + n) * 2 + 1];
        float v[8];
#pragma unroll
        for (int i = 0; i < 8; ++i) { const float br = Bre[(dir * 64 + n) * 16 + q0 + i], bi = Bim[(dir * 64 + n) * 16 + q0 + i]; v[i] = reim == 0 ? (ar * br - ai * bi) : (ar * bi + ai * br); }
        u32x4 o; o.x = pk2(v[0], v[1]); o.y = pk2(v[2], v[3]); o.z = pk2(v[4], v[5]); o.w = pk2(v[6], v[7]);
        *(u32x4*)(WE + (size_t)comp * 512 + kin0) = o;
    }
    __syncthreads();
    RGN(13, 1);
}
__device__ __forceinline__ void cvt_fp8_layer(const Ctx& c, const Args& a, int layer, int widx, int nw) {
    for (int r0 = widx; r0 < 2 * 16384; r0 += 4 * nw) {
      f32x4 vq[4][4];
#pragma unroll
      for (int u = 0; u < 4; ++u) { const int q = r0 + u * nw < 2 * 16384 ? r0 + u * nw : r0; const int tab = q >> 14, rr = layer * 16384 + (q & 16383);
          const float* srcp = (tab ? a.in[I_EV] : a.in[I_EU]) + (size_t)rr * D + 16 * c.lane;
#pragma unroll
          for (int j = 0; j < 4; ++j) vq[u][j] = *(const f32x4*)(srcp + 4 * j); }
#pragma unroll
      for (int u = 0; u < 4; ++u) {
        const int q = r0 + u * nw; if (q >= 2 * 16384) break;
        const int tab = q >> 14, rr = layer * 16384 + (q & 16383), r = tab * 32768 + rr;
        f32x4 v[4]; float mx = 0.f;
#pragma unroll
        for (int j = 0; j < 4; ++j) { v[j] = vq[u][j]; mx = fmaxf(mx, fmaxf(fmaxf(fabsf(v[j][0]), fabsf(v[j][1])), fmaxf(fabsf(v[j][2]), fabsf(v[j][3])))); }
        mx = wave_max(mx);
        const float sc = mx > 0.f ? 448.f / mx : 1.f;
        u32x4 o;
#pragma unroll
        for (int j = 0; j < 4; ++j) { int w = 0;
            w = __builtin_amdgcn_cvt_pk_fp8_f32(fminf(fmaxf(v[j][0] * sc, -448.f), 448.f), fminf(fmaxf(v[j][1] * sc, -448.f), 448.f), w, false);
            w = __builtin_amdgcn_cvt_pk_fp8_f32(fminf(fmaxf(v[j][2] * sc, -448.f), 448.f), fminf(fmaxf(v[j][3] * sc, -448.f), 448.f), w, true);
            o[j] = (unsigned)w; }
        *(u32x4*)(a.ws + (tab ? WS_EV : WS_EU) + (size_t)rr * D + 16 * c.lane) = o;
        if (c.lane == 0) ((float*)(a.ws + WS_ESC))[r] = mx > 0.f ? mx * (1.f / 448.f) : 1.f;
      }
    }
}
__device__ __forceinline__ void p0_prologue(const Ctx& c, const Args& a) {
    unsigned char* rgn_ws = a.ws; (void)rgn_ws; RGN(4, 0);
    const bool ssm_first = (c.blk & 1) == 0;
#define P0_SSM() do { const int np = c.nblk >= 256 ? 4 : 1;     \
      for (int u = c.blk; u < 2 * NG * np; u += c.nblk) ssm_tables_unit(c, a, (u / np) / NG, (u / np) % NG, u % np, np); } while (0)
    if (ssm_first) P0_SSM();
    RGN(4, 1); RGN(5, 0);
    const int gw = c.blk * 8 + c.wave, NGW = c.nblk * 8;
    {
        constexpr int I0 = 80, I1 = 16, I2 = 64, I3 = 128, I4 = 64, I5 = 16, IL = I0 + I1 + I2 + I3 + I4 + I5;
        __syncthreads();
        for (int it = c.blk; it < 2 * IL; it += c.nblk) {
            const int L = it / IL; int r = it % IL; unsigned char* lw = a.ws + WS_LW + (size_t)L * LW_STRIDE;
            if (r < I0) { transpose_wg_item(c, a.in[I_WIN] + (size_t)L * D * DIN, D, DIN, (bf16_t*)(lw + LW_WIN), a.in[I_NMIXG] + L * D, r); continue; } r -= I0;
            if (r < I1) { transpose_wg_item(c, a.in[I_WGLU] + (size_t)L * 512 * 512, 512, 512, (bf16_t*)(lw + LW_WGLU), nullptr, r); continue; } r -= I1;
            if (r < I2) { const int k0 = 64 * (r / 4); const float* gn = k0 < 512 ? a.in[I_SSMG] + L * 512 : a.in[I_ATTG] + L * 512 - 512;
                transpose_wg_item(c, a.in[I_WOUT] + (size_t)L * D * D, D, D, (bf16_t*)(lw + LW_WOUT), gn, r); continue; } r -= I2;
            if (r < I3) { transpose_wg_item(c, a.in[I_WQ] + (size_t)L * D * 2048, D, 2048, (bf16_t*)(lw + LW_WQ), a.in[I_NFFNG] + L * D, r); continue; } r -= I3;
            if (r < I4) { transpose_wg_item(c, a.in[I_WGATE] + (size_t)L * D * D, D, D, (bf16_t*)(lw + LW_WGATE), a.in[I_NPLEG] + L * D, r); continue; } r -= I4;
            transpose_wg_item(c, a.in[I_WPROJ] + (size_t)L * 256 * D, 256, D, (bf16_t*)(lw + LW_WPROJ), nullptr, r);
        }
    }
    RGN(5, 1); RGN(6, 0);
    cvt_fp8_layer(c, a, 0, gw, NGW);
    if (c.nblk != 256) cvt_fp8_layer(c, a, 1, gw, NGW);
    RGN(6, 1); RGN(7, 0);
    cvt_range(c, a.in[I_P], (bf16_t*)(a.ws + WS_PB), (size_t)2 * M * 256);
    for (int L = 0; L < 2; ++L) {
        cvt_range(c, a.in[I_SK1] + (size_t)L * 8 * 128 * 128, (bf16_t*)(a.ws + WS_LW + (size_t)L * LW_STRIDE + LW_SK1), (size_t)8 * 128 * 128);
        cvt_range(c, a.in[I_SK2] + (size_t)L * 8 * 128 * 128, (bf16_t*)(a.ws + WS_LW + (size_t)L * LW_STRIDE + LW_SK2), (size_t)8 * 128 * 128);
    }
    RGN(7, 1); RGN(8, 0);
    {
        bf16_t* XB = (bf16_t*)(a.ws + WS_XB); float* SSQ0 = (float*)(a.ws + WS_SSQ0);
        for (int m = gw; m < M; m += NGW) {
            const f32x4* xr = (const f32x4*)(a.in[I_X] + (size_t)m * D) + c.lane; float s = 0.f;
#pragma unroll
            for (int j = 0; j < 4; ++j) { const f32x4 v = xr[64 * j]; s += v[0] * v[0] + v[1] * v[1] + v[2] * v[2] + v[3] * v[3];
                *(u32x2*)(XB + (size_t)m * D + 256 * j + 4 * c.lane) = pack4(v); }
            s = wave_sum(s);
            if (c.lane < 16) SSQ0[(size_t)m * 16 + c.lane] = c.lane == 0 ? s : 0.f;
        }
    }
    RGN(8, 1);
    if (!ssm_first) P0_SSM();
#undef P0_SSM
    if (c.blk == c.nblk - 1) {
        float* R = (float*)(a.ws + WS_ROPE);
        for (int e = c.tid; e < 3072; e += 512) {
            const bool isr = e < 2048; const int pos = isr ? (e >> 4) : ((e - 2048) >> 4), f = e & 15;
            const float inv = powf(10000.f, -(float)f / 16.f), ang = (float)pos * inv; float sn, cs; sincosf(ang, &sn, &cs);
            if (isr) { R[e] = cs; R[2048 + e] = sn; } else { R[4096 + (e - 2048)] = cs; R[5120 + (e - 2048)] = sn; }
        }
    }
}

__device__ __forceinline__ void s1_unit(const Ctx& c, const Args& a, int layer, int gb  ) {
    unsigned char* lw = a.ws + WS_LW + (size_t)layer * LW_STRIDE;
    bf16_t* UC = (bf16_t*)(a.ws + WS_UCAT); float* EB = (float*)(a.ws + WS_EBUF);
    const int g = gb >> 1;
    GemmD gd; gd.A = UC; gd.lda = KCAT; gd.Bt = (const bf16_t*)(lw + LW_WE); gd.ldb = 512; gd.K = 512; gd.kmid = -1;
    EpiS1 E; E.ebuf = EB;
    Unit u; u.pm = gb; u.pn = g;
    unsigned char* rgn_ws = a.ws; (void)rgn_ws; if (layer == 0) RGN(1, 0);
#ifdef USE_SGEMM
    sgemm_unit(gd, u, E, c.wave, c.lane);
#else
    { pg8::OneUnit S; S.u = u; run_gemm(c.lds, gd, S, E, c.tid); }
#endif
    VM_WAIT(); __syncthreads();
    if (layer == 0) { RGN(1, 1); RGN(2, 0); }
    {
        const float* AL = (const float*)(lw + LW_AL);
        f32x4* Es4 = (f32x4*)c.lds; const float* Es = (const float*)c.lds;
        float* SEG = (float*)(c.lds + LDSCTL_OFF + 1024);
        const int n = c.lane, sg = c.wave;
        for (int dir = 0; dir < 2; ++dir) {
            {
#pragma unroll 1
                for (int k0 = 0; k0 < 16; k0 += 8) { f32x4 ev[8];
#pragma unroll
                    for (int k = 0; k < 8; ++k) { const int i = c.tid + 512 * (k0 + k), ch = i >> 5, q4 = i & 31; ev[k] = *(const f32x4*)(EB + ((size_t)gb * NCH + ch) * 256 + dir * 128 + q4 * 4); }
#pragma unroll
                    for (int k = 0; k < 8; ++k) Es4[c.tid + 512 * (k0 + k)] = ev[k]; }
            }
            __syncthreads();
            const float alr = AL[((dir * NG + g) * 64 + n) * 2 + 0], ali = AL[((dir * NG + g) * 64 + n) * 2 + 1];
            float hr = 0.f, hi = 0.f, pr = 1.f, pi = 0.f;
#pragma unroll 8
            for (int s = 0; s < 32; ++s) {
                const int st = sg * 32 + s, ch = dir == 0 ? st : NCH - 1 - st;
                const float er = Es[ch * 128 + n], ei = Es[ch * 128 + 64 + n];
                const float nr = alr * hr - ali * hi + er, ni = alr * hi + ali * hr + ei; hr = nr; hi = ni;
                const float qr = pr * alr - pi * ali, qi = pr * ali + pi * alr; pr = qr; pi = qi;
            }
            SEG[(sg * 64 + n) * 2] = hr; SEG[(sg * 64 + n) * 2 + 1] = hi;
            __syncthreads();
            float sr = 0.f, si = 0.f;
            for (int j = 0; j < sg; ++j) { const float er = SEG[(j * 64 + n) * 2], ei = SEG[(j * 64 + n) * 2 + 1];
                const float nr = pr * sr - pi * si + er, ni = pr * si + pi * sr + ei; sr = nr; si = ni; }
            hr = sr; hi = si;
            bf16_t* hc = UC + (size_t)gb * NCH * KCAT + 512 + dir * 128 + n;
#pragma unroll 8
            for (int s = 0; s < 32; ++s) {
                const int st = sg * 32 + s, ch = dir == 0 ? st : NCH - 1 - st;
                hc[(size_t)ch * KCAT] = (bf16_t)f2bf(hr); hc[(size_t)ch * KCAT + 64] = (bf16_t)f2bf(hi);
                const float er = Es[ch * 128 + n], ei = Es[ch * 128 + 64 + n];
                const float nr = alr * hr - ali * hi + er, ni = alr * hi + ali * hr + ei; hr = nr; hi = ni;
            }
            __syncthreads();
        }
    }
    if (layer == 0) RGN(2, 1);
}
constexpr int QKP_N = 8;
__device__ __forceinline__ void qkprep(const Ctx& c, const Args& a, int layer, int widx, int nw, int mode = 0, int tok0 = 0) {
    bf16_t* QR = (bf16_t*)(a.ws + WS_QRAW); bf16_t* KV = (bf16_t*)(a.ws + WS_KV); const float* R = (const float*)(a.ws + WS_ROPE);
    const int half = c.lane >> 5, i = c.lane & 31, f = i & 15;
    const int d = i < 16 ? i : 32 + (i - 16);
    unsigned char* rgn_ws = a.ws; (void)rgn_ws; if (layer == 0) RGN(3, 0);
    const float gq1 = a.in[I_QNG][layer * 64 + d], gq2 = a.in[I_QNG][layer * 64 + d + 16], gk1 = a.in[I_KNG][layer * 64 + d], gk2 = a.in[I_KNG][layer * 64 + d + 16];
    const int nitems = mode == 0 ? M * 5 : mode == 1 ? M * 4 : 256;
    for (int base = widx; base < nitems; base += QKP_N * nw) {
        bf16_t* p[QKP_N]; float x1[QKP_N], x2[QKP_N], cs[QKP_N], sn[QKP_N]; int hh[QKP_N]; bool ok[QKP_N];
#pragma unroll
        for (int u = 0; u < QKP_N; ++u) {
            int it = base + u * nw; ok[u] = it < nitems; if (!ok[u]) it = base;
            const int m = mode == 0 ? it / 5 : mode == 1 ? it >> 2 : tok0 + it; hh[u] = (mode == 0 ? it % 5 : mode == 1 ? (it & 3) : 4) * 2 + half;
            p[u] = hh[u] < 8 ? QR + (size_t)m * 512 + hh[u] * 64 : KV + (size_t)m * 256 + (hh[u] - 8) * 64;
            x1[u] = bf1(p[u][d]); x2[u] = bf1(p[u][d + 16]);
            const int s = m & (SEQ - 1);
            if (i < 16) { const int pos = s >> 6; cs[u] = R[pos * 16 + f]; sn[u] = R[2048 + pos * 16 + f]; }
            else { const int pos = s & 63; cs[u] = R[4096 + pos * 16 + f]; sn[u] = R[5120 + pos * 16 + f]; }
        }
#pragma unroll
        for (int u = 0; u < QKP_N; ++u) {
            float ss = x1[u] * x1[u] + x2[u] * x2[u];
#pragma unroll
            for (int o = 1; o < 32; o <<= 1) ss += __shfl_xor(ss, o);
            const float rstd = rsqrtf(ss * (1.f / 64.f) + EPS);
            const float y1 = x1[u] * rstd * (hh[u] < 8 ? gq1 : gk1), y2 = x2[u] * rstd * (hh[u] < 8 ? gq2 : gk2);
            float o1 = y1 * cs[u] - y2 * sn[u], o2 = y2 * cs[u] + y1 * sn[u];
            if (hh[u] < 8) { o1 *= C2; o2 *= C2; }
            if (ok[u]) { p[u][d] = (bf16_t)f2bf(o1); p[u][d + 16] = (bf16_t)f2bf(o2); }
        }
    }
    if (layer == 0) RGN(3, 1);
}

#include <hip/hip_bf16.h>
#include <cmath>
namespace attn_body {
using bf16=__hip_bfloat16;
using bf16x8=__attribute__((ext_vector_type(8)))short;
using s16x4=__attribute__((ext_vector_type(4)))short;
using f32x16=__attribute__((ext_vector_type(16)))float;
using u32x4=__attribute__((ext_vector_type(4)))unsigned;
constexpr int SEQ=8192,D=64,QPITCH=512,KVPITCH=256,OPITCH=1024;
constexpr int NW=8,QBLK=32,QB=QBLK*NW,KVBLK=64,NQB=SEQ/QB;
__device__ __forceinline__ int crow(int r,int hi){return (r&3)+8*(r>>2)+4*hi;}
#define SBAR() __builtin_amdgcn_sched_barrier(0)
__device__ __forceinline__ void cmask(f32x16&p0,f32x16&p1,int jb,int qrel,int hi){
  const float NEG=-INFINITY; int kb=64*jb+4*hi;
  #pragma unroll
  for(int r=0;r<16;++r){int kv=kb+(r&3)+8*(r>>2); if(kv>qrel)p0[r]=NEG; if(kv+32>qrel)p1[r]=NEG;}
}

constexpr int NSLOT=3, SLOTB=8192;
constexpr int LDS_K=0, LDS_V=NSLOT*SLOTB, LDS_WS=2*NSLOT*SLOTB, LDS_OST=LDS_WS+NW*64*4, LDS_BYTES=LDS_OST+NW*4096;
constexpr float C2=0.125f*1.4426950408889634f;
__device__ __forceinline__ void glds16(const void*gsrc,unsigned lds_dst){unsigned keep;
  asm volatile("s_mov_b32 %0, m0\n\ts_mov_b32 m0, %2\n\ts_nop 0\n\tglobal_load_lds_dwordx4 %1, off\n\ts_mov_b32 m0, %0":"=&s"(keep):"v"(gsrc),"s"(lds_dst):"memory");}
__device__ __forceinline__ float max3f(float a,float b,float c){float r;asm("v_max3_f32 %0, %1, %2, %3":"=v"(r):"v"(a),"v"(b),"v"(c));return r;}
__device__ __forceinline__ float max2f(float a,float b){float r;asm("v_max_f32_e32 %0, %1, %2":"=v"(r):"v"(a),"v"(b));return r;}
__device__ __forceinline__ float fadd_s(float a,float b){float r;asm("v_add_f32_e32 %0, %1, %2":"=v"(r):"v"(a),"v"(b));return r;}
__device__ __forceinline__ float fsub_s(float a,float b){float r;asm("v_sub_f32_e32 %0, %1, %2":"=v"(r):"v"(a),"v"(b));return r;}
typedef float f32x2_t __attribute__((ext_vector_type(2))); typedef __bf16 bf16x2_t __attribute__((ext_vector_type(2)));
__device__ __forceinline__ unsigned cvtpk_s(float lo,float hi){f32x2_t v={lo,hi};bf16x2_t b=__builtin_convertvector(v,bf16x2_t);return __builtin_bit_cast(unsigned,b);}
#define WAIT_BAR(N) asm volatile("s_waitcnt vmcnt(" #N ") lgkmcnt(0)\n\ts_barrier":::"memory")

__device__ __forceinline__ void qkt(f32x16&p0,f32x16&p1,const char*Kslot,const bf16x8*qr,const f32x16&negm,int r32,int hi){
  const char*kb=Kslot+hi*1024+r32*16;
  #pragma unroll
  for(int d0=0;d0<4;++d0){
    const bf16x8 b0=*reinterpret_cast<const bf16x8*>(kb+d0*2048);
    const bf16x8 b1=*reinterpret_cast<const bf16x8*>(kb+d0*2048+512);
    if(d0==0){p0=__builtin_amdgcn_mfma_f32_32x32x16_bf16(b0,qr[0],negm,0,0,0);p1=__builtin_amdgcn_mfma_f32_32x32x16_bf16(b1,qr[0],negm,0,0,0);}
    else{p0=__builtin_amdgcn_mfma_f32_32x32x16_bf16(b0,qr[d0],p0,0,0,0);p1=__builtin_amdgcn_mfma_f32_32x32x16_bf16(b1,qr[d0],p1,0,0,0);}}
}
typedef __attribute__((address_space(3))) const char* lds_cptr;
typedef short v4i16_t __attribute__((ext_vector_type(4)));
__device__ __forceinline__ void kload8(bf16x8*kf,lds_cptr kp){
  kf[0]=*(const __attribute__((address_space(3))) bf16x8*)(kp);      kf[1]=*(const __attribute__((address_space(3))) bf16x8*)(kp+512);
  kf[2]=*(const __attribute__((address_space(3))) bf16x8*)(kp+2048); kf[3]=*(const __attribute__((address_space(3))) bf16x8*)(kp+2560);
  kf[4]=*(const __attribute__((address_space(3))) bf16x8*)(kp+4096); kf[5]=*(const __attribute__((address_space(3))) bf16x8*)(kp+4608);
  kf[6]=*(const __attribute__((address_space(3))) bf16x8*)(kp+6144); kf[7]=*(const __attribute__((address_space(3))) bf16x8*)(kp+6656);
}
__device__ __forceinline__ void kload2(bf16x8*kf,lds_cptr kp,int j){ kf[2*j]=*(const __attribute__((address_space(3))) bf16x8*)(kp+j*2048); kf[2*j+1]=*(const __attribute__((address_space(3))) bf16x8*)(kp+j*2048+512); }
__device__ __forceinline__ s16x4 vtr(lds_cptr p){ return __builtin_bit_cast(s16x4,__builtin_amdgcn_ds_read_tr16_b64_v4i16((__attribute__((address_space(3))) v4i16_t*)p)); }
__device__ __forceinline__ float rowmax(const f32x16&p0,const f32x16&p1){
  float a=max3f(p0[0],p0[1],p1[0]),b=max3f(p0[2],p0[3],p1[1]);a=max3f(a,p1[2],p1[3]);
  #pragma unroll
  for(int r=4;r<16;r+=4){a=max3f(a,p0[r],p0[r+1]);b=max3f(b,p0[r+2],p0[r+3]);a=max3f(a,p1[r],p1[r+1]);b=max3f(b,p1[r+2],p1[r+3]);}
  const float m=max2f(a,b);
  auto rr=__builtin_amdgcn_permlane32_swap(__float_as_uint(m),__float_as_uint(m),false,false);
  return max2f(__uint_as_float(rr[0]),__uint_as_float(rr[1]));
}
__device__ __forceinline__ void pv(f32x16*o,int vb,bf16x8 pa0,bf16x8 pa1,bf16x8 pa2,bf16x8 pa3){
  #pragma unroll
  for(int d0=0;d0<2;++d0){s16x4 lo[4],hi[4];
    #pragma unroll
    for(int ks=0;ks<4;++ks){
      asm volatile("ds_read_b64_tr_b16 %0,%1 offset:%c2":"=&v"(lo[ks]):"v"(vb),"i"(d0*4096+ks*1024):"memory");
      asm volatile("ds_read_b64_tr_b16 %0,%1 offset:%c2":"=&v"(hi[ks]):"v"(vb),"i"(d0*4096+ks*1024+512):"memory");}
    asm volatile("s_waitcnt lgkmcnt(0)":::"memory");SBAR();
    #define PK(k) (bf16x8){lo[k][0],lo[k][1],lo[k][2],lo[k][3],hi[k][0],hi[k][1],hi[k][2],hi[k][3]}
    o[d0]=__builtin_amdgcn_mfma_f32_32x32x16_bf16(pa0,PK(0),o[d0],0,0,0);
    o[d0]=__builtin_amdgcn_mfma_f32_32x32x16_bf16(pa1,PK(1),o[d0],0,0,0);
    o[d0]=__builtin_amdgcn_mfma_f32_32x32x16_bf16(pa2,PK(2),o[d0],0,0,0);
    o[d0]=__builtin_amdgcn_mfma_f32_32x32x16_bf16(pa3,PK(3),o[d0],0,0,0);
    #undef PK
  }
}

#ifndef ATTN_STORE16
#define ATTN_STORE16(p,v) (*(u32x4*)(p)=(v))
#endif
template<int THRL> __device__ __forceinline__ void attn_unit(int b,int h,int qb,const bf16*Q,const bf16*KV,bf16*O,float*SSQA,char*shm,const int tid,const float mfix){
  const int lane=tid&63,r32=lane&31,hi=lane>>5; const int wid=__builtin_amdgcn_readfirstlane(tid>>6);
  const long rowbase=(long)b*SEQ; const int q0=qb*QB;
  const bf16*Qw=Q+(rowbase+q0+wid*QBLK)*QPITCH+h*D;
  const bf16*Kh=KV+rowbase*KVPITCH+(h>>2)*D,*Vh=Kh+128;
  const unsigned lds0=(unsigned)(uintptr_t)shm;
  float*wsf=(float*)(shm+LDS_WS)+wid*64;
  const bf16*ksrc=Kh+(long)lane*KVPITCH+wid*8;
  const bf16*vsrc=Vh+(long)(16*(wid&3)+(lane>>2))*KVPITCH+(wid>>2)*32+(lane&3)*8;
  const unsigned kdst=lds0+LDS_K+wid*1024, vdst=lds0+LDS_V+wid*1024;
  #define DMA_K(t,slot) glds16(ksrc+(long)(t)*KVBLK*KVPITCH,(unsigned)__builtin_amdgcn_readfirstlane(kdst+(slot)))
  #define DMA_V(t,slot) glds16(vsrc+(long)(t)*KVBLK*KVPITCH,(unsigned)__builtin_amdgcn_readfirstlane(vdst+(slot)))
  const int vb0=(int)(lds0+LDS_V)+((lane>>4)&1)*32+(lane&3)*8+(4*hi+((lane&15)>>2))*64;
  const char*Kbase=shm+LDS_K; bf16x8 kf[8];
  const lds_cptr shm3=(lds_cptr)shm; const lds_cptr kp0=shm3+LDS_K+hi*1024+r32*16; const lds_cptr vp0=shm3+LDS_V+((lane>>4)&1)*32+(lane&3)*8+(4*hi+((lane&15)>>2))*64;
  const int NT=SEQ/KVBLK;
  DMA_K(0,0);DMA_V(0,0);DMA_K(1,SLOTB);
  bf16x8 qr[4];
  #pragma unroll
  for(int d0=0;d0<4;++d0)qr[d0]=*reinterpret_cast<const bf16x8*>(&Qw[(long)r32*QPITCH+d0*16+hi*8]);
  float mhat=0.f,l_reg=0.f;f32x16 o[2];f32x16 negm;{float z_=0.f;asm volatile("":"+v"(z_));
  #pragma unroll
  for(int r=0;r<16;++r){o[0][r]=z_;o[1][r]=z_;negm[r]=(THRL<0)?(z_-mfix):z_;}}asm volatile("":"+v"(negm)); if(THRL<0)mhat=mfix;
  #define CMASK(P0,P1,t) do{}while(0)
  bool resc=false;
  #define START(P0,P1) do{ resc=false; \
    if constexpr(THRL>=0){ const float rm=rowmax(P0,P1); const float dl=rm; mhat=fadd_s(mhat,dl); \
      _Pragma("unroll") for(int r=0;r<16;++r){P0[r]=fsub_s(P0[r],dl);P1[r]=fsub_s(P1[r],dl);} \
      _Pragma("unroll") for(int r=0;r<16;++r)negm[r]=-mhat; asm volatile("":"+v"(negm)); } \
    _Pragma("unroll") for(int r=0;r<16;++r)P0[r]=__builtin_amdgcn_exp2f(P0[r]); }while(0)
  #define RESC() do{ if(resc){ asm volatile("s_waitcnt lgkmcnt(0)":::"memory"); \
      _Pragma("unroll") for(int d_=0;d_<2;++d_) _Pragma("unroll") for(int r=0;r<16;++r)o[d_][r]*=wsf[crow(r,hi)]; } }while(0)
  f32x16 pA0,pA1,pB0,pB1;
  int sl_prev=0,sl_cur=0,sl_next=SLOTB;
  #define ROT() do{sl_prev=sl_cur;sl_cur=sl_next;sl_next=(sl_next==(NSLOT-1)*SLOTB)?0:sl_next+SLOTB;}while(0)
  DMA_K(2,2*SLOTB);
  WAIT_BAR(3);
  qkt(pA0,pA1,Kbase,qr,negm,r32,hi);asm volatile("s_nop 15\n\ts_nop 7":"+v"(pA0),"+v"(pA1));CMASK(pA0,pA1,0);
  START(pA0,pA1);
  _Pragma("unroll") for(int r=0;r<16;++r)pA1[r]=__builtin_amdgcn_exp2f(pA1[r]);
  WAIT_BAR(0);
  DMA_K(3,0);DMA_V(1,SLOTB);
  ROT();
  kload8(kf,kp0+sl_cur);
  WAIT_BAR(2);
  s16x4 vlo[8],vhi[8]; u32x4 pw0,pw1,pw2,pw3;
  #define PKW(P,B) cvtpk_s(P[B],P[B+1])
  #define PAF(k) __builtin_bit_cast(bf16x8,pw##k)
  #define VFR(i) (bf16x8){vlo[i][0],vlo[i][1],vlo[i][2],vlo[i][3],vhi[i][0],vhi[i][1],vhi[i][2],vhi[i][3]}
  #define PIN(x) asm volatile("":"+v"(x))
  #define MX3(a,b,c) __builtin_fmaxf(__builtin_fmaxf((a),(b)),(c))
  #define GAPA(MF,A0,A1,A2,A3,W0,W1,PW) do{ MF; sacc+=A0; sacc+=A1; sacc+=A2; sacc+=A3; PIN(sacc); W0; W1; PIN(PW); SBAR(); }while(0)
  #define EX(v) __builtin_amdgcn_exp2f(v)
  #define GAPB(MF,X,B) do{ MF; X[B]=EX(X[B]); X[B+1]=EX(X[B+1]); X[B+2]=EX(X[B+2]); X[B+3]=EX(X[B+3]); PIN(X); SBAR(); }while(0)
  #define VRD(i) do{ vlo[i]=vtr(vp_+(((i)>>2)*4096+((i)&3)*1024)); vhi[i]=vtr(vp_+(((i)>>2)*4096+((i)&3)*1024+512)); }while(0)
  #define KRD(G,j) do{ if(G){ kload2(kf,kp0+sl_next,j); SBAR(); } }while(0)
  #define STEP(C0,C1,P0,P1,t,GK,GV,GL) do{ SBAR(); \
    const lds_cptr vp_=vp0+sl_prev; \
    VRD(0); SBAR(); float sacc=(P0[0]+P0[1]); \
    GAPA(C0=__builtin_amdgcn_mfma_f32_32x32x16_bf16(kf[0],qr[0],negm,0,0,0), P0[2],P0[3],P0[4],P0[5],     pw0[0]=PKW(P0,0), pw0[1]=PKW(P0,2), pw0); \
    VRD(4); SBAR(); GAPA(C1=__builtin_amdgcn_mfma_f32_32x32x16_bf16(kf[1],qr[0],negm,0,0,0), P0[6],P0[7],P0[8],P0[9],     pw0[2]=PKW(P0,4), pw0[3]=PKW(P0,6), pw0); \
    VRD(1); SBAR(); GAPA(C0=__builtin_amdgcn_mfma_f32_32x32x16_bf16(kf[2],qr[1],C0,0,0,0),   P0[10],P0[11],P0[12],P0[13], pw1[0]=PKW(P0,8), pw1[1]=PKW(P0,10), pw1); \
    VRD(5); SBAR(); GAPA(C1=__builtin_amdgcn_mfma_f32_32x32x16_bf16(kf[3],qr[1],C1,0,0,0),   P0[14],P0[15],P1[0],P1[1],   pw1[2]=PKW(P0,12),pw1[3]=PKW(P0,14), pw1); \
    VRD(2); SBAR(); GAPA(C0=__builtin_amdgcn_mfma_f32_32x32x16_bf16(kf[4],qr[2],C0,0,0,0),   P1[2],P1[3],P1[4],P1[5],     pw2[0]=PKW(P1,0), pw2[1]=PKW(P1,2), pw2); \
    VRD(6); SBAR(); GAPA(C1=__builtin_amdgcn_mfma_f32_32x32x16_bf16(kf[5],qr[2],C1,0,0,0),   P1[6],P1[7],P1[8],P1[9],     pw2[2]=PKW(P1,4), pw2[3]=PKW(P1,6), pw2); \
    VRD(3); SBAR(); GAPA(C0=__builtin_amdgcn_mfma_f32_32x32x16_bf16(kf[6],qr[3],C0,0,0,0),   P1[10],P1[11],P1[12],P1[13], pw3[0]=PKW(P1,8), pw3[1]=PKW(P1,10), pw3); \
    VRD(7); SBAR(); GAPA(C1=__builtin_amdgcn_mfma_f32_32x32x16_bf16(kf[7],qr[3],C1,0,0,0),   P1[14],P1[15],0.f,0.f,       pw3[2]=PKW(P1,12),pw3[3]=PKW(P1,14), pw3); \
    l_reg+=sacc; \
    if(GK){DMA_K((t)+3,sl_cur);} if(GV){DMA_V((t)+1,sl_next);} \
    CMASK(C0,C1,t); \
    if constexpr(THRL>=0){ float a=MX3(C0[0],C0[1],C1[0]),b=MX3(C0[2],C0[3],C1[1]); a=MX3(a,C1[2],C1[3]); \
      _Pragma("unroll") for(int r=4;r<16;r+=4){a=MX3(a,C0[r],C0[r+1]);b=MX3(b,C0[r+2],C0[r+3]);a=MX3(a,C1[r],C1[r+1]);b=MX3(b,C1[r+2],C1[r+3]);} \
      float rm=__builtin_fmaxf(a,b); { auto rr=__builtin_amdgcn_permlane32_swap(__float_as_uint(rm),__float_as_uint(rm),false,false); rm=__builtin_fmaxf(__uint_as_float(rr[0]),__uint_as_float(rr[1])); } \
      resc=false; \
      if(__builtin_expect(__any(rm>(float)THRL),0)){ const float dl=__builtin_fmaxf(rm,0.f); mhat+=dl; \
        _Pragma("unroll") for(int r=0;r<16;++r){C0[r]-=dl;C1[r]-=dl;} \
        _Pragma("unroll") for(int r=0;r<16;++r)negm[r]=-mhat; asm volatile("":"+v"(negm)); \
        const float f=__builtin_amdgcn_exp2f(-dl); l_reg*=f; if(hi==0)wsf[r32]=f; resc=true; } } \
    SBAR(); \
    GAPB(o[0]=__builtin_amdgcn_mfma_f32_32x32x16_bf16(PAF(0),VFR(0),o[0],0,0,0), C0,0); \
    GAPB(o[1]=__builtin_amdgcn_mfma_f32_32x32x16_bf16(PAF(0),VFR(4),o[1],0,0,0), C0,4); \
    KRD(GL,0); GAPB(o[0]=__builtin_amdgcn_mfma_f32_32x32x16_bf16(PAF(1),VFR(1),o[0],0,0,0), C0,8); \
    KRD(GL,1); GAPB(o[1]=__builtin_amdgcn_mfma_f32_32x32x16_bf16(PAF(1),VFR(5),o[1],0,0,0), C0,12); \
    KRD(GL,2); GAPB(o[0]=__builtin_amdgcn_mfma_f32_32x32x16_bf16(PAF(2),VFR(2),o[0],0,0,0), C1,0); \
    KRD(GL,3); GAPB(o[1]=__builtin_amdgcn_mfma_f32_32x32x16_bf16(PAF(2),VFR(6),o[1],0,0,0), C1,4); \
    GAPB(o[0]=__builtin_amdgcn_mfma_f32_32x32x16_bf16(PAF(3),VFR(3),o[0],0,0,0), C1,8); \
    GAPB(o[1]=__builtin_amdgcn_mfma_f32_32x32x16_bf16(PAF(3),VFR(7),o[1],0,0,0), C1,12); \
    }while(0)
  int t=1;
  #undef CMASK
  #define CMASK(P0,P1,t) do{}while(0)
  for(;t+5<NT;t+=2){
    STEP(pB0,pB1,pA0,pA1,t,true,true,true);     WAIT_BAR(2); RESC(); ROT();
    STEP(pA0,pA1,pB0,pB1,t+1,true,true,true);   WAIT_BAR(2); RESC(); ROT();
  }
  #undef CMASK
  #define CMASK(P0,P1,t) do{}while(0)
  #define ENDW(tt) do{ if((tt)+3<NT){WAIT_BAR(2);} else if((tt)+2<NT){WAIT_BAR(1);} else {WAIT_BAR(0);} }while(0)
  for(;t+1<NT;t+=2){
    STEP(pB0,pB1,pA0,pA1,t,(t+3<NT),(t+1<NT),(t+1<NT));       ENDW(t);   RESC(); ROT();
    STEP(pA0,pA1,pB0,pB1,t+1,(t+4<NT),(t+2<NT),(t+2<NT));     ENDW(t+1); RESC(); ROT();
  }
  STEP(pB0,pB1,pA0,pA1,NT-1,false,false,false); RESC();
  { float sacc=pB0[0]+pB0[1]; _Pragma("unroll") for(int r=2;r<16;++r)sacc+=pB0[r]; _Pragma("unroll") for(int r=0;r<16;++r)sacc+=pB1[r]; l_reg+=sacc;
    pw0=(u32x4){PKW(pB0,0),PKW(pB0,2),PKW(pB0,4),PKW(pB0,6)};pw1=(u32x4){PKW(pB0,8),PKW(pB0,10),PKW(pB0,12),PKW(pB0,14)};pw2=(u32x4){PKW(pB1,0),PKW(pB1,2),PKW(pB1,4),PKW(pB1,6)};pw3=(u32x4){PKW(pB1,8),PKW(pB1,10),PKW(pB1,12),PKW(pB1,14)};
    SBAR(); pv(o,vb0+sl_cur,PAF(0),PAF(1),PAF(2),PAF(3)); }
  #undef PKW
  #undef PAF
  #undef VFR
  #undef PIN
  #undef MX3
  #undef GAPA
  #undef GAPB
  #undef EX
  #undef VRD
  #undef KRD
  #undef STEP
  #undef ENDW
  {auto rr=__builtin_amdgcn_permlane32_swap(__float_as_uint(l_reg),__float_as_uint(l_reg),false,false);l_reg=__uint_as_float(rr[0])+__uint_as_float(rr[1]);}
  if(hi==0)wsf[32+r32]=l_reg;asm volatile("s_waitcnt lgkmcnt(0)":::"memory");
  float rli[16];
  #pragma unroll
  for(int r=0;r<16;++r)rli[r]=__builtin_amdgcn_rcpf(wsf[32+crow(r,hi)]);
  bf16*Ow=O+(rowbase+q0+wid*QBLK)*OPITCH+512+h*D; float*Sw=SSQA+(rowbase+q0+wid*QBLK)*16+h;
  { bf16*stg=(bf16*)(shm+LDS_OST)+wid*2048;
    #pragma unroll
    for(int r=0;r<16;++r){const int orow=crow(r,hi);
      #pragma unroll
      for(int d0=0;d0<2;++d0)stg[orow*64+d0*32+r32]=__float2bfloat16(o[d0][r]*rli[r]);}
    asm volatile("s_waitcnt lgkmcnt(0)":::"memory");
    #pragma unroll
    for(int i=0;i<4;++i){const int row=i*8+(lane>>3),ch=lane&7; const u32x4 v=*(const u32x4*)(stg+row*64+ch*8); ATTN_STORE16(Ow+(long)row*OPITCH+ch*8,v);
      float ss=0.f; for(int e=0;e<4;++e){const float lo_=__uint_as_float(v[e]<<16),hi_=__uint_as_float(v[e]&0xffff0000u); ss+=lo_*lo_+hi_*hi_;}
      ss+=__shfl_xor(ss,1); ss+=__shfl_xor(ss,2); ss+=__shfl_xor(ss,4); if(ch==0)Sw[(long)row*16]=ss; } }
  asm volatile("s_waitcnt lgkmcnt(0)\n\ts_barrier":::"memory");
  #undef DMA_K
  #undef DMA_V
  #undef CMASK
  #undef START
  #undef RESC
  #undef ROT
}
constexpr int ATTN_LDS_BYTES=LDS_BYTES;
#undef SBAR
#undef WAIT_BAR
}

#ifdef ATT_NAIVE
__device__ __forceinline__ void attn_naive_unit(const Ctx& c, const Args& a, int b, int h, int qblk) {
    const bf16_t* QR = (const bf16_t*)(a.ws + WS_QRAW); const bf16_t* KV = (const bf16_t*)(a.ws + WS_KV);
    bf16_t* Y = (bf16_t*)(a.ws + WS_Y); float* SSQA = (float*)(a.ws + WS_SSQA);
    float* Ks = (float*)c.lds; float* Vs = Ks + 64 * 64;
    const long row = (long)b * SEQ + qblk * 512 + c.tid; const int kvh = h >> 2;
    float q[64], o[64];
#pragma unroll
    for (int v = 0; v < 8; ++v) { const u32x4 w = *(const u32x4*)(QR + row * 512 + h * 64 + v * 8);
        q[v * 8 + 0] = bflo(w.x); q[v * 8 + 1] = bfhi(w.x); q[v * 8 + 2] = bflo(w.y); q[v * 8 + 3] = bfhi(w.y);
        q[v * 8 + 4] = bflo(w.z); q[v * 8 + 5] = bfhi(w.z); q[v * 8 + 6] = bflo(w.w); q[v * 8 + 7] = bfhi(w.w); }
#pragma unroll
    for (int dd = 0; dd < 64; ++dd) o[dd] = 0.f;
    float mrun = -1e30f, l = 0.f;
    const int lk = c.tid >> 3, lp = c.tid & 7;
    for (int t0 = 0; t0 < SEQ; t0 += 64) {
        __syncthreads();
        { const bf16_t* kp = KV + ((long)b * SEQ + t0 + lk) * 256 + kvh * 64 + lp * 8;
          const u32x4 kw = *(const u32x4*)kp, vw = *(const u32x4*)(kp + 128);
          float* kd = Ks + lk * 64 + lp * 8; float* vd = Vs + lk * 64 + lp * 8;
          kd[0] = bflo(kw.x); kd[1] = bfhi(kw.x); kd[2] = bflo(kw.y); kd[3] = bfhi(kw.y); kd[4] = bflo(kw.z); kd[5] = bfhi(kw.z); kd[6] = bflo(kw.w); kd[7] = bfhi(kw.w);
          vd[0] = bflo(vw.x); vd[1] = bfhi(vw.x); vd[2] = bflo(vw.y); vd[3] = bfhi(vw.y); vd[4] = bflo(vw.z); vd[5] = bfhi(vw.z); vd[6] = bflo(vw.w); vd[7] = bfhi(vw.w); }
        __syncthreads();
#pragma unroll 1
        for (int j = 0; j < 64; ++j) {
            float acc = 0.f; const float* kr = Ks + j * 64;
#pragma unroll
            for (int dd = 0; dd < 64; dd += 4) { const f32x4 kk = *(const f32x4*)(kr + dd); acc += q[dd] * kk[0] + q[dd + 1] * kk[1] + q[dd + 2] * kk[2] + q[dd + 3] * kk[3];
                if ((dd & 15) == 12) __builtin_amdgcn_sched_barrier(0); }
            if (acc > mrun) { const float sc = exp2f(mrun - acc); l *= sc; mrun = acc;
#pragma unroll
                for (int dd = 0; dd < 64; ++dd) o[dd] *= sc; }
            const float p = exp2f(acc - mrun); l += p; const float* vr = Vs + j * 64;
#pragma unroll
            for (int dd = 0; dd < 64; dd += 4) { const f32x4 vv = *(const f32x4*)(vr + dd); o[dd] += p * vv[0]; o[dd + 1] += p * vv[1]; o[dd + 2] += p * vv[2]; o[dd + 3] += p * vv[3];
                if ((dd & 15) == 12) __builtin_amdgcn_sched_barrier(0); }
        }
    }
    const float il = 1.f / l; float ss = 0.f;
#pragma unroll
    for (int v = 0; v < 8; ++v) { float t[8];
#pragma unroll
        for (int e = 0; e < 8; ++e) { t[e] = o[v * 8 + e] * il; ss += t[e] * t[e]; }
        u32x4 w; w.x = pk2(t[0], t[1]); w.y = pk2(t[2], t[3]); w.z = pk2(t[4], t[5]); w.w = pk2(t[6], t[7]);
        *(u32x4*)(Y + row * 1024 + 512 + h * 64 + v * 8) = w; }
    SSQA[row * 16 + h] = ss;
    __syncthreads();
}

#endif
template <int NV> __device__ __forceinline__ float top16(float (&v)[NV], int lane) {
    float res = -INFINITY;
    for (int it = 0; it < 16; ++it) {
        float m = v[0];
#pragma unroll
        for (int i = 1; i < NV; ++i) m = fmaxf(m, v[i]);
        m = wave_max(m);
#pragma unroll
        for (int i = 0; i < NV; ++i) if (v[i] == m) v[i] = -INFINITY;
        if (lane == it) res = m;
    }
    return res;
}
__device__ __forceinline__ float dot8(const u32x4 a, const u32x4 b) {
    return bflo(a.x) * bflo(b.x) + bfhi(a.x) * bfhi(b.x) + bflo(a.y) * bflo(b.y) + bfhi(a.y) * bfhi(b.y)
         + bflo(a.z) * bflo(b.z) + bfhi(a.z) * bfhi(b.z) + bflo(a.w) * bflo(b.w) + bfhi(a.w) * bfhi(b.w);
}
__device__ __forceinline__ void peer_topk(const Ctx& c, const Args& a, int layer, int widx, int nw) {
    const bf16_t* QP = (const bf16_t*)(a.ws + WS_QP);
    const bf16_t* SK1 = (const bf16_t*)(a.ws + WS_LW + (size_t)layer * LW_STRIDE + LW_SK1);
    const bf16_t* SK2 = (const bf16_t*)(a.ws + WS_LW + (size_t)layer * LW_STRIDE + LW_SK2);
    int* SELI = (int*)(a.ws + WS_SELI); float* SELW = (float*)(a.ws + WS_SELW);
    const int lane = c.lane;
    for (int it = widx; it < M * 8; it += nw) {
        const int t = it >> 3, h = it & 7;
        const bf16_t* qrow = QP + (size_t)t * 2048 + h * 256;
        const bf16_t* k1a = SK1 + ((size_t)(h * 128 + lane)) * 128; const bf16_t* k1b = k1a + 64 * 128;
        const bf16_t* k2a = SK2 + ((size_t)(h * 128 + lane)) * 128; const bf16_t* k2b = k2a + 64 * 128;
        float s1[2] = {0.f, 0.f}, s2[2] = {0.f, 0.f};
#pragma unroll 4
        for (int kk = 0; kk < 128; kk += 8) {
            const u32x4 q1 = *(const u32x4*)(qrow + kk), q2 = *(const u32x4*)(qrow + 128 + kk);
            s1[0] += dot8(q1, *(const u32x4*)(k1a + kk)); s1[1] += dot8(q1, *(const u32x4*)(k1b + kk));
            s2[0] += dot8(q2, *(const u32x4*)(k2a + kk)); s2[1] += dot8(q2, *(const u32x4*)(k2b + kk));
        }
        s1[0] = __uint_as_float((__float_as_uint(s1[0]) & ~127u) | (unsigned)lane); s1[1] = __uint_as_float((__float_as_uint(s1[1]) & ~127u) | (unsigned)(lane + 64));
        s2[0] = __uint_as_float((__float_as_uint(s2[0]) & ~127u) | (unsigned)lane); s2[1] = __uint_as_float((__float_as_uint(s2[1]) & ~127u) | (unsigned)(lane + 64));
        const float v1 = top16<2>(s1, lane), v2 = top16<2>(s2, lane);
        float cand[4];
#pragma unroll
        for (int mm = 0; mm < 4; ++mm) {
            const float va = __shfl(v1, (lane >> 4) + 4 * mm), vb = __shfl(v2, lane & 15);
            const unsigned ua = __float_as_uint(va), ub = __float_as_uint(vb);
            const float sum = __uint_as_float(ua & ~127u) + __uint_as_float(ub & ~127u);
            cand[mm] = __uint_as_float((__float_as_uint(sum) & ~16383u) | ((ua & 127u) << 7) | (ub & 127u));
        }
        const float best = top16<4>(cand, lane);
        const unsigned ub = __float_as_uint(best);
        const float sc = __uint_as_float(ub & ~16383u);
        const float mx = __shfl(sc, 0);
        const float e = lane < 16 ? __expf(sc - mx) : 0.f;
        const float sum = wave_sum(e);
        if (lane < 16) { SELI[(size_t)t * 128 + h * 16 + lane] = (int)(ub & 16383u); SELW[(size_t)t * 128 + h * 16 + lane] = e / sum; }
    }
}

typedef float f32x16 __attribute__((ext_vector_type(16)));
#define CE_DESC(x, y) do { const float hi__ = fmaxf(x, y), lo__ = fminf(x, y); x = hi__; y = lo__; } while (0)
__device__ __forceinline__ void sort16_desc(float (&v)[16]) {
#pragma unroll
    for (int k = 2; k <= 16; k <<= 1)
#pragma unroll
        for (int j = k >> 1; j > 0; j >>= 1)
#pragma unroll
            for (int i = 0; i < 16; ++i) { const int l = i ^ j; if (l > i) { if ((i & k) == 0) CE_DESC(v[i], v[l]); else CE_DESC(v[l], v[i]); } }
}
__device__ __forceinline__ void merge16_desc(float (&a)[16], const float (&b)[16]) {
#pragma unroll
    for (int i = 0; i < 16; ++i) a[i] = fmaxf(a[i], b[15 - i]);
#pragma unroll
    for (int j = 8; j > 0; j >>= 1)
#pragma unroll
        for (int i = 0; i < 16; ++i) { const int l = i ^ j; if (l > i) CE_DESC(a[i], a[l]); }
}
__device__ __forceinline__ void merge16_partner(float (&a)[16]) {
    float b[16];
#pragma unroll
    for (int i = 0; i < 16; ++i) b[i] = __shfl_xor(a[i], 32);
    merge16_desc(a, b);
}
__device__ __forceinline__ void peer_topk_fast(const Ctx& c, const Args& a, int layer, int widx, int nw, int only_unit = -1) {
    const bf16_t* QP = (const bf16_t*)(a.ws + WS_QP);
    const bf16_t* SK1 = (const bf16_t*)(a.ws + WS_LW + (size_t)layer * LW_STRIDE + LW_SK1);
    const bf16_t* SK2 = (const bf16_t*)(a.ws + WS_LW + (size_t)layer * LW_STRIDE + LW_SK2);
    int* SELI = (int*)(a.ws + WS_SELI); float* SELW = (float*)(a.ws + WS_SELW);
    const int lane = c.lane, tl = lane & 31, hi = lane >> 5;
    for (int unit = only_unit >= 0 ? only_unit : widx; unit < (M / 32) * 8; unit += nw) {
        const int tg = unit >> 3, h = unit & 7; const long token = (long)tg * 32 + tl;
        float vv[2][16];
#pragma unroll
        for (int half = 0; half < 2; ++half) {
            f32x16 acc[4];
#pragma unroll
            for (int t = 0; t < 4; ++t)
#pragma unroll
                for (int r = 0; r < 16; ++r) acc[t][r] = 0.f;
            const bf16_t* qb = QP + token * 2048 + h * 256 + half * 128 + 8 * hi;
            const bf16_t* kb = (half ? SK2 : SK1) + ((long)(h * 128 + tl)) * 128 + 8 * hi;
#pragma unroll 1
            for (int k4 = 0; k4 < 8; k4 += 4) {
                bf16x8 bq[4], ak[4][4];
#pragma unroll
                for (int u = 0; u < 4; ++u) { bq[u] = *(const bf16x8*)(qb + 16 * (k4 + u));
#pragma unroll
                    for (int t = 0; t < 4; ++t) ak[u][t] = *(const bf16x8*)(kb + (long)t * 32 * 128 + 16 * (k4 + u)); }
#pragma unroll
                for (int u = 0; u < 4; ++u)
#pragma unroll
                    for (int t = 0; t < 4; ++t) acc[t] = __builtin_amdgcn_mfma_f32_32x32x16_bf16(ak[u][t], bq[u], acc[t], 0, 0, 0);
            }
            float L[4][16];
#pragma unroll
            for (int t = 0; t < 4; ++t) {
#pragma unroll
                for (int r = 0; r < 16; ++r) L[t][r] = __uint_as_float((__float_as_uint(acc[t][r]) & ~127u) | (unsigned)(32 * t + (r & 3) + 8 * (r >> 2) + 4 * hi));
                sort16_desc(L[t]);
            }
            merge16_desc(L[0], L[1]); merge16_desc(L[2], L[3]); merge16_desc(L[0], L[2]);
            merge16_partner(L[0]);
#pragma unroll
            for (int i = 0; i < 16; ++i) vv[half][i] = L[0][i];
        }
        float f1[16], f2[16]; unsigned i1[16], i2[16];
#pragma unroll
        for (int i = 0; i < 16; ++i) { const unsigned u1 = __float_as_uint(vv[0][i]), u2 = __float_as_uint(vv[1][i]);
            f1[i] = __uint_as_float(u1 & ~127u); f2[i] = __uint_as_float(u2 & ~127u); i1[i] = (u1 & 127u) << 7; i2[i] = u2 & 127u; }
        float cA[16], cB[16];
#pragma unroll
        for (int i = 0; i < 16; ++i) { cA[i] = -INFINITY; cB[i] = -INFINITY; }
        {
            int n = 0;
#pragma unroll
            for (int aa = 0; aa < 16; ++aa)
#pragma unroll
                for (int bb = 0; bb < 16; ++bb) if ((aa + 1) * (bb + 1) <= 16) {
                    const float s = f1[aa] + f2[bb]; const float pk = __uint_as_float((__float_as_uint(s) & ~16383u) | i1[aa] | i2[bb]);
                    const int slot = n >> 1; const bool mine = ((n & 1) == hi);
                    if (slot < 16) cA[slot] = mine ? pk : cA[slot]; else cB[slot - 16] = mine ? pk : cB[slot - 16];
                    ++n;
                }
        }
        sort16_desc(cA); sort16_desc(cB); merge16_desc(cA, cB); merge16_partner(cA);
        float sc[16], e[16]; float sum = 0.f;
#pragma unroll
        for (int i = 0; i < 16; ++i) { sc[i] = __uint_as_float(__float_as_uint(cA[i]) & ~16383u); e[i] = __expf(sc[i] - sc[0]); sum += e[i]; }
        const float inv = 1.f / sum;
        u32x4 oi[2]; f32x4 ow[2];
#pragma unroll
        for (int i = 0; i < 8; ++i) { const float pk = hi ? cA[8 + i] : cA[i]; const float w = (hi ? e[8 + i] : e[i]) * inv;
            oi[i >> 2][i & 3] = __float_as_uint(pk) & 16383u; ow[i >> 2][i & 3] = w; }
        int* si = SELI + token * 128 + h * 16 + 8 * hi; float* sw = SELW + token * 128 + h * 16 + 8 * hi;
        *(u32x4*)si = oi[0]; *(u32x4*)(si + 4) = oi[1]; *(f32x4*)sw = ow[0]; *(f32x4*)(sw + 4) = ow[1];
        if (only_unit >= 0) break;
    }
}

__device__ __forceinline__ void dec16(const u32x4 w, float (&f)[16]) {
#pragma unroll
    for (int j = 0; j < 4; ++j) { const auto lo = __builtin_amdgcn_cvt_pk_f32_fp8((int)w[j], false); const auto hi = __builtin_amdgcn_cvt_pk_f32_fp8((int)w[j], true);
        f[4 * j + 0] = lo[0]; f[4 * j + 1] = lo[1]; f[4 * j + 2] = hi[0]; f[4 * j + 3] = hi[1]; }
}
__device__ __forceinline__ void peer_gather(const Ctx& c, const Args& a, int layer, int widx, int nw) {
    float* XR = a.out; bf16_t* XN2 = (bf16_t*)(a.ws + WS_XN2);
    const unsigned char* EU = a.ws + WS_EU + (size_t)layer * 16384 * 1024;
    const unsigned char* EV = a.ws + WS_EV + (size_t)layer * 16384 * 1024;
    const float* SCU = (const float*)(a.ws + WS_ESC) + layer * 16384; const float* SCV = SCU + 32768;
    const int* SELI = (const int*)(a.ws + WS_SELI); const float* SELW = (const float*)(a.ws + WS_SELW);
    const float* gf = a.in[I_NFFNG] + layer * D; const float* gp = a.in[I_NPLEG] + layer * D;
    const int lane = c.lane;
    for (int t = widx; t < M; t += nw) {
        float x[16], hh[16], acc[16];
        float* xr = XR + (size_t)t * D + 16 * lane;
        float ss = 0.f;
#pragma unroll
        for (int j = 0; j < 4; ++j) { const f32x4 u0 = *(const f32x4*)(xr + 4 * j);
#pragma unroll
            for (int e = 0; e < 4; ++e) x[4 * j + e] = u0[e]; }
#pragma unroll
        for (int e = 0; e < 16; ++e) { ss += x[e] * x[e]; acc[e] = 0.f; }
        ss = wave_sum(ss);
        const float rstd = rsqrtf(ss * (1.f / D) + EPS);
#pragma unroll
        for (int j = 0; j < 4; ++j) { const f32x4 g4 = *(const f32x4*)(gf + 16 * lane + 4 * j);
#pragma unroll
            for (int e = 0; e < 4; ++e) hh[4 * j + e] = x[4 * j + e] * rstd * g4[e]; }
        const int idxA = SELI[(size_t)t * 128 + lane], idxB = SELI[(size_t)t * 128 + 64 + lane];
        const float wA = SELW[(size_t)t * 128 + lane], wB = SELW[(size_t)t * 128 + 64 + lane];
        const float suA = SCU[idxA], suB = SCU[idxB], svA = SCV[idxA], svB = SCV[idxB];
#pragma unroll 1
        for (int hf = 0; hf < 2; ++hf) {
            const int idxv = hf ? idxB : idxA; const float wv = hf ? wB : wA, suv = hf ? suB : suA, svv = hf ? svB : svA;
#pragma unroll 1
            for (int k0 = 0; k0 < 64; k0 += 8) {
                u32x4 ur[8], vr[8]; float w[8], su[8], sv[8];
#pragma unroll
                for (int r = 0; r < 8; ++r) {
                    const int e = __builtin_amdgcn_readlane(idxv, k0 + r);
                    w[r] = __uint_as_float(__builtin_amdgcn_readlane(__float_as_uint(wv), k0 + r));
                    su[r] = __uint_as_float(__builtin_amdgcn_readlane(__float_as_uint(suv), k0 + r));
                    sv[r] = __uint_as_float(__builtin_amdgcn_readlane(__float_as_uint(svv), k0 + r));
                    ur[r] = *(const u32x4*)(EU + (size_t)e * D + 16 * lane); vr[r] = *(const u32x4*)(EV + (size_t)e * D + 16 * lane);
                }
#pragma unroll
                for (int r = 0; r < 8; ++r) {
                    float f[16]; dec16(ur[r], f);
                    float d = 0.f;
#pragma unroll
                    for (int e = 0; e < 16; ++e) d += hh[e] * f[e];
                    d = wave_sum(d) * su[r];
                    const float av = gelu_tanh(d) * w[r] * sv[r];
                    dec16(vr[r], f);
#pragma unroll
                    for (int e = 0; e < 16; ++e) acc[e] += av * f[e];
                }
            }
        }
        float s2 = 0.f;
#pragma unroll
        for (int e = 0; e < 16; ++e) { x[e] += acc[e]; s2 += x[e] * x[e]; }
        s2 = wave_sum(s2);
        const float rstd2 = rsqrtf(s2 * (1.f / D) + EPS);
#pragma unroll
        for (int j = 0; j < 4; ++j) *(f32x4*)(xr + 4 * j) = (f32x4){x[4 * j + 0], x[4 * j + 1], x[4 * j + 2], x[4 * j + 3]};
        float y[16];
#pragma unroll
        for (int j = 0; j < 4; ++j) { const f32x4 g4 = *(const f32x4*)(gp + 16 * lane + 4 * j);
#pragma unroll
            for (int e = 0; e < 4; ++e) y[4 * j + e] = x[4 * j + e] * rstd2 * g4[e]; }
        u32x4 o0, o1; o0.x = pk2(y[0], y[1]); o0.y = pk2(y[2], y[3]); o0.z = pk2(y[4], y[5]); o0.w = pk2(y[6], y[7]);
        o1.x = pk2(y[8], y[9]); o1.y = pk2(y[10], y[11]); o1.z = pk2(y[12], y[13]); o1.w = pk2(y[14], y[15]);
        *(u32x4*)(XN2 + (size_t)t * D + 16 * lane) = o0; *(u32x4*)(XN2 + (size_t)t * D + 16 * lane + 8) = o1;
    }
}

#define DPP_ADD(v, ctrl, rmask) v += __uint_as_float(__builtin_amdgcn_update_dpp(0u, __float_as_uint(v), ctrl, rmask, 0xf, true))
__device__ __forceinline__ float wave_sum_dpp(float v) {
    DPP_ADD(v, 0x111, 0xf); DPP_ADD(v, 0x112, 0xf); DPP_ADD(v, 0x114, 0xf); DPP_ADD(v, 0x118, 0xf); DPP_ADD(v, 0x142, 0xa); DPP_ADD(v, 0x143, 0xc);
    return __uint_as_float(__builtin_amdgcn_readlane(__float_as_uint(v), 63));
}
struct GrpSplit { int grp, G, gwave, nwave; };
__device__ __forceinline__ GrpSplit grp_split(const Ctx& c) { GrpSplit s; s.G = c.nblk < 8 ? c.nblk : 8; s.grp = c.blk % s.G; const int rank = c.blk / s.G, cnt = (c.nblk - s.grp + s.G - 1) / s.G;
    s.gwave = rank * 8 + c.wave; s.nwave = cnt * 8; return s; }
#define DPP_ADDC(v, ctrl) v += __uint_as_float(__builtin_amdgcn_update_dpp(0u, __float_as_uint(v), ctrl, 0xf, 0xf, true))
template <bool VSTEP, int MODE = 0>
__device__ __forceinline__ void peer_step(const Ctx& c, const Args& a, int layer, bf16_t* XB) {
    float* SSQ2 = (float*)(a.ws + WS_SSQS); const float* SSQ1 = (const float*)(a.ws + WS_SSQ1);
    const unsigned char* ET = a.ws + (VSTEP ? WS_EV : WS_EU) + (size_t)layer * 16384 * 1024;
    const int* SELI = (const int*)(a.ws + WS_SELI); const float* AOUT = (const float*)(a.ws + WS_AOUT); float* DP = (float*)(a.ws + WS_QP);
    const float* gf = a.in[I_NFFNG] + layer * D;
    const int lane = c.lane, sub = lane >> 3, ch = lane & 7; const GrpSplit gs = grp_split(c);
#define PS_LOADIX(ix_, tt) do { const u32x4* ip_ = (const u32x4*)(SELI + (size_t)(tt) * 128 + 16 * sub); ix_[0] = ip_[0]; ix_[1] = ip_[1]; ix_[2] = ip_[2]; ix_[3] = ip_[3]; } while (0)
#define PS_LOADOPS(raw_, q_, tt) do { \
        if (VSTEP) { const u32x4* ap_ = (const u32x4*)(AOUT + (size_t)(tt) * 128 + 16 * sub); raw_[0] = ap_[0]; raw_[1] = ap_[1]; raw_[2] = ap_[2]; raw_[3] = ap_[3]; } \
        else { raw_[0] = *(const u32x4*)(XB + (size_t)(tt) * D + 128 * p + 16 * ch); raw_[1] = *(const u32x4*)(XB + (size_t)(tt) * D + 128 * p + 16 * ch + 8); \
               const f32x4* sq_ = (const f32x4*)(SSQ1 + (size_t)(tt) * 16); q_[0] = sq_[0]; q_[1] = sq_[1]; q_[2] = sq_[2]; q_[3] = sq_[3]; } } while (0)
#define PS_SEG(ix_, j_) (*(const u32x4*)(ETp + (unsigned)((ix_)[(j_) >> 2][(j_) & 3] * 1024u + lane_off)))
    for (int p = gs.grp; p < 8; p += gs.G) {
        float g16[16];
        if (!VSTEP) {
#pragma unroll
            for (int j = 0; j < 4; ++j) { const f32x4 g4 = *(const f32x4*)(gf + 128 * p + 16 * ch + 4 * j); g16[4 * j] = g4[0]; g16[4 * j + 1] = g4[1]; g16[4 * j + 2] = g4[2]; g16[4 * j + 3] = g4[3]; }
        }
        int t = gs.gwave;
        if (t >= M) continue;
        const unsigned char* ETp = ET + 128 * p; const unsigned lane_off = 16u * (unsigned)ch;
        u32x4 ring[16], nix[4], nnix[4], craw[4], nraw[4]; f32x4 cq[4], nq[4];
        { u32x4 cix[4]; PS_LOADIX(cix, t); PS_LOADOPS(craw, cq, t);
#pragma unroll
          for (int j = 0; j < 16; ++j) ring[j] = PS_SEG(cix, j); }
        { const int t1 = t + gs.nwave < M ? t + gs.nwave : t; PS_LOADIX(nix, t1); }
#pragma unroll 1
        for (;;) {
            const int tn = t + gs.nwave, tnn = tn + gs.nwave; const bool has_next = tn < M;
            { const int tc = has_next ? tn : t, tcc = tnn < M ? tnn : t; PS_LOADOPS(nraw, nq, tc); PS_LOADIX(nnix, tcc); }
            unsigned xrw = 0u;
            if (VSTEP) xrw = *(const unsigned*)(XB + (size_t)t * D + 128 * p + 16 * ch + 2 * sub);
            float hx[16]; f32x4 cav[4];
            if (!VSTEP) {
                const float rstd = rsqrtf(((cq[0][0] + cq[0][1] + cq[0][2] + cq[0][3]) + (cq[1][0] + cq[1][1] + cq[1][2] + cq[1][3]) + (cq[2][0] + cq[2][1] + cq[2][2] + cq[2][3]) + (cq[3][0] + cq[3][1] + cq[3][2] + cq[3][3])) * (1.f / D) + EPS);
#pragma unroll
                for (int w = 0; w < 2; ++w)
#pragma unroll
                    for (int e = 0; e < 4; ++e) { hx[8 * w + 2 * e] = bflo(craw[w][e]) * rstd * g16[8 * w + 2 * e]; hx[8 * w + 2 * e + 1] = bfhi(craw[w][e]) * rstd * g16[8 * w + 2 * e + 1]; }
            } else {
#pragma unroll
                for (int j = 0; j < 4; ++j) cav[j] = __builtin_bit_cast(f32x4, craw[j]);
            }
            typedef float f32x2_ __attribute__((ext_vector_type(2)));
            float acc[16]; f32x2_ acc2[8];
#pragma unroll
            for (int e = 0; e < 16; ++e) acc[e] = 0.f;
#pragma unroll
            for (int e = 0; e < 8; ++e) acc2[e] = (f32x2_){0.f, 0.f};
#define PS_PIN() do { if (VSTEP) asm volatile("" : "+v"(acc2[0]), "+v"(acc2[1]), "+v"(acc2[2]), "+v"(acc2[3]), "+v"(acc2[4]), "+v"(acc2[5]), "+v"(acc2[6]), "+v"(acc2[7])); \
        else asm volatile("" : "+v"(acc[0]), "+v"(acc[1]), "+v"(acc[2]), "+v"(acc[3]), "+v"(acc[4]), "+v"(acc[5]), "+v"(acc[6]), "+v"(acc[7]), "+v"(acc[8]), "+v"(acc[9]), "+v"(acc[10]), "+v"(acc[11]), "+v"(acc[12]), "+v"(acc[13]), "+v"(acc[14]), "+v"(acc[15])); __builtin_amdgcn_sched_barrier(0); } while (0)
#pragma unroll
            for (int j = 0; j < 16; ++j) {
                if (MODE == 1) { acc[j] += __uint_as_float((ring[j][0] ^ ring[j][1] ^ ring[j][2] ^ ring[j][3]) & 0x3fffffffu); }
                else {
                f32x2_ f2[8];
#pragma unroll
                for (int w = 0; w < 4; ++w) { f2[2 * w] = __builtin_amdgcn_cvt_pk_f32_fp8((int)ring[j][w], false); f2[2 * w + 1] = __builtin_amdgcn_cvt_pk_f32_fp8((int)ring[j][w], true); }
                if (VSTEP) { const float av_ = cav[j >> 2][j & 3]; const f32x2_ av2 = (f32x2_){av_, av_};
#pragma unroll
                    for (int i = 0; i < 8; ++i) acc2[i] = __builtin_elementwise_fma(av2, f2[i], acc2[i]); }
                else { f32x2_ d0 = (f32x2_){hx[0], hx[1]} * f2[0], d1 = (f32x2_){hx[2], hx[3]} * f2[1];
#pragma unroll
                    for (int i = 2; i < 8; i += 2) { d0 = __builtin_elementwise_fma((f32x2_){hx[2 * i], hx[2 * i + 1]}, f2[i], d0); d1 = __builtin_elementwise_fma((f32x2_){hx[2 * i + 2], hx[2 * i + 3]}, f2[i + 1], d1); }
                    const f32x2_ ds = d0 + d1; float d = ds[0] + ds[1];
                    DPP_ADDC(d, 0xB1); DPP_ADDC(d, 0x4E); DPP_ADDC(d, 0x141); acc[j] = d; } }
                if (MODE != 2) ring[j] = PS_SEG(nix, j);
                if ((j & 1) == 1) PS_PIN();
            }
            if (!VSTEP) {
                if (ch == 0) { f32x4* dp = (f32x4*)(DP + ((size_t)t * 8 + p) * 128 + 16 * sub);
#pragma unroll
                    for (int j = 0; j < 4; ++j) dp[j] = (f32x4){acc[4 * j], acc[4 * j + 1], acc[4 * j + 2], acc[4 * j + 3]}; }
            } else {
#pragma unroll
                for (int i = 0; i < 8; ++i) { acc[2 * i] = acc2[i][0]; acc[2 * i + 1] = acc2[i][1]; }
                float r8[8], r4[4], r2[2];
#pragma unroll
                for (int i = 0; i < 8; ++i) { const auto rr = __builtin_amdgcn_permlane32_swap(__float_as_uint(acc[i]), __float_as_uint(acc[i + 8]), false, false); r8[i] = __uint_as_float(rr[0]) + __uint_as_float(rr[1]); }
#pragma unroll
                for (int i = 0; i < 4; ++i) { const auto rr = __builtin_amdgcn_permlane16_swap(__float_as_uint(r8[i]), __float_as_uint(r8[i + 4]), false, false); r4[i] = __uint_as_float(rr[0]) + __uint_as_float(rr[1]); }
                const bool b3 = (lane & 8) != 0;
#pragma unroll
                for (int i = 0; i < 2; ++i) { const float keep = b3 ? r4[i + 2] : r4[i], send = b3 ? r4[i] : r4[i + 2];
                    r2[i] = keep + __uint_as_float(__builtin_amdgcn_update_dpp(0u, __float_as_uint(send), 0x128, 0xf, 0xf, true)); }
                const unsigned ow = pk2(r2[0] + bflo(xrw), r2[1] + bfhi(xrw));
                const float y0 = bflo(ow), y1 = bfhi(ow);
                const float s2 = wave_sum_dpp(y0 * y0 + y1 * y1);
                *(unsigned*)(XB + (size_t)t * D + 128 * p + 16 * ch + 2 * sub) = ow;
                if (lane == 0) SSQ2[(size_t)t * 16 + p] = s2;
            }
            if (!has_next) break;
#pragma unroll
            for (int j = 0; j < 4; ++j) { nix[j] = nnix[j]; craw[j] = nraw[j]; if (!VSTEP) cq[j] = nq[j]; }
            t = tn;
        }
    }
#undef PS_LOADIX
#undef PS_LOADOPS
#undef PS_SEG
#undef PS_PIN
}
__device__ __forceinline__ void peer_combine(const Ctx& c, const Args& a, int layer) {
    const float* SCU = (const float*)(a.ws + WS_ESC) + layer * 16384; const float* SCV = SCU + 32768;
    const int* SELI = (const int*)(a.ws + WS_SELI); const float* SELW = (const float*)(a.ws + WS_SELW); float* AOUT = (float*)(a.ws + WS_AOUT); const float* DP = (const float*)(a.ws + WS_QP);
    const size_t n4 = (size_t)M * 32, stride = (size_t)c.nblk * 512;
    for (size_t v0 = (size_t)c.blk * 512 + c.tid; v0 < n4; v0 += 2 * stride) {
        f32x4 s[2]; u32x4 ix[2]; f32x4 w[2]; float su[2][4], sv[2][4];
#pragma unroll
        for (int u = 0; u < 2; ++u) { const size_t v = v0 + u * stride < n4 ? v0 + u * stride : v0; const size_t t = v >> 5; const int q = (int)(v & 31) * 4;
            s[u] = *(const f32x4*)(DP + (t * 8) * 128 + q);
#pragma unroll
            for (int p = 1; p < 8; ++p) s[u] += *(const f32x4*)(DP + (t * 8 + p) * 128 + q);
            ix[u] = *(const u32x4*)(SELI + t * 128 + q); w[u] = *(const f32x4*)(SELW + t * 128 + q);
#pragma unroll
            for (int e = 0; e < 4; ++e) { su[u][e] = SCU[ix[u][e]]; sv[u][e] = SCV[ix[u][e]]; } }
#pragma unroll
        for (int u = 0; u < 2; ++u) { const size_t v = v0 + u * stride; if (v >= n4) break; const size_t t = v >> 5; const int q = (int)(v & 31) * 4;
            f32x4 o;
#pragma unroll
            for (int e = 0; e < 4; ++e) o[e] = gelu_tanh(s[u][e] * su[u][e]) * w[u][e] * sv[u][e];
            *(f32x4*)(AOUT + t * 128 + q) = o; }
    }
}

__device__ __forceinline__ void final_norm(const Ctx& c, const Args& a, int widx, int nw) {
    const float* gfin = a.in[I_FING]; const bf16_t* XB = (const bf16_t*)(a.ws + WS_XB);
    for (int m0 = widx; m0 < M; m0 += 2 * nw) {
        u32x4 w[2][2];
#pragma unroll
        for (int u = 0; u < 2; ++u) { const int m = m0 + u * nw < M ? m0 + u * nw : m0; const u32x4* xr = (const u32x4*)(XB + (size_t)m * D + 16 * c.lane); w[u][0] = xr[0]; w[u][1] = xr[1]; }
#pragma unroll
        for (int u = 0; u < 2; ++u) { const int m = m0 + u * nw; if (m >= M) break;
            float x[16]; float s = 0.f;
#pragma unroll
            for (int j = 0; j < 2; ++j)
#pragma unroll
                for (int e = 0; e < 4; ++e) { x[8 * j + 2 * e] = bflo(w[u][j][e]); x[8 * j + 2 * e + 1] = bfhi(w[u][j][e]); }
#pragma unroll
            for (int e = 0; e < 16; ++e) s += x[e] * x[e];
            s = wave_sum(s); const float rstd = rsqrtf(s * (1.f / D) + EPS);
            f32x4* orow = (f32x4*)(a.out + (size_t)m * D + 16 * c.lane);
#pragma unroll
            for (int j = 0; j < 4; ++j) { const f32x4 gg = *(const f32x4*)(gfin + 16 * c.lane + 4 * j); orow[j] = (f32x4){x[4 * j] * rstd * gg[0], x[4 * j + 1] * rstd * gg[1], x[4 * j + 2] * rstd * gg[2], x[4 * j + 3] * rstd * gg[3]}; } }
    }
}

__global__ void __launch_bounds__(512, 2) mk_fwd(Args a) {
    extern __shared__ __attribute__((aligned(16))) unsigned char lds[];
    Ctx c0; c0.tid = threadIdx.x; c0.lane = c0.tid & 63; c0.wave = __builtin_amdgcn_readfirstlane(c0.tid >> 6); c0.blk = blockIdx.x; c0.nblk = gridDim.x; c0.lds = lds;
    const Ctx& c = c0;
    volatile LAS unsigned* MISC = (volatile LAS unsigned*)((LAS unsigned char*)lds + MISC_OFF);
    for (int u = c.tid; u < (LDS_BYTES - LDSCTL_OFF) / 4; u += 512) ((LAS unsigned*)((LAS unsigned char*)lds + LDSCTL_OFF))[u] = 0u;
    __syncthreads();
    const bool multi = (a.ph_hi - a.ph_lo) > 1;
    XcdBarrier bar; bar.bar = (unsigned*)(a.ws + WS_CTL) + CW_BAR; bar.x = 0; bar.st = nullptr;
    if (multi) bar = xcd_barrier_post((unsigned*)(a.ws + WS_CTL) + CW_BAR, MISC + 8);
    const int gw = c.blk * 8 + c.wave, NGW = c.nblk * 8;

#define IN(k) (lo <= (k) && (k) < hi)
#define FRESH() Ctx c = c0; { int t_ = c0.tid; asm volatile("" : "+v"(t_)); c.tid = t_; c.lane = t_ & 63; int w_ = c0.wave; asm volatile("" : "+s"(w_)); c.wave = w_; int b_ = c0.blk; asm volatile("" : "+s"(b_)); c.blk = b_; int n_ = c0.nblk; asm volatile("" : "+s"(n_)); c.nblk = n_; }
#define GRIDBAR() do { XcdBarrier b_ = bar; unsigned* p_ = b_.bar; asm volatile("" : "+s"(p_)); b_.bar = p_; xcd_barrier(b_); } while (0)
#ifdef PROBE_PH
#define PROBE_STAMP(slot) do { if (blockIdx.x == 0 && threadIdx.x == 0) ((unsigned long long*)(a.ws + WS_CTL + 48 * 1024))[slot] = __builtin_amdgcn_s_memrealtime(); } while (0)
#define SEAM(k) do { if ((k) == PROBE_PH - 1) { if (IN(k) && IN((k) + 1)) GRIDBAR(); PROBE_STAMP(0); } else if ((k) == PROBE_PH) { if (IN(k) && IN((k) + 1)) GRIDBAR(); PROBE_STAMP(1); } else { if (IN(k) && IN((k) + 1)) GRIDBAR(); } } while (0)
#else
#define SEAM(k) do { if (IN(k) && IN((k) + 1)) GRIDBAR(); } while (0)
#endif
    const int lo = a.ph_lo, hi = a.ph_hi;
#ifdef PROBE_PH
    if (PROBE_PH == 0) PROBE_STAMP(0);
#endif
    if (IN(0)) {
        FRESH();
        p0_prologue(c, a);
    }
    SEAM(0);
#pragma unroll 1
    for (int layer = 0; layer < 2; ++layer) {
        const int pb = 1 + 11 * layer;
        unsigned char* lw = a.ws + WS_LW + (size_t)layer * LW_STRIDE;
        unsigned char* xbc = a.ws + (layer & 1 ? WS_XB2 : WS_XB); unsigned char* xbn = a.ws + (layer & 1 ? WS_XB : WS_XB2);
        if (IN(pb + 0)) {
            FRESH();
            GemmD g; g.A = (const bf16_t*)xbc; g.lda = D; g.Bt = (const bf16_t*)(lw + LW_WIN); g.ldb = D; g.K = D; g.kmid = -1;
            EpiInproj E; E.ssq0 = (const float*)(a.ws + WS_SSQ0); E.ucat = (bf16_t*)(a.ws + WS_UCAT); E.qraw = (bf16_t*)(a.ws + WS_QRAW); E.kv = (bf16_t*)(a.ws + WS_KV);
            gemm_phase_dense(c, g, M / 256, c.nblk == 256 ? 4 : DIN / 256, E);
            if (layer == 0 && c.nblk != 256) {}
        }
        SEAM(pb + 0);
        if (IN(pb + 1)) {
            FRESH();
            if (c.nblk == 256) {
                if (c.blk < 64) s1_unit(c, a, layer, c.blk);
                else if (c.blk < 128) {
                    GemmD g; g.A = (const bf16_t*)xbc; g.lda = D; g.Bt = (const bf16_t*)(lw + LW_WIN); g.ldb = D; g.K = D; g.kmid = -1;
                    EpiInproj E; E.ssq0 = (const float*)(a.ws + WS_SSQ0); E.ucat = (bf16_t*)(a.ws + WS_UCAT); E.qraw = (bf16_t*)(a.ws + WS_QRAW); E.kv = (bf16_t*)(a.ws + WS_KV);
                    pg8::OneUnit S; S.u.pm = c.blk - 64; S.u.pn = 4; run_gemm(c.lds, g, S, E, c.tid);
                    VM_WAIT(); __syncthreads();
                    qkprep(c, a, layer, c.wave, 8, 2, (c.blk - 64) * 256);
                    if (layer == 0) cvt_fp8_layer(c, a, 1, (c.blk - 64) * 8 + c.wave, 192 * 8);
                } else {
                    qkprep(c, a, layer, (c.blk - 128) * 8 + c.wave, 128 * 8, 1);
                    if (layer == 0) cvt_fp8_layer(c, a, 1, (c.blk - 64) * 8 + c.wave, 192 * 8);
                }
            } else if (c.nblk > 64) {
                if (c.blk < 64) s1_unit(c, a, layer, c.blk);
                else qkprep(c, a, layer, (c.blk - 64) * 8 + c.wave, (c.nblk - 64) * 8);
            } else {
                for (int u = c.blk; u < 64; u += c.nblk) s1_unit(c, a, layer, u);
                qkprep(c, a, layer, gw, NGW);
            }
        }
        SEAM(pb + 1);
        if (IN(pb + 2)) {
            FRESH();
            GemmD g; g.A = (const bf16_t*)(a.ws + WS_UCAT); g.lda = KCAT; g.Bt = (const bf16_t*)(lw + LW_WY); g.ldb = KCAT; g.K = KCAT; g.kmid = -1;
            EpiS2 E; E.G = (bf16_t*)(a.ws + WS_G);
#ifdef USE_SGEMM
            for (int ui = c.blk; ui < 128; ui += c.nblk) { Unit u; u.pm = ui >> 1; u.pn = (ui >> 2) * 2 + (ui & 1); sgemm_unit(g, u, E, c.wave, c.lane); }
#else
            { pg8::S2Order S; S.blk = c.blk; S.nblk = c.nblk; run_gemm(c.lds, g, S, E, c.tid); }
#endif
#ifdef ATT_NAIVE
            for (int ui = c.blk; ui < 256; ui += c.nblk) attn_naive_unit(c, a, ui >> 7, (ui >> 4) & 7, ui & 15);
#else
            float mfix = 0.f;
            {
                float gq = 0.f, gk = 0.f;
                for (int d = 0; d < 64; ++d) { gq = fmaxf(gq, fabsf(a.in[I_QNG][layer * 64 + d])); gk = fmaxf(gk, fabsf(a.in[I_KNG][layer * 64 + d])); }
                mfix = 64.f * gq * gk * C2 * 1.02f;
            }
            for (int ui = c.blk; ui < 512; ui += c.nblk) {
                int ab, ah, aq;
                if (c.nblk == 256) { const int bl = ui & 255, vcu = (bl & 7) * 32 + (bl >> 3), combo = (ui >> 8) * 2 + (vcu >> 7), w = vcu & 127; ab = combo >> 1; ah = (combo & 1) * 4 + (w >> 5); aq = w & 31; }
                else { ab = ui >> 8; ah = (ui >> 5) & 7; aq = ui & 31; }
                attn_body::attn_unit<ATT_THRL>(ab, ah, aq, (const attn_body::bf16*)(a.ws + WS_QRAW), (const attn_body::bf16*)(a.ws + WS_KV), (attn_body::bf16*)(a.ws + WS_Y), (float*)(a.ws + WS_SSQA), (char*)lds, c.tid, mfix);
            }
#endif
        }
        SEAM(pb + 2);
        if (IN(pb + 3)) {
            FRESH();
            GemmD g; g.A = (const bf16_t*)(a.ws + WS_G); g.lda = 512; g.Bt = (const bf16_t*)(lw + LW_WGLU); g.ldb = 512; g.K = 512; g.kmid = -1;
            EpiGlu E; E.G = (const bf16_t*)(a.ws + WS_G); E.bglu = a.in[I_BGLU] + layer * 512; E.Y = (bf16_t*)(a.ws + WS_Y); E.ssqs = (float*)(a.ws + WS_SSQS);
            GemmD g1; g1.A = (const bf16_t*)(a.ws + WS_PB) + (size_t)layer * M * 256; g1.lda = 256; g1.Bt = (const bf16_t*)(lw + LW_WPROJ); g1.ldb = 256; g1.K = 256; g1.kmid = -1;
            EpiProj E1; E1.pr = (bf16_t*)(a.ws + WS_PRB);
            if (c.nblk >= 256) { if (c.blk < 128) gemm_phase_sub(c, g, M / 256, 2, E, 128, c.blk); else if (c.blk < 256) gemm_phase_sub(c, g1, M / 256, 4, E1, 128, c.blk - 128); }
            else { gemm_phase_dense(c, g, M / 256, 2, E); gemm_phase_dense(c, g1, M / 256, 4, E1); }
        }
        SEAM(pb + 3);
        if (IN(pb + 4)) {
            FRESH();
            GemmD g; g.A = (const bf16_t*)(a.ws + WS_Y); g.lda = D; g.Bt = (const bf16_t*)(lw + LW_WOUT); g.ldb = D; g.K = D; g.kmid = 512;
            float* RS = (float*)(a.ws + WS_RS);
            { const float* ssqs = (const float*)(a.ws + WS_SSQS); const float* ssqa = (const float*)(a.ws + WS_SSQA);
              pg8::StaticOrder S0; S0.init(M, D, c.nblk, c.blk); Unit u0;
              for (int i = 0; S0.next(i, u0); ++i) if (c.tid < 256) { const int row = u0.pm * 256 + c.tid;
                  const float s = rsqrtf(sumn(ssqs + (long)row * 16, 8) * (1.f / 512.f) + EPS), t = rsqrtf(sumn(ssqa + (long)row * 16, 8) * (1.f / 512.f) + EPS);
                  RS[(long)row * 2] = s / t; RS[(long)row * 2 + 1] = t; }
              VM_WAIT(); __syncthreads(); }
            EpiOut E; E.rs = RS; E.xb = (bf16_t*)xbc; E.ssq1 = (float*)(a.ws + WS_SSQ1);
            gemm_phase_dense(c, g, M / 256, 4, E);
        }
        SEAM(pb + 4);
        if (IN(pb + 5)) {
            FRESH();
            GemmD g; g.A = (const bf16_t*)xbc; g.lda = D; g.Bt = (const bf16_t*)(lw + LW_WQ); g.ldb = D; g.K = D; g.kmid = -1;
            EpiQ E; E.ssq1 = (const float*)(a.ws + WS_SSQ1); E.qp = (bf16_t*)(a.ws + WS_QP);
            gemm_phase_dense(c, g, M / 256, 8, E);
            VM_WAIT(); __syncthreads();
            { pg8::StaticOrder S0; S0.init(M, 2048, c.nblk, c.blk); Unit u0;
              for (int i = 0; S0.next(i, u0); ++i) peer_topk_fast(c, a, layer, 0, 1 << 30, (u0.pm * 8 + c.wave) * 8 + u0.pn); }
        }
        SEAM(pb + 5);
        if (IN(pb + 7)) {
            FRESH();
#ifdef EXP_MODE
            peer_step<false, EXP_MODE>(c, a, layer, (bf16_t*)xbc);
            VM_WAIT(); __syncthreads();
#endif
            peer_step<false>(c, a, layer, (bf16_t*)xbc);
        }
        SEAM(pb + 7);
        if (IN(pb + 8)) {
            FRESH();
            peer_combine(c, a, layer);
        }
        SEAM(pb + 8);
        if (IN(pb + 9)) {
            FRESH();
            peer_step<true>(c, a, layer, (bf16_t*)xbc);
        }
        SEAM(pb + 9);
        if (IN(pb + 10)) {
            FRESH();
            GemmD g2; g2.A = (const bf16_t*)xbc; g2.lda = D; g2.Bt = (const bf16_t*)(lw + LW_WGATE); g2.ldb = D; g2.K = D; g2.kmid = -1;
            EpiGate E2; E2.pr = (const bf16_t*)(a.ws + WS_PRB); E2.xin = (const bf16_t*)xbc; E2.xout = (bf16_t*)xbn; E2.ssq0 = (float*)(a.ws + WS_SSQ0); E2.ssq2 = (const float*)(a.ws + WS_SSQS);
            gemm_phase_dense(c, g2, M / 256, 4, E2);
        }
        SEAM(pb + 10);
    }
    if (IN(NPHASE - 1)) { FRESH(); final_norm(c, a, gw, NGW); }
#ifdef PROBE_RGN
    if (blockIdx.x == 0 && threadIdx.x == 0) {
        VM_WAIT();
        const unsigned long long* st = (const unsigned long long*)(a.ws + WS_CTL + 48 * 1024);
        const unsigned long long t0 = __hip_atomic_load(st, __ATOMIC_RELAXED, __HIP_MEMORY_SCOPE_AGENT), t1 = __hip_atomic_load(st + 1, __ATOMIC_RELAXED, __HIP_MEMORY_SCOPE_AGENT);
        const unsigned long long span = (t1 > t0 ? t1 - t0 : 0) * PROBE_MULT, s0 = __builtin_amdgcn_s_memrealtime();
        while (__builtin_amdgcn_s_memrealtime() - s0 < span) __builtin_amdgcn_s_sleep(8);
    }
#endif
#ifdef PROBE_PH
    if (blockIdx.x == 0 && threadIdx.x == 0) {
        VM_WAIT();
        const unsigned long long* st = (const unsigned long long*)(a.ws + WS_CTL + 48 * 1024);
        const unsigned long long t0 = __hip_atomic_load(st, __ATOMIC_RELAXED, __HIP_MEMORY_SCOPE_AGENT), t1 = __hip_atomic_load(st + 1, __ATOMIC_RELAXED, __HIP_MEMORY_SCOPE_AGENT);
        const unsigned long long span = (t1 > t0 ? t1 - t0 : 0) * PROBE_MULT, s0 = __builtin_amdgcn_s_memrealtime();
        while (__builtin_amdgcn_s_memrealtime() - s0 < span) __builtin_amdgcn_s_sleep(8);
    }
#endif
#undef IN
#undef SEAM
}

extern "C" void kernel_launch(void* const* d_in, const int* in_sizes, int n_in, void* d_out, int out_size, void* d_ws, size_t ws_size, hipStream_t stream) {
    static int grid = 0;
    if (grid == 0) {
        if (n_in != 29 || in_sizes[0] != M * D || out_size != M * D || in_sizes[3] != 2 * D * DIN || ws_size < WS_END) {
            fprintf(stderr, "kernel_launch: unexpected problem: n_in %d in0 %d in3 %d out %d ws %zu (need %zu); nothing launched\n", n_in, n_in > 0 ? in_sizes[0] : -1, n_in > 3 ? in_sizes[3] : -1, out_size, ws_size, (size_t)WS_END);
            grid = -1; return; }
        int dev = 0, cus = 0, per_cu = 0;
        if (hipGetDevice(&dev) != hipSuccess || hipDeviceGetAttribute(&cus, hipDeviceAttributeMultiprocessorCount, dev) != hipSuccess) { grid = -1; return; }
        if (hipFuncSetAttribute((const void*)mk_fwd, hipFuncAttributeMaxDynamicSharedMemorySize, LDS_BYTES) != hipSuccess) { fprintf(stderr, "kernel_launch: hipFuncSetAttribute failed\n"); grid = -1; return; }
        if (hipOccupancyMaxActiveBlocksPerMultiprocessor(&per_cu, (const void*)mk_fwd, 512, LDS_BYTES) != hipSuccess || per_cu < 1)
            fprintf(stderr, "kernel_launch: note: occupancy query reports %d workgroups per CU\n", per_cu);
        (void)hipGetLastError();
        grid = cus;
    }
    if (grid < 0) return;
    (void)hipMemsetAsync((char*)d_ws + WS_CTL, 0, CTL_ZERO_BYTES, stream);
    Args a{};
    for (int i = 0; i < 29; ++i) a.in[i] = (const float*)d_in[i];
    a.out = (float*)d_out; a.ws = (unsigned char*)d_ws;
    constexpr int NL = MK_N_LAUNCHES;
    for (int li = 0; li < NL; ++li) {
        a.ph_lo = (NPHASE * li) / NL; a.ph_hi = (NPHASE * (li + 1)) / NL;
        hipLaunchKernelGGL(mk_fwd, dim3(grid), dim3(512), LDS_BYTES, stream, a);
    }
}
```

```cpp
#include <hip/hip_runtime.h>
#include <cstdio>
#include <cstdint>

#ifndef ATT_THRL
#define ATT_THRL -1
#endif
#ifndef MK_N_LAUNCHES
#define MK_N_LAUNCHES 1
#endif

#define LAS __attribute__((address_space(3)))
typedef unsigned short bf16_t;
typedef short bf16x8 __attribute__((ext_vector_type(8)));
typedef float f32x4 __attribute__((ext_vector_type(4)));
typedef unsigned u32x4 __attribute__((ext_vector_type(4)));
typedef unsigned u32x2 __attribute__((ext_vector_type(2)));

constexpr int NB = 2, SEQ = 8192, M = NB * SEQ, D = 1024, DIN = 1280;
constexpr int NG = 32, LCH = 32, NCH = SEQ / LCH, KCAT = 768;
constexpr float EPS = 1e-6f;
constexpr float C2 = 0.125f * 1.4426950408889634f;
constexpr int NPHASE = 24;

constexpr size_t MiB = 1u << 20;
constexpr size_t WS_CTL = 0, CTL_ZERO_BYTES = 64 * 1024;
constexpr size_t WS_EU = 1 * MiB, WS_EV = 65 * MiB;
constexpr size_t WS_ESC = 241 * MiB + 256 * 1024;
constexpr size_t WS_LW = 129 * MiB, LW_STRIDE = 48 * MiB;
constexpr size_t LW_WIN = 0, LW_WGLU = 3 * MiB, LW_WOUT = 4 * MiB, LW_WQ = 6 * MiB, LW_SK1 = 10 * MiB, LW_SK2 = 10 * MiB + 512 * 1024,
                 LW_WGATE = 11 * MiB, LW_WPROJ = 13 * MiB, LW_AL = 13 * MiB + 512 * 1024, LW_WE = 14 * MiB, LW_WY = 22 * MiB;
constexpr size_t WS_PB = 225 * MiB, WS_ROPE = 241 * MiB, WS_XB = 242 * MiB, WS_UCAT = 274 * MiB, WS_QRAW = 300 * MiB, WS_KV = 316 * MiB,
                 WS_EBUF = 324 * MiB, WS_G = 340 * MiB, WS_Y = 356 * MiB, WS_SSQS = 388 * MiB, WS_SSQA = 389 * MiB, WS_SSQ0 = 390 * MiB, WS_SSQ1 = 391 * MiB, WS_RS = 241 * MiB + 512 * 1024, WS_PRB = 33 * MiB  ,
                 WS_QP = 392 * MiB  , WS_SELI = 456 * MiB, WS_SELW = 464 * MiB, WS_XN2 = 472 * MiB, WS_AOUT = 472 * MiB  , WS_XB2 = 480 * MiB  , WS_END = 512 * MiB;
constexpr int CW_BAR = 4096;

constexpr int RING_BYTES = 131072, LDSCTL_OFF = RING_BYTES, MISC_OFF = LDSCTL_OFF + 320, LDS_BYTES = 147456;

__device__ __forceinline__ unsigned f2bf(float f) { unsigned u = __float_as_uint(f); return (u + 0x7fffu + ((u >> 16) & 1u)) >> 16; }
__device__ __forceinline__ unsigned pk2(float lo, float hi) { return f2bf(lo) | (f2bf(hi) << 16); }
__device__ __forceinline__ float bflo(unsigned w) { return __uint_as_float(w << 16); }
__device__ __forceinline__ float bfhi(unsigned w) { return __uint_as_float(w & 0xffff0000u); }
__device__ __forceinline__ float bf1(bf16_t h) { return __uint_as_float((unsigned)h << 16); }
__device__ __forceinline__ float wave_sum(float v) {
#pragma unroll
    for (int o = 1; o < 64; o <<= 1) v += __shfl_xor(v, o);
    return v;
}
__device__ __forceinline__ float wave_max(float v) {
#pragma unroll
    for (int o = 1; o < 64; o <<= 1) v = fmaxf(v, __shfl_xor(v, o));
    return v;
}
__device__ __forceinline__ float sigmoidf_(float x) { return 1.f / (1.f + __expf(-x)); }
__device__ __forceinline__ float gelu_tanh(float x) {
    const float z = 0.7978845608028654f * (x + 0.044715f * x * x * x);
    const float e = __expf(2.f * z);
    const float th = 1.f - 2.f / (e + 1.f);
    return 0.5f * x * (1.f + th);
}
__device__ __forceinline__ float sumn(const float* p, int n) { float s = 0.f; for (int i = 0; i < n; ++i) s += p[i]; return s; }
#define LDS_WAIT() asm volatile("s_waitcnt lgkmcnt(0)" ::: "memory")
#define VM_WAIT() asm volatile("s_waitcnt vmcnt(0)" ::: "memory")

#define XB_TMO      128
#define XB_XCNT(j)  (256  + 64 * (j))
#define XB_XSUB(j)  (1280 + 64 * (j))
#define XB_XGEN(j)  (2304 + 64 * (j))
#define XB_TOP      3328
#define XB_TOPGEN   3392
#define XCD_BAR_WORDS 3456
#define XB_SPIN_CAP (1u << 18)
__device__ __forceinline__ unsigned xb_ld(unsigned* p)              { return __hip_atomic_load(p, __ATOMIC_RELAXED, __HIP_MEMORY_SCOPE_AGENT); }
__device__ __forceinline__ unsigned xb_add(unsigned* p, unsigned v) { return __hip_atomic_fetch_add(p, v, __ATOMIC_RELAXED, __HIP_MEMORY_SCOPE_AGENT); }
__device__ __forceinline__ unsigned xb_xcc_id() { return (unsigned)__builtin_amdgcn_s_getreg((3 << 11) | 20) & 0xFu; }
#define XB_SPIN(cond, bar) do { unsigned _sp = 0; while (cond) { __builtin_amdgcn_s_sleep(1); \
    if ((++_sp & 255u) == 0u) { if (xb_ld(&(bar)[XB_TMO])) break; if (_sp > XB_SPIN_CAP) { atomicAdd(&(bar)[XB_TMO], 1u); break; } } } } while (0)
struct XcdBarrier { unsigned* bar; unsigned x; volatile LAS unsigned* st; };
__device__ __forceinline__ XcdBarrier xcd_barrier_post(unsigned* bar, volatile LAS unsigned* st) {
    XcdBarrier b; b.bar = bar; b.x = xb_xcc_id(); b.st = st;
    if (threadIdx.x == 0) (void)xb_add(&bar[XB_XCNT(b.x)], 1u);
    return b;
}
__device__ __forceinline__ void xcd_barrier_complete(unsigned* bar, unsigned x, unsigned& nloc, unsigned& nx) {
    const unsigned G = gridDim.x * gridDim.y * gridDim.z;
    unsigned sum, cnt, mine, sp = 0u;
    for (;;) {
        sum = 0u; cnt = 0u; mine = 0u;
#pragma unroll
        for (unsigned j = 0; j < 16; ++j) { const unsigned c = xb_ld(&bar[XB_XCNT(j)]); sum += c; cnt += (c > 0u) ? 1u : 0u; mine = (j == x) ? c : mine; }
        if (sum == G) break;
        __builtin_amdgcn_s_sleep(1);
        if ((++sp & 255u) == 0u) { if (xb_ld(&bar[XB_TMO])) break; if (sp > XB_SPIN_CAP) { atomicAdd(&bar[XB_TMO], 1u); break; } }
    }
    nloc = mine > 0u ? mine : 1u; nx = cnt > 0u ? cnt : 1u;
}
__device__ __forceinline__ void xcd_barrier(const XcdBarrier& b) {
    asm volatile("s_waitcnt vmcnt(0)" ::: "memory");
    __syncthreads();
    if (threadIdx.x == 0) {
        unsigned* bar = b.bar;
        __builtin_amdgcn_s_waitcnt(0);
        unsigned nloc = b.st[0], nx = b.st[1];
        if (nloc == 0u) { xcd_barrier_complete(bar, b.x, nloc, nx); b.st[0] = nloc; b.st[1] = nx; }
        const unsigned old = xb_add(&bar[XB_XSUB(b.x)], 1u);
        const unsigned gen = old / nloc;
        if (old + 1u == (gen + 1u) * nloc) {
            __builtin_amdgcn_fence(__ATOMIC_RELEASE, "agent");
            asm volatile("s_waitcnt vmcnt(0)" ::: "memory");
            const unsigned og = xb_add(&bar[XB_TOP], 1u);
            const unsigned tg = og / nx;
            if (og + 1u == (tg + 1u) * nx) xb_add(&bar[XB_TOPGEN], 1u);
            else XB_SPIN(xb_ld(&bar[XB_TOPGEN]) == tg, bar);
            __builtin_amdgcn_fence(__ATOMIC_ACQUIRE, "agent");
            xb_add(&bar[XB_XGEN(b.x)], 1u);
            asm volatile("s_waitcnt vmcnt(0)" ::: "memory");
        } else {
            XB_SPIN(xb_ld(&bar[XB_XGEN(b.x)]) == gen, bar);
            __builtin_amdgcn_fence(__ATOMIC_ACQUIRE, "agent");
            asm volatile("s_waitcnt vmcnt(0)" ::: "memory");
        }
    }
    __syncthreads();
}

#ifdef PROBE_RGN
#define RGN(n, e) do { if ((n) == PROBE_RGN && blockIdx.x == PROBE_BLK && threadIdx.x == 0) { asm volatile("s_waitcnt vmcnt(0) lgkmcnt(0)" ::: "memory"); ((unsigned long long*)(rgn_ws + 48 * 1024))[e] = __builtin_amdgcn_s_memrealtime(); } } while (0)
#else
#define RGN(n, e) do {} while (0)
#endif
struct Args { const float* in[29]; float* out; unsigned char* ws; int ph_lo, ph_hi; };
enum { I_X = 0, I_P, I_NMIXG, I_WIN, I_LRE, I_LIM, I_LOGDT, I_BRE, I_BIM, I_CRE, I_CIM, I_DSKIP, I_WGLU, I_BGLU, I_QNG, I_KNG, I_SSMG, I_ATTG, I_WOUT,
       I_NFFNG, I_WQ, I_SK1, I_SK2, I_EU, I_EV, I_NPLEG, I_WGATE, I_WPROJ, I_FING };

struct Ctx { int tid, lane, wave, blk, nblk; unsigned char* lds; };

struct GemmD { const bf16_t* A; long lda; const bf16_t* Bt; long ldb; int K; int kmid; };
struct Unit { int pm, pn; };

template <class Epi>
__device__ __forceinline__ void sgemm_unit(const GemmD& g, const Unit u, const Epi& E, int wave, int lane) {
    const int i = lane & 15, q = lane >> 4;
    const bf16_t* Ab = g.A + (long)(u.pm * 256 + wave * 32) * g.lda;
    const bf16_t* Bb = g.Bt + (long)(u.pn * 256) * g.ldb;
    const int row0 = u.pm * 256 + wave * 32 + i;
    float ssq[2] = {0.f, 0.f};
    float rs[2] = {1.f, 1.f};
    if constexpr (Epi::ROWSCALE) { rs[0] = E.rscale(row0); rs[1] = E.rscale(row0 + 16); }
    for (int cg = 0; cg < 4; ++cg) {
        f32x4 acc[2][4];
#pragma unroll
        for (int mi = 0; mi < 2; ++mi)
#pragma unroll
            for (int ni = 0; ni < 4; ++ni) acc[mi][ni] = (f32x4){0.f, 0.f, 0.f, 0.f};
        for (int k0 = 0; k0 < g.K; k0 += 32) {
            if constexpr (Epi::MID) { if (k0 == g.kmid) {
#pragma unroll
                for (int mi = 0; mi < 2; ++mi) { const float f = E.mid(row0 + 16 * mi);
#pragma unroll
                    for (int ni = 0; ni < 4; ++ni) acc[mi][ni] *= f; } } }
            bf16x8 a[2], b[4];
#pragma unroll
            for (int mi = 0; mi < 2; ++mi) a[mi] = *(const bf16x8*)(Ab + (long)(16 * mi + i) * g.lda + k0 + 8 * q);
#pragma unroll
            for (int ni = 0; ni < 4; ++ni) b[ni] = *(const bf16x8*)(Bb + (long)(cg * 64 + 16 * ni + i) * g.ldb + k0 + 8 * q);
#pragma unroll
            for (int mi = 0; mi < 2; ++mi)
#pragma unroll
                for (int ni = 0; ni < 4; ++ni) acc[mi][ni] = __builtin_amdgcn_mfma_f32_16x16x32_bf16(b[ni], a[mi], acc[mi][ni], 0, 0, 0);
        }
#pragma unroll
        for (int mi = 0; mi < 2; ++mi)
#pragma unroll
            for (int ni = 0; ni < 4; ++ni) {
                const f32x4 v = acc[mi][ni] * rs[mi];
                const f32x4 w = E.put(row0 + 16 * mi, u.pn * 256 + cg * 64 + 16 * ni + 4 * q, v);
                ssq[mi] += w[0] * w[0] + w[1] * w[1] + w[2] * w[2] + w[3] * w[3];
            }
    }
    if constexpr (Epi::SSQ) {
#pragma unroll
        for (int mi = 0; mi < 2; ++mi) { float s = ssq[mi]; s += __shfl_xor(s, 16); s += __shfl_xor(s, 32);
            if (q == 0) { E.ssq(row0 + 16 * mi, u.pn * 4 + 0, s); E.ssq(row0 + 16 * mi, u.pn * 4 + 1, 0.f); E.ssq(row0 + 16 * mi, u.pn * 4 + 2, 0.f); E.ssq(row0 + 16 * mi, u.pn * 4 + 3, 0.f); } }
    }
}

__device__ __forceinline__ u32x2 pack4(f32x4 v) { u32x2 w; w.x = pk2(v[0], v[1]); w.y = pk2(v[2], v[3]); return w; }
__device__ __forceinline__ u32x4 pack8(f32x4 a, f32x4 b) { u32x4 w; w.x = pk2(a[0], a[1]); w.y = pk2(a[2], a[3]); w.z = pk2(b[0], b[1]); w.w = pk2(b[2], b[3]); return w; }
__device__ __forceinline__ void unpack8(u32x4 w, f32x4& a, f32x4& b) { a = (f32x4){bflo(w.x), bfhi(w.x), bflo(w.y), bfhi(w.y)}; b = (f32x4){bflo(w.z), bfhi(w.z), bflo(w.w), bfhi(w.w)}; }

struct EpiInproj {
    static constexpr bool MID = false, ROWSCALE = true, SSQ = false;
    const float* ssq0; bf16_t* ucat; bf16_t* qraw; bf16_t* kv;
    __device__ __forceinline__ float rscale(int row) const { return rsqrtf(sumn(ssq0 + (long)row * 16, 16) * (1.f / D) + EPS); }
    __device__ __forceinline__ f32x4 put(int row, int col, f32x4 v) const {
        const u32x2 w = pack4(v);
        if (col < 512) { const int g = col >> 4, qq = col & 15, b = row >> 13, s = row & (SEQ - 1), c = s >> 5, j = s & 31;
            *(u32x2*)(ucat + ((long)((g * 2 + b) * NCH + c) * KCAT + j * 16 + qq)) = w; }
        else if (col < 1024) *(u32x2*)(qraw + (long)row * 512 + (col - 512)) = w;
        else *(u32x2*)(kv + (long)row * 256 + (col - 1024)) = w;
        return v;
    }
    __device__ __forceinline__ void put8(int row, int col, f32x4 v0, f32x4 v1, f32x4& w0, f32x4& w1) const {
        const u32x4 w = pack8(v0, v1); w0 = v0; w1 = v1;
        if (col < 512) { const int g = col >> 4, qq = col & 15, b = row >> 13, s = row & (SEQ - 1), c = s >> 5, j = s & 31;
            *(u32x4*)(ucat + ((long)((g * 2 + b) * NCH + c) * KCAT + j * 16 + qq)) = w; }
        else if (col < 1024) *(u32x4*)(qraw + (long)row * 512 + (col - 512)) = w;
        else *(u32x4*)(kv + (long)row * 256 + (col - 1024)) = w;
    }
    __device__ __forceinline__ void ssq(int, int, float) const {}
};
struct EpiS1 {
    static constexpr bool MID = false, ROWSCALE = false, SSQ = false;
    float* ebuf;
    __device__ __forceinline__ f32x4 put(int row, int col, f32x4 v) const { *(f32x4*)(ebuf + ((long)row * 256 + (col & 255))) = v; return v; }
    __device__ __forceinline__ void put8(int row, int col, f32x4 v0, f32x4 v1, f32x4& w0, f32x4& w1) const { float* p = ebuf + ((long)row * 256 + (col & 255)); *(f32x4*)p = v0; *(f32x4*)(p + 4) = v1; w0 = v0; w1 = v1; }
    __device__ __forceinline__ void ssq(int, int, float) const {}
};
struct EpiS2 {
    static constexpr bool MID = false, ROWSCALE = false, SSQ = false;
    bf16_t* G;
    __device__ __forceinline__ f32x4 put(int row, int col, f32x4 v) const {
        const int pm = row >> 8, c = row & 255, g = pm >> 1, b = pm & 1, nout = col & 511, j = nout >> 4, p = nout & 15;
        const long tok = (long)b * SEQ + c * LCH + j;
        f32x4 y; y[0] = gelu_tanh(v[0]); y[1] = gelu_tanh(v[1]); y[2] = gelu_tanh(v[2]); y[3] = gelu_tanh(v[3]);
        *(u32x2*)(G + tok * 512 + 16 * g + p) = pack4(y); return v;
    }
    __device__ __forceinline__ void put8(int row, int col, f32x4 v0, f32x4 v1, f32x4& w0, f32x4& w1) const {
        const int pm = row >> 8, c = row & 255, g = pm >> 1, b = pm & 1, nout = col & 511, j = nout >> 4, p = nout & 15;
        const long tok = (long)b * SEQ + c * LCH + j;
        f32x4 y0, y1;
#pragma unroll
        for (int e = 0; e < 4; ++e) { y0[e] = gelu_tanh(v0[e]); y1[e] = gelu_tanh(v1[e]); }
        *(u32x4*)(G + tok * 512 + 16 * g + p) = pack8(y0, y1); w0 = v0; w1 = v1;
    }
    __device__ __forceinline__ void ssq(int, int, float) const {}
};
struct EpiGlu {
    static constexpr bool MID = false, ROWSCALE = false, SSQ = true;
    const bf16_t* G; const float* bglu; bf16_t* Y; float* ssqs;
    __device__ __forceinline__ f32x4 put(int row, int col, f32x4 v) const {
        const u32x2 gw = *(const u32x2*)(G + (long)row * 512 + col);
        const f32x4 bb = *(const f32x4*)(bglu + col);
        f32x4 ys; ys[0] = bflo(gw.x) * sigmoidf_(v[0] + bb[0]); ys[1] = bfhi(gw.x) * sigmoidf_(v[1] + bb[1]);
        ys[2] = bflo(gw.y) * sigmoidf_(v[2] + bb[2]); ys[3] = bfhi(gw.y) * sigmoidf_(v[3] + bb[3]);
        *(u32x2*)(Y + (long)row * 1024 + col) = pack4(ys); return ys;
    }
    __device__ __forceinline__ void put8(int row, int col, f32x4 v0, f32x4 v1, f32x4& w0, f32x4& w1) const {
        f32x4 g0, g1; unpack8(*(const u32x4*)(G + (long)row * 512 + col), g0, g1);
        const f32x4 b0 = *(const f32x4*)(bglu + col), b1 = *(const f32x4*)(bglu + col + 4);
#pragma unroll
        for (int e = 0; e < 4; ++e) { w0[e] = g0[e] * sigmoidf_(v0[e] + b0[e]); w1[e] = g1[e] * sigmoidf_(v1[e] + b1[e]); }
        *(u32x4*)(Y + (long)row * 1024 + col) = pack8(w0, w1);
    }
    __device__ __forceinline__ void ssq(int row, int slot, float s) const { ssqs[(long)row * 16 + slot] = s; }
};
struct EpiOut {
    static constexpr bool MID = true, ROWSCALE = true, SSQ = true;
    const float* rs; bf16_t* xb; float* ssq1;
    __device__ __forceinline__ float mid(int row) const { return rs[(long)row * 2]; }
    __device__ __forceinline__ float rscale(int row) const { return rs[(long)row * 2 + 1]; }
    __device__ __forceinline__ f32x4 put(int row, int col, f32x4 v) const {
        const long o = (long)row * D + col; const u32x2 xw = *(const u32x2*)(xb + o); const f32x4 x1 = (f32x4){bflo(xw.x), bfhi(xw.x), bflo(xw.y), bfhi(xw.y)} + v;
        const u32x2 ow = pack4(x1); *(u32x2*)(xb + o) = ow; return (f32x4){bflo(ow.x), bfhi(ow.x), bflo(ow.y), bfhi(ow.y)};
    }
    __device__ __forceinline__ void put8(int row, int col, f32x4 v0, f32x4 v1, f32x4& w0, f32x4& w1) const {
        const long o = (long)row * D + col; f32x4 x0, x1; unpack8(*(const u32x4*)(xb + o), x0, x1);
        const u32x4 ow = pack8(x0 + v0, x1 + v1); *(u32x4*)(xb + o) = ow; unpack8(ow, w0, w1);
    }
    __device__ __forceinline__ void ssq(int row, int slot, float s) const { ssq1[(long)row * 16 + slot] = s; }
};
struct EpiQ {
    static constexpr bool MID = false, ROWSCALE = true, SSQ = false;
    const float* ssq1; bf16_t* qp;
    __device__ __forceinline__ float rscale(int row) const { return rsqrtf(sumn(ssq1 + (long)row * 16, 16) * (1.f / D) + EPS); }
    __device__ __forceinline__ f32x4 put(int row, int col, f32x4 v) const { *(u32x2*)(qp + (long)row * 2048 + col) = pack4(v); return v; }
    __device__ __forceinline__ void put8(int row, int col, f32x4 v0, f32x4 v1, f32x4& w0, f32x4& w1) const { *(u32x4*)(qp + (long)row * 2048 + col) = pack8(v0, v1); w0 = v0; w1 = v1; }
    __device__ __forceinline__ void ssq(int, int, float) const {}
};
struct EpiProj {
    static constexpr bool MID = false, ROWSCALE = false, SSQ = false;
    bf16_t* pr;
    __device__ __forceinline__ f32x4 put(int row, int col, f32x4 v) const { *(u32x2*)(pr + (long)row * D + col) = pack4(v); return v; }
    __device__ __forceinline__ void put8(int row, int col, f32x4 v0, f32x4 v1, f32x4& w0, f32x4& w1) const { *(u32x4*)(pr + (long)row * D + col) = pack8(v0, v1); w0 = v0; w1 = v1; }
    __device__ __forceinline__ void ssq(int, int, float) const {}
};
struct EpiGate {
    static constexpr bool MID = false, ROWSCALE = true, SSQ = true;
    const bf16_t* pr; const bf16_t* xin; bf16_t* xout; float* ssq0; const float* ssq2;
    __device__ __forceinline__ float rscale(int row) const { return rsqrtf(sumn(ssq2 + (long)row * 16, 8) * (1.f / D) + EPS); }
    __device__ __forceinline__ f32x4 put(int row, int col, f32x4 v) const {
        const long o = (long)row * D + col; const u32x2 pw = *(const u32x2*)(pr + o); const f32x4 pv = (f32x4){bflo(pw.x), bfhi(pw.x), bflo(pw.y), bfhi(pw.y)}; const u32x2 xw = *(const u32x2*)(xin + o); f32x4 x3 = (f32x4){bflo(xw.x), bfhi(xw.x), bflo(xw.y), bfhi(xw.y)};
        x3[0] += sigmoidf_(v[0]) * pv[0]; x3[1] += sigmoidf_(v[1]) * pv[1]; x3[2] += sigmoidf_(v[2]) * pv[2]; x3[3] += sigmoidf_(v[3]) * pv[3];
        const u32x2 ow = pack4(x3); *(u32x2*)(xout + o) = ow; return (f32x4){bflo(ow.x), bfhi(ow.x), bflo(ow.y), bfhi(ow.y)};
    }
    __device__ __forceinline__ void put8(int row, int col, f32x4 v0, f32x4 v1, f32x4& w0, f32x4& w1) const {
        const long o = (long)row * D + col; f32x4 p0, p1, x0, x1; unpack8(*(const u32x4*)(pr + o), p0, p1); unpack8(*(const u32x4*)(xin + o), x0, x1);
#pragma unroll
        for (int e = 0; e < 4; ++e) { x0[e] += sigmoidf_(v0[e]) * p0[e]; x1[e] += sigmoidf_(v1[e]) * p1[e]; }
        const u32x4 ow = pack8(x0, x1); *(u32x4*)(xout + o) = ow; unpack8(ow, w0, w1);
    }
    __device__ __forceinline__ void ssq(int row, int slot, float s) const { ssq0[(long)row * 16 + slot] = s; }
};


namespace pg8 {
#define PG8_LAS __attribute__((address_space(3)))
constexpr int BM = 256, BK = 64, HALF = 128, HTB = HALF * BK * 2, STAGE_BYTES = 8 * HTB, NXCD = 8, WGM = 8;
__host__ __device__ __forceinline__ int lds_byte(int r, int c) { const int st = (r >> 4) * 2 + (c >> 5), rr = r & 15, cc = c & 31, ob = rr * 64 + cc * 2; return st * 1024 + (ob ^ (((ob >> 9) & 1) << 5)); }
__host__ __device__ __forceinline__ void stage_rc(int b, int& R, int& C) { const int st = b / 1024, sb = b % 1024, swz = sb ^ (((sb >> 9) & 1) << 5); R = (st >> 1) * 16 + swz / 64; C = (st & 1) * 32 + (swz % 64) / 2; }
__host__ __device__ __forceinline__ int perm32(int rho) { const int n = rho >> 4, i = rho & 15; return 8 * (i >> 2) + 4 * n + (i & 3); }
using ::Unit;
struct Gemm { const bf16_t* A; const bf16_t* Bt; int K, lda, ldb, kmid; };
struct StaticOrder {
    int nM, nN, nwg, G, c;
    __host__ __device__ __forceinline__ void init(int M_, int N_, int G_, int c_) { nM = M_ / BM; nN = N_ / BM; nwg = nM * nN; G = G_; c = c_; }
    __host__ __device__ __forceinline__ bool next(int i, Unit& u) const {
        const long L = (long)i * G + c; if (L >= nwg) return false;
        int wgid = (int)L; { const int q = nwg / NXCD, r = nwg % NXCD, xcd = wgid % NXCD, off = wgid / NXCD; wgid = (xcd < r ? xcd * (q + 1) : r * (q + 1) + (xcd - r) * q) + off; }
        const int nig = WGM * nN, gid = wgid / nig, fm = gid * WGM, gsz = (nM - fm) < WGM ? (nM - fm) : WGM;
        u.pm = fm + ((wgid % nig) % gsz); u.pn = (wgid % nig) / gsz; return true;
    }
    __device__ __forceinline__ void a_ready(const Unit&) const {}
    __device__ __forceinline__ void done(const Unit&) const {}
};
struct OneUnit { Unit u;
    __device__ __forceinline__ bool next(int i, Unit& o) const { if (i) return false; o = u; return true; }
    __device__ __forceinline__ void a_ready(const Unit&) const {}
    __device__ __forceinline__ void done(const Unit&) const {} };
struct S2Order { int blk, nblk;
    __device__ __forceinline__ bool next(int i, Unit& o) const { const int ui = blk + i * nblk; if (ui >= 128) return false; o.pm = ui >> 1; o.pn = (ui >> 2) * 2 + (ui & 1); return true; }
    __device__ __forceinline__ void a_ready(const Unit&) const {}
    __device__ __forceinline__ void done(const Unit&) const {} };
template <class F> struct Epi {
    static constexpr bool PERM = true, AFTER_DRAIN = false, MID = F::MID;
    F f;
    __device__ __forceinline__ void operator()(const f32x4 (&acc)[2][2][4][2], const Unit& u, int wr, int wc, int fr, int fq) const {
        asm volatile("" : "+v"(fr), "+v"(fq));
        const int rowb = u.pm * BM + wr * 64 + fr, colb = u.pn * BM + wc * 32 + 8 * fq;
#pragma unroll
        for (int ai = 0; ai < 2; ++ai)
#pragma unroll
            for (int m = 0; m < 4; ++m) {
                const int row = rowb + ai * HALF + m * 16; float rs = 1.f; if constexpr (F::ROWSCALE) rs = f.rscale(row);
                float ss = 0.f;
#pragma unroll
                for (int bj = 0; bj < 2; ++bj) { f32x4 w0, w1; f.put8(row, colb + bj * HALF, acc[ai][bj][m][0] * rs, acc[ai][bj][m][1] * rs, w0, w1);
                    ss += (w0[0] * w0[0] + w0[1] * w0[1] + w0[2] * w0[2] + w0[3] * w0[3]) + (w1[0] * w1[0] + w1[1] * w1[1] + w1[2] * w1[2] + w1[3] * w1[3]); }
                if constexpr (F::SSQ) { ss += __shfl_xor(ss, 16); ss += __shfl_xor(ss, 32); if (fq == 0) f.ssq(row, u.pn * 4 + wc, ss); }
                asm volatile("" ::: "memory");
            }
    }
    __device__ __forceinline__ void midscale(f32x4 (&acc)[2][2][4][2], const Unit& u, int wr, int wc, int fr, int fq) const {
        if constexpr (F::MID) {
            asm volatile("" : "+v"(fr));
            const int rowb = u.pm * BM + wr * 64 + fr;
#pragma unroll
            for (int ai = 0; ai < 2; ++ai)
#pragma unroll
                for (int m = 0; m < 4; ++m) { const float s = f.mid(rowb + ai * HALF + m * 16);
#pragma unroll
                    for (int bj = 0; bj < 2; ++bj)
#pragma unroll
                        for (int n = 0; n < 2; ++n) acc[ai][bj][m][n] *= s; }
        }
    }
};
template <class Epi, class Sched, bool ALIGN_EPI = false, bool SP2 = false>
__device__ __forceinline__ void gemm_phase(PG8_LAS unsigned char* lds, const Gemm g, const Sched& S, const Epi& E, const int tid) {
    const int wid = __builtin_amdgcn_readfirstlane(tid >> 6), lane = tid & 63, wr = wid >> 2, wc = wid & 3, fr = lane & 15, fq = lane >> 4;
    const int K = g.K, nt = K / BK;
    unsigned voffA[2], voffB[2];
#pragma unroll
    for (int i = 0; i < 2; ++i) { int R, C; stage_rc(tid * 16 + i * 8192, R, C); const int Rb = Epi::PERM ? ((R & ~31) + perm32(R & 31)) : R;
        voffA[i] = (unsigned)(R * g.lda + C) * 2u; voffB[i] = (unsigned)(Rb * g.ldb + C) * 2u; }
    const size_t kstep = (size_t)(BK * 2);
    const size_t hstepA = (size_t)HALF * g.lda * 2, hstepB = (size_t)HALF * g.ldb * 2;
    const size_t tstepA = 2 * hstepA, tstepB = 2 * hstepB;
    const unsigned ldsw = (unsigned)wid * 1024u;
    const int aoff = lds_byte(wr * 64 + fr, fq * 8), boff = lds_byte(wc * 32 + fr, fq * 8);
#define PG8_SA(b, h) (((b) * 2 + (h)) * HTB)
#define PG8_SB(b, h) ((4 + (b) * 2 + (h)) * HTB)
#define PG8_STAGE(bufoff, gbase, voff) do { _Pragma("unroll") for (int _i = 0; _i < 2; ++_i) \
        __builtin_amdgcn_global_load_lds((const unsigned*)((const char*)(gbase) + (voff)[_i]), (PG8_LAS unsigned*)(lds + (bufoff) + ldsw + _i * 8192), 16, 0, 0); } while (0)
#define PG8_LDA(dst, b, h) do { _Pragma("unroll") for (int m = 0; m < 4; ++m) _Pragma("unroll") for (int k = 0; k < 2; ++k) dst[m][k] = *(const PG8_LAS bf16x8*)(lds + PG8_SA(b, h) + aoff + m * 2048 + k * 1024); } while (0)
#define PG8_LDB(dst, b, h) do { _Pragma("unroll") for (int n = 0; n < 2; ++n) _Pragma("unroll") for (int k = 0; k < 2; ++k) dst[n][k] = *(const PG8_LAS bf16x8*)(lds + PG8_SB(b, h) + boff + n * 2048 + k * 1024); } while (0)
#define PG8_MMA(ai, bj, At, Bt) do { __builtin_amdgcn_s_setprio(1); _Pragma("unroll") for (int m = 0; m < 4; ++m) _Pragma("unroll") for (int n = 0; n < 2; ++n) _Pragma("unroll") for (int k = 0; k < 2; ++k) \
        acc[ai][bj][m][n] = __builtin_amdgcn_mfma_f32_16x16x32_bf16(Bt[n][k], At[m][k], acc[ai][bj][m][n], 0, 0, 0); __builtin_amdgcn_s_setprio(0); } while (0)
#define PG8_WAIT_V(n) asm volatile("s_waitcnt vmcnt(" #n ")" ::: "memory")
#define PG8_WAIT_L(n) asm volatile("s_waitcnt lgkmcnt(" #n ")" ::: "memory")
#define PG8_BAR __builtin_amdgcn_s_barrier()
#define PG8_SCHED __builtin_amdgcn_sched_barrier(0)
    Unit cur, nxt; int ui = 0;
    if (!S.next(0, cur)) return;
    f32x4 acc[2][2][4][2];
#pragma unroll
    for (int a = 0; a < 2; ++a)
#pragma unroll
        for (int b = 0; b < 2; ++b)
#pragma unroll
            for (int m = 0; m < 4; ++m)
#pragma unroll
                for (int n = 0; n < 2; ++n) acc[a][b][m][n] = (f32x4){0.f, 0.f, 0.f, 0.f};
    bf16x8 At[4][2], B0[2][2], B1[2][2];
    const char* cA = (const char*)g.A + (size_t)cur.pm * tstepA; const char* cB = (const char*)g.Bt + (size_t)cur.pn * tstepB;
    S.a_ready(cur);
    if constexpr (SP2) {
        PG8_STAGE(PG8_SB(0, 0), cB, voffB); PG8_STAGE(PG8_SB(0, 1), cB + hstepB, voffB); PG8_STAGE(PG8_SA(0, 0), cA, voffA); PG8_STAGE(PG8_SA(0, 1), cA + hstepA, voffA);
        if (wr == 1) PG8_BAR;
        PG8_WAIT_V(2); PG8_BAR;
        PG8_STAGE(PG8_SB(1, 0), cB + kstep, voffB); PG8_STAGE(PG8_SA(1, 0), cA + kstep, voffA); PG8_STAGE(PG8_SB(1, 1), cB + hstepB + kstep, voffB);
        PG8_WAIT_V(6); PG8_BAR;
    } else {
        PG8_STAGE(PG8_SB(0, 0), cB, voffB); PG8_STAGE(PG8_SA(0, 0), cA, voffA); PG8_STAGE(PG8_SB(0, 1), cB + hstepB, voffB); PG8_STAGE(PG8_SA(0, 1), cA + hstepA, voffA);
        if (wr == 1) PG8_BAR;
        PG8_WAIT_V(4); PG8_BAR;
        PG8_STAGE(PG8_SB(1, 0), cB + kstep, voffB); PG8_STAGE(PG8_SA(1, 0), cA + kstep, voffA); PG8_STAGE(PG8_SB(1, 1), cB + hstepB + kstep, voffB);
        PG8_WAIT_V(6); PG8_BAR;
    }
    for (;;) {
        const bool has_next = S.next(ui + 1, nxt);
        const char* nA = has_next ? (const char*)g.A + (size_t)nxt.pm * tstepA : cA; const char* nB = has_next ? (const char*)g.Bt + (size_t)nxt.pn * tstepB : cB;
        for (int t = 0; t < nt; t += 2) {
            const bool last = (t == nt - 2);
            if constexpr (Epi::MID) { if (t * BK == g.kmid) E.midscale(acc, cur, wr, wc, fr, fq); }
            const char* a1 = cA + (size_t)(t + 1) * kstep;
            const char* a2 = last ? nA : cA + (size_t)(t + 2) * kstep; const char* b2 = last ? nB : cB + (size_t)(t + 2) * kstep;
            const char* a3 = a2 + kstep; const char* b3 = b2 + kstep;
            if (last && has_next) S.a_ready(nxt);
            if constexpr (SP2) {
            PG8_LDB(B0, 0, 0); PG8_LDB(B1, 0, 1); PG8_SCHED; PG8_LDA(At, 0, 0); PG8_STAGE(PG8_SA(1, 1), a1 + hstepA, voffA);
            PG8_WAIT_V(8); PG8_WAIT_L(0); PG8_BAR; PG8_MMA(0, 0, At, B0); PG8_MMA(0, 1, At, B1); PG8_BAR; PG8_SCHED;
            PG8_LDA(At, 0, 1); PG8_STAGE(PG8_SB(0, 0), b2, voffB); PG8_STAGE(PG8_SB(0, 1), b2 + hstepB, voffB); PG8_STAGE(PG8_SA(0, 0), a2, voffA);
            PG8_WAIT_V(8); PG8_WAIT_L(0); PG8_BAR; PG8_MMA(1, 0, At, B0); PG8_MMA(1, 1, At, B1); PG8_BAR; PG8_SCHED;
            PG8_LDB(B0, 1, 0); PG8_LDB(B1, 1, 1); PG8_SCHED; PG8_LDA(At, 1, 0); PG8_STAGE(PG8_SA(0, 1), a2 + hstepA, voffA);
            PG8_WAIT_V(8); PG8_WAIT_L(0); PG8_BAR; PG8_MMA(0, 0, At, B0); PG8_MMA(0, 1, At, B1); PG8_BAR; PG8_SCHED;
            PG8_LDA(At, 1, 1); PG8_STAGE(PG8_SB(1, 0), b3, voffB); PG8_STAGE(PG8_SB(1, 1), b3 + hstepB, voffB); PG8_STAGE(PG8_SA(1, 0), a3, voffA);
            PG8_WAIT_V(8); PG8_WAIT_L(0); PG8_BAR; PG8_MMA(1, 0, At, B0); PG8_MMA(1, 1, At, B1); PG8_BAR; PG8_SCHED;
            } else {
            PG8_LDB(B0, 0, 0); PG8_SCHED; PG8_LDA(At, 0, 0); PG8_STAGE(PG8_SA(1, 1), a1 + hstepA, voffA);
            PG8_WAIT_L(8); PG8_BAR; PG8_WAIT_L(0); PG8_MMA(0, 0, At, B0); PG8_BAR; PG8_SCHED;
            PG8_LDB(B1, 0, 1); PG8_STAGE(PG8_SB(0, 0), b2, voffB);
            PG8_BAR; PG8_WAIT_L(0); PG8_MMA(0, 1, At, B1); PG8_BAR;
            PG8_LDA(At, 0, 1); PG8_STAGE(PG8_SA(0, 0), a2, voffA);
            PG8_BAR; PG8_WAIT_L(0); PG8_MMA(1, 0, At, B0); PG8_BAR; PG8_SCHED;
            PG8_STAGE(PG8_SB(0, 1), b2 + hstepB, voffB);
            PG8_WAIT_V(6); PG8_BAR; PG8_MMA(1, 1, At, B1); PG8_BAR;
            PG8_LDB(B0, 1, 0); PG8_SCHED; PG8_LDA(At, 1, 0); PG8_STAGE(PG8_SA(0, 1), a2 + hstepA, voffA);
            PG8_WAIT_L(8); PG8_BAR; PG8_WAIT_L(0); PG8_MMA(0, 0, At, B0); PG8_BAR; PG8_SCHED;
            PG8_LDB(B1, 1, 1); PG8_STAGE(PG8_SB(1, 0), b3, voffB);
            PG8_BAR; PG8_WAIT_L(0); PG8_MMA(0, 1, At, B1); PG8_BAR;
            PG8_LDA(At, 1, 1); PG8_STAGE(PG8_SA(1, 0), a3, voffA);
            PG8_BAR; PG8_WAIT_L(0); PG8_MMA(1, 0, At, B0); PG8_BAR; PG8_SCHED;
            PG8_STAGE(PG8_SB(1, 1), b3 + hstepB, voffB);
            PG8_WAIT_V(6); PG8_BAR; PG8_MMA(1, 1, At, B1); PG8_BAR;
            }
        }
        if constexpr (ALIGN_EPI) { if (wr == 0) PG8_BAR; }
        if constexpr (!Epi::AFTER_DRAIN) { E(acc, cur, wr, wc, fr, fq); S.done(cur); }
        if (!has_next) break;
#pragma unroll
        for (int a = 0; a < 2; ++a)
#pragma unroll
            for (int b = 0; b < 2; ++b)
#pragma unroll
                for (int m = 0; m < 4; ++m)
#pragma unroll
                    for (int n = 0; n < 2; ++n) acc[a][b][m][n] = (f32x4){0.f, 0.f, 0.f, 0.f};
        cur = nxt; cA = nA; cB = nB; ++ui;
        if constexpr (ALIGN_EPI) { if (wr == 1) PG8_BAR; }
    }
    PG8_WAIT_V(0);
    if constexpr (!ALIGN_EPI) { if (wr == 0) PG8_BAR; }
    PG8_BAR;
    if constexpr (Epi::AFTER_DRAIN) { E.fused(acc, cur, wr, wc, fr, fq, lds, wid, lane); S.done(cur); }
#undef PG8_SA
#undef PG8_SB
#undef PG8_STAGE
#undef PG8_LDA
#undef PG8_LDB
#undef PG8_MMA
#undef PG8_WAIT_V
#undef PG8_WAIT_L
#undef PG8_BAR
#undef PG8_SCHED
}

}

template <class F, class Sched>
__device__ __forceinline__ void run_gemm(unsigned char* lds, const GemmD& g, const Sched& S, const F& f, const int tid) {
    pg8::Gemm pg; pg.A = g.A; pg.Bt = g.Bt; pg.K = g.K; pg.lda = (int)g.lda; pg.ldb = (int)g.ldb; pg.kmid = g.kmid;
    pg8::Epi<F> E; E.f = f;
    pg8::gemm_phase<pg8::Epi<F>, Sched, true, true>((PG8_LAS unsigned char*)lds, pg, S, E, tid);
}
template <class Epi>
__device__ __forceinline__ void gemm_phase_sub(const Ctx& c, const GemmD& g, int nM, int nN, const Epi& E, int G, int cidx) {
    pg8::StaticOrder S; S.init(nM * 256, nN * 256, G, cidx);
    run_gemm(c.lds, g, S, E, c.tid);
}
template <class Epi>
__device__ __forceinline__ void gemm_phase_dense(const Ctx& c, const GemmD& g, int nM, int nN, const Epi& E) {
#ifdef USE_SGEMM
    const int nU = nM * nN;
    for (int ui = c.blk; ui < nU; ui += c.nblk) { Unit u; u.pn = ui % nN; u.pm = ui / nN; sgemm_unit(g, u, E, c.wave, c.lane); }
#else
    pg8::StaticOrder S; S.init(nM * 256, nN * 256, c.nblk, c.blk);
    run_gemm(c.lds, g, S, E, c.tid);
#endif
}

__device__ __forceinline__ void transpose_item(const float* W, int K, int N, bf16_t* WT, const float* gain, float* scr, int item, int lane) {
    const int nblk = N / 32, kb = item / nblk, nb = item % nblk, k0 = 64 * kb, n0 = 32 * nb;
    { f32x4 v[8];
#pragma unroll
      for (int i = 0; i < 8; ++i) v[i] = *(const f32x4*)(W + (size_t)(k0 + 8 * i + (lane >> 3)) * N + n0 + 4 * (lane & 7));
#pragma unroll
      for (int i = 0; i < 8; ++i) { const int kk = 8 * i + (lane >> 3); const float gg = gain ? gain[k0 + kk] : 1.f; float* s = scr + kk * 33 + 4 * (lane & 7);
          s[0] = v[i][0] * gg; s[1] = v[i][1] * gg; s[2] = v[i][2] * gg; s[3] = v[i][3] * gg; } }
    LDS_WAIT(); asm volatile("" ::: "memory");
    const int cc = lane & 7;
#pragma unroll
    for (int j = 0; j < 4; ++j) { const int n = (lane >> 3) + 8 * j; const float* s = scr + (8 * cc) * 33 + n;
        u32x4 o; o.x = pk2(s[0 * 33], s[1 * 33]); o.y = pk2(s[2 * 33], s[3 * 33]); o.z = pk2(s[4 * 33], s[5 * 33]); o.w = pk2(s[6 * 33], s[7 * 33]);
        *(u32x4*)(WT + (size_t)(n0 + n) * K + k0 + 8 * cc) = o; }
    LDS_WAIT(); asm volatile("" ::: "memory");
}
__device__ __forceinline__ void transpose_wg_item(const Ctx& c, const float* W, int K, int N, bf16_t* WT, const float* gain, int item) {
    const int nblk = N / 256, kb = item / nblk, nb = item % nblk, k0 = 64 * kb, n0 = 256 * nb;
    float* T = (float*)c.lds;
    f32x4 v[8];
#pragma unroll
    for (int i = 0; i < 8; ++i) { const int idx = i * 512 + c.tid, row = idx >> 6, c4 = idx & 63; v[i] = *(const f32x4*)(W + (size_t)(k0 + row) * N + n0 + 4 * c4); }
#pragma unroll
    for (int i = 0; i < 8; ++i) { const int idx = i * 512 + c.tid, row = idx >> 6, c4 = idx & 63; const float gg = gain ? gain[k0 + row] : 1.f; float* s = T + row * 257 + 4 * c4;
        s[0] = v[i][0] * gg; s[1] = v[i][1] * gg; s[2] = v[i][2] * gg; s[3] = v[i][3] * gg; }
    __syncthreads();
#pragma unroll
    for (int j = 0; j < 4; ++j) { const int id = j * 512 + c.tid, n = id >> 3, cc = id & 7; const float* s = T + (8 * cc) * 257 + n;
        u32x4 o; o.x = pk2(s[0 * 257], s[1 * 257]); o.y = pk2(s[2 * 257], s[3 * 257]); o.z = pk2(s[4 * 257], s[5 * 257]); o.w = pk2(s[6 * 257], s[7 * 257]);
        *(u32x4*)(WT + (size_t)(n0 + n) * K + k0 + 8 * cc) = o; }
    __syncthreads();
}
__device__ __forceinline__ void cvt_range(const Ctx& c, const float* src, bf16_t* dst, size_t n) {
    const size_t nv = n / 8, stride = (size_t)c.nblk * 512;
    for (size_t v0 = (size_t)c.blk * 512 + c.tid; v0 < nv; v0 += 4 * stride) {
        f32x4 a[4], b[4];
#pragma unroll
        for (int u = 0; u < 4; ++u) { const size_t v = v0 + u * stride < nv ? v0 + u * stride : v0; a[u] = *(const f32x4*)(src + v * 8); b[u] = *(const f32x4*)(src + v * 8 + 4); }
#pragma unroll
        for (int u = 0; u < 4; ++u) { const size_t v = v0 + u * stride; if (v < nv) { u32x4 o; o.x = pk2(a[u][0], a[u][1]); o.y = pk2(a[u][2], a[u][3]); o.z = pk2(b[u][0], b[u][1]); o.w = pk2(b[u][2], b[u][3]);
            *(u32x4*)(dst + v * 8) = o; } }
    }
}
__device__ __forceinline__ void ssm_tables_unit(const Ctx& c, const Args& a, int layer, int g, int part, int nparts) {
    float* Apow = (float*)c.lds;
    float* Bre = Apow + 2 * 33 * 64 * 2;
    float* Bim = Bre + 2 * 64 * 16;
    float* Cre = Bim + 2 * 64 * 16;
    float* Cim = Cre + 2 * 16 * 64;
    float* Tt = Cim + 2 * 16 * 64;
    unsigned char* lw = a.ws + WS_LW + (size_t)layer * LW_STRIDE;
    float* AL = (float*)(lw + LW_AL);
    bf16_t* WE = (bf16_t*)(lw + LW_WE) + (size_t)g * 256 * 512;
    bf16_t* WY = (bf16_t*)(lw + LW_WY) + (size_t)g * 512 * KCAT;
    const int tid = c.tid;
    unsigned char* rgn_ws = a.ws; (void)rgn_ws;
    __syncthreads();
    RGN(11, 0);
    if (tid < 128) {
        const int dir = tid >> 6, n = tid & 63; const int ldg = (layer * 2 + dir) * NG + g;
        const float lre = a.in[I_LRE][ldg * 64 + n], lim = a.in[I_LIM][ldg * 64 + n];
        const float dt = expf(a.in[I_LOGDT][ldg]);
        { const float dec = expf(lre * dt); float sn, cs; sincosf(lim * dt, &sn, &cs); const float a1r = dec * cs, a1i = dec * sn;
          float pr = 1.f, pi = 0.f;
          for (int k = 0; k <= 32; ++k) { Apow[((dir * 33 + k) * 64 + n) * 2 + 0] = pr; Apow[((dir * 33 + k) * 64 + n) * 2 + 1] = pi;
              const float nr_ = pr * a1r - pi * a1i, ni_ = pr * a1i + pi * a1r; pr = nr_; pi = ni_; } }
        const float abr = Apow[((dir * 33 + 1) * 64 + n) * 2 + 0], abi = Apow[((dir * 33 + 1) * 64 + n) * 2 + 1];
        const float den = lre * lre + lim * lim, nr = abr - 1.f;
        const float fre = (nr * lre + abi * lim) / den, fim = (abi * lre - nr * lim) / den;
        for (int q = 0; q < 16; ++q) { const float br = a.in[I_BRE][(ldg * 64 + n) * 16 + q], bi = a.in[I_BIM][(ldg * 64 + n) * 16 + q];
            Bre[(dir * 64 + n) * 16 + q] = fre * br - fim * bi; Bim[(dir * 64 + n) * 16 + q] = fre * bi + fim * br; }
        for (int p = 0; p < 16; ++p) { Cre[(dir * 16 + p) * 64 + n] = a.in[I_CRE][(ldg * 16 + p) * 64 + n]; Cim[(dir * 16 + p) * 64 + n] = a.in[I_CIM][(ldg * 16 + p) * 64 + n]; }
        if (part == 0) { AL[((dir * NG + g) * 64 + n) * 2 + 0] = Apow[((dir * 33 + 32) * 64 + n) * 2 + 0];
        AL[((dir * NG + g) * 64 + n) * 2 + 1] = Apow[((dir * 33 + 32) * 64 + n) * 2 + 1]; }
    }
    __syncthreads();
    RGN(11, 1); RGN(12, 0);
    const int kk_lo = nparts == 4 ? 8 * part : 0, nkk = nparts == 4 ? 39 : 63;
    {
        const int l15 = c.lane & 15, l4 = c.lane >> 4;
      for (int kb0 = 0; kb0 < nkk; kb0 += 40) {
        f32x4 accs[5]; int ks[5]; bool val[5];
#pragma unroll
        for (int i = 0; i < 5; ++i) { const int kx = kb0 + c.wave + 8 * i; val[i] = kx < nkk; ks[i] = kk_lo + (val[i] ? kx : 0) - 31; accs[i] = (f32x4){0.f, 0.f, 0.f, 0.f}; }
#pragma unroll 2
        for (int st = 0; st < 32; ++st) {
            const int kidx = 4 * st + l4, n = kidx & 63; const bool lo = kidx < 64;
            const float cr0 = Cre[l15 * 64 + n], ci0 = Cim[l15 * 64 + n], cr1 = Cre[(16 + l15) * 64 + n], ci1 = Cim[(16 + l15) * 64 + n];
            const float b0 = lo ? Bre[n * 16 + l15] : Bim[n * 16 + l15], b1 = lo ? Bre[(64 + n) * 16 + l15] : Bim[(64 + n) * 16 + l15];
#pragma unroll
            for (int i = 0; i < 5; ++i) {
                const int dir = ks[i] < 0 ? 1 : 0, e = ks[i] < 0 ? -ks[i] : ks[i];
                const float ar = Apow[((dir * 33 + e) * 64 + n) * 2 + 0], ai = Apow[((dir * 33 + e) * 64 + n) * 2 + 1];
                const float cr = dir ? cr1 : cr0, ci = dir ? ci1 : ci0;
                const float av = lo ? (cr * ar - ci * ai) : -(cr * ai + ci * ar);
                accs[i] = __builtin_amdgcn_mfma_f32_16x16x4f32(av, dir ? b1 : b0, accs[i], 0, 0, 0);
            }
        }
#pragma unroll
        for (int i = 0; i < 5; ++i) if (val[i] && ks[i] == 0) {
#pragma unroll 4
            for (int st = 0; st < 32; ++st) {
                const int kidx = 4 * st + l4, n = kidx & 63; const bool lo = kidx < 64;
                const float cr = Cre[(16 + l15) * 64 + n], ci = Cim[(16 + l15) * 64 + n];
                const float ar = Apow[((33 + 0) * 64 + n) * 2 + 0], ai = Apow[((33 + 0) * 64 + n) * 2 + 1];
                const float av = lo ? (cr * ar - ci * ai) : -(cr * ai + ci * ar);
                const float bv = lo ? Bre[(64 + n) * 16 + l15] : Bim[(64 + n) * 16 + l15];
                accs[i] = __builtin_amdgcn_mfma_f32_16x16x4f32(av, bv, accs[i], 0, 0, 0);
            }
        }
#pragma unroll
        for (int i = 0; i < 5; ++i) if (val[i]) { const int kk = ks[i] + 31;
#pragma unroll
            for (int r = 0; r < 4; ++r) { const int p = 4 * l4 + r;
                Tt[(kk * 16 + p) * 16 + l15] = accs[i][r] + ((ks[i] == 0 && l15 == p) ? a.in[I_DSKIP][layer * 512 + 16 * g + p] : 0.f); } }
      }
    }
    __syncthreads();
    RGN(12, 1); RGN(13, 0);
    const int wy_lo = (512 * 96 / nparts) * part, wy_hi = wy_lo + 512 * 96 / nparts, we_lo = (256 * 64 / nparts) * part, we_hi = we_lo + 256 * 64 / nparts;
    for (int it = wy_lo + tid; it < wy_hi; it += 512) {
        const int nout = it / 96, kin0 = (it % 96) * 8, j = nout >> 4, p = nout & 15;
        float v[8];
        if (kin0 < 512) { const int s = kin0 >> 4, q0 = kin0 & 15, kk = j - s + 31;
#pragma unroll
            for (int i = 0; i < 8; ++i) v[i] = Tt[(kk * 16 + p) * 16 + q0 + i]; }
        else { const int comp = kin0 - 512, dir = comp >> 7, reim = (comp >> 6) & 1, n0 = comp & 63, e = dir == 0 ? j + 1 : 32 - j;
#pragma unroll
            for (int i = 0; i < 8; ++i) { const int n = n0 + i; const float cr = Cre[(dir * 16 + p) * 64 + n], ci = Cim[(dir * 16 + p) * 64 + n];
                const float ar = Apow[((dir * 33 + e) * 64 + n) * 2 + 0], ai = Apow[((dir * 33 + e) * 64 + n) * 2 + 1];
                v[i] = reim == 0 ? (cr * ar - ci * ai) : -(cr * ai + ci * ar); } }
        u32x4 o; o.x = pk2(v[0], v[1]); o.y = pk2(v[2], v[3]); o.z = pk2(v[4], v[5]); o.w = pk2(v[6], v[7]);
        *(u32x4*)(WY + (size_t)nout * KCAT + kin0) = o;
    }
    for (int it = we_lo + tid; it < we_hi; it += 512) {
        const int comp = it >> 6, kin0 = (it & 63) * 8, j = kin0 >> 4, q0 = kin0 & 15, dir = comp >> 7, reim = (comp >> 6) & 1, n = comp & 63, e = dir == 0 ? 31 - j : j;
        const float ar = Apow[((dir * 33 + e) * 64 + n) * 2 + 0], ai = Apow[((dir * 33 + e) * 64 + n) * 2 + 1];
        float v[8];
#pragma unroll
        for (int i = 0; i < 8; ++i) { const float br = Bre[(dir * 64 + n) * 16 + q0 + i], bi = Bim[(dir * 64 + n) * 16 + q0 + i]; v[i] = reim == 0 ? (ar * br - ai * bi) : (ar * bi + ai * br); }
        u32x4 o; o.x = pk2(v[0], v[1]); o.y = pk2(v[2], v[3]); o.z = pk2(v[4], v[5]); o.w = pk2(v[6], v[7]);
        *(u32x4*)(WE + (size_t)comp * 512 + kin0) = o;
    }
    __syncthreads();
    RGN(13, 1);
}
__device__ __forceinline__ void cvt_fp8_layer(const Ctx& c, const Args& a, int layer, int widx, int nw) {
    for (int r0 = widx; r0 < 2 * 16384; r0 += 4 * nw) {
      f32x4 vq[4][4];
#pragma unroll
      for (int u = 0; u < 4; ++u) { const int q = r0 + u * nw < 2 * 16384 ? r0 + u * nw : r0; const int tab = q >> 14, rr = layer * 16384 + (q & 16383);
          const float* srcp = (tab ? a.in[I_EV] : a.in[I_EU]) + (size_t)rr * D + 16 * c.lane;
#pragma unroll
          for (int j = 0; j < 4; ++j) vq[u][j] = *(const f32x4*)(srcp + 4 * j); }
#pragma unroll
      for (int u = 0; u < 4; ++u) {
        const int q = r0 + u * nw; if (q >= 2 * 16384) break;
        const int tab = q >> 14, rr = layer * 16384 + (q & 16383), r = tab * 32768 + rr;
        f32x4 v[4]; float mx = 0.f;
#pragma unroll
        for (int j = 0; j < 4; ++j) { v[j] = vq[u][j]; mx = fmaxf(mx, fmaxf(fmaxf(fabsf(v[j][0]), fabsf(v[j][1])), fmaxf(fabsf(v[j][2]), fabsf(v[j][3])))); }
        mx = wave_max(mx);
        const float sc = mx > 0.f ? 448.f / mx : 1.f;
        u32x4 o;
#pragma unroll
        for (int j = 0; j < 4; ++j) { int w = 0;
            w = __builtin_amdgcn_cvt_pk_fp8_f32(fminf(fmaxf(v[j][0] * sc, -448.f), 448.f), fminf(fmaxf(v[j][1] * sc, -448.f), 448.f), w, false);
            w = __builtin_amdgcn_cvt_pk_fp8_f32(fminf(fmaxf(v[j][2] * sc, -448.f), 448.f), fminf(fmaxf(v[j][3] * sc, -448.f), 448.f), w, true);
            o[j] = (unsigned)w; }
        *(u32x4*)(a.ws + (tab ? WS_EV : WS_EU) + (size_t)rr * D + 16 * c.lane) = o;
        if (c.lane == 0) ((float*)(a.ws + WS_ESC))[r] = mx > 0.f ? mx * (1.f / 448.f) : 1.f;
      }
    }
}
__device__ __forceinline__ void p0_prologue(const Ctx& c, const Args& a) {
    unsigned char* rgn_ws = a.ws; (void)rgn_ws; RGN(4, 0);
    const bool ssm_first = (c.blk & 1) == 0;
#define P0_SSM() do { const int np = c.nblk >= 256 ? 4 : 1;     \
      for (int u = c.blk; u < 2 * NG * np; u += c.nblk) ssm_tables_unit(c, a, (u / np) / NG, (u / np) % NG, u % np, np); } while (0)
    if (ssm_first) P0_SSM();
    RGN(4, 1); RGN(5, 0);
    const int gw = c.blk * 8 + c.wave, NGW = c.nblk * 8;
    {
        constexpr int I0 = 80, I1 = 16, I2 = 64, I3 = 128, I4 = 64, I5 = 16, IL = I0 + I1 + I2 + I3 + I4 + I5;
        __syncthreads();
        for (int it = c.blk; it < 2 * IL; it += c.nblk) {
            const int L = it / IL; int r = it % IL; unsigned char* lw = a.ws + WS_LW + (size_t)L * LW_STRIDE;
            if (r < I0) { transpose_wg_item(c, a.in[I_WIN] + (size_t)L * D * DIN, D, DIN, (bf16_t*)(lw + LW_WIN), a.in[I_NMIXG] + L * D, r); continue; } r -= I0;
            if (r < I1) { transpose_wg_item(c, a.in[I_WGLU] + (size_t)L * 512 * 512, 512, 512, (bf16_t*)(lw + LW_WGLU), nullptr, r); continue; } r -= I1;
            if (r < I2) { const int k0 = 64 * (r / 4); const float* gn = k0 < 512 ? a.in[I_SSMG] + L * 512 : a.in[I_ATTG] + L * 512 - 512;
                transpose_wg_item(c, a.in[I_WOUT] + (size_t)L * D * D, D, D, (bf16_t*)(lw + LW_WOUT), gn, r); continue; } r -= I2;
            if (r < I3) { transpose_wg_item(c, a.in[I_WQ] + (size_t)L * D * 2048, D, 2048, (bf16_t*)(lw + LW_WQ), a.in[I_NFFNG] + L * D, r); continue; } r -= I3;
            if (r < I4) { transpose_wg_item(c, a.in[I_WGATE] + (size_t)L * D * D, D, D, (bf16_t*)(lw + LW_WGATE), a.in[I_NPLEG] + L * D, r); continue; } r -= I4;
            transpose_wg_item(c, a.in[I_WPROJ] + (size_t)L * 256 * D, 256, D, (bf16_t*)(lw + LW_WPROJ), nullptr, r);
        }
    }
    RGN(5, 1); RGN(6, 0);
    cvt_fp8_layer(c, a, 0, gw, NGW);
    if (c.nblk != 256) cvt_fp8_layer(c, a, 1, gw, NGW);
    RGN(6, 1); RGN(7, 0);
    cvt_range(c, a.in[I_P], (bf16_t*)(a.ws + WS_PB), (size_t)2 * M * 256);
    for (int L = 0; L < 2; ++L) {
        cvt_range(c, a.in[I_SK1] + (size_t)L * 8 * 128 * 128, (bf16_t*)(a.ws + WS_LW + (size_t)L * LW_STRIDE + LW_SK1), (size_t)8 * 128 * 128);
        cvt_range(c, a.in[I_SK2] + (size_t)L * 8 * 128 * 128, (bf16_t*)(a.ws + WS_LW + (size_t)L * LW_STRIDE + LW_SK2), (size_t)8 * 128 * 128);
    }
    RGN(7, 1); RGN(8, 0);
    {
        bf16_t* XB = (bf16_t*)(a.ws + WS_XB); float* SSQ0 = (float*)(a.ws + WS_SSQ0);
        for (int m = gw; m < M; m += NGW) {
            const f32x4* xr = (const f32x4*)(a.in[I_X] + (size_t)m * D) + c.lane; float s = 0.f;
#pragma unroll
            for (int j = 0; j < 4; ++j) { const f32x4 v = xr[64 * j]; s += v[0] * v[0] + v[1] * v[1] + v[2] * v[2] + v[3] * v[3];
                *(u32x2*)(XB + (size_t)m * D + 256 * j + 4 * c.lane) = pack4(v); }
            s = wave_sum(s);
            if (c.lane < 16) SSQ0[(size_t)m * 16 + c.lane] = c.lane == 0 ? s : 0.f;
        }
    }
    RGN(8, 1);
    if (!ssm_first) P0_SSM();
#undef P0_SSM
    if (c.blk == c.nblk - 1) {
        float* R = (float*)(a.ws + WS_ROPE);
        for (int e = c.tid; e < 3072; e += 512) {
            const bool isr = e < 2048; const int pos = isr ? (e >> 4) : ((e - 2048) >> 4), f = e & 15;
            const float inv = powf(10000.f, -(float)f / 16.f), ang = (float)pos * inv; float sn, cs; sincosf(ang, &sn, &cs);
            if (isr) { R[e] = cs; R[2048 + e] = sn; } else { R[4096 + (e - 2048)] = cs; R[5120 + (e - 2048)] = sn; }
        }
    }
}

__device__ __forceinline__ void s1_unit(const Ctx& c, const Args& a, int layer, int gb  ) {
    unsigned char* lw = a.ws + WS_LW + (size_t)layer * LW_STRIDE;
    bf16_t* UC = (bf16_t*)(a.ws + WS_UCAT); float* EB = (float*)(a.ws + WS_EBUF);
    const int g = gb >> 1;
    GemmD gd; gd.A = UC; gd.lda = KCAT; gd.Bt = (const bf16_t*)(lw + LW_WE); gd.ldb = 512; gd.K = 512; gd.kmid = -1;
    EpiS1 E; E.ebuf = EB;
    Unit u; u.pm = gb; u.pn = g;
    unsigned char* rgn_ws = a.ws; (void)rgn_ws; if (layer == 0) RGN(1, 0);
#ifdef USE_SGEMM
    sgemm_unit(gd, u, E, c.wave, c.lane);
#else
    { pg8::OneUnit S; S.u = u; run_gemm(c.lds, gd, S, E, c.tid); }
#endif
    VM_WAIT(); __syncthreads();
    if (layer == 0) { RGN(1, 1); RGN(2, 0); }
    {
        const float* AL = (const float*)(lw + LW_AL);
        f32x4* Es4 = (f32x4*)c.lds; const float* Es = (const float*)c.lds;
        float* SEG = (float*)(c.lds + LDSCTL_OFF + 1024);
        const int n = c.lane, sg = c.wave;
        for (int dir = 0; dir < 2; ++dir) {
            {
#pragma unroll 1
                for (int k0 = 0; k0 < 16; k0 += 8) { f32x4 ev[8];
#pragma unroll
                    for (int k = 0; k < 8; ++k) { const int i = c.tid + 512 * (k0 + k), ch = i >> 5, q4 = i & 31; ev[k] = *(const f32x4*)(EB + ((size_t)gb * NCH + ch) * 256 + dir * 128 + q4 * 4); }
#pragma unroll
                    for (int k = 0; k < 8; ++k) Es4[c.tid + 512 * (k0 + k)] = ev[k]; }
            }
            __syncthreads();
            const float alr = AL[((dir * NG + g) * 64 + n) * 2 + 0], ali = AL[((dir * NG + g) * 64 + n) * 2 + 1];
            float hr = 0.f, hi = 0.f, pr = 1.f, pi = 0.f;
#pragma unroll 8
            for (int s = 0; s < 32; ++s) {
                const int st = sg * 32 + s, ch = dir == 0 ? st : NCH - 1 - st;
                const float er = Es[ch * 128 + n], ei = Es[ch * 128 + 64 + n];
                const float nr = alr * hr - ali * hi + er, ni = alr * hi + ali * hr + ei; hr = nr; hi = ni;
                const float qr = pr * alr - pi * ali, qi = pr * ali + pi * alr; pr = qr; pi = qi;
            }
            SEG[(sg * 64 + n) * 2] = hr; SEG[(sg * 64 + n) * 2 + 1] = hi;
            __syncthreads();
            float sr = 0.f, si = 0.f;
            for (int j = 0; j < sg; ++j) { const float er = SEG[(j * 64 + n) * 2], ei = SEG[(j * 64 + n) * 2 + 1];
                const float nr = pr * sr - pi * si + er, ni = pr * si + pi * sr + ei; sr = nr; si = ni; }
            hr = sr; hi = si;
            bf16_t* hc = UC + (size_t)gb * NCH * KCAT + 512 + dir * 128 + n;
#pragma unroll 8
            for (int s = 0; s < 32; ++s) {
                const int st = sg * 32 + s, ch = dir == 0 ? st : NCH - 1 - st;
                hc[(size_t)ch * KCAT] = (bf16_t)f2bf(hr); hc[(size_t)ch * KCAT + 64] = (bf16_t)f2bf(hi);
                const float er = Es[ch * 128 + n], ei = Es[ch * 128 + 64 + n];
                const float nr = alr * hr - ali * hi + er, ni = alr * hi + ali * hr + ei; hr = nr; hi = ni;
            }
            __syncthreads();
        }
    }
    if (layer == 0) RGN(2, 1);
}
constexpr int QKP_N = 8;
__device__ __forceinline__ void qkprep(const Ctx& c, const Args& a, int layer, int widx, int nw, int mode = 0, int tok0 = 0) {
    bf16_t* QR = (bf16_t*)(a.ws + WS_QRAW); bf16_t* KV = (bf16_t*)(a.ws + WS_KV); const float* R = (const float*)(a.ws + WS_ROPE);
    const int half = c.lane >> 5, i = c.lane & 31, f = i & 15;
    const int d = i < 16 ? i : 32 + (i - 16);
    unsigned char* rgn_ws = a.ws; (void)rgn_ws; if (layer == 0) RGN(3, 0);
    const float gq1 = a.in[I_QNG][layer * 64 + d], gq2 = a.in[I_QNG][layer * 64 + d + 16], gk1 = a.in[I_KNG][layer * 64 + d], gk2 = a.in[I_KNG][layer * 64 + d + 16];
    const int nitems = mode == 0 ? M * 5 : mode == 1 ? M * 4 : 256;
    for (int base = widx; base < nitems; base += QKP_N * nw) {
        bf16_t* p[QKP_N]; float x1[QKP_N], x2[QKP_N], cs[QKP_N], sn[QKP_N]; int hh[QKP_N]; bool ok[QKP_N];
#pragma unroll
        for (int u = 0; u < QKP_N; ++u) {
            int it = base + u * nw; ok[u] = it < nitems; if (!ok[u]) it = base;
            const int m = mode == 0 ? it / 5 : mode == 1 ? it >> 2 : tok0 + it; hh[u] = (mode == 0 ? it % 5 : mode == 1 ? (it & 3) : 4) * 2 + half;
            p[u] = hh[u] < 8 ? QR + (size_t)m * 512 + hh[u] * 64 : KV + (size_t)m * 256 + (hh[u] - 8) * 64;
            x1[u] = bf1(p[u][d]); x2[u] = bf1(p[u][d + 16]);
            const int s = m & (SEQ - 1);
            if (i < 16) { const int pos = s >> 6; cs[u] = R[pos * 16 + f]; sn[u] = R[2048 + pos * 16 + f]; }
            else { const int pos = s & 63; cs[u] = R[4096 + pos * 16 + f]; sn[u] = R[5120 + pos * 16 + f]; }
        }
#pragma unroll
        for (int u = 0; u < QKP_N; ++u) {
            float ss = x1[u] * x1[u] + x2[u] * x2[u];
#pragma unroll
            for (int o = 1; o < 32; o <<= 1) ss += __shfl_xor(ss, o);
            const float rstd = rsqrtf(ss * (1.f / 64.f) + EPS);
            const float y1 = x1[u] * rstd * (hh[u] < 8 ? gq1 : gk1), y2 = x2[u] * rstd * (hh[u] < 8 ? gq2 : gk2);
            float o1 = y1 * cs[u] - y2 * sn[u], o2 = y2 * cs[u] + y1 * sn[u];
            if (hh[u] < 8) { o1 *= C2; o2 *= C2; }
            if (ok[u]) { p[u][d] = (bf16_t)f2bf(o1); p[u][d + 16] = (bf16_t)f2bf(o2); }
        }
    }
    if (layer == 0) RGN(3, 1);
}

#include <hip/hip_bf16.h>
#include <cmath>
namespace attn_body {
using bf16=__hip_bfloat16;
using bf16x8=__attribute__((ext_vector_type(8)))short;
using s16x4=__attribute__((ext_vector_type(4)))short;
using f32x16=__attribute__((ext_vector_type(16)))float;
using u32x4=__attribute__((ext_vector_type(4)))unsigned;
constexpr int SEQ=8192,D=64,QPITCH=512,KVPITCH=256,OPITCH=1024;
constexpr int NW=8,QBLK=32,QB=QBLK*NW,KVBLK=64,NQB=SEQ/QB;
__device__ __forceinline__ int crow(int r,int hi){return (r&3)+8*(r>>2)+4*hi;}
#define SBAR() __builtin_amdgcn_sched_barrier(0)
__device__ __forceinline__ void cmask(f32x16&p0,f32x16&p1,int jb,int qrel,int hi){
  const float NEG=-INFINITY; int kb=64*jb+4*hi;
  #pragma unroll
  for(int r=0;r<16;++r){int kv=kb+(r&3)+8*(r>>2); if(kv>qrel)p0[r]=NEG; if(kv+32>qrel)p1[r]=NEG;}
}

constexpr int NSLOT=3, SLOTB=8192;
constexpr int LDS_K=0, LDS_V=NSLOT*SLOTB, LDS_WS=2*NSLOT*SLOTB, LDS_OST=LDS_WS+NW*64*4, LDS_BYTES=LDS_OST+NW*4096;
constexpr float C2=0.125f*1.4426950408889634f;
__device__ __forceinline__ void glds16(const void*gsrc,unsigned lds_dst){unsigned keep;
  asm volatile("s_mov_b32 %0, m0\n\ts_mov_b32 m0, %2\n\ts_nop 0\n\tglobal_load_lds_dwordx4 %1, off\n\ts_mov_b32 m0, %0":"=&s"(keep):"v"(gsrc),"s"(lds_dst):"memory");}
__device__ __forceinline__ float max3f(float a,float b,float c){float r;asm("v_max3_f32 %0, %1, %2, %3":"=v"(r):"v"(a),"v"(b),"v"(c));return r;}
__device__ __forceinline__ float max2f(float a,float b){float r;asm("v_max_f32_e32 %0, %1, %2":"=v"(r):"v"(a),"v"(b));return r;}
__device__ __forceinline__ float fadd_s(float a,float b){float r;asm("v_add_f32_e32 %0, %1, %2":"=v"(r):"v"(a),"v"(b));return r;}
__device__ __forceinline__ float fsub_s(float a,float b){float r;asm("v_sub_f32_e32 %0, %1, %2":"=v"(r):"v"(a),"v"(b));return r;}
typedef float f32x2_t __attribute__((ext_vector_type(2))); typedef __bf16 bf16x2_t __attribute__((ext_vector_type(2)));
__device__ __forceinline__ unsigned cvtpk_s(float lo,float hi){f32x2_t v={lo,hi};bf16x2_t b=__builtin_convertvector(v,bf16x2_t);return __builtin_bit_cast(unsigned,b);}
#define WAIT_BAR(N) asm volatile("s_waitcnt vmcnt(" #N ") lgkmcnt(0)\n\ts_barrier":::"memory")

__device__ __forceinline__ void qkt(f32x16&p0,f32x16&p1,const char*Kslot,const bf16x8*qr,const f32x16&negm,int r32,int hi){
  const char*kb=Kslot+hi*1024+r32*16;
  #pragma unroll
  for(int d0=0;d0<4;++d0){
    const bf16x8 b0=*reinterpret_cast<const bf16x8*>(kb+d0*2048);
    const bf16x8 b1=*reinterpret_cast<const bf16x8*>(kb+d0*2048+512);
    if(d0==0){p0=__builtin_amdgcn_mfma_f32_32x32x16_bf16(b0,qr[0],negm,0,0,0);p1=__builtin_amdgcn_mfma_f32_32x32x16_bf16(b1,qr[0],negm,0,0,0);}
    else{p0=__builtin_amdgcn_mfma_f32_32x32x16_bf16(b0,qr[d0],p0,0,0,0);p1=__builtin_amdgcn_mfma_f32_32x32x16_bf16(b1,qr[d0],p1,0,0,0);}}
}
typedef __attribute__((address_space(3))) const char* lds_cptr;
typedef short v4i16_t __attribute__((ext_vector_type(4)));
__device__ __forceinline__ void kload8(bf16x8*kf,lds_cptr kp){
  kf[0]=*(const __attribute__((address_space(3))) bf16x8*)(kp);      kf[1]=*(const __attribute__((address_space(3))) bf16x8*)(kp+512);
  kf[2]=*(const __attribute__((address_space(3))) bf16x8*)(kp+2048); kf[3]=*(const __attribute__((address_space(3))) bf16x8*)(kp+2560);
  kf[4]=*(const __attribute__((address_space(3))) bf16x8*)(kp+4096); kf[5]=*(const __attribute__((address_space(3))) bf16x8*)(kp+4608);
  kf[6]=*(const __attribute__((address_space(3))) bf16x8*)(kp+6144); kf[7]=*(const __attribute__((address_space(3))) bf16x8*)(kp+6656);
}
__device__ __forceinline__ void kload2(bf16x8*kf,lds_cptr kp,int j){ kf[2*j]=*(const __attribute__((address_space(3))) bf16x8*)(kp+j*2048); kf[2*j+1]=*(const __attribute__((address_space(3))) bf16x8*)(kp+j*2048+512); }
__device__ __forceinline__ s16x4 vtr(lds_cptr p){ return __builtin_bit_cast(s16x4,__builtin_amdgcn_ds_read_tr16_b64_v4i16((__attribute__((address_space(3))) v4i16_t*)p)); }
__device__ __forceinline__ float rowmax(const f32x16&p0,const f32x16&p1){
  float a=max3f(p0[0],p0[1],p1[0]),b=max3f(p0[2],p0[3],p1[1]);a=max3f(a,p1[2],p1[3]);
  #pragma unroll
  for(int r=4;r<16;r+=4){a=max3f(a,p0[r],p0[r+1]);b=max3f(b,p0[r+2],p0[r+3]);a=max3f(a,p1[r],p1[r+1]);b=max3f(b,p1[r+2],p1[r+3]);}
  const float m=max2f(a,b);
  auto rr=__builtin_amdgcn_permlane32_swap(__float_as_uint(m),__float_as_uint(m),false,false);
  return max2f(__uint_as_float(rr[0]),__uint_as_float(rr[1]));
}
__device__ __forceinline__ void pv(f32x16*o,int vb,bf16x8 pa0,bf16x8 pa1,bf16x8 pa2,bf16x8 pa3){
  #pragma unroll
  for(int d0=0;d0<2;++d0){s16x4 lo[4],hi[4];
    #pragma unroll
    for(int ks=0;ks<4;++ks){
      asm volatile("ds_read_b64_tr_b16 %0,%1 offset:%c2":"=&v"(lo[ks]):"v"(vb),"i"(d0*4096+ks*1024):"memory");
      asm volatile("ds_read_b64_tr_b16 %0,%1 offset:%c2":"=&v"(hi[ks]):"v"(vb),"i"(d0*4096+ks*1024+512):"memory");}
    asm volatile("s_waitcnt lgkmcnt(0)":::"memory");SBAR();
    #define PK(k) (bf16x8){lo[k][0],lo[k][1],lo[k][2],lo[k][3],hi[k][0],hi[k][1],hi[k][2],hi[k][3]}
    o[d0]=__builtin_amdgcn_mfma_f32_32x32x16_bf16(pa0,PK(0),o[d0],0,0,0);
    o[d0]=__builtin_amdgcn_mfma_f32_32x32x16_bf16(pa1,PK(1),o[d0],0,0,0);
    o[d0]=__builtin_amdgcn_mfma_f32_32x32x16_bf16(pa2,PK(2),o[d0],0,0,0);
    o[d0]=__builtin_amdgcn_mfma_f32_32x32x16_bf16(pa3,PK(3),o[d0],0,0,0);
    #undef PK
  }
}

#ifndef ATTN_STORE16
#define ATTN_STORE16(p,v) (*(u32x4*)(p)=(v))
#endif
template<int THRL> __device__ __forceinline__ void attn_unit(int b,int h,int qb,const bf16*Q,const bf16*KV,bf16*O,float*SSQA,char*shm,const int tid,const float mfix){
  const int lane=tid&63,r32=lane&31,hi=lane>>5; const int wid=__builtin_amdgcn_readfirstlane(tid>>6);
  const long rowbase=(long)b*SEQ; const int q0=qb*QB;
  const bf16*Qw=Q+(rowbase+q0+wid*QBLK)*QPITCH+h*D;
  const bf16*Kh=KV+rowbase*KVPITCH+(h>>2)*D,*Vh=Kh+128;
  const unsigned lds0=(unsigned)(uintptr_t)shm;
  float*wsf=(float*)(shm+LDS_WS)+wid*64;
  const bf16*ksrc=Kh+(long)lane*KVPITCH+wid*8;
  const bf16*vsrc=Vh+(long)(16*(wid&3)+(lane>>2))*KVPITCH+(wid>>2)*32+(lane&3)*8;
  const unsigned kdst=lds0+LDS_K+wid*1024, vdst=lds0+LDS_V+wid*1024;
  #define DMA_K(t,slot) glds16(ksrc+(long)(t)*KVBLK*KVPITCH,(unsigned)__builtin_amdgcn_readfirstlane(kdst+(slot)))
  #define DMA_V(t,slot) glds16(vsrc+(long)(t)*KVBLK*KVPITCH,(unsigned)__builtin_amdgcn_readfirstlane(vdst+(slot)))
  const int vb0=(int)(lds0+LDS_V)+((lane>>4)&1)*32+(lane&3)*8+(4*hi+((lane&15)>>2))*64;
  const char*Kbase=shm+LDS_K; bf16x8 kf[8];
  const lds_cptr shm3=(lds_cptr)shm; const lds_cptr kp0=shm3+LDS_K+hi*1024+r32*16; const lds_cptr vp0=shm3+LDS_V+((lane>>4)&1)*32+(lane&3)*8+(4*hi+((lane&15)>>2))*64;
  const int NT=SEQ/KVBLK;
  DMA_K(0,0);DMA_V(0,0);DMA_K(1,SLOTB);
  bf16x8 qr[4];
  #pragma unroll
  for(int d0=0;d0<4;++d0)qr[d0]=*reinterpret_cast<const bf16x8*>(&Qw[(long)r32*QPITCH+d0*16+hi*8]);
  float mhat=0.f,l_reg=0.f;f32x16 o[2];f32x16 negm;{float z_=0.f;asm volatile("":"+v"(z_));
  #pragma unroll
  for(int r=0;r<16;++r){o[0][r]=z_;o[1][r]=z_;negm[r]=(THRL<0)?(z_-mfix):z_;}}asm volatile("":"+v"(negm)); if(THRL<0)mhat=mfix;
  #define CMASK(P0,P1,t) do{}while(0)
  bool resc=false;
  #define START(P0,P1) do{ resc=false; \
    if constexpr(THRL>=0){ const float rm=rowmax(P0,P1); const float dl=rm; mhat=fadd_s(mhat,dl); \
      _Pragma("unroll") for(int r=0;r<16;++r){P0[r]=fsub_s(P0[r],dl);P1[r]=fsub_s(P1[r],dl);} \
      _Pragma("unroll") for(int r=0;r<16;++r)negm[r]=-mhat; asm volatile("":"+v"(negm)); } \
    _Pragma("unroll") for(int r=0;r<16;++r)P0[r]=__builtin_amdgcn_exp2f(P0[r]); }while(0)
  #define RESC() do{ if(resc){ asm volatile("s_waitcnt lgkmcnt(0)":::"memory"); \
      _Pragma("unroll") for(int d_=0;d_<2;++d_) _Pragma("unroll") for(int r=0;r<16;++r)o[d_][r]*=wsf[crow(r,hi)]; } }while(0)
  f32x16 pA0,pA1,pB0,pB1;
  int sl_prev=0,sl_cur=0,sl_next=SLOTB;
  #define ROT() do{sl_prev=sl_cur;sl_cur=sl_next;sl_next=(sl_next==(NSLOT-1)*SLOTB)?0:sl_next+SLOTB;}while(0)
  DMA_K(2,2*SLOTB);
  WAIT_BAR(3);
  qkt(pA0,pA1,Kbase,qr,negm,r32,hi);asm volatile("s_nop 15\n\ts_nop 7":"+v"(pA0),"+v"(pA1));CMASK(pA0,pA1,0);
  START(pA0,pA1);
  _Pragma("unroll") for(int r=0;r<16;++r)pA1[r]=__builtin_amdgcn_exp2f(pA1[r]);
  WAIT_BAR(0);
  DMA_K(3,0);DMA_V(1,SLOTB);
  ROT();
  kload8(kf,kp0+sl_cur);
  WAIT_BAR(2);
  s16x4 vlo[8],vhi[8]; u32x4 pw0,pw1,pw2,pw3;
  #define PKW(P,B) cvtpk_s(P[B],P[B+1])
  #define PAF(k) __builtin_bit_cast(bf16x8,pw##k)
  #define VFR(i) (bf16x8){vlo[i][0],vlo[i][1],vlo[i][2],vlo[i][3],vhi[i][0],vhi[i][1],vhi[i][2],vhi[i][3]}
  #define PIN(x) asm volatile("":"+v"(x))
  #define MX3(a,b,c) __builtin_fmaxf(__builtin_fmaxf((a),(b)),(c))
  #define GAPA(MF,A0,A1,A2,A3,W0,W1,PW) do{ MF; sacc+=A0; sacc+=A1; sacc+=A2; sacc+=A3; PIN(sacc); W0; W1; PIN(PW); SBAR(); }while(0)
  #define EX(v) __builtin_amdgcn_exp2f(v)
  #define GAPB(MF,X,B) do{ MF; X[B]=EX(X[B]); X[B+1]=EX(X[B+1]); X[B+2]=EX(X[B+2]); X[B+3]=EX(X[B+3]); PIN(X); SBAR(); }while(0)
  #define VRD(i) do{ vlo[i]=vtr(vp_+(((i)>>2)*4096+((i)&3)*1024)); vhi[i]=vtr(vp_+(((i)>>2)*4096+((i)&3)*1024+512)); }while(0)
  #define KRD(G,j) do{ if(G){ kload2(kf,kp0+sl_next,j); SBAR(); } }while(0)
  #define STEP(C0,C1,P0,P1,t,GK,GV,GL) do{ SBAR(); \
    const lds_cptr vp_=vp0+sl_prev; \
    VRD(0); SBAR(); float sacc=(P0[0]+P0[1]); \
    GAPA(C0=__builtin_amdgcn_mfma_f32_32x32x16_bf16(kf[0],qr[0],negm,0,0,0), P0[2],P0[3],P0[4],P0[5],     pw0[0]=PKW(P0,0), pw0[1]=PKW(P0,2), pw0); \
    VRD(4); SBAR(); GAPA(C1=__builtin_amdgcn_mfma_f32_32x32x16_bf16(kf[1],qr[0],negm,0,0,0), P0[6],P0[7],P0[8],P0[9],     pw0[2]=PKW(P0,4), pw0[3]=PKW(P0,6), pw0); \
    VRD(1); SBAR(); GAPA(C0=__builtin_amdgcn_mfma_f32_32x32x16_bf16(kf[2],qr[1],C0,0,0,0),   P0[10],P0[11],P0[12],P0[13], pw1[0]=PKW(P0,8), pw1[1]=PKW(P0,10), pw1); \
    VRD(5); SBAR(); GAPA(C1=__builtin_amdgcn_mfma_f32_32x32x16_bf16(kf[3],qr[1],C1,0,0,0),   P0[14],P0[15],P1[0],P1[1],   pw1[2]=PKW(P0,12),pw1[3]=PKW(P0,14), pw1); \
    VRD(2); SBAR(); GAPA(C0=__builtin_amdgcn_mfma_f32_32x32x16_bf16(kf[4],qr[2],C0,0,0,0),   P1[2],P1[3],P1[4],P1[5],     pw2[0]=PKW(P1,0), pw2[1]=PKW(P1,2), pw2); \
    VRD(6); SBAR(); GAPA(C1=__builtin_amdgcn_mfma_f32_32x32x16_bf16(kf[5],qr[2],C1,0,0,0),   P1[6],P1[7],P1[8],P1[9],     pw2[2]=PKW(P1,4), pw2[3]=PKW(P1,6), pw2); \
    VRD(3); SBAR(); GAPA(C0=__builtin_amdgcn_mfma_f32_32x32x16_bf16(kf[6],qr[3],C0,0,0,0),   P1[10],P1[11],P1[12],P1[13], pw3[0]=PKW(P1,8), pw3[1]=PKW(P1,10), pw3); \
    VRD(7); SBAR(); GAPA(C1=__builtin_amdgcn_mfma_f32_32x32x16_bf16(kf[7],qr[3],C1,0,0,0),   P1[14],P1[15],0.f,0.f,       pw3[2]=PKW(P1,12),pw3[3]=PKW(P1,14), pw3); \
    l_reg+=sacc; \
    if(GK){DMA_K((t)+3,sl_cur);} if(GV){DMA_V((t)+1,sl_next);} \
    CMASK(C0,C1,t); \
    if constexpr(THRL>=0){ float a=MX3(C0[0],C0[1],C1[0]),b=MX3(C0[2],C0[3],C1[1]); a=MX3(a,C1[2],C1[3]); \
      _Pragma("unroll") for(int r=4;r<16;r+=4){a=MX3(a,C0[r],C0[r+1]);b=MX3(b,C0[r+2],C0[r+3]);a=MX3(a,C1[r],C1[r+1]);b=MX3(b,C1[r+2],C1[r+3]);} \
      float rm=__builtin_fmaxf(a,b); { auto rr=__builtin_amdgcn_permlane32_swap(__float_as_uint(rm),__float_as_uint(rm),false,false); rm=__builtin_fmaxf(__uint_as_float(rr[0]),__uint_as_float(rr[1])); } \
      resc=false; \
      if(__builtin_expect(__any(rm>(float)THRL),0)){ const float dl=__builtin_fmaxf(rm,0.f); mhat+=dl; \
        _Pragma("unroll") for(int r=0;r<16;++r){C0[r]-=dl;C1[r]-=dl;} \
        _Pragma("unroll") for(int r=0;r<16;++r)negm[r]=-mhat; asm volatile("":"+v"(negm)); \
        const float f=__builtin_amdgcn_exp2f(-dl); l_reg*=f; if(hi==0)wsf[r32]=f; resc=true; } } \
    SBAR(); \
    GAPB(o[0]=__builtin_amdgcn_mfma_f32_32x32x16_bf16(PAF(0),VFR(0),o[0],0,0,0), C0,0); \
    GAPB(o[1]=__builtin_amdgcn_mfma_f32_32x32x16_bf16(PAF(0),VFR(4),o[1],0,0,0), C0,4); \
    KRD(GL,0); GAPB(o[0]=__builtin_amdgcn_mfma_f32_32x32x16_bf16(PAF(1),VFR(1),o[0],0,0,0), C0,8); \
    KRD(GL,1); GAPB(o[1]=__builtin_amdgcn_mfma_f32_32x32x16_bf16(PAF(1),VFR(5),o[1],0,0,0), C0,12); \
    KRD(GL,2); GAPB(o[0]=__builtin_amdgcn_mfma_f32_32x32x16_bf16(PAF(2),VFR(2),o[0],0,0,0), C1,0); \
    KRD(GL,3); GAPB(o[1]=__builtin_amdgcn_mfma_f32_32x32x16_bf16(PAF(2),VFR(6),o[1],0,0,0), C1,4); \
    GAPB(o[0]=__builtin_amdgcn_mfma_f32_32x32x16_bf16(PAF(3),VFR(3),o[0],0,0,0), C1,8); \
    GAPB(o[1]=__builtin_amdgcn_mfma_f32_32x32x16_bf16(PAF(3),VFR(7),o[1],0,0,0), C1,12); \
    }while(0)
  int t=1;
  #undef CMASK
  #define CMASK(P0,P1,t) do{}while(0)
  for(;t+5<NT;t+=2){
    STEP(pB0,pB1,pA0,pA1,t,true,true,true);     WAIT_BAR(2); RESC(); ROT();
    STEP(pA0,pA1,pB0,pB1,t+1,true,true,true);   WAIT_BAR(2); RESC(); ROT();
  }
  #undef CMASK
  #define CMASK(P0,P1,t) do{}while(0)
  #define ENDW(tt) do{ if((tt)+3<NT){WAIT_BAR(2);} else if((tt)+2<NT){WAIT_BAR(1);} else {WAIT_BAR(0);} }while(0)
  for(;t+1<NT;t+=2){
    STEP(pB0,pB1,pA0,pA1,t,(t+3<NT),(t+1<NT),(t+1<NT));       ENDW(t);   RESC(); ROT();
    STEP(pA0,pA1,pB0,pB1,t+1,(t+4<NT),(t+2<NT),(t+2<NT));     ENDW(t+1); RESC(); ROT();
  }
  STEP(pB0,pB1,pA0,pA1,NT-1,false,false,false); RESC();
  { float sacc=pB0[0]+pB0[1]; _Pragma("unroll") for(int r=2;r<16;++r)sacc+=pB0[r]; _Pragma("unroll") for(int r=0;r<16;++r)sacc+=pB1[r]; l_reg+=sacc;
    pw0=(u32x4){PKW(pB0,0),PKW(pB0,2),PKW(pB0,4),PKW(pB0,6)};pw1=(u32x4){PKW(pB0,8),PKW(pB0,10),PKW(pB0,12),PKW(pB0,14)};pw2=(u32x4){PKW(pB1,0),PKW(pB1,2),PKW(pB1,4),PKW(pB1,6)};pw3=(u32x4){PKW(pB1,8),PKW(pB1,10),PKW(pB1,12),PKW(pB1,14)};
    SBAR(); pv(o,vb0+sl_cur,PAF(0),PAF(1),PAF(2),PAF(3)); }
  #undef PKW
  #undef PAF
  #undef VFR
  #undef PIN
  #undef MX3
  #undef GAPA
  #undef GAPB
  #undef EX
  #undef VRD
  #undef KRD
  #undef STEP
  #undef ENDW
  {auto rr=__builtin_amdgcn_permlane32_swap(__float_as_uint(l_reg),__float_as_uint(l_reg),false,false);l_reg=__uint_as_float(rr[0])+__uint_as_float(rr[1]);}
  if(hi==0)wsf[32+r32]=l_reg;asm volatile("s_waitcnt lgkmcnt(0)":::"memory");
  float rli[16];
  #pragma unroll
  for(int r=0;r<16;++r)rli[r]=__builtin_amdgcn_rcpf(wsf[32+crow(r,hi)]);
  bf16*Ow=O+(rowbase+q0+wid*QBLK)*OPITCH+512+h*D; float*Sw=SSQA+(rowbase+q0+wid*QBLK)*16+h;
  { bf16*stg=(bf16*)(shm+LDS_OST)+wid*2048;
    #pragma unroll
    for(int r=0;r<16;++r){const int orow=crow(r,hi);
      #pragma unroll
      for(int d0=0;d0<2;++d0)stg[orow*64+d0*32+r32]=__float2bfloat16(o[d0][r]*rli[r]);}
    asm volatile("s_waitcnt lgkmcnt(0)":::"memory");
    #pragma unroll
    for(int i=0;i<4;++i){const int row=i*8+(lane>>3),ch=lane&7; const u32x4 v=*(const u32x4*)(stg+row*64+ch*8); ATTN_STORE16(Ow+(long)row*OPITCH+ch*8,v);
      float ss=0.f; for(int e=0;e<4;++e){const float lo_=__uint_as_float(v[e]<<16),hi_=__uint_as_float(v[e]&0xffff0000u); ss+=lo_*lo_+hi_*hi_;}
      ss+=__shfl_xor(ss,1); ss+=__shfl_xor(ss,2); ss+=__shfl_xor(ss,4); if(ch==0)Sw[(long)row*16]=ss; } }
  asm volatile("s_waitcnt lgkmcnt(0)\n\ts_barrier":::"memory");
  #undef DMA_K
  #undef DMA_V
  #undef CMASK
  #undef START
  #undef RESC
  #undef ROT
}
constexpr int ATTN_LDS_BYTES=LDS_BYTES;
#undef SBAR
#undef WAIT_BAR
}

#ifdef ATT_NAIVE
__device__ __forceinline__ void attn_naive_unit(const Ctx& c, const Args& a, int b, int h, int qblk) {
    const bf16_t* QR = (const bf16_t*)(a.ws + WS_QRAW); const bf16_t* KV = (const bf16_t*)(a.ws + WS_KV);
    bf16_t* Y = (bf16_t*)(a.ws + WS_Y); float* SSQA = (float*)(a.ws + WS_SSQA);
    float* Ks = (float*)c.lds; float* Vs = Ks + 64 * 64;
    const long row = (long)b * SEQ + qblk * 512 + c.tid; const int kvh = h >> 2;
    float q[64], o[64];
#pragma unroll
    for (int v = 0; v < 8; ++v) { const u32x4 w = *(const u32x4*)(QR + row * 512 + h * 64 + v * 8);
        q[v * 8 + 0] = bflo(w.x); q[v * 8 + 1] = bfhi(w.x); q[v * 8 + 2] = bflo(w.y); q[v * 8 + 3] = bfhi(w.y);
        q[v * 8 + 4] = bflo(w.z); q[v * 8 + 5] = bfhi(w.z); q[v * 8 + 6] = bflo(w.w); q[v * 8 + 7] = bfhi(w.w); }
#pragma unroll
    for (int dd = 0; dd < 64; ++dd) o[dd] = 0.f;
    float mrun = -1e30f, l = 0.f;
    const int lk = c.tid >> 3, lp = c.tid & 7;
    for (int t0 = 0; t0 < SEQ; t0 += 64) {
        __syncthreads();
        { const bf16_t* kp = KV + ((long)b * SEQ + t0 + lk) * 256 + kvh * 64 + lp * 8;
          const u32x4 kw = *(const u32x4*)kp, vw = *(const u32x4*)(kp + 128);
          float* kd = Ks + lk * 64 + lp * 8; float* vd = Vs + lk * 64 + lp * 8;
          kd[0] = bflo(kw.x); kd[1] = bfhi(kw.x); kd[2] = bflo(kw.y); kd[3] = bfhi(kw.y); kd[4] = bflo(kw.z); kd[5] = bfhi(kw.z); kd[6] = bflo(kw.w); kd[7] = bfhi(kw.w);
          vd[0] = bflo(vw.x); vd[1] = bfhi(vw.x); vd[2] = bflo(vw.y); vd[3] = bfhi(vw.y); vd[4] = bflo(vw.z); vd[5] = bfhi(vw.z); vd[6] = bflo(vw.w); vd[7] = bfhi(vw.w); }
        __syncthreads();
#pragma unroll 1
        for (int j = 0; j < 64; ++j) {
            float acc = 0.f; const float* kr = Ks + j * 64;
#pragma unroll
            for (int dd = 0; dd < 64; dd += 4) { const f32x4 kk = *(const f32x4*)(kr + dd); acc += q[dd] * kk[0] + q[dd + 1] * kk[1] + q[dd + 2] * kk[2] + q[dd + 3] * kk[3];
                if ((dd & 15) == 12) __builtin_amdgcn_sched_barrier(0); }
            if (acc > mrun) { const float sc = exp2f(mrun - acc); l *= sc; mrun = acc;
#pragma unroll
                for (int dd = 0; dd < 64; ++dd) o[dd] *= sc; }
            const float p = exp2f(acc - mrun); l += p; const float* vr = Vs + j * 64;
#pragma unroll
            for (int dd = 0; dd < 64; dd += 4) { const f32x4 vv = *(const f32x4*)(vr + dd); o[dd] += p * vv[0]; o[dd + 1] += p * vv[1]; o[dd + 2] += p * vv[2]; o[dd + 3] += p * vv[3];
                if ((dd & 15) == 12) __builtin_amdgcn_sched_barrier(0); }
        }
    }
    const float il = 1.f / l; float ss = 0.f;
#pragma unroll
    for (int v = 0; v < 8; ++v) { float t[8];
#pragma unroll
        for (int e = 0; e < 8; ++e) { t[e] = o[v * 8 + e] * il; ss += t[e] * t[e]; }
        u32x4 w; w.x = pk2(t[0], t[1]); w.y = pk2(t[2], t[3]); w.z = pk2(t[4], t[5]); w.w = pk2(t[6], t[7]);
        *(u32x4*)(Y + row * 1024 + 512 + h * 64 + v * 8) = w; }
    SSQA[row * 16 + h] = ss;
    __syncthreads();
}

#endif
template <int NV> __device__ __forceinline__ float top16(float (&v)[NV], int lane) {
    float res = -INFINITY;
    for (int it = 0; it < 16; ++it) {
        float m = v[0];
#pragma unroll
        for (int i = 1; i < NV; ++i) m = fmaxf(m, v[i]);
        m = wave_max(m);
#pragma unroll
        for (int i = 0; i < NV; ++i) if (v[i] == m) v[i] = -INFINITY;
        if (lane == it) res = m;
    }
    return res;
}
__device__ __forceinline__ float dot8(const u32x4 a, const u32x4 b) {
    return bflo(a.x) * bflo(b.x) + bfhi(a.x) * bfhi(b.x) + bflo(a.y) * bflo(b.y) + bfhi(a.y) * bfhi(b.y)
         + bflo(a.z) * bflo(b.z) + bfhi(a.z) * bfhi(b.z) + bflo(a.w) * bflo(b.w) + bfhi(a.w) * bfhi(b.w);
}
__device__ __forceinline__ void peer_topk(const Ctx& c, const Args& a, int layer, int widx, int nw) {
    const bf16_t* QP = (const bf16_t*)(a.ws + WS_QP);
    const bf16_t* SK1 = (const bf16_t*)(a.ws + WS_LW + (size_t)layer * LW_STRIDE + LW_SK1);
    const bf16_t* SK2 = (const bf16_t*)(a.ws + WS_LW + (size_t)layer * LW_STRIDE + LW_SK2);
    int* SELI = (int*)(a.ws + WS_SELI); float* SELW = (float*)(a.ws + WS_SELW);
    const int lane = c.lane;
    for (int it = widx; it < M * 8; it += nw) {
        const int t = it >> 3, h = it & 7;
        const bf16_t* qrow = QP + (size_t)t * 2048 + h * 256;
        const bf16_t* k1a = SK1 + ((size_t)(h * 128 + lane)) * 128; const bf16_t* k1b = k1a + 64 * 128;
        const bf16_t* k2a = SK2 + ((size_t)(h * 128 + lane)) * 128; const bf16_t* k2b = k2a + 64 * 128;
        float s1[2] = {0.f, 0.f}, s2[2] = {0.f, 0.f};
#pragma unroll 4
        for (int kk = 0; kk < 128; kk += 8) {
            const u32x4 q1 = *(const u32x4*)(qrow + kk), q2 = *(const u32x4*)(qrow + 128 + kk);
            s1[0] += dot8(q1, *(const u32x4*)(k1a + kk)); s1[1] += dot8(q1, *(const u32x4*)(k1b + kk));
            s2[0] += dot8(q2, *(const u32x4*)(k2a + kk)); s2[1] += dot8(q2, *(const u32x4*)(k2b + kk));
        }
        s1[0] = __uint_as_float((__float_as_uint(s1[0]) & ~127u) | (unsigned)lane); s1[1] = __uint_as_float((__float_as_uint(s1[1]) & ~127u) | (unsigned)(lane + 64));
        s2[0] = __uint_as_float((__float_as_uint(s2[0]) & ~127u) | (unsigned)lane); s2[1] = __uint_as_float((__float_as_uint(s2[1]) & ~127u) | (unsigned)(lane + 64));
        const float v1 = top16<2>(s1, lane), v2 = top16<2>(s2, lane);
        float cand[4];
#pragma unroll
        for (int mm = 0; mm < 4; ++mm) {
            const float va = __shfl(v1, (lane >> 4) + 4 * mm), vb = __shfl(v2, lane & 15);
            const unsigned ua = __float_as_uint(va), ub = __float_as_uint(vb);
            const float sum = __uint_as_float(ua & ~127u) + __uint_as_float(ub & ~127u);
            cand[mm] = __uint_as_float((__float_as_uint(sum) & ~16383u) | ((ua & 127u) << 7) | (ub & 127u));
        }
        const float best = top16<4>(cand, lane);
        const unsigned ub = __float_as_uint(best);
        const float sc = __uint_as_float(ub & ~16383u);
        const float mx = __shfl(sc, 0);
        const float e = lane < 16 ? __expf(sc - mx) : 0.f;
        const float sum = wave_sum(e);
        if (lane < 16) { SELI[(size_t)t * 128 + h * 16 + lane] = (int)(ub & 16383u); SELW[(size_t)t * 128 + h * 16 + lane] = e / sum; }
    }
}

typedef float f32x16 __attribute__((ext_vector_type(16)));
#define CE_DESC(x, y) do { const float hi__ = fmaxf(x, y), lo__ = fminf(x, y); x = hi__; y = lo__; } while (0)
__device__ __forceinline__ void sort16_desc(float (&v)[16]) {
#pragma unroll
    for (int k = 2; k <= 16; k <<= 1)
#pragma unroll
        for (int j = k >> 1; j > 0; j >>= 1)
#pragma unroll
            for (int i = 0; i < 16; ++i) { const int l = i ^ j; if (l > i) { if ((i & k) == 0) CE_DESC(v[i], v[l]); else CE_DESC(v[l], v[i]); } }
}
__device__ __forceinline__ void merge16_desc(float (&a)[16], const float (&b)[16]) {
#pragma unroll
    for (int i = 0; i < 16; ++i) a[i] = fmaxf(a[i], b[15 - i]);
#pragma unroll
    for (int j = 8; j > 0; j >>= 1)
#pragma unroll
        for (int i = 0; i < 16; ++i) { const int l = i ^ j; if (l > i) CE_DESC(a[i], a[l]); }
}
__device__ __forceinline__ void merge16_partner(float (&a)[16]) {
    float b[16];
#pragma unroll
    for (int i = 0; i < 16; ++i) b[i] = __shfl_xor(a[i], 32);
    merge16_desc(a, b);
}
__device__ __forceinline__ void peer_topk_fast(const Ctx& c, const Args& a, int layer, int widx, int nw, int only_unit = -1) {
    const bf16_t* QP = (const bf16_t*)(a.ws + WS_QP);
    const bf16_t* SK1 = (const bf16_t*)(a.ws + WS_LW + (size_t)layer * LW_STRIDE + LW_SK1);
    const bf16_t* SK2 = (const bf16_t*)(a.ws + WS_LW + (size_t)layer * LW_STRIDE + LW_SK2);
    int* SELI = (int*)(a.ws + WS_SELI); float* SELW = (float*)(a.ws + WS_SELW);
    const int lane = c.lane, tl = lane & 31, hi = lane >> 5;
    for (int unit = only_unit >= 0 ? only_unit : widx; unit < (M / 32) * 8; unit += nw) {
        const int tg = unit >> 3, h = unit & 7; const long token = (long)tg * 32 + tl;
        float vv[2][16];
#pragma unroll
        for (int half = 0; half < 2; ++half) {
            f32x16 acc[4];
#pragma unroll
            for (int t = 0; t < 4; ++t)
#pragma unroll
                for (int r = 0; r < 16; ++r) acc[t][r] = 0.f;
            const bf16_t* qb = QP + token * 2048 + h * 256 + half * 128 + 8 * hi;
            const bf16_t* kb = (half ? SK2 : SK1) + ((long)(h * 128 + tl)) * 128 + 8 * hi;
#pragma unroll 1
            for (int k4 = 0; k4 < 8; k4 += 4) {
                bf16x8 bq[4], ak[4][4];
#pragma unroll
                for (int u = 0; u < 4; ++u) { bq[u] = *(const bf16x8*)(qb + 16 * (k4 + u));
#pragma unroll
                    for (int t = 0; t < 4; ++t) ak[u][t] = *(const bf16x8*)(kb + (long)t * 32 * 128 + 16 * (k4 + u)); }
#pragma unroll
                for (int u = 0; u < 4; ++u)
#pragma unroll
                    for (int t = 0; t < 4; ++t) acc[t] = __builtin_amdgcn_mfma_f32_32x32x16_bf16(ak[u][t], bq[u], acc[t], 0, 0, 0);
            }
            float L[4][16];
#pragma unroll
            for (int t = 0; t < 4; ++t) {
#pragma unroll
                for (int r = 0; r < 16; ++r) L[t][r] = __uint_as_float((__float_as_uint(acc[t][r]) & ~127u) | (unsigned)(32 * t + (r & 3) + 8 * (r >> 2) + 4 * hi));
                sort16_desc(L[t]);
            }
            merge16_desc(L[0], L[1]); merge16_desc(L[2], L[3]); merge16_desc(L[0], L[2]);
            merge16_partner(L[0]);
#pragma unroll
            for (int i = 0; i < 16; ++i) vv[half][i] = L[0][i];
        }
        float f1[16], f2[16]; unsigned i1[16], i2[16];
#pragma unroll
        for (int i = 0; i < 16; ++i) { const unsigned u1 = __float_as_uint(vv[0][i]), u2 = __float_as_uint(vv[1][i]);
            f1[i] = __uint_as_float(u1 & ~127u); f2[i] = __uint_as_float(u2 & ~127u); i1[i] = (u1 & 127u) << 7; i2[i] = u2 & 127u; }
        float cA[16], cB[16];
#pragma unroll
        for (int i = 0; i < 16; ++i) { cA[i] = -INFINITY; cB[i] = -INFINITY; }
        {
            int n = 0;
#pragma unroll
            for (int aa = 0; aa < 16; ++aa)
#pragma unroll
                for (int bb = 0; bb < 16; ++bb) if ((aa + 1) * (bb + 1) <= 16) {
                    const float s = f1[aa] + f2[bb]; const float pk = __uint_as_float((__float_as_uint(s) & ~16383u) | i1[aa] | i2[bb]);
                    const int slot = n >> 1; const bool mine = ((n & 1) == hi);
                    if (slot < 16) cA[slot] = mine ? pk : cA[slot]; else cB[slot - 16] = mine ? pk : cB[slot - 16];
                    ++n;
                }
        }
        sort16_desc(cA); sort16_desc(cB); merge16_desc(cA, cB); merge16_partner(cA);
        float sc[16], e[16]; float sum = 0.f;
#pragma unroll
        for (int i = 0; i < 16; ++i) { sc[i] = __uint_as_float(__float_as_uint(cA[i]) & ~16383u); e[i] = __expf(sc[i] - sc[0]); sum += e[i]; }
        const float inv = 1.f / sum;
        u32x4 oi[2]; f32x4 ow[2];
#pragma unroll
        for (int i = 0; i < 8; ++i) { const float pk = hi ? cA[8 + i] : cA[i]; const float w = (hi ? e[8 + i] : e[i]) * inv;
            oi[i >> 2][i & 3] = __float_as_uint(pk) & 16383u; ow[i >> 2][i & 3] = w; }
        int* si = SELI + token * 128 + h * 16 + 8 * hi; float* sw = SELW + token * 128 + h * 16 + 8 * hi;
        *(u32x4*)si = oi[0]; *(u32x4*)(si + 4) = oi[1]; *(f32x4*)sw = ow[0]; *(f32x4*)(sw + 4) = ow[1];
        if (only_unit >= 0) break;
    }
}

__device__ __forceinline__ void dec16(const u32x4 w, float (&f)[16]) {
#pragma unroll
    for (int j = 0; j < 4; ++j) { const auto lo = __builtin_amdgcn_cvt_pk_f32_fp8((int)w[j], false); const auto hi = __builtin_amdgcn_cvt_pk_f32_fp8((int)w[j], true);
        f[4 * j + 0] = lo[0]; f[4 * j + 1] = lo[1]; f[4 * j + 2] = hi[0]; f[4 * j + 3] = hi[1]; }
}
__device__ __forceinline__ void peer_gather(const Ctx& c, const Args& a, int layer, int widx, int nw) {
    float* XR = a.out; bf16_t* XN2 = (bf16_t*)(a.ws + WS_XN2);
    const unsigned char* EU = a.ws + WS_EU + (size_t)layer * 16384 * 1024;
    const unsigned char* EV = a.ws + WS_EV + (size_t)layer * 16384 * 1024;
    const float* SCU = (const float*)(a.ws + WS_ESC) + layer * 16384; const float* SCV = SCU + 32768;
    const int* SELI = (const int*)(a.ws + WS_SELI); const float* SELW = (const float*)(a.ws + WS_SELW);
    const float* gf = a.in[I_NFFNG] + layer * D; const float* gp = a.in[I_NPLEG] + layer * D;
    const int lane = c.lane;
    for (int t = widx; t < M; t += nw) {
        float x[16], hh[16], acc[16];
        float* xr = XR + (size_t)t * D + 16 * lane;
        float ss = 0.f;
#pragma unroll
        for (int j = 0; j < 4; ++j) { const f32x4 u0 = *(const f32x4*)(xr + 4 * j);
#pragma unroll
            for (int e = 0; e < 4; ++e) x[4 * j + e] = u0[e]; }
#pragma unroll
        for (int e = 0; e < 16; ++e) { ss += x[e] * x[e]; acc[e] = 0.f; }
        ss = wave_sum(ss);
        const float rstd = rsqrtf(ss * (1.f / D) + EPS);
#pragma unroll
        for (int j = 0; j < 4; ++j) { const f32x4 g4 = *(const f32x4*)(gf + 16 * lane + 4 * j);
#pragma unroll
            for (int e = 0; e < 4; ++e) hh[4 * j + e] = x[4 * j + e] * rstd * g4[e]; }
        const int idxA = SELI[(size_t)t * 128 + lane], idxB = SELI[(size_t)t * 128 + 64 + lane];
        const float wA = SELW[(size_t)t * 128 + lane], wB = SELW[(size_t)t * 128 + 64 + lane];
        const float suA = SCU[idxA], suB = SCU[idxB], svA = SCV[idxA], svB = SCV[idxB];
#pragma unroll 1
        for (int hf = 0; hf < 2; ++hf) {
            const int idxv = hf ? idxB : idxA; const float wv = hf ? wB : wA, suv = hf ? suB : suA, svv = hf ? svB : svA;
#pragma unroll 1
            for (int k0 = 0; k0 < 64; k0 += 8) {
                u32x4 ur[8], vr[8]; float w[8], su[8], sv[8];
#pragma unroll
                for (int r = 0; r < 8; ++r) {
                    const int e = __builtin_amdgcn_readlane(idxv, k0 + r);
                    w[r] = __uint_as_float(__builtin_amdgcn_readlane(__float_as_uint(wv), k0 + r));
                    su[r] = __uint_as_float(__builtin_amdgcn_readlane(__float_as_uint(suv), k0 + r));
                    sv[r] = __uint_as_float(__builtin_amdgcn_readlane(__float_as_uint(svv), k0 + r));
                    ur[r] = *(const u32x4*)(EU + (size_t)e * D + 16 * lane); vr[r] = *(const u32x4*)(EV + (size_t)e * D + 16 * lane);
                }
#pragma unroll
                for (int r = 0; r < 8; ++r) {
                    float f[16]; dec16(ur[r], f);
                    float d = 0.f;
#pragma unroll
                    for (int e = 0; e < 16; ++e) d += hh[e] * f[e];
                    d = wave_sum(d) * su[r];
                    const float av = gelu_tanh(d) * w[r] * sv[r];
                    dec16(vr[r], f);
#pragma unroll
                    for (int e = 0; e < 16; ++e) acc[e] += av * f[e];
                }
            }
        }
        float s2 = 0.f;
#pragma unroll
        for (int e = 0; e < 16; ++e) { x[e] += acc[e]; s2 += x[e] * x[e]; }
        s2 = wave_sum(s2);
        const float rstd2 = rsqrtf(s2 * (1.f / D) + EPS);
#pragma unroll
        for (int j = 0; j < 4; ++j) *(f32x4*)(xr + 4 * j) = (f32x4){x[4 * j + 0], x[4 * j + 1], x[4 * j + 2], x[4 * j + 3]};
        float y[16];
#pragma unroll
        for (int j = 0; j < 4; ++j) { const f32x4 g4 = *(const f32x4*)(gp + 16 * lane + 4 * j);
#pragma unroll
            for (int e = 0; e < 4; ++e) y[4 * j + e] = x[4 * j + e] * rstd2 * g4[e]; }
        u32x4 o0, o1; o0.x = pk2(y[0], y[1]); o0.y = pk2(y[2], y[3]); o0.z = pk2(y[4], y[5]); o0.w = pk2(y[6], y[7]);
        o1.x = pk2(y[8], y[9]); o1.y = pk2(y[10], y[11]); o1.z = pk2(y[12], y[13]); o1.w = pk2(y[14], y[15]);
        *(u32x4*)(XN2 + (size_t)t * D + 16 * lane) = o0; *(u32x4*)(XN2 + (size_t)t * D + 16 * lane + 8) = o1;
    }
}

#define DPP_ADD(v, ctrl, rmask) v += __uint_as_float(__builtin_amdgcn_update_dpp(0u, __float_as_uint(v), ctrl, rmask, 0xf, true))
__device__ __forceinline__ float wave_sum_dpp(float v) {
    DPP_ADD(v, 0x111, 0xf); DPP_ADD(v, 0x112, 0xf); DPP_ADD(v, 0x114, 0xf); DPP_ADD(v, 0x118, 0xf); DPP_ADD(v, 0x142, 0xa); DPP_ADD(v, 0x143, 0xc);
    return __uint_as_float(__builtin_amdgcn_readlane(__float_as_uint(v), 63));
}
struct GrpSplit { int grp, G, gwave, nwave; };
__device__ __forceinline__ GrpSplit grp_split(const Ctx& c) { GrpSplit s; s.G = c.nblk < 8 ? c.nblk : 8; s.grp = c.blk % s.G; const int rank = c.blk / s.G, cnt = (c.nblk - s.grp + s.G - 1) / s.G;
    s.gwave = rank * 8 + c.wave; s.nwave = cnt * 8; return s; }
#define DPP_ADDC(v, ctrl) v += __uint_as_float(__builtin_amdgcn_update_dpp(0u, __float_as_uint(v), ctrl, 0xf, 0xf, true))
template <bool VSTEP, int MODE = 0>
__device__ __forceinline__ void peer_step(const Ctx& c, const Args& a, int layer, bf16_t* XB) {
    float* SSQ2 = (float*)(a.ws + WS_SSQS); const float* SSQ1 = (const float*)(a.ws + WS_SSQ1);
    const unsigned char* ET = a.ws + (VSTEP ? WS_EV : WS_EU) + (size_t)layer * 16384 * 1024;
    const int* SELI = (const int*)(a.ws + WS_SELI); const float* AOUT = (const float*)(a.ws + WS_AOUT); float* DP = (float*)(a.ws + WS_QP);
    const float* gf = a.in[I_NFFNG] + layer * D;
    const int lane = c.lane, sub = lane >> 3, ch = lane & 7; const GrpSplit gs = grp_split(c);
#define PS_LOADIX(ix_, tt) do { const u32x4* ip_ = (const u32x4*)(SELI + (size_t)(tt) * 128 + 16 * sub); ix_[0] = ip_[0]; ix_[1] = ip_[1]; ix_[2] = ip_[2]; ix_[3] = ip_[3]; } while (0)
#define PS_LOADOPS(raw_, q_, tt) do { \
        if (VSTEP) { const u32x4* ap_ = (const u32x4*)(AOUT + (size_t)(tt) * 128 + 16 * sub); raw_[0] = ap_[0]; raw_[1] = ap_[1]; raw_[2] = ap_[2]; raw_[3] = ap_[3]; } \
        else { raw_[0] = *(const u32x4*)(XB + (size_t)(tt) * D + 128 * p + 16 * ch); raw_[1] = *(const u32x4*)(XB + (size_t)(tt) * D + 128 * p + 16 * ch + 8); \
               const f32x4* sq_ = (const f32x4*)(SSQ1 + (size_t)(tt) * 16); q_[0] = sq_[0]; q_[1] = sq_[1]; q_[2] = sq_[2]; q_[3] = sq_[3]; } } while (0)
#define PS_SEG(ix_, j_) (*(const u32x4*)(ETp + (unsigned)((ix_)[(j_) >> 2][(j_) & 3] * 1024u + lane_off)))
    for (int p = gs.grp; p < 8; p += gs.G) {
        float g16[16];
        if (!VSTEP) {
#pragma unroll
            for (int j = 0; j < 4; ++j) { const f32x4 g4 = *(const f32x4*)(gf + 128 * p + 16 * ch + 4 * j); g16[4 * j] = g4[0]; g16[4 * j + 1] = g4[1]; g16[4 * j + 2] = g4[2]; g16[4 * j + 3] = g4[3]; }
        }
        int t = gs.gwave;
        if (t >= M) continue;
        const unsigned char* ETp = ET + 128 * p; const unsigned lane_off = 16u * (unsigned)ch;
        u32x4 ring[16], nix[4], nnix[4], craw[4], nraw[4]; f32x4 cq[4], nq[4];
        { u32x4 cix[4]; PS_LOADIX(cix, t); PS_LOADOPS(craw, cq, t);
#pragma unroll
          for (int j = 0; j < 16; ++j) ring[j] = PS_SEG(cix, j); }
        { const int t1 = t + gs.nwave < M ? t + gs.nwave : t; PS_LOADIX(nix, t1); }
#pragma unroll 1
        for (;;) {
            const int tn = t + gs.nwave, tnn = tn + gs.nwave; const bool has_next = tn < M;
            { const int tc = has_next ? tn : t, tcc = tnn < M ? tnn : t; PS_LOADOPS(nraw, nq, tc); PS_LOADIX(nnix, tcc); }
            unsigned xrw = 0u;
            if (VSTEP) xrw = *(const unsigned*)(XB + (size_t)t * D + 128 * p + 16 * ch + 2 * sub);
            float hx[16]; f32x4 cav[4];
            if (!VSTEP) {
                const float rstd = rsqrtf(((cq[0][0] + cq[0][1] + cq[0][2] + cq[0][3]) + (cq[1][0] + cq[1][1] + cq[1][2] + cq[1][3]) + (cq[2][0] + cq[2][1] + cq[2][2] + cq[2][3]) + (cq[3][0] + cq[3][1] + cq[3][2] + cq[3][3])) * (1.f / D) + EPS);
#pragma unroll
                for (int w = 0; w < 2; ++w)
#pragma unroll
                    for (int e = 0; e < 4; ++e) { hx[8 * w + 2 * e] = bflo(craw[w][e]) * rstd * g16[8 * w + 2 * e]; hx[8 * w + 2 * e + 1] = bfhi(craw[w][e]) * rstd * g16[8 * w + 2 * e + 1]; }
            } else {
#pragma unroll
                for (int j = 0; j < 4; ++j) cav[j] = __builtin_bit_cast(f32x4, craw[j]);
            }
            typedef float f32x2_ __attribute__((ext_vector_type(2)));
            float acc[16]; f32x2_ acc2[8];
#pragma unroll
            for (int e = 0; e < 16; ++e) acc[e] = 0.f;
#pragma unroll
            for (int e = 0; e < 8; ++e) acc2[e] = (f32x2_){0.f, 0.f};
#define PS_PIN() do { if (VSTEP) asm volatile("" : "+v"(acc2[0]), "+v"(acc2[1]), "+v"(acc2[2]), "+v"(acc2[3]), "+v"(acc2[4]), "+v"(acc2[5]), "+v"(acc2[6]), "+v"(acc2[7])); \
        else asm volatile("" : "+v"(acc[0]), "+v"(acc[1]), "+v"(acc[2]), "+v"(acc[3]), "+v"(acc[4]), "+v"(acc[5]), "+v"(acc[6]), "+v"(acc[7]), "+v"(acc[8]), "+v"(acc[9]), "+v"(acc[10]), "+v"(acc[11]), "+v"(acc[12]), "+v"(acc[13]), "+v"(acc[14]), "+v"(acc[15])); __builtin_amdgcn_sched_barrier(0); } while (0)
#pragma unroll
            for (int j = 0; j < 16; ++j) {
                if (MODE == 1) { acc[j] += __uint_as_float((ring[j][0] ^ ring[j][1] ^ ring[j][2] ^ ring[j][3]) & 0x3fffffffu); }
                else {
                f32x2_ f2[8];
#pragma unroll
                for (int w = 0; w < 4; ++w) { f2[2 * w] = __builtin_amdgcn_cvt_pk_f32_fp8((int)ring[j][w], false); f2[2 * w + 1] = __builtin_amdgcn_cvt_pk_f32_fp8((int)ring[j][w], true); }
                if (VSTEP) { const float av_ = cav[j >> 2][j & 3]; const f32x2_ av2 = (f32x2_){av_, av_};
#pragma unroll
                    for (int i = 0; i < 8; ++i) acc2[i] = __builtin_elementwise_fma(av2, f2[i], acc2[i]); }
                else { f32x2_ d0 = (f32x2_){hx[0], hx[1]} * f2[0], d1 = (f32x2_){hx[2], hx[3]} * f2[1];
#pragma unroll
                    for (int i = 2; i < 8; i += 2) { d0 = __builtin_elementwise_fma((f32x2_){hx[2 * i], hx[2 * i + 1]}, f2[i], d0); d1 = __builtin_elementwise_fma((f32x2_){hx[2 * i + 2], hx[2 * i + 3]}, f2[i + 1], d1); }
                    const f32x2_ ds = d0 + d1; float d = ds[0] + ds[1];
                    DPP_ADDC(d, 0xB1); DPP_ADDC(d, 0x4E); DPP_ADDC(d, 0x141); acc[j] = d; } }
                if (MODE != 2) ring[j] = PS_SEG(nix, j);
                if ((j & 1) == 1) PS_PIN();
            }
            if (!VSTEP) {
                if (ch == 0) { u32x4* dp = (u32x4*)((bf16_t*)DP + ((size_t)t * 8 + p) * 128 + 16 * sub);
                    u32x4 o0, o1; o0.x = pk2(acc[0], acc[1]); o0.y = pk2(acc[2], acc[3]); o0.z = pk2(acc[4], acc[5]); o0.w = pk2(acc[6], acc[7]);
                    o1.x = pk2(acc[8], acc[9]); o1.y = pk2(acc[10], acc[11]); o1.z = pk2(acc[12], acc[13]); o1.w = pk2(acc[14], acc[15]); dp[0] = o0; dp[1] = o1; }
            } else {
#pragma unroll
                for (int i = 0; i < 8; ++i) { acc[2 * i] = acc2[i][0]; acc[2 * i + 1] = acc2[i][1]; }
                float r8[8], r4[4], r2[2];
#pragma unroll
                for (int i = 0; i < 8; ++i) { const auto rr = __builtin_amdgcn_permlane32_swap(__float_as_uint(acc[i]), __float_as_uint(acc[i + 8]), false, false); r8[i] = __uint_as_float(rr[0]) + __uint_as_float(rr[1]); }
#pragma unroll
                for (int i = 0; i < 4; ++i) { const auto rr = __builtin_amdgcn_permlane16_swap(__float_as_uint(r8[i]), __float_as_uint(r8[i + 4]), false, false); r4[i] = __uint_as_float(rr[0]) + __uint_as_float(rr[1]); }
                const bool b3 = (lane & 8) != 0;
#pragma unroll
                for (int i = 0; i < 2; ++i) { const float keep = b3 ? r4[i + 2] : r4[i], send = b3 ? r4[i] : r4[i + 2];
                    r2[i] = keep + __uint_as_float(__builtin_amdgcn_update_dpp(0u, __float_as_uint(send), 0x128, 0xf, 0xf, true)); }
                const unsigned ow = pk2(r2[0] + bflo(xrw), r2[1] + bfhi(xrw));
                const float y0 = bflo(ow), y1 = bfhi(ow);
                const float s2 = wave_sum_dpp(y0 * y0 + y1 * y1);
                *(unsigned*)(XB + (size_t)t * D + 128 * p + 16 * ch + 2 * sub) = ow;
                if (lane == 0) SSQ2[(size_t)t * 16 + p] = s2;
            }
            if (!has_next) break;
#pragma unroll
            for (int j = 0; j < 4; ++j) { nix[j] = nnix[j]; craw[j] = nraw[j]; if (!VSTEP) cq[j] = nq[j]; }
            t = tn;
        }
    }
#undef PS_LOADIX
#undef PS_LOADOPS
#undef PS_SEG
#undef PS_PIN
}
__device__ __forceinline__ void peer_combine(const Ctx& c, const Args& a, int layer) {
    const float* SCU = (const float*)(a.ws + WS_ESC) + layer * 16384; const float* SCV = SCU + 32768;
    const int* SELI = (const int*)(a.ws + WS_SELI); const float* SELW = (const float*)(a.ws + WS_SELW); float* AOUT = (float*)(a.ws + WS_AOUT); const float* DP = (const float*)(a.ws + WS_QP);
    const bf16_t* DPB = (const bf16_t*)DP;
    const size_t n8 = (size_t)M * 16, stride = (size_t)c.nblk * 512;
    constexpr int CMB_N = 2;
    for (size_t v0 = (size_t)c.blk * 512 + c.tid; v0 < n8; v0 += CMB_N * stride) {
        f32x4 s0[CMB_N], s1[CMB_N]; u32x4 ix0[CMB_N], ix1[CMB_N]; f32x4 w0[CMB_N], w1[CMB_N];
#pragma unroll
        for (int u = 0; u < CMB_N; ++u) { const size_t v = v0 + u * stride < n8 ? v0 + u * stride : v0; const size_t t = v >> 4; const int q = (int)(v & 15) * 8;
            ix0[u] = *(const u32x4*)(SELI + t * 128 + q); ix1[u] = *(const u32x4*)(SELI + t * 128 + q + 4); w0[u] = *(const f32x4*)(SELW + t * 128 + q); w1[u] = *(const f32x4*)(SELW + t * 128 + q + 4);
            s0[u] = (f32x4){0.f, 0.f, 0.f, 0.f}; s1[u] = s0[u];
#pragma unroll
            for (int p = 0; p < 8; ++p) { f32x4 a0, a1; unpack8(*(const u32x4*)(DPB + (t * 8 + p) * 128 + q), a0, a1); s0[u] += a0; s1[u] += a1; } }
#pragma unroll
        for (int u = 0; u < CMB_N; ++u) { const size_t v = v0 + u * stride; if (v >= n8) break; const size_t t = v >> 4; const int q = (int)(v & 15) * 8;
            f32x4 o0, o1;
#pragma unroll
            for (int e = 0; e < 4; ++e) { o0[e] = gelu_tanh(s0[u][e] * SCU[ix0[u][e]]) * w0[u][e] * SCV[ix0[u][e]]; o1[e] = gelu_tanh(s1[u][e] * SCU[ix1[u][e]]) * w1[u][e] * SCV[ix1[u][e]]; }
            *(f32x4*)(AOUT + t * 128 + q) = o0; *(f32x4*)(AOUT + t * 128 + q + 4) = o1; }
    }
}

__device__ __forceinline__ void final_norm(const Ctx& c, const Args& a, int widx, int nw) {
    const float* gfin = a.in[I_FING]; const bf16_t* XB = (const bf16_t*)(a.ws + WS_XB);
    for (int m0 = widx; m0 < M; m0 += 2 * nw) {
        u32x4 w[2][2];
#pragma unroll
        for (int u = 0; u < 2; ++u) { const int m = m0 + u * nw < M ? m0 + u * nw : m0; const u32x4* xr = (const u32x4*)(XB + (size_t)m * D + 16 * c.lane); w[u][0] = xr[0]; w[u][1] = xr[1]; }
#pragma unroll
        for (int u = 0; u < 2; ++u) { const int m = m0 + u * nw; if (m >= M) break;
            float x[16]; float s = 0.f;
#pragma unroll
            for (int j = 0; j < 2; ++j)
#pragma unroll
                for (int e = 0; e < 4; ++e) { x[8 * j + 2 * e] = bflo(w[u][j][e]); x[8 * j + 2 * e + 1] = bfhi(w[u][j][e]); }
#pragma unroll
            for (int e = 0; e < 16; ++e) s += x[e] * x[e];
            s = wave_sum(s); const float rstd = rsqrtf(s * (1.f / D) + EPS);
            f32x4* orow = (f32x4*)(a.out + (size_t)m * D + 16 * c.lane);
#pragma unroll
            for (int j = 0; j < 4; ++j) { const f32x4 gg = *(const f32x4*)(gfin + 16 * c.lane + 4 * j); orow[j] = (f32x4){x[4 * j] * rstd * gg[0], x[4 * j + 1] * rstd * gg[1], x[4 * j + 2] * rstd * gg[2], x[4 * j + 3] * rstd * gg[3]}; } }
    }
}

__global__ void __launch_bounds__(512, 2) mk_fwd(Args a) {
    extern __shared__ __attribute__((aligned(16))) unsigned char lds[];
    Ctx c0; c0.tid = threadIdx.x; c0.lane = c0.tid & 63; c0.wave = __builtin_amdgcn_readfirstlane(c0.tid >> 6); c0.blk = blockIdx.x; c0.nblk = gridDim.x; c0.lds = lds;
    const Ctx& c = c0;
    volatile LAS unsigned* MISC = (volatile LAS unsigned*)((LAS unsigned char*)lds + MISC_OFF);
    for (int u = c.tid; u < (LDS_BYTES - LDSCTL_OFF) / 4; u += 512) ((LAS unsigned*)((LAS unsigned char*)lds + LDSCTL_OFF))[u] = 0u;
    __syncthreads();
    const bool multi = (a.ph_hi - a.ph_lo) > 1;
    XcdBarrier bar; bar.bar = (unsigned*)(a.ws + WS_CTL) + CW_BAR; bar.x = 0; bar.st = nullptr;
    if (multi) bar = xcd_barrier_post((unsigned*)(a.ws + WS_CTL) + CW_BAR, MISC + 8);
    const int gw = c.blk * 8 + c.wave, NGW = c.nblk * 8;

#define IN(k) (lo <= (k) && (k) < hi)
#define FRESH() Ctx c = c0; { int t_ = c0.tid; asm volatile("" : "+v"(t_)); c.tid = t_; c.lane = t_ & 63; int w_ = c0.wave; asm volatile("" : "+s"(w_)); c.wave = w_; int b_ = c0.blk; asm volatile("" : "+s"(b_)); c.blk = b_; int n_ = c0.nblk; asm volatile("" : "+s"(n_)); c.nblk = n_; }
#define GRIDBAR() do { XcdBarrier b_ = bar; unsigned* p_ = b_.bar; asm volatile("" : "+s"(p_)); b_.bar = p_; xcd_barrier(b_); } while (0)
#ifdef PROBE_PH
#define PROBE_STAMP(slot) do { if (blockIdx.x == 0 && threadIdx.x == 0) ((unsigned long long*)(a.ws + WS_CTL + 48 * 1024))[slot] = __builtin_amdgcn_s_memrealtime(); } while (0)
#define SEAM(k) do { if ((k) == PROBE_PH - 1) { if (IN(k) && IN((k) + 1)) GRIDBAR(); PROBE_STAMP(0); } else if ((k) == PROBE_PH) { if (IN(k) && IN((k) + 1)) GRIDBAR(); PROBE_STAMP(1); } else { if (IN(k) && IN((k) + 1)) GRIDBAR(); } } while (0)
#else
#define SEAM(k) do { if (IN(k) && IN((k) + 1)) GRIDBAR(); } while (0)
#endif
    const int lo = a.ph_lo, hi = a.ph_hi;
#ifdef PROBE_PH
    if (PROBE_PH == 0) PROBE_STAMP(0);
#endif
    if (IN(0)) {
        FRESH();
        p0_prologue(c, a);
    }
    SEAM(0);
#pragma unroll 1
    for (int layer = 0; layer < 2; ++layer) {
        const int pb = 1 + 11 * layer;
        unsigned char* lw = a.ws + WS_LW + (size_t)layer * LW_STRIDE;
        unsigned char* xbc = a.ws + (layer & 1 ? WS_XB2 : WS_XB); unsigned char* xbn = a.ws + (layer & 1 ? WS_XB : WS_XB2);
        if (IN(pb + 0)) {
            FRESH();
            GemmD g; g.A = (const bf16_t*)xbc; g.lda = D; g.Bt = (const bf16_t*)(lw + LW_WIN); g.ldb = D; g.K = D; g.kmid = -1;
            EpiInproj E; E.ssq0 = (const float*)(a.ws + WS_SSQ0); E.ucat = (bf16_t*)(a.ws + WS_UCAT); E.qraw = (bf16_t*)(a.ws + WS_QRAW); E.kv = (bf16_t*)(a.ws + WS_KV);
            gemm_phase_dense(c, g, M / 256, c.nblk == 256 ? 4 : DIN / 256, E);
            if (layer == 0 && c.nblk != 256) {}
        }
        SEAM(pb + 0);
        if (IN(pb + 1)) {
            FRESH();
            if (c.nblk == 256) {
                if (c.blk < 64) s1_unit(c, a, layer, c.blk);
                else if (c.blk < 128) {
                    GemmD g; g.A = (const bf16_t*)xbc; g.lda = D; g.Bt = (const bf16_t*)(lw + LW_WIN); g.ldb = D; g.K = D; g.kmid = -1;
                    EpiInproj E; E.ssq0 = (const float*)(a.ws + WS_SSQ0); E.ucat = (bf16_t*)(a.ws + WS_UCAT); E.qraw = (bf16_t*)(a.ws + WS_QRAW); E.kv = (bf16_t*)(a.ws + WS_KV);
                    pg8::OneUnit S; S.u.pm = c.blk - 64; S.u.pn = 4; run_gemm(c.lds, g, S, E, c.tid);
                    VM_WAIT(); __syncthreads();
                    qkprep(c, a, layer, c.wave, 8, 2, (c.blk - 64) * 256);
                    if (layer == 0) cvt_fp8_layer(c, a, 1, (c.blk - 64) * 8 + c.wave, 192 * 8);
                } else {
                    qkprep(c, a, layer, (c.blk - 128) * 8 + c.wave, 128 * 8, 1);
                    if (layer == 0) cvt_fp8_layer(c, a, 1, (c.blk - 64) * 8 + c.wave, 192 * 8);
                }
            } else if (c.nblk > 64) {
                if (c.blk < 64) s1_unit(c, a, layer, c.blk);
                else qkprep(c, a, layer, (c.blk - 64) * 8 + c.wave, (c.nblk - 64) * 8);
            } else {
                for (int u = c.blk; u < 64; u += c.nblk) s1_unit(c, a, layer, u);
                qkprep(c, a, layer, gw, NGW);
            }
        }
        SEAM(pb + 1);
        if (IN(pb + 2)) {
            FRESH();
            GemmD g; g.A = (const bf16_t*)(a.ws + WS_UCAT); g.lda = KCAT; g.Bt = (const bf16_t*)(lw + LW_WY); g.ldb = KCAT; g.K = KCAT; g.kmid = -1;
            EpiS2 E; E.G = (bf16_t*)(a.ws + WS_G);
#ifdef USE_SGEMM
            for (int ui = c.blk; ui < 128; ui += c.nblk) { Unit u; u.pm = ui >> 1; u.pn = (ui >> 2) * 2 + (ui & 1); sgemm_unit(g, u, E, c.wave, c.lane); }
#else
            { pg8::S2Order S; S.blk = c.blk; S.nblk = c.nblk; run_gemm(c.lds, g, S, E, c.tid); }
#endif
#ifdef ATT_NAIVE
            for (int ui = c.blk; ui < 256; ui += c.nblk) attn_naive_unit(c, a, ui >> 7, (ui >> 4) & 7, ui & 15);
#else
            float mfix = 0.f;
            {
                float gq = 0.f, gk = 0.f;
                for (int d = 0; d < 64; ++d) { gq = fmaxf(gq, fabsf(a.in[I_QNG][layer * 64 + d])); gk = fmaxf(gk, fabsf(a.in[I_KNG][layer * 64 + d])); }
                mfix = 64.f * gq * gk * C2 * 1.02f;
            }
            for (int ui = c.blk; ui < 512; ui += c.nblk) {
                int ab, ah, aq;
                if (c.nblk == 256) { const int bl = ui & 255, vcu = (bl & 7) * 32 + (bl >> 3), combo = (ui >> 8) * 2 + (vcu >> 7), w = vcu & 127; ab = combo >> 1; ah = (combo & 1) * 4 + (w >> 5); aq = w & 31; }
                else { ab = ui >> 8; ah = (ui >> 5) & 7; aq = ui & 31; }
                attn_body::attn_unit<ATT_THRL>(ab, ah, aq, (const attn_body::bf16*)(a.ws + WS_QRAW), (const attn_body::bf16*)(a.ws + WS_KV), (attn_body::bf16*)(a.ws + WS_Y), (float*)(a.ws + WS_SSQA), (char*)lds, c.tid, mfix);
            }
#endif
        }
        SEAM(pb + 2);
        if (IN(pb + 3)) {
            FRESH();
            GemmD g; g.A = (const bf16_t*)(a.ws + WS_G); g.lda = 512; g.Bt = (const bf16_t*)(lw + LW_WGLU); g.ldb = 512; g.K = 512; g.kmid = -1;
            EpiGlu E; E.G = (const bf16_t*)(a.ws + WS_G); E.bglu = a.in[I_BGLU] + layer * 512; E.Y = (bf16_t*)(a.ws + WS_Y); E.ssqs = (float*)(a.ws + WS_SSQS);
            GemmD g1; g1.A = (const bf16_t*)(a.ws + WS_PB) + (size_t)layer * M * 256; g1.lda = 256; g1.Bt = (const bf16_t*)(lw + LW_WPROJ); g1.ldb = 256; g1.K = 256; g1.kmid = -1;
            EpiProj E1; E1.pr = (bf16_t*)(a.ws + WS_PRB);
            if (c.nblk >= 256) { if (c.blk < 128) gemm_phase_sub(c, g, M / 256, 2, E, 128, c.blk); else if (c.blk < 256) gemm_phase_sub(c, g1, M / 256, 4, E1, 128, c.blk - 128); }
            else { gemm_phase_dense(c, g, M / 256, 2, E); gemm_phase_dense(c, g1, M / 256, 4, E1); }
        }
        SEAM(pb + 3);
        if (IN(pb + 4)) {
            FRESH();
            GemmD g; g.A = (const bf16_t*)(a.ws + WS_Y); g.lda = D; g.Bt = (const bf16_t*)(lw + LW_WOUT); g.ldb = D; g.K = D; g.kmid = 512;
            float* RS = (float*)(a.ws + WS_RS);
            { const float* ssqs = (const float*)(a.ws + WS_SSQS); const float* ssqa = (const float*)(a.ws + WS_SSQA);
              pg8::StaticOrder S0; S0.init(M, D, c.nblk, c.blk); Unit u0;
              for (int i = 0; S0.next(i, u0); ++i) if (c.tid < 256) { const int row = u0.pm * 256 + c.tid;
                  const float s = rsqrtf(sumn(ssqs + (long)row * 16, 8) * (1.f / 512.f) + EPS), t = rsqrtf(sumn(ssqa + (long)row * 16, 8) * (1.f / 512.f) + EPS);
                  RS[(long)row * 2] = s / t; RS[(long)row * 2 + 1] = t; }
              VM_WAIT(); __syncthreads(); }
            EpiOut E; E.rs = RS; E.xb = (bf16_t*)xbc; E.ssq1 = (float*)(a.ws + WS_SSQ1);
            gemm_phase_dense(c, g, M / 256, 4, E);
        }
        SEAM(pb + 4);
        if (IN(pb + 5)) {
            FRESH();
            GemmD g; g.A = (const bf16_t*)xbc; g.lda = D; g.Bt = (const bf16_t*)(lw + LW_WQ); g.ldb = D; g.K = D; g.kmid = -1;
            EpiQ E; E.ssq1 = (const float*)(a.ws + WS_SSQ1); E.qp = (bf16_t*)(a.ws + WS_QP);
            gemm_phase_dense(c, g, M / 256, 8, E);
            VM_WAIT(); __syncthreads();
            { pg8::StaticOrder S0; S0.init(M, 2048, c.nblk, c.blk); Unit u0;
              for (int i = 0; S0.next(i, u0); ++i) peer_topk_fast(c, a, layer, 0, 1 << 30, (u0.pm * 8 + c.wave) * 8 + u0.pn); }
        }
        SEAM(pb + 5);
        if (IN(pb + 7)) {
            FRESH();
#ifdef EXP_MODE
            peer_step<false, EXP_MODE>(c, a, layer, (bf16_t*)xbc);
            VM_WAIT(); __syncthreads();
#endif
            peer_step<false>(c, a, layer, (bf16_t*)xbc);
        }
        SEAM(pb + 7);
        if (IN(pb + 8)) {
            FRESH();
            peer_combine(c, a, layer);
        }
        SEAM(pb + 8);
        if (IN(pb + 9)) {
            FRESH();
            peer_step<true>(c, a, layer, (bf16_t*)xbc);
        }
        SEAM(pb + 9);
        if (IN(pb + 10)) {
            FRESH();
            GemmD g2; g2.A = (const bf16_t*)xbc; g2.lda = D; g2.Bt = (const bf16_t*)(lw + LW_WGATE); g2.ldb = D; g2.K = D; g2.kmid = -1;
            EpiGate E2; E2.pr = (const bf16_t*)(a.ws + WS_PRB); E2.xin = (const bf16_t*)xbc; E2.xout = (bf16_t*)xbn; E2.ssq0 = (float*)(a.ws + WS_SSQ0); E2.ssq2 = (const float*)(a.ws + WS_SSQS);
            gemm_phase_dense(c, g2, M / 256, 4, E2);
        }
        SEAM(pb + 10);
    }
    if (IN(NPHASE - 1)) { FRESH(); final_norm(c, a, gw, NGW); }
#ifdef PROBE_RGN
    if (blockIdx.x == 0 && threadIdx.x == 0) {
        VM_WAIT();
        const unsigned long long* st = (const unsigned long long*)(a.ws + WS_CTL + 48 * 1024);
        const unsigned long long t0 = __hip_atomic_load(st, __ATOMIC_RELAXED, __HIP_MEMORY_SCOPE_AGENT), t1 = __hip_atomic_load(st + 1, __ATOMIC_RELAXED, __HIP_MEMORY_SCOPE_AGENT);
        const unsigned long long span = (t1 > t0 ? t1 - t0 : 0) * PROBE_MULT, s0 = __builtin_amdgcn_s_memrealtime();
        while (__builtin_amdgcn_s_memrealtime() - s0 < span) __builtin_amdgcn_s_sleep(8);
    }
#endif
#ifdef PROBE_PH
    if (blockIdx.x == 0 && threadIdx.x == 0) {
        VM_WAIT();
        const unsigned long long* st = (const unsigned long long*)(a.ws + WS_CTL + 48 * 1024);
        const unsigned long long t0 = __hip_atomic_load(st, __ATOMIC_RELAXED, __HIP_MEMORY_SCOPE_AGENT), t1 = __hip_atomic_load(st + 1, __ATOMIC_RELAXED, __HIP_MEMORY_SCOPE_AGENT);
        const unsigned long long span = (t1 > t0 ? t1 - t0 : 0) * PROBE_MULT, s0 = __builtin_amdgcn_s_memrealtime();
        while (__builtin_amdgcn_s_memrealtime() - s0 < span) __builtin_amdgcn_s_sleep(8);
    }
#endif
#undef IN
#undef SEAM
}

extern "C" void kernel_launch(void* const* d_in, const int* in_sizes, int n_in, void* d_out, int out_size, void* d_ws, size_t ws_size, hipStream_t stream) {
    static int grid = 0;
    if (grid == 0) {
        if (n_in != 29 || in_sizes[0] != M * D || out_size != M * D || in_sizes[3] != 2 * D * DIN || ws_size < WS_END) {
            fprintf(stderr, "kernel_launch: unexpected problem: n_in %d in0 %d in3 %d out %d ws %zu (need %zu); nothing launched\n", n_in, n_in > 0 ? in_sizes[0] : -1, n_in > 3 ? in_sizes[3] : -1, out_size, ws_size, (size_t)WS_END);
            grid = -1; return; }
        int dev = 0, cus = 0, per_cu = 0;
        if (hipGetDevice(&dev) != hipSuccess || hipDeviceGetAttribute(&cus, hipDeviceAttributeMultiprocessorCount, dev) != hipSuccess) { grid = -1; return; }
        if (hipFuncSetAttribute((const void*)mk_fwd, hipFuncAttributeMaxDynamicSharedMemorySize, LDS_BYTES) != hipSuccess) { fprintf(stderr, "kernel_launch: hipFuncSetAttribute failed\n"); grid = -1; return; }
        if (hipOccupancyMaxActiveBlocksPerMultiprocessor(&per_cu, (const void*)mk_fwd, 512, LDS_BYTES) != hipSuccess || per_cu < 1)
            fprintf(stderr, "kernel_launch: note: occupancy query reports %d workgroups per CU\n", per_cu);
        (void)hipGetLastError();
        grid = cus;
    }
    if (grid < 0) return;
    (void)hipMemsetAsync((char*)d_ws + WS_CTL, 0, CTL_ZERO_BYTES, stream);
    Args a{};
    for (int i = 0; i < 29; ++i) a.in[i] = (const float*)d_in[i];
    a.out = (float*)d_out; a.ws = (unsigned char*)d_ws;
    constexpr int NL = MK_N_LAUNCHES;
    for (int li = 0; li < NL; ++li) {
        a.ph_lo = (NPHASE * li) / NL; a.ph_hi = (NPHASE * (li + 1)) / NL;
        hipLaunchKernelGGL(mk_fwd, dim3(grid), dim3(512), LDS_BYTES, stream, a);
    }
}
```

```cpp
#include <hip/hip_runtime.h>
#include <cstdio>
#include <cstdint>

#ifndef ATT_THRL
#define ATT_THRL -1
#endif
#ifndef MK_N_LAUNCHES
#define MK_N_LAUNCHES 1
#endif

#define LAS __attribute__((address_space(3)))
typedef unsigned short bf16_t;
typedef short bf16x8 __attribute__((ext_vector_type(8)));
typedef float f32x4 __attribute__((ext_vector_type(4)));
typedef unsigned u32x4 __attribute__((ext_vector_type(4)));
typedef unsigned u32x2 __attribute__((ext_vector_type(2)));

constexpr int NB = 2, SEQ = 8192, M = NB * SEQ, D = 1024, DIN = 1280;
constexpr int NG = 32, LCH = 32, NCH = SEQ / LCH, KCAT = 768;
constexpr float EPS = 1e-6f;
constexpr float C2 = 0.125f * 1.4426950408889634f;
constexpr int NPHASE = 24;

constexpr size_t MiB = 1u << 20;
constexpr size_t WS_CTL = 0, CTL_ZERO_BYTES = 64 * 1024;
constexpr size_t WS_EU = 1 * MiB, WS_EV = 65 * MiB;
constexpr size_t WS_ESC = 241 * MiB + 256 * 1024;
constexpr size_t WS_LW = 129 * MiB, LW_STRIDE = 48 * MiB;
constexpr size_t LW_WIN = 0, LW_WGLU = 3 * MiB, LW_WOUT = 4 * MiB, LW_WQ = 6 * MiB, LW_SK1 = 10 * MiB, LW_SK2 = 10 * MiB + 512 * 1024,
                 LW_WGATE = 11 * MiB, LW_WPROJ = 13 * MiB, LW_AL = 13 * MiB + 512 * 1024, LW_WE = 14 * MiB, LW_WY = 22 * MiB;
constexpr size_t WS_PB = 225 * MiB, WS_ROPE = 241 * MiB, WS_XB = 242 * MiB, WS_UCAT = 274 * MiB, WS_QRAW = 300 * MiB, WS_KV = 316 * MiB,
                 WS_EBUF = 324 * MiB, WS_G = 340 * MiB, WS_Y = 356 * MiB, WS_SSQS = 388 * MiB, WS_SSQA = 389 * MiB, WS_SSQ0 = 390 * MiB, WS_SSQ1 = 391 * MiB, WS_RS = 241 * MiB + 512 * 1024, WS_RSX = 241 * MiB + 768 * 1024  , WS_PRB = 33 * MiB  ,
                 WS_QP = 392 * MiB  , WS_SELI = 456 * MiB, WS_SELW = 464 * MiB, WS_XN2 = 472 * MiB, WS_AOUT = 472 * MiB  , WS_XB2 = 480 * MiB  , WS_END = 512 * MiB;
constexpr int CW_BAR = 4096;

constexpr int RING_BYTES = 131072, LDSCTL_OFF = RING_BYTES, MISC_OFF = LDSCTL_OFF + 320, LDS_BYTES = 147456;

__device__ __forceinline__ unsigned f2bf(float f) { unsigned u = __float_as_uint(f); return (u + 0x7fffu + ((u >> 16) & 1u)) >> 16; }
__device__ __forceinline__ unsigned pk2(float lo, float hi) { return f2bf(lo) | (f2bf(hi) << 16); }
__device__ __forceinline__ float bflo(unsigned w) { return __uint_as_float(w << 16); }
__device__ __forceinline__ float bfhi(unsigned w) { return __uint_as_float(w & 0xffff0000u); }
__device__ __forceinline__ float bf1(bf16_t h) { return __uint_as_float((unsigned)h << 16); }
__device__ __forceinline__ float wave_sum(float v) {
#pragma unroll
    for (int o = 1; o < 64; o <<= 1) v += __shfl_xor(v, o);
    return v;
}
__device__ __forceinline__ float wave_max(float v) {
#pragma unroll
    for (int o = 1; o < 64; o <<= 1) v = fmaxf(v, __shfl_xor(v, o));
    return v;
}
__device__ __forceinline__ float sigmoidf_(float x) { return 1.f / (1.f + __expf(-x)); }
__device__ __forceinline__ float gelu_tanh(float x) {
    const float z = 0.7978845608028654f * (x + 0.044715f * x * x * x);
    const float e = __expf(2.f * z);
    const float th = 1.f - 2.f / (e + 1.f);
    return 0.5f * x * (1.f + th);
}
__device__ __forceinline__ float sumn(const float* p, int n) { float s = 0.f; for (int i = 0; i < n; ++i) s += p[i]; return s; }
#define LDS_WAIT() asm volatile("s_waitcnt lgkmcnt(0)" ::: "memory")
#define VM_WAIT() asm volatile("s_waitcnt vmcnt(0)" ::: "memory")

#define XB_TMO      128
#define XB_XCNT(j)  (256  + 64 * (j))
#define XB_XSUB(j)  (1280 + 64 * (j))
#define XB_XGEN(j)  (2304 + 64 * (j))
#define XB_TOP      3328
#define XB_TOPGEN   3392
#define XCD_BAR_WORDS 3456
#define XB_SPIN_CAP (1u << 18)
__device__ __forceinline__ unsigned xb_ld(unsigned* p)              { return __hip_atomic_load(p, __ATOMIC_RELAXED, __HIP_MEMORY_SCOPE_AGENT); }
__device__ __forceinline__ unsigned xb_add(unsigned* p, unsigned v) { return __hip_atomic_fetch_add(p, v, __ATOMIC_RELAXED, __HIP_MEMORY_SCOPE_AGENT); }
__device__ __forceinline__ unsigned xb_xcc_id() { return (unsigned)__builtin_amdgcn_s_getreg((3 << 11) | 20) & 0xFu; }
#define XB_SPIN(cond, bar) do { unsigned _sp = 0; while (cond) { __builtin_amdgcn_s_sleep(1); \
    if ((++_sp & 255u) == 0u) { if (xb_ld(&(bar)[XB_TMO])) break; if (_sp > XB_SPIN_CAP) { atomicAdd(&(bar)[XB_TMO], 1u); break; } } } } while (0)
struct XcdBarrier { unsigned* bar; unsigned x; volatile LAS unsigned* st; };
__device__ __forceinline__ XcdBarrier xcd_barrier_post(unsigned* bar, volatile LAS unsigned* st) {
    XcdBarrier b; b.bar = bar; b.x = xb_xcc_id(); b.st = st;
    if (threadIdx.x == 0) (void)xb_add(&bar[XB_XCNT(b.x)], 1u);
    return b;
}
__device__ __forceinline__ void xcd_barrier_complete(unsigned* bar, unsigned x, unsigned& nloc, unsigned& nx) {
    const unsigned G = gridDim.x * gridDim.y * gridDim.z;
    unsigned sum, cnt, mine, sp = 0u;
    for (;;) {
        sum = 0u; cnt = 0u; mine = 0u;
#pragma unroll
        for (unsigned j = 0; j < 16; ++j) { const unsigned c = xb_ld(&bar[XB_XCNT(j)]); sum += c; cnt += (c > 0u) ? 1u : 0u; mine = (j == x) ? c : mine; }
        if (sum == G) break;
        __builtin_amdgcn_s_sleep(1);
        if ((++sp & 255u) == 0u) { if (xb_ld(&bar[XB_TMO])) break; if (sp > XB_SPIN_CAP) { atomicAdd(&bar[XB_TMO], 1u); break; } }
    }
    nloc = mine > 0u ? mine : 1u; nx = cnt > 0u ? cnt : 1u;
}
__device__ __forceinline__ void xcd_barrier(const XcdBarrier& b) {
    asm volatile("s_waitcnt vmcnt(0)" ::: "memory");
    __syncthreads();
    if (threadIdx.x == 0) {
        unsigned* bar = b.bar;
        __builtin_amdgcn_s_waitcnt(0);
        unsigned nloc = b.st[0], nx = b.st[1];
        if (nloc == 0u) { xcd_barrier_complete(bar, b.x, nloc, nx); b.st[0] = nloc; b.st[1] = nx; }
        const unsigned old = xb_add(&bar[XB_XSUB(b.x)], 1u);
        const unsigned gen = old / nloc;
        if (old + 1u == (gen + 1u) * nloc) {
            __builtin_amdgcn_fence(__ATOMIC_RELEASE, "agent");
            asm volatile("s_waitcnt vmcnt(0)" ::: "memory");
            const unsigned og = xb_add(&bar[XB_TOP], 1u);
            const unsigned tg = og / nx;
            if (og + 1u == (tg + 1u) * nx) xb_add(&bar[XB_TOPGEN], 1u);
            else XB_SPIN(xb_ld(&bar[XB_TOPGEN]) == tg, bar);
            __builtin_amdgcn_fence(__ATOMIC_ACQUIRE, "agent");
            xb_add(&bar[XB_XGEN(b.x)], 1u);
            asm volatile("s_waitcnt vmcnt(0)" ::: "memory");
        } else {
            XB_SPIN(xb_ld(&bar[XB_XGEN(b.x)]) == gen, bar);
            __builtin_amdgcn_fence(__ATOMIC_ACQUIRE, "agent");
            asm volatile("s_waitcnt vmcnt(0)" ::: "memory");
        }
    }
    __syncthreads();
}

#ifdef PROBE_RGN
#define RGN(n, e) do { if ((n) == PROBE_RGN && blockIdx.x == PROBE_BLK && threadIdx.x == 0) { asm volatile("s_waitcnt vmcnt(0) lgkmcnt(0)" ::: "memory"); ((unsigned long long*)(rgn_ws + 48 * 1024))[e] = __builtin_amdgcn_s_memrealtime(); } } while (0)
#else
#define RGN(n, e) do {} while (0)
#endif
struct Args { const float* in[29]; float* out; unsigned char* ws; int ph_lo, ph_hi; };
enum { I_X = 0, I_P, I_NMIXG, I_WIN, I_LRE, I_LIM, I_LOGDT, I_BRE, I_BIM, I_CRE, I_CIM, I_DSKIP, I_WGLU, I_BGLU, I_QNG, I_KNG, I_SSMG, I_ATTG, I_WOUT,
       I_NFFNG, I_WQ, I_SK1, I_SK2, I_EU, I_EV, I_NPLEG, I_WGATE, I_WPROJ, I_FING };

struct Ctx { int tid, lane, wave, blk, nblk; unsigned char* lds; };

struct GemmD { const bf16_t* A; long lda; const bf16_t* Bt; long ldb; int K; int kmid; };
struct Unit { int pm, pn; };

template <class Epi>
__device__ __forceinline__ void sgemm_unit(const GemmD& g, const Unit u, const Epi& E, int wave, int lane) {
    const int i = lane & 15, q = lane >> 4;
    const bf16_t* Ab = g.A + (long)(u.pm * 256 + wave * 32) * g.lda;
    const bf16_t* Bb = g.Bt + (long)(u.pn * 256) * g.ldb;
    const int row0 = u.pm * 256 + wave * 32 + i;
    float ssq[2] = {0.f, 0.f};
    float rs[2] = {1.f, 1.f};
    if constexpr (Epi::ROWSCALE) { rs[0] = E.rscale(row0); rs[1] = E.rscale(row0 + 16); }
    for (int cg = 0; cg < 4; ++cg) {
        f32x4 acc[2][4];
#pragma unroll
        for (int mi = 0; mi < 2; ++mi)
#pragma unroll
            for (int ni = 0; ni < 4; ++ni) acc[mi][ni] = (f32x4){0.f, 0.f, 0.f, 0.f};
        for (int k0 = 0; k0 < g.K; k0 += 32) {
            if constexpr (Epi::MID) { if (k0 == g.kmid) {
#pragma unroll
                for (int mi = 0; mi < 2; ++mi) { const float f = E.mid(row0 + 16 * mi);
#pragma unroll
                    for (int ni = 0; ni < 4; ++ni) acc[mi][ni] *= f; } } }
            bf16x8 a[2], b[4];
#pragma unroll
            for (int mi = 0; mi < 2; ++mi) a[mi] = *(const bf16x8*)(Ab + (long)(16 * mi + i) * g.lda + k0 + 8 * q);
#pragma unroll
            for (int ni = 0; ni < 4; ++ni) b[ni] = *(const bf16x8*)(Bb + (long)(cg * 64 + 16 * ni + i) * g.ldb + k0 + 8 * q);
#pragma unroll
            for (int mi = 0; mi < 2; ++mi)
#pragma unroll
                for (int ni = 0; ni < 4; ++ni) acc[mi][ni] = __builtin_amdgcn_mfma_f32_16x16x32_bf16(b[ni], a[mi], acc[mi][ni], 0, 0, 0);
        }
#pragma unroll
        for (int mi = 0; mi < 2; ++mi)
#pragma unroll
            for (int ni = 0; ni < 4; ++ni) {
                const f32x4 v = acc[mi][ni] * rs[mi];
                const f32x4 w = E.put(row0 + 16 * mi, u.pn * 256 + cg * 64 + 16 * ni + 4 * q, v);
                ssq[mi] += w[0] * w[0] + w[1] * w[1] + w[2] * w[2] + w[3] * w[3];
            }
    }
    if constexpr (Epi::SSQ) {
#pragma unroll
        for (int mi = 0; mi < 2; ++mi) { float s = ssq[mi]; s += __shfl_xor(s, 16); s += __shfl_xor(s, 32);
            if (q == 0) { E.ssq(row0 + 16 * mi, u.pn * 4 + 0, s); E.ssq(row0 + 16 * mi, u.pn * 4 + 1, 0.f); E.ssq(row0 + 16 * mi, u.pn * 4 + 2, 0.f); E.ssq(row0 + 16 * mi, u.pn * 4 + 3, 0.f); } }
    }
}

__device__ __forceinline__ u32x2 pack4(f32x4 v) { u32x2 w; w.x = pk2(v[0], v[1]); w.y = pk2(v[2], v[3]); return w; }
__device__ __forceinline__ u32x4 pack8(f32x4 a, f32x4 b) { u32x4 w; w.x = pk2(a[0], a[1]); w.y = pk2(a[2], a[3]); w.z = pk2(b[0], b[1]); w.w = pk2(b[2], b[3]); return w; }
__device__ __forceinline__ void unpack8(u32x4 w, f32x4& a, f32x4& b) { a = (f32x4){bflo(w.x), bfhi(w.x), bflo(w.y), bfhi(w.y)}; b = (f32x4){bflo(w.z), bfhi(w.z), bflo(w.w), bfhi(w.w)}; }

struct EpiInproj {
    static constexpr bool MID = false, ROWSCALE = true, SSQ = false;
    const float* ssq0; bf16_t* ucat; bf16_t* qraw; bf16_t* kv;
    __device__ __forceinline__ float rscale(int row) const { return ssq0[row]; }
    __device__ __forceinline__ f32x4 put(int row, int col, f32x4 v) const {
        const u32x2 w = pack4(v);
        if (col < 512) { const int g = col >> 4, qq = col & 15, b = row >> 13, s = row & (SEQ - 1), c = s >> 5, j = s & 31;
            *(u32x2*)(ucat + ((long)((g * 2 + b) * NCH + c) * KCAT + j * 16 + qq)) = w; }
        else if (col < 1024) *(u32x2*)(qraw + (long)row * 512 + (col - 512)) = w;
        else *(u32x2*)(kv + (long)row * 256 + (col - 1024)) = w;
        return v;
    }
    __device__ __forceinline__ void put8(int row, int col, f32x4 v0, f32x4 v1, f32x4& w0, f32x4& w1) const {
        const u32x4 w = pack8(v0, v1); w0 = v0; w1 = v1;
        if (col < 512) { const int g = col >> 4, qq = col & 15, b = row >> 13, s = row & (SEQ - 1), c = s >> 5, j = s & 31;
            *(u32x4*)(ucat + ((long)((g * 2 + b) * NCH + c) * KCAT + j * 16 + qq)) = w; }
        else if (col < 1024) *(u32x4*)(qraw + (long)row * 512 + (col - 512)) = w;
        else *(u32x4*)(kv + (long)row * 256 + (col - 1024)) = w;
    }
    __device__ __forceinline__ void ssq(int, int, float) const {}
};
struct EpiS1 {
    static constexpr bool MID = false, ROWSCALE = false, SSQ = false;
    float* ebuf;
    __device__ __forceinline__ f32x4 put(int row, int col, f32x4 v) const { *(f32x4*)(ebuf + ((long)row * 256 + (col & 255))) = v; return v; }
    __device__ __forceinline__ void put8(int row, int col, f32x4 v0, f32x4 v1, f32x4& w0, f32x4& w1) const { float* p = ebuf + ((long)row * 256 + (col & 255)); *(f32x4*)p = v0; *(f32x4*)(p + 4) = v1; w0 = v0; w1 = v1; }
    __device__ __forceinline__ void ssq(int, int, float) const {}
};
struct EpiS2 {
    static constexpr bool MID = false, ROWSCALE = false, SSQ = false;
    bf16_t* G;
    __device__ __forceinline__ f32x4 put(int row, int col, f32x4 v) const {
        const int pm = row >> 8, c = row & 255, g = pm >> 1, b = pm & 1, nout = col & 511, j = nout >> 4, p = nout & 15;
        const long tok = (long)b * SEQ + c * LCH + j;
        f32x4 y; y[0] = gelu_tanh(v[0]); y[1] = gelu_tanh(v[1]); y[2] = gelu_tanh(v[2]); y[3] = gelu_tanh(v[3]);
        *(u32x2*)(G + tok * 512 + 16 * g + p) = pack4(y); return v;
    }
    __device__ __forceinline__ void put8(int row, int col, f32x4 v0, f32x4 v1, f32x4& w0, f32x4& w1) const {
        const int pm = row >> 8, c = row & 255, g = pm >> 1, b = pm & 1, nout = col & 511, j = nout >> 4, p = nout & 15;
        const long tok = (long)b * SEQ + c * LCH + j;
        f32x4 y0, y1;
#pragma unroll
        for (int e = 0; e < 4; ++e) { y0[e] = gelu_tanh(v0[e]); y1[e] = gelu_tanh(v1[e]); }
        *(u32x4*)(G + tok * 512 + 16 * g + p) = pack8(y0, y1); w0 = v0; w1 = v1;
    }
    __device__ __forceinline__ void ssq(int, int, float) const {}
};
struct EpiGlu {
    static constexpr bool MID = false, ROWSCALE = false, SSQ = true;
    const bf16_t* G; const float* bglu; bf16_t* Y; float* ssqs;
    __device__ __forceinline__ f32x4 put(int row, int col, f32x4 v) const {
        const u32x2 gw = *(const u32x2*)(G + (long)row * 512 + col);
        const f32x4 bb = *(const f32x4*)(bglu + col);
        f32x4 ys; ys[0] = bflo(gw.x) * sigmoidf_(v[0] + bb[0]); ys[1] = bfhi(gw.x) * sigmoidf_(v[1] + bb[1]);
        ys[2] = bflo(gw.y) * sigmoidf_(v[2] + bb[2]); ys[3] = bfhi(gw.y) * sigmoidf_(v[3] + bb[3]);
        *(u32x2*)(Y + (long)row * 1024 + col) = pack4(ys); return ys;
    }
    __device__ __forceinline__ void put8(int row, int col, f32x4 v0, f32x4 v1, f32x4& w0, f32x4& w1) const {
        f32x4 g0, g1; unpack8(*(const u32x4*)(G + (long)row * 512 + col), g0, g1);
        const f32x4 b0 = *(const f32x4*)(bglu + col), b1 = *(const f32x4*)(bglu + col + 4);
#pragma unroll
        for (int e = 0; e < 4; ++e) { w0[e] = g0[e] * sigmoidf_(v0[e] + b0[e]); w1[e] = g1[e] * sigmoidf_(v1[e] + b1[e]); }
        *(u32x4*)(Y + (long)row * 1024 + col) = pack8(w0, w1);
    }
    __device__ __forceinline__ void ssq(int row, int slot, float s) const { ssqs[(long)row * 16 + slot] = s; }
};
struct EpiOut {
    static constexpr bool MID = true, ROWSCALE = true, SSQ = true;
    const float* rs; bf16_t* xb; float* ssq1;
    __device__ __forceinline__ float mid(int row) const { return rs[(long)row * 2]; }
    __device__ __forceinline__ float rscale(int row) const { return rs[(long)row * 2 + 1]; }
    __device__ __forceinline__ f32x4 put(int row, int col, f32x4 v) const {
        const long o = (long)row * D + col; const u32x2 xw = *(const u32x2*)(xb + o); const f32x4 x1 = (f32x4){bflo(xw.x), bfhi(xw.x), bflo(xw.y), bfhi(xw.y)} + v;
        const u32x2 ow = pack4(x1); *(u32x2*)(xb + o) = ow; return (f32x4){bflo(ow.x), bfhi(ow.x), bflo(ow.y), bfhi(ow.y)};
    }
    __device__ __forceinline__ void put8(int row, int col, f32x4 v0, f32x4 v1, f32x4& w0, f32x4& w1) const {
        const long o = (long)row * D + col; f32x4 x0, x1; unpack8(*(const u32x4*)(xb + o), x0, x1);
        const u32x4 ow = pack8(x0 + v0, x1 + v1); *(u32x4*)(xb + o) = ow; unpack8(ow, w0, w1);
    }
    __device__ __forceinline__ void ssq(int row, int slot, float s) const { ssq1[(long)row * 16 + slot] = s; }
};
struct EpiQ {
    static constexpr bool MID = false, ROWSCALE = true, SSQ = false;
    const float* ssq1; bf16_t* qp;
    __device__ __forceinline__ float rscale(int row) const { return ssq1[row]; }
    __device__ __forceinline__ f32x4 put(int row, int col, f32x4 v) const { *(u32x2*)(qp + (long)row * 2048 + col) = pack4(v); return v; }
    __device__ __forceinline__ void put8(int row, int col, f32x4 v0, f32x4 v1, f32x4& w0, f32x4& w1) const { *(u32x4*)(qp + (long)row * 2048 + col) = pack8(v0, v1); w0 = v0; w1 = v1; }
    __device__ __forceinline__ void ssq(int, int, float) const {}
};
struct EpiProj {
    static constexpr bool MID = false, ROWSCALE = false, SSQ = false;
    bf16_t* pr;
    __device__ __forceinline__ f32x4 put(int row, int col, f32x4 v) const { *(u32x2*)(pr + (long)row * D + col) = pack4(v); return v; }
    __device__ __forceinline__ void put8(int row, int col, f32x4 v0, f32x4 v1, f32x4& w0, f32x4& w1) const { *(u32x4*)(pr + (long)row * D + col) = pack8(v0, v1); w0 = v0; w1 = v1; }
    __device__ __forceinline__ void ssq(int, int, float) const {}
};
struct EpiGate {
    static constexpr bool MID = false, ROWSCALE = true, SSQ = true;
    const bf16_t* pr; const bf16_t* xin; bf16_t* xout; float* ssq0; const float* ssq2;
    __device__ __forceinline__ float rscale(int row) const { return ssq2[row]; }
    __device__ __forceinline__ f32x4 put(int row, int col, f32x4 v) const {
        const long o = (long)row * D + col; const u32x2 pw = *(const u32x2*)(pr + o); const f32x4 pv = (f32x4){bflo(pw.x), bfhi(pw.x), bflo(pw.y), bfhi(pw.y)}; const u32x2 xw = *(const u32x2*)(xin + o); f32x4 x3 = (f32x4){bflo(xw.x), bfhi(xw.x), bflo(xw.y), bfhi(xw.y)};
        x3[0] += sigmoidf_(v[0]) * pv[0]; x3[1] += sigmoidf_(v[1]) * pv[1]; x3[2] += sigmoidf_(v[2]) * pv[2]; x3[3] += sigmoidf_(v[3]) * pv[3];
        const u32x2 ow = pack4(x3); *(u32x2*)(xout + o) = ow; return (f32x4){bflo(ow.x), bfhi(ow.x), bflo(ow.y), bfhi(ow.y)};
    }
    __device__ __forceinline__ void put8(int row, int col, f32x4 v0, f32x4 v1, f32x4& w0, f32x4& w1) const {
        const long o = (long)row * D + col; f32x4 p0, p1, x0, x1; unpack8(*(const u32x4*)(pr + o), p0, p1); unpack8(*(const u32x4*)(xin + o), x0, x1);
#pragma unroll
        for (int e = 0; e < 4; ++e) { x0[e] += sigmoidf_(v0[e]) * p0[e]; x1[e] += sigmoidf_(v1[e]) * p1[e]; }
        const u32x4 ow = pack8(x0, x1); *(u32x4*)(xout + o) = ow; unpack8(ow, w0, w1);
    }
    __device__ __forceinline__ void ssq(int row, int slot, float s) const { ssq0[(long)row * 16 + slot] = s; }
};


namespace pg8 {
#define PG8_LAS __attribute__((address_space(3)))
constexpr int BM = 256, BK = 64, HALF = 128, HTB = HALF * BK * 2, STAGE_BYTES = 8 * HTB, NXCD = 8, WGM = 8;
__host__ __device__ __forceinline__ int lds_byte(int r, int c) { const int st = (r >> 4) * 2 + (c >> 5), rr = r & 15, cc = c & 31, ob = rr * 64 + cc * 2; return st * 1024 + (ob ^ (((ob >> 9) & 1) << 5)); }
__host__ __device__ __forceinline__ void stage_rc(int b, int& R, int& C) { const int st = b / 1024, sb = b % 1024, swz = sb ^ (((sb >> 9) & 1) << 5); R = (st >> 1) * 16 + swz / 64; C = (st & 1) * 32 + (swz % 64) / 2; }
__host__ __device__ __forceinline__ int perm32(int rho) { const int n = rho >> 4, i = rho & 15; return 8 * (i >> 2) + 4 * n + (i & 3); }
using ::Unit;
struct Gemm { const bf16_t* A; const bf16_t* Bt; int K, lda, ldb, kmid; };
struct StaticOrder {
    int nM, nN, nwg, G, c;
    __host__ __device__ __forceinline__ void init(int M_, int N_, int G_, int c_) { nM = M_ / BM; nN = N_ / BM; nwg = nM * nN; G = G_; c = c_; }
    __host__ __device__ __forceinline__ bool next(int i, Unit& u) const {
        const long L = (long)i * G + c; if (L >= nwg) return false;
        int wgid = (int)L; { const int q = nwg / NXCD, r = nwg % NXCD, xcd = wgid % NXCD, off = wgid / NXCD; wgid = (xcd < r ? xcd * (q + 1) : r * (q + 1) + (xcd - r) * q) + off; }
        const int nig = WGM * nN, gid = wgid / nig, fm = gid * WGM, gsz = (nM - fm) < WGM ? (nM - fm) : WGM;
        u.pm = fm + ((wgid % nig) % gsz); u.pn = (wgid % nig) / gsz; return true;
    }
    __device__ __forceinline__ void a_ready(const Unit&) const {}
    __device__ __forceinline__ void done(const Unit&) const {}
};
struct OneUnit { Unit u;
    __device__ __forceinline__ bool next(int i, Unit& o) const { if (i) return false; o = u; return true; }
    __device__ __forceinline__ void a_ready(const Unit&) const {}
    __device__ __forceinline__ void done(const Unit&) const {} };
struct S2Order { int blk, nblk;
    __device__ __forceinline__ bool next(int i, Unit& o) const { const int ui = blk + i * nblk; if (ui >= 128) return false; o.pm = ui >> 1; o.pn = (ui >> 2) * 2 + (ui & 1); return true; }
    __device__ __forceinline__ void a_ready(const Unit&) const {}
    __device__ __forceinline__ void done(const Unit&) const {} };
template <class F> struct Epi {
    static constexpr bool PERM = true, AFTER_DRAIN = false, MID = F::MID;
    F f;
    __device__ __forceinline__ void operator()(const f32x4 (&acc)[2][2][4][2], const Unit& u, int wr, int wc, int fr, int fq) const {
        asm volatile("" : "+v"(fr), "+v"(fq));
        const int rowb = u.pm * BM + wr * 64 + fr, colb = u.pn * BM + wc * 32 + 8 * fq;
        float rsv[8];
#pragma unroll
        for (int i = 0; i < 8; ++i) { rsv[i] = 1.f; if constexpr (F::ROWSCALE) rsv[i] = f.rscale(rowb + (i >> 2) * HALF + (i & 3) * 16); }
#pragma unroll
        for (int ai = 0; ai < 2; ++ai)
#pragma unroll
            for (int m = 0; m < 4; ++m) {
                const int row = rowb + ai * HALF + m * 16; const float rs = rsv[ai * 4 + m];
                float ss = 0.f;
#pragma unroll
                for (int bj = 0; bj < 2; ++bj) { f32x4 w0, w1; f.put8(row, colb + bj * HALF, acc[ai][bj][m][0] * rs, acc[ai][bj][m][1] * rs, w0, w1);
                    ss += (w0[0] * w0[0] + w0[1] * w0[1] + w0[2] * w0[2] + w0[3] * w0[3]) + (w1[0] * w1[0] + w1[1] * w1[1] + w1[2] * w1[2] + w1[3] * w1[3]); }
                if constexpr (F::SSQ) { ss += __shfl_xor(ss, 16); ss += __shfl_xor(ss, 32); if (fq == 0) f.ssq(row, u.pn * 4 + wc, ss); }
                asm volatile("" ::: "memory");
            }
    }
    __device__ __forceinline__ void midscale(f32x4 (&acc)[2][2][4][2], const Unit& u, int wr, int wc, int fr, int fq) const {
        if constexpr (F::MID) {
            asm volatile("" : "+v"(fr));
            const int rowb = u.pm * BM + wr * 64 + fr;
#pragma unroll
            for (int ai = 0; ai < 2; ++ai)
#pragma unroll
                for (int m = 0; m < 4; ++m) { const float s = f.mid(rowb + ai * HALF + m * 16);
#pragma unroll
                    for (int bj = 0; bj < 2; ++bj)
#pragma unroll
                        for (int n = 0; n < 2; ++n) acc[ai][bj][m][n] *= s; }
        }
    }
};
template <class Epi, class Sched, bool ALIGN_EPI = false, bool SP2 = false>
__device__ __forceinline__ void gemm_phase(PG8_LAS unsigned char* lds, const Gemm g, const Sched& S, const Epi& E, const int tid) {
    const int wid = __builtin_amdgcn_readfirstlane(tid >> 6), lane = tid & 63, wr = wid >> 2, wc = wid & 3, fr = lane & 15, fq = lane >> 4;
    const int K = g.K, nt = K / BK;
    unsigned voffA[2], voffB[2];
#pragma unroll
    for (int i = 0; i < 2; ++i) { int R, C; stage_rc(tid * 16 + i * 8192, R, C); const int Rb = Epi::PERM ? ((R & ~31) + perm32(R & 31)) : R;
        voffA[i] = (unsigned)(R * g.lda + C) * 2u; voffB[i] = (unsigned)(Rb * g.ldb + C) * 2u; }
    const size_t kstep = (size_t)(BK * 2);
    const size_t hstepA = (size_t)HALF * g.lda * 2, hstepB = (size_t)HALF * g.ldb * 2;
    const size_t tstepA = 2 * hstepA, tstepB = 2 * hstepB;
    const unsigned ldsw = (unsigned)wid * 1024u;
    const int aoff = lds_byte(wr * 64 + fr, fq * 8), boff = lds_byte(wc * 32 + fr, fq * 8);
#define PG8_SA(b, h) (((b) * 2 + (h)) * HTB)
#define PG8_SB(b, h) ((4 + (b) * 2 + (h)) * HTB)
#define PG8_STAGE(bufoff, gbase, voff) do { _Pragma("unroll") for (int _i = 0; _i < 2; ++_i) \
        __builtin_amdgcn_global_load_lds((const unsigned*)((const char*)(gbase) + (voff)[_i]), (PG8_LAS unsigned*)(lds + (bufoff) + ldsw + _i * 8192), 16, 0, 0); } while (0)
#define PG8_LDA(dst, b, h) do { _Pragma("unroll") for (int m = 0; m < 4; ++m) _Pragma("unroll") for (int k = 0; k < 2; ++k) dst[m][k] = *(const PG8_LAS bf16x8*)(lds + PG8_SA(b, h) + aoff + m * 2048 + k * 1024); } while (0)
#define PG8_LDB(dst, b, h) do { _Pragma("unroll") for (int n = 0; n < 2; ++n) _Pragma("unroll") for (int k = 0; k < 2; ++k) dst[n][k] = *(const PG8_LAS bf16x8*)(lds + PG8_SB(b, h) + boff + n * 2048 + k * 1024); } while (0)
#define PG8_MMA(ai, bj, At, Bt) do { __builtin_amdgcn_s_setprio(1); _Pragma("unroll") for (int m = 0; m < 4; ++m) _Pragma("unroll") for (int n = 0; n < 2; ++n) _Pragma("unroll") for (int k = 0; k < 2; ++k) \
        acc[ai][bj][m][n] = __builtin_amdgcn_mfma_f32_16x16x32_bf16(Bt[n][k], At[m][k], acc[ai][bj][m][n], 0, 0, 0); __builtin_amdgcn_s_setprio(0); } while (0)
#define PG8_WAIT_V(n) asm volatile("s_waitcnt vmcnt(" #n ")" ::: "memory")
#define PG8_WAIT_L(n) asm volatile("s_waitcnt lgkmcnt(" #n ")" ::: "memory")
#define PG8_BAR __builtin_amdgcn_s_barrier()
#define PG8_SCHED __builtin_amdgcn_sched_barrier(0)
    Unit cur, nxt; int ui = 0;
    if (!S.next(0, cur)) return;
    f32x4 acc[2][2][4][2];
#pragma unroll
    for (int a = 0; a < 2; ++a)
#pragma unroll
        for (int b = 0; b < 2; ++b)
#pragma unroll
            for (int m = 0; m < 4; ++m)
#pragma unroll
                for (int n = 0; n < 2; ++n) acc[a][b][m][n] = (f32x4){0.f, 0.f, 0.f, 0.f};
    bf16x8 At[4][2], B0[2][2], B1[2][2];
    const char* cA = (const char*)g.A + (size_t)cur.pm * tstepA; const char* cB = (const char*)g.Bt + (size_t)cur.pn * tstepB;
    S.a_ready(cur);
    if constexpr (SP2) {
        PG8_STAGE(PG8_SB(0, 0), cB, voffB); PG8_STAGE(PG8_SB(0, 1), cB + hstepB, voffB); PG8_STAGE(PG8_SA(0, 0), cA, voffA); PG8_STAGE(PG8_SA(0, 1), cA + hstepA, voffA);
        if (wr == 1) PG8_BAR;
        PG8_WAIT_V(2); PG8_BAR;
        PG8_STAGE(PG8_SB(1, 0), cB + kstep, voffB); PG8_STAGE(PG8_SA(1, 0), cA + kstep, voffA); PG8_STAGE(PG8_SB(1, 1), cB + hstepB + kstep, voffB);
        PG8_WAIT_V(6); PG8_BAR;
    } else {
        PG8_STAGE(PG8_SB(0, 0), cB, voffB); PG8_STAGE(PG8_SA(0, 0), cA, voffA); PG8_STAGE(PG8_SB(0, 1), cB + hstepB, voffB); PG8_STAGE(PG8_SA(0, 1), cA + hstepA, voffA);
        if (wr == 1) PG8_BAR;
        PG8_WAIT_V(4); PG8_BAR;
        PG8_STAGE(PG8_SB(1, 0), cB + kstep, voffB); PG8_STAGE(PG8_SA(1, 0), cA + kstep, voffA); PG8_STAGE(PG8_SB(1, 1), cB + hstepB + kstep, voffB);
        PG8_WAIT_V(6); PG8_BAR;
    }
    for (;;) {
        const bool has_next = S.next(ui + 1, nxt);
        const char* nA = has_next ? (const char*)g.A + (size_t)nxt.pm * tstepA : cA; const char* nB = has_next ? (const char*)g.Bt + (size_t)nxt.pn * tstepB : cB;
        for (int t = 0; t < nt; t += 2) {
            const bool last = (t == nt - 2);
            if constexpr (Epi::MID) { if (t * BK == g.kmid) E.midscale(acc, cur, wr, wc, fr, fq); }
            const char* a1 = cA + (size_t)(t + 1) * kstep;
            const char* a2 = last ? nA : cA + (size_t)(t + 2) * kstep; const char* b2 = last ? nB : cB + (size_t)(t + 2) * kstep;
            const char* a3 = a2 + kstep; const char* b3 = b2 + kstep;
            if (last && has_next) S.a_ready(nxt);
            if constexpr (SP2) {
            PG8_LDB(B0, 0, 0); PG8_LDB(B1, 0, 1); PG8_SCHED; PG8_LDA(At, 0, 0); PG8_STAGE(PG8_SA(1, 1), a1 + hstepA, voffA);
            PG8_WAIT_V(8); PG8_WAIT_L(0); PG8_BAR; PG8_MMA(0, 0, At, B0); PG8_MMA(0, 1, At, B1); PG8_BAR; PG8_SCHED;
            PG8_LDA(At, 0, 1); PG8_STAGE(PG8_SB(0, 0), b2, voffB); PG8_STAGE(PG8_SB(0, 1), b2 + hstepB, voffB); PG8_STAGE(PG8_SA(0, 0), a2, voffA);
            PG8_WAIT_V(8); PG8_WAIT_L(0); PG8_BAR; PG8_MMA(1, 0, At, B0); PG8_MMA(1, 1, At, B1); PG8_BAR; PG8_SCHED;
            PG8_LDB(B0, 1, 0); PG8_LDB(B1, 1, 1); PG8_SCHED; PG8_LDA(At, 1, 0); PG8_STAGE(PG8_SA(0, 1), a2 + hstepA, voffA);
            PG8_WAIT_V(8); PG8_WAIT_L(0); PG8_BAR; PG8_MMA(0, 0, At, B0); PG8_MMA(0, 1, At, B1); PG8_BAR; PG8_SCHED;
            PG8_LDA(At, 1, 1); PG8_STAGE(PG8_SB(1, 0), b3, voffB); PG8_STAGE(PG8_SB(1, 1), b3 + hstepB, voffB); PG8_STAGE(PG8_SA(1, 0), a3, voffA);
            PG8_WAIT_V(8); PG8_WAIT_L(0); PG8_BAR; PG8_MMA(1, 0, At, B0); PG8_MMA(1, 1, At, B1); PG8_BAR; PG8_SCHED;
            } else {
            PG8_LDB(B0, 0, 0); PG8_SCHED; PG8_LDA(At, 0, 0); PG8_STAGE(PG8_SA(1, 1), a1 + hstepA, voffA);
            PG8_WAIT_L(8); PG8_BAR; PG8_WAIT_L(0); PG8_MMA(0, 0, At, B0); PG8_BAR; PG8_SCHED;
            PG8_LDB(B1, 0, 1); PG8_STAGE(PG8_SB(0, 0), b2, voffB);
            PG8_BAR; PG8_WAIT_L(0); PG8_MMA(0, 1, At, B1); PG8_BAR;
            PG8_LDA(At, 0, 1); PG8_STAGE(PG8_SA(0, 0), a2, voffA);
            PG8_BAR; PG8_WAIT_L(0); PG8_MMA(1, 0, At, B0); PG8_BAR; PG8_SCHED;
            PG8_STAGE(PG8_SB(0, 1), b2 + hstepB, voffB);
            PG8_WAIT_V(6); PG8_BAR; PG8_MMA(1, 1, At, B1); PG8_BAR;
            PG8_LDB(B0, 1, 0); PG8_SCHED; PG8_LDA(At, 1, 0); PG8_STAGE(PG8_SA(0, 1), a2 + hstepA, voffA);
            PG8_WAIT_L(8); PG8_BAR; PG8_WAIT_L(0); PG8_MMA(0, 0, At, B0); PG8_BAR; PG8_SCHED;
            PG8_LDB(B1, 1, 1); PG8_STAGE(PG8_SB(1, 0), b3, voffB);
            PG8_BAR; PG8_WAIT_L(0); PG8_MMA(0, 1, At, B1); PG8_BAR;
            PG8_LDA(At, 1, 1); PG8_STAGE(PG8_SA(1, 0), a3, voffA);
            PG8_BAR; PG8_WAIT_L(0); PG8_MMA(1, 0, At, B0); PG8_BAR; PG8_SCHED;
            PG8_STAGE(PG8_SB(1, 1), b3 + hstepB, voffB);
            PG8_WAIT_V(6); PG8_BAR; PG8_MMA(1, 1, At, B1); PG8_BAR;
            }
        }
        if constexpr (ALIGN_EPI) { if (wr == 0) PG8_BAR; }
        if constexpr (!Epi::AFTER_DRAIN) { E(acc, cur, wr, wc, fr, fq); S.done(cur); }
        if (!has_next) break;
#pragma unroll
        for (int a = 0; a < 2; ++a)
#pragma unroll
            for (int b = 0; b < 2; ++b)
#pragma unroll
                for (int m = 0; m < 4; ++m)
#pragma unroll
                    for (int n = 0; n < 2; ++n) acc[a][b][m][n] = (f32x4){0.f, 0.f, 0.f, 0.f};
        cur = nxt; cA = nA; cB = nB; ++ui;
        if constexpr (ALIGN_EPI) { if (wr == 1) PG8_BAR; }
    }
    PG8_WAIT_V(0);
    if constexpr (!ALIGN_EPI) { if (wr == 0) PG8_BAR; }
    PG8_BAR;
    if constexpr (Epi::AFTER_DRAIN) { E.fused(acc, cur, wr, wc, fr, fq, lds, wid, lane); S.done(cur); }
#undef PG8_SA
#undef PG8_SB
#undef PG8_STAGE
#undef PG8_LDA
#undef PG8_LDB
#undef PG8_MMA
#undef PG8_WAIT_V
#undef PG8_WAIT_L
#undef PG8_BAR
#undef PG8_SCHED
}

}

template <class F, class Sched>
__device__ __forceinline__ void run_gemm(unsigned char* lds, const GemmD& g, const Sched& S, const F& f, const int tid) {
    pg8::Gemm pg; pg.A = g.A; pg.Bt = g.Bt; pg.K = g.K; pg.lda = (int)g.lda; pg.ldb = (int)g.ldb; pg.kmid = g.kmid;
    pg8::Epi<F> E; E.f = f;
    pg8::gemm_phase<pg8::Epi<F>, Sched, true, true>((PG8_LAS unsigned char*)lds, pg, S, E, tid);
}
__device__ __forceinline__ void rstd_rows(const Ctx& c, const float* ssq, int nslot, float* rsx, int nN, int G, int cidx) {
    pg8::StaticOrder S0; S0.init(M, nN * 256, G, cidx); Unit u0;
    for (int i = 0; S0.next(i, u0); ++i) if (c.tid < 256) { const int row = u0.pm * 256 + c.tid; rsx[row] = rsqrtf(sumn(ssq + (long)row * 16, nslot) * (1.f / D) + EPS); }
    VM_WAIT(); __syncthreads();
}
template <class Epi>
__device__ __forceinline__ void gemm_phase_sub(const Ctx& c, const GemmD& g, int nM, int nN, const Epi& E, int G, int cidx) {
    pg8::StaticOrder S; S.init(nM * 256, nN * 256, G, cidx);
    run_gemm(c.lds, g, S, E, c.tid);
}
template <class Epi>
__device__ __forceinline__ void gemm_phase_dense(const Ctx& c, const GemmD& g, int nM, int nN, const Epi& E) {
#ifdef USE_SGEMM
    const int nU = nM * nN;
    for (int ui = c.blk; ui < nU; ui += c.nblk) { Unit u; u.pn = ui % nN; u.pm = ui / nN; sgemm_unit(g, u, E, c.wave, c.lane); }
#else
    pg8::StaticOrder S; S.init(nM * 256, nN * 256, c.nblk, c.blk);
    run_gemm(c.lds, g, S, E, c.tid);
#endif
}

__device__ __forceinline__ void transpose_item(const float* W, int K, int N, bf16_t* WT, const float* gain, float* scr, int item, int lane) {
    const int nblk = N / 32, kb = item / nblk, nb = item % nblk, k0 = 64 * kb, n0 = 32 * nb;
    { f32x4 v[8];
#pragma unroll
      for (int i = 0; i < 8; ++i) v[i] = *(const f32x4*)(W + (size_t)(k0 + 8 * i + (lane >> 3)) * N + n0 + 4 * (lane & 7));
#pragma unroll
      for (int i = 0; i < 8; ++i) { const int kk = 8 * i + (lane >> 3); const float gg = gain ? gain[k0 + kk] : 1.f; float* s = scr + kk * 33 + 4 * (lane & 7);
          s[0] = v[i][0] * gg; s[1] = v[i][1] * gg; s[2] = v[i][2] * gg; s[3] = v[i][3] * gg; } }
    LDS_WAIT(); asm volatile("" ::: "memory");
    const int cc = lane & 7;
#pragma unroll
    for (int j = 0; j < 4; ++j) { const int n = (lane >> 3) + 8 * j; const float* s = scr + (8 * cc) * 33 + n;
        u32x4 o; o.x = pk2(s[0 * 33], s[1 * 33]); o.y = pk2(s[2 * 33], s[3 * 33]); o.z = pk2(s[4 * 33], s[5 * 33]); o.w = pk2(s[6 * 33], s[7 * 33]);
        *(u32x4*)(WT + (size_t)(n0 + n) * K + k0 + 8 * cc) = o; }
    LDS_WAIT(); asm volatile("" ::: "memory");
}
__device__ __forceinline__ void transpose_wg_item(const Ctx& c, const float* W, int K, int N, bf16_t* WT, const float* gain, int item) {
    const int nblk = N / 256, kb = item / nblk, nb = item % nblk, k0 = 64 * kb, n0 = 256 * nb;
    float* T = (float*)c.lds;
    f32x4 v[8];
#pragma unroll
    for (int i = 0; i < 8; ++i) { const int idx = i * 512 + c.tid, row = idx >> 6, c4 = idx & 63; v[i] = *(const f32x4*)(W + (size_t)(k0 + row) * N + n0 + 4 * c4); }
#pragma unroll
    for (int i = 0; i < 8; ++i) { const int idx = i * 512 + c.tid, row = idx >> 6, c4 = idx & 63; const float gg = gain ? gain[k0 + row] : 1.f; float* s = T + row * 257 + 4 * c4;
        s[0] = v[i][0] * gg; s[1] = v[i][1] * gg; s[2] = v[i][2] * gg; s[3] = v[i][3] * gg; }
    __syncthreads();
#pragma unroll
    for (int j = 0; j < 4; ++j) { const int id = j * 512 + c.tid, n = id >> 3, cc = id & 7; const float* s = T + (8 * cc) * 257 + n;
        u32x4 o; o.x = pk2(s[0 * 257], s[1 * 257]); o.y = pk2(s[2 * 257], s[3 * 257]); o.z = pk2(s[4 * 257], s[5 * 257]); o.w = pk2(s[6 * 257], s[7 * 257]);
        *(u32x4*)(WT + (size_t)(n0 + n) * K + k0 + 8 * cc) = o; }
    __syncthreads();
}
__device__ __forceinline__ void cvt_range(const Ctx& c, const float* src, bf16_t* dst, size_t n) {
    const size_t nv = n / 8, stride = (size_t)c.nblk * 512;
    for (size_t v0 = (size_t)c.blk * 512 + c.tid; v0 < nv; v0 += 4 * stride) {
        f32x4 a[4], b[4];
#pragma unroll
        for (int u = 0; u < 4; ++u) { const size_t v = v0 + u * stride < nv ? v0 + u * stride : v0; a[u] = *(const f32x4*)(src + v * 8); b[u] = *(const f32x4*)(src + v * 8 + 4); }
#pragma unroll
        for (int u = 0; u < 4; ++u) { const size_t v = v0 + u * stride; if (v < nv) { u32x4 o; o.x = pk2(a[u][0], a[u][1]); o.y = pk2(a[u][2], a[u][3]); o.z = pk2(b[u][0], b[u][1]); o.w = pk2(b[u][2], b[u][3]);
            *(u32x4*)(dst + v * 8) = o; } }
    }
}
__device__ __forceinline__ void ssm_tables_unit(const Ctx& c, const Args& a, int layer, int g, int part, int nparts) {
    float* Apow = (float*)c.lds;
    float* Bre = Apow + 2 * 33 * 64 * 2;
    float* Bim = Bre + 2 * 64 * 16;
    float* Cre = Bim + 2 * 64 * 16;
    float* Cim = Cre + 2 * 16 * 64;
    float* Tt = Cim + 2 * 16 * 64;
    unsigned char* lw = a.ws + WS_LW + (size_t)layer * LW_STRIDE;
    float* AL = (float*)(lw + LW_AL);
    bf16_t* WE = (bf16_t*)(lw + LW_WE) + (size_t)g * 256 * 512;
    bf16_t* WY = (bf16_t*)(lw + LW_WY) + (size_t)g * 512 * KCAT;
    const int tid = c.tid;
    unsigned char* rgn_ws = a.ws; (void)rgn_ws;
    __syncthreads();
    RGN(11, 0);
    if (tid < 128) {
        const int dir = tid >> 6, n = tid & 63; const int ldg = (layer * 2 + dir) * NG + g;
        const float lre = a.in[I_LRE][ldg * 64 + n], lim = a.in[I_LIM][ldg * 64 + n];
        const float dt = expf(a.in[I_LOGDT][ldg]);
        { const float dec = expf(lre * dt); float sn, cs; sincosf(lim * dt, &sn, &cs); const float a1r = dec * cs, a1i = dec * sn;
          float pr = 1.f, pi = 0.f;
          for (int k = 0; k <= 32; ++k) { Apow[((dir * 33 + k) * 64 + n) * 2 + 0] = pr; Apow[((dir * 33 + k) * 64 + n) * 2 + 1] = pi;
              const float nr_ = pr * a1r - pi * a1i, ni_ = pr * a1i + pi * a1r; pr = nr_; pi = ni_; } }
        const float abr = Apow[((dir * 33 + 1) * 64 + n) * 2 + 0], abi = Apow[((dir * 33 + 1) * 64 + n) * 2 + 1];
        const float den = lre * lre + lim * lim, nr = abr - 1.f;
        const float fre = (nr * lre + abi * lim) / den, fim = (abi * lre - nr * lim) / den;
        for (int q = 0; q < 16; ++q) { const float br = a.in[I_BRE][(ldg * 64 + n) * 16 + q], bi = a.in[I_BIM][(ldg * 64 + n) * 16 + q];
            Bre[(dir * 64 + n) * 16 + q] = fre * br - fim * bi; Bim[(dir * 64 + n) * 16 + q] = fre * bi + fim * br; }
        for (int p = 0; p < 16; ++p) { Cre[(dir * 16 + p) * 64 + n] = a.in[I_CRE][(ldg * 16 + p) * 64 + n]; Cim[(dir * 16 + p) * 64 + n] = a.in[I_CIM][(ldg * 16 + p) * 64 + n]; }
        if (part == 0) { AL[((dir * NG + g) * 64 + n) * 2 + 0] = Apow[((dir * 33 + 32) * 64 + n) * 2 + 0];
        AL[((dir * NG + g) * 64 + n) * 2 + 1] = Apow[((dir * 33 + 32) * 64 + n) * 2 + 1]; }
    }
    __syncthreads();
    RGN(11, 1); RGN(12, 0);
    const int kk_lo = nparts == 4 ? 8 * part : 0, nkk = nparts == 4 ? 39 : 63;
    {
        const int l15 = c.lane & 15, l4 = c.lane >> 4;
      for (int kb0 = 0; kb0 < nkk; kb0 += 40) {
        f32x4 accs[5]; int ks[5]; bool val[5];
#pragma unroll
        for (int i = 0; i < 5; ++i) { const int kx = kb0 + c.wave + 8 * i; val[i] = kx < nkk; ks[i] = kk_lo + (val[i] ? kx : 0) - 31; accs[i] = (f32x4){0.f, 0.f, 0.f, 0.f}; }
#pragma unroll 2
        for (int st = 0; st < 32; ++st) {
            const int kidx = 4 * st + l4, n = kidx & 63; const bool lo = kidx < 64;
            const float cr0 = Cre[l15 * 64 + n], ci0 = Cim[l15 * 64 + n], cr1 = Cre[(16 + l15) * 64 + n], ci1 = Cim[(16 + l15) * 64 + n];
            const float b0 = lo ? Bre[n * 16 + l15] : Bim[n * 16 + l15], b1 = lo ? Bre[(64 + n) * 16 + l15] : Bim[(64 + n) * 16 + l15];
#pragma unroll
            for (int i = 0; i < 5; ++i) {
                const int dir = ks[i] < 0 ? 1 : 0, e = ks[i] < 0 ? -ks[i] : ks[i];
                const float ar = Apow[((dir * 33 + e) * 64 + n) * 2 + 0], ai = Apow[((dir * 33 + e) * 64 + n) * 2 + 1];
                const float cr = dir ? cr1 : cr0, ci = dir ? ci1 : ci0;
                const float av = lo ? (cr * ar - ci * ai) : -(cr * ai + ci * ar);
                accs[i] = __builtin_amdgcn_mfma_f32_16x16x4f32(av, dir ? b1 : b0, accs[i], 0, 0, 0);
            }
        }
#pragma unroll
        for (int i = 0; i < 5; ++i) if (val[i] && ks[i] == 0) {
#pragma unroll 4
            for (int st = 0; st < 32; ++st) {
                const int kidx = 4 * st + l4, n = kidx & 63; const bool lo = kidx < 64;
                const float cr = Cre[(16 + l15) * 64 + n], ci = Cim[(16 + l15) * 64 + n];
                const float ar = Apow[((33 + 0) * 64 + n) * 2 + 0], ai = Apow[((33 + 0) * 64 + n) * 2 + 1];
                const float av = lo ? (cr * ar - ci * ai) : -(cr * ai + ci * ar);
                const float bv = lo ? Bre[(64 + n) * 16 + l15] : Bim[(64 + n) * 16 + l15];
                accs[i] = __builtin_amdgcn_mfma_f32_16x16x4f32(av, bv, accs[i], 0, 0, 0);
            }
        }
#pragma unroll
        for (int i = 0; i < 5; ++i) if (val[i]) { const int kk = ks[i] + 31;
#pragma unroll
            for (int r = 0; r < 4; ++r) { const int p = 4 * l4 + r;
                Tt[(kk * 16 + p) * 16 + l15] = accs[i][r] + ((ks[i] == 0 && l15 == p) ? a.in[I_DSKIP][layer * 512 + 16 * g + p] : 0.f); } }
      }
    }
    __syncthreads();
    RGN(12, 1); RGN(13, 0);
    const int wy_lo = (512 * 96 / nparts) * part, wy_hi = wy_lo + 512 * 96 / nparts, we_lo = (256 * 64 / nparts) * part, we_hi = we_lo + 256 * 64 / nparts;
    for (int it = wy_lo + tid; it < wy_hi; it += 512) {
        const int nout = it / 96, kin0 = (it % 96) * 8, j = nout >> 4, p = nout & 15;
        float v[8];
        if (kin0 < 512) { const int s = kin0 >> 4, q0 = kin0 & 15, kk = j - s + 31;
#pragma unroll
            for (int i = 0; i < 8; ++i) v[i] = Tt[(kk * 16 + p) * 16 + q0 + i]; }
        else { const int comp = kin0 - 512, dir = comp >> 7, reim = (comp >> 6) & 1, n0 = comp & 63, e = dir == 0 ? j + 1 : 32 - j;
#pragma unroll
            for (int i = 0; i < 8; ++i) { const int n = n0 + i; const float cr = Cre[(dir * 16 + p) * 64 + n], ci = Cim[(dir * 16 + p) * 64 + n];
                const float ar = Apow[((dir * 33 + e) * 64 + n) * 2 + 0], ai = Apow[((dir * 33 + e) * 64 + n) * 2 + 1];
                v[i] = reim == 0 ? (cr * ar - ci * ai) : -(cr * ai + ci * ar); } }
        u32x4 o; o.x = pk2(v[0], v[1]); o.y = pk2(v[2], v[3]); o.z = pk2(v[4], v[5]); o.w = pk2(v[6], v[7]);
        *(u32x4*)(WY + (size_t)nout * KCAT + kin0) = o;
    }
    for (int it = we_lo + tid; it < we_hi; it += 512) {
        const int comp = it >> 6, kin0 = (it & 63) * 8, j = kin0 >> 4, q0 = kin0 & 15, dir = comp >> 7, reim = (comp >> 6) & 1, n = comp & 63, e = dir == 0 ? 31 - j : j;
        const float ar = Apow[((dir * 33 + e) * 64 + n) * 2 + 0], ai = Apow[((dir * 33 + e) * 64 + n) * 2 + 1];
        float v[8];
#pragma unroll
        for (int i = 0; i < 8; ++i) { const float br = Bre[(dir * 64 + n) * 16 + q0 + i], bi = Bim[(dir * 64 + n) * 16 + q0 + i]; v[i] = reim == 0 ? (ar * br - ai * bi) : (ar * bi + ai * br); }
        u32x4 o; o.x = pk2(v[0], v[1]); o.y = pk2(v[2], v[3]); o.z = pk2(v[4], v[5]); o.w = pk2(v[6], v[7]);
        *(u32x4*)(WE + (size_t)comp * 512 + kin0) = o;
    }
    __syncthreads();
    RGN(13, 1);
}
__device__ __forceinline__ void cvt_fp8_layer(const Ctx& c, const Args& a, int layer, int widx, int nw) {
    for (int r0 = widx; r0 < 2 * 16384; r0 += 4 * nw) {
      f32x4 vq[4][4];
#pragma unroll
      for (int u = 0; u < 4; ++u) { const int q = r0 + u * nw < 2 * 16384 ? r0 + u * nw : r0; const int tab = q >> 14, rr = layer * 16384 + (q & 16383);
          const float* srcp = (tab ? a.in[I_EV] : a.in[I_EU]) + (size_t)rr * D + 16 * c.lane;
#pragma unroll
          for (int j = 0; j < 4; ++j) vq[u][j] = *(const f32x4*)(srcp + 4 * j); }
#pragma unroll
      for (int u = 0; u < 4; ++u) {
        const int q = r0 + u * nw; if (q >= 2 * 16384) break;
        const int tab = q >> 14, rr = layer * 16384 + (q & 16383), r = tab * 32768 + rr;
        f32x4 v[4]; float mx = 0.f;
#pragma unroll
        for (int j = 0; j < 4; ++j) { v[j] = vq[u][j]; mx = fmaxf(mx, fmaxf(fmaxf(fabsf(v[j][0]), fabsf(v[j][1])), fmaxf(fabsf(v[j][2]), fabsf(v[j][3])))); }
        mx = wave_max(mx);
        const float sc = mx > 0.f ? 448.f / mx : 1.f;
        u32x4 o;
#pragma unroll
        for (int j = 0; j < 4; ++j) { int w = 0;
            w = __builtin_amdgcn_cvt_pk_fp8_f32(fminf(fmaxf(v[j][0] * sc, -448.f), 448.f), fminf(fmaxf(v[j][1] * sc, -448.f), 448.f), w, false);
            w = __builtin_amdgcn_cvt_pk_fp8_f32(fminf(fmaxf(v[j][2] * sc, -448.f), 448.f), fminf(fmaxf(v[j][3] * sc, -448.f), 448.f), w, true);
            o[j] = (unsigned)w; }
        *(u32x4*)(a.ws + (tab ? WS_EV : WS_EU) + (size_t)rr * D + 16 * c.lane) = o;
        if (c.lane == 0) ((float*)(a.ws + WS_ESC))[r] = mx > 0.f ? mx * (1.f / 448.f) : 1.f;
      }
    }
}
__device__ __forceinline__ void p0_prologue(const Ctx& c, const Args& a) {
    unsigned char* rgn_ws = a.ws; (void)rgn_ws; RGN(4, 0);
    const bool ssm_first = (c.blk & 1) == 0;
#define P0_SSM() do { const int np = c.nblk >= 256 ? 4 : 1;     \
      for (int u = c.blk; u < 2 * NG * np; u += c.nblk) ssm_tables_unit(c, a, (u / np) / NG, (u / np) % NG, u % np, np); } while (0)
    if (ssm_first) P0_SSM();
    RGN(4, 1); RGN(5, 0);
    const int gw = c.blk * 8 + c.wave, NGW = c.nblk * 8;
    {
        constexpr int I0 = 80, I1 = 16, I2 = 64, I3 = 128, I4 = 64, I5 = 16, IL = I0 + I1 + I2 + I3 + I4 + I5;
        __syncthreads();
        for (int it = c.blk; it < 2 * IL; it += c.nblk) {
            const int L = it / IL; int r = it % IL; unsigned char* lw = a.ws + WS_LW + (size_t)L * LW_STRIDE;
            if (r < I0) { transpose_wg_item(c, a.in[I_WIN] + (size_t)L * D * DIN, D, DIN, (bf16_t*)(lw + LW_WIN), a.in[I_NMIXG] + L * D, r); continue; } r -= I0;
            if (r < I1) { transpose_wg_item(c, a.in[I_WGLU] + (size_t)L * 512 * 512, 512, 512, (bf16_t*)(lw + LW_WGLU), nullptr, r); continue; } r -= I1;
            if (r < I2) { const int k0 = 64 * (r / 4); const float* gn = k0 < 512 ? a.in[I_SSMG] + L * 512 : a.in[I_ATTG] + L * 512 - 512;
                transpose_wg_item(c, a.in[I_WOUT] + (size_t)L * D * D, D, D, (bf16_t*)(lw + LW_WOUT), gn, r); continue; } r -= I2;
            if (r < I3) { transpose_wg_item(c, a.in[I_WQ] + (size_t)L * D * 2048, D, 2048, (bf16_t*)(lw + LW_WQ), a.in[I_NFFNG] + L * D, r); continue; } r -= I3;
            if (r < I4) { transpose_wg_item(c, a.in[I_WGATE] + (size_t)L * D * D, D, D, (bf16_t*)(lw + LW_WGATE), a.in[I_NPLEG] + L * D, r); continue; } r -= I4;
            transpose_wg_item(c, a.in[I_WPROJ] + (size_t)L * 256 * D, 256, D, (bf16_t*)(lw + LW_WPROJ), nullptr, r);
        }
    }
    RGN(5, 1); RGN(6, 0);
    cvt_fp8_layer(c, a, 0, gw, NGW);
    if (c.nblk != 256) cvt_fp8_layer(c, a, 1, gw, NGW);
    RGN(6, 1); RGN(7, 0);
    cvt_range(c, a.in[I_P], (bf16_t*)(a.ws + WS_PB), (size_t)2 * M * 256);
    for (int L = 0; L < 2; ++L) {
        cvt_range(c, a.in[I_SK1] + (size_t)L * 8 * 128 * 128, (bf16_t*)(a.ws + WS_LW + (size_t)L * LW_STRIDE + LW_SK1), (size_t)8 * 128 * 128);
        cvt_range(c, a.in[I_SK2] + (size_t)L * 8 * 128 * 128, (bf16_t*)(a.ws + WS_LW + (size_t)L * LW_STRIDE + LW_SK2), (size_t)8 * 128 * 128);
    }
    RGN(7, 1); RGN(8, 0);
    {
        bf16_t* XB = (bf16_t*)(a.ws + WS_XB); float* SSQ0 = (float*)(a.ws + WS_SSQ0);
        for (int m = gw; m < M; m += NGW) {
            const f32x4* xr = (const f32x4*)(a.in[I_X] + (size_t)m * D) + c.lane; float s = 0.f;
#pragma unroll
            for (int j = 0; j < 4; ++j) { const f32x4 v = xr[64 * j]; s += v[0] * v[0] + v[1] * v[1] + v[2] * v[2] + v[3] * v[3];
                *(u32x2*)(XB + (size_t)m * D + 256 * j + 4 * c.lane) = pack4(v); }
            s = wave_sum(s);
            if (c.lane < 16) SSQ0[(size_t)m * 16 + c.lane] = c.lane == 0 ? s : 0.f;
        }
    }
    RGN(8, 1);
    if (!ssm_first) P0_SSM();
#undef P0_SSM
    if (c.blk == c.nblk - 1) {
        float* R = (float*)(a.ws + WS_ROPE);
        for (int e = c.tid; e < 3072; e += 512) {
            const bool isr = e < 2048; const int pos = isr ? (e >> 4) : ((e - 2048) >> 4), f = e & 15;
            const float inv = powf(10000.f, -(float)f / 16.f), ang = (float)pos * inv; float sn, cs; sincosf(ang, &sn, &cs);
            if (isr) { R[e] = cs; R[2048 + e] = sn; } else { R[4096 + (e - 2048)] = cs; R[5120 + (e - 2048)] = sn; }
        }
    }
}

__device__ __forceinline__ void s1_unit(const Ctx& c, const Args& a, int layer, int gb  ) {
    unsigned char* lw = a.ws + WS_LW + (size_t)layer * LW_STRIDE;
    bf16_t* UC = (bf16_t*)(a.ws + WS_UCAT); float* EB = (float*)(a.ws + WS_EBUF);
    const int g = gb >> 1;
    GemmD gd; gd.A = UC; gd.lda = KCAT; gd.Bt = (const bf16_t*)(lw + LW_WE); gd.ldb = 512; gd.K = 512; gd.kmid = -1;
    EpiS1 E; E.ebuf = EB;
    Unit u; u.pm = gb; u.pn = g;
    unsigned char* rgn_ws = a.ws; (void)rgn_ws; if (layer == 0) RGN(1, 0);
#ifdef USE_SGEMM
    sgemm_unit(gd, u, E, c.wave, c.lane);
#else
    { pg8::OneUnit S; S.u = u; run_gemm(c.lds, gd, S, E, c.tid); }
#endif
    VM_WAIT(); __syncthreads();
    if (layer == 0) { RGN(1, 1); RGN(2, 0); }
    {
        const float* AL = (const float*)(lw + LW_AL);
        f32x4* Es4 = (f32x4*)c.lds; const float* Es = (const float*)c.lds;
        float* SEG = (float*)(c.lds + LDSCTL_OFF + 1024);
        const int n = c.lane, sg = c.wave;
        for (int dir = 0; dir < 2; ++dir) {
            {
#pragma unroll 1
                for (int k0 = 0; k0 < 16; k0 += 8) { f32x4 ev[8];
#pragma unroll
                    for (int k = 0; k < 8; ++k) { const int i = c.tid + 512 * (k0 + k), ch = i >> 5, q4 = i & 31; ev[k] = *(const f32x4*)(EB + ((size_t)gb * NCH + ch) * 256 + dir * 128 + q4 * 4); }
#pragma unroll
                    for (int k = 0; k < 8; ++k) Es4[c.tid + 512 * (k0 + k)] = ev[k]; }
            }
            __syncthreads();
            const float alr = AL[((dir * NG + g) * 64 + n) * 2 + 0], ali = AL[((dir * NG + g) * 64 + n) * 2 + 1];
            float hr = 0.f, hi = 0.f, pr = 1.f, pi = 0.f;
#pragma unroll 8
            for (int s = 0; s < 32; ++s) {
                const int st = sg * 32 + s, ch = dir == 0 ? st : NCH - 1 - st;
                const float er = Es[ch * 128 + n], ei = Es[ch * 128 + 64 + n];
                const float nr = alr * hr - ali * hi + er, ni = alr * hi + ali * hr + ei; hr = nr; hi = ni;
                const float qr = pr * alr - pi * ali, qi = pr * ali + pi * alr; pr = qr; pi = qi;
            }
            SEG[(sg * 64 + n) * 2] = hr; SEG[(sg * 64 + n) * 2 + 1] = hi;
            __syncthreads();
            float sr = 0.f, si = 0.f;
            for (int j = 0; j < sg; ++j) { const float er = SEG[(j * 64 + n) * 2], ei = SEG[(j * 64 + n) * 2 + 1];
                const float nr = pr * sr - pi * si + er, ni = pr * si + pi * sr + ei; sr = nr; si = ni; }
            hr = sr; hi = si;
            bf16_t* hc = UC + (size_t)gb * NCH * KCAT + 512 + dir * 128 + n;
#pragma unroll 8
            for (int s = 0; s < 32; ++s) {
                const int st = sg * 32 + s, ch = dir == 0 ? st : NCH - 1 - st;
                hc[(size_t)ch * KCAT] = (bf16_t)f2bf(hr); hc[(size_t)ch * KCAT + 64] = (bf16_t)f2bf(hi);
                const float er = Es[ch * 128 + n], ei = Es[ch * 128 + 64 + n];
                const float nr = alr * hr - ali * hi + er, ni = alr * hi + ali * hr + ei; hr = nr; hi = ni;
            }
            __syncthreads();
        }
    }
    if (layer == 0) RGN(2, 1);
}
constexpr int QKP_N = 8;
__device__ __forceinline__ void qkprep(const Ctx& c, const Args& a, int layer, int widx, int nw, int mode = 0, int tok0 = 0) {
    bf16_t* QR = (bf16_t*)(a.ws + WS_QRAW); bf16_t* KV = (bf16_t*)(a.ws + WS_KV); const float* R = (const float*)(a.ws + WS_ROPE);
    const int half = c.lane >> 5, i = c.lane & 31, f = i & 15;
    const int d = i < 16 ? i : 32 + (i - 16);
    unsigned char* rgn_ws = a.ws; (void)rgn_ws; if (layer == 0) RGN(3, 0);
    const float gq1 = a.in[I_QNG][layer * 64 + d], gq2 = a.in[I_QNG][layer * 64 + d + 16], gk1 = a.in[I_KNG][layer * 64 + d], gk2 = a.in[I_KNG][layer * 64 + d + 16];
    const int nitems = mode == 0 ? M * 5 : mode == 1 ? M * 4 : 256;
    for (int base = widx; base < nitems; base += QKP_N * nw) {
        bf16_t* p[QKP_N]; float x1[QKP_N], x2[QKP_N], cs[QKP_N], sn[QKP_N]; int hh[QKP_N]; bool ok[QKP_N];
#pragma unroll
        for (int u = 0; u < QKP_N; ++u) {
            int it = base + u * nw; ok[u] = it < nitems; if (!ok[u]) it = base;
            const int m = mode == 0 ? it / 5 : mode == 1 ? it >> 2 : tok0 + it; hh[u] = (mode == 0 ? it % 5 : mode == 1 ? (it & 3) : 4) * 2 + half;
            p[u] = hh[u] < 8 ? QR + (size_t)m * 512 + hh[u] * 64 : KV + (size_t)m * 256 + (hh[u] - 8) * 64;
            x1[u] = bf1(p[u][d]); x2[u] = bf1(p[u][d + 16]);
            const int s = m & (SEQ - 1);
            if (i < 16) { const int pos = s >> 6; cs[u] = R[pos * 16 + f]; sn[u] = R[2048 + pos * 16 + f]; }
            else { const int pos = s & 63; cs[u] = R[4096 + pos * 16 + f]; sn[u] = R[5120 + pos * 16 + f]; }
        }
#pragma unroll
        for (int u = 0; u < QKP_N; ++u) {
            float ss = x1[u] * x1[u] + x2[u] * x2[u];
#pragma unroll
            for (int o = 1; o < 32; o <<= 1) ss += __shfl_xor(ss, o);
            const float rstd = rsqrtf(ss * (1.f / 64.f) + EPS);
            const float y1 = x1[u] * rstd * (hh[u] < 8 ? gq1 : gk1), y2 = x2[u] * rstd * (hh[u] < 8 ? gq2 : gk2);
            float o1 = y1 * cs[u] - y2 * sn[u], o2 = y2 * cs[u] + y1 * sn[u];
            if (hh[u] < 8) { o1 *= C2; o2 *= C2; }
            if (ok[u]) { p[u][d] = (bf16_t)f2bf(o1); p[u][d + 16] = (bf16_t)f2bf(o2); }
        }
    }
    if (layer == 0) RGN(3, 1);
}

#include <hip/hip_bf16.h>
#include <cmath>
namespace attn_body {
using bf16=__hip_bfloat16;
using bf16x8=__attribute__((ext_vector_type(8)))short;
using s16x4=__attribute__((ext_vector_type(4)))short;
using f32x16=__attribute__((ext_vector_type(16)))float;
using u32x4=__attribute__((ext_vector_type(4)))unsigned;
constexpr int SEQ=8192,D=64,QPITCH=512,KVPITCH=256,OPITCH=1024;
constexpr int NW=8,QBLK=32,QB=QBLK*NW,KVBLK=64,NQB=SEQ/QB;
__device__ __forceinline__ int crow(int r,int hi){return (r&3)+8*(r>>2)+4*hi;}
#define SBAR() __builtin_amdgcn_sched_barrier(0)
__device__ __forceinline__ void cmask(f32x16&p0,f32x16&p1,int jb,int qrel,int hi){
  const float NEG=-INFINITY; int kb=64*jb+4*hi;
  #pragma unroll
  for(int r=0;r<16;++r){int kv=kb+(r&3)+8*(r>>2); if(kv>qrel)p0[r]=NEG; if(kv+32>qrel)p1[r]=NEG;}
}

constexpr int NSLOT=3, SLOTB=8192;
constexpr int LDS_K=0, LDS_V=NSLOT*SLOTB, LDS_WS=2*NSLOT*SLOTB, LDS_OST=LDS_WS+NW*64*4, LDS_BYTES=LDS_OST+NW*4096;
constexpr float C2=0.125f*1.4426950408889634f;
__device__ __forceinline__ void glds16(const void*gsrc,unsigned lds_dst){unsigned keep;
  asm volatile("s_mov_b32 %0, m0\n\ts_mov_b32 m0, %2\n\ts_nop 0\n\tglobal_load_lds_dwordx4 %1, off\n\ts_mov_b32 m0, %0":"=&s"(keep):"v"(gsrc),"s"(lds_dst):"memory");}
__device__ __forceinline__ float max3f(float a,float b,float c){float r;asm("v_max3_f32 %0, %1, %2, %3":"=v"(r):"v"(a),"v"(b),"v"(c));return r;}
__device__ __forceinline__ float max2f(float a,float b){float r;asm("v_max_f32_e32 %0, %1, %2":"=v"(r):"v"(a),"v"(b));return r;}
__device__ __forceinline__ float fadd_s(float a,float b){float r;asm("v_add_f32_e32 %0, %1, %2":"=v"(r):"v"(a),"v"(b));return r;}
__device__ __forceinline__ float fsub_s(float a,float b){float r;asm("v_sub_f32_e32 %0, %1, %2":"=v"(r):"v"(a),"v"(b));return r;}
typedef float f32x2_t __attribute__((ext_vector_type(2))); typedef __bf16 bf16x2_t __attribute__((ext_vector_type(2)));
__device__ __forceinline__ unsigned cvtpk_s(float lo,float hi){f32x2_t v={lo,hi};bf16x2_t b=__builtin_convertvector(v,bf16x2_t);return __builtin_bit_cast(unsigned,b);}
#define WAIT_BAR(N) asm volatile("s_waitcnt vmcnt(" #N ") lgkmcnt(0)\n\ts_barrier":::"memory")

__device__ __forceinline__ void qkt(f32x16&p0,f32x16&p1,const char*Kslot,const bf16x8*qr,const f32x16&negm,int r32,int hi){
  const char*kb=Kslot+hi*1024+r32*16;
  #pragma unroll
  for(int d0=0;d0<4;++d0){
    const bf16x8 b0=*reinterpret_cast<const bf16x8*>(kb+d0*2048);
    const bf16x8 b1=*reinterpret_cast<const bf16x8*>(kb+d0*2048+512);
    if(d0==0){p0=__builtin_amdgcn_mfma_f32_32x32x16_bf16(b0,qr[0],negm,0,0,0);p1=__builtin_amdgcn_mfma_f32_32x32x16_bf16(b1,qr[0],negm,0,0,0);}
    else{p0=__builtin_amdgcn_mfma_f32_32x32x16_bf16(b0,qr[d0],p0,0,0,0);p1=__builtin_amdgcn_mfma_f32_32x32x16_bf16(b1,qr[d0],p1,0,0,0);}}
}
typedef __attribute__((address_space(3))) const char* lds_cptr;
typedef short v4i16_t __attribute__((ext_vector_type(4)));
__device__ __forceinline__ void kload8(bf16x8*kf,lds_cptr kp){
  kf[0]=*(const __attribute__((address_space(3))) bf16x8*)(kp);      kf[1]=*(const __attribute__((address_space(3))) bf16x8*)(kp+512);
  kf[2]=*(const __attribute__((address_space(3))) bf16x8*)(kp+2048); kf[3]=*(const __attribute__((address_space(3))) bf16x8*)(kp+2560);
  kf[4]=*(const __attribute__((address_space(3))) bf16x8*)(kp+4096); kf[5]=*(const __attribute__((address_space(3))) bf16x8*)(kp+4608);
  kf[6]=*(const __attribute__((address_space(3))) bf16x8*)(kp+6144); kf[7]=*(const __attribute__((address_space(3))) bf16x8*)(kp+6656);
}
__device__ __forceinline__ void kload2(bf16x8*kf,lds_cptr kp,int j){ kf[2*j]=*(const __attribute__((address_space(3))) bf16x8*)(kp+j*2048); kf[2*j+1]=*(const __attribute__((address_space(3))) bf16x8*)(kp+j*2048+512); }
__device__ __forceinline__ s16x4 vtr(lds_cptr p){ return __builtin_bit_cast(s16x4,__builtin_amdgcn_ds_read_tr16_b64_v4i16((__attribute__((address_space(3))) v4i16_t*)p)); }
__device__ __forceinline__ float rowmax(const f32x16&p0,const f32x16&p1){
  float a=max3f(p0[0],p0[1],p1[0]),b=max3f(p0[2],p0[3],p1[1]);a=max3f(a,p1[2],p1[3]);
  #pragma unroll
  for(int r=4;r<16;r+=4){a=max3f(a,p0[r],p0[r+1]);b=max3f(b,p0[r+2],p0[r+3]);a=max3f(a,p1[r],p1[r+1]);b=max3f(b,p1[r+2],p1[r+3]);}
  const float m=max2f(a,b);
  auto rr=__builtin_amdgcn_permlane32_swap(__float_as_uint(m),__float_as_uint(m),false,false);
  return max2f(__uint_as_float(rr[0]),__uint_as_float(rr[1]));
}
__device__ __forceinline__ void pv(f32x16*o,int vb,bf16x8 pa0,bf16x8 pa1,bf16x8 pa2,bf16x8 pa3){
  #pragma unroll
  for(int d0=0;d0<2;++d0){s16x4 lo[4],hi[4];
    #pragma unroll
    for(int ks=0;ks<4;++ks){
      asm volatile("ds_read_b64_tr_b16 %0,%1 offset:%c2":"=&v"(lo[ks]):"v"(vb),"i"(d0*4096+ks*1024):"memory");
      asm volatile("ds_read_b64_tr_b16 %0,%1 offset:%c2":"=&v"(hi[ks]):"v"(vb),"i"(d0*4096+ks*1024+512):"memory");}
    asm volatile("s_waitcnt lgkmcnt(0)":::"memory");SBAR();
    #define PK(k) (bf16x8){lo[k][0],lo[k][1],lo[k][2],lo[k][3],hi[k][0],hi[k][1],hi[k][2],hi[k][3]}
    o[d0]=__builtin_amdgcn_mfma_f32_32x32x16_bf16(pa0,PK(0),o[d0],0,0,0);
    o[d0]=__builtin_amdgcn_mfma_f32_32x32x16_bf16(pa1,PK(1),o[d0],0,0,0);
    o[d0]=__builtin_amdgcn_mfma_f32_32x32x16_bf16(pa2,PK(2),o[d0],0,0,0);
    o[d0]=__builtin_amdgcn_mfma_f32_32x32x16_bf16(pa3,PK(3),o[d0],0,0,0);
    #undef PK
  }
}

#ifndef ATTN_STORE16
#define ATTN_STORE16(p,v) (*(u32x4*)(p)=(v))
#endif
template<int THRL> __device__ __forceinline__ void attn_unit(int b,int h,int qb,const bf16*Q,const bf16*KV,bf16*O,float*SSQA,char*shm,const int tid,const float mfix){
  const int lane=tid&63,r32=lane&31,hi=lane>>5; const int wid=__builtin_amdgcn_readfirstlane(tid>>6);
  const long rowbase=(long)b*SEQ; const int q0=qb*QB;
  const bf16*Qw=Q+(rowbase+q0+wid*QBLK)*QPITCH+h*D;
  const bf16*Kh=KV+rowbase*KVPITCH+(h>>2)*D,*Vh=Kh+128;
  const unsigned lds0=(unsigned)(uintptr_t)shm;
  float*wsf=(float*)(shm+LDS_WS)+wid*64;
  const bf16*ksrc=Kh+(long)lane*KVPITCH+wid*8;
  const bf16*vsrc=Vh+(long)(16*(wid&3)+(lane>>2))*KVPITCH+(wid>>2)*32+(lane&3)*8;
  const unsigned kdst=lds0+LDS_K+wid*1024, vdst=lds0+LDS_V+wid*1024;
  #define DMA_K(t,slot) glds16(ksrc+(long)(t)*KVBLK*KVPITCH,(unsigned)__builtin_amdgcn_readfirstlane(kdst+(slot)))
  #define DMA_V(t,slot) glds16(vsrc+(long)(t)*KVBLK*KVPITCH,(unsigned)__builtin_amdgcn_readfirstlane(vdst+(slot)))
  const int vb0=(int)(lds0+LDS_V)+((lane>>4)&1)*32+(lane&3)*8+(4*hi+((lane&15)>>2))*64;
  const char*Kbase=shm+LDS_K; bf16x8 kf[8];
  const lds_cptr shm3=(lds_cptr)shm; const lds_cptr kp0=shm3+LDS_K+hi*1024+r32*16; const lds_cptr vp0=shm3+LDS_V+((lane>>4)&1)*32+(lane&3)*8+(4*hi+((lane&15)>>2))*64;
  const int NT=SEQ/KVBLK;
  DMA_K(0,0);DMA_V(0,0);DMA_K(1,SLOTB);
  bf16x8 qr[4];
  #pragma unroll
  for(int d0=0;d0<4;++d0)qr[d0]=*reinterpret_cast<const bf16x8*>(&Qw[(long)r32*QPITCH+d0*16+hi*8]);
  float mhat=0.f,l_reg=0.f;f32x16 o[2];f32x16 negm;{float z_=0.f;asm volatile("":"+v"(z_));
  #pragma unroll
  for(int r=0;r<16;++r){o[0][r]=z_;o[1][r]=z_;negm[r]=(THRL<0)?(z_-mfix):z_;}}asm volatile("":"+v"(negm)); if(THRL<0)mhat=mfix;
  #define CMASK(P0,P1,t) do{}while(0)
  bool resc=false;
  #define START(P0,P1) do{ resc=false; \
    if constexpr(THRL>=0){ const float rm=rowmax(P0,P1); const float dl=rm; mhat=fadd_s(mhat,dl); \
      _Pragma("unroll") for(int r=0;r<16;++r){P0[r]=fsub_s(P0[r],dl);P1[r]=fsub_s(P1[r],dl);} \
      _Pragma("unroll") for(int r=0;r<16;++r)negm[r]=-mhat; asm volatile("":"+v"(negm)); } \
    _Pragma("unroll") for(int r=0;r<16;++r)P0[r]=__builtin_amdgcn_exp2f(P0[r]); }while(0)
  #define RESC() do{ if(resc){ asm volatile("s_waitcnt lgkmcnt(0)":::"memory"); \
      _Pragma("unroll") for(int d_=0;d_<2;++d_) _Pragma("unroll") for(int r=0;r<16;++r)o[d_][r]*=wsf[crow(r,hi)]; } }while(0)
  f32x16 pA0,pA1,pB0,pB1;
  int sl_prev=0,sl_cur=0,sl_next=SLOTB;
  #define ROT() do{sl_prev=sl_cur;sl_cur=sl_next;sl_next=(sl_next==(NSLOT-1)*SLOTB)?0:sl_next+SLOTB;}while(0)
  DMA_K(2,2*SLOTB);
  WAIT_BAR(3);
  qkt(pA0,pA1,Kbase,qr,negm,r32,hi);asm volatile("s_nop 15\n\ts_nop 7":"+v"(pA0),"+v"(pA1));CMASK(pA0,pA1,0);
  START(pA0,pA1);
  _Pragma("unroll") for(int r=0;r<16;++r)pA1[r]=__builtin_amdgcn_exp2f(pA1[r]);
  WAIT_BAR(0);
  DMA_K(3,0);DMA_V(1,SLOTB);
  ROT();
  kload8(kf,kp0+sl_cur);
  WAIT_BAR(2);
  s16x4 vlo[8],vhi[8]; u32x4 pw0,pw1,pw2,pw3;
  #define PKW(P,B) cvtpk_s(P[B],P[B+1])
  #define PAF(k) __builtin_bit_cast(bf16x8,pw##k)
  #define VFR(i) (bf16x8){vlo[i][0],vlo[i][1],vlo[i][2],vlo[i][3],vhi[i][0],vhi[i][1],vhi[i][2],vhi[i][3]}
  #define PIN(x) asm volatile("":"+v"(x))
  #define MX3(a,b,c) __builtin_fmaxf(__builtin_fmaxf((a),(b)),(c))
  #define GAPA(MF,A0,A1,A2,A3,W0,W1,PW) do{ MF; sacc+=A0; sacc+=A1; sacc+=A2; sacc+=A3; PIN(sacc); W0; W1; PIN(PW); SBAR(); }while(0)
  #define EX(v) __builtin_amdgcn_exp2f(v)
  #define GAPB(MF,X,B) do{ MF; X[B]=EX(X[B]); X[B+1]=EX(X[B+1]); X[B+2]=EX(X[B+2]); X[B+3]=EX(X[B+3]); PIN(X); SBAR(); }while(0)
  #define VRD(i) do{ vlo[i]=vtr(vp_+(((i)>>2)*4096+((i)&3)*1024)); vhi[i]=vtr(vp_+(((i)>>2)*4096+((i)&3)*1024+512)); }while(0)
  #define KRD(G,j) do{ if(G){ kload2(kf,kp0+sl_next,j); SBAR(); } }while(0)
  #define STEP(C0,C1,P0,P1,t,GK,GV,GL) do{ SBAR(); \
    const lds_cptr vp_=vp0+sl_prev; \
    VRD(0); SBAR(); float sacc=(P0[0]+P0[1]); \
    GAPA(C0=__builtin_amdgcn_mfma_f32_32x32x16_bf16(kf[0],qr[0],negm,0,0,0), P0[2],P0[3],P0[4],P0[5],     pw0[0]=PKW(P0,0), pw0[1]=PKW(P0,2), pw0); \
    VRD(4); SBAR(); GAPA(C1=__builtin_amdgcn_mfma_f32_32x32x16_bf16(kf[1],qr[0],negm,0,0,0), P0[6],P0[7],P0[8],P0[9],     pw0[2]=PKW(P0,4), pw0[3]=PKW(P0,6), pw0); \
    VRD(1); SBAR(); GAPA(C0=__builtin_amdgcn_mfma_f32_32x32x16_bf16(kf[2],qr[1],C0,0,0,0),   P0[10],P0[11],P0[12],P0[13], pw1[0]=PKW(P0,8), pw1[1]=PKW(P0,10), pw1); \
    VRD(5); SBAR(); GAPA(C1=__builtin_amdgcn_mfma_f32_32x32x16_bf16(kf[3],qr[1],C1,0,0,0),   P0[14],P0[15],P1[0],P1[1],   pw1[2]=PKW(P0,12),pw1[3]=PKW(P0,14), pw1); \
    VRD(2); SBAR(); GAPA(C0=__builtin_amdgcn_mfma_f32_32x32x16_bf16(kf[4],qr[2],C0,0,0,0),   P1[2],P1[3],P1[4],P1[5],     pw2[0]=PKW(P1,0), pw2[1]=PKW(P1,2), pw2); \
    VRD(6); SBAR(); GAPA(C1=__builtin_amdgcn_mfma_f32_32x32x16_bf16(kf[5],qr[2],C1,0,0,0),   P1[6],P1[7],P1[8],P1[9],     pw2[2]=PKW(P1,4), pw2[3]=PKW(P1,6), pw2); \
    VRD(3); SBAR(); GAPA(C0=__builtin_amdgcn_mfma_f32_32x32x16_bf16(kf[6],qr[3],C0,0,0,0),   P1[10],P1[11],P1[12],P1[13], pw3[0]=PKW(P1,8), pw3[1]=PKW(P1,10), pw3); \
    VRD(7); SBAR(); GAPA(C1=__builtin_amdgcn_mfma_f32_32x32x16_bf16(kf[7],qr[3],C1,0,0,0),   P1[14],P1[15],0.f,0.f,       pw3[2]=PKW(P1,12),pw3[3]=PKW(P1,14), pw3); \
    l_reg+=sacc; \
    if(GK){DMA_K((t)+3,sl_cur);} if(GV){DMA_V((t)+1,sl_next);} \
    CMASK(C0,C1,t); \
    if constexpr(THRL>=0){ float a=MX3(C0[0],C0[1],C1[0]),b=MX3(C0[2],C0[3],C1[1]); a=MX3(a,C1[2],C1[3]); \
      _Pragma("unroll") for(int r=4;r<16;r+=4){a=MX3(a,C0[r],C0[r+1]);b=MX3(b,C0[r+2],C0[r+3]);a=MX3(a,C1[r],C1[r+1]);b=MX3(b,C1[r+2],C1[r+3]);} \
      float rm=__builtin_fmaxf(a,b); { auto rr=__builtin_amdgcn_permlane32_swap(__float_as_uint(rm),__float_as_uint(rm),false,false); rm=__builtin_fmaxf(__uint_as_float(rr[0]),__uint_as_float(rr[1])); } \
      resc=false; \
      if(__builtin_expect(__any(rm>(float)THRL),0)){ const float dl=__builtin_fmaxf(rm,0.f); mhat+=dl; \
        _Pragma("unroll") for(int r=0;r<16;++r){C0[r]-=dl;C1[r]-=dl;} \
        _Pragma("unroll") for(int r=0;r<16;++r)negm[r]=-mhat; asm volatile("":"+v"(negm)); \
        const float f=__builtin_amdgcn_exp2f(-dl); l_reg*=f; if(hi==0)wsf[r32]=f; resc=true; } } \
    SBAR(); \
    GAPB(o[0]=__builtin_amdgcn_mfma_f32_32x32x16_bf16(PAF(0),VFR(0),o[0],0,0,0), C0,0); \
    GAPB(o[1]=__builtin_amdgcn_mfma_f32_32x32x16_bf16(PAF(0),VFR(4),o[1],0,0,0), C0,4); \
    KRD(GL,0); GAPB(o[0]=__builtin_amdgcn_mfma_f32_32x32x16_bf16(PAF(1),VFR(1),o[0],0,0,0), C0,8); \
    KRD(GL,1); GAPB(o[1]=__builtin_amdgcn_mfma_f32_32x32x16_bf16(PAF(1),VFR(5),o[1],0,0,0), C0,12); \
    KRD(GL,2); GAPB(o[0]=__builtin_amdgcn_mfma_f32_32x32x16_bf16(PAF(2),VFR(2),o[0],0,0,0), C1,0); \
    KRD(GL,3); GAPB(o[1]=__builtin_amdgcn_mfma_f32_32x32x16_bf16(PAF(2),VFR(6),o[1],0,0,0), C1,4); \
    GAPB(o[0]=__builtin_amdgcn_mfma_f32_32x32x16_bf16(PAF(3),VFR(3),o[0],0,0,0), C1,8); \
    GAPB(o[1]=__builtin_amdgcn_mfma_f32_32x32x16_bf16(PAF(3),VFR(7),o[1],0,0,0), C1,12); \
    }while(0)
  int t=1;
  #undef CMASK
  #define CMASK(P0,P1,t) do{}while(0)
  for(;t+5<NT;t+=2){
    STEP(pB0,pB1,pA0,pA1,t,true,true,true);     WAIT_BAR(2); RESC(); ROT();
    STEP(pA0,pA1,pB0,pB1,t+1,true,true,true);   WAIT_BAR(2); RESC(); ROT();
  }
  #undef CMASK
  #define CMASK(P0,P1,t) do{}while(0)
  #define ENDW(tt) do{ if((tt)+3<NT){WAIT_BAR(2);} else if((tt)+2<NT){WAIT_BAR(1);} else {WAIT_BAR(0);} }while(0)
  for(;t+1<NT;t+=2){
    STEP(pB0,pB1,pA0,pA1,t,(t+3<NT),(t+1<NT),(t+1<NT));       ENDW(t);   RESC(); ROT();
    STEP(pA0,pA1,pB0,pB1,t+1,(t+4<NT),(t+2<NT),(t+2<NT));     ENDW(t+1); RESC(); ROT();
  }
  STEP(pB0,pB1,pA0,pA1,NT-1,false,false,false); RESC();
  { float sacc=pB0[0]+pB0[1]; _Pragma("unroll") for(int r=2;r<16;++r)sacc+=pB0[r]; _Pragma("unroll") for(int r=0;r<16;++r)sacc+=pB1[r]; l_reg+=sacc;
    pw0=(u32x4){PKW(pB0,0),PKW(pB0,2),PKW(pB0,4),PKW(pB0,6)};pw1=(u32x4){PKW(pB0,8),PKW(pB0,10),PKW(pB0,12),PKW(pB0,14)};pw2=(u32x4){PKW(pB1,0),PKW(pB1,2),PKW(pB1,4),PKW(pB1,6)};pw3=(u32x4){PKW(pB1,8),PKW(pB1,10),PKW(pB1,12),PKW(pB1,14)};
    SBAR(); pv(o,vb0+sl_cur,PAF(0),PAF(1),PAF(2),PAF(3)); }
  #undef PKW
  #undef PAF
  #undef VFR
  #undef PIN
  #undef MX3
  #undef GAPA
  #undef GAPB
  #undef EX
  #undef VRD
  #undef KRD
  #undef STEP
  #undef ENDW
  {auto rr=__builtin_amdgcn_permlane32_swap(__float_as_uint(l_reg),__float_as_uint(l_reg),false,false);l_reg=__uint_as_float(rr[0])+__uint_as_float(rr[1]);}
  if(hi==0)wsf[32+r32]=l_reg;asm volatile("s_waitcnt lgkmcnt(0)":::"memory");
  float rli[16];
  #pragma unroll
  for(int r=0;r<16;++r)rli[r]=__builtin_amdgcn_rcpf(wsf[32+crow(r,hi)]);
  bf16*Ow=O+(rowbase+q0+wid*QBLK)*OPITCH+512+h*D; float*Sw=SSQA+(rowbase+q0+wid*QBLK)*16+h;
  { bf16*stg=(bf16*)(shm+LDS_OST)+wid*2048;
    #pragma unroll
    for(int r=0;r<16;++r){const int orow=crow(r,hi);
      #pragma unroll
      for(int d0=0;d0<2;++d0)stg[orow*64+d0*32+r32]=__float2bfloat16(o[d0][r]*rli[r]);}
    asm volatile("s_waitcnt lgkmcnt(0)":::"memory");
    #pragma unroll
    for(int i=0;i<4;++i){const int row=i*8+(lane>>3),ch=lane&7; const u32x4 v=*(const u32x4*)(stg+row*64+ch*8); ATTN_STORE16(Ow+(long)row*OPITCH+ch*8,v);
      float ss=0.f; for(int e=0;e<4;++e){const float lo_=__uint_as_float(v[e]<<16),hi_=__uint_as_float(v[e]&0xffff0000u); ss+=lo_*lo_+hi_*hi_;}
      ss+=__shfl_xor(ss,1); ss+=__shfl_xor(ss,2); ss+=__shfl_xor(ss,4); if(ch==0)Sw[(long)row*16]=ss; } }
  asm volatile("s_waitcnt lgkmcnt(0)\n\ts_barrier":::"memory");
  #undef DMA_K
  #undef DMA_V
  #undef CMASK
  #undef START
  #undef RESC
  #undef ROT
}
constexpr int ATTN_LDS_BYTES=LDS_BYTES;
#undef SBAR
#undef WAIT_BAR
}

#ifdef ATT_NAIVE
__device__ __forceinline__ void attn_naive_unit(const Ctx& c, const Args& a, int b, int h, int qblk) {
    const bf16_t* QR = (const bf16_t*)(a.ws + WS_QRAW); const bf16_t* KV = (const bf16_t*)(a.ws + WS_KV);
    bf16_t* Y = (bf16_t*)(a.ws + WS_Y); float* SSQA = (float*)(a.ws + WS_SSQA);
    float* Ks = (float*)c.lds; float* Vs = Ks + 64 * 64;
    const long row = (long)b * SEQ + qblk * 512 + c.tid; const int kvh = h >> 2;
    float q[64], o[64];
#pragma unroll
    for (int v = 0; v < 8; ++v) { const u32x4 w = *(const u32x4*)(QR + row * 512 + h * 64 + v * 8);
        q[v * 8 + 0] = bflo(w.x); q[v * 8 + 1] = bfhi(w.x); q[v * 8 + 2] = bflo(w.y); q[v * 8 + 3] = bfhi(w.y);
        q[v * 8 + 4] = bflo(w.z); q[v * 8 + 5] = bfhi(w.z); q[v * 8 + 6] = bflo(w.w); q[v * 8 + 7] = bfhi(w.w); }
#pragma unroll
    for (int dd = 0; dd < 64; ++dd) o[dd] = 0.f;
    float mrun = -1e30f, l = 0.f;
    const int lk = c.tid >> 3, lp = c.tid & 7;
    for (int t0 = 0; t0 < SEQ; t0 += 64) {
        __syncthreads();
        { const bf16_t* kp = KV + ((long)b * SEQ + t0 + lk) * 256 + kvh * 64 + lp * 8;
          const u32x4 kw = *(const u32x4*)kp, vw = *(const u32x4*)(kp + 128);
          float* kd = Ks + lk * 64 + lp * 8; float* vd = Vs + lk * 64 + lp * 8;
          kd[0] = bflo(kw.x); kd[1] = bfhi(kw.x); kd[2] = bflo(kw.y); kd[3] = bfhi(kw.y); kd[4] = bflo(kw.z); kd[5] = bfhi(kw.z); kd[6] = bflo(kw.w); kd[7] = bfhi(kw.w);
          vd[0] = bflo(vw.x); vd[1] = bfhi(vw.x); vd[2] = bflo(vw.y); vd[3] = bfhi(vw.y); vd[4] = bflo(vw.z); vd[5] = bfhi(vw.z); vd[6] = bflo(vw.w); vd[7] = bfhi(vw.w); }
        __syncthreads();
#pragma unroll 1
        for (int j = 0; j < 64; ++j) {
            float acc = 0.f; const float* kr = Ks + j * 64;
#pragma unroll
            for (int dd = 0; dd < 64; dd += 4) { const f32x4 kk = *(const f32x4*)(kr + dd); acc += q[dd] * kk[0] + q[dd + 1] * kk[1] + q[dd + 2] * kk[2] + q[dd + 3] * kk[3];
                if ((dd & 15) == 12) __builtin_amdgcn_sched_barrier(0); }
            if (acc > mrun) { const float sc = exp2f(mrun - acc); l *= sc; mrun = acc;
#pragma unroll
                for (int dd = 0; dd < 64; ++dd) o[dd] *= sc; }
            const float p = exp2f(acc - mrun); l += p; const float* vr = Vs + j * 64;
#pragma unroll
            for (int dd = 0; dd < 64; dd += 4) { const f32x4 vv = *(const f32x4*)(vr + dd); o[dd] += p * vv[0]; o[dd + 1] += p * vv[1]; o[dd + 2] += p * vv[2]; o[dd + 3] += p * vv[3];
                if ((dd & 15) == 12) __builtin_amdgcn_sched_barrier(0); }
        }
    }
    const float il = 1.f / l; float ss = 0.f;
#pragma unroll
    for (int v = 0; v < 8; ++v) { float t[8];
#pragma unroll
        for (int e = 0; e < 8; ++e) { t[e] = o[v * 8 + e] * il; ss += t[e] * t[e]; }
        u32x4 w; w.x = pk2(t[0], t[1]); w.y = pk2(t[2], t[3]); w.z = pk2(t[4], t[5]); w.w = pk2(t[6], t[7]);
        *(u32x4*)(Y + row * 1024 + 512 + h * 64 + v * 8) = w; }
    SSQA[row * 16 + h] = ss;
    __syncthreads();
}

#endif
template <int NV> __device__ __forceinline__ float top16(float (&v)[NV], int lane) {
    float res = -INFINITY;
    for (int it = 0; it < 16; ++it) {
        float m = v[0];
#pragma unroll
        for (int i = 1; i < NV; ++i) m = fmaxf(m, v[i]);
        m = wave_max(m);
#pragma unroll
        for (int i = 0; i < NV; ++i) if (v[i] == m) v[i] = -INFINITY;
        if (lane == it) res = m;
    }
    return res;
}
__device__ __forceinline__ float dot8(const u32x4 a, const u32x4 b) {
    return bflo(a.x) * bflo(b.x) + bfhi(a.x) * bfhi(b.x) + bflo(a.y) * bflo(b.y) + bfhi(a.y) * bfhi(b.y)
         + bflo(a.z) * bflo(b.z) + bfhi(a.z) * bfhi(b.z) + bflo(a.w) * bflo(b.w) + bfhi(a.w) * bfhi(b.w);
}
__device__ __forceinline__ void peer_topk(const Ctx& c, const Args& a, int layer, int widx, int nw) {
    const bf16_t* QP = (const bf16_t*)(a.ws + WS_QP);
    const bf16_t* SK1 = (const bf16_t*)(a.ws + WS_LW + (size_t)layer * LW_STRIDE + LW_SK1);
    const bf16_t* SK2 = (const bf16_t*)(a.ws + WS_LW + (size_t)layer * LW_STRIDE + LW_SK2);
    int* SELI = (int*)(a.ws + WS_SELI); float* SELW = (float*)(a.ws + WS_SELW);
    const int lane = c.lane;
    for (int it = widx; it < M * 8; it += nw) {
        const int t = it >> 3, h = it & 7;
        const bf16_t* qrow = QP + (size_t)t * 2048 + h * 256;
        const bf16_t* k1a = SK1 + ((size_t)(h * 128 + lane)) * 128; const bf16_t* k1b = k1a + 64 * 128;
        const bf16_t* k2a = SK2 + ((size_t)(h * 128 + lane)) * 128; const bf16_t* k2b = k2a + 64 * 128;
        float s1[2] = {0.f, 0.f}, s2[2] = {0.f, 0.f};
#pragma unroll 4
        for (int kk = 0; kk < 128; kk += 8) {
            const u32x4 q1 = *(const u32x4*)(qrow + kk), q2 = *(const u32x4*)(qrow + 128 + kk);
            s1[0] += dot8(q1, *(const u32x4*)(k1a + kk)); s1[1] += dot8(q1, *(const u32x4*)(k1b + kk));
            s2[0] += dot8(q2, *(const u32x4*)(k2a + kk)); s2[1] += dot8(q2, *(const u32x4*)(k2b + kk));
        }
        s1[0] = __uint_as_float((__float_as_uint(s1[0]) & ~127u) | (unsigned)lane); s1[1] = __uint_as_float((__float_as_uint(s1[1]) & ~127u) | (unsigned)(lane + 64));
        s2[0] = __uint_as_float((__float_as_uint(s2[0]) & ~127u) | (unsigned)lane); s2[1] = __uint_as_float((__float_as_uint(s2[1]) & ~127u) | (unsigned)(lane + 64));
        const float v1 = top16<2>(s1, lane), v2 = top16<2>(s2, lane);
        float cand[4];
#pragma unroll
        for (int mm = 0; mm < 4; ++mm) {
            const float va = __shfl(v1, (lane >> 4) + 4 * mm), vb = __shfl(v2, lane & 15);
            const unsigned ua = __float_as_uint(va), ub = __float_as_uint(vb);
            const float sum = __uint_as_float(ua & ~127u) + __uint_as_float(ub & ~127u);
            cand[mm] = __uint_as_float((__float_as_uint(sum) & ~16383u) | ((ua & 127u) << 7) | (ub & 127u));
        }
        const float best = top16<4>(cand, lane);
        const unsigned ub = __float_as_uint(best);
        const float sc = __uint_as_float(ub & ~16383u);
        const float mx = __shfl(sc, 0);
        const float e = lane < 16 ? __expf(sc - mx) : 0.f;
        const float sum = wave_sum(e);
        if (lane < 16) { SELI[(size_t)t * 128 + h * 16 + lane] = (int)(ub & 16383u); SELW[(size_t)t * 128 + h * 16 + lane] = e / sum; }
    }
}

typedef float f32x16 __attribute__((ext_vector_type(16)));
#define CE_DESC(x, y) do { const float hi__ = fmaxf(x, y), lo__ = fminf(x, y); x = hi__; y = lo__; } while (0)
__device__ __forceinline__ void sort16_desc(float (&v)[16]) {
#pragma unroll
    for (int k = 2; k <= 16; k <<= 1)
#pragma unroll
        for (int j = k >> 1; j > 0; j >>= 1)
#pragma unroll
            for (int i = 0; i < 16; ++i) { const int l = i ^ j; if (l > i) { if ((i & k) == 0) CE_DESC(v[i], v[l]); else CE_DESC(v[l], v[i]); } }
}
__device__ __forceinline__ void merge16_desc(float (&a)[16], const float (&b)[16]) {
#pragma unroll
    for (int i = 0; i < 16; ++i) a[i] = fmaxf(a[i], b[15 - i]);
#pragma unroll
    for (int j = 8; j > 0; j >>= 1)
#pragma unroll
        for (int i = 0; i < 16; ++i) { const int l = i ^ j; if (l > i) CE_DESC(a[i], a[l]); }
}
__device__ __forceinline__ void merge16_partner(float (&a)[16]) {
    float b[16];
#pragma unroll
    for (int i = 0; i < 16; ++i) b[i] = __shfl_xor(a[i], 32);
    merge16_desc(a, b);
}
__device__ __forceinline__ void peer_topk_fast(const Ctx& c, const Args& a, int layer, int widx, int nw, int only_unit = -1) {
    const bf16_t* QP = (const bf16_t*)(a.ws + WS_QP);
    const bf16_t* SK1 = (const bf16_t*)(a.ws + WS_LW + (size_t)layer * LW_STRIDE + LW_SK1);
    const bf16_t* SK2 = (const bf16_t*)(a.ws + WS_LW + (size_t)layer * LW_STRIDE + LW_SK2);
    int* SELI = (int*)(a.ws + WS_SELI); float* SELW = (float*)(a.ws + WS_SELW);
    const int lane = c.lane, tl = lane & 31, hi = lane >> 5;
    for (int unit = only_unit >= 0 ? only_unit : widx; unit < (M / 32) * 8; unit += nw) {
        const int tg = unit >> 3, h = unit & 7; const long token = (long)tg * 32 + tl;
        float vv[2][16];
#pragma unroll
        for (int half = 0; half < 2; ++half) {
            f32x16 acc[4];
#pragma unroll
            for (int t = 0; t < 4; ++t)
#pragma unroll
                for (int r = 0; r < 16; ++r) acc[t][r] = 0.f;
            const bf16_t* qb = QP + token * 2048 + h * 256 + half * 128 + 8 * hi;
            const bf16_t* kb = (half ? SK2 : SK1) + ((long)(h * 128 + tl)) * 128 + 8 * hi;
#pragma unroll 1
            for (int k4 = 0; k4 < 8; k4 += 4) {
                bf16x8 bq[4], ak[4][4];
#pragma unroll
                for (int u = 0; u < 4; ++u) { bq[u] = *(const bf16x8*)(qb + 16 * (k4 + u));
#pragma unroll
                    for (int t = 0; t < 4; ++t) ak[u][t] = *(const bf16x8*)(kb + (long)t * 32 * 128 + 16 * (k4 + u)); }
#pragma unroll
                for (int u = 0; u < 4; ++u)
#pragma unroll
                    for (int t = 0; t < 4; ++t) acc[t] = __builtin_amdgcn_mfma_f32_32x32x16_bf16(ak[u][t], bq[u], acc[t], 0, 0, 0);
            }
            float L[4][16];
#pragma unroll
            for (int t = 0; t < 4; ++t) {
#pragma unroll
                for (int r = 0; r < 16; ++r) L[t][r] = __uint_as_float((__float_as_uint(acc[t][r]) & ~127u) | (unsigned)(32 * t + (r & 3) + 8 * (r >> 2) + 4 * hi));
                sort16_desc(L[t]);
            }
            merge16_desc(L[0], L[1]); merge16_desc(L[2], L[3]); merge16_desc(L[0], L[2]);
            merge16_partner(L[0]);
#pragma unroll
            for (int i = 0; i < 16; ++i) vv[half][i] = L[0][i];
        }
        float f1[16], f2[16]; unsigned i1[16], i2[16];
#pragma unroll
        for (int i = 0; i < 16; ++i) { const unsigned u1 = __float_as_uint(vv[0][i]), u2 = __float_as_uint(vv[1][i]);
            f1[i] = __uint_as_float(u1 & ~127u); f2[i] = __uint_as_float(u2 & ~127u); i1[i] = (u1 & 127u) << 7; i2[i] = u2 & 127u; }
        float cA[16], cB[16];
#pragma unroll
        for (int i = 0; i < 16; ++i) { cA[i] = -INFINITY; cB[i] = -INFINITY; }
        {
            int n = 0;
#pragma unroll
            for (int aa = 0; aa < 16; ++aa)
#pragma unroll
                for (int bb = 0; bb < 16; ++bb) if ((aa + 1) * (bb + 1) <= 16) {
                    const float s = f1[aa] + f2[bb]; const float pk = __uint_as_float((__float_as_uint(s) & ~16383u) | i1[aa] | i2[bb]);
                    const int slot = n >> 1; const bool mine = ((n & 1) == hi);
                    if (slot < 16) cA[slot] = mine ? pk : cA[slot]; else cB[slot - 16] = mine ? pk : cB[slot - 16];
                    ++n;
                }
        }
        sort16_desc(cA); sort16_desc(cB); merge16_desc(cA, cB); merge16_partner(cA);
        float sc[16], e[16]; float sum = 0.f;
#pragma unroll
        for (int i = 0; i < 16; ++i) { sc[i] = __uint_as_float(__float_as_uint(cA[i]) & ~16383u); e[i] = __expf(sc[i] - sc[0]); sum += e[i]; }
        const float inv = 1.f / sum;
        u32x4 oi[2]; f32x4 ow[2];
#pragma unroll
        for (int i = 0; i < 8; ++i) { const float pk = hi ? cA[8 + i] : cA[i]; const float w = (hi ? e[8 + i] : e[i]) * inv;
            oi[i >> 2][i & 3] = __float_as_uint(pk) & 16383u; ow[i >> 2][i & 3] = w; }
        int* si = SELI + token * 128 + h * 16 + 8 * hi; float* sw = SELW + token * 128 + h * 16 + 8 * hi;
        *(u32x4*)si = oi[0]; *(u32x4*)(si + 4) = oi[1]; *(f32x4*)sw = ow[0]; *(f32x4*)(sw + 4) = ow[1];
        if (only_unit >= 0) break;
    }
}

__device__ __forceinline__ void dec16(const u32x4 w, float (&f)[16]) {
#pragma unroll
    for (int j = 0; j < 4; ++j) { const auto lo = __builtin_amdgcn_cvt_pk_f32_fp8((int)w[j], false); const auto hi = __builtin_amdgcn_cvt_pk_f32_fp8((int)w[j], true);
        f[4 * j + 0] = lo[0]; f[4 * j + 1] = lo[1]; f[4 * j + 2] = hi[0]; f[4 * j + 3] = hi[1]; }
}
__device__ __forceinline__ void peer_gather(const Ctx& c, const Args& a, int layer, int widx, int nw) {
    float* XR = a.out; bf16_t* XN2 = (bf16_t*)(a.ws + WS_XN2);
    const unsigned char* EU = a.ws + WS_EU + (size_t)layer * 16384 * 1024;
    const unsigned char* EV = a.ws + WS_EV + (size_t)layer * 16384 * 1024;
    const float* SCU = (const float*)(a.ws + WS_ESC) + layer * 16384; const float* SCV = SCU + 32768;
    const int* SELI = (const int*)(a.ws + WS_SELI); const float* SELW = (const float*)(a.ws + WS_SELW);
    const float* gf = a.in[I_NFFNG] + layer * D; const float* gp = a.in[I_NPLEG] + layer * D;
    const int lane = c.lane;
    for (int t = widx; t < M; t += nw) {
        float x[16], hh[16], acc[16];
        float* xr = XR + (size_t)t * D + 16 * lane;
        float ss = 0.f;
#pragma unroll
        for (int j = 0; j < 4; ++j) { const f32x4 u0 = *(const f32x4*)(xr + 4 * j);
#pragma unroll
            for (int e = 0; e < 4; ++e) x[4 * j + e] = u0[e]; }
#pragma unroll
        for (int e = 0; e < 16; ++e) { ss += x[e] * x[e]; acc[e] = 0.f; }
        ss = wave_sum(ss);
        const float rstd = rsqrtf(ss * (1.f / D) + EPS);
#pragma unroll
        for (int j = 0; j < 4; ++j) { const f32x4 g4 = *(const f32x4*)(gf + 16 * lane + 4 * j);
#pragma unroll
            for (int e = 0; e < 4; ++e) hh[4 * j + e] = x[4 * j + e] * rstd * g4[e]; }
        const int idxA = SELI[(size_t)t * 128 + lane], idxB = SELI[(size_t)t * 128 + 64 + lane];
        const float wA = SELW[(size_t)t * 128 + lane], wB = SELW[(size_t)t * 128 + 64 + lane];
        const float suA = SCU[idxA], suB = SCU[idxB], svA = SCV[idxA], svB = SCV[idxB];
#pragma unroll 1
        for (int hf = 0; hf < 2; ++hf) {
            const int idxv = hf ? idxB : idxA; const float wv = hf ? wB : wA, suv = hf ? suB : suA, svv = hf ? svB : svA;
#pragma unroll 1
            for (int k0 = 0; k0 < 64; k0 += 8) {
                u32x4 ur[8], vr[8]; float w[8], su[8], sv[8];
#pragma unroll
                for (int r = 0; r < 8; ++r) {
                    const int e = __builtin_amdgcn_readlane(idxv, k0 + r);
                    w[r] = __uint_as_float(__builtin_amdgcn_readlane(__float_as_uint(wv), k0 + r));
                    su[r] = __uint_as_float(__builtin_amdgcn_readlane(__float_as_uint(suv), k0 + r));
                    sv[r] = __uint_as_float(__builtin_amdgcn_readlane(__float_as_uint(svv), k0 + r));
                    ur[r] = *(const u32x4*)(EU + (size_t)e * D + 16 * lane); vr[r] = *(const u32x4*)(EV + (size_t)e * D + 16 * lane);
                }
#pragma unroll
                for (int r = 0; r < 8; ++r) {
                    float f[16]; dec16(ur[r], f);
                    float d = 0.f;
#pragma unroll
                    for (int e = 0; e < 16; ++e) d += hh[e] * f[e];
                    d = wave_sum(d) * su[r];
                    const float av = gelu_tanh(d) * w[r] * sv[r];
                    dec16(vr[r], f);
#pragma unroll
                    for (int e = 0; e < 16; ++e) acc[e] += av * f[e];
                }
            }
        }
        float s2 = 0.f;
#pragma unroll
        for (int e = 0; e < 16; ++e) { x[e] += acc[e]; s2 += x[e] * x[e]; }
        s2 = wave_sum(s2);
        const float rstd2 = rsqrtf(s2 * (1.f / D) + EPS);
#pragma unroll
        for (int j = 0; j < 4; ++j) *(f32x4*)(xr + 4 * j) = (f32x4){x[4 * j + 0], x[4 * j + 1], x[4 * j + 2], x[4 * j + 3]};
        float y[16];
#pragma unroll
        for (int j = 0; j < 4; ++j) { const f32x4 g4 = *(const f32x4*)(gp + 16 * lane + 4 * j);
#pragma unroll
            for (int e = 0; e < 4; ++e) y[4 * j + e] = x[4 * j + e] * rstd2 * g4[e]; }
        u32x4 o0, o1; o0.x = pk2(y[0], y[1]); o0.y = pk2(y[2], y[3]); o0.z = pk2(y[4], y[5]); o0.w = pk2(y[6], y[7]);
        o1.x = pk2(y[8], y[9]); o1.y = pk2(y[10], y[11]); o1.z = pk2(y[12], y[13]); o1.w = pk2(y[14], y[15]);
        *(u32x4*)(XN2 + (size_t)t * D + 16 * lane) = o0; *(u32x4*)(XN2 + (size_t)t * D + 16 * lane + 8) = o1;
    }
}

#define DPP_ADD(v, ctrl, rmask) v += __uint_as_float(__builtin_amdgcn_update_dpp(0u, __float_as_uint(v), ctrl, rmask, 0xf, true))
__device__ __forceinline__ float wave_sum_dpp(float v) {
    DPP_ADD(v, 0x111, 0xf); DPP_ADD(v, 0x112, 0xf); DPP_ADD(v, 0x114, 0xf); DPP_ADD(v, 0x118, 0xf); DPP_ADD(v, 0x142, 0xa); DPP_ADD(v, 0x143, 0xc);
    return __uint_as_float(__builtin_amdgcn_readlane(__float_as_uint(v), 63));
}
struct GrpSplit { int grp, G, gwave, nwave; };
__device__ __forceinline__ GrpSplit grp_split(const Ctx& c) { GrpSplit s; s.G = c.nblk < 8 ? c.nblk : 8; s.grp = c.blk % s.G; const int rank = c.blk / s.G, cnt = (c.nblk - s.grp + s.G - 1) / s.G;
    s.gwave = rank * 8 + c.wave; s.nwave = cnt * 8; return s; }
#define DPP_ADDC(v, ctrl) v += __uint_as_float(__builtin_amdgcn_update_dpp(0u, __float_as_uint(v), ctrl, 0xf, 0xf, true))
template <bool VSTEP, int MODE = 0>
__device__ __forceinline__ void peer_step(const Ctx& c, const Args& a, int layer, bf16_t* XB) {
    float* SSQ2 = (float*)(a.ws + WS_SSQS); const float* SSQ1 = (const float*)(a.ws + WS_SSQ1);
    const unsigned char* ET = a.ws + (VSTEP ? WS_EV : WS_EU) + (size_t)layer * 16384 * 1024;
    const int* SELI = (const int*)(a.ws + WS_SELI); const float* AOUT = (const float*)(a.ws + WS_AOUT); float* DP = (float*)(a.ws + WS_QP);
    const float* gf = a.in[I_NFFNG] + layer * D;
    const int lane = c.lane, sub = lane >> 3, ch = lane & 7; const GrpSplit gs = grp_split(c);
#define PS_LOADIX(ix_, tt) do { const u32x4* ip_ = (const u32x4*)(SELI + (size_t)(tt) * 128 + 16 * sub); ix_[0] = ip_[0]; ix_[1] = ip_[1]; ix_[2] = ip_[2]; ix_[3] = ip_[3]; } while (0)
#define PS_LOADOPS(raw_, q_, tt) do { \
        if (VSTEP) { const u32x4* ap_ = (const u32x4*)(AOUT + (size_t)(tt) * 128 + 16 * sub); raw_[0] = ap_[0]; raw_[1] = ap_[1]; raw_[2] = ap_[2]; raw_[3] = ap_[3]; } \
        else { raw_[0] = *(const u32x4*)(XB + (size_t)(tt) * D + 128 * p + 16 * ch); raw_[1] = *(const u32x4*)(XB + (size_t)(tt) * D + 128 * p + 16 * ch + 8); \
               const f32x4* sq_ = (const f32x4*)(SSQ1 + (size_t)(tt) * 16); q_[0] = sq_[0]; q_[1] = sq_[1]; q_[2] = sq_[2]; q_[3] = sq_[3]; } } while (0)
#define PS_SEG(ix_, j_) (*(const u32x4*)(ETp + (unsigned)((ix_)[(j_) >> 2][(j_) & 3] * 1024u + lane_off)))
    for (int p = gs.grp; p < 8; p += gs.G) {
        float g16[16];
        if (!VSTEP) {
#pragma unroll
            for (int j = 0; j < 4; ++j) { const f32x4 g4 = *(const f32x4*)(gf + 128 * p + 16 * ch + 4 * j); g16[4 * j] = g4[0]; g16[4 * j + 1] = g4[1]; g16[4 * j + 2] = g4[2]; g16[4 * j + 3] = g4[3]; }
        }
        int t = gs.gwave;
        if (t >= M) continue;
        const unsigned char* ETp = ET + 128 * p; const unsigned lane_off = 16u * (unsigned)ch;
        u32x4 ring[16], nix[4], nnix[4], craw[4], nraw[4]; f32x4 cq[4], nq[4];
        { u32x4 cix[4]; PS_LOADIX(cix, t); PS_LOADOPS(craw, cq, t);
#pragma unroll
          for (int j = 0; j < 16; ++j) ring[j] = PS_SEG(cix, j); }
        { const int t1 = t + gs.nwave < M ? t + gs.nwave : t; PS_LOADIX(nix, t1); }
#pragma unroll 1
        for (;;) {
            const int tn = t + gs.nwave, tnn = tn + gs.nwave; const bool has_next = tn < M;
            { const int tc = has_next ? tn : t, tcc = tnn < M ? tnn : t; PS_LOADOPS(nraw, nq, tc); PS_LOADIX(nnix, tcc); }
            unsigned xrw = 0u;
            if (VSTEP) xrw = *(const unsigned*)(XB + (size_t)t * D + 128 * p + 16 * ch + 2 * sub);
            float hx[16]; f32x4 cav[4];
            if (!VSTEP) {
                const float rstd = rsqrtf(((cq[0][0] + cq[0][1] + cq[0][2] + cq[0][3]) + (cq[1][0] + cq[1][1] + cq[1][2] + cq[1][3]) + (cq[2][0] + cq[2][1] + cq[2][2] + cq[2][3]) + (cq[3][0] + cq[3][1] + cq[3][2] + cq[3][3])) * (1.f / D) + EPS);
#pragma unroll
                for (int w = 0; w < 2; ++w)
#pragma unroll
                    for (int e = 0; e < 4; ++e) { hx[8 * w + 2 * e] = bflo(craw[w][e]) * rstd * g16[8 * w + 2 * e]; hx[8 * w + 2 * e + 1] = bfhi(craw[w][e]) * rstd * g16[8 * w + 2 * e + 1]; }
            } else {
#pragma unroll
                for (int j = 0; j < 4; ++j) cav[j] = __builtin_bit_cast(f32x4, craw[j]);
            }
            typedef float f32x2_ __attribute__((ext_vector_type(2)));
            float acc[16]; f32x2_ acc2[8];
#pragma unroll
            for (int e = 0; e < 16; ++e) acc[e] = 0.f;
#pragma unroll
            for (int e = 0; e < 8; ++e) acc2[e] = (f32x2_){0.f, 0.f};
#define PS_PIN() do { if (VSTEP) asm volatile("" : "+v"(acc2[0]), "+v"(acc2[1]), "+v"(acc2[2]), "+v"(acc2[3]), "+v"(acc2[4]), "+v"(acc2[5]), "+v"(acc2[6]), "+v"(acc2[7])); \
        else asm volatile("" : "+v"(acc[0]), "+v"(acc[1]), "+v"(acc[2]), "+v"(acc[3]), "+v"(acc[4]), "+v"(acc[5]), "+v"(acc[6]), "+v"(acc[7]), "+v"(acc[8]), "+v"(acc[9]), "+v"(acc[10]), "+v"(acc[11]), "+v"(acc[12]), "+v"(acc[13]), "+v"(acc[14]), "+v"(acc[15])); __builtin_amdgcn_sched_barrier(0); } while (0)
#pragma unroll
            for (int j = 0; j < 16; ++j) {
                if (MODE == 1) { acc[j] += __uint_as_float((ring[j][0] ^ ring[j][1] ^ ring[j][2] ^ ring[j][3]) & 0x3fffffffu); }
                else {
                f32x2_ f2[8];
#pragma unroll
                for (int w = 0; w < 4; ++w) { f2[2 * w] = __builtin_amdgcn_cvt_pk_f32_fp8((int)ring[j][w], false); f2[2 * w + 1] = __builtin_amdgcn_cvt_pk_f32_fp8((int)ring[j][w], true); }
                if (VSTEP) { const float av_ = cav[j >> 2][j & 3]; const f32x2_ av2 = (f32x2_){av_, av_};
#pragma unroll
                    for (int i = 0; i < 8; ++i) acc2[i] = __builtin_elementwise_fma(av2, f2[i], acc2[i]); }
                else { f32x2_ d0 = (f32x2_){hx[0], hx[1]} * f2[0], d1 = (f32x2_){hx[2], hx[3]} * f2[1];
#pragma unroll
                    for (int i = 2; i < 8; i += 2) { d0 = __builtin_elementwise_fma((f32x2_){hx[2 * i], hx[2 * i + 1]}, f2[i], d0); d1 = __builtin_elementwise_fma((f32x2_){hx[2 * i + 2], hx[2 * i + 3]}, f2[i + 1], d1); }
                    const f32x2_ ds = d0 + d1; float d = ds[0] + ds[1];
                    DPP_ADDC(d, 0xB1); DPP_ADDC(d, 0x4E); DPP_ADDC(d, 0x141); acc[j] = d; } }
                if (MODE != 2) ring[j] = PS_SEG(nix, j);
                if ((j & 1) == 1) PS_PIN();
            }
            if (!VSTEP) {
                if (ch == 0) { u32x4* dp = (u32x4*)((bf16_t*)DP + ((size_t)t * 8 + p) * 128 + 16 * sub);
                    u32x4 o0, o1; o0.x = pk2(acc[0], acc[1]); o0.y = pk2(acc[2], acc[3]); o0.z = pk2(acc[4], acc[5]); o0.w = pk2(acc[6], acc[7]);
                    o1.x = pk2(acc[8], acc[9]); o1.y = pk2(acc[10], acc[11]); o1.z = pk2(acc[12], acc[13]); o1.w = pk2(acc[14], acc[15]); dp[0] = o0; dp[1] = o1; }
            } else {
#pragma unroll
                for (int i = 0; i < 8; ++i) { acc[2 * i] = acc2[i][0]; acc[2 * i + 1] = acc2[i][1]; }
                float r8[8], r4[4], r2[2];
#pragma unroll
                for (int i = 0; i < 8; ++i) { const auto rr = __builtin_amdgcn_permlane32_swap(__float_as_uint(acc[i]), __float_as_uint(acc[i + 8]), false, false); r8[i] = __uint_as_float(rr[0]) + __uint_as_float(rr[1]); }
#pragma unroll
                for (int i = 0; i < 4; ++i) { const auto rr = __builtin_amdgcn_permlane16_swap(__float_as_uint(r8[i]), __float_as_uint(r8[i + 4]), false, false); r4[i] = __uint_as_float(rr[0]) + __uint_as_float(rr[1]); }
                const bool b3 = (lane & 8) != 0;
#pragma unroll
                for (int i = 0; i < 2; ++i) { const float keep = b3 ? r4[i + 2] : r4[i], send = b3 ? r4[i] : r4[i + 2];
                    r2[i] = keep + __uint_as_float(__builtin_amdgcn_update_dpp(0u, __float_as_uint(send), 0x128, 0xf, 0xf, true)); }
                const unsigned ow = pk2(r2[0] + bflo(xrw), r2[1] + bfhi(xrw));
                const float y0 = bflo(ow), y1 = bfhi(ow);
                const float s2 = wave_sum_dpp(y0 * y0 + y1 * y1);
                *(unsigned*)(XB + (size_t)t * D + 128 * p + 16 * ch + 2 * sub) = ow;
                if (lane == 0) SSQ2[(size_t)t * 16 + p] = s2;
            }
            if (!has_next) break;
#pragma unroll
            for (int j = 0; j < 4; ++j) { nix[j] = nnix[j]; craw[j] = nraw[j]; if (!VSTEP) cq[j] = nq[j]; }
            t = tn;
        }
    }
#undef PS_LOADIX
#undef PS_LOADOPS
#undef PS_SEG
#undef PS_PIN
}
__device__ __forceinline__ void peer_combine(const Ctx& c, const Args& a, int layer) {
    const float* SCU = (const float*)(a.ws + WS_ESC) + layer * 16384; const float* SCV = SCU + 32768;
    const int* SELI = (const int*)(a.ws + WS_SELI); const float* SELW = (const float*)(a.ws + WS_SELW); float* AOUT = (float*)(a.ws + WS_AOUT); const float* DP = (const float*)(a.ws + WS_QP);
    const bf16_t* DPB = (const bf16_t*)DP;
    const size_t n8 = (size_t)M * 16, stride = (size_t)c.nblk * 512;
    constexpr int CMB_N = 2;
    for (size_t v0 = (size_t)c.blk * 512 + c.tid; v0 < n8; v0 += CMB_N * stride) {
        f32x4 s0[CMB_N], s1[CMB_N]; u32x4 ix0[CMB_N], ix1[CMB_N]; f32x4 w0[CMB_N], w1[CMB_N];
#pragma unroll
        for (int u = 0; u < CMB_N; ++u) { const size_t v = v0 + u * stride < n8 ? v0 + u * stride : v0; const size_t t = v >> 4; const int q = (int)(v & 15) * 8;
            ix0[u] = *(const u32x4*)(SELI + t * 128 + q); ix1[u] = *(const u32x4*)(SELI + t * 128 + q + 4); w0[u] = *(const f32x4*)(SELW + t * 128 + q); w1[u] = *(const f32x4*)(SELW + t * 128 + q + 4);
            s0[u] = (f32x4){0.f, 0.f, 0.f, 0.f}; s1[u] = s0[u];
#pragma unroll
            for (int p = 0; p < 8; ++p) { f32x4 a0, a1; unpack8(*(const u32x4*)(DPB + (t * 8 + p) * 128 + q), a0, a1); s0[u] += a0; s1[u] += a1; } }
#pragma unroll
        for (int u = 0; u < CMB_N; ++u) { const size_t v = v0 + u * stride; if (v >= n8) break; const size_t t = v >> 4; const int q = (int)(v & 15) * 8;
            f32x4 o0, o1;
#pragma unroll
            for (int e = 0; e < 4; ++e) { o0[e] = gelu_tanh(s0[u][e] * SCU[ix0[u][e]]) * w0[u][e] * SCV[ix0[u][e]]; o1[e] = gelu_tanh(s1[u][e] * SCU[ix1[u][e]]) * w1[u][e] * SCV[ix1[u][e]]; }
            *(f32x4*)(AOUT + t * 128 + q) = o0; *(f32x4*)(AOUT + t * 128 + q + 4) = o1; }
    }
}

__device__ __forceinline__ void final_norm(const Ctx& c, const Args& a, int widx, int nw) {
    const float* gfin = a.in[I_FING]; const bf16_t* XB = (const bf16_t*)(a.ws + WS_XB);
    for (int m0 = widx; m0 < M; m0 += 2 * nw) {
        u32x4 w[2][2];
#pragma unroll
        for (int u = 0; u < 2; ++u) { const int m = m0 + u * nw < M ? m0 + u * nw : m0; const u32x4* xr = (const u32x4*)(XB + (size_t)m * D + 16 * c.lane); w[u][0] = xr[0]; w[u][1] = xr[1]; }
#pragma unroll
        for (int u = 0; u < 2; ++u) { const int m = m0 + u * nw; if (m >= M) break;
            float x[16]; float s = 0.f;
#pragma unroll
            for (int j = 0; j < 2; ++j)
#pragma unroll
                for (int e = 0; e < 4; ++e) { x[8 * j + 2 * e] = bflo(w[u][j][e]); x[8 * j + 2 * e + 1] = bfhi(w[u][j][e]); }
#pragma unroll
            for (int e = 0; e < 16; ++e) s += x[e] * x[e];
            s = wave_sum(s); const float rstd = rsqrtf(s * (1.f / D) + EPS);
            f32x4* orow = (f32x4*)(a.out + (size_t)m * D + 16 * c.lane);
#pragma unroll
            for (int j = 0; j < 4; ++j) { const f32x4 gg = *(const f32x4*)(gfin + 16 * c.lane + 4 * j); orow[j] = (f32x4){x[4 * j] * rstd * gg[0], x[4 * j + 1] * rstd * gg[1], x[4 * j + 2] * rstd * gg[2], x[4 * j + 3] * rstd * gg[3]}; } }
    }
}

__global__ void __launch_bounds__(512, 2) mk_fwd(Args a) {
    extern __shared__ __attribute__((aligned(16))) unsigned char lds[];
    Ctx c0; c0.tid = threadIdx.x; c0.lane = c0.tid & 63; c0.wave = __builtin_amdgcn_readfirstlane(c0.tid >> 6); c0.blk = blockIdx.x; c0.nblk = gridDim.x; c0.lds = lds;
    const Ctx& c = c0;
    volatile LAS unsigned* MISC = (volatile LAS unsigned*)((LAS unsigned char*)lds + MISC_OFF);
    for (int u = c.tid; u < (LDS_BYTES - LDSCTL_OFF) / 4; u += 512) ((LAS unsigned*)((LAS unsigned char*)lds + LDSCTL_OFF))[u] = 0u;
    __syncthreads();
    const bool multi = (a.ph_hi - a.ph_lo) > 1;
    XcdBarrier bar; bar.bar = (unsigned*)(a.ws + WS_CTL) + CW_BAR; bar.x = 0; bar.st = nullptr;
    if (multi) bar = xcd_barrier_post((unsigned*)(a.ws + WS_CTL) + CW_BAR, MISC + 8);
    const int gw = c.blk * 8 + c.wave, NGW = c.nblk * 8;

#define IN(k) (lo <= (k) && (k) < hi)
#define FRESH() Ctx c = c0; { int t_ = c0.tid; asm volatile("" : "+v"(t_)); c.tid = t_; c.lane = t_ & 63; int w_ = c0.wave; asm volatile("" : "+s"(w_)); c.wave = w_; int b_ = c0.blk; asm volatile("" : "+s"(b_)); c.blk = b_; int n_ = c0.nblk; asm volatile("" : "+s"(n_)); c.nblk = n_; }
#define GRIDBAR() do { XcdBarrier b_ = bar; unsigned* p_ = b_.bar; asm volatile("" : "+s"(p_)); b_.bar = p_; xcd_barrier(b_); } while (0)
#ifdef PROBE_PH
#define PROBE_STAMP(slot) do { if (blockIdx.x == 0 && threadIdx.x == 0) ((unsigned long long*)(a.ws + WS_CTL + 48 * 1024))[slot] = __builtin_amdgcn_s_memrealtime(); } while (0)
#define SEAM(k) do { if ((k) == PROBE_PH - 1) { if (IN(k) && IN((k) + 1)) GRIDBAR(); PROBE_STAMP(0); } else if ((k) == PROBE_PH) { if (IN(k) && IN((k) + 1)) GRIDBAR(); PROBE_STAMP(1); } else { if (IN(k) && IN((k) + 1)) GRIDBAR(); } } while (0)
#else
#define SEAM(k) do { if (IN(k) && IN((k) + 1)) GRIDBAR(); } while (0)
#endif
    const int lo = a.ph_lo, hi = a.ph_hi;
#ifdef PROBE_PH
    if (PROBE_PH == 0) PROBE_STAMP(0);
#endif
    if (IN(0)) {
        FRESH();
        p0_prologue(c, a);
    }
    SEAM(0);
#pragma unroll 1
    for (int layer = 0; layer < 2; ++layer) {
        const int pb = 1 + 11 * layer;
        unsigned char* lw = a.ws + WS_LW + (size_t)layer * LW_STRIDE;
        unsigned char* xbc = a.ws + (layer & 1 ? WS_XB2 : WS_XB); unsigned char* xbn = a.ws + (layer & 1 ? WS_XB : WS_XB2);
        if (IN(pb + 0)) {
            FRESH();
            GemmD g; g.A = (const bf16_t*)xbc; g.lda = D; g.Bt = (const bf16_t*)(lw + LW_WIN); g.ldb = D; g.K = D; g.kmid = -1;
            float* RSX = (float*)(a.ws + WS_RSX);
            rstd_rows(c, (const float*)(a.ws + WS_SSQ0), 16, RSX, c.nblk == 256 ? 4 : DIN / 256, c.nblk, c.blk);
            EpiInproj E; E.ssq0 = RSX; E.ucat = (bf16_t*)(a.ws + WS_UCAT); E.qraw = (bf16_t*)(a.ws + WS_QRAW); E.kv = (bf16_t*)(a.ws + WS_KV);
            gemm_phase_dense(c, g, M / 256, c.nblk == 256 ? 4 : DIN / 256, E);
            if (layer == 0 && c.nblk != 256) {}
        }
        SEAM(pb + 0);
        if (IN(pb + 1)) {
            FRESH();
            if (c.nblk == 256) {
                if (c.blk < 64) s1_unit(c, a, layer, c.blk);
                else if (c.blk < 128) {
                    GemmD g; g.A = (const bf16_t*)xbc; g.lda = D; g.Bt = (const bf16_t*)(lw + LW_WIN); g.ldb = D; g.K = D; g.kmid = -1;
                    float* RSX = (float*)(a.ws + WS_RSX);
                    if (c.tid < 256) { const int row = (c.blk - 64) * 256 + c.tid; RSX[row] = rsqrtf(sumn((const float*)(a.ws + WS_SSQ0) + (long)row * 16, 16) * (1.f / D) + EPS); }
                    VM_WAIT(); __syncthreads();
                    EpiInproj E; E.ssq0 = RSX; E.ucat = (bf16_t*)(a.ws + WS_UCAT); E.qraw = (bf16_t*)(a.ws + WS_QRAW); E.kv = (bf16_t*)(a.ws + WS_KV);
                    pg8::OneUnit S; S.u.pm = c.blk - 64; S.u.pn = 4; run_gemm(c.lds, g, S, E, c.tid);
                    VM_WAIT(); __syncthreads();
                    qkprep(c, a, layer, c.wave, 8, 2, (c.blk - 64) * 256);
                    if (layer == 0) cvt_fp8_layer(c, a, 1, (c.blk - 64) * 8 + c.wave, 192 * 8);
                } else {
                    qkprep(c, a, layer, (c.blk - 128) * 8 + c.wave, 128 * 8, 1);
                    if (layer == 0) cvt_fp8_layer(c, a, 1, (c.blk - 64) * 8 + c.wave, 192 * 8);
                }
            } else if (c.nblk > 64) {
                if (c.blk < 64) s1_unit(c, a, layer, c.blk);
                else qkprep(c, a, layer, (c.blk - 64) * 8 + c.wave, (c.nblk - 64) * 8);
            } else {
                for (int u = c.blk; u < 64; u += c.nblk) s1_unit(c, a, layer, u);
                qkprep(c, a, layer, gw, NGW);
            }
        }
        SEAM(pb + 1);
        if (IN(pb + 2)) {
            FRESH();
            GemmD g; g.A = (const bf16_t*)(a.ws + WS_UCAT); g.lda = KCAT; g.Bt = (const bf16_t*)(lw + LW_WY); g.ldb = KCAT; g.K = KCAT; g.kmid = -1;
            EpiS2 E; E.G = (bf16_t*)(a.ws + WS_G);
#ifdef USE_SGEMM
            for (int ui = c.blk; ui < 128; ui += c.nblk) { Unit u; u.pm = ui >> 1; u.pn = (ui >> 2) * 2 + (ui & 1); sgemm_unit(g, u, E, c.wave, c.lane); }
#else
            { pg8::S2Order S; S.blk = c.blk; S.nblk = c.nblk; run_gemm(c.lds, g, S, E, c.tid); }
#endif
#ifdef ATT_NAIVE
            for (int ui = c.blk; ui < 256; ui += c.nblk) attn_naive_unit(c, a, ui >> 7, (ui >> 4) & 7, ui & 15);
#else
            float mfix = 0.f;
            {
                float gq = 0.f, gk = 0.f;
                for (int d = 0; d < 64; ++d) { gq = fmaxf(gq, fabsf(a.in[I_QNG][layer * 64 + d])); gk = fmaxf(gk, fabsf(a.in[I_KNG][layer * 64 + d])); }
                mfix = 64.f * gq * gk * C2 * 1.02f;
            }
            for (int ui = c.blk; ui < 512; ui += c.nblk) {
                int ab, ah, aq;
                if (c.nblk == 256) { const int bl = ui & 255, vcu = (bl & 7) * 32 + (bl >> 3), combo = (ui >> 8) * 2 + (vcu >> 7), w = vcu & 127; ab = combo >> 1; ah = (combo & 1) * 4 + (w >> 5); aq = w & 31; }
                else { ab = ui >> 8; ah = (ui >> 5) & 7; aq = ui & 31; }
                attn_body::attn_unit<ATT_THRL>(ab, ah, aq, (const attn_body::bf16*)(a.ws + WS_QRAW), (const attn_body::bf16*)(a.ws + WS_KV), (attn_body::bf16*)(a.ws + WS_Y), (float*)(a.ws + WS_SSQA), (char*)lds, c.tid, mfix);
            }
#endif
        }
        SEAM(pb + 2);
        if (IN(pb + 3)) {
            FRESH();
            GemmD g; g.A = (const bf16_t*)(a.ws + WS_G); g.lda = 512; g.Bt = (const bf16_t*)(lw + LW_WGLU); g.ldb = 512; g.K = 512; g.kmid = -1;
            EpiGlu E; E.G = (const bf16_t*)(a.ws + WS_G); E.bglu = a.in[I_BGLU] + layer * 512; E.Y = (bf16_t*)(a.ws + WS_Y); E.ssqs = (float*)(a.ws + WS_SSQS);
            GemmD g1; g1.A = (const bf16_t*)(a.ws + WS_PB) + (size_t)layer * M * 256; g1.lda = 256; g1.Bt = (const bf16_t*)(lw + LW_WPROJ); g1.ldb = 256; g1.K = 256; g1.kmid = -1;
            EpiProj E1; E1.pr = (bf16_t*)(a.ws + WS_PRB);
            if (c.nblk >= 256) { if (c.blk < 128) gemm_phase_sub(c, g, M / 256, 2, E, 128, c.blk); else if (c.blk < 256) gemm_phase_sub(c, g1, M / 256, 4, E1, 128, c.blk - 128); }
            else { gemm_phase_dense(c, g, M / 256, 2, E); gemm_phase_dense(c, g1, M / 256, 4, E1); }
        }
        SEAM(pb + 3);
        if (IN(pb + 4)) {
            FRESH();
            GemmD g; g.A = (const bf16_t*)(a.ws + WS_Y); g.lda = D; g.Bt = (const bf16_t*)(lw + LW_WOUT); g.ldb = D; g.K = D; g.kmid = 512;
            float* RS = (float*)(a.ws + WS_RS);
            { const float* ssqs = (const float*)(a.ws + WS_SSQS); const float* ssqa = (const float*)(a.ws + WS_SSQA);
              pg8::StaticOrder S0; S0.init(M, D, c.nblk, c.blk); Unit u0;
              for (int i = 0; S0.next(i, u0); ++i) if (c.tid < 256) { const int row = u0.pm * 256 + c.tid;
                  const float s = rsqrtf(sumn(ssqs + (long)row * 16, 8) * (1.f / 512.f) + EPS), t = rsqrtf(sumn(ssqa + (long)row * 16, 8) * (1.f / 512.f) + EPS);
                  RS[(long)row * 2] = s / t; RS[(long)row * 2 + 1] = t; }
              VM_WAIT(); __syncthreads(); }
            EpiOut E; E.rs = RS; E.xb = (bf16_t*)xbc; E.ssq1 = (float*)(a.ws + WS_SSQ1);
            gemm_phase_dense(c, g, M / 256, 4, E);
        }
        SEAM(pb + 4);
        if (IN(pb + 5)) {
            FRESH();
            GemmD g; g.A = (const bf16_t*)xbc; g.lda = D; g.Bt = (const bf16_t*)(lw + LW_WQ); g.ldb = D; g.K = D; g.kmid = -1;
            float* RSX = (float*)(a.ws + WS_RSX);
            rstd_rows(c, (const float*)(a.ws + WS_SSQ1), 16, RSX, 8, c.nblk, c.blk);
            EpiQ E; E.ssq1 = RSX; E.qp = (bf16_t*)(a.ws + WS_QP);
            gemm_phase_dense(c, g, M / 256, 8, E);
            VM_WAIT(); __syncthreads();
            { pg8::StaticOrder S0; S0.init(M, 2048, c.nblk, c.blk); Unit u0;
              for (int i = 0; S0.next(i, u0); ++i) peer_topk_fast(c, a, layer, 0, 1 << 30, (u0.pm * 8 + c.wave) * 8 + u0.pn); }
        }
        SEAM(pb + 5);
        if (IN(pb + 7)) {
            FRESH();
#ifdef EXP_MODE
            peer_step<false, EXP_MODE>(c, a, layer, (bf16_t*)xbc);
            VM_WAIT(); __syncthreads();
#endif
            peer_step<false>(c, a, layer, (bf16_t*)xbc);
        }
        SEAM(pb + 7);
        if (IN(pb + 8)) {
            FRESH();
            peer_combine(c, a, layer);
        }
        SEAM(pb + 8);
        if (IN(pb + 9)) {
            FRESH();
            peer_step<true>(c, a, layer, (bf16_t*)xbc);
        }
        SEAM(pb + 9);
        if (IN(pb + 10)) {
            FRESH();
            GemmD g2; g2.A = (const bf16_t*)xbc; g2.lda = D; g2.Bt = (const bf16_t*)(lw + LW_WGATE); g2.ldb = D; g2.K = D; g2.kmid = -1;
            float* RSX = (float*)(a.ws + WS_RSX);
            rstd_rows(c, (const float*)(a.ws + WS_SSQS), 8, RSX, 4, c.nblk, c.blk);
            EpiGate E2; E2.pr = (const bf16_t*)(a.ws + WS_PRB); E2.xin = (const bf16_t*)xbc; E2.xout = (bf16_t*)xbn; E2.ssq0 = (float*)(a.ws + WS_SSQ0); E2.ssq2 = RSX;
            gemm_phase_dense(c, g2, M / 256, 4, E2);
        }
        SEAM(pb + 10);
    }
    if (IN(NPHASE - 1)) { FRESH(); final_norm(c, a, gw, NGW); }
#ifdef PROBE_RGN
    if (blockIdx.x == 0 && threadIdx.x == 0) {
        VM_WAIT();
        const unsigned long long* st = (const unsigned long long*)(a.ws + WS_CTL + 48 * 1024);
        const unsigned long long t0 = __hip_atomic_load(st, __ATOMIC_RELAXED, __HIP_MEMORY_SCOPE_AGENT), t1 = __hip_atomic_load(st + 1, __ATOMIC_RELAXED, __HIP_MEMORY_SCOPE_AGENT);
        const unsigned long long span = (t1 > t0 ? t1 - t0 : 0) * PROBE_MULT, s0 = __builtin_amdgcn_s_memrealtime();
        while (__builtin_amdgcn_s_memrealtime() - s0 < span) __builtin_amdgcn_s_sleep(8);
    }
#endif
#ifdef PROBE_PH
    if (blockIdx.x == 0 && threadIdx.x == 0) {
        VM_WAIT();
        const unsigned long long* st = (const unsigned long long*)(a.ws + WS_CTL + 48 * 1024);
        const unsigned long long t0 = __hip_atomic_load(st, __ATOMIC_RELAXED, __HIP_MEMORY_SCOPE_AGENT), t1 = __hip_atomic_load(st + 1, __ATOMIC_RELAXED, __HIP_MEMORY_SCOPE_AGENT);
        const unsigned long long span = (t1 > t0 ? t1 - t0 : 0) * PROBE_MULT, s0 = __builtin_amdgcn_s_memrealtime();
        while (__builtin_amdgcn_s_memrealtime() - s0 < span) __builtin_amdgcn_s_sleep(8);
    }
#endif
#undef IN
#undef SEAM
}

extern "C" void kernel_launch(void* const* d_in, const int* in_sizes, int n_in, void* d_out, int out_size, void* d_ws, size_t ws_size, hipStream_t stream) {
    static int grid = 0;
    if (grid == 0) {
        if (n_in != 29 || in_sizes[0] != M * D || out_size != M * D || in_sizes[3] != 2 * D * DIN || ws_size < WS_END) {
            fprintf(stderr, "kernel_launch: unexpected problem: n_in %d in0 %d in3 %d out %d ws %zu (need %zu); nothing launched\n", n_in, n_in > 0 ? in_sizes[0] : -1, n_in > 3 ? in_sizes[3] : -1, out_size, ws_size, (size_t)WS_END);
            grid = -1; return; }
        int dev = 0, cus = 0, per_cu = 0;
        if (hipGetDevice(&dev) != hipSuccess || hipDeviceGetAttribute(&cus, hipDeviceAttributeMultiprocessorCount, dev) != hipSuccess) { grid = -1; return; }
        if (hipFuncSetAttribute((const void*)mk_fwd, hipFuncAttributeMaxDynamicSharedMemorySize, LDS_BYTES) != hipSuccess) { fprintf(stderr, "kernel_launch: hipFuncSetAttribute failed\n"); grid = -1; return; }
        if (hipOccupancyMaxActiveBlocksPerMultiprocessor(&per_cu, (const void*)mk_fwd, 512, LDS_BYTES) != hipSuccess || per_cu < 1)
            fprintf(stderr, "kernel_launch: note: occupancy query reports %d workgroups per CU\n", per_cu);
        (void)hipGetLastError();
        grid = cus;
    }
    if (grid < 0) return;
    (void)hipMemsetAsync((char*)d_ws + WS_CTL, 0, CTL_ZERO_BYTES, stream);
    Args a{};
    for (int i = 0; i < 29; ++i) a.in[i] = (const float*)d_in[i];
    a.out = (float*)d_out; a.ws = (unsigned char*)d_ws;
    constexpr int NL = MK_N_LAUNCHES;
    for (int li = 0; li < NL; ++li) {
        a.ph_lo = (NPHASE * li) / NL; a.ph_hi = (NPHASE * (li + 1)) / NL;
        hipLaunchKernelGGL(mk_fwd, dim3(grid), dim3(512), LDS_BYTES, stream, a);
    }
}
```

```cpp
#include <hip/hip_runtime.h>
#include <cstdio>
#include <cstdint>

#ifndef ATT_THRL
#define ATT_THRL -1
#endif
#ifndef MK_N_LAUNCHES
#define MK_N_LAUNCHES 1
#endif

#define LAS __attribute__((address_space(3)))
typedef unsigned short bf16_t;
typedef short bf16x8 __attribute__((ext_vector_type(8)));
typedef float f32x4 __attribute__((ext_vector_type(4)));
typedef unsigned u32x4 __attribute__((ext_vector_type(4)));
typedef unsigned u32x2 __attribute__((ext_vector_type(2)));

constexpr int NB = 2, SEQ = 8192, M = NB * SEQ, D = 1024, DIN = 1280;
constexpr int NG = 32, LCH = 32, NCH = SEQ / LCH, KCAT = 768;
constexpr float EPS = 1e-6f;
constexpr float C2 = 0.125f * 1.4426950408889634f;
constexpr int NPHASE = 24;

constexpr size_t MiB = 1u << 20;
constexpr size_t WS_CTL = 0, CTL_ZERO_BYTES = 64 * 1024;
constexpr size_t WS_EU = 1 * MiB, WS_EV = 65 * MiB;
constexpr size_t WS_ESC = 241 * MiB + 256 * 1024;
constexpr size_t WS_LW = 129 * MiB, LW_STRIDE = 48 * MiB;
constexpr size_t LW_WIN = 0, LW_WGLU = 3 * MiB, LW_WOUT = 4 * MiB, LW_WQ = 6 * MiB, LW_SK1 = 10 * MiB, LW_SK2 = 10 * MiB + 512 * 1024,
                 LW_WGATE = 11 * MiB, LW_WPROJ = 13 * MiB, LW_AL = 13 * MiB + 512 * 1024, LW_WE = 14 * MiB, LW_WY = 22 * MiB;
constexpr size_t WS_PB = 225 * MiB, WS_ROPE = 241 * MiB, WS_XB = 242 * MiB, WS_UCAT = 274 * MiB, WS_QRAW = 300 * MiB, WS_KV = 316 * MiB,
                 WS_EBUF = 324 * MiB, WS_G = 340 * MiB, WS_Y = 356 * MiB, WS_SSQS = 388 * MiB, WS_SSQA = 389 * MiB, WS_SSQ0 = 390 * MiB, WS_SSQ1 = 391 * MiB, WS_RS = 241 * MiB + 512 * 1024, WS_RSX = 241 * MiB + 768 * 1024  , WS_PRB = 33 * MiB  ,
                 WS_QP = 392 * MiB  , WS_SELI = 456 * MiB, WS_SELW = 464 * MiB, WS_XN2 = 472 * MiB, WS_AOUT = 472 * MiB  , WS_XB2 = 480 * MiB  , WS_END = 512 * MiB;
constexpr int CW_BAR = 4096;

constexpr int RING_BYTES = 131072, LDSCTL_OFF = RING_BYTES, MISC_OFF = LDSCTL_OFF + 320, LDS_BYTES = 147456;

__device__ __forceinline__ unsigned f2bf(float f) { unsigned u = __float_as_uint(f); return (u + 0x7fffu + ((u >> 16) & 1u)) >> 16; }
__device__ __forceinline__ unsigned pk2(float lo, float hi) { return f2bf(lo) | (f2bf(hi) << 16); }
__device__ __forceinline__ float bflo(unsigned w) { return __uint_as_float(w << 16); }
__device__ __forceinline__ float bfhi(unsigned w) { return __uint_as_float(w & 0xffff0000u); }
__device__ __forceinline__ float bf1(bf16_t h) { return __uint_as_float((unsigned)h << 16); }
__device__ __forceinline__ float wave_sum(float v) {
#pragma unroll
    for (int o = 1; o < 64; o <<= 1) v += __shfl_xor(v, o);
    return v;
}
__device__ __forceinline__ float wave_max(float v) {
#pragma unroll
    for (int o = 1; o < 64; o <<= 1) v = fmaxf(v, __shfl_xor(v, o));
    return v;
}
__device__ __forceinline__ float sigmoidf_(float x) { return 1.f / (1.f + __expf(-x)); }
__device__ __forceinline__ float gelu_tanh(float x) {
    const float z = 0.7978845608028654f * (x + 0.044715f * x * x * x);
    const float e = __expf(2.f * z);
    const float th = 1.f - 2.f / (e + 1.f);
    return 0.5f * x * (1.f + th);
}
__device__ __forceinline__ float sumn(const float* p, int n) { float s = 0.f; for (int i = 0; i < n; ++i) s += p[i]; return s; }
#define LDS_WAIT() asm volatile("s_waitcnt lgkmcnt(0)" ::: "memory")
#define VM_WAIT() asm volatile("s_waitcnt vmcnt(0)" ::: "memory")

#define XB_TMO      128
#define XB_XCNT(j)  (256  + 64 * (j))
#define XB_XSUB(j)  (1280 + 64 * (j))
#define XB_XGEN(j)  (2304 + 64 * (j))
#define XB_TOP      3328
#define XB_TOPGEN   3392
#define XCD_BAR_WORDS 3456
#define XB_SPIN_CAP (1u << 18)
__device__ __forceinline__ unsigned xb_ld(unsigned* p)              { return __hip_atomic_load(p, __ATOMIC_RELAXED, __HIP_MEMORY_SCOPE_AGENT); }
__device__ __forceinline__ unsigned xb_add(unsigned* p, unsigned v) { return __hip_atomic_fetch_add(p, v, __ATOMIC_RELAXED, __HIP_MEMORY_SCOPE_AGENT); }
__device__ __forceinline__ unsigned xb_xcc_id() { return (unsigned)__builtin_amdgcn_s_getreg((3 << 11) | 20) & 0xFu; }
#define XB_SPIN(cond, bar) do { unsigned _sp = 0; while (cond) { __builtin_amdgcn_s_sleep(1); \
    if ((++_sp & 255u) == 0u) { if (xb_ld(&(bar)[XB_TMO])) break; if (_sp > XB_SPIN_CAP) { atomicAdd(&(bar)[XB_TMO], 1u); break; } } } } while (0)
struct XcdBarrier { unsigned* bar; unsigned x; volatile LAS unsigned* st; };
__device__ __forceinline__ XcdBarrier xcd_barrier_post(unsigned* bar, volatile LAS unsigned* st) {
    XcdBarrier b; b.bar = bar; b.x = xb_xcc_id(); b.st = st;
    if (threadIdx.x == 0) (void)xb_add(&bar[XB_XCNT(b.x)], 1u);
    return b;
}
__device__ __forceinline__ void xcd_barrier_complete(unsigned* bar, unsigned x, unsigned& nloc, unsigned& nx) {
    const unsigned G = gridDim.x * gridDim.y * gridDim.z;
    unsigned sum, cnt, mine, sp = 0u;
    for (;;) {
        sum = 0u; cnt = 0u; mine = 0u;
#pragma unroll
        for (unsigned j = 0; j < 16; ++j) { const unsigned c = xb_ld(&bar[XB_XCNT(j)]); sum += c; cnt += (c > 0u) ? 1u : 0u; mine = (j == x) ? c : mine; }
        if (sum == G) break;
        __builtin_amdgcn_s_sleep(1);
        if ((++sp & 255u) == 0u) { if (xb_ld(&bar[XB_TMO])) break; if (sp > XB_SPIN_CAP) { atomicAdd(&bar[XB_TMO], 1u); break; } }
    }
    nloc = mine > 0u ? mine : 1u; nx = cnt > 0u ? cnt : 1u;
}
__device__ __forceinline__ void xcd_barrier(const XcdBarrier& b) {
    asm volatile("s_waitcnt vmcnt(0)" ::: "memory");
    __syncthreads();
    if (threadIdx.x == 0) {
        unsigned* bar = b.bar;
        __builtin_amdgcn_s_waitcnt(0);
        unsigned nloc = b.st[0], nx = b.st[1];
        if (nloc == 0u) { xcd_barrier_complete(bar, b.x, nloc, nx); b.st[0] = nloc; b.st[1] = nx; }
        const unsigned old = xb_add(&bar[XB_XSUB(b.x)], 1u);
        const unsigned gen = old / nloc;
        if (old + 1u == (gen + 1u) * nloc) {
            __builtin_amdgcn_fence(__ATOMIC_RELEASE, "agent");
            asm volatile("s_waitcnt vmcnt(0)" ::: "memory");
            const unsigned og = xb_add(&bar[XB_TOP], 1u);
            const unsigned tg = og / nx;
            if (og + 1u == (tg + 1u) * nx) xb_add(&bar[XB_TOPGEN], 1u);
            else XB_SPIN(xb_ld(&bar[XB_TOPGEN]) == tg, bar);
            __builtin_amdgcn_fence(__ATOMIC_ACQUIRE, "agent");
            xb_add(&bar[XB_XGEN(b.x)], 1u);
            asm volatile("s_waitcnt vmcnt(0)" ::: "memory");
        } else {
            XB_SPIN(xb_ld(&bar[XB_XGEN(b.x)]) == gen, bar);
            __builtin_amdgcn_fence(__ATOMIC_ACQUIRE, "agent");
            asm volatile("s_waitcnt vmcnt(0)" ::: "memory");
        }
    }
    __syncthreads();
}

#ifdef PROBE_RGN
#define RGN(n, e) do { if ((n) == PROBE_RGN && blockIdx.x == PROBE_BLK && threadIdx.x == 0) { asm volatile("s_waitcnt vmcnt(0) lgkmcnt(0)" ::: "memory"); ((unsigned long long*)(rgn_ws + 48 * 1024))[e] = __builtin_amdgcn_s_memrealtime(); } } while (0)
#else
#define RGN(n, e) do {} while (0)
#endif
struct Args { const float* in[29]; float* out; unsigned char* ws; int ph_lo, ph_hi; };
enum { I_X = 0, I_P, I_NMIXG, I_WIN, I_LRE, I_LIM, I_LOGDT, I_BRE, I_BIM, I_CRE, I_CIM, I_DSKIP, I_WGLU, I_BGLU, I_QNG, I_KNG, I_SSMG, I_ATTG, I_WOUT,
       I_NFFNG, I_WQ, I_SK1, I_SK2, I_EU, I_EV, I_NPLEG, I_WGATE, I_WPROJ, I_FING };

struct Ctx { int tid, lane, wave, blk, nblk; unsigned char* lds; };

struct GemmD { const bf16_t* A; long lda; const bf16_t* Bt; long ldb; int K; int kmid; };
struct Unit { int pm, pn; };

template <class Epi>
__device__ __forceinline__ void sgemm_unit(const GemmD& g, const Unit u, const Epi& E, int wave, int lane) {
    const int i = lane & 15, q = lane >> 4;
    const bf16_t* Ab = g.A + (long)(u.pm * 256 + wave * 32) * g.lda;
    const bf16_t* Bb = g.Bt + (long)(u.pn * 256) * g.ldb;
    const int row0 = u.pm * 256 + wave * 32 + i;
    float ssq[2] = {0.f, 0.f};
    float rs[2] = {1.f, 1.f};
    if constexpr (Epi::ROWSCALE) { rs[0] = E.rscale(row0); rs[1] = E.rscale(row0 + 16); }
    for (int cg = 0; cg < 4; ++cg) {
        f32x4 acc[2][4];
#pragma unroll
        for (int mi = 0; mi < 2; ++mi)
#pragma unroll
            for (int ni = 0; ni < 4; ++ni) acc[mi][ni] = (f32x4){0.f, 0.f, 0.f, 0.f};
        for (int k0 = 0; k0 < g.K; k0 += 32) {
            if constexpr (Epi::MID) { if (k0 == g.kmid) {
#pragma unroll
                for (int mi = 0; mi < 2; ++mi) { const float f = E.mid(row0 + 16 * mi);
#pragma unroll
                    for (int ni = 0; ni < 4; ++ni) acc[mi][ni] *= f; } } }
            bf16x8 a[2], b[4];
#pragma unroll
            for (int mi = 0; mi < 2; ++mi) a[mi] = *(const bf16x8*)(Ab + (long)(16 * mi + i) * g.lda + k0 + 8 * q);
#pragma unroll
            for (int ni = 0; ni < 4; ++ni) b[ni] = *(const bf16x8*)(Bb + (long)(cg * 64 + 16 * ni + i) * g.ldb + k0 + 8 * q);
#pragma unroll
            for (int mi = 0; mi < 2; ++mi)
#pragma unroll
                for (int ni = 0; ni < 4; ++ni) acc[mi][ni] = __builtin_amdgcn_mfma_f32_16x16x32_bf16(b[ni], a[mi], acc[mi][ni], 0, 0, 0);
        }
#pragma unroll
        for (int mi = 0; mi < 2; ++mi)
#pragma unroll
            for (int ni = 0; ni < 4; ++ni) {
                const f32x4 v = acc[mi][ni] * rs[mi];
                const f32x4 w = E.put(row0 + 16 * mi, u.pn * 256 + cg * 64 + 16 * ni + 4 * q, v);
                ssq[mi] += w[0] * w[0] + w[1] * w[1] + w[2] * w[2] + w[3] * w[3];
            }
    }
    if constexpr (Epi::SSQ) {
#pragma unroll
        for (int mi = 0; mi < 2; ++mi) { float s = ssq[mi]; s += __shfl_xor(s, 16); s += __shfl_xor(s, 32);
            if (q == 0) { E.ssq(row0 + 16 * mi, u.pn * 4 + 0, s); E.ssq(row0 + 16 * mi, u.pn * 4 + 1, 0.f); E.ssq(row0 + 16 * mi, u.pn * 4 + 2, 0.f); E.ssq(row0 + 16 * mi, u.pn * 4 + 3, 0.f); } }
    }
}

__device__ __forceinline__ u32x2 pack4(f32x4 v) { u32x2 w; w.x = pk2(v[0], v[1]); w.y = pk2(v[2], v[3]); return w; }
__device__ __forceinline__ u32x4 pack8(f32x4 a, f32x4 b) { u32x4 w; w.x = pk2(a[0], a[1]); w.y = pk2(a[2], a[3]); w.z = pk2(b[0], b[1]); w.w = pk2(b[2], b[3]); return w; }
__device__ __forceinline__ void unpack8(u32x4 w, f32x4& a, f32x4& b) { a = (f32x4){bflo(w.x), bfhi(w.x), bflo(w.y), bfhi(w.y)}; b = (f32x4){bflo(w.z), bfhi(w.z), bflo(w.w), bfhi(w.w)}; }

struct EpiInproj {
    static constexpr bool MID = false, ROWSCALE = true, SSQ = false;
    const float* ssq0; bf16_t* ucat; bf16_t* qraw; bf16_t* kv;
    __device__ __forceinline__ float rscale(int row) const { return ssq0[row]; }
    __device__ __forceinline__ f32x4 put(int row, int col, f32x4 v) const {
        const u32x2 w = pack4(v);
        if (col < 512) { const int g = col >> 4, qq = col & 15, b = row >> 13, s = row & (SEQ - 1), c = s >> 5, j = s & 31;
            *(u32x2*)(ucat + ((long)((g * 2 + b) * NCH + c) * KCAT + j * 16 + qq)) = w; }
        else if (col < 1024) *(u32x2*)(qraw + (long)row * 512 + (col - 512)) = w;
        else *(u32x2*)(kv + (long)row * 256 + (col - 1024)) = w;
        return v;
    }
    __device__ __forceinline__ void put8(int row, int col, f32x4 v0, f32x4 v1, f32x4& w0, f32x4& w1) const {
        const u32x4 w = pack8(v0, v1); w0 = v0; w1 = v1;
        if (col < 512) { const int g = col >> 4, qq = col & 15, b = row >> 13, s = row & (SEQ - 1), c = s >> 5, j = s & 31;
            *(u32x4*)(ucat + ((long)((g * 2 + b) * NCH + c) * KCAT + j * 16 + qq)) = w; }
        else if (col < 1024) *(u32x4*)(qraw + (long)row * 512 + (col - 512)) = w;
        else *(u32x4*)(kv + (long)row * 256 + (col - 1024)) = w;
    }
    __device__ __forceinline__ void ssq(int, int, float) const {}
};
struct EpiS1 {
    static constexpr bool MID = false, ROWSCALE = false, SSQ = false;
    float* ebuf;
    __device__ __forceinline__ f32x4 put(int row, int col, f32x4 v) const { *(f32x4*)(ebuf + ((long)row * 256 + (col & 255))) = v; return v; }
    __device__ __forceinline__ void put8(int row, int col, f32x4 v0, f32x4 v1, f32x4& w0, f32x4& w1) const { float* p = ebuf + ((long)row * 256 + (col & 255)); *(f32x4*)p = v0; *(f32x4*)(p + 4) = v1; w0 = v0; w1 = v1; }
    __device__ __forceinline__ void ssq(int, int, float) const {}
};
struct EpiS2 {
    static constexpr bool MID = false, ROWSCALE = false, SSQ = false;
    bf16_t* G;
    __device__ __forceinline__ f32x4 put(int row, int col, f32x4 v) const {
        const int pm = row >> 8, c = row & 255, g = pm >> 1, b = pm & 1, nout = col & 511, j = nout >> 4, p = nout & 15;
        const long tok = (long)b * SEQ + c * LCH + j;
        f32x4 y; y[0] = gelu_tanh(v[0]); y[1] = gelu_tanh(v[1]); y[2] = gelu_tanh(v[2]); y[3] = gelu_tanh(v[3]);
        *(u32x2*)(G + tok * 512 + 16 * g + p) = pack4(y); return v;
    }
    __device__ __forceinline__ void put8(int row, int col, f32x4 v0, f32x4 v1, f32x4& w0, f32x4& w1) const {
        const int pm = row >> 8, c = row & 255, g = pm >> 1, b = pm & 1, nout = col & 511, j = nout >> 4, p = nout & 15;
        const long tok = (long)b * SEQ + c * LCH + j;
        f32x4 y0, y1;
#pragma unroll
        for (int e = 0; e < 4; ++e) { y0[e] = gelu_tanh(v0[e]); y1[e] = gelu_tanh(v1[e]); }
        *(u32x4*)(G + tok * 512 + 16 * g + p) = pack8(y0, y1); w0 = v0; w1 = v1;
    }
    __device__ __forceinline__ void ssq(int, int, float) const {}
};
struct EpiGlu {
    static constexpr bool MID = false, ROWSCALE = false, SSQ = true;
    const bf16_t* G; const float* bglu; bf16_t* Y; float* ssqs;
    __device__ __forceinline__ f32x4 put(int row, int col, f32x4 v) const {
        const u32x2 gw = *(const u32x2*)(G + (long)row * 512 + col);
        const f32x4 bb = *(const f32x4*)(bglu + col);
        f32x4 ys; ys[0] = bflo(gw.x) * sigmoidf_(v[0] + bb[0]); ys[1] = bfhi(gw.x) * sigmoidf_(v[1] + bb[1]);
        ys[2] = bflo(gw.y) * sigmoidf_(v[2] + bb[2]); ys[3] = bfhi(gw.y) * sigmoidf_(v[3] + bb[3]);
        *(u32x2*)(Y + (long)row * 1024 + col) = pack4(ys); return ys;
    }
    __device__ __forceinline__ void put8(int row, int col, f32x4 v0, f32x4 v1, f32x4& w0, f32x4& w1) const {
        f32x4 g0, g1; unpack8(*(const u32x4*)(G + (long)row * 512 + col), g0, g1);
        const f32x4 b0 = *(const f32x4*)(bglu + col), b1 = *(const f32x4*)(bglu + col + 4);
#pragma unroll
        for (int e = 0; e < 4; ++e) { w0[e] = g0[e] * sigmoidf_(v0[e] + b0[e]); w1[e] = g1[e] * sigmoidf_(v1[e] + b1[e]); }
        *(u32x4*)(Y + (long)row * 1024 + col) = pack8(w0, w1);
    }
    __device__ __forceinline__ void ssq(int row, int slot, float s) const { ssqs[(long)row * 16 + slot] = s; }
};
struct EpiOut {
    static constexpr bool MID = true, ROWSCALE = true, SSQ = true;
    const float* rs; bf16_t* xb; float* ssq1;
    __device__ __forceinline__ float mid(int row) const { return rs[(long)row * 2]; }
    __device__ __forceinline__ float rscale(int row) const { return rs[(long)row * 2 + 1]; }
    __device__ __forceinline__ f32x4 put(int row, int col, f32x4 v) const {
        const long o = (long)row * D + col; const u32x2 xw = *(const u32x2*)(xb + o); const f32x4 x1 = (f32x4){bflo(xw.x), bfhi(xw.x), bflo(xw.y), bfhi(xw.y)} + v;
        const u32x2 ow = pack4(x1); *(u32x2*)(xb + o) = ow; return (f32x4){bflo(ow.x), bfhi(ow.x), bflo(ow.y), bfhi(ow.y)};
    }
    __device__ __forceinline__ void put8(int row, int col, f32x4 v0, f32x4 v1, f32x4& w0, f32x4& w1) const {
        const long o = (long)row * D + col; f32x4 x0, x1; unpack8(*(const u32x4*)(xb + o), x0, x1);
        const u32x4 ow = pack8(x0 + v0, x1 + v1); *(u32x4*)(xb + o) = ow; unpack8(ow, w0, w1);
    }
    __device__ __forceinline__ void ssq(int row, int slot, float s) const { ssq1[(long)row * 16 + slot] = s; }
};
struct EpiQ {
    static constexpr bool MID = false, ROWSCALE = true, SSQ = false;
    const float* ssq1; bf16_t* qp;
    __device__ __forceinline__ float rscale(int row) const { return ssq1[row]; }
    __device__ __forceinline__ f32x4 put(int row, int col, f32x4 v) const { *(u32x2*)(qp + (long)row * 2048 + col) = pack4(v); return v; }
    __device__ __forceinline__ void put8(int row, int col, f32x4 v0, f32x4 v1, f32x4& w0, f32x4& w1) const { *(u32x4*)(qp + (long)row * 2048 + col) = pack8(v0, v1); w0 = v0; w1 = v1; }
    __device__ __forceinline__ void ssq(int, int, float) const {}
};
struct EpiProj {
    static constexpr bool MID = false, ROWSCALE = false, SSQ = false;
    bf16_t* pr;
    __device__ __forceinline__ f32x4 put(int row, int col, f32x4 v) const { *(u32x2*)(pr + (long)row * D + col) = pack4(v); return v; }
    __device__ __forceinline__ void put8(int row, int col, f32x4 v0, f32x4 v1, f32x4& w0, f32x4& w1) const { *(u32x4*)(pr + (long)row * D + col) = pack8(v0, v1); w0 = v0; w1 = v1; }
    __device__ __forceinline__ void ssq(int, int, float) const {}
};
struct EpiGate {
    static constexpr bool MID = false, ROWSCALE = true, SSQ = true;
    const bf16_t* pr; const bf16_t* xin; bf16_t* xout; float* ssq0; const float* ssq2;
    __device__ __forceinline__ float rscale(int row) const { return ssq2[row]; }
    __device__ __forceinline__ f32x4 put(int row, int col, f32x4 v) const {
        const long o = (long)row * D + col; const u32x2 pw = *(const u32x2*)(pr + o); const f32x4 pv = (f32x4){bflo(pw.x), bfhi(pw.x), bflo(pw.y), bfhi(pw.y)}; const u32x2 xw = *(const u32x2*)(xin + o); f32x4 x3 = (f32x4){bflo(xw.x), bfhi(xw.x), bflo(xw.y), bfhi(xw.y)};
        x3[0] += sigmoidf_(v[0]) * pv[0]; x3[1] += sigmoidf_(v[1]) * pv[1]; x3[2] += sigmoidf_(v[2]) * pv[2]; x3[3] += sigmoidf_(v[3]) * pv[3];
        const u32x2 ow = pack4(x3); *(u32x2*)(xout + o) = ow; return (f32x4){bflo(ow.x), bfhi(ow.x), bflo(ow.y), bfhi(ow.y)};
    }
    __device__ __forceinline__ void put8(int row, int col, f32x4 v0, f32x4 v1, f32x4& w0, f32x4& w1) const {
        const long o = (long)row * D + col; f32x4 p0, p1, x0, x1; unpack8(*(const u32x4*)(pr + o), p0, p1); unpack8(*(const u32x4*)(xin + o), x0, x1);
#pragma unroll
        for (int e = 0; e < 4; ++e) { x0[e] += sigmoidf_(v0[e]) * p0[e]; x1[e] += sigmoidf_(v1[e]) * p1[e]; }
        const u32x4 ow = pack8(x0, x1); *(u32x4*)(xout + o) = ow; unpack8(ow, w0, w1);
    }
    __device__ __forceinline__ void ssq(int row, int slot, float s) const { ssq0[(long)row * 16 + slot] = s; }
};


namespace pg8 {
#define PG8_LAS __attribute__((address_space(3)))
constexpr int BM = 256, BK = 64, HALF = 128, HTB = HALF * BK * 2, STAGE_BYTES = 8 * HTB, NXCD = 8, WGM = 8;
__host__ __device__ __forceinline__ int lds_byte(int r, int c) { const int st = (r >> 4) * 2 + (c >> 5), rr = r & 15, cc = c & 31, ob = rr * 64 + cc * 2; return st * 1024 + (ob ^ (((ob >> 9) & 1) << 5)); }
__host__ __device__ __forceinline__ void stage_rc(int b, int& R, int& C) { const int st = b / 1024, sb = b % 1024, swz = sb ^ (((sb >> 9) & 1) << 5); R = (st >> 1) * 16 + swz / 64; C = (st & 1) * 32 + (swz % 64) / 2; }
__host__ __device__ __forceinline__ int perm32(int rho) { const int n = rho >> 4, i = rho & 15; return 8 * (i >> 2) + 4 * n + (i & 3); }
using ::Unit;
struct Gemm { const bf16_t* A; const bf16_t* Bt; int K, lda, ldb, kmid; };
struct StaticOrder {
    int nM, nN, nwg, G, c;
    __host__ __device__ __forceinline__ void init(int M_, int N_, int G_, int c_) { nM = M_ / BM; nN = N_ / BM; nwg = nM * nN; G = G_; c = c_; }
    __host__ __device__ __forceinline__ bool next(int i, Unit& u) const {
        const long L = (long)i * G + c; if (L >= nwg) return false;
        int wgid = (int)L; { const int q = nwg / NXCD, r = nwg % NXCD, xcd = wgid % NXCD, off = wgid / NXCD; wgid = (xcd < r ? xcd * (q + 1) : r * (q + 1) + (xcd - r) * q) + off; }
        const int nig = WGM * nN, gid = wgid / nig, fm = gid * WGM, gsz = (nM - fm) < WGM ? (nM - fm) : WGM;
        u.pm = fm + ((wgid % nig) % gsz); u.pn = (wgid % nig) / gsz; return true;
    }
    __device__ __forceinline__ void a_ready(const Unit&) const {}
    __device__ __forceinline__ void done(const Unit&) const {}
};
struct OneUnit { Unit u;
    __device__ __forceinline__ bool next(int i, Unit& o) const { if (i) return false; o = u; return true; }
    __device__ __forceinline__ void a_ready(const Unit&) const {}
    __device__ __forceinline__ void done(const Unit&) const {} };
struct S2Order { int blk, nblk;
    __device__ __forceinline__ bool next(int i, Unit& o) const { const int ui = blk + i * nblk; if (ui >= 128) return false; o.pm = ui >> 1; o.pn = (ui >> 2) * 2 + (ui & 1); return true; }
    __device__ __forceinline__ void a_ready(const Unit&) const {}
    __device__ __forceinline__ void done(const Unit&) const {} };
template <class F> struct Epi {
    static constexpr bool PERM = true, AFTER_DRAIN = false, MID = F::MID;
    F f;
    __device__ __forceinline__ void operator()(const f32x4 (&acc)[2][2][4][2], const Unit& u, int wr, int wc, int fr, int fq) const {
        asm volatile("" : "+v"(fr), "+v"(fq));
        const int rowb = u.pm * BM + wr * 64 + fr, colb = u.pn * BM + wc * 32 + 8 * fq;
        float rsv[8];
#pragma unroll
        for (int i = 0; i < 8; ++i) { rsv[i] = 1.f; if constexpr (F::ROWSCALE) rsv[i] = f.rscale(rowb + (i >> 2) * HALF + (i & 3) * 16); }
#pragma unroll
        for (int ai = 0; ai < 2; ++ai)
#pragma unroll
            for (int m = 0; m < 4; ++m) {
                const int row = rowb + ai * HALF + m * 16; const float rs = rsv[ai * 4 + m];
                float ss = 0.f;
#pragma unroll
                for (int bj = 0; bj < 2; ++bj) { f32x4 w0, w1; f.put8(row, colb + bj * HALF, acc[ai][bj][m][0] * rs, acc[ai][bj][m][1] * rs, w0, w1);
                    ss += (w0[0] * w0[0] + w0[1] * w0[1] + w0[2] * w0[2] + w0[3] * w0[3]) + (w1[0] * w1[0] + w1[1] * w1[1] + w1[2] * w1[2] + w1[3] * w1[3]); }
                if constexpr (F::SSQ) { ss += __shfl_xor(ss, 16); ss += __shfl_xor(ss, 32); if (fq == 0) f.ssq(row, u.pn * 4 + wc, ss); }
                asm volatile("" ::: "memory");
            }
    }
    __device__ __forceinline__ void midscale(f32x4 (&acc)[2][2][4][2], const Unit& u, int wr, int wc, int fr, int fq) const {
        if constexpr (F::MID) {
            asm volatile("" : "+v"(fr));
            const int rowb = u.pm * BM + wr * 64 + fr;
#pragma unroll
            for (int ai = 0; ai < 2; ++ai)
#pragma unroll
                for (int m = 0; m < 4; ++m) { const float s = f.mid(rowb + ai * HALF + m * 16);
#pragma unroll
                    for (int bj = 0; bj < 2; ++bj)
#pragma unroll
                        for (int n = 0; n < 2; ++n) acc[ai][bj][m][n] *= s; }
        }
    }
};
template <class Epi, class Sched, bool ALIGN_EPI = false, bool SP2 = false>
__device__ __forceinline__ void gemm_phase(PG8_LAS unsigned char* lds, const Gemm g, const Sched& S, const Epi& E, const int tid) {
    const int wid = __builtin_amdgcn_readfirstlane(tid >> 6), lane = tid & 63, wr = wid >> 2, wc = wid & 3, fr = lane & 15, fq = lane >> 4;
    const int K = g.K, nt = K / BK;
    unsigned voffA[2], voffB[2];
#pragma unroll
    for (int i = 0; i < 2; ++i) { int R, C; stage_rc(tid * 16 + i * 8192, R, C); const int Rb = Epi::PERM ? ((R & ~31) + perm32(R & 31)) : R;
        voffA[i] = (unsigned)(R * g.lda + C) * 2u; voffB[i] = (unsigned)(Rb * g.ldb + C) * 2u; }
    const size_t kstep = (size_t)(BK * 2);
    const size_t hstepA = (size_t)HALF * g.lda * 2, hstepB = (size_t)HALF * g.ldb * 2;
    const size_t tstepA = 2 * hstepA, tstepB = 2 * hstepB;
    const unsigned ldsw = (unsigned)wid * 1024u;
    const int aoff = lds_byte(wr * 64 + fr, fq * 8), boff = lds_byte(wc * 32 + fr, fq * 8);
#define PG8_SA(b, h) (((b) * 2 + (h)) * HTB)
#define PG8_SB(b, h) ((4 + (b) * 2 + (h)) * HTB)
#define PG8_STAGE(bufoff, gbase, voff) do { _Pragma("unroll") for (int _i = 0; _i < 2; ++_i) \
        __builtin_amdgcn_global_load_lds((const unsigned*)((const char*)(gbase) + (voff)[_i]), (PG8_LAS unsigned*)(lds + (bufoff) + ldsw + _i * 8192), 16, 0, 0); } while (0)
#define PG8_LDA(dst, b, h) do { _Pragma("unroll") for (int m = 0; m < 4; ++m) _Pragma("unroll") for (int k = 0; k < 2; ++k) dst[m][k] = *(const PG8_LAS bf16x8*)(lds + PG8_SA(b, h) + aoff + m * 2048 + k * 1024); } while (0)
#define PG8_LDB(dst, b, h) do { _Pragma("unroll") for (int n = 0; n < 2; ++n) _Pragma("unroll") for (int k = 0; k < 2; ++k) dst[n][k] = *(const PG8_LAS bf16x8*)(lds + PG8_SB(b, h) + boff + n * 2048 + k * 1024); } while (0)
#define PG8_MMA(ai, bj, At, Bt) do { __builtin_amdgcn_s_setprio(1); _Pragma("unroll") for (int m = 0; m < 4; ++m) _Pragma("unroll") for (int n = 0; n < 2; ++n) _Pragma("unroll") for (int k = 0; k < 2; ++k) \
        acc[ai][bj][m][n] = __builtin_amdgcn_mfma_f32_16x16x32_bf16(Bt[n][k], At[m][k], acc[ai][bj][m][n], 0, 0, 0); __builtin_amdgcn_s_setprio(0); } while (0)
#define PG8_WAIT_V(n) asm volatile("s_waitcnt vmcnt(" #n ")" ::: "memory")
#define PG8_WAIT_L(n) asm volatile("s_waitcnt lgkmcnt(" #n ")" ::: "memory")
#define PG8_BAR __builtin_amdgcn_s_barrier()
#define PG8_SCHED __builtin_amdgcn_sched_barrier(0)
    Unit cur, nxt; int ui = 0;
    if (!S.next(0, cur)) return;
    f32x4 acc[2][2][4][2];
#pragma unroll
    for (int a = 0; a < 2; ++a)
#pragma unroll
        for (int b = 0; b < 2; ++b)
#pragma unroll
            for (int m = 0; m < 4; ++m)
#pragma unroll
                for (int n = 0; n < 2; ++n) acc[a][b][m][n] = (f32x4){0.f, 0.f, 0.f, 0.f};
    bf16x8 At[4][2], B0[2][2], B1[2][2];
    const char* cA = (const char*)g.A + (size_t)cur.pm * tstepA; const char* cB = (const char*)g.Bt + (size_t)cur.pn * tstepB;
    S.a_ready(cur);
    if constexpr (SP2) {
        PG8_STAGE(PG8_SB(0, 0), cB, voffB); PG8_STAGE(PG8_SB(0, 1), cB + hstepB, voffB); PG8_STAGE(PG8_SA(0, 0), cA, voffA); PG8_STAGE(PG8_SA(0, 1), cA + hstepA, voffA);
        if (wr == 1) PG8_BAR;
        PG8_WAIT_V(2); PG8_BAR;
        PG8_STAGE(PG8_SB(1, 0), cB + kstep, voffB); PG8_STAGE(PG8_SA(1, 0), cA + kstep, voffA); PG8_STAGE(PG8_SB(1, 1), cB + hstepB + kstep, voffB);
        PG8_WAIT_V(6); PG8_BAR;
    } else {
        PG8_STAGE(PG8_SB(0, 0), cB, voffB); PG8_STAGE(PG8_SA(0, 0), cA, voffA); PG8_STAGE(PG8_SB(0, 1), cB + hstepB, voffB); PG8_STAGE(PG8_SA(0, 1), cA + hstepA, voffA);
        if (wr == 1) PG8_BAR;
        PG8_WAIT_V(4); PG8_BAR;
        PG8_STAGE(PG8_SB(1, 0), cB + kstep, voffB); PG8_STAGE(PG8_SA(1, 0), cA + kstep, voffA); PG8_STAGE(PG8_SB(1, 1), cB + hstepB + kstep, voffB);
        PG8_WAIT_V(6); PG8_BAR;
    }
    for (;;) {
        const bool has_next = S.next(ui + 1, nxt);
        const char* nA = has_next ? (const char*)g.A + (size_t)nxt.pm * tstepA : cA; const char* nB = has_next ? (const char*)g.Bt + (size_t)nxt.pn * tstepB : cB;
        for (int t = 0; t < nt; t += 2) {
            const bool last = (t == nt - 2);
            if constexpr (Epi::MID) { if (t * BK == g.kmid) E.midscale(acc, cur, wr, wc, fr, fq); }
            const char* a1 = cA + (size_t)(t + 1) * kstep;
            const char* a2 = last ? nA : cA + (size_t)(t + 2) * kstep; const char* b2 = last ? nB : cB + (size_t)(t + 2) * kstep;
            const char* a3 = a2 + kstep; const char* b3 = b2 + kstep;
            if (last && has_next) S.a_ready(nxt);
            if constexpr (SP2) {
            PG8_LDB(B0, 0, 0); PG8_LDB(B1, 0, 1); PG8_SCHED; PG8_LDA(At, 0, 0); PG8_STAGE(PG8_SA(1, 1), a1 + hstepA, voffA);
            PG8_WAIT_V(8); PG8_WAIT_L(0); PG8_BAR; PG8_MMA(0, 0, At, B0); PG8_MMA(0, 1, At, B1); PG8_BAR; PG8_SCHED;
            PG8_LDA(At, 0, 1); PG8_STAGE(PG8_SB(0, 0), b2, voffB); PG8_STAGE(PG8_SB(0, 1), b2 + hstepB, voffB); PG8_STAGE(PG8_SA(0, 0), a2, voffA);
            PG8_WAIT_V(8); PG8_WAIT_L(0); PG8_BAR; PG8_MMA(1, 0, At, B0); PG8_MMA(1, 1, At, B1); PG8_BAR; PG8_SCHED;
            PG8_LDB(B0, 1, 0); PG8_LDB(B1, 1, 1); PG8_SCHED; PG8_LDA(At, 1, 0); PG8_STAGE(PG8_SA(0, 1), a2 + hstepA, voffA);
            PG8_WAIT_V(8); PG8_WAIT_L(0); PG8_BAR; PG8_MMA(0, 0, At, B0); PG8_MMA(0, 1, At, B1); PG8_BAR; PG8_SCHED;
            PG8_LDA(At, 1, 1); PG8_STAGE(PG8_SB(1, 0), b3, voffB); PG8_STAGE(PG8_SB(1, 1), b3 + hstepB, voffB); PG8_STAGE(PG8_SA(1, 0), a3, voffA);
            PG8_WAIT_V(8); PG8_WAIT_L(0); PG8_BAR; PG8_MMA(1, 0, At, B0); PG8_MMA(1, 1, At, B1); PG8_BAR; PG8_SCHED;
            } else {
            PG8_LDB(B0, 0, 0); PG8_SCHED; PG8_LDA(At, 0, 0); PG8_STAGE(PG8_SA(1, 1), a1 + hstepA, voffA);
            PG8_WAIT_L(8); PG8_BAR; PG8_WAIT_L(0); PG8_MMA(0, 0, At, B0); PG8_BAR; PG8_SCHED;
            PG8_LDB(B1, 0, 1); PG8_STAGE(PG8_SB(0, 0), b2, voffB);
            PG8_BAR; PG8_WAIT_L(0); PG8_MMA(0, 1, At, B1); PG8_BAR;
            PG8_LDA(At, 0, 1); PG8_STAGE(PG8_SA(0, 0), a2, voffA);
            PG8_BAR; PG8_WAIT_L(0); PG8_MMA(1, 0, At, B0); PG8_BAR; PG8_SCHED;
            PG8_STAGE(PG8_SB(0, 1), b2 + hstepB, voffB);
            PG8_WAIT_V(6); PG8_BAR; PG8_MMA(1, 1, At, B1); PG8_BAR;
            PG8_LDB(B0, 1, 0); PG8_SCHED; PG8_LDA(At, 1, 0); PG8_STAGE(PG8_SA(0, 1), a2 + hstepA, voffA);
            PG8_WAIT_L(8); PG8_BAR; PG8_WAIT_L(0); PG8_MMA(0, 0, At, B0); PG8_BAR; PG8_SCHED;
            PG8_LDB(B1, 1, 1); PG8_STAGE(PG8_SB(1, 0), b3, voffB);
            PG8_BAR; PG8_WAIT_L(0); PG8_MMA(0, 1, At, B1); PG8_BAR;
            PG8_LDA(At, 1, 1); PG8_STAGE(PG8_SA(1, 0), a3, voffA);
            PG8_BAR; PG8_WAIT_L(0); PG8_MMA(1, 0, At, B0); PG8_BAR; PG8_SCHED;
            PG8_STAGE(PG8_SB(1, 1), b3 + hstepB, voffB);
            PG8_WAIT_V(6); PG8_BAR; PG8_MMA(1, 1, At, B1); PG8_BAR;
            }
        }
        if constexpr (ALIGN_EPI) { if (wr == 0) PG8_BAR; }
        if constexpr (!Epi::AFTER_DRAIN) { E(acc, cur, wr, wc, fr, fq); S.done(cur); }
        if (!has_next) break;
#pragma unroll
        for (int a = 0; a < 2; ++a)
#pragma unroll
            for (int b = 0; b < 2; ++b)
#pragma unroll
                for (int m = 0; m < 4; ++m)
#pragma unroll
                    for (int n = 0; n < 2; ++n) acc[a][b][m][n] = (f32x4){0.f, 0.f, 0.f, 0.f};
        cur = nxt; cA = nA; cB = nB; ++ui;
        if constexpr (ALIGN_EPI) { if (wr == 1) PG8_BAR; }
    }
    PG8_WAIT_V(0);
    if constexpr (!ALIGN_EPI) { if (wr == 0) PG8_BAR; }
    PG8_BAR;
    if constexpr (Epi::AFTER_DRAIN) { E.fused(acc, cur, wr, wc, fr, fq, lds, wid, lane); S.done(cur); }
#undef PG8_SA
#undef PG8_SB
#undef PG8_STAGE
#undef PG8_LDA
#undef PG8_LDB
#undef PG8_MMA
#undef PG8_WAIT_V
#undef PG8_WAIT_L
#undef PG8_BAR
#undef PG8_SCHED
}

}

template <class F, class Sched>
__device__ __forceinline__ void run_gemm(unsigned char* lds, const GemmD& g, const Sched& S, const F& f, const int tid) {
    pg8::Gemm pg; pg.A = g.A; pg.Bt = g.Bt; pg.K = g.K; pg.lda = (int)g.lda; pg.ldb = (int)g.ldb; pg.kmid = g.kmid;
    pg8::Epi<F> E; E.f = f;
    pg8::gemm_phase<pg8::Epi<F>, Sched, true, true>((PG8_LAS unsigned char*)lds, pg, S, E, tid);
}
__device__ __forceinline__ void rstd_rows(const Ctx& c, const float* ssq, int nslot, float* rsx, int nN, int G, int cidx) {
    pg8::StaticOrder S0; S0.init(M, nN * 256, G, cidx); Unit u0;
    for (int i = 0; S0.next(i, u0); ++i) if (c.tid < 256) { const int row = u0.pm * 256 + c.tid; rsx[row] = rsqrtf(sumn(ssq + (long)row * 16, nslot) * (1.f / D) + EPS); }
    VM_WAIT(); __syncthreads();
}
template <class Epi>
__device__ __forceinline__ void gemm_phase_sub(const Ctx& c, const GemmD& g, int nM, int nN, const Epi& E, int G, int cidx) {
    pg8::StaticOrder S; S.init(nM * 256, nN * 256, G, cidx);
    run_gemm(c.lds, g, S, E, c.tid);
}
template <class Epi>
__device__ __forceinline__ void gemm_phase_dense(const Ctx& c, const GemmD& g, int nM, int nN, const Epi& E) {
#ifdef USE_SGEMM
    const int nU = nM * nN;
    for (int ui = c.blk; ui < nU; ui += c.nblk) { Unit u; u.pn = ui % nN; u.pm = ui / nN; sgemm_unit(g, u, E, c.wave, c.lane); }
#else
    pg8::StaticOrder S; S.init(nM * 256, nN * 256, c.nblk, c.blk);
    run_gemm(c.lds, g, S, E, c.tid);
#endif
}

__device__ __forceinline__ void transpose_item(const float* W, int K, int N, bf16_t* WT, const float* gain, float* scr, int item, int lane) {
    const int nblk = N / 32, kb = item / nblk, nb = item % nblk, k0 = 64 * kb, n0 = 32 * nb;
    { f32x4 v[8];
#pragma unroll
      for (int i = 0; i < 8; ++i) v[i] = *(const f32x4*)(W + (size_t)(k0 + 8 * i + (lane >> 3)) * N + n0 + 4 * (lane & 7));
#pragma unroll
      for (int i = 0; i < 8; ++i) { const int kk = 8 * i + (lane >> 3); const float gg = gain ? gain[k0 + kk] : 1.f; float* s = scr + kk * 33 + 4 * (lane & 7);
          s[0] = v[i][0] * gg; s[1] = v[i][1] * gg; s[2] = v[i][2] * gg; s[3] = v[i][3] * gg; } }
    LDS_WAIT(); asm volatile("" ::: "memory");
    const int cc = lane & 7;
#pragma unroll
    for (int j = 0; j < 4; ++j) { const int n = (lane >> 3) + 8 * j; const float* s = scr + (8 * cc) * 33 + n;
        u32x4 o; o.x = pk2(s[0 * 33], s[1 * 33]); o.y = pk2(s[2 * 33], s[3 * 33]); o.z = pk2(s[4 * 33], s[5 * 33]); o.w = pk2(s[6 * 33], s[7 * 33]);
        *(u32x4*)(WT + (size_t)(n0 + n) * K + k0 + 8 * cc) = o; }
    LDS_WAIT(); asm volatile("" ::: "memory");
}
__device__ __forceinline__ void transpose_wg_item(const Ctx& c, const float* W, int K, int N, bf16_t* WT, const float* gain, int item) {
    const int nblk = N / 256, kb = item / nblk, nb = item % nblk, k0 = 64 * kb, n0 = 256 * nb;
    float* T = (float*)c.lds;
    f32x4 v[8];
#pragma unroll
    for (int i = 0; i < 8; ++i) { const int idx = i * 512 + c.tid, row = idx >> 6, c4 = idx & 63; v[i] = *(const f32x4*)(W + (size_t)(k0 + row) * N + n0 + 4 * c4); }
#pragma unroll
    for (int i = 0; i < 8; ++i) { const int idx = i * 512 + c.tid, row = idx >> 6, c4 = idx & 63; const float gg = gain ? gain[k0 + row] : 1.f; float* s = T + row * 257 + 4 * c4;
        s[0] = v[i][0] * gg; s[1] = v[i][1] * gg; s[2] = v[i][2] * gg; s[3] = v[i][3] * gg; }
    __syncthreads();
#pragma unroll
    for (int j = 0; j < 4; ++j) { const int id = j * 512 + c.tid, n = id >> 3, cc = id & 7; const float* s = T + (8 * cc) * 257 + n;
        u32x4 o; o.x = pk2(s[0 * 257], s[1 * 257]); o.y = pk2(s[2 * 257], s[3 * 257]); o.z = pk2(s[4 * 257], s[5 * 257]); o.w = pk2(s[6 * 257], s[7 * 257]);
        *(u32x4*)(WT + (size_t)(n0 + n) * K + k0 + 8 * cc) = o; }
    __syncthreads();
}
__device__ __forceinline__ void cvt_range(const Ctx& c, const float* src, bf16_t* dst, size_t n) {
    const size_t nv = n / 8, stride = (size_t)c.nblk * 512;
    for (size_t v0 = (size_t)c.blk * 512 + c.tid; v0 < nv; v0 += 4 * stride) {
        f32x4 a[4], b[4];
#pragma unroll
        for (int u = 0; u < 4; ++u) { const size_t v = v0 + u * stride < nv ? v0 + u * stride : v0; a[u] = *(const f32x4*)(src + v * 8); b[u] = *(const f32x4*)(src + v * 8 + 4); }
#pragma unroll
        for (int u = 0; u < 4; ++u) { const size_t v = v0 + u * stride; if (v < nv) { u32x4 o; o.x = pk2(a[u][0], a[u][1]); o.y = pk2(a[u][2], a[u][3]); o.z = pk2(b[u][0], b[u][1]); o.w = pk2(b[u][2], b[u][3]);
            *(u32x4*)(dst + v * 8) = o; } }
    }
}
__device__ __forceinline__ void ssm_tables_unit(const Ctx& c, const Args& a, int layer, int g, int part, int nparts) {
    float* Apow = (float*)c.lds;
    float* Bre = Apow + 2 * 33 * 64 * 2;
    float* Bim = Bre + 2 * 64 * 16;
    float* Cre = Bim + 2 * 64 * 16;
    float* Cim = Cre + 2 * 16 * 64;
    float* Tt = Cim + 2 * 16 * 64;
    unsigned char* lw = a.ws + WS_LW + (size_t)layer * LW_STRIDE;
    float* AL = (float*)(lw + LW_AL);
    bf16_t* WE = (bf16_t*)(lw + LW_WE) + (size_t)g * 256 * 512;
    bf16_t* WY = (bf16_t*)(lw + LW_WY) + (size_t)g * 512 * KCAT;
    const int tid = c.tid;
    unsigned char* rgn_ws = a.ws; (void)rgn_ws;
    __syncthreads();
    RGN(11, 0);
    if (tid < 128) {
        const int dir = tid >> 6, n = tid & 63; const int ldg = (layer * 2 + dir) * NG + g;
        const float lre = a.in[I_LRE][ldg * 64 + n], lim = a.in[I_LIM][ldg * 64 + n];
        const float dt = expf(a.in[I_LOGDT][ldg]);
        { const float dec = expf(lre * dt); float sn, cs; sincosf(lim * dt, &sn, &cs); const float a1r = dec * cs, a1i = dec * sn;
          float pr = 1.f, pi = 0.f;
          for (int k = 0; k <= 32; ++k) { Apow[((dir * 33 + k) * 64 + n) * 2 + 0] = pr; Apow[((dir * 33 + k) * 64 + n) * 2 + 1] = pi;
              const float nr_ = pr * a1r - pi * a1i, ni_ = pr * a1i + pi * a1r; pr = nr_; pi = ni_; } }
        const float abr = Apow[((dir * 33 + 1) * 64 + n) * 2 + 0], abi = Apow[((dir * 33 + 1) * 64 + n) * 2 + 1];
        const float den = lre * lre + lim * lim, nr = abr - 1.f;
        const float fre = (nr * lre + abi * lim) / den, fim = (abi * lre - nr * lim) / den;
        for (int q = 0; q < 16; ++q) { const float br = a.in[I_BRE][(ldg * 64 + n) * 16 + q], bi = a.in[I_BIM][(ldg * 64 + n) * 16 + q];
            Bre[(dir * 64 + n) * 16 + q] = fre * br - fim * bi; Bim[(dir * 64 + n) * 16 + q] = fre * bi + fim * br; }
        for (int p = 0; p < 16; ++p) { Cre[(dir * 16 + p) * 64 + n] = a.in[I_CRE][(ldg * 16 + p) * 64 + n]; Cim[(dir * 16 + p) * 64 + n] = a.in[I_CIM][(ldg * 16 + p) * 64 + n]; }
        if (part == 0) { AL[((dir * NG + g) * 64 + n) * 2 + 0] = Apow[((dir * 33 + 32) * 64 + n) * 2 + 0];
        AL[((dir * NG + g) * 64 + n) * 2 + 1] = Apow[((dir * 33 + 32) * 64 + n) * 2 + 1]; }
    }
    __syncthreads();
    RGN(11, 1); RGN(12, 0);
    const int kk_lo = nparts == 4 ? 8 * part : 0, nkk = nparts == 4 ? 39 : 63;
    {
        const int l15 = c.lane & 15, l4 = c.lane >> 4;
      for (int kb0 = 0; kb0 < nkk; kb0 += 40) {
        f32x4 accs[5]; int ks[5]; bool val[5];
#pragma unroll
        for (int i = 0; i < 5; ++i) { const int kx = kb0 + c.wave + 8 * i; val[i] = kx < nkk; ks[i] = kk_lo + (val[i] ? kx : 0) - 31; accs[i] = (f32x4){0.f, 0.f, 0.f, 0.f}; }
#pragma unroll 2
        for (int st = 0; st < 32; ++st) {
            const int kidx = 4 * st + l4, n = kidx & 63; const bool lo = kidx < 64;
            const float cr0 = Cre[l15 * 64 + n], ci0 = Cim[l15 * 64 + n], cr1 = Cre[(16 + l15) * 64 + n], ci1 = Cim[(16 + l15) * 64 + n];
            const float b0 = lo ? Bre[n * 16 + l15] : Bim[n * 16 + l15], b1 = lo ? Bre[(64 + n) * 16 + l15] : Bim[(64 + n) * 16 + l15];
#pragma unroll
            for (int i = 0; i < 5; ++i) {
                const int dir = ks[i] < 0 ? 1 : 0, e = ks[i] < 0 ? -ks[i] : ks[i];
                const float ar = Apow[((dir * 33 + e) * 64 + n) * 2 + 0], ai = Apow[((dir * 33 + e) * 64 + n) * 2 + 1];
                const float cr = dir ? cr1 : cr0, ci = dir ? ci1 : ci0;
                const float av = lo ? (cr * ar - ci * ai) : -(cr * ai + ci * ar);
                accs[i] = __builtin_amdgcn_mfma_f32_16x16x4f32(av, dir ? b1 : b0, accs[i], 0, 0, 0);
            }
        }
#pragma unroll
        for (int i = 0; i < 5; ++i) if (val[i] && ks[i] == 0) {
#pragma unroll 4
            for (int st = 0; st < 32; ++st) {
                const int kidx = 4 * st + l4, n = kidx & 63; const bool lo = kidx < 64;
                const float cr = Cre[(16 + l15) * 64 + n], ci = Cim[(16 + l15) * 64 + n];
                const float ar = Apow[((33 + 0) * 64 + n) * 2 + 0], ai = Apow[((33 + 0) * 64 + n) * 2 + 1];
                const float av = lo ? (cr * ar - ci * ai) : -(cr * ai + ci * ar);
                const float bv = lo ? Bre[(64 + n) * 16 + l15] : Bim[(64 + n) * 16 + l15];
                accs[i] = __builtin_amdgcn_mfma_f32_16x16x4f32(av, bv, accs[i], 0, 0, 0);
            }
        }
#pragma unroll
        for (int i = 0; i < 5; ++i) if (val[i]) { const int kk = ks[i] + 31;
#pragma unroll
            for (int r = 0; r < 4; ++r) { const int p = 4 * l4 + r;
                Tt[(kk * 16 + p) * 16 + l15] = accs[i][r] + ((ks[i] == 0 && l15 == p) ? a.in[I_DSKIP][layer * 512 + 16 * g + p] : 0.f); } }
      }
    }
    __syncthreads();
    RGN(12, 1); RGN(13, 0);
    const int wy_lo = (512 * 96 / nparts) * part, wy_hi = wy_lo + 512 * 96 / nparts, we_lo = (256 * 64 / nparts) * part, we_hi = we_lo + 256 * 64 / nparts;
    for (int it = wy_lo + tid; it < wy_hi; it += 512) {
        const int nout = it / 96, kin0 = (it % 96) * 8, j = nout >> 4, p = nout & 15;
        float v[8];
        if (kin0 < 512) { const int s = kin0 >> 4, q0 = kin0 & 15, kk = j - s + 31;
#pragma unroll
            for (int i = 0; i < 8; ++i) v[i] = Tt[(kk * 16 + p) * 16 + q0 + i]; }
        else { const int comp = kin0 - 512, dir = comp >> 7, reim = (comp >> 6) & 1, n0 = comp & 63, e = dir == 0 ? j + 1 : 32 - j;
#pragma unroll
            for (int i = 0; i < 8; ++i) { const int n = n0 + i; const float cr = Cre[(dir * 16 + p) * 64 + n], ci = Cim[(dir * 16 + p) * 64 + n];
                const float ar = Apow[((dir * 33 + e) * 64 + n) * 2 + 0], ai = Apow[((dir * 33 + e) * 64 + n) * 2 + 1];
                v[i] = reim == 0 ? (cr * ar - ci * ai) : -(cr * ai + ci * ar); } }
        u32x4 o; o.x = pk2(v[0], v[1]); o.y = pk2(v[2], v[3]); o.z = pk2(v[4], v[5]); o.w = pk2(v[6], v[7]);
        *(u32x4*)(WY + (size_t)nout * KCAT + kin0) = o;
    }
    for (int it = we_lo + tid; it < we_hi; it += 512) {
        const int comp = it >> 6, kin0 = (it & 63) * 8, j = kin0 >> 4, q0 = kin0 & 15, dir = comp >> 7, reim = (comp >> 6) & 1, n = comp & 63, e = dir == 0 ? 31 - j : j;
        const float ar = Apow[((dir * 33 + e) * 64 + n) * 2 + 0], ai = Apow[((dir * 33 + e) * 64 + n) * 2 + 1];
        float v[8];
#pragma unroll
        for (int i = 0; i < 8; ++i) { const float br = Bre[(dir * 64 + n) * 16 + q0 + i], bi = Bim[(dir * 64 + n) * 16 + q0 + i]; v[i] = reim == 0 ? (ar * br - ai * bi) : (ar * bi + ai * br); }
        u32x4 o; o.x = pk2(v[0], v[1]); o.y = pk2(v[2], v[3]); o.z = pk2(v[4], v[5]); o.w = pk2(v[6], v[7]);
        *(u32x4*)(WE + (size_t)comp * 512 + kin0) = o;
    }
    __syncthreads();
    RGN(13, 1);
}
__device__ __forceinline__ void cvt_fp8_layer(const Ctx& c, const Args& a, int layer, int widx, int nw) {
    for (int r0 = widx; r0 < 2 * 16384; r0 += 4 * nw) {
      f32x4 vq[4][4];
#pragma unroll
      for (int u = 0; u < 4; ++u) { const int q = r0 + u * nw < 2 * 16384 ? r0 + u * nw : r0; const int tab = q >> 14, rr = layer * 16384 + (q & 16383);
          const float* srcp = (tab ? a.in[I_EV] : a.in[I_EU]) + (size_t)rr * D + 16 * c.lane;
#pragma unroll
          for (int j = 0; j < 4; ++j) vq[u][j] = *(const f32x4*)(srcp + 4 * j); }
#pragma unroll
      for (int u = 0; u < 4; ++u) {
        const int q = r0 + u * nw; if (q >= 2 * 16384) break;
        const int tab = q >> 14, rr = layer * 16384 + (q & 16383), r = tab * 32768 + rr;
        f32x4 v[4]; float mx = 0.f;
#pragma unroll
        for (int j = 0; j < 4; ++j) { v[j] = vq[u][j]; mx = fmaxf(mx, fmaxf(fmaxf(fabsf(v[j][0]), fabsf(v[j][1])), fmaxf(fabsf(v[j][2]), fabsf(v[j][3])))); }
        mx = wave_max(mx);
        const float sc = mx > 0.f ? 448.f / mx : 1.f;
        u32x4 o;
#pragma unroll
        for (int j = 0; j < 4; ++j) { int w = 0;
            w = __builtin_amdgcn_cvt_pk_fp8_f32(fminf(fmaxf(v[j][0] * sc, -448.f), 448.f), fminf(fmaxf(v[j][1] * sc, -448.f), 448.f), w, false);
            w = __builtin_amdgcn_cvt_pk_fp8_f32(fminf(fmaxf(v[j][2] * sc, -448.f), 448.f), fminf(fmaxf(v[j][3] * sc, -448.f), 448.f), w, true);
            o[j] = (unsigned)w; }
        *(u32x4*)(a.ws + (tab ? WS_EV : WS_EU) + (size_t)rr * D + 16 * c.lane) = o;
        if (c.lane == 0) ((float*)(a.ws + WS_ESC))[r] = mx > 0.f ? mx * (1.f / 448.f) : 1.f;
      }
    }
}
__device__ __forceinline__ void p0_prologue(const Ctx& c, const Args& a) {
    unsigned char* rgn_ws = a.ws; (void)rgn_ws; RGN(4, 0);
    const bool ssm_first = (c.blk & 1) == 0;
#define P0_SSM() do { const int np = c.nblk >= 256 ? 4 : 1;     \
      for (int u = c.blk; u < 2 * NG * np; u += c.nblk) ssm_tables_unit(c, a, (u / np) / NG, (u / np) % NG, u % np, np); } while (0)
    if (ssm_first) P0_SSM();
    RGN(4, 1); RGN(5, 0);
    const int gw = c.blk * 8 + c.wave, NGW = c.nblk * 8;
    {
        constexpr int I0 = 80, I1 = 16, I2 = 64, I3 = 128, I4 = 64, I5 = 16, IL = I0 + I1 + I2 + I3 + I4 + I5;
        __syncthreads();
        for (int it = c.blk; it < 2 * IL; it += c.nblk) {
            const int L = it / IL; int r = it % IL; unsigned char* lw = a.ws + WS_LW + (size_t)L * LW_STRIDE;
            if (r < I0) { transpose_wg_item(c, a.in[I_WIN] + (size_t)L * D * DIN, D, DIN, (bf16_t*)(lw + LW_WIN), a.in[I_NMIXG] + L * D, r); continue; } r -= I0;
            if (r < I1) { transpose_wg_item(c, a.in[I_WGLU] + (size_t)L * 512 * 512, 512, 512, (bf16_t*)(lw + LW_WGLU), nullptr, r); continue; } r -= I1;
            if (r < I2) { const int k0 = 64 * (r / 4); const float* gn = k0 < 512 ? a.in[I_SSMG] + L * 512 : a.in[I_ATTG] + L * 512 - 512;
                transpose_wg_item(c, a.in[I_WOUT] + (size_t)L * D * D, D, D, (bf16_t*)(lw + LW_WOUT), gn, r); continue; } r -= I2;
            if (r < I3) { transpose_wg_item(c, a.in[I_WQ] + (size_t)L * D * 2048, D, 2048, (bf16_t*)(lw + LW_WQ), a.in[I_NFFNG] + L * D, r); continue; } r -= I3;
            if (r < I4) { transpose_wg_item(c, a.in[I_WGATE] + (size_t)L * D * D, D, D, (bf16_t*)(lw + LW_WGATE), a.in[I_NPLEG] + L * D, r); continue; } r -= I4;
            transpose_wg_item(c, a.in[I_WPROJ] + (size_t)L * 256 * D, 256, D, (bf16_t*)(lw + LW_WPROJ), nullptr, r);
        }
    }
    RGN(5, 1); RGN(6, 0);
    cvt_fp8_layer(c, a, 0, gw, NGW);
    if (c.nblk != 256) cvt_fp8_layer(c, a, 1, gw, NGW);
    RGN(6, 1); RGN(7, 0);
    cvt_range(c, a.in[I_P], (bf16_t*)(a.ws + WS_PB), (size_t)2 * M * 256);
    for (int L = 0; L < 2; ++L) {
        cvt_range(c, a.in[I_SK1] + (size_t)L * 8 * 128 * 128, (bf16_t*)(a.ws + WS_LW + (size_t)L * LW_STRIDE + LW_SK1), (size_t)8 * 128 * 128);
        cvt_range(c, a.in[I_SK2] + (size_t)L * 8 * 128 * 128, (bf16_t*)(a.ws + WS_LW + (size_t)L * LW_STRIDE + LW_SK2), (size_t)8 * 128 * 128);
    }
    RGN(7, 1); RGN(8, 0);
    {
        bf16_t* XB = (bf16_t*)(a.ws + WS_XB); float* SSQ0 = (float*)(a.ws + WS_SSQ0);
        for (int m0 = gw; m0 < M; m0 += 4 * NGW) {
            f32x4 v[4][4];
#pragma unroll
            for (int u = 0; u < 4; ++u) { const int m = m0 + u * NGW < M ? m0 + u * NGW : m0; const f32x4* xr = (const f32x4*)(a.in[I_X] + (size_t)m * D) + c.lane;
#pragma unroll
                for (int j = 0; j < 4; ++j) v[u][j] = xr[64 * j]; }
#pragma unroll
            for (int u = 0; u < 4; ++u) { const int m = m0 + u * NGW; if (m >= M) break; float s = 0.f;
#pragma unroll
                for (int j = 0; j < 4; ++j) { const f32x4 w = v[u][j]; const u32x2 o = pack4(w); *(u32x2*)(XB + (size_t)m * D + 256 * j + 4 * c.lane) = o;
                    const float y0 = bflo(o.x), y1 = bfhi(o.x), y2 = bflo(o.y), y3 = bfhi(o.y); s += y0 * y0 + y1 * y1 + y2 * y2 + y3 * y3; }
                s = wave_sum(s);
                if (c.lane < 16) SSQ0[(size_t)m * 16 + c.lane] = c.lane == 0 ? s : 0.f; }
        }
    }
    RGN(8, 1);
    if (!ssm_first) P0_SSM();
#undef P0_SSM
    if (c.blk == c.nblk - 1) {
        float* R = (float*)(a.ws + WS_ROPE);
        for (int e = c.tid; e < 3072; e += 512) {
            const bool isr = e < 2048; const int pos = isr ? (e >> 4) : ((e - 2048) >> 4), f = e & 15;
            const float inv = powf(10000.f, -(float)f / 16.f), ang = (float)pos * inv; float sn, cs; sincosf(ang, &sn, &cs);
            if (isr) { R[e] = cs; R[2048 + e] = sn; } else { R[4096 + (e - 2048)] = cs; R[5120 + (e - 2048)] = sn; }
        }
    }
}

__device__ __forceinline__ void s1_unit(const Ctx& c, const Args& a, int layer, int gb  ) {
    unsigned char* lw = a.ws + WS_LW + (size_t)layer * LW_STRIDE;
    bf16_t* UC = (bf16_t*)(a.ws + WS_UCAT); float* EB = (float*)(a.ws + WS_EBUF);
    const int g = gb >> 1;
    GemmD gd; gd.A = UC; gd.lda = KCAT; gd.Bt = (const bf16_t*)(lw + LW_WE); gd.ldb = 512; gd.K = 512; gd.kmid = -1;
    EpiS1 E; E.ebuf = EB;
    Unit u; u.pm = gb; u.pn = g;
    unsigned char* rgn_ws = a.ws; (void)rgn_ws; if (layer == 0) RGN(1, 0);
#ifdef USE_SGEMM
    sgemm_unit(gd, u, E, c.wave, c.lane);
#else
    { pg8::OneUnit S; S.u = u; run_gemm(c.lds, gd, S, E, c.tid); }
#endif
    VM_WAIT(); __syncthreads();
    if (layer == 0) { RGN(1, 1); RGN(2, 0); }
    {
        const float* AL = (const float*)(lw + LW_AL);
        f32x4* Es4 = (f32x4*)c.lds; const float* Es = (const float*)c.lds;
        float* SEG = (float*)(c.lds + LDSCTL_OFF + 1024);
        const int n = c.lane, sg = c.wave;
        for (int dir = 0; dir < 2; ++dir) {
            {
#pragma unroll 1
                for (int k0 = 0; k0 < 16; k0 += 8) { f32x4 ev[8];
#pragma unroll
                    for (int k = 0; k < 8; ++k) { const int i = c.tid + 512 * (k0 + k), ch = i >> 5, q4 = i & 31; ev[k] = *(const f32x4*)(EB + ((size_t)gb * NCH + ch) * 256 + dir * 128 + q4 * 4); }
#pragma unroll
                    for (int k = 0; k < 8; ++k) Es4[c.tid + 512 * (k0 + k)] = ev[k]; }
            }
            __syncthreads();
            const float alr = AL[((dir * NG + g) * 64 + n) * 2 + 0], ali = AL[((dir * NG + g) * 64 + n) * 2 + 1];
            float hr = 0.f, hi = 0.f, pr = 1.f, pi = 0.f;
#pragma unroll 8
            for (int s = 0; s < 32; ++s) {
                const int st = sg * 32 + s, ch = dir == 0 ? st : NCH - 1 - st;
                const float er = Es[ch * 128 + n], ei = Es[ch * 128 + 64 + n];
                const float nr = alr * hr - ali * hi + er, ni = alr * hi + ali * hr + ei; hr = nr; hi = ni;
                const float qr = pr * alr - pi * ali, qi = pr * ali + pi * alr; pr = qr; pi = qi;
            }
            SEG[(sg * 64 + n) * 2] = hr; SEG[(sg * 64 + n) * 2 + 1] = hi;
            __syncthreads();
            float sr = 0.f, si = 0.f;
            for (int j = 0; j < sg; ++j) { const float er = SEG[(j * 64 + n) * 2], ei = SEG[(j * 64 + n) * 2 + 1];
                const float nr = pr * sr - pi * si + er, ni = pr * si + pi * sr + ei; sr = nr; si = ni; }
            hr = sr; hi = si;
            bf16_t* hc = UC + (size_t)gb * NCH * KCAT + 512 + dir * 128 + n;
#pragma unroll 8
            for (int s = 0; s < 32; ++s) {
                const int st = sg * 32 + s, ch = dir == 0 ? st : NCH - 1 - st;
                hc[(size_t)ch * KCAT] = (bf16_t)f2bf(hr); hc[(size_t)ch * KCAT + 64] = (bf16_t)f2bf(hi);
                const float er = Es[ch * 128 + n], ei = Es[ch * 128 + 64 + n];
                const float nr = alr * hr - ali * hi + er, ni = alr * hi + ali * hr + ei; hr = nr; hi = ni;
            }
            __syncthreads();
        }
    }
    if (layer == 0) RGN(2, 1);
}
constexpr int QKP_N = 8;
__device__ __forceinline__ void qkprep(const Ctx& c, const Args& a, int layer, int widx, int nw, int mode = 0, int tok0 = 0) {
    bf16_t* QR = (bf16_t*)(a.ws + WS_QRAW); bf16_t* KV = (bf16_t*)(a.ws + WS_KV); const float* R = (const float*)(a.ws + WS_ROPE);
    const int half = c.lane >> 5, i = c.lane & 31, f = i & 15;
    const int d = i < 16 ? i : 32 + (i - 16);
    unsigned char* rgn_ws = a.ws; (void)rgn_ws; if (layer == 0) RGN(3, 0);
    const float gq1 = a.in[I_QNG][layer * 64 + d], gq2 = a.in[I_QNG][layer * 64 + d + 16], gk1 = a.in[I_KNG][layer * 64 + d], gk2 = a.in[I_KNG][layer * 64 + d + 16];
    const int nitems = mode == 0 ? M * 5 : mode == 1 ? M * 4 : 256;
    for (int base = widx; base < nitems; base += QKP_N * nw) {
        bf16_t* p[QKP_N]; float x1[QKP_N], x2[QKP_N], cs[QKP_N], sn[QKP_N]; int hh[QKP_N]; bool ok[QKP_N];
#pragma unroll
        for (int u = 0; u < QKP_N; ++u) {
            int it = base + u * nw; ok[u] = it < nitems; if (!ok[u]) it = base;
            const int m = mode == 0 ? it / 5 : mode == 1 ? it >> 2 : tok0 + it; hh[u] = (mode == 0 ? it % 5 : mode == 1 ? (it & 3) : 4) * 2 + half;
            p[u] = hh[u] < 8 ? QR + (size_t)m * 512 + hh[u] * 64 : KV + (size_t)m * 256 + (hh[u] - 8) * 64;
            x1[u] = bf1(p[u][d]); x2[u] = bf1(p[u][d + 16]);
            const int s = m & (SEQ - 1);
            if (i < 16) { const int pos = s >> 6; cs[u] = R[pos * 16 + f]; sn[u] = R[2048 + pos * 16 + f]; }
            else { const int pos = s & 63; cs[u] = R[4096 + pos * 16 + f]; sn[u] = R[5120 + pos * 16 + f]; }
        }
#pragma unroll
        for (int u = 0; u < QKP_N; ++u) {
            float ss = x1[u] * x1[u] + x2[u] * x2[u];
#pragma unroll
            for (int o = 1; o < 32; o <<= 1) ss += __shfl_xor(ss, o);
            const float rstd = rsqrtf(ss * (1.f / 64.f) + EPS);
            const float y1 = x1[u] * rstd * (hh[u] < 8 ? gq1 : gk1), y2 = x2[u] * rstd * (hh[u] < 8 ? gq2 : gk2);
            float o1 = y1 * cs[u] - y2 * sn[u], o2 = y2 * cs[u] + y1 * sn[u];
            if (hh[u] < 8) { o1 *= C2; o2 *= C2; }
            if (ok[u]) { p[u][d] = (bf16_t)f2bf(o1); p[u][d + 16] = (bf16_t)f2bf(o2); }
        }
    }
    if (layer == 0) RGN(3, 1);
}

#include <hip/hip_bf16.h>
#include <cmath>
namespace attn_body {
using bf16=__hip_bfloat16;
using bf16x8=__attribute__((ext_vector_type(8)))short;
using s16x4=__attribute__((ext_vector_type(4)))short;
using f32x16=__attribute__((ext_vector_type(16)))float;
using u32x4=__attribute__((ext_vector_type(4)))unsigned;
constexpr int SEQ=8192,D=64,QPITCH=512,KVPITCH=256,OPITCH=1024;
constexpr int NW=8,QBLK=32,QB=QBLK*NW,KVBLK=64,NQB=SEQ/QB;
__device__ __forceinline__ int crow(int r,int hi){return (r&3)+8*(r>>2)+4*hi;}
#define SBAR() __builtin_amdgcn_sched_barrier(0)
__device__ __forceinline__ void cmask(f32x16&p0,f32x16&p1,int jb,int qrel,int hi){
  const float NEG=-INFINITY; int kb=64*jb+4*hi;
  #pragma unroll
  for(int r=0;r<16;++r){int kv=kb+(r&3)+8*(r>>2); if(kv>qrel)p0[r]=NEG; if(kv+32>qrel)p1[r]=NEG;}
}

constexpr int NSLOT=3, SLOTB=8192;
constexpr int LDS_K=0, LDS_V=NSLOT*SLOTB, LDS_WS=2*NSLOT*SLOTB, LDS_OST=LDS_WS+NW*64*4, LDS_BYTES=LDS_OST+NW*4096;
constexpr float C2=0.125f*1.4426950408889634f;
__device__ __forceinline__ void glds16(const void*gsrc,unsigned lds_dst){unsigned keep;
  asm volatile("s_mov_b32 %0, m0\n\ts_mov_b32 m0, %2\n\ts_nop 0\n\tglobal_load_lds_dwordx4 %1, off\n\ts_mov_b32 m0, %0":"=&s"(keep):"v"(gsrc),"s"(lds_dst):"memory");}
__device__ __forceinline__ float max3f(float a,float b,float c){float r;asm("v_max3_f32 %0, %1, %2, %3":"=v"(r):"v"(a),"v"(b),"v"(c));return r;}
__device__ __forceinline__ float max2f(float a,float b){float r;asm("v_max_f32_e32 %0, %1, %2":"=v"(r):"v"(a),"v"(b));return r;}
__device__ __forceinline__ float fadd_s(float a,float b){float r;asm("v_add_f32_e32 %0, %1, %2":"=v"(r):"v"(a),"v"(b));return r;}
__device__ __forceinline__ float fsub_s(float a,float b){float r;asm("v_sub_f32_e32 %0, %1, %2":"=v"(r):"v"(a),"v"(b));return r;}
typedef float f32x2_t __attribute__((ext_vector_type(2))); typedef __bf16 bf16x2_t __attribute__((ext_vector_type(2)));
__device__ __forceinline__ unsigned cvtpk_s(float lo,float hi){f32x2_t v={lo,hi};bf16x2_t b=__builtin_convertvector(v,bf16x2_t);return __builtin_bit_cast(unsigned,b);}
#define WAIT_BAR(N) asm volatile("s_waitcnt vmcnt(" #N ") lgkmcnt(0)\n\ts_barrier":::"memory")

__device__ __forceinline__ void qkt(f32x16&p0,f32x16&p1,const char*Kslot,const bf16x8*qr,const f32x16&negm,int r32,int hi){
  const char*kb=Kslot+hi*1024+r32*16;
  #pragma unroll
  for(int d0=0;d0<4;++d0){
    const bf16x8 b0=*reinterpret_cast<const bf16x8*>(kb+d0*2048);
    const bf16x8 b1=*reinterpret_cast<const bf16x8*>(kb+d0*2048+512);
    if(d0==0){p0=__builtin_amdgcn_mfma_f32_32x32x16_bf16(b0,qr[0],negm,0,0,0);p1=__builtin_amdgcn_mfma_f32_32x32x16_bf16(b1,qr[0],negm,0,0,0);}
    else{p0=__builtin_amdgcn_mfma_f32_32x32x16_bf16(b0,qr[d0],p0,0,0,0);p1=__builtin_amdgcn_mfma_f32_32x32x16_bf16(b1,qr[d0],p1,0,0,0);}}
}
typedef __attribute__((address_space(3))) const char* lds_cptr;
typedef short v4i16_t __attribute__((ext_vector_type(4)));
__device__ __forceinline__ void kload8(bf16x8*kf,lds_cptr kp){
  kf[0]=*(const __attribute__((address_space(3))) bf16x8*)(kp);      kf[1]=*(const __attribute__((address_space(3))) bf16x8*)(kp+512);
  kf[2]=*(const __attribute__((address_space(3))) bf16x8*)(kp+2048); kf[3]=*(const __attribute__((address_space(3))) bf16x8*)(kp+2560);
  kf[4]=*(const __attribute__((address_space(3))) bf16x8*)(kp+4096); kf[5]=*(const __attribute__((address_space(3))) bf16x8*)(kp+4608);
  kf[6]=*(const __attribute__((address_space(3))) bf16x8*)(kp+6144); kf[7]=*(const __attribute__((address_space(3))) bf16x8*)(kp+6656);
}
__device__ __forceinline__ void kload2(bf16x8*kf,lds_cptr kp,int j){ kf[2*j]=*(const __attribute__((address_space(3))) bf16x8*)(kp+j*2048); kf[2*j+1]=*(const __attribute__((address_space(3))) bf16x8*)(kp+j*2048+512); }
__device__ __forceinline__ s16x4 vtr(lds_cptr p){ return __builtin_bit_cast(s16x4,__builtin_amdgcn_ds_read_tr16_b64_v4i16((__attribute__((address_space(3))) v4i16_t*)p)); }
__device__ __forceinline__ float rowmax(const f32x16&p0,const f32x16&p1){
  float a=max3f(p0[0],p0[1],p1[0]),b=max3f(p0[2],p0[3],p1[1]);a=max3f(a,p1[2],p1[3]);
  #pragma unroll
  for(int r=4;r<16;r+=4){a=max3f(a,p0[r],p0[r+1]);b=max3f(b,p0[r+2],p0[r+3]);a=max3f(a,p1[r],p1[r+1]);b=max3f(b,p1[r+2],p1[r+3]);}
  const float m=max2f(a,b);
  auto rr=__builtin_amdgcn_permlane32_swap(__float_as_uint(m),__float_as_uint(m),false,false);
  return max2f(__uint_as_float(rr[0]),__uint_as_float(rr[1]));
}
__device__ __forceinline__ void pv(f32x16*o,int vb,bf16x8 pa0,bf16x8 pa1,bf16x8 pa2,bf16x8 pa3){
  #pragma unroll
  for(int d0=0;d0<2;++d0){s16x4 lo[4],hi[4];
    #pragma unroll
    for(int ks=0;ks<4;++ks){
      asm volatile("ds_read_b64_tr_b16 %0,%1 offset:%c2":"=&v"(lo[ks]):"v"(vb),"i"(d0*4096+ks*1024):"memory");
      asm volatile("ds_read_b64_tr_b16 %0,%1 offset:%c2":"=&v"(hi[ks]):"v"(vb),"i"(d0*4096+ks*1024+512):"memory");}
    asm volatile("s_waitcnt lgkmcnt(0)":::"memory");SBAR();
    #define PK(k) (bf16x8){lo[k][0],lo[k][1],lo[k][2],lo[k][3],hi[k][0],hi[k][1],hi[k][2],hi[k][3]}
    o[d0]=__builtin_amdgcn_mfma_f32_32x32x16_bf16(pa0,PK(0),o[d0],0,0,0);
    o[d0]=__builtin_amdgcn_mfma_f32_32x32x16_bf16(pa1,PK(1),o[d0],0,0,0);
    o[d0]=__builtin_amdgcn_mfma_f32_32x32x16_bf16(pa2,PK(2),o[d0],0,0,0);
    o[d0]=__builtin_amdgcn_mfma_f32_32x32x16_bf16(pa3,PK(3),o[d0],0,0,0);
    #undef PK
  }
}

#ifndef ATTN_STORE16
#define ATTN_STORE16(p,v) (*(u32x4*)(p)=(v))
#endif
template<int THRL> __device__ __forceinline__ void attn_unit(int b,int h,int qb,const bf16*Q,const bf16*KV,bf16*O,float*SSQA,char*shm,const int tid,const float mfix){
  const int lane=tid&63,r32=lane&31,hi=lane>>5; const int wid=__builtin_amdgcn_readfirstlane(tid>>6);
  const long rowbase=(long)b*SEQ; const int q0=qb*QB;
  const bf16*Qw=Q+(rowbase+q0+wid*QBLK)*QPITCH+h*D;
  const bf16*Kh=KV+rowbase*KVPITCH+(h>>2)*D,*Vh=Kh+128;
  const unsigned lds0=(unsigned)(uintptr_t)shm;
  float*wsf=(float*)(shm+LDS_WS)+wid*64;
  const bf16*ksrc=Kh+(long)lane*KVPITCH+wid*8;
  const bf16*vsrc=Vh+(long)(16*(wid&3)+(lane>>2))*KVPITCH+(wid>>2)*32+(lane&3)*8;
  const unsigned kdst=lds0+LDS_K+wid*1024, vdst=lds0+LDS_V+wid*1024;
  #define DMA_K(t,slot) glds16(ksrc+(long)(t)*KVBLK*KVPITCH,(unsigned)__builtin_amdgcn_readfirstlane(kdst+(slot)))
  #define DMA_V(t,slot) glds16(vsrc+(long)(t)*KVBLK*KVPITCH,(unsigned)__builtin_amdgcn_readfirstlane(vdst+(slot)))
  const int vb0=(int)(lds0+LDS_V)+((lane>>4)&1)*32+(lane&3)*8+(4*hi+((lane&15)>>2))*64;
  const char*Kbase=shm+LDS_K; bf16x8 kf[8];
  const lds_cptr shm3=(lds_cptr)shm; const lds_cptr kp0=shm3+LDS_K+hi*1024+r32*16; const lds_cptr vp0=shm3+LDS_V+((lane>>4)&1)*32+(lane&3)*8+(4*hi+((lane&15)>>2))*64;
  const int NT=SEQ/KVBLK;
  DMA_K(0,0);DMA_V(0,0);DMA_K(1,SLOTB);
  bf16x8 qr[4];
  #pragma unroll
  for(int d0=0;d0<4;++d0)qr[d0]=*reinterpret_cast<const bf16x8*>(&Qw[(long)r32*QPITCH+d0*16+hi*8]);
  float mhat=0.f,l_reg=0.f;f32x16 o[2];f32x16 negm;{float z_=0.f;asm volatile("":"+v"(z_));
  #pragma unroll
  for(int r=0;r<16;++r){o[0][r]=z_;o[1][r]=z_;negm[r]=(THRL<0)?(z_-mfix):z_;}}asm volatile("":"+v"(negm)); if(THRL<0)mhat=mfix;
  #define CMASK(P0,P1,t) do{}while(0)
  bool resc=false;
  #define START(P0,P1) do{ resc=false; \
    if constexpr(THRL>=0){ const float rm=rowmax(P0,P1); const float dl=rm; mhat=fadd_s(mhat,dl); \
      _Pragma("unroll") for(int r=0;r<16;++r){P0[r]=fsub_s(P0[r],dl);P1[r]=fsub_s(P1[r],dl);} \
      _Pragma("unroll") for(int r=0;r<16;++r)negm[r]=-mhat; asm volatile("":"+v"(negm)); } \
    _Pragma("unroll") for(int r=0;r<16;++r)P0[r]=__builtin_amdgcn_exp2f(P0[r]); }while(0)
  #define RESC() do{ if(resc){ asm volatile("s_waitcnt lgkmcnt(0)":::"memory"); \
      _Pragma("unroll") for(int d_=0;d_<2;++d_) _Pragma("unroll") for(int r=0;r<16;++r)o[d_][r]*=wsf[crow(r,hi)]; } }while(0)
  f32x16 pA0,pA1,pB0,pB1;
  int sl_prev=0,sl_cur=0,sl_next=SLOTB;
  #define ROT() do{sl_prev=sl_cur;sl_cur=sl_next;sl_next=(sl_next==(NSLOT-1)*SLOTB)?0:sl_next+SLOTB;}while(0)
  DMA_K(2,2*SLOTB);
  WAIT_BAR(3);
  qkt(pA0,pA1,Kbase,qr,negm,r32,hi);asm volatile("s_nop 15\n\ts_nop 7":"+v"(pA0),"+v"(pA1));CMASK(pA0,pA1,0);
  START(pA0,pA1);
  _Pragma("unroll") for(int r=0;r<16;++r)pA1[r]=__builtin_amdgcn_exp2f(pA1[r]);
  WAIT_BAR(0);
  DMA_K(3,0);DMA_V(1,SLOTB);
  ROT();
  kload8(kf,kp0+sl_cur);
  WAIT_BAR(2);
  s16x4 vlo[8],vhi[8]; u32x4 pw0,pw1,pw2,pw3;
  #define PKW(P,B) cvtpk_s(P[B],P[B+1])
  #define PAF(k) __builtin_bit_cast(bf16x8,pw##k)
  #define VFR(i) (bf16x8){vlo[i][0],vlo[i][1],vlo[i][2],vlo[i][3],vhi[i][0],vhi[i][1],vhi[i][2],vhi[i][3]}
  #define PIN(x) asm volatile("":"+v"(x))
  #define MX3(a,b,c) __builtin_fmaxf(__builtin_fmaxf((a),(b)),(c))
  #define GAPA(MF,A0,A1,A2,A3,W0,W1,PW) do{ MF; sacc+=A0; sacc+=A1; sacc+=A2; sacc+=A3; PIN(sacc); W0; W1; PIN(PW); SBAR(); }while(0)
  #define EX(v) __builtin_amdgcn_exp2f(v)
  #define GAPB(MF,X,B) do{ MF; X[B]=EX(X[B]); X[B+1]=EX(X[B+1]); X[B+2]=EX(X[B+2]); X[B+3]=EX(X[B+3]); PIN(X); SBAR(); }while(0)
  #define VRD(i) do{ vlo[i]=vtr(vp_+(((i)>>2)*4096+((i)&3)*1024)); vhi[i]=vtr(vp_+(((i)>>2)*4096+((i)&3)*1024+512)); }while(0)
  #define KRD(G,j) do{ if(G){ kload2(kf,kp0+sl_next,j); SBAR(); } }while(0)
  #define STEP(C0,C1,P0,P1,t,GK,GV,GL) do{ SBAR(); \
    const lds_cptr vp_=vp0+sl_prev; \
    VRD(0); SBAR(); float sacc=(P0[0]+P0[1]); \
    GAPA(C0=__builtin_amdgcn_mfma_f32_32x32x16_bf16(kf[0],qr[0],negm,0,0,0), P0[2],P0[3],P0[4],P0[5],     pw0[0]=PKW(P0,0), pw0[1]=PKW(P0,2), pw0); \
    VRD(4); SBAR(); GAPA(C1=__builtin_amdgcn_mfma_f32_32x32x16_bf16(kf[1],qr[0],negm,0,0,0), P0[6],P0[7],P0[8],P0[9],     pw0[2]=PKW(P0,4), pw0[3]=PKW(P0,6), pw0); \
    VRD(1); SBAR(); GAPA(C0=__builtin_amdgcn_mfma_f32_32x32x16_bf16(kf[2],qr[1],C0,0,0,0),   P0[10],P0[11],P0[12],P0[13], pw1[0]=PKW(P0,8), pw1[1]=PKW(P0,10), pw1); \
    VRD(5); SBAR(); GAPA(C1=__builtin_amdgcn_mfma_f32_32x32x16_bf16(kf[3],qr[1],C1,0,0,0),   P0[14],P0[15],P1[0],P1[1],   pw1[2]=PKW(P0,12),pw1[3]=PKW(P0,14), pw1); \
    VRD(2); SBAR(); GAPA(C0=__builtin_amdgcn_mfma_f32_32x32x16_bf16(kf[4],qr[2],C0,0,0,0),   P1[2],P1[3],P1[4],P1[5],     pw2[0]=PKW(P1,0), pw2[1]=PKW(P1,2), pw2); \
    VRD(6); SBAR(); GAPA(C1=__builtin_amdgcn_mfma_f32_32x32x16_bf16(kf[5],qr[2],C1,0,0,0),   P1[6],P1[7],P1[8],P1[9],     pw2[2]=PKW(P1,4), pw2[3]=PKW(P1,6), pw2); \
    VRD(3); SBAR(); GAPA(C0=__builtin_amdgcn_mfma_f32_32x32x16_bf16(kf[6],qr[3],C0,0,0,0),   P1[10],P1[11],P1[12],P1[13], pw3[0]=PKW(P1,8), pw3[1]=PKW(P1,10), pw3); \
    VRD(7); SBAR(); GAPA(C1=__builtin_amdgcn_mfma_f32_32x32x16_bf16(kf[7],qr[3],C1,0,0,0),   P1[14],P1[15],0.f,0.f,       pw3[2]=PKW(P1,12),pw3[3]=PKW(P1,14), pw3); \
    l_reg+=sacc; \
    if(GK){DMA_K((t)+3,sl_cur);} if(GV){DMA_V((t)+1,sl_next);} \
    CMASK(C0,C1,t); \
    if constexpr(THRL>=0){ float a=MX3(C0[0],C0[1],C1[0]),b=MX3(C0[2],C0[3],C1[1]); a=MX3(a,C1[2],C1[3]); \
      _Pragma("unroll") for(int r=4;r<16;r+=4){a=MX3(a,C0[r],C0[r+1]);b=MX3(b,C0[r+2],C0[r+3]);a=MX3(a,C1[r],C1[r+1]);b=MX3(b,C1[r+2],C1[r+3]);} \
      float rm=__builtin_fmaxf(a,b); { auto rr=__builtin_amdgcn_permlane32_swap(__float_as_uint(rm),__float_as_uint(rm),false,false); rm=__builtin_fmaxf(__uint_as_float(rr[0]),__uint_as_float(rr[1])); } \
      resc=false; \
      if(__builtin_expect(__any(rm>(float)THRL),0)){ const float dl=__builtin_fmaxf(rm,0.f); mhat+=dl; \
        _Pragma("unroll") for(int r=0;r<16;++r){C0[r]-=dl;C1[r]-=dl;} \
        _Pragma("unroll") for(int r=0;r<16;++r)negm[r]=-mhat; asm volatile("":"+v"(negm)); \
        const float f=__builtin_amdgcn_exp2f(-dl); l_reg*=f; if(hi==0)wsf[r32]=f; resc=true; } } \
    SBAR(); \
    GAPB(o[0]=__builtin_amdgcn_mfma_f32_32x32x16_bf16(PAF(0),VFR(0),o[0],0,0,0), C0,0); \
    GAPB(o[1]=__builtin_amdgcn_mfma_f32_32x32x16_bf16(PAF(0),VFR(4),o[1],0,0,0), C0,4); \
    KRD(GL,0); GAPB(o[0]=__builtin_amdgcn_mfma_f32_32x32x16_bf16(PAF(1),VFR(1),o[0],0,0,0), C0,8); \
    KRD(GL,1); GAPB(o[1]=__builtin_amdgcn_mfma_f32_32x32x16_bf16(PAF(1),VFR(5),o[1],0,0,0), C0,12); \
    KRD(GL,2); GAPB(o[0]=__builtin_amdgcn_mfma_f32_32x32x16_bf16(PAF(2),VFR(2),o[0],0,0,0), C1,0); \
    KRD(GL,3); GAPB(o[1]=__builtin_amdgcn_mfma_f32_32x32x16_bf16(PAF(2),VFR(6),o[1],0,0,0), C1,4); \
    GAPB(o[0]=__builtin_amdgcn_mfma_f32_32x32x16_bf16(PAF(3),VFR(3),o[0],0,0,0), C1,8); \
    GAPB(o[1]=__builtin_amdgcn_mfma_f32_32x32x16_bf16(PAF(3),VFR(7),o[1],0,0,0), C1,12); \
    }while(0)
  int t=1;
  #undef CMASK
  #define CMASK(P0,P1,t) do{}while(0)
  for(;t+5<NT;t+=2){
    STEP(pB0,pB1,pA0,pA1,t,true,true,true);     WAIT_BAR(2); RESC(); ROT();
    STEP(pA0,pA1,pB0,pB1,t+1,true,true,true);   WAIT_BAR(2); RESC(); ROT();
  }
  #undef CMASK
  #define CMASK(P0,P1,t) do{}while(0)
  #define ENDW(tt) do{ if((tt)+3<NT){WAIT_BAR(2);} else if((tt)+2<NT){WAIT_BAR(1);} else {WAIT_BAR(0);} }while(0)
  for(;t+1<NT;t+=2){
    STEP(pB0,pB1,pA0,pA1,t,(t+3<NT),(t+1<NT),(t+1<NT));       ENDW(t);   RESC(); ROT();
    STEP(pA0,pA1,pB0,pB1,t+1,(t+4<NT),(t+2<NT),(t+2<NT));     ENDW(t+1); RESC(); ROT();
  }
  STEP(pB0,pB1,pA0,pA1,NT-1,false,false,false); RESC();
  { float sacc=pB0[0]+pB0[1]; _Pragma("unroll") for(int r=2;r<16;++r)sacc+=pB0[r]; _Pragma("unroll") for(int r=0;r<16;++r)sacc+=pB1[r]; l_reg+=sacc;
    pw0=(u32x4){PKW(pB0,0),PKW(pB0,2),PKW(pB0,4),PKW(pB0,6)};pw1=(u32x4){PKW(pB0,8),PKW(pB0,10),PKW(pB0,12),PKW(pB0,14)};pw2=(u32x4){PKW(pB1,0),PKW(pB1,2),PKW(pB1,4),PKW(pB1,6)};pw3=(u32x4){PKW(pB1,8),PKW(pB1,10),PKW(pB1,12),PKW(pB1,14)};
    SBAR(); pv(o,vb0+sl_cur,PAF(0),PAF(1),PAF(2),PAF(3)); }
  #undef PKW
  #undef PAF
  #undef VFR
  #undef PIN
  #undef MX3
  #undef GAPA
  #undef GAPB
  #undef EX
  #undef VRD
  #undef KRD
  #undef STEP
  #undef ENDW
  {auto rr=__builtin_amdgcn_permlane32_swap(__float_as_uint(l_reg),__float_as_uint(l_reg),false,false);l_reg=__uint_as_float(rr[0])+__uint_as_float(rr[1]);}
  if(hi==0)wsf[32+r32]=l_reg;asm volatile("s_waitcnt lgkmcnt(0)":::"memory");
  float rli[16];
  #pragma unroll
  for(int r=0;r<16;++r)rli[r]=__builtin_amdgcn_rcpf(wsf[32+crow(r,hi)]);
  bf16*Ow=O+(rowbase+q0+wid*QBLK)*OPITCH+512+h*D; float*Sw=SSQA+(rowbase+q0+wid*QBLK)*16+h;
  { bf16*stg=(bf16*)(shm+LDS_OST)+wid*2048;
    #pragma unroll
    for(int r=0;r<16;++r){const int orow=crow(r,hi);
      #pragma unroll
      for(int d0=0;d0<2;++d0)stg[orow*64+d0*32+r32]=__float2bfloat16(o[d0][r]*rli[r]);}
    asm volatile("s_waitcnt lgkmcnt(0)":::"memory");
    #pragma unroll
    for(int i=0;i<4;++i){const int row=i*8+(lane>>3),ch=lane&7; const u32x4 v=*(const u32x4*)(stg+row*64+ch*8); ATTN_STORE16(Ow+(long)row*OPITCH+ch*8,v);
      float ss=0.f; for(int e=0;e<4;++e){const float lo_=__uint_as_float(v[e]<<16),hi_=__uint_as_float(v[e]&0xffff0000u); ss+=lo_*lo_+hi_*hi_;}
      ss+=__shfl_xor(ss,1); ss+=__shfl_xor(ss,2); ss+=__shfl_xor(ss,4); if(ch==0)Sw[(long)row*16]=ss; } }
  asm volatile("s_waitcnt lgkmcnt(0)\n\ts_barrier":::"memory");
  #undef DMA_K
  #undef DMA_V
  #undef CMASK
  #undef START
  #undef RESC
  #undef ROT
}
constexpr int ATTN_LDS_BYTES=LDS_BYTES;
#undef SBAR
#undef WAIT_BAR
}

#ifdef ATT_NAIVE
__device__ __forceinline__ void attn_naive_unit(const Ctx& c, const Args& a, int b, int h, int qblk) {
    const bf16_t* QR = (const bf16_t*)(a.ws + WS_QRAW); const bf16_t* KV = (const bf16_t*)(a.ws + WS_KV);
    bf16_t* Y = (bf16_t*)(a.ws + WS_Y); float* SSQA = (float*)(a.ws + WS_SSQA);
    float* Ks = (float*)c.lds; float* Vs = Ks + 64 * 64;
    const long row = (long)b * SEQ + qblk * 512 + c.tid; const int kvh = h >> 2;
    float q[64], o[64];
#pragma unroll
    for (int v = 0; v < 8; ++v) { const u32x4 w = *(const u32x4*)(QR + row * 512 + h * 64 + v * 8);
        q[v * 8 + 0] = bflo(w.x); q[v * 8 + 1] = bfhi(w.x); q[v * 8 + 2] = bflo(w.y); q[v * 8 + 3] = bfhi(w.y);
        q[v * 8 + 4] = bflo(w.z); q[v * 8 + 5] = bfhi(w.z); q[v * 8 + 6] = bflo(w.w); q[v * 8 + 7] = bfhi(w.w); }
#pragma unroll
    for (int dd = 0; dd < 64; ++dd) o[dd] = 0.f;
    float mrun = -1e30f, l = 0.f;
    const int lk = c.tid >> 3, lp = c.tid & 7;
    for (int t0 = 0; t0 < SEQ; t0 += 64) {
        __syncthreads();
        { const bf16_t* kp = KV + ((long)b * SEQ + t0 + lk) * 256 + kvh * 64 + lp * 8;
          const u32x4 kw = *(const u32x4*)kp, vw = *(const u32x4*)(kp + 128);
          float* kd = Ks + lk * 64 + lp * 8; float* vd = Vs + lk * 64 + lp * 8;
          kd[0] = bflo(kw.x); kd[1] = bfhi(kw.x); kd[2] = bflo(kw.y); kd[3] = bfhi(kw.y); kd[4] = bflo(kw.z); kd[5] = bfhi(kw.z); kd[6] = bflo(kw.w); kd[7] = bfhi(kw.w);
          vd[0] = bflo(vw.x); vd[1] = bfhi(vw.x); vd[2] = bflo(vw.y); vd[3] = bfhi(vw.y); vd[4] = bflo(vw.z); vd[5] = bfhi(vw.z); vd[6] = bflo(vw.w); vd[7] = bfhi(vw.w); }
        __syncthreads();
#pragma unroll 1
        for (int j = 0; j < 64; ++j) {
            float acc = 0.f; const float* kr = Ks + j * 64;
#pragma unroll
            for (int dd = 0; dd < 64; dd += 4) { const f32x4 kk = *(const f32x4*)(kr + dd); acc += q[dd] * kk[0] + q[dd + 1] * kk[1] + q[dd + 2] * kk[2] + q[dd + 3] * kk[3];
                if ((dd & 15) == 12) __builtin_amdgcn_sched_barrier(0); }
            if (acc > mrun) { const float sc = exp2f(mrun - acc); l *= sc; mrun = acc;
#pragma unroll
                for (int dd = 0; dd < 64; ++dd) o[dd] *= sc; }
            const float p = exp2f(acc - mrun); l += p; const float* vr = Vs + j * 64;
#pragma unroll
            for (int dd = 0; dd < 64; dd += 4) { const f32x4 vv = *(const f32x4*)(vr + dd); o[dd] += p * vv[0]; o[dd + 1] += p * vv[1]; o[dd + 2] += p * vv[2]; o[dd + 3] += p * vv[3];
                if ((dd & 15) == 12) __builtin_amdgcn_sched_barrier(0); }
        }
    }
    const float il = 1.f / l; float ss = 0.f;
#pragma unroll
    for (int v = 0; v < 8; ++v) { float t[8];
#pragma unroll
        for (int e = 0; e < 8; ++e) { t[e] = o[v * 8 + e] * il; ss += t[e] * t[e]; }
        u32x4 w; w.x = pk2(t[0], t[1]); w.y = pk2(t[2], t[3]); w.z = pk2(t[4], t[5]); w.w = pk2(t[6], t[7]);
        *(u32x4*)(Y + row * 1024 + 512 + h * 64 + v * 8) = w; }
    SSQA[row * 16 + h] = ss;
    __syncthreads();
}

#endif
template <int NV> __device__ __forceinline__ float top16(float (&v)[NV], int lane) {
    float res = -INFINITY;
    for (int it = 0; it < 16; ++it) {
        float m = v[0];
#pragma unroll
        for (int i = 1; i < NV; ++i) m = fmaxf(m, v[i]);
        m = wave_max(m);
#pragma unroll
        for (int i = 0; i < NV; ++i) if (v[i] == m) v[i] = -INFINITY;
        if (lane == it) res = m;
    }
    return res;
}
__device__ __forceinline__ float dot8(const u32x4 a, const u32x4 b) {
    return bflo(a.x) * bflo(b.x) + bfhi(a.x) * bfhi(b.x) + bflo(a.y) * bflo(b.y) + bfhi(a.y) * bfhi(b.y)
         + bflo(a.z) * bflo(b.z) + bfhi(a.z) * bfhi(b.z) + bflo(a.w) * bflo(b.w) + bfhi(a.w) * bfhi(b.w);
}
__device__ __forceinline__ void peer_topk(const Ctx& c, const Args& a, int layer, int widx, int nw) {
    const bf16_t* QP = (const bf16_t*)(a.ws + WS_QP);
    const bf16_t* SK1 = (const bf16_t*)(a.ws + WS_LW + (size_t)layer * LW_STRIDE + LW_SK1);
    const bf16_t* SK2 = (const bf16_t*)(a.ws + WS_LW + (size_t)layer * LW_STRIDE + LW_SK2);
    int* SELI = (int*)(a.ws + WS_SELI); float* SELW = (float*)(a.ws + WS_SELW);
    const int lane = c.lane;
    for (int it = widx; it < M * 8; it += nw) {
        const int t = it >> 3, h = it & 7;
        const bf16_t* qrow = QP + (size_t)t * 2048 + h * 256;
        const bf16_t* k1a = SK1 + ((size_t)(h * 128 + lane)) * 128; const bf16_t* k1b = k1a + 64 * 128;
        const bf16_t* k2a = SK2 + ((size_t)(h * 128 + lane)) * 128; const bf16_t* k2b = k2a + 64 * 128;
        float s1[2] = {0.f, 0.f}, s2[2] = {0.f, 0.f};
#pragma unroll 4
        for (int kk = 0; kk < 128; kk += 8) {
            const u32x4 q1 = *(const u32x4*)(qrow + kk), q2 = *(const u32x4*)(qrow + 128 + kk);
            s1[0] += dot8(q1, *(const u32x4*)(k1a + kk)); s1[1] += dot8(q1, *(const u32x4*)(k1b + kk));
            s2[0] += dot8(q2, *(const u32x4*)(k2a + kk)); s2[1] += dot8(q2, *(const u32x4*)(k2b + kk));
        }
        s1[0] = __uint_as_float((__float_as_uint(s1[0]) & ~127u) | (unsigned)lane); s1[1] = __uint_as_float((__float_as_uint(s1[1]) & ~127u) | (unsigned)(lane + 64));
        s2[0] = __uint_as_float((__float_as_uint(s2[0]) & ~127u) | (unsigned)lane); s2[1] = __uint_as_float((__float_as_uint(s2[1]) & ~127u) | (unsigned)(lane + 64));
        const float v1 = top16<2>(s1, lane), v2 = top16<2>(s2, lane);
        float cand[4];
#pragma unroll
        for (int mm = 0; mm < 4; ++mm) {
            const float va = __shfl(v1, (lane >> 4) + 4 * mm), vb = __shfl(v2, lane & 15);
            const unsigned ua = __float_as_uint(va), ub = __float_as_uint(vb);
            const float sum = __uint_as_float(ua & ~127u) + __uint_as_float(ub & ~127u);
            cand[mm] = __uint_as_float((__float_as_uint(sum) & ~16383u) | ((ua & 127u) << 7) | (ub & 127u));
        }
        const float best = top16<4>(cand, lane);
        const unsigned ub = __float_as_uint(best);
        const float sc = __uint_as_float(ub & ~16383u);
        const float mx = __shfl(sc, 0);
        const float e = lane < 16 ? __expf(sc - mx) : 0.f;
        const float sum = wave_sum(e);
        if (lane < 16) { SELI[(size_t)t * 128 + h * 16 + lane] = (int)(ub & 16383u); SELW[(size_t)t * 128 + h * 16 + lane] = e / sum; }
    }
}

typedef float f32x16 __attribute__((ext_vector_type(16)));
#define CE_DESC(x, y) do { const float hi__ = fmaxf(x, y), lo__ = fminf(x, y); x = hi__; y = lo__; } while (0)
__device__ __forceinline__ void sort16_desc(float (&v)[16]) {
#pragma unroll
    for (int k = 2; k <= 16; k <<= 1)
#pragma unroll
        for (int j = k >> 1; j > 0; j >>= 1)
#pragma unroll
            for (int i = 0; i < 16; ++i) { const int l = i ^ j; if (l > i) { if ((i & k) == 0) CE_DESC(v[i], v[l]); else CE_DESC(v[l], v[i]); } }
}
__device__ __forceinline__ void merge16_desc(float (&a)[16], const float (&b)[16]) {
#pragma unroll
    for (int i = 0; i < 16; ++i) a[i] = fmaxf(a[i], b[15 - i]);
#pragma unroll
    for (int j = 8; j > 0; j >>= 1)
#pragma unroll
        for (int i = 0; i < 16; ++i) { const int l = i ^ j; if (l > i) CE_DESC(a[i], a[l]); }
}
__device__ __forceinline__ void merge16_partner(float (&a)[16]) {
    float b[16];
#pragma unroll
    for (int i = 0; i < 16; ++i) b[i] = __shfl_xor(a[i], 32);
    merge16_desc(a, b);
}
__device__ __forceinline__ void peer_topk_fast(const Ctx& c, const Args& a, int layer, int widx, int nw, int only_unit = -1) {
    const bf16_t* QP = (const bf16_t*)(a.ws + WS_QP);
    const bf16_t* SK1 = (const bf16_t*)(a.ws + WS_LW + (size_t)layer * LW_STRIDE + LW_SK1);
    const bf16_t* SK2 = (const bf16_t*)(a.ws + WS_LW + (size_t)layer * LW_STRIDE + LW_SK2);
    int* SELI = (int*)(a.ws + WS_SELI); float* SELW = (float*)(a.ws + WS_SELW);
    const int lane = c.lane, tl = lane & 31, hi = lane >> 5;
    for (int unit = only_unit >= 0 ? only_unit : widx; unit < (M / 32) * 8; unit += nw) {
        const int tg = unit >> 3, h = unit & 7; const long token = (long)tg * 32 + tl;
        float vv[2][16];
#pragma unroll
        for (int half = 0; half < 2; ++half) {
            f32x16 acc[4];
#pragma unroll
            for (int t = 0; t < 4; ++t)
#pragma unroll
                for (int r = 0; r < 16; ++r) acc[t][r] = 0.f;
            const bf16_t* qb = QP + token * 2048 + h * 256 + half * 128 + 8 * hi;
            const bf16_t* kb = (half ? SK2 : SK1) + ((long)(h * 128 + tl)) * 128 + 8 * hi;
#pragma unroll 1
            for (int k4 = 0; k4 < 8; k4 += 4) {
                bf16x8 bq[4], ak[4][4];
#pragma unroll
                for (int u = 0; u < 4; ++u) { bq[u] = *(const bf16x8*)(qb + 16 * (k4 + u));
#pragma unroll
                    for (int t = 0; t < 4; ++t) ak[u][t] = *(const bf16x8*)(kb + (long)t * 32 * 128 + 16 * (k4 + u)); }
#pragma unroll
                for (int u = 0; u < 4; ++u)
#pragma unroll
                    for (int t = 0; t < 4; ++t) acc[t] = __builtin_amdgcn_mfma_f32_32x32x16_bf16(ak[u][t], bq[u], acc[t], 0, 0, 0);
            }
            float L[4][16];
#pragma unroll
            for (int t = 0; t < 4; ++t) {
#pragma unroll
                for (int r = 0; r < 16; ++r) L[t][r] = __uint_as_float((__float_as_uint(acc[t][r]) & ~127u) | (unsigned)(32 * t + (r & 3) + 8 * (r >> 2) + 4 * hi));
                sort16_desc(L[t]);
            }
            merge16_desc(L[0], L[1]); merge16_desc(L[2], L[3]); merge16_desc(L[0], L[2]);
            merge16_partner(L[0]);
#pragma unroll
            for (int i = 0; i < 16; ++i) vv[half][i] = L[0][i];
        }
        float f1[16], f2[16]; unsigned i1[16], i2[16];
#pragma unroll
        for (int i = 0; i < 16; ++i) { const unsigned u1 = __float_as_uint(vv[0][i]), u2 = __float_as_uint(vv[1][i]);
            f1[i] = __uint_as_float(u1 & ~127u); f2[i] = __uint_as_float(u2 & ~127u); i1[i] = (u1 & 127u) << 7; i2[i] = u2 & 127u; }
        float cA[16], cB[16];
#pragma unroll
        for (int i = 0; i < 16; ++i) { cA[i] = -INFINITY; cB[i] = -INFINITY; }
        {
            int n = 0;
#pragma unroll
            for (int aa = 0; aa < 16; ++aa)
#pragma unroll
                for (int bb = 0; bb < 16; ++bb) if ((aa + 1) * (bb + 1) <= 16) {
                    const float s = f1[aa] + f2[bb]; const float pk = __uint_as_float((__float_as_uint(s) & ~16383u) | i1[aa] | i2[bb]);
                    const int slot = n >> 1; const bool mine = ((n & 1) == hi);
                    if (slot < 16) cA[slot] = mine ? pk : cA[slot]; else cB[slot - 16] = mine ? pk : cB[slot - 16];
                    ++n;
                }
        }
        sort16_desc(cA); sort16_desc(cB); merge16_desc(cA, cB); merge16_partner(cA);
        float sc[16], e[16]; float sum = 0.f;
#pragma unroll
        for (int i = 0; i < 16; ++i) { sc[i] = __uint_as_float(__float_as_uint(cA[i]) & ~16383u); e[i] = __expf(sc[i] - sc[0]); sum += e[i]; }
        const float inv = 1.f / sum;
        u32x4 oi[2]; f32x4 ow[2];
#pragma unroll
        for (int i = 0; i < 8; ++i) { const float pk = hi ? cA[8 + i] : cA[i]; const float w = (hi ? e[8 + i] : e[i]) * inv;
            oi[i >> 2][i & 3] = __float_as_uint(pk) & 16383u; ow[i >> 2][i & 3] = w; }
        int* si = SELI + token * 128 + h * 16 + 8 * hi; float* sw = SELW + token * 128 + h * 16 + 8 * hi;
        *(u32x4*)si = oi[0]; *(u32x4*)(si + 4) = oi[1]; *(f32x4*)sw = ow[0]; *(f32x4*)(sw + 4) = ow[1];
        if (only_unit >= 0) break;
    }
}

__device__ __forceinline__ void dec16(const u32x4 w, float (&f)[16]) {
#pragma unroll
    for (int j = 0; j < 4; ++j) { const auto lo = __builtin_amdgcn_cvt_pk_f32_fp8((int)w[j], false); const auto hi = __builtin_amdgcn_cvt_pk_f32_fp8((int)w[j], true);
        f[4 * j + 0] = lo[0]; f[4 * j + 1] = lo[1]; f[4 * j + 2] = hi[0]; f[4 * j + 3] = hi[1]; }
}
__device__ __forceinline__ void peer_gather(const Ctx& c, const Args& a, int layer, int widx, int nw) {
    float* XR = a.out; bf16_t* XN2 = (bf16_t*)(a.ws + WS_XN2);
    const unsigned char* EU = a.ws + WS_EU + (size_t)layer * 16384 * 1024;
    const unsigned char* EV = a.ws + WS_EV + (size_t)layer * 16384 * 1024;
    const float* SCU = (const float*)(a.ws + WS_ESC) + layer * 16384; const float* SCV = SCU + 32768;
    const int* SELI = (const int*)(a.ws + WS_SELI); const float* SELW = (const float*)(a.ws + WS_SELW);
    const float* gf = a.in[I_NFFNG] + layer * D; const float* gp = a.in[I_NPLEG] + layer * D;
    const int lane = c.lane;
    for (int t = widx; t < M; t += nw) {
        float x[16], hh[16], acc[16];
        float* xr = XR + (size_t)t * D + 16 * lane;
        float ss = 0.f;
#pragma unroll
        for (int j = 0; j < 4; ++j) { const f32x4 u0 = *(const f32x4*)(xr + 4 * j);
#pragma unroll
            for (int e = 0; e < 4; ++e) x[4 * j + e] = u0[e]; }
#pragma unroll
        for (int e = 0; e < 16; ++e) { ss += x[e] * x[e]; acc[e] = 0.f; }
        ss = wave_sum(ss);
        const float rstd = rsqrtf(ss * (1.f / D) + EPS);
#pragma unroll
        for (int j = 0; j < 4; ++j) { const f32x4 g4 = *(const f32x4*)(gf + 16 * lane + 4 * j);
#pragma unroll
            for (int e = 0; e < 4; ++e) hh[4 * j + e] = x[4 * j + e] * rstd * g4[e]; }
        const int idxA = SELI[(size_t)t * 128 + lane], idxB = SELI[(size_t)t * 128 + 64 + lane];
        const float wA = SELW[(size_t)t * 128 + lane], wB = SELW[(size_t)t * 128 + 64 + lane];
        const float suA = SCU[idxA], suB = SCU[idxB], svA = SCV[idxA], svB = SCV[idxB];
#pragma unroll 1
        for (int hf = 0; hf < 2; ++hf) {
            const int idxv = hf ? idxB : idxA; const float wv = hf ? wB : wA, suv = hf ? suB : suA, svv = hf ? svB : svA;
#pragma unroll 1
            for (int k0 = 0; k0 < 64; k0 += 8) {
                u32x4 ur[8], vr[8]; float w[8], su[8], sv[8];
#pragma unroll
                for (int r = 0; r < 8; ++r) {
                    const int e = __builtin_amdgcn_readlane(idxv, k0 + r);
                    w[r] = __uint_as_float(__builtin_amdgcn_readlane(__float_as_uint(wv), k0 + r));
                    su[r] = __uint_as_float(__builtin_amdgcn_readlane(__float_as_uint(suv), k0 + r));
                    sv[r] = __uint_as_float(__builtin_amdgcn_readlane(__float_as_uint(svv), k0 + r));
                    ur[r] = *(const u32x4*)(EU + (size_t)e * D + 16 * lane); vr[r] = *(const u32x4*)(EV + (size_t)e * D + 16 * lane);
                }
#pragma unroll
                for (int r = 0; r < 8; ++r) {
                    float f[16]; dec16(ur[r], f);
                    float d = 0.f;
#pragma unroll
                    for (int e = 0; e < 16; ++e) d += hh[e] * f[e];
                    d = wave_sum(d) * su[r];
                    const float av = gelu_tanh(d) * w[r] * sv[r];
                    dec16(vr[r], f);
#pragma unroll
                    for (int e = 0; e < 16; ++e) acc[e] += av * f[e];
                }
            }
        }
        float s2 = 0.f;
#pragma unroll
        for (int e = 0; e < 16; ++e) { x[e] += acc[e]; s2 += x[e] * x[e]; }
        s2 = wave_sum(s2);
        const float rstd2 = rsqrtf(s2 * (1.f / D) + EPS);
#pragma unroll
        for (int j = 0; j < 4; ++j) *(f32x4*)(xr + 4 * j) = (f32x4){x[4 * j + 0], x[4 * j + 1], x[4 * j + 2], x[4 * j + 3]};
        float y[16];
#pragma unroll
        for (int j = 0; j < 4; ++j) { const f32x4 g4 = *(const f32x4*)(gp + 16 * lane + 4 * j);
#pragma unroll
            for (int e = 0; e < 4; ++e) y[4 * j + e] = x[4 * j + e] * rstd2 * g4[e]; }
        u32x4 o0, o1; o0.x = pk2(y[0], y[1]); o0.y = pk2(y[2], y[3]); o0.z = pk2(y[4], y[5]); o0.w = pk2(y[6], y[7]);
        o1.x = pk2(y[8], y[9]); o1.y = pk2(y[10], y[11]); o1.z = pk2(y[12], y[13]); o1.w = pk2(y[14], y[15]);
        *(u32x4*)(XN2 + (size_t)t * D + 16 * lane) = o0; *(u32x4*)(XN2 + (size_t)t * D + 16 * lane + 8) = o1;
    }
}

#define DPP_ADD(v, ctrl, rmask) v += __uint_as_float(__builtin_amdgcn_update_dpp(0u, __float_as_uint(v), ctrl, rmask, 0xf, true))
__device__ __forceinline__ float wave_sum_dpp(float v) {
    DPP_ADD(v, 0x111, 0xf); DPP_ADD(v, 0x112, 0xf); DPP_ADD(v, 0x114, 0xf); DPP_ADD(v, 0x118, 0xf); DPP_ADD(v, 0x142, 0xa); DPP_ADD(v, 0x143, 0xc);
    return __uint_as_float(__builtin_amdgcn_readlane(__float_as_uint(v), 63));
}
struct GrpSplit { int grp, G, gwave, nwave; };
__device__ __forceinline__ GrpSplit grp_split(const Ctx& c) { GrpSplit s; s.G = c.nblk < 8 ? c.nblk : 8; s.grp = c.blk % s.G; const int rank = c.blk / s.G, cnt = (c.nblk - s.grp + s.G - 1) / s.G;
    s.gwave = rank * 8 + c.wave; s.nwave = cnt * 8; return s; }
#define DPP_ADDC(v, ctrl) v += __uint_as_float(__builtin_amdgcn_update_dpp(0u, __float_as_uint(v), ctrl, 0xf, 0xf, true))
template <bool VSTEP, int MODE = 0>
__device__ __forceinline__ void peer_step(const Ctx& c, const Args& a, int layer, bf16_t* XB) {
    float* SSQ2 = (float*)(a.ws + WS_SSQS); const float* SSQ1 = (const float*)(a.ws + WS_SSQ1);
    const unsigned char* ET = a.ws + (VSTEP ? WS_EV : WS_EU) + (size_t)layer * 16384 * 1024;
    const int* SELI = (const int*)(a.ws + WS_SELI); const float* AOUT = (const float*)(a.ws + WS_AOUT); float* DP = (float*)(a.ws + WS_QP);
    const float* gf = a.in[I_NFFNG] + layer * D;
    const int lane = c.lane, sub = lane >> 3, ch = lane & 7; const GrpSplit gs = grp_split(c);
#define PS_LOADIX(ix_, tt) do { const u32x4* ip_ = (const u32x4*)(SELI + (size_t)(tt) * 128 + 16 * sub); ix_[0] = ip_[0]; ix_[1] = ip_[1]; ix_[2] = ip_[2]; ix_[3] = ip_[3]; } while (0)
#define PS_LOADOPS(raw_, q_, tt) do { \
        if (VSTEP) { const u32x4* ap_ = (const u32x4*)(AOUT + (size_t)(tt) * 128 + 16 * sub); raw_[0] = ap_[0]; raw_[1] = ap_[1]; raw_[2] = ap_[2]; raw_[3] = ap_[3]; } \
        else { raw_[0] = *(const u32x4*)(XB + (size_t)(tt) * D + 128 * p + 16 * ch); raw_[1] = *(const u32x4*)(XB + (size_t)(tt) * D + 128 * p + 16 * ch + 8); \
               const f32x4* sq_ = (const f32x4*)(SSQ1 + (size_t)(tt) * 16); q_[0] = sq_[0]; q_[1] = sq_[1]; q_[2] = sq_[2]; q_[3] = sq_[3]; } } while (0)
#define PS_SEG(ix_, j_) (*(const u32x4*)(ETp + (unsigned)((ix_)[(j_) >> 2][(j_) & 3] * 1024u + lane_off)))
    for (int p = gs.grp; p < 8; p += gs.G) {
        float g16[16];
        if (!VSTEP) {
#pragma unroll
            for (int j = 0; j < 4; ++j) { const f32x4 g4 = *(const f32x4*)(gf + 128 * p + 16 * ch + 4 * j); g16[4 * j] = g4[0]; g16[4 * j + 1] = g4[1]; g16[4 * j + 2] = g4[2]; g16[4 * j + 3] = g4[3]; }
        }
        int t = gs.gwave;
        if (t >= M) continue;
        const unsigned char* ETp = ET + 128 * p; const unsigned lane_off = 16u * (unsigned)ch;
        u32x4 ring[16], nix[4], nnix[4], craw[4], nraw[4]; f32x4 cq[4], nq[4];
        { u32x4 cix[4]; PS_LOADIX(cix, t); PS_LOADOPS(craw, cq, t);
#pragma unroll
          for (int j = 0; j < 16; ++j) ring[j] = PS_SEG(cix, j); }
        { const int t1 = t + gs.nwave < M ? t + gs.nwave : t; PS_LOADIX(nix, t1); }
#pragma unroll 1
        for (;;) {
            const int tn = t + gs.nwave, tnn = tn + gs.nwave; const bool has_next = tn < M;
            { const int tc = has_next ? tn : t, tcc = tnn < M ? tnn : t; PS_LOADOPS(nraw, nq, tc); PS_LOADIX(nnix, tcc); }
            unsigned xrw = 0u;
            if (VSTEP) xrw = *(const unsigned*)(XB + (size_t)t * D + 128 * p + 16 * ch + 2 * sub);
            float hx[16]; f32x4 cav[4];
            if (!VSTEP) {
                const float rstd = rsqrtf(((cq[0][0] + cq[0][1] + cq[0][2] + cq[0][3]) + (cq[1][0] + cq[1][1] + cq[1][2] + cq[1][3]) + (cq[2][0] + cq[2][1] + cq[2][2] + cq[2][3]) + (cq[3][0] + cq[3][1] + cq[3][2] + cq[3][3])) * (1.f / D) + EPS);
#pragma unroll
                for (int w = 0; w < 2; ++w)
#pragma unroll
                    for (int e = 0; e < 4; ++e) { hx[8 * w + 2 * e] = bflo(craw[w][e]) * rstd * g16[8 * w + 2 * e]; hx[8 * w + 2 * e + 1] = bfhi(craw[w][e]) * rstd * g16[8 * w + 2 * e + 1]; }
            } else {
#pragma unroll
                for (int j = 0; j < 4; ++j) cav[j] = __builtin_bit_cast(f32x4, craw[j]);
            }
            typedef float f32x2_ __attribute__((ext_vector_type(2)));
            float acc[16]; f32x2_ acc2[8];
#pragma unroll
            for (int e = 0; e < 16; ++e) acc[e] = 0.f;
#pragma unroll
            for (int e = 0; e < 8; ++e) acc2[e] = (f32x2_){0.f, 0.f};
#define PS_PIN() do { if (VSTEP) asm volatile("" : "+v"(acc2[0]), "+v"(acc2[1]), "+v"(acc2[2]), "+v"(acc2[3]), "+v"(acc2[4]), "+v"(acc2[5]), "+v"(acc2[6]), "+v"(acc2[7])); \
        else asm volatile("" : "+v"(acc[0]), "+v"(acc[1]), "+v"(acc[2]), "+v"(acc[3]), "+v"(acc[4]), "+v"(acc[5]), "+v"(acc[6]), "+v"(acc[7]), "+v"(acc[8]), "+v"(acc[9]), "+v"(acc[10]), "+v"(acc[11]), "+v"(acc[12]), "+v"(acc[13]), "+v"(acc[14]), "+v"(acc[15])); __builtin_amdgcn_sched_barrier(0); } while (0)
#pragma unroll
            for (int j = 0; j < 16; ++j) {
                if (MODE == 1) { acc[j] += __uint_as_float((ring[j][0] ^ ring[j][1] ^ ring[j][2] ^ ring[j][3]) & 0x3fffffffu); }
                else {
                f32x2_ f2[8];
#pragma unroll
                for (int w = 0; w < 4; ++w) { f2[2 * w] = __builtin_amdgcn_cvt_pk_f32_fp8((int)ring[j][w], false); f2[2 * w + 1] = __builtin_amdgcn_cvt_pk_f32_fp8((int)ring[j][w], true); }
                if (VSTEP) { const float av_ = cav[j >> 2][j & 3]; const f32x2_ av2 = (f32x2_){av_, av_};
#pragma unroll
                    for (int i = 0; i < 8; ++i) acc2[i] = __builtin_elementwise_fma(av2, f2[i], acc2[i]); }
                else { f32x2_ d0 = (f32x2_){hx[0], hx[1]} * f2[0], d1 = (f32x2_){hx[2], hx[3]} * f2[1];
#pragma unroll
                    for (int i = 2; i < 8; i += 2) { d0 = __builtin_elementwise_fma((f32x2_){hx[2 * i], hx[2 * i + 1]}, f2[i], d0); d1 = __builtin_elementwise_fma((f32x2_){hx[2 * i + 2], hx[2 * i + 3]}, f2[i + 1], d1); }
                    const f32x2_ ds = d0 + d1; float d = ds[0] + ds[1];
                    DPP_ADDC(d, 0xB1); DPP_ADDC(d, 0x4E); DPP_ADDC(d, 0x141); acc[j] = d; } }
                if (MODE != 2) ring[j] = PS_SEG(nix, j);
                if ((j & 1) == 1) PS_PIN();
            }
            if (!VSTEP) {
                if (ch == 0) { u32x4* dp = (u32x4*)((bf16_t*)DP + ((size_t)t * 8 + p) * 128 + 16 * sub);
                    u32x4 o0, o1; o0.x = pk2(acc[0], acc[1]); o0.y = pk2(acc[2], acc[3]); o0.z = pk2(acc[4], acc[5]); o0.w = pk2(acc[6], acc[7]);
                    o1.x = pk2(acc[8], acc[9]); o1.y = pk2(acc[10], acc[11]); o1.z = pk2(acc[12], acc[13]); o1.w = pk2(acc[14], acc[15]); dp[0] = o0; dp[1] = o1; }
            } else {
#pragma unroll
                for (int i = 0; i < 8; ++i) { acc[2 * i] = acc2[i][0]; acc[2 * i + 1] = acc2[i][1]; }
                float r8[8], r4[4], r2[2];
#pragma unroll
                for (int i = 0; i < 8; ++i) { const auto rr = __builtin_amdgcn_permlane32_swap(__float_as_uint(acc[i]), __float_as_uint(acc[i + 8]), false, false); r8[i] = __uint_as_float(rr[0]) + __uint_as_float(rr[1]); }
#pragma unroll
                for (int i = 0; i < 4; ++i) { const auto rr = __builtin_amdgcn_permlane16_swap(__float_as_uint(r8[i]), __float_as_uint(r8[i + 4]), false, false); r4[i] = __uint_as_float(rr[0]) + __uint_as_float(rr[1]); }
                const bool b3 = (lane & 8) != 0;
#pragma unroll
                for (int i = 0; i < 2; ++i) { const float keep = b3 ? r4[i + 2] : r4[i], send = b3 ? r4[i] : r4[i + 2];
                    r2[i] = keep + __uint_as_float(__builtin_amdgcn_update_dpp(0u, __float_as_uint(send), 0x128, 0xf, 0xf, true)); }
                const unsigned ow = pk2(r2[0] + bflo(xrw), r2[1] + bfhi(xrw));
                const float y0 = bflo(ow), y1 = bfhi(ow);
                const float s2 = wave_sum_dpp(y0 * y0 + y1 * y1);
                *(unsigned*)(XB + (size_t)t * D + 128 * p + 16 * ch + 2 * sub) = ow;
                if (lane == 0) SSQ2[(size_t)t * 16 + p] = s2;
            }
            if (!has_next) break;
#pragma unroll
            for (int j = 0; j < 4; ++j) { nix[j] = nnix[j]; craw[j] = nraw[j]; if (!VSTEP) cq[j] = nq[j]; }
            t = tn;
        }
    }
#undef PS_LOADIX
#undef PS_LOADOPS
#undef PS_SEG
#undef PS_PIN
}
__device__ __forceinline__ void peer_combine(const Ctx& c, const Args& a, int layer) {
    const float* SCU = (const float*)(a.ws + WS_ESC) + layer * 16384; const float* SCV = SCU + 32768;
    const int* SELI = (const int*)(a.ws + WS_SELI); const float* SELW = (const float*)(a.ws + WS_SELW); float* AOUT = (float*)(a.ws + WS_AOUT); const float* DP = (const float*)(a.ws + WS_QP);
    const bf16_t* DPB = (const bf16_t*)DP;
    const size_t n8 = (size_t)M * 16, stride = (size_t)c.nblk * 512;
    constexpr int CMB_N = 2;
    for (size_t v0 = (size_t)c.blk * 512 + c.tid; v0 < n8; v0 += CMB_N * stride) {
        f32x4 s0[CMB_N], s1[CMB_N]; u32x4 ix0[CMB_N], ix1[CMB_N]; f32x4 w0[CMB_N], w1[CMB_N];
#pragma unroll
        for (int u = 0; u < CMB_N; ++u) { const size_t v = v0 + u * stride < n8 ? v0 + u * stride : v0; const size_t t = v >> 4; const int q = (int)(v & 15) * 8;
            ix0[u] = *(const u32x4*)(SELI + t * 128 + q); ix1[u] = *(const u32x4*)(SELI + t * 128 + q + 4); w0[u] = *(const f32x4*)(SELW + t * 128 + q); w1[u] = *(const f32x4*)(SELW + t * 128 + q + 4);
            s0[u] = (f32x4){0.f, 0.f, 0.f, 0.f}; s1[u] = s0[u];
#pragma unroll
            for (int p = 0; p < 8; ++p) { f32x4 a0, a1; unpack8(*(const u32x4*)(DPB + (t * 8 + p) * 128 + q), a0, a1); s0[u] += a0; s1[u] += a1; } }
#pragma unroll
        for (int u = 0; u < CMB_N; ++u) { const size_t v = v0 + u * stride; if (v >= n8) break; const size_t t = v >> 4; const int q = (int)(v & 15) * 8;
            f32x4 o0, o1;
#pragma unroll
            for (int e = 0; e < 4; ++e) { o0[e] = gelu_tanh(s0[u][e] * SCU[ix0[u][e]]) * w0[u][e] * SCV[ix0[u][e]]; o1[e] = gelu_tanh(s1[u][e] * SCU[ix1[u][e]]) * w1[u][e] * SCV[ix1[u][e]]; }
            *(f32x4*)(AOUT + t * 128 + q) = o0; *(f32x4*)(AOUT + t * 128 + q + 4) = o1; }
    }
}

__device__ __forceinline__ void final_norm(const Ctx& c, const Args& a, int widx, int nw) {
    const float* gfin = a.in[I_FING]; const bf16_t* XB = (const bf16_t*)(a.ws + WS_XB);
    for (int m0 = widx; m0 < M; m0 += 4 * nw) {
        u32x4 w[4][2];
#pragma unroll
        for (int u = 0; u < 4; ++u) { const int m = m0 + u * nw < M ? m0 + u * nw : m0; const u32x4* xr = (const u32x4*)(XB + (size_t)m * D + 16 * c.lane); w[u][0] = xr[0]; w[u][1] = xr[1]; }
#pragma unroll
        for (int u = 0; u < 4; ++u) { const int m = m0 + u * nw; if (m >= M) break;
            float x[16]; float s = 0.f;
#pragma unroll
            for (int j = 0; j < 2; ++j)
#pragma unroll
                for (int e = 0; e < 4; ++e) { x[8 * j + 2 * e] = bflo(w[u][j][e]); x[8 * j + 2 * e + 1] = bfhi(w[u][j][e]); }
#pragma unroll
            for (int e = 0; e < 16; ++e) s += x[e] * x[e];
            s = wave_sum(s); const float rstd = rsqrtf(s * (1.f / D) + EPS);
            f32x4* orow = (f32x4*)(a.out + (size_t)m * D + 16 * c.lane);
#pragma unroll
            for (int j = 0; j < 4; ++j) { const f32x4 gg = *(const f32x4*)(gfin + 16 * c.lane + 4 * j); orow[j] = (f32x4){x[4 * j] * rstd * gg[0], x[4 * j + 1] * rstd * gg[1], x[4 * j + 2] * rstd * gg[2], x[4 * j + 3] * rstd * gg[3]}; } }
    }
}

__global__ void __launch_bounds__(512, 2) mk_fwd(Args a) {
    extern __shared__ __attribute__((aligned(16))) unsigned char lds[];
    Ctx c0; c0.tid = threadIdx.x; c0.lane = c0.tid & 63; c0.wave = __builtin_amdgcn_readfirstlane(c0.tid >> 6); c0.blk = blockIdx.x; c0.nblk = gridDim.x; c0.lds = lds;
    const Ctx& c = c0;
    volatile LAS unsigned* MISC = (volatile LAS unsigned*)((LAS unsigned char*)lds + MISC_OFF);
    for (int u = c.tid; u < (LDS_BYTES - LDSCTL_OFF) / 4; u += 512) ((LAS unsigned*)((LAS unsigned char*)lds + LDSCTL_OFF))[u] = 0u;
    __syncthreads();
    const bool multi = (a.ph_hi - a.ph_lo) > 1;
    XcdBarrier bar; bar.bar = (unsigned*)(a.ws + WS_CTL) + CW_BAR; bar.x = 0; bar.st = nullptr;
    if (multi) bar = xcd_barrier_post((unsigned*)(a.ws + WS_CTL) + CW_BAR, MISC + 8);
    const int gw = c.blk * 8 + c.wave, NGW = c.nblk * 8;

#define IN(k) (lo <= (k) && (k) < hi)
#define FRESH() Ctx c = c0; { int t_ = c0.tid; asm volatile("" : "+v"(t_)); c.tid = t_; c.lane = t_ & 63; int w_ = c0.wave; asm volatile("" : "+s"(w_)); c.wave = w_; int b_ = c0.blk; asm volatile("" : "+s"(b_)); c.blk = b_; int n_ = c0.nblk; asm volatile("" : "+s"(n_)); c.nblk = n_; }
#define GRIDBAR() do { XcdBarrier b_ = bar; unsigned* p_ = b_.bar; asm volatile("" : "+s"(p_)); b_.bar = p_; xcd_barrier(b_); } while (0)
#ifdef PROBE_PH
#define PROBE_STAMP(slot) do { if (blockIdx.x == 0 && threadIdx.x == 0) ((unsigned long long*)(a.ws + WS_CTL + 48 * 1024))[slot] = __builtin_amdgcn_s_memrealtime(); } while (0)
#define SEAM(k) do { if ((k) == PROBE_PH - 1) { if (IN(k) && IN((k) + 1)) GRIDBAR(); PROBE_STAMP(0); } else if ((k) == PROBE_PH) { if (IN(k) && IN((k) + 1)) GRIDBAR(); PROBE_STAMP(1); } else { if (IN(k) && IN((k) + 1)) GRIDBAR(); } } while (0)
#else
#define SEAM(k) do { if (IN(k) && IN((k) + 1)) GRIDBAR(); } while (0)
#endif
    const int lo = a.ph_lo, hi = a.ph_hi;
#ifdef PROBE_PH
    if (PROBE_PH == 0) PROBE_STAMP(0);
#endif
    if (IN(0)) {
        FRESH();
        p0_prologue(c, a);
    }
    SEAM(0);
#pragma unroll 1
    for (int layer = 0; layer < 2; ++layer) {
        const int pb = 1 + 11 * layer;
        unsigned char* lw = a.ws + WS_LW + (size_t)layer * LW_STRIDE;
        unsigned char* xbc = a.ws + (layer & 1 ? WS_XB2 : WS_XB); unsigned char* xbn = a.ws + (layer & 1 ? WS_XB : WS_XB2);
        if (IN(pb + 0)) {
            FRESH();
            GemmD g; g.A = (const bf16_t*)xbc; g.lda = D; g.Bt = (const bf16_t*)(lw + LW_WIN); g.ldb = D; g.K = D; g.kmid = -1;
            float* RSX = (float*)(a.ws + WS_RSX);
            rstd_rows(c, (const float*)(a.ws + WS_SSQ0), 16, RSX, c.nblk == 256 ? 4 : DIN / 256, c.nblk, c.blk);
            EpiInproj E; E.ssq0 = RSX; E.ucat = (bf16_t*)(a.ws + WS_UCAT); E.qraw = (bf16_t*)(a.ws + WS_QRAW); E.kv = (bf16_t*)(a.ws + WS_KV);
            gemm_phase_dense(c, g, M / 256, c.nblk == 256 ? 4 : DIN / 256, E);
            if (layer == 0 && c.nblk != 256) {}
        }
        SEAM(pb + 0);
        if (IN(pb + 1)) {
            FRESH();
            if (c.nblk == 256) {
                if (c.blk < 64) s1_unit(c, a, layer, c.blk);
                else if (c.blk < 128) {
                    GemmD g; g.A = (const bf16_t*)xbc; g.lda = D; g.Bt = (const bf16_t*)(lw + LW_WIN); g.ldb = D; g.K = D; g.kmid = -1;
                    float* RSX = (float*)(a.ws + WS_RSX);
                    if (c.tid < 256) { const int row = (c.blk - 64) * 256 + c.tid; RSX[row] = rsqrtf(sumn((const float*)(a.ws + WS_SSQ0) + (long)row * 16, 16) * (1.f / D) + EPS); }
                    VM_WAIT(); __syncthreads();
                    EpiInproj E; E.ssq0 = RSX; E.ucat = (bf16_t*)(a.ws + WS_UCAT); E.qraw = (bf16_t*)(a.ws + WS_QRAW); E.kv = (bf16_t*)(a.ws + WS_KV);
                    pg8::OneUnit S; S.u.pm = c.blk - 64; S.u.pn = 4; run_gemm(c.lds, g, S, E, c.tid);
                    VM_WAIT(); __syncthreads();
                    qkprep(c, a, layer, c.wave, 8, 2, (c.blk - 64) * 256);
                    if (layer == 0) cvt_fp8_layer(c, a, 1, (c.blk - 64) * 8 + c.wave, 192 * 8);
                } else {
                    qkprep(c, a, layer, (c.blk - 128) * 8 + c.wave, 128 * 8, 1);
                    if (layer == 0) cvt_fp8_layer(c, a, 1, (c.blk - 64) * 8 + c.wave, 192 * 8);
                }
            } else if (c.nblk > 64) {
                if (c.blk < 64) s1_unit(c, a, layer, c.blk);
                else qkprep(c, a, layer, (c.blk - 64) * 8 + c.wave, (c.nblk - 64) * 8);
            } else {
                for (int u = c.blk; u < 64; u += c.nblk) s1_unit(c, a, layer, u);
                qkprep(c, a, layer, gw, NGW);
            }
        }
        SEAM(pb + 1);
        if (IN(pb + 2)) {
            FRESH();
            GemmD g; g.A = (const bf16_t*)(a.ws + WS_UCAT); g.lda = KCAT; g.Bt = (const bf16_t*)(lw + LW_WY); g.ldb = KCAT; g.K = KCAT; g.kmid = -1;
            EpiS2 E; E.G = (bf16_t*)(a.ws + WS_G);
#ifdef USE_SGEMM
            for (int ui = c.blk; ui < 128; ui += c.nblk) { Unit u; u.pm = ui >> 1; u.pn = (ui >> 2) * 2 + (ui & 1); sgemm_unit(g, u, E, c.wave, c.lane); }
#else
            { pg8::S2Order S; S.blk = c.blk; S.nblk = c.nblk; run_gemm(c.lds, g, S, E, c.tid); }
#endif
#ifdef ATT_NAIVE
            for (int ui = c.blk; ui < 256; ui += c.nblk) attn_naive_unit(c, a, ui >> 7, (ui >> 4) & 7, ui & 15);
#else
            float mfix = 0.f;
            {
                float gq = 0.f, gk = 0.f;
                for (int d = 0; d < 64; ++d) { gq = fmaxf(gq, fabsf(a.in[I_QNG][layer * 64 + d])); gk = fmaxf(gk, fabsf(a.in[I_KNG][layer * 64 + d])); }
                mfix = 64.f * gq * gk * C2 * 1.02f;
            }
            for (int ui = c.blk; ui < 512; ui += c.nblk) {
                int ab, ah, aq;
                if (c.nblk == 256) { const int bl = ui & 255, vcu = (bl & 7) * 32 + (bl >> 3), combo = (ui >> 8) * 2 + (vcu >> 7), w = vcu & 127; ab = combo >> 1; ah = (combo & 1) * 4 + (w >> 5); aq = w & 31; }
                else { ab = ui >> 8; ah = (ui >> 5) & 7; aq = ui & 31; }
                attn_body::attn_unit<ATT_THRL>(ab, ah, aq, (const attn_body::bf16*)(a.ws + WS_QRAW), (const attn_body::bf16*)(a.ws + WS_KV), (attn_body::bf16*)(a.ws + WS_Y), (float*)(a.ws + WS_SSQA), (char*)lds, c.tid, mfix);
            }
#endif
        }
        SEAM(pb + 2);
        if (IN(pb + 3)) {
            FRESH();
            GemmD g; g.A = (const bf16_t*)(a.ws + WS_G); g.lda = 512; g.Bt = (const bf16_t*)(lw + LW_WGLU); g.ldb = 512; g.K = 512; g.kmid = -1;
            EpiGlu E; E.G = (const bf16_t*)(a.ws + WS_G); E.bglu = a.in[I_BGLU] + layer * 512; E.Y = (bf16_t*)(a.ws + WS_Y); E.ssqs = (float*)(a.ws + WS_SSQS);
            GemmD g1; g1.A = (const bf16_t*)(a.ws + WS_PB) + (size_t)layer * M * 256; g1.lda = 256; g1.Bt = (const bf16_t*)(lw + LW_WPROJ); g1.ldb = 256; g1.K = 256; g1.kmid = -1;
            EpiProj E1; E1.pr = (bf16_t*)(a.ws + WS_PRB);
            if (c.nblk >= 256) { if (c.blk < 128) gemm_phase_sub(c, g, M / 256, 2, E, 128, c.blk); else if (c.blk < 256) gemm_phase_sub(c, g1, M / 256, 4, E1, 128, c.blk - 128); }
            else { gemm_phase_dense(c, g, M / 256, 2, E); gemm_phase_dense(c, g1, M / 256, 4, E1); }
        }
        SEAM(pb + 3);
        if (IN(pb + 4)) {
            FRESH();
            GemmD g; g.A = (const bf16_t*)(a.ws + WS_Y); g.lda = D; g.Bt = (const bf16_t*)(lw + LW_WOUT); g.ldb = D; g.K = D; g.kmid = 512;
            float* RS = (float*)(a.ws + WS_RS);
            { const float* ssqs = (const float*)(a.ws + WS_SSQS); const float* ssqa = (const float*)(a.ws + WS_SSQA);
              pg8::StaticOrder S0; S0.init(M, D, c.nblk, c.blk); Unit u0;
              for (int i = 0; S0.next(i, u0); ++i) if (c.tid < 256) { const int row = u0.pm * 256 + c.tid;
                  const float s = rsqrtf(sumn(ssqs + (long)row * 16, 8) * (1.f / 512.f) + EPS), t = rsqrtf(sumn(ssqa + (long)row * 16, 8) * (1.f / 512.f) + EPS);
                  RS[(long)row * 2] = s / t; RS[(long)row * 2 + 1] = t; }
              VM_WAIT(); __syncthreads(); }
            EpiOut E; E.rs = RS; E.xb = (bf16_t*)xbc; E.ssq1 = (float*)(a.ws + WS_SSQ1);
            gemm_phase_dense(c, g, M / 256, 4, E);
        }
        SEAM(pb + 4);
        if (IN(pb + 5)) {
            FRESH();
            GemmD g; g.A = (const bf16_t*)xbc; g.lda = D; g.Bt = (const bf16_t*)(lw + LW_WQ); g.ldb = D; g.K = D; g.kmid = -1;
            float* RSX = (float*)(a.ws + WS_RSX);
            rstd_rows(c, (const float*)(a.ws + WS_SSQ1), 16, RSX, 8, c.nblk, c.blk);
            EpiQ E; E.ssq1 = RSX; E.qp = (bf16_t*)(a.ws + WS_QP);
            gemm_phase_dense(c, g, M / 256, 8, E);
            VM_WAIT(); __syncthreads();
            { pg8::StaticOrder S0; S0.init(M, 2048, c.nblk, c.blk); Unit u0;
              for (int i = 0; S0.next(i, u0); ++i) peer_topk_fast(c, a, layer, 0, 1 << 30, (u0.pm * 8 + c.wave) * 8 + u0.pn); }
        }
        SEAM(pb + 5);
        if (IN(pb + 7)) {
            FRESH();
#ifdef EXP_MODE
            peer_step<false, EXP_MODE>(c, a, layer, (bf16_t*)xbc);
            VM_WAIT(); __syncthreads();
#endif
            peer_step<false>(c, a, layer, (bf16_t*)xbc);
        }
        SEAM(pb + 7);
        if (IN(pb + 8)) {
            FRESH();
            peer_combine(c, a, layer);
        }
        SEAM(pb + 8);
        if (IN(pb + 9)) {
            FRESH();
            peer_step<true>(c, a, layer, (bf16_t*)xbc);
        }
        SEAM(pb + 9);
        if (IN(pb + 10)) {
            FRESH();
            GemmD g2; g2.A = (const bf16_t*)xbc; g2.lda = D; g2.Bt = (const bf16_t*)(lw + LW_WGATE); g2.ldb = D; g2.K = D; g2.kmid = -1;
            float* RSX = (float*)(a.ws + WS_RSX);
            rstd_rows(c, (const float*)(a.ws + WS_SSQS), 8, RSX, 4, c.nblk, c.blk);
            EpiGate E2; E2.pr = (const bf16_t*)(a.ws + WS_PRB); E2.xin = (const bf16_t*)xbc; E2.xout = (bf16_t*)xbn; E2.ssq0 = (float*)(a.ws + WS_SSQ0); E2.ssq2 = RSX;
            gemm_phase_dense(c, g2, M / 256, 4, E2);
        }
        SEAM(pb + 10);
    }
    if (IN(NPHASE - 1)) { FRESH(); final_norm(c, a, gw, NGW); }
#ifdef PROBE_RGN
    if (blockIdx.x == 0 && threadIdx.x == 0) {
        VM_WAIT();
        const unsigned long long* st = (const unsigned long long*)(a.ws + WS_CTL + 48 * 1024);
        const unsigned long long t0 = __hip_atomic_load(st, __ATOMIC_RELAXED, __HIP_MEMORY_SCOPE_AGENT), t1 = __hip_atomic_load(st + 1, __ATOMIC_RELAXED, __HIP_MEMORY_SCOPE_AGENT);
        const unsigned long long span = (t1 > t0 ? t1 - t0 : 0) * PROBE_MULT, s0 = __builtin_amdgcn_s_memrealtime();
        while (__builtin_amdgcn_s_memrealtime() - s0 < span) __builtin_amdgcn_s_sleep(8);
    }
#endif
#ifdef PROBE_PH
    if (blockIdx.x == 0 && threadIdx.x == 0) {
        VM_WAIT();
        const unsigned long long* st = (const unsigned long long*)(a.ws + WS_CTL + 48 * 1024);
        const unsigned long long t0 = __hip_atomic_load(st, __ATOMIC_RELAXED, __HIP_MEMORY_SCOPE_AGENT), t1 = __hip_atomic_load(st + 1, __ATOMIC_RELAXED, __HIP_MEMORY_SCOPE_AGENT);
        const unsigned long long span = (t1 > t0 ? t1 - t0 : 0) * PROBE_MULT, s0 = __builtin_amdgcn_s_memrealtime();
        while (__builtin_amdgcn_s_memrealtime() - s0 < span) __builtin_amdgcn_s_sleep(8);
    }
#endif
#undef IN
#undef SEAM
}

extern "C" void kernel_launch(void* const* d_in, const int* in_sizes, int n_in, void* d_out, int out_size, void* d_ws, size_t ws_size, hipStream_t stream) {
    static int grid = 0;
    if (grid == 0) {
        if (n_in != 29 || in_sizes[0] != M * D || out_size != M * D || in_sizes[3] != 2 * D * DIN || ws_size < WS_END) {
            fprintf(stderr, "kernel_launch: unexpected problem: n_in %d in0 %d in3 %d out %d ws %zu (need %zu); nothing launched\n", n_in, n_in > 0 ? in_sizes[0] : -1, n_in > 3 ? in_sizes[3] : -1, out_size, ws_size, (size_t)WS_END);
            grid = -1; return; }
        int dev = 0, cus = 0, per_cu = 0;
        if (hipGetDevice(&dev) != hipSuccess || hipDeviceGetAttribute(&cus, hipDeviceAttributeMultiprocessorCount, dev) != hipSuccess) { grid = -1; return; }
        if (hipFuncSetAttribute((const void*)mk_fwd, hipFuncAttributeMaxDynamicSharedMemorySize, LDS_BYTES) != hipSuccess) { fprintf(stderr, "kernel_launch: hipFuncSetAttribute failed\n"); grid = -1; return; }
        if (hipOccupancyMaxActiveBlocksPerMultiprocessor(&per_cu, (const void*)mk_fwd, 512, LDS_BYTES) != hipSuccess || per_cu < 1)
            fprintf(stderr, "kernel_launch: note: occupancy query reports %d workgroups per CU\n", per_cu);
        (void)hipGetLastError();
        grid = cus;
    }
    if (grid < 0) return;
    (void)hipMemsetAsync((char*)d_ws + WS_CTL, 0, CTL_ZERO_BYTES, stream);
    Args a{};
    for (int i = 0; i < 29; ++i) a.in[i] = (const float*)d_in[i];
    a.out = (float*)d_out; a.ws = (unsigned char*)d_ws;
    constexpr int NL = MK_N_LAUNCHES;
    for (int li = 0; li < NL; ++li) {
        a.ph_lo = (NPHASE * li) / NL; a.ph_hi = (NPHASE * (li + 1)) / NL;
        hipLaunchKernelGGL(mk_fwd, dim3(grid), dim3(512), LDS_BYTES, stream, a);
    }
}
```

```cpp
#include <hip/hip_runtime.h>
#include <cstdio>
#include <cstdint>

#ifndef ATT_THRL
#define ATT_THRL -1
#endif
#ifndef MK_N_LAUNCHES
#define MK_N_LAUNCHES 1
#endif

#define LAS __attribute__((address_space(3)))
typedef unsigned short bf16_t;
typedef short bf16x8 __attribute__((ext_vector_type(8)));
typedef float f32x4 __attribute__((ext_vector_type(4)));
typedef unsigned u32x4 __attribute__((ext_vector_type(4)));
typedef unsigned u32x2 __attribute__((ext_vector_type(2)));

constexpr int NB = 2, SEQ = 8192, M = NB * SEQ, D = 1024, DIN = 1280;
constexpr int NG = 32, LCH = 32, NCH = SEQ / LCH, KCAT = 768;
constexpr float EPS = 1e-6f;
constexpr float C2 = 0.125f * 1.4426950408889634f;
constexpr int NPHASE = 24;

constexpr size_t MiB = 1u << 20;
constexpr size_t WS_CTL = 0, CTL_ZERO_BYTES = 64 * 1024;
constexpr size_t WS_EU = 1 * MiB, WS_EV = 65 * MiB;
constexpr size_t WS_ESC = 241 * MiB + 256 * 1024;
constexpr size_t WS_LW = 129 * MiB, LW_STRIDE = 48 * MiB;
constexpr size_t LW_WIN = 0, LW_WGLU = 3 * MiB, LW_WOUT = 4 * MiB, LW_WQ = 6 * MiB, LW_SK1 = 10 * MiB, LW_SK2 = 10 * MiB + 512 * 1024,
                 LW_WGATE = 11 * MiB, LW_WPROJ = 13 * MiB, LW_AL = 13 * MiB + 512 * 1024, LW_WE = 14 * MiB, LW_WY = 22 * MiB;
constexpr size_t WS_PB = 225 * MiB, WS_ROPE = 241 * MiB, WS_XB = 242 * MiB, WS_UCAT = 274 * MiB, WS_QRAW = 300 * MiB, WS_KV = 316 * MiB,
                 WS_EBUF = 324 * MiB, WS_G = 340 * MiB, WS_Y = 356 * MiB, WS_SSQS = 388 * MiB, WS_SSQA = 389 * MiB, WS_SSQ0 = 390 * MiB, WS_SSQ1 = 391 * MiB, WS_RS = 241 * MiB + 512 * 1024, WS_RSX = 241 * MiB + 768 * 1024  , WS_PRB = 33 * MiB  ,
                 WS_QP = 392 * MiB  , WS_SELI = 456 * MiB, WS_SELW = 464 * MiB, WS_XN2 = 472 * MiB, WS_AOUT = 472 * MiB  , WS_XB2 = 480 * MiB  , WS_END = 512 * MiB;
constexpr int CW_BAR = 4096;

constexpr int RING_BYTES = 131072, LDSCTL_OFF = RING_BYTES, MISC_OFF = LDSCTL_OFF + 320, LDS_BYTES = 147456;

__device__ __forceinline__ unsigned f2bf(float f) { unsigned u = __float_as_uint(f); return (u + 0x7fffu + ((u >> 16) & 1u)) >> 16; }
__device__ __forceinline__ unsigned pk2(float lo, float hi) { return f2bf(lo) | (f2bf(hi) << 16); }
__device__ __forceinline__ float bflo(unsigned w) { return __uint_as_float(w << 16); }
__device__ __forceinline__ float bfhi(unsigned w) { return __uint_as_float(w & 0xffff0000u); }
__device__ __forceinline__ float bf1(bf16_t h) { return __uint_as_float((unsigned)h << 16); }
__device__ __forceinline__ float wave_sum(float v) {
#pragma unroll
    for (int o = 1; o < 64; o <<= 1) v += __shfl_xor(v, o);
    return v;
}
__device__ __forceinline__ float wave_max(float v) {
#pragma unroll
    for (int o = 1; o < 64; o <<= 1) v = fmaxf(v, __shfl_xor(v, o));
    return v;
}
__device__ __forceinline__ float sigmoidf_(float x) { return 1.f / (1.f + __expf(-x)); }
__device__ __forceinline__ float gelu_tanh(float x) {
    const float z = 0.7978845608028654f * (x + 0.044715f * x * x * x);
    const float e = __expf(2.f * z);
    const float th = 1.f - 2.f / (e + 1.f);
    return 0.5f * x * (1.f + th);
}
__device__ __forceinline__ float sumn(const float* p, int n) { float s = 0.f; for (int i = 0; i < n; ++i) s += p[i]; return s; }
#define LDS_WAIT() asm volatile("s_waitcnt lgkmcnt(0)" ::: "memory")
#define VM_WAIT() asm volatile("s_waitcnt vmcnt(0)" ::: "memory")

#define XB_TMO      128
#define XB_XCNT(j)  (256  + 64 * (j))
#define XB_XSUB(j)  (1280 + 64 * (j))
#define XB_XGEN(j)  (2304 + 64 * (j))
#define XB_TOP      3328
#define XB_TOPGEN   3392
#define XCD_BAR_WORDS 3456
#define XB_SPIN_CAP (1u << 18)
__device__ __forceinline__ unsigned xb_ld(unsigned* p)              { return __hip_atomic_load(p, __ATOMIC_RELAXED, __HIP_MEMORY_SCOPE_AGENT); }
__device__ __forceinline__ unsigned xb_add(unsigned* p, unsigned v) { return __hip_atomic_fetch_add(p, v, __ATOMIC_RELAXED, __HIP_MEMORY_SCOPE_AGENT); }
__device__ __forceinline__ unsigned xb_xcc_id() { return (unsigned)__builtin_amdgcn_s_getreg((3 << 11) | 20) & 0xFu; }
#define XB_SPIN(cond, bar) do { unsigned _sp = 0; while (cond) { __builtin_amdgcn_s_sleep(1); \
    if ((++_sp & 255u) == 0u) { if (xb_ld(&(bar)[XB_TMO])) break; if (_sp > XB_SPIN_CAP) { atomicAdd(&(bar)[XB_TMO], 1u); break; } } } } while (0)
struct XcdBarrier { unsigned* bar; unsigned x; volatile LAS unsigned* st; };
__device__ __forceinline__ XcdBarrier xcd_barrier_post(unsigned* bar, volatile LAS unsigned* st) {
    XcdBarrier b; b.bar = bar; b.x = xb_xcc_id(); b.st = st;
    if (threadIdx.x == 0) (void)xb_add(&bar[XB_XCNT(b.x)], 1u);
    return b;
}
__device__ __forceinline__ void xcd_barrier_complete(unsigned* bar, unsigned x, unsigned& nloc, unsigned& nx) {
    const unsigned G = gridDim.x * gridDim.y * gridDim.z;
    unsigned sum, cnt, mine, sp = 0u;
    for (;;) {
        sum = 0u; cnt = 0u; mine = 0u;
#pragma unroll
        for (unsigned j = 0; j < 16; ++j) { const unsigned c = xb_ld(&bar[XB_XCNT(j)]); sum += c; cnt += (c > 0u) ? 1u : 0u; mine = (j == x) ? c : mine; }
        if (sum == G) break;
        __builtin_amdgcn_s_sleep(1);
        if ((++sp & 255u) == 0u) { if (xb_ld(&bar[XB_TMO])) break; if (sp > XB_SPIN_CAP) { atomicAdd(&bar[XB_TMO], 1u); break; } }
    }
    nloc = mine > 0u ? mine : 1u; nx = cnt > 0u ? cnt : 1u;
}
__device__ __forceinline__ void xcd_barrier(const XcdBarrier& b) {
    asm volatile("s_waitcnt vmcnt(0)" ::: "memory");
    __syncthreads();
    if (threadIdx.x == 0) {
        unsigned* bar = b.bar;
        __builtin_amdgcn_s_waitcnt(0);
        unsigned nloc = b.st[0], nx = b.st[1];
        if (nloc == 0u) { xcd_barrier_complete(bar, b.x, nloc, nx); b.st[0] = nloc; b.st[1] = nx; }
        const unsigned old = xb_add(&bar[XB_XSUB(b.x)], 1u);
        const unsigned gen = old / nloc;
        if (old + 1u == (gen + 1u) * nloc) {
            __builtin_amdgcn_fence(__ATOMIC_RELEASE, "agent");
            asm volatile("s_waitcnt vmcnt(0)" ::: "memory");
            const unsigned og = xb_add(&bar[XB_TOP], 1u);
            const unsigned tg = og / nx;
            if (og + 1u == (tg + 1u) * nx) xb_add(&bar[XB_TOPGEN], 1u);
            else XB_SPIN(xb_ld(&bar[XB_TOPGEN]) == tg, bar);
            __builtin_amdgcn_fence(__ATOMIC_ACQUIRE, "agent");
            xb_add(&bar[XB_XGEN(b.x)], 1u);
            asm volatile("s_waitcnt vmcnt(0)" ::: "memory");
        } else {
            XB_SPIN(xb_ld(&bar[XB_XGEN(b.x)]) == gen, bar);
            __builtin_amdgcn_fence(__ATOMIC_ACQUIRE, "agent");
            asm volatile("s_waitcnt vmcnt(0)" ::: "memory");
        }
    }
    __syncthreads();
}

#ifdef PROBE_RGN
#define RGN(n, e) do { if ((n) == PROBE_RGN && blockIdx.x == PROBE_BLK && threadIdx.x == 0) { asm volatile("s_waitcnt vmcnt(0) lgkmcnt(0)" ::: "memory"); ((unsigned long long*)(rgn_ws + 48 * 1024))[e] = __builtin_amdgcn_s_memrealtime(); } } while (0)
#else
#define RGN(n, e) do {} while (0)
#endif
struct Args { const float* in[29]; float* out; unsigned char* ws; int ph_lo, ph_hi; };
enum { I_X = 0, I_P, I_NMIXG, I_WIN, I_LRE, I_LIM, I_LOGDT, I_BRE, I_BIM, I_CRE, I_CIM, I_DSKIP, I_WGLU, I_BGLU, I_QNG, I_KNG, I_SSMG, I_ATTG, I_WOUT,
       I_NFFNG, I_WQ, I_SK1, I_SK2, I_EU, I_EV, I_NPLEG, I_WGATE, I_WPROJ, I_FING };

struct Ctx { int tid, lane, wave, blk, nblk; unsigned char* lds; };

struct GemmD { const bf16_t* A; long lda; const bf16_t* Bt; long ldb; int K; int kmid; };
struct Unit { int pm, pn; };

template <class Epi>
__device__ __forceinline__ void sgemm_unit(const GemmD& g, const Unit u, const Epi& E, int wave, int lane) {
    const int i = lane & 15, q = lane >> 4;
    const bf16_t* Ab = g.A + (long)(u.pm * 256 + wave * 32) * g.lda;
    const bf16_t* Bb = g.Bt + (long)(u.pn * 256) * g.ldb;
    const int row0 = u.pm * 256 + wave * 32 + i;
    float ssq[2] = {0.f, 0.f};
    float rs[2] = {1.f, 1.f};
    if constexpr (Epi::ROWSCALE) { rs[0] = E.rscale(row0); rs[1] = E.rscale(row0 + 16); }
    for (int cg = 0; cg < 4; ++cg) {
        f32x4 acc[2][4];
#pragma unroll
        for (int mi = 0; mi < 2; ++mi)
#pragma unroll
            for (int ni = 0; ni < 4; ++ni) acc[mi][ni] = (f32x4){0.f, 0.f, 0.f, 0.f};
        for (int k0 = 0; k0 < g.K; k0 += 32) {
            if constexpr (Epi::MID) { if (k0 == g.kmid) {
#pragma unroll
                for (int mi = 0; mi < 2; ++mi) { const float f = E.mid(row0 + 16 * mi);
#pragma unroll
                    for (int ni = 0; ni < 4; ++ni) acc[mi][ni] *= f; } } }
            bf16x8 a[2], b[4];
#pragma unroll
            for (int mi = 0; mi < 2; ++mi) a[mi] = *(const bf16x8*)(Ab + (long)(16 * mi + i) * g.lda + k0 + 8 * q);
#pragma unroll
            for (int ni = 0; ni < 4; ++ni) b[ni] = *(const bf16x8*)(Bb + (long)(cg * 64 + 16 * ni + i) * g.ldb + k0 + 8 * q);
#pragma unroll
            for (int mi = 0; mi < 2; ++mi)
#pragma unroll
                for (int ni = 0; ni < 4; ++ni) acc[mi][ni] = __builtin_amdgcn_mfma_f32_16x16x32_bf16(b[ni], a[mi], acc[mi][ni], 0, 0, 0);
        }
#pragma unroll
        for (int mi = 0; mi < 2; ++mi)
#pragma unroll
            for (int ni = 0; ni < 4; ++ni) {
                const f32x4 v = acc[mi][ni] * rs[mi];
                const f32x4 w = E.put(row0 + 16 * mi, u.pn * 256 + cg * 64 + 16 * ni + 4 * q, v);
                ssq[mi] += w[0] * w[0] + w[1] * w[1] + w[2] * w[2] + w[3] * w[3];
            }
    }
    if constexpr (Epi::SSQ) {
#pragma unroll
        for (int mi = 0; mi < 2; ++mi) { float s = ssq[mi]; s += __shfl_xor(s, 16); s += __shfl_xor(s, 32);
            if (q == 0) { E.ssq(row0 + 16 * mi, u.pn * 4 + 0, s); E.ssq(row0 + 16 * mi, u.pn * 4 + 1, 0.f); E.ssq(row0 + 16 * mi, u.pn * 4 + 2, 0.f); E.ssq(row0 + 16 * mi, u.pn * 4 + 3, 0.f); } }
    }
}

__device__ __forceinline__ u32x2 pack4(f32x4 v) { u32x2 w; w.x = pk2(v[0], v[1]); w.y = pk2(v[2], v[3]); return w; }
__device__ __forceinline__ u32x4 pack8(f32x4 a, f32x4 b) { u32x4 w; w.x = pk2(a[0], a[1]); w.y = pk2(a[2], a[3]); w.z = pk2(b[0], b[1]); w.w = pk2(b[2], b[3]); return w; }
__device__ __forceinline__ void unpack8(u32x4 w, f32x4& a, f32x4& b) { a = (f32x4){bflo(w.x), bfhi(w.x), bflo(w.y), bfhi(w.y)}; b = (f32x4){bflo(w.z), bfhi(w.z), bflo(w.w), bfhi(w.w)}; }

struct EpiInproj {
    static constexpr bool MID = false, ROWSCALE = true, SSQ = false;
    const float* ssq0; bf16_t* ucat; bf16_t* qraw; bf16_t* kv;
    __device__ __forceinline__ float rscale(int row) const { return ssq0[row]; }
    __device__ __forceinline__ f32x4 put(int row, int col, f32x4 v) const {
        const u32x2 w = pack4(v);
        if (col < 512) { const int g = col >> 4, qq = col & 15, b = row >> 13, s = row & (SEQ - 1), c = s >> 5, j = s & 31;
            *(u32x2*)(ucat + ((long)((g * 2 + b) * NCH + c) * KCAT + j * 16 + qq)) = w; }
        else if (col < 1024) *(u32x2*)(qraw + (long)row * 512 + (col - 512)) = w;
        else *(u32x2*)(kv + (long)row * 256 + (col - 1024)) = w;
        return v;
    }
    __device__ __forceinline__ void put8(int row, int col, f32x4 v0, f32x4 v1, f32x4& w0, f32x4& w1) const {
        const u32x4 w = pack8(v0, v1); w0 = v0; w1 = v1;
        if (col < 512) { const int g = col >> 4, qq = col & 15, b = row >> 13, s = row & (SEQ - 1), c = s >> 5, j = s & 31;
            *(u32x4*)(ucat + ((long)((g * 2 + b) * NCH + c) * KCAT + j * 16 + qq)) = w; }
        else if (col < 1024) *(u32x4*)(qraw + (long)row * 512 + (col - 512)) = w;
        else *(u32x4*)(kv + (long)row * 256 + (col - 1024)) = w;
    }
    __device__ __forceinline__ void ssq(int, int, float) const {}
};
struct EpiS1 {
    static constexpr bool MID = false, ROWSCALE = false, SSQ = false;
    float* ebuf;
    __device__ __forceinline__ f32x4 put(int row, int col, f32x4 v) const { *(f32x4*)(ebuf + ((long)row * 256 + (col & 255))) = v; return v; }
    __device__ __forceinline__ void put8(int row, int col, f32x4 v0, f32x4 v1, f32x4& w0, f32x4& w1) const { float* p = ebuf + ((long)row * 256 + (col & 255)); *(f32x4*)p = v0; *(f32x4*)(p + 4) = v1; w0 = v0; w1 = v1; }
    __device__ __forceinline__ void ssq(int, int, float) const {}
};
struct EpiS2 {
    static constexpr bool MID = false, ROWSCALE = false, SSQ = false;
    bf16_t* G;
    __device__ __forceinline__ f32x4 put(int row, int col, f32x4 v) const {
        const int pm = row >> 8, c = row & 255, g = pm >> 1, b = pm & 1, nout = col & 511, j = nout >> 4, p = nout & 15;
        const long tok = (long)b * SEQ + c * LCH + j;
        f32x4 y; y[0] = gelu_tanh(v[0]); y[1] = gelu_tanh(v[1]); y[2] = gelu_tanh(v[2]); y[3] = gelu_tanh(v[3]);
        *(u32x2*)(G + tok * 512 + 16 * g + p) = pack4(y); return v;
    }
    __device__ __forceinline__ void put8(int row, int col, f32x4 v0, f32x4 v1, f32x4& w0, f32x4& w1) const {
        const int pm = row >> 8, c = row & 255, g = pm >> 1, b = pm & 1, nout = col & 511, j = nout >> 4, p = nout & 15;
        const long tok = (long)b * SEQ + c * LCH + j;
        f32x4 y0, y1;
#pragma unroll
        for (int e = 0; e < 4; ++e) { y0[e] = gelu_tanh(v0[e]); y1[e] = gelu_tanh(v1[e]); }
        *(u32x4*)(G + tok * 512 + 16 * g + p) = pack8(y0, y1); w0 = v0; w1 = v1;
    }
    __device__ __forceinline__ void ssq(int, int, float) const {}
};
struct EpiGlu {
    static constexpr bool MID = false, ROWSCALE = false, SSQ = true;
    const bf16_t* G; const float* bglu; bf16_t* Y; float* ssqs;
    __device__ __forceinline__ f32x4 put(int row, int col, f32x4 v) const {
        const u32x2 gw = *(const u32x2*)(G + (long)row * 512 + col);
        const f32x4 bb = *(const f32x4*)(bglu + col);
        f32x4 ys; ys[0] = bflo(gw.x) * sigmoidf_(v[0] + bb[0]); ys[1] = bfhi(gw.x) * sigmoidf_(v[1] + bb[1]);
        ys[2] = bflo(gw.y) * sigmoidf_(v[2] + bb[2]); ys[3] = bfhi(gw.y) * sigmoidf_(v[3] + bb[3]);
        *(u32x2*)(Y + (long)row * 1024 + col) = pack4(ys); return ys;
    }
    __device__ __forceinline__ void put8(int row, int col, f32x4 v0, f32x4 v1, f32x4& w0, f32x4& w1) const {
        f32x4 g0, g1; unpack8(*(const u32x4*)(G + (long)row * 512 + col), g0, g1);
        const f32x4 b0 = *(const f32x4*)(bglu + col), b1 = *(const f32x4*)(bglu + col + 4);
#pragma unroll
        for (int e = 0; e < 4; ++e) { w0[e] = g0[e] * sigmoidf_(v0[e] + b0[e]); w1[e] = g1[e] * sigmoidf_(v1[e] + b1[e]); }
        *(u32x4*)(Y + (long)row * 1024 + col) = pack8(w0, w1);
    }
    __device__ __forceinline__ void ssq(int row, int slot, float s) const { ssqs[(long)row * 16 + slot] = s; }
};
struct EpiOut {
    static constexpr bool MID = true, ROWSCALE = true, SSQ = true;
    const float* rs; bf16_t* xb; float* ssq1;
    __device__ __forceinline__ float mid(int row) const { return rs[(long)row * 2]; }
    __device__ __forceinline__ float rscale(int row) const { return rs[(long)row * 2 + 1]; }
    __device__ __forceinline__ f32x4 put(int row, int col, f32x4 v) const {
        const long o = (long)row * D + col; const u32x2 xw = *(const u32x2*)(xb + o); const f32x4 x1 = (f32x4){bflo(xw.x), bfhi(xw.x), bflo(xw.y), bfhi(xw.y)} + v;
        const u32x2 ow = pack4(x1); *(u32x2*)(xb + o) = ow; return (f32x4){bflo(ow.x), bfhi(ow.x), bflo(ow.y), bfhi(ow.y)};
    }
    __device__ __forceinline__ void put8(int row, int col, f32x4 v0, f32x4 v1, f32x4& w0, f32x4& w1) const {
        const long o = (long)row * D + col; f32x4 x0, x1; unpack8(*(const u32x4*)(xb + o), x0, x1);
        const u32x4 ow = pack8(x0 + v0, x1 + v1); *(u32x4*)(xb + o) = ow; unpack8(ow, w0, w1);
    }
    __device__ __forceinline__ void ssq(int row, int slot, float s) const { ssq1[(long)row * 16 + slot] = s; }
};
struct EpiQ {
    static constexpr bool MID = false, ROWSCALE = true, SSQ = false;
    const float* ssq1; bf16_t* qp;
    __device__ __forceinline__ float rscale(int row) const { return ssq1[row]; }
    __device__ __forceinline__ f32x4 put(int row, int col, f32x4 v) const { *(u32x2*)(qp + (long)row * 2048 + col) = pack4(v); return v; }
    __device__ __forceinline__ void put8(int row, int col, f32x4 v0, f32x4 v1, f32x4& w0, f32x4& w1) const {
        const int pm = row >> 8, tgl = (row >> 5) & 7, tl = row & 31, h = col >> 8, half = (col >> 7) & 1, d = col & 127, ks = d >> 4, hi = (d >> 3) & 1;
        const size_t off = ((((((size_t)(pm * 8 + h) * 8 + tgl) * 2 + half) * 8 + ks) * 64) + (hi * 32 + tl)) * 8;
        *(u32x4*)(qp + off) = pack8(v0, v1); w0 = v0; w1 = v1; }
    __device__ __forceinline__ void ssq(int, int, float) const {}
};
struct EpiProj {
    static constexpr bool MID = false, ROWSCALE = false, SSQ = false;
    bf16_t* pr;
    __device__ __forceinline__ f32x4 put(int row, int col, f32x4 v) const { *(u32x2*)(pr + (long)row * D + col) = pack4(v); return v; }
    __device__ __forceinline__ void put8(int row, int col, f32x4 v0, f32x4 v1, f32x4& w0, f32x4& w1) const { *(u32x4*)(pr + (long)row * D + col) = pack8(v0, v1); w0 = v0; w1 = v1; }
    __device__ __forceinline__ void ssq(int, int, float) const {}
};
struct EpiGate {
    static constexpr bool MID = false, ROWSCALE = true, SSQ = true;
    const bf16_t* pr; const bf16_t* xin; bf16_t* xout; float* ssq0; const float* ssq2;
    __device__ __forceinline__ float rscale(int row) const { return ssq2[row]; }
    __device__ __forceinline__ f32x4 put(int row, int col, f32x4 v) const {
        const long o = (long)row * D + col; const u32x2 pw = *(const u32x2*)(pr + o); const f32x4 pv = (f32x4){bflo(pw.x), bfhi(pw.x), bflo(pw.y), bfhi(pw.y)}; const u32x2 xw = *(const u32x2*)(xin + o); f32x4 x3 = (f32x4){bflo(xw.x), bfhi(xw.x), bflo(xw.y), bfhi(xw.y)};
        x3[0] += sigmoidf_(v[0]) * pv[0]; x3[1] += sigmoidf_(v[1]) * pv[1]; x3[2] += sigmoidf_(v[2]) * pv[2]; x3[3] += sigmoidf_(v[3]) * pv[3];
        const u32x2 ow = pack4(x3); *(u32x2*)(xout + o) = ow; return (f32x4){bflo(ow.x), bfhi(ow.x), bflo(ow.y), bfhi(ow.y)};
    }
    __device__ __forceinline__ void put8(int row, int col, f32x4 v0, f32x4 v1, f32x4& w0, f32x4& w1) const {
        const long o = (long)row * D + col; f32x4 p0, p1, x0, x1; unpack8(*(const u32x4*)(pr + o), p0, p1); unpack8(*(const u32x4*)(xin + o), x0, x1);
#pragma unroll
        for (int e = 0; e < 4; ++e) { x0[e] += sigmoidf_(v0[e]) * p0[e]; x1[e] += sigmoidf_(v1[e]) * p1[e]; }
        const u32x4 ow = pack8(x0, x1); *(u32x4*)(xout + o) = ow; unpack8(ow, w0, w1);
    }
    __device__ __forceinline__ void ssq(int row, int slot, float s) const { ssq0[(long)row * 16 + slot] = s; }
};


namespace pg8 {
#define PG8_LAS __attribute__((address_space(3)))
constexpr int BM = 256, BK = 64, HALF = 128, HTB = HALF * BK * 2, STAGE_BYTES = 8 * HTB, NXCD = 8, WGM = 8;
__host__ __device__ __forceinline__ int lds_byte(int r, int c) { const int st = (r >> 4) * 2 + (c >> 5), rr = r & 15, cc = c & 31, ob = rr * 64 + cc * 2; return st * 1024 + (ob ^ (((ob >> 9) & 1) << 5)); }
__host__ __device__ __forceinline__ void stage_rc(int b, int& R, int& C) { const int st = b / 1024, sb = b % 1024, swz = sb ^ (((sb >> 9) & 1) << 5); R = (st >> 1) * 16 + swz / 64; C = (st & 1) * 32 + (swz % 64) / 2; }
__host__ __device__ __forceinline__ int perm32(int rho) { const int n = rho >> 4, i = rho & 15; return 8 * (i >> 2) + 4 * n + (i & 3); }
using ::Unit;
struct Gemm { const bf16_t* A; const bf16_t* Bt; int K, lda, ldb, kmid; };
struct StaticOrder {
    int nM, nN, nwg, G, c;
    __host__ __device__ __forceinline__ void init(int M_, int N_, int G_, int c_) { nM = M_ / BM; nN = N_ / BM; nwg = nM * nN; G = G_; c = c_; }
    __host__ __device__ __forceinline__ bool next(int i, Unit& u) const {
        const long L = (long)i * G + c; if (L >= nwg) return false;
        int wgid = (int)L; { const int q = nwg / NXCD, r = nwg % NXCD, xcd = wgid % NXCD, off = wgid / NXCD; wgid = (xcd < r ? xcd * (q + 1) : r * (q + 1) + (xcd - r) * q) + off; }
        const int nig = WGM * nN, gid = wgid / nig, fm = gid * WGM, gsz = (nM - fm) < WGM ? (nM - fm) : WGM;
        u.pm = fm + ((wgid % nig) % gsz); u.pn = (wgid % nig) / gsz; return true;
    }
    __device__ __forceinline__ void a_ready(const Unit&) const {}
    __device__ __forceinline__ void done(const Unit&) const {}
};
struct OneUnit { Unit u;
    __device__ __forceinline__ bool next(int i, Unit& o) const { if (i) return false; o = u; return true; }
    __device__ __forceinline__ void a_ready(const Unit&) const {}
    __device__ __forceinline__ void done(const Unit&) const {} };
struct S2Order { int blk, nblk;
    __device__ __forceinline__ bool next(int i, Unit& o) const { const int ui = blk + i * nblk; if (ui >= 128) return false; o.pm = ui >> 1; o.pn = (ui >> 2) * 2 + (ui & 1); return true; }
    __device__ __forceinline__ void a_ready(const Unit&) const {}
    __device__ __forceinline__ void done(const Unit&) const {} };
template <class F> struct Epi {
    static constexpr bool PERM = true, AFTER_DRAIN = false, MID = F::MID;
    F f;
    __device__ __forceinline__ void operator()(const f32x4 (&acc)[2][2][4][2], const Unit& u, int wr, int wc, int fr, int fq) const {
        asm volatile("" : "+v"(fr), "+v"(fq));
        const int rowb = u.pm * BM + wr * 64 + fr, colb = u.pn * BM + wc * 32 + 8 * fq;
        float rsv[8];
#pragma unroll
        for (int i = 0; i < 8; ++i) { rsv[i] = 1.f; if constexpr (F::ROWSCALE) rsv[i] = f.rscale(rowb + (i >> 2) * HALF + (i & 3) * 16); }
#pragma unroll
        for (int ai = 0; ai < 2; ++ai)
#pragma unroll
            for (int m = 0; m < 4; ++m) {
                const int row = rowb + ai * HALF + m * 16; const float rs = rsv[ai * 4 + m];
                float ss = 0.f;
#pragma unroll
                for (int bj = 0; bj < 2; ++bj) { f32x4 w0, w1; f.put8(row, colb + bj * HALF, acc[ai][bj][m][0] * rs, acc[ai][bj][m][1] * rs, w0, w1);
                    ss += (w0[0] * w0[0] + w0[1] * w0[1] + w0[2] * w0[2] + w0[3] * w0[3]) + (w1[0] * w1[0] + w1[1] * w1[1] + w1[2] * w1[2] + w1[3] * w1[3]); }
                if constexpr (F::SSQ) { ss += __shfl_xor(ss, 16); ss += __shfl_xor(ss, 32); if (fq == 0) f.ssq(row, u.pn * 4 + wc, ss); }
                asm volatile("" ::: "memory");
            }
    }
    __device__ __forceinline__ void midscale(f32x4 (&acc)[2][2][4][2], const Unit& u, int wr, int wc, int fr, int fq) const {
        if constexpr (F::MID) {
            asm volatile("" : "+v"(fr));
            const int rowb = u.pm * BM + wr * 64 + fr;
#pragma unroll
            for (int ai = 0; ai < 2; ++ai)
#pragma unroll
                for (int m = 0; m < 4; ++m) { const float s = f.mid(rowb + ai * HALF + m * 16);
#pragma unroll
                    for (int bj = 0; bj < 2; ++bj)
#pragma unroll
                        for (int n = 0; n < 2; ++n) acc[ai][bj][m][n] *= s; }
        }
    }
};
template <class Epi, class Sched, bool ALIGN_EPI = false, bool SP2 = false>
__device__ __forceinline__ void gemm_phase(PG8_LAS unsigned char* lds, const Gemm g, const Sched& S, const Epi& E, const int tid) {
    const int wid = __builtin_amdgcn_readfirstlane(tid >> 6), lane = tid & 63, wr = wid >> 2, wc = wid & 3, fr = lane & 15, fq = lane >> 4;
    const int K = g.K, nt = K / BK;
    unsigned voffA[2], voffB[2];
#pragma unroll
    for (int i = 0; i < 2; ++i) { int R, C; stage_rc(tid * 16 + i * 8192, R, C); const int Rb = Epi::PERM ? ((R & ~31) + perm32(R & 31)) : R;
        voffA[i] = (unsigned)(R * g.lda + C) * 2u; voffB[i] = (unsigned)(Rb * g.ldb + C) * 2u; }
    const size_t kstep = (size_t)(BK * 2);
    const size_t hstepA = (size_t)HALF * g.lda * 2, hstepB = (size_t)HALF * g.ldb * 2;
    const size_t tstepA = 2 * hstepA, tstepB = 2 * hstepB;
    const unsigned ldsw = (unsigned)wid * 1024u;
    const int aoff = lds_byte(wr * 64 + fr, fq * 8), boff = lds_byte(wc * 32 + fr, fq * 8);
#define PG8_SA(b, h) (((b) * 2 + (h)) * HTB)
#define PG8_SB(b, h) ((4 + (b) * 2 + (h)) * HTB)
#define PG8_STAGE(bufoff, gbase, voff) do { _Pragma("unroll") for (int _i = 0; _i < 2; ++_i) \
        __builtin_amdgcn_global_load_lds((const unsigned*)((const char*)(gbase) + (voff)[_i]), (PG8_LAS unsigned*)(lds + (bufoff) + ldsw + _i * 8192), 16, 0, 0); } while (0)
#define PG8_LDA(dst, b, h) do { _Pragma("unroll") for (int m = 0; m < 4; ++m) _Pragma("unroll") for (int k = 0; k < 2; ++k) dst[m][k] = *(const PG8_LAS bf16x8*)(lds + PG8_SA(b, h) + aoff + m * 2048 + k * 1024); } while (0)
#define PG8_LDB(dst, b, h) do { _Pragma("unroll") for (int n = 0; n < 2; ++n) _Pragma("unroll") for (int k = 0; k < 2; ++k) dst[n][k] = *(const PG8_LAS bf16x8*)(lds + PG8_SB(b, h) + boff + n * 2048 + k * 1024); } while (0)
#define PG8_MMA(ai, bj, At, Bt) do { __builtin_amdgcn_s_setprio(1); _Pragma("unroll") for (int m = 0; m < 4; ++m) _Pragma("unroll") for (int n = 0; n < 2; ++n) _Pragma("unroll") for (int k = 0; k < 2; ++k) \
        acc[ai][bj][m][n] = __builtin_amdgcn_mfma_f32_16x16x32_bf16(Bt[n][k], At[m][k], acc[ai][bj][m][n], 0, 0, 0); __builtin_amdgcn_s_setprio(0); } while (0)
#define PG8_WAIT_V(n) asm volatile("s_waitcnt vmcnt(" #n ")" ::: "memory")
#define PG8_WAIT_L(n) asm volatile("s_waitcnt lgkmcnt(" #n ")" ::: "memory")
#define PG8_BAR __builtin_amdgcn_s_barrier()
#define PG8_SCHED __builtin_amdgcn_sched_barrier(0)
    Unit cur, nxt; int ui = 0;
    if (!S.next(0, cur)) return;
    f32x4 acc[2][2][4][2];
#pragma unroll
    for (int a = 0; a < 2; ++a)
#pragma unroll
        for (int b = 0; b < 2; ++b)
#pragma unroll
            for (int m = 0; m < 4; ++m)
#pragma unroll
                for (int n = 0; n < 2; ++n) acc[a][b][m][n] = (f32x4){0.f, 0.f, 0.f, 0.f};
    bf16x8 At[4][2], B0[2][2], B1[2][2];
    const char* cA = (const char*)g.A + (size_t)cur.pm * tstepA; const char* cB = (const char*)g.Bt + (size_t)cur.pn * tstepB;
    S.a_ready(cur);
    if constexpr (SP2) {
        PG8_STAGE(PG8_SB(0, 0), cB, voffB); PG8_STAGE(PG8_SB(0, 1), cB + hstepB, voffB); PG8_STAGE(PG8_SA(0, 0), cA, voffA); PG8_STAGE(PG8_SA(0, 1), cA + hstepA, voffA);
        if (wr == 1) PG8_BAR;
        PG8_WAIT_V(2); PG8_BAR;
        PG8_STAGE(PG8_SB(1, 0), cB + kstep, voffB); PG8_STAGE(PG8_SA(1, 0), cA + kstep, voffA); PG8_STAGE(PG8_SB(1, 1), cB + hstepB + kstep, voffB);
        PG8_WAIT_V(6); PG8_BAR;
    } else {
        PG8_STAGE(PG8_SB(0, 0), cB, voffB); PG8_STAGE(PG8_SA(0, 0), cA, voffA); PG8_STAGE(PG8_SB(0, 1), cB + hstepB, voffB); PG8_STAGE(PG8_SA(0, 1), cA + hstepA, voffA);
        if (wr == 1) PG8_BAR;
        PG8_WAIT_V(4); PG8_BAR;
        PG8_STAGE(PG8_SB(1, 0), cB + kstep, voffB); PG8_STAGE(PG8_SA(1, 0), cA + kstep, voffA); PG8_STAGE(PG8_SB(1, 1), cB + hstepB + kstep, voffB);
        PG8_WAIT_V(6); PG8_BAR;
    }
    for (;;) {
        const bool has_next = S.next(ui + 1, nxt);
        const char* nA = has_next ? (const char*)g.A + (size_t)nxt.pm * tstepA : cA; const char* nB = has_next ? (const char*)g.Bt + (size_t)nxt.pn * tstepB : cB;
        for (int t = 0; t < nt; t += 2) {
            const bool last = (t == nt - 2);
            if constexpr (Epi::MID) { if (t * BK == g.kmid) E.midscale(acc, cur, wr, wc, fr, fq); }
            const char* a1 = cA + (size_t)(t + 1) * kstep;
            const char* a2 = last ? nA : cA + (size_t)(t + 2) * kstep; const char* b2 = last ? nB : cB + (size_t)(t + 2) * kstep;
            const char* a3 = a2 + kstep; const char* b3 = b2 + kstep;
            if (last && has_next) S.a_ready(nxt);
            if constexpr (SP2) {
            PG8_LDB(B0, 0, 0); PG8_LDB(B1, 0, 1); PG8_SCHED; PG8_LDA(At, 0, 0); PG8_STAGE(PG8_SA(1, 1), a1 + hstepA, voffA);
            PG8_WAIT_V(8); PG8_WAIT_L(0); PG8_BAR; PG8_MMA(0, 0, At, B0); PG8_MMA(0, 1, At, B1); PG8_BAR; PG8_SCHED;
            PG8_LDA(At, 0, 1); PG8_STAGE(PG8_SB(0, 0), b2, voffB); PG8_STAGE(PG8_SB(0, 1), b2 + hstepB, voffB); PG8_STAGE(PG8_SA(0, 0), a2, voffA);
            PG8_WAIT_V(8); PG8_WAIT_L(0); PG8_BAR; PG8_MMA(1, 0, At, B0); PG8_MMA(1, 1, At, B1); PG8_BAR; PG8_SCHED;
            PG8_LDB(B0, 1, 0); PG8_LDB(B1, 1, 1); PG8_SCHED; PG8_LDA(At, 1, 0); PG8_STAGE(PG8_SA(0, 1), a2 + hstepA, voffA);
            PG8_WAIT_V(8); PG8_WAIT_L(0); PG8_BAR; PG8_MMA(0, 0, At, B0); PG8_MMA(0, 1, At, B1); PG8_BAR; PG8_SCHED;
            PG8_LDA(At, 1, 1); PG8_STAGE(PG8_SB(1, 0), b3, voffB); PG8_STAGE(PG8_SB(1, 1), b3 + hstepB, voffB); PG8_STAGE(PG8_SA(1, 0), a3, voffA);
            PG8_WAIT_V(8); PG8_WAIT_L(0); PG8_BAR; PG8_MMA(1, 0, At, B0); PG8_MMA(1, 1, At, B1); PG8_BAR; PG8_SCHED;
            } else {
            PG8_LDB(B0, 0, 0); PG8_SCHED; PG8_LDA(At, 0, 0); PG8_STAGE(PG8_SA(1, 1), a1 + hstepA, voffA);
            PG8_WAIT_L(8); PG8_BAR; PG8_WAIT_L(0); PG8_MMA(0, 0, At, B0); PG8_BAR; PG8_SCHED;
            PG8_LDB(B1, 0, 1); PG8_STAGE(PG8_SB(0, 0), b2, voffB);
            PG8_BAR; PG8_WAIT_L(0); PG8_MMA(0, 1, At, B1); PG8_BAR;
            PG8_LDA(At, 0, 1); PG8_STAGE(PG8_SA(0, 0), a2, voffA);
            PG8_BAR; PG8_WAIT_L(0); PG8_MMA(1, 0, At, B0); PG8_BAR; PG8_SCHED;
            PG8_STAGE(PG8_SB(0, 1), b2 + hstepB, voffB);
            PG8_WAIT_V(6); PG8_BAR; PG8_MMA(1, 1, At, B1); PG8_BAR;
            PG8_LDB(B0, 1, 0); PG8_SCHED; PG8_LDA(At, 1, 0); PG8_STAGE(PG8_SA(0, 1), a2 + hstepA, voffA);
            PG8_WAIT_L(8); PG8_BAR; PG8_WAIT_L(0); PG8_MMA(0, 0, At, B0); PG8_BAR; PG8_SCHED;
            PG8_LDB(B1, 1, 1); PG8_STAGE(PG8_SB(1, 0), b3, voffB);
            PG8_BAR; PG8_WAIT_L(0); PG8_MMA(0, 1, At, B1); PG8_BAR;
            PG8_LDA(At, 1, 1); PG8_STAGE(PG8_SA(1, 0), a3, voffA);
            PG8_BAR; PG8_WAIT_L(0); PG8_MMA(1, 0, At, B0); PG8_BAR; PG8_SCHED;
            PG8_STAGE(PG8_SB(1, 1), b3 + hstepB, voffB);
            PG8_WAIT_V(6); PG8_BAR; PG8_MMA(1, 1, At, B1); PG8_BAR;
            }
        }
        if constexpr (ALIGN_EPI) { if (wr == 0) PG8_BAR; }
        if constexpr (!Epi::AFTER_DRAIN) { E(acc, cur, wr, wc, fr, fq); S.done(cur); }
        if (!has_next) break;
#pragma unroll
        for (int a = 0; a < 2; ++a)
#pragma unroll
            for (int b = 0; b < 2; ++b)
#pragma unroll
                for (int m = 0; m < 4; ++m)
#pragma unroll
                    for (int n = 0; n < 2; ++n) acc[a][b][m][n] = (f32x4){0.f, 0.f, 0.f, 0.f};
        cur = nxt; cA = nA; cB = nB; ++ui;
        if constexpr (ALIGN_EPI) { if (wr == 1) PG8_BAR; }
    }
    PG8_WAIT_V(0);
    if constexpr (!ALIGN_EPI) { if (wr == 0) PG8_BAR; }
    PG8_BAR;
    if constexpr (Epi::AFTER_DRAIN) { E.fused(acc, cur, wr, wc, fr, fq, lds, wid, lane); S.done(cur); }
#undef PG8_SA
#undef PG8_SB
#undef PG8_STAGE
#undef PG8_LDA
#undef PG8_LDB
#undef PG8_MMA
#undef PG8_WAIT_V
#undef PG8_WAIT_L
#undef PG8_BAR
#undef PG8_SCHED
}

}

template <class F, class Sched>
__device__ __forceinline__ void run_gemm(unsigned char* lds, const GemmD& g, const Sched& S, const F& f, const int tid) {
    pg8::Gemm pg; pg.A = g.A; pg.Bt = g.Bt; pg.K = g.K; pg.lda = (int)g.lda; pg.ldb = (int)g.ldb; pg.kmid = g.kmid;
    pg8::Epi<F> E; E.f = f;
    pg8::gemm_phase<pg8::Epi<F>, Sched, true, true>((PG8_LAS unsigned char*)lds, pg, S, E, tid);
}
__device__ __forceinline__ void rstd_rows(const Ctx& c, const float* ssq, int nslot, float* rsx, int nN, int G, int cidx) {
    pg8::StaticOrder S0; S0.init(M, nN * 256, G, cidx); Unit u0;
    for (int i = 0; S0.next(i, u0); ++i) if (c.tid < 256) { const int row = u0.pm * 256 + c.tid; rsx[row] = rsqrtf(sumn(ssq + (long)row * 16, nslot) * (1.f / D) + EPS); }
    VM_WAIT(); __syncthreads();
}
template <class Epi>
__device__ __forceinline__ void gemm_phase_sub(const Ctx& c, const GemmD& g, int nM, int nN, const Epi& E, int G, int cidx) {
    pg8::StaticOrder S; S.init(nM * 256, nN * 256, G, cidx);
    run_gemm(c.lds, g, S, E, c.tid);
}
template <class Epi>
__device__ __forceinline__ void gemm_phase_dense(const Ctx& c, const GemmD& g, int nM, int nN, const Epi& E) {
#ifdef USE_SGEMM
    const int nU = nM * nN;
    for (int ui = c.blk; ui < nU; ui += c.nblk) { Unit u; u.pn = ui % nN; u.pm = ui / nN; sgemm_unit(g, u, E, c.wave, c.lane); }
#else
    pg8::StaticOrder S; S.init(nM * 256, nN * 256, c.nblk, c.blk);
    run_gemm(c.lds, g, S, E, c.tid);
#endif
}

__device__ __forceinline__ void transpose_item(const float* W, int K, int N, bf16_t* WT, const float* gain, float* scr, int item, int lane) {
    const int nblk = N / 32, kb = item / nblk, nb = item % nblk, k0 = 64 * kb, n0 = 32 * nb;
    { f32x4 v[8];
#pragma unroll
      for (int i = 0; i < 8; ++i) v[i] = *(const f32x4*)(W + (size_t)(k0 + 8 * i + (lane >> 3)) * N + n0 + 4 * (lane & 7));
#pragma unroll
      for (int i = 0; i < 8; ++i) { const int kk = 8 * i + (lane >> 3); const float gg = gain ? gain[k0 + kk] : 1.f; float* s = scr + kk * 33 + 4 * (lane & 7);
          s[0] = v[i][0] * gg; s[1] = v[i][1] * gg; s[2] = v[i][2] * gg; s[3] = v[i][3] * gg; } }
    LDS_WAIT(); asm volatile("" ::: "memory");
    const int cc = lane & 7;
#pragma unroll
    for (int j = 0; j < 4; ++j) { const int n = (lane >> 3) + 8 * j; const float* s = scr + (8 * cc) * 33 + n;
        u32x4 o; o.x = pk2(s[0 * 33], s[1 * 33]); o.y = pk2(s[2 * 33], s[3 * 33]); o.z = pk2(s[4 * 33], s[5 * 33]); o.w = pk2(s[6 * 33], s[7 * 33]);
        *(u32x4*)(WT + (size_t)(n0 + n) * K + k0 + 8 * cc) = o; }
    LDS_WAIT(); asm volatile("" ::: "memory");
}
__device__ __forceinline__ void transpose_wg_item(const Ctx& c, const float* W, int K, int N, bf16_t* WT, const float* gain, int item) {
    const int nblk = N / 256, kb = item / nblk, nb = item % nblk, k0 = 64 * kb, n0 = 256 * nb;
    float* T = (float*)c.lds;
    f32x4 v[8];
#pragma unroll
    for (int i = 0; i < 8; ++i) { const int idx = i * 512 + c.tid, row = idx >> 6, c4 = idx & 63; v[i] = *(const f32x4*)(W + (size_t)(k0 + row) * N + n0 + 4 * c4); }
#pragma unroll
    for (int i = 0; i < 8; ++i) { const int idx = i * 512 + c.tid, row = idx >> 6, c4 = idx & 63; const float gg = gain ? gain[k0 + row] : 1.f; float* s = T + row * 257 + 4 * c4;
        s[0] = v[i][0] * gg; s[1] = v[i][1] * gg; s[2] = v[i][2] * gg; s[3] = v[i][3] * gg; }
    __syncthreads();
#pragma unroll
    for (int j = 0; j < 4; ++j) { const int id = j * 512 + c.tid, n = id >> 3, cc = id & 7; const float* s = T + (8 * cc) * 257 + n;
        u32x4 o; o.x = pk2(s[0 * 257], s[1 * 257]); o.y = pk2(s[2 * 257], s[3 * 257]); o.z = pk2(s[4 * 257], s[5 * 257]); o.w = pk2(s[6 * 257], s[7 * 257]);
        *(u32x4*)(WT + (size_t)(n0 + n) * K + k0 + 8 * cc) = o; }
    __syncthreads();
}
__device__ __forceinline__ void cvt_range(const Ctx& c, const float* src, bf16_t* dst, size_t n) {
    const size_t nv = n / 8, stride = (size_t)c.nblk * 512;
    for (size_t v0 = (size_t)c.blk * 512 + c.tid; v0 < nv; v0 += 4 * stride) {
        f32x4 a[4], b[4];
#pragma unroll
        for (int u = 0; u < 4; ++u) { const size_t v = v0 + u * stride < nv ? v0 + u * stride : v0; a[u] = *(const f32x4*)(src + v * 8); b[u] = *(const f32x4*)(src + v * 8 + 4); }
#pragma unroll
        for (int u = 0; u < 4; ++u) { const size_t v = v0 + u * stride; if (v < nv) { u32x4 o; o.x = pk2(a[u][0], a[u][1]); o.y = pk2(a[u][2], a[u][3]); o.z = pk2(b[u][0], b[u][1]); o.w = pk2(b[u][2], b[u][3]);
            *(u32x4*)(dst + v * 8) = o; } }
    }
}
__device__ __forceinline__ void ssm_tables_unit(const Ctx& c, const Args& a, int layer, int g, int part, int nparts) {
    float* Apow = (float*)c.lds;
    float* Bre = Apow + 2 * 33 * 64 * 2;
    float* Bim = Bre + 2 * 64 * 16;
    float* Cre = Bim + 2 * 64 * 16;
    float* Cim = Cre + 2 * 16 * 64;
    float* Tt = Cim + 2 * 16 * 64;
    unsigned char* lw = a.ws + WS_LW + (size_t)layer * LW_STRIDE;
    float* AL = (float*)(lw + LW_AL);
    bf16_t* WE = (bf16_t*)(lw + LW_WE) + (size_t)g * 256 * 512;
    bf16_t* WY = (bf16_t*)(lw + LW_WY) + (size_t)g * 512 * KCAT;
    const int tid = c.tid;
    unsigned char* rgn_ws = a.ws; (void)rgn_ws;
    __syncthreads();
    RGN(11, 0);
    if (tid < 128) {
        const int dir = tid >> 6, n = tid & 63; const int ldg = (layer * 2 + dir) * NG + g;
        const float lre = a.in[I_LRE][ldg * 64 + n], lim = a.in[I_LIM][ldg * 64 + n];
        const float dt = expf(a.in[I_LOGDT][ldg]);
        { const float dec = expf(lre * dt); float sn, cs; sincosf(lim * dt, &sn, &cs); const float a1r = dec * cs, a1i = dec * sn;
          float pr = 1.f, pi = 0.f;
          for (int k = 0; k <= 32; ++k) { Apow[((dir * 33 + k) * 64 + n) * 2 + 0] = pr; Apow[((dir * 33 + k) * 64 + n) * 2 + 1] = pi;
              const float nr_ = pr * a1r - pi * a1i, ni_ = pr * a1i + pi * a1r; pr = nr_; pi = ni_; } }
        const float abr = Apow[((dir * 33 + 1) * 64 + n) * 2 + 0], abi = Apow[((dir * 33 + 1) * 64 + n) * 2 + 1];
        const float den = lre * lre + lim * lim, nr = abr - 1.f;
        const float fre = (nr * lre + abi * lim) / den, fim = (abi * lre - nr * lim) / den;
        for (int q = 0; q < 16; ++q) { const float br = a.in[I_BRE][(ldg * 64 + n) * 16 + q], bi = a.in[I_BIM][(ldg * 64 + n) * 16 + q];
            Bre[(dir * 64 + n) * 16 + q] = fre * br - fim * bi; Bim[(dir * 64 + n) * 16 + q] = fre * bi + fim * br; }
        for (int p = 0; p < 16; ++p) { Cre[(dir * 16 + p) * 64 + n] = a.in[I_CRE][(ldg * 16 + p) * 64 + n]; Cim[(dir * 16 + p) * 64 + n] = a.in[I_CIM][(ldg * 16 + p) * 64 + n]; }
        if (part == 0) { AL[((dir * NG + g) * 64 + n) * 2 + 0] = Apow[((dir * 33 + 32) * 64 + n) * 2 + 0];
        AL[((dir * NG + g) * 64 + n) * 2 + 1] = Apow[((dir * 33 + 32) * 64 + n) * 2 + 1]; }
    }
    __syncthreads();
    RGN(11, 1); RGN(12, 0);
    const int kk_lo = nparts == 4 ? 8 * part : 0, nkk = nparts == 4 ? 39 : 63;
    {
        const int l15 = c.lane & 15, l4 = c.lane >> 4;
      for (int kb0 = 0; kb0 < nkk; kb0 += 40) {
        f32x4 accs[5]; int ks[5]; bool val[5];
#pragma unroll
        for (int i = 0; i < 5; ++i) { const int kx = kb0 + c.wave + 8 * i; val[i] = kx < nkk; ks[i] = kk_lo + (val[i] ? kx : 0) - 31; accs[i] = (f32x4){0.f, 0.f, 0.f, 0.f}; }
#pragma unroll 2
        for (int st = 0; st < 32; ++st) {
            const int kidx = 4 * st + l4, n = kidx & 63; const bool lo = kidx < 64;
            const float cr0 = Cre[l15 * 64 + n], ci0 = Cim[l15 * 64 + n], cr1 = Cre[(16 + l15) * 64 + n], ci1 = Cim[(16 + l15) * 64 + n];
            const float b0 = lo ? Bre[n * 16 + l15] : Bim[n * 16 + l15], b1 = lo ? Bre[(64 + n) * 16 + l15] : Bim[(64 + n) * 16 + l15];
#pragma unroll
            for (int i = 0; i < 5; ++i) {
                const int dir = ks[i] < 0 ? 1 : 0, e = ks[i] < 0 ? -ks[i] : ks[i];
                const float ar = Apow[((dir * 33 + e) * 64 + n) * 2 + 0], ai = Apow[((dir * 33 + e) * 64 + n) * 2 + 1];
                const float cr = dir ? cr1 : cr0, ci = dir ? ci1 : ci0;
                const float av = lo ? (cr * ar - ci * ai) : -(cr * ai + ci * ar);
                accs[i] = __builtin_amdgcn_mfma_f32_16x16x4f32(av, dir ? b1 : b0, accs[i], 0, 0, 0);
            }
        }
#pragma unroll
        for (int i = 0; i < 5; ++i) if (val[i] && ks[i] == 0) {
#pragma unroll 4
            for (int st = 0; st < 32; ++st) {
                const int kidx = 4 * st + l4, n = kidx & 63; const bool lo = kidx < 64;
                const float cr = Cre[(16 + l15) * 64 + n], ci = Cim[(16 + l15) * 64 + n];
                const float ar = Apow[((33 + 0) * 64 + n) * 2 + 0], ai = Apow[((33 + 0) * 64 + n) * 2 + 1];
                const float av = lo ? (cr * ar - ci * ai) : -(cr * ai + ci * ar);
                const float bv = lo ? Bre[(64 + n) * 16 + l15] : Bim[(64 + n) * 16 + l15];
                accs[i] = __builtin_amdgcn_mfma_f32_16x16x4f32(av, bv, accs[i], 0, 0, 0);
            }
        }
#pragma unroll
        for (int i = 0; i < 5; ++i) if (val[i]) { const int kk = ks[i] + 31;
#pragma unroll
            for (int r = 0; r < 4; ++r) { const int p = 4 * l4 + r;
                Tt[(kk * 16 + p) * 16 + l15] = accs[i][r] + ((ks[i] == 0 && l15 == p) ? a.in[I_DSKIP][layer * 512 + 16 * g + p] : 0.f); } }
      }
    }
    __syncthreads();
    RGN(12, 1); RGN(13, 0);
    const int wy_lo = (512 * 96 / nparts) * part, wy_hi = wy_lo + 512 * 96 / nparts, we_lo = (256 * 64 / nparts) * part, we_hi = we_lo + 256 * 64 / nparts;
    for (int it = wy_lo + tid; it < wy_hi; it += 512) {
        const int nout = it / 96, kin0 = (it % 96) * 8, j = nout >> 4, p = nout & 15;
        float v[8];
        if (kin0 < 512) { const int s = kin0 >> 4, q0 = kin0 & 15, kk = j - s + 31;
#pragma unroll
            for (int i = 0; i < 8; ++i) v[i] = Tt[(kk * 16 + p) * 16 + q0 + i]; }
        else { const int comp = kin0 - 512, dir = comp >> 7, reim = (comp >> 6) & 1, n0 = comp & 63, e = dir == 0 ? j + 1 : 32 - j;
#pragma unroll
            for (int i = 0; i < 8; ++i) { const int n = n0 + i; const float cr = Cre[(dir * 16 + p) * 64 + n], ci = Cim[(dir * 16 + p) * 64 + n];
                const float ar = Apow[((dir * 33 + e) * 64 + n) * 2 + 0], ai = Apow[((dir * 33 + e) * 64 + n) * 2 + 1];
                v[i] = reim == 0 ? (cr * ar - ci * ai) : -(cr * ai + ci * ar); } }
        u32x4 o; o.x = pk2(v[0], v[1]); o.y = pk2(v[2], v[3]); o.z = pk2(v[4], v[5]); o.w = pk2(v[6], v[7]);
        *(u32x4*)(WY + (size_t)nout * KCAT + kin0) = o;
    }
    for (int it = we_lo + tid; it < we_hi; it += 512) {
        const int comp = it >> 6, kin0 = (it & 63) * 8, j = kin0 >> 4, q0 = kin0 & 15, dir = comp >> 7, reim = (comp >> 6) & 1, n = comp & 63, e = dir == 0 ? 31 - j : j;
        const float ar = Apow[((dir * 33 + e) * 64 + n) * 2 + 0], ai = Apow[((dir * 33 + e) * 64 + n) * 2 + 1];
        float v[8];
#pragma unroll
        for (int i = 0; i < 8; ++i) { const float br = Bre[(dir * 64 + n) * 16 + q0 + i], bi = Bim[(dir * 64 + n) * 16 + q0 + i]; v[i] = reim == 0 ? (ar * br - ai * bi) : (ar * bi + ai * br); }
        u32x4 o; o.x = pk2(v[0], v[1]); o.y = pk2(v[2], v[3]); o.z = pk2(v[4], v[5]); o.w = pk2(v[6], v[7]);
        *(u32x4*)(WE + (size_t)comp * 512 + kin0) = o;
    }
    __syncthreads();
    RGN(13, 1);
}
__device__ __forceinline__ void cvt_fp8_layer(const Ctx& c, const Args& a, int layer, int widx, int nw) {
    for (int r0 = widx; r0 < 2 * 16384; r0 += 4 * nw) {
      f32x4 vq[4][4];
#pragma unroll
      for (int u = 0; u < 4; ++u) { const int q = r0 + u * nw < 2 * 16384 ? r0 + u * nw : r0; const int tab = q >> 14, rr = layer * 16384 + (q & 16383);
          const float* srcp = (tab ? a.in[I_EV] : a.in[I_EU]) + (size_t)rr * D + 16 * c.lane;
#pragma unroll
          for (int j = 0; j < 4; ++j) vq[u][j] = *(const f32x4*)(srcp + 4 * j); }
#pragma unroll
      for (int u = 0; u < 4; ++u) {
        const int q = r0 + u * nw; if (q >= 2 * 16384) break;
        const int tab = q >> 14, rr = layer * 16384 + (q & 16383), r = tab * 32768 + rr;
        f32x4 v[4]; float mx = 0.f;
#pragma unroll
        for (int j = 0; j < 4; ++j) { v[j] = vq[u][j]; mx = fmaxf(mx, fmaxf(fmaxf(fabsf(v[j][0]), fabsf(v[j][1])), fmaxf(fabsf(v[j][2]), fabsf(v[j][3])))); }
        mx = wave_max(mx);
        const float sc = mx > 0.f ? 448.f / mx : 1.f;
        u32x4 o;
#pragma unroll
        for (int j = 0; j < 4; ++j) { int w = 0;
            w = __builtin_amdgcn_cvt_pk_fp8_f32(fminf(fmaxf(v[j][0] * sc, -448.f), 448.f), fminf(fmaxf(v[j][1] * sc, -448.f), 448.f), w, false);
            w = __builtin_amdgcn_cvt_pk_fp8_f32(fminf(fmaxf(v[j][2] * sc, -448.f), 448.f), fminf(fmaxf(v[j][3] * sc, -448.f), 448.f), w, true);
            o[j] = (unsigned)w; }
        *(u32x4*)(a.ws + (tab ? WS_EV : WS_EU) + (size_t)rr * D + 16 * c.lane) = o;
        if (c.lane == 0) ((float*)(a.ws + WS_ESC))[r] = mx > 0.f ? mx * (1.f / 448.f) : 1.f;
      }
    }
}
__device__ __forceinline__ void p0_prologue(const Ctx& c, const Args& a) {
    unsigned char* rgn_ws = a.ws; (void)rgn_ws; RGN(4, 0);
    const bool ssm_first = (c.blk & 1) == 0;
#define P0_SSM() do { const int np = c.nblk >= 256 ? 4 : 1;     \
      for (int u = c.blk; u < 2 * NG * np; u += c.nblk) ssm_tables_unit(c, a, (u / np) / NG, (u / np) % NG, u % np, np); } while (0)
    if (ssm_first) P0_SSM();
    RGN(4, 1); RGN(5, 0);
    const int gw = c.blk * 8 + c.wave, NGW = c.nblk * 8;
    {
        constexpr int I0 = 80, I1 = 16, I2 = 64, I3 = 128, I4 = 64, I5 = 16, IL = I0 + I1 + I2 + I3 + I4 + I5;
        __syncthreads();
        for (int it = c.blk; it < 2 * IL; it += c.nblk) {
            const int L = it / IL; int r = it % IL; unsigned char* lw = a.ws + WS_LW + (size_t)L * LW_STRIDE;
            if (r < I0) { transpose_wg_item(c, a.in[I_WIN] + (size_t)L * D * DIN, D, DIN, (bf16_t*)(lw + LW_WIN), a.in[I_NMIXG] + L * D, r); continue; } r -= I0;
            if (r < I1) { transpose_wg_item(c, a.in[I_WGLU] + (size_t)L * 512 * 512, 512, 512, (bf16_t*)(lw + LW_WGLU), nullptr, r); continue; } r -= I1;
            if (r < I2) { const int k0 = 64 * (r / 4); const float* gn = k0 < 512 ? a.in[I_SSMG] + L * 512 : a.in[I_ATTG] + L * 512 - 512;
                transpose_wg_item(c, a.in[I_WOUT] + (size_t)L * D * D, D, D, (bf16_t*)(lw + LW_WOUT), gn, r); continue; } r -= I2;
            if (r < I3) { transpose_wg_item(c, a.in[I_WQ] + (size_t)L * D * 2048, D, 2048, (bf16_t*)(lw + LW_WQ), a.in[I_NFFNG] + L * D, r); continue; } r -= I3;
            if (r < I4) { transpose_wg_item(c, a.in[I_WGATE] + (size_t)L * D * D, D, D, (bf16_t*)(lw + LW_WGATE), a.in[I_NPLEG] + L * D, r); continue; } r -= I4;
            transpose_wg_item(c, a.in[I_WPROJ] + (size_t)L * 256 * D, 256, D, (bf16_t*)(lw + LW_WPROJ), nullptr, r);
        }
    }
    RGN(5, 1); RGN(6, 0);
    cvt_fp8_layer(c, a, 0, gw, NGW);
    if (c.nblk != 256) cvt_fp8_layer(c, a, 1, gw, NGW);
    RGN(6, 1); RGN(7, 0);
    cvt_range(c, a.in[I_P], (bf16_t*)(a.ws + WS_PB), (size_t)2 * M * 256);
    for (int L = 0; L < 2; ++L) {
        cvt_range(c, a.in[I_SK1] + (size_t)L * 8 * 128 * 128, (bf16_t*)(a.ws + WS_LW + (size_t)L * LW_STRIDE + LW_SK1), (size_t)8 * 128 * 128);
        cvt_range(c, a.in[I_SK2] + (size_t)L * 8 * 128 * 128, (bf16_t*)(a.ws + WS_LW + (size_t)L * LW_STRIDE + LW_SK2), (size_t)8 * 128 * 128);
    }
    RGN(7, 1); RGN(8, 0);
    {
        bf16_t* XB = (bf16_t*)(a.ws + WS_XB); float* SSQ0 = (float*)(a.ws + WS_SSQ0);
        for (int m0 = gw; m0 < M; m0 += 4 * NGW) {
            f32x4 v[4][4];
#pragma unroll
            for (int u = 0; u < 4; ++u) { const int m = m0 + u * NGW < M ? m0 + u * NGW : m0; const f32x4* xr = (const f32x4*)(a.in[I_X] + (size_t)m * D) + c.lane;
#pragma unroll
                for (int j = 0; j < 4; ++j) v[u][j] = xr[64 * j]; }
#pragma unroll
            for (int u = 0; u < 4; ++u) { const int m = m0 + u * NGW; if (m >= M) break; float s = 0.f;
#pragma unroll
                for (int j = 0; j < 4; ++j) { const f32x4 w = v[u][j]; const u32x2 o = pack4(w); *(u32x2*)(XB + (size_t)m * D + 256 * j + 4 * c.lane) = o;
                    const float y0 = bflo(o.x), y1 = bfhi(o.x), y2 = bflo(o.y), y3 = bfhi(o.y); s += y0 * y0 + y1 * y1 + y2 * y2 + y3 * y3; }
                s = wave_sum(s);
                if (c.lane < 16) SSQ0[(size_t)m * 16 + c.lane] = c.lane == 0 ? s : 0.f; }
        }
    }
    RGN(8, 1);
    if (!ssm_first) P0_SSM();
#undef P0_SSM
    if (c.blk == c.nblk - 1) {
        float* R = (float*)(a.ws + WS_ROPE);
        for (int e = c.tid; e < 3072; e += 512) {
            const bool isr = e < 2048; const int pos = isr ? (e >> 4) : ((e - 2048) >> 4), f = e & 15;
            const float inv = powf(10000.f, -(float)f / 16.f), ang = (float)pos * inv; float sn, cs; sincosf(ang, &sn, &cs);
            if (isr) { R[e] = cs; R[2048 + e] = sn; } else { R[4096 + (e - 2048)] = cs; R[5120 + (e - 2048)] = sn; }
        }
    }
}

__device__ __forceinline__ void s1_unit(const Ctx& c, const Args& a, int layer, int gb  ) {
    unsigned char* lw = a.ws + WS_LW + (size_t)layer * LW_STRIDE;
    bf16_t* UC = (bf16_t*)(a.ws + WS_UCAT); float* EB = (float*)(a.ws + WS_EBUF);
    const int g = gb >> 1;
    GemmD gd; gd.A = UC; gd.lda = KCAT; gd.Bt = (const bf16_t*)(lw + LW_WE); gd.ldb = 512; gd.K = 512; gd.kmid = -1;
    EpiS1 E; E.ebuf = EB;
    Unit u; u.pm = gb; u.pn = g;
    unsigned char* rgn_ws = a.ws; (void)rgn_ws; if (layer == 0) RGN(1, 0);
#ifdef USE_SGEMM
    sgemm_unit(gd, u, E, c.wave, c.lane);
#else
    { pg8::OneUnit S; S.u = u; run_gemm(c.lds, gd, S, E, c.tid); }
#endif
    VM_WAIT(); __syncthreads();
    if (layer == 0) { RGN(1, 1); RGN(2, 0); }
    {
        const float* AL = (const float*)(lw + LW_AL);
        f32x4* Es4 = (f32x4*)c.lds; const float* Es = (const float*)c.lds;
        float* SEG = (float*)(c.lds + LDSCTL_OFF + 1024);
        const int n = c.lane, sg = c.wave;
        for (int dir = 0; dir < 2; ++dir) {
            {
#pragma unroll 1
                for (int k0 = 0; k0 < 16; k0 += 8) { f32x4 ev[8];
#pragma unroll
                    for (int k = 0; k < 8; ++k) { const int i = c.tid + 512 * (k0 + k), ch = i >> 5, q4 = i & 31; ev[k] = *(const f32x4*)(EB + ((size_t)gb * NCH + ch) * 256 + dir * 128 + q4 * 4); }
#pragma unroll
                    for (int k = 0; k < 8; ++k) Es4[c.tid + 512 * (k0 + k)] = ev[k]; }
            }
            __syncthreads();
            const float alr = AL[((dir * NG + g) * 64 + n) * 2 + 0], ali = AL[((dir * NG + g) * 64 + n) * 2 + 1];
            float hr = 0.f, hi = 0.f, pr = 1.f, pi = 0.f;
#pragma unroll 8
            for (int s = 0; s < 32; ++s) {
                const int st = sg * 32 + s, ch = dir == 0 ? st : NCH - 1 - st;
                const float er = Es[ch * 128 + n], ei = Es[ch * 128 + 64 + n];
                const float nr = alr * hr - ali * hi + er, ni = alr * hi + ali * hr + ei; hr = nr; hi = ni;
                const float qr = pr * alr - pi * ali, qi = pr * ali + pi * alr; pr = qr; pi = qi;
            }
            SEG[(sg * 64 + n) * 2] = hr; SEG[(sg * 64 + n) * 2 + 1] = hi;
            __syncthreads();
            float sr = 0.f, si = 0.f;
            for (int j = 0; j < sg; ++j) { const float er = SEG[(j * 64 + n) * 2], ei = SEG[(j * 64 + n) * 2 + 1];
                const float nr = pr * sr - pi * si + er, ni = pr * si + pi * sr + ei; sr = nr; si = ni; }
            hr = sr; hi = si;
            bf16_t* hc = UC + (size_t)gb * NCH * KCAT + 512 + dir * 128 + n;
#pragma unroll 8
            for (int s = 0; s < 32; ++s) {
                const int st = sg * 32 + s, ch = dir == 0 ? st : NCH - 1 - st;
                hc[(size_t)ch * KCAT] = (bf16_t)f2bf(hr); hc[(size_t)ch * KCAT + 64] = (bf16_t)f2bf(hi);
                const float er = Es[ch * 128 + n], ei = Es[ch * 128 + 64 + n];
                const float nr = alr * hr - ali * hi + er, ni = alr * hi + ali * hr + ei; hr = nr; hi = ni;
            }
            __syncthreads();
        }
    }
    if (layer == 0) RGN(2, 1);
}
constexpr int QKP_N = 8;
__device__ __forceinline__ void qkprep(const Ctx& c, const Args& a, int layer, int widx, int nw, int mode = 0, int tok0 = 0) {
    bf16_t* QR = (bf16_t*)(a.ws + WS_QRAW); bf16_t* KV = (bf16_t*)(a.ws + WS_KV); const float* R = (const float*)(a.ws + WS_ROPE);
    const int half = c.lane >> 5, i = c.lane & 31, f = i & 15;
    const int d = i < 16 ? i : 32 + (i - 16);
    unsigned char* rgn_ws = a.ws; (void)rgn_ws; if (layer == 0) RGN(3, 0);
    const float gq1 = a.in[I_QNG][layer * 64 + d], gq2 = a.in[I_QNG][layer * 64 + d + 16], gk1 = a.in[I_KNG][layer * 64 + d], gk2 = a.in[I_KNG][layer * 64 + d + 16];
    const int nitems = mode == 0 ? M * 5 : mode == 1 ? M * 4 : 256;
    for (int base = widx; base < nitems; base += QKP_N * nw) {
        bf16_t* p[QKP_N]; float x1[QKP_N], x2[QKP_N], cs[QKP_N], sn[QKP_N]; int hh[QKP_N]; bool ok[QKP_N];
#pragma unroll
        for (int u = 0; u < QKP_N; ++u) {
            int it = base + u * nw; ok[u] = it < nitems; if (!ok[u]) it = base;
            const int m = mode == 0 ? it / 5 : mode == 1 ? it >> 2 : tok0 + it; hh[u] = (mode == 0 ? it % 5 : mode == 1 ? (it & 3) : 4) * 2 + half;
            p[u] = hh[u] < 8 ? QR + (size_t)m * 512 + hh[u] * 64 : KV + (size_t)m * 256 + (hh[u] - 8) * 64;
            x1[u] = bf1(p[u][d]); x2[u] = bf1(p[u][d + 16]);
            const int s = m & (SEQ - 1);
            if (i < 16) { const int pos = s >> 6; cs[u] = R[pos * 16 + f]; sn[u] = R[2048 + pos * 16 + f]; }
            else { const int pos = s & 63; cs[u] = R[4096 + pos * 16 + f]; sn[u] = R[5120 + pos * 16 + f]; }
        }
#pragma unroll
        for (int u = 0; u < QKP_N; ++u) {
            float ss = x1[u] * x1[u] + x2[u] * x2[u];
#pragma unroll
            for (int o = 1; o < 32; o <<= 1) ss += __shfl_xor(ss, o);
            const float rstd = rsqrtf(ss * (1.f / 64.f) + EPS);
            const float y1 = x1[u] * rstd * (hh[u] < 8 ? gq1 : gk1), y2 = x2[u] * rstd * (hh[u] < 8 ? gq2 : gk2);
            float o1 = y1 * cs[u] - y2 * sn[u], o2 = y2 * cs[u] + y1 * sn[u];
            if (hh[u] < 8) { o1 *= C2; o2 *= C2; }
            if (ok[u]) { p[u][d] = (bf16_t)f2bf(o1); p[u][d + 16] = (bf16_t)f2bf(o2); }
        }
    }
    if (layer == 0) RGN(3, 1);
}

#include <hip/hip_bf16.h>
#include <cmath>
namespace attn_body {
using bf16=__hip_bfloat16;
using bf16x8=__attribute__((ext_vector_type(8)))short;
using s16x4=__attribute__((ext_vector_type(4)))short;
using f32x16=__attribute__((ext_vector_type(16)))float;
using u32x4=__attribute__((ext_vector_type(4)))unsigned;
constexpr int SEQ=8192,D=64,QPITCH=512,KVPITCH=256,OPITCH=1024;
constexpr int NW=8,QBLK=32,QB=QBLK*NW,KVBLK=64,NQB=SEQ/QB;
__device__ __forceinline__ int crow(int r,int hi){return (r&3)+8*(r>>2)+4*hi;}
#define SBAR() __builtin_amdgcn_sched_barrier(0)
__device__ __forceinline__ void cmask(f32x16&p0,f32x16&p1,int jb,int qrel,int hi){
  const float NEG=-INFINITY; int kb=64*jb+4*hi;
  #pragma unroll
  for(int r=0;r<16;++r){int kv=kb+(r&3)+8*(r>>2); if(kv>qrel)p0[r]=NEG; if(kv+32>qrel)p1[r]=NEG;}
}

constexpr int NSLOT=3, SLOTB=8192;
constexpr int LDS_K=0, LDS_V=NSLOT*SLOTB, LDS_WS=2*NSLOT*SLOTB, LDS_OST=LDS_WS+NW*64*4, LDS_BYTES=LDS_OST+NW*4096;
constexpr float C2=0.125f*1.4426950408889634f;
__device__ __forceinline__ void glds16(const void*gsrc,unsigned lds_dst){unsigned keep;
  asm volatile("s_mov_b32 %0, m0\n\ts_mov_b32 m0, %2\n\ts_nop 0\n\tglobal_load_lds_dwordx4 %1, off\n\ts_mov_b32 m0, %0":"=&s"(keep):"v"(gsrc),"s"(lds_dst):"memory");}
__device__ __forceinline__ float max3f(float a,float b,float c){float r;asm("v_max3_f32 %0, %1, %2, %3":"=v"(r):"v"(a),"v"(b),"v"(c));return r;}
__device__ __forceinline__ float max2f(float a,float b){float r;asm("v_max_f32_e32 %0, %1, %2":"=v"(r):"v"(a),"v"(b));return r;}
__device__ __forceinline__ float fadd_s(float a,float b){float r;asm("v_add_f32_e32 %0, %1, %2":"=v"(r):"v"(a),"v"(b));return r;}
__device__ __forceinline__ float fsub_s(float a,float b){float r;asm("v_sub_f32_e32 %0, %1, %2":"=v"(r):"v"(a),"v"(b));return r;}
typedef float f32x2_t __attribute__((ext_vector_type(2))); typedef __bf16 bf16x2_t __attribute__((ext_vector_type(2)));
__device__ __forceinline__ unsigned cvtpk_s(float lo,float hi){f32x2_t v={lo,hi};bf16x2_t b=__builtin_convertvector(v,bf16x2_t);return __builtin_bit_cast(unsigned,b);}
#define WAIT_BAR(N) asm volatile("s_waitcnt vmcnt(" #N ") lgkmcnt(0)\n\ts_barrier":::"memory")

__device__ __forceinline__ void qkt(f32x16&p0,f32x16&p1,const char*Kslot,const bf16x8*qr,const f32x16&negm,int r32,int hi){
  const char*kb=Kslot+hi*1024+r32*16;
  #pragma unroll
  for(int d0=0;d0<4;++d0){
    const bf16x8 b0=*reinterpret_cast<const bf16x8*>(kb+d0*2048);
    const bf16x8 b1=*reinterpret_cast<const bf16x8*>(kb+d0*2048+512);
    if(d0==0){p0=__builtin_amdgcn_mfma_f32_32x32x16_bf16(b0,qr[0],negm,0,0,0);p1=__builtin_amdgcn_mfma_f32_32x32x16_bf16(b1,qr[0],negm,0,0,0);}
    else{p0=__builtin_amdgcn_mfma_f32_32x32x16_bf16(b0,qr[d0],p0,0,0,0);p1=__builtin_amdgcn_mfma_f32_32x32x16_bf16(b1,qr[d0],p1,0,0,0);}}
}
typedef __attribute__((address_space(3))) const char* lds_cptr;
typedef short v4i16_t __attribute__((ext_vector_type(4)));
__device__ __forceinline__ void kload8(bf16x8*kf,lds_cptr kp){
  kf[0]=*(const __attribute__((address_space(3))) bf16x8*)(kp);      kf[1]=*(const __attribute__((address_space(3))) bf16x8*)(kp+512);
  kf[2]=*(const __attribute__((address_space(3))) bf16x8*)(kp+2048); kf[3]=*(const __attribute__((address_space(3))) bf16x8*)(kp+2560);
  kf[4]=*(const __attribute__((address_space(3))) bf16x8*)(kp+4096); kf[5]=*(const __attribute__((address_space(3))) bf16x8*)(kp+4608);
  kf[6]=*(const __attribute__((address_space(3))) bf16x8*)(kp+6144); kf[7]=*(const __attribute__((address_space(3))) bf16x8*)(kp+6656);
}
__device__ __forceinline__ void kload2(bf16x8*kf,lds_cptr kp,int j){ kf[2*j]=*(const __attribute__((address_space(3))) bf16x8*)(kp+j*2048); kf[2*j+1]=*(const __attribute__((address_space(3))) bf16x8*)(kp+j*2048+512); }
__device__ __forceinline__ s16x4 vtr(lds_cptr p){ return __builtin_bit_cast(s16x4,__builtin_amdgcn_ds_read_tr16_b64_v4i16((__attribute__((address_space(3))) v4i16_t*)p)); }
__device__ __forceinline__ float rowmax(const f32x16&p0,const f32x16&p1){
  float a=max3f(p0[0],p0[1],p1[0]),b=max3f(p0[2],p0[3],p1[1]);a=max3f(a,p1[2],p1[3]);
  #pragma unroll
  for(int r=4;r<16;r+=4){a=max3f(a,p0[r],p0[r+1]);b=max3f(b,p0[r+2],p0[r+3]);a=max3f(a,p1[r],p1[r+1]);b=max3f(b,p1[r+2],p1[r+3]);}
  const float m=max2f(a,b);
  auto rr=__builtin_amdgcn_permlane32_swap(__float_as_uint(m),__float_as_uint(m),false,false);
  return max2f(__uint_as_float(rr[0]),__uint_as_float(rr[1]));
}
__device__ __forceinline__ void pv(f32x16*o,int vb,bf16x8 pa0,bf16x8 pa1,bf16x8 pa2,bf16x8 pa3){
  #pragma unroll
  for(int d0=0;d0<2;++d0){s16x4 lo[4],hi[4];
    #pragma unroll
    for(int ks=0;ks<4;++ks){
      asm volatile("ds_read_b64_tr_b16 %0,%1 offset:%c2":"=&v"(lo[ks]):"v"(vb),"i"(d0*4096+ks*1024):"memory");
      asm volatile("ds_read_b64_tr_b16 %0,%1 offset:%c2":"=&v"(hi[ks]):"v"(vb),"i"(d0*4096+ks*1024+512):"memory");}
    asm volatile("s_waitcnt lgkmcnt(0)":::"memory");SBAR();
    #define PK(k) (bf16x8){lo[k][0],lo[k][1],lo[k][2],lo[k][3],hi[k][0],hi[k][1],hi[k][2],hi[k][3]}
    o[d0]=__builtin_amdgcn_mfma_f32_32x32x16_bf16(pa0,PK(0),o[d0],0,0,0);
    o[d0]=__builtin_amdgcn_mfma_f32_32x32x16_bf16(pa1,PK(1),o[d0],0,0,0);
    o[d0]=__builtin_amdgcn_mfma_f32_32x32x16_bf16(pa2,PK(2),o[d0],0,0,0);
    o[d0]=__builtin_amdgcn_mfma_f32_32x32x16_bf16(pa3,PK(3),o[d0],0,0,0);
    #undef PK
  }
}

#ifndef ATTN_STORE16
#define ATTN_STORE16(p,v) (*(u32x4*)(p)=(v))
#endif
template<int THRL> __device__ __forceinline__ void attn_unit(int b,int h,int qb,const bf16*Q,const bf16*KV,bf16*O,float*SSQA,char*shm,const int tid,const float mfix){
  const int lane=tid&63,r32=lane&31,hi=lane>>5; const int wid=__builtin_amdgcn_readfirstlane(tid>>6);
  const long rowbase=(long)b*SEQ; const int q0=qb*QB;
  const bf16*Qw=Q+(rowbase+q0+wid*QBLK)*QPITCH+h*D;
  const bf16*Kh=KV+rowbase*KVPITCH+(h>>2)*D,*Vh=Kh+128;
  const unsigned lds0=(unsigned)(uintptr_t)shm;
  float*wsf=(float*)(shm+LDS_WS)+wid*64;
  const bf16*ksrc=Kh+(long)lane*KVPITCH+wid*8;
  const bf16*vsrc=Vh+(long)(16*(wid&3)+(lane>>2))*KVPITCH+(wid>>2)*32+(lane&3)*8;
  const unsigned kdst=lds0+LDS_K+wid*1024, vdst=lds0+LDS_V+wid*1024;
  #define DMA_K(t,slot) glds16(ksrc+(long)(t)*KVBLK*KVPITCH,(unsigned)__builtin_amdgcn_readfirstlane(kdst+(slot)))
  #define DMA_V(t,slot) glds16(vsrc+(long)(t)*KVBLK*KVPITCH,(unsigned)__builtin_amdgcn_readfirstlane(vdst+(slot)))
  const int vb0=(int)(lds0+LDS_V)+((lane>>4)&1)*32+(lane&3)*8+(4*hi+((lane&15)>>2))*64;
  const char*Kbase=shm+LDS_K; bf16x8 kf[8];
  const lds_cptr shm3=(lds_cptr)shm; const lds_cptr kp0=shm3+LDS_K+hi*1024+r32*16; const lds_cptr vp0=shm3+LDS_V+((lane>>4)&1)*32+(lane&3)*8+(4*hi+((lane&15)>>2))*64;
  const int NT=SEQ/KVBLK;
  DMA_K(0,0);DMA_V(0,0);DMA_K(1,SLOTB);
  bf16x8 qr[4];
  #pragma unroll
  for(int d0=0;d0<4;++d0)qr[d0]=*reinterpret_cast<const bf16x8*>(&Qw[(long)r32*QPITCH+d0*16+hi*8]);
  float mhat=0.f,l_reg=0.f;f32x16 o[2];f32x16 negm;{float z_=0.f;asm volatile("":"+v"(z_));
  #pragma unroll
  for(int r=0;r<16;++r){o[0][r]=z_;o[1][r]=z_;negm[r]=(THRL<0)?(z_-mfix):z_;}}asm volatile("":"+v"(negm)); if(THRL<0)mhat=mfix;
  #define CMASK(P0,P1,t) do{}while(0)
  bool resc=false;
  #define START(P0,P1) do{ resc=false; \
    if constexpr(THRL>=0){ const float rm=rowmax(P0,P1); const float dl=rm; mhat=fadd_s(mhat,dl); \
      _Pragma("unroll") for(int r=0;r<16;++r){P0[r]=fsub_s(P0[r],dl);P1[r]=fsub_s(P1[r],dl);} \
      _Pragma("unroll") for(int r=0;r<16;++r)negm[r]=-mhat; asm volatile("":"+v"(negm)); } \
    _Pragma("unroll") for(int r=0;r<16;++r)P0[r]=__builtin_amdgcn_exp2f(P0[r]); }while(0)
  #define RESC() do{ if(resc){ asm volatile("s_waitcnt lgkmcnt(0)":::"memory"); \
      _Pragma("unroll") for(int d_=0;d_<2;++d_) _Pragma("unroll") for(int r=0;r<16;++r)o[d_][r]*=wsf[crow(r,hi)]; } }while(0)
  f32x16 pA0,pA1,pB0,pB1;
  int sl_prev=0,sl_cur=0,sl_next=SLOTB;
  #define ROT() do{sl_prev=sl_cur;sl_cur=sl_next;sl_next=(sl_next==(NSLOT-1)*SLOTB)?0:sl_next+SLOTB;}while(0)
  DMA_K(2,2*SLOTB);
  WAIT_BAR(3);
  qkt(pA0,pA1,Kbase,qr,negm,r32,hi);asm volatile("s_nop 15\n\ts_nop 7":"+v"(pA0),"+v"(pA1));CMASK(pA0,pA1,0);
  START(pA0,pA1);
  _Pragma("unroll") for(int r=0;r<16;++r)pA1[r]=__builtin_amdgcn_exp2f(pA1[r]);
  WAIT_BAR(0);
  DMA_K(3,0);DMA_V(1,SLOTB);
  ROT();
  kload8(kf,kp0+sl_cur);
  WAIT_BAR(2);
  s16x4 vlo[8],vhi[8]; u32x4 pw0,pw1,pw2,pw3;
  #define PKW(P,B) cvtpk_s(P[B],P[B+1])
  #define PAF(k) __builtin_bit_cast(bf16x8,pw##k)
  #define VFR(i) (bf16x8){vlo[i][0],vlo[i][1],vlo[i][2],vlo[i][3],vhi[i][0],vhi[i][1],vhi[i][2],vhi[i][3]}
  #define PIN(x) asm volatile("":"+v"(x))
  #define MX3(a,b,c) __builtin_fmaxf(__builtin_fmaxf((a),(b)),(c))
  #define GAPA(MF,A0,A1,A2,A3,W0,W1,PW) do{ MF; sacc+=A0; sacc+=A1; sacc+=A2; sacc+=A3; PIN(sacc); W0; W1; PIN(PW); SBAR(); }while(0)
  #define EX(v) __builtin_amdgcn_exp2f(v)
  #define GAPB(MF,X,B) do{ MF; X[B]=EX(X[B]); X[B+1]=EX(X[B+1]); X[B+2]=EX(X[B+2]); X[B+3]=EX(X[B+3]); PIN(X); SBAR(); }while(0)
  #define VRD(i) do{ vlo[i]=vtr(vp_+(((i)>>2)*4096+((i)&3)*1024)); vhi[i]=vtr(vp_+(((i)>>2)*4096+((i)&3)*1024+512)); }while(0)
  #define KRD(G,j) do{ if(G){ kload2(kf,kp0+sl_next,j); SBAR(); } }while(0)
  #define STEP(C0,C1,P0,P1,t,GK,GV,GL) do{ SBAR(); \
    const lds_cptr vp_=vp0+sl_prev; \
    VRD(0); SBAR(); float sacc=(P0[0]+P0[1]); \
    GAPA(C0=__builtin_amdgcn_mfma_f32_32x32x16_bf16(kf[0],qr[0],negm,0,0,0), P0[2],P0[3],P0[4],P0[5],     pw0[0]=PKW(P0,0), pw0[1]=PKW(P0,2), pw0); \
    VRD(4); SBAR(); GAPA(C1=__builtin_amdgcn_mfma_f32_32x32x16_bf16(kf[1],qr[0],negm,0,0,0), P0[6],P0[7],P0[8],P0[9],     pw0[2]=PKW(P0,4), pw0[3]=PKW(P0,6), pw0); \
    VRD(1); SBAR(); GAPA(C0=__builtin_amdgcn_mfma_f32_32x32x16_bf16(kf[2],qr[1],C0,0,0,0),   P0[10],P0[11],P0[12],P0[13], pw1[0]=PKW(P0,8), pw1[1]=PKW(P0,10), pw1); \
    VRD(5); SBAR(); GAPA(C1=__builtin_amdgcn_mfma_f32_32x32x16_bf16(kf[3],qr[1],C1,0,0,0),   P0[14],P0[15],P1[0],P1[1],   pw1[2]=PKW(P0,12),pw1[3]=PKW(P0,14), pw1); \
    VRD(2); SBAR(); GAPA(C0=__builtin_amdgcn_mfma_f32_32x32x16_bf16(kf[4],qr[2],C0,0,0,0),   P1[2],P1[3],P1[4],P1[5],     pw2[0]=PKW(P1,0), pw2[1]=PKW(P1,2), pw2); \
    VRD(6); SBAR(); GAPA(C1=__builtin_amdgcn_mfma_f32_32x32x16_bf16(kf[5],qr[2],C1,0,0,0),   P1[6],P1[7],P1[8],P1[9],     pw2[2]=PKW(P1,4), pw2[3]=PKW(P1,6), pw2); \
    VRD(3); SBAR(); GAPA(C0=__builtin_amdgcn_mfma_f32_32x32x16_bf16(kf[6],qr[3],C0,0,0,0),   P1[10],P1[11],P1[12],P1[13], pw3[0]=PKW(P1,8), pw3[1]=PKW(P1,10), pw3); \
    VRD(7); SBAR(); GAPA(C1=__builtin_amdgcn_mfma_f32_32x32x16_bf16(kf[7],qr[3],C1,0,0,0),   P1[14],P1[15],0.f,0.f,       pw3[2]=PKW(P1,12),pw3[3]=PKW(P1,14), pw3); \
    l_reg+=sacc; \
    if(GK){DMA_K((t)+3,sl_cur);} if(GV){DMA_V((t)+1,sl_next);} \
    CMASK(C0,C1,t); \
    if constexpr(THRL>=0){ float a=MX3(C0[0],C0[1],C1[0]),b=MX3(C0[2],C0[3],C1[1]); a=MX3(a,C1[2],C1[3]); \
      _Pragma("unroll") for(int r=4;r<16;r+=4){a=MX3(a,C0[r],C0[r+1]);b=MX3(b,C0[r+2],C0[r+3]);a=MX3(a,C1[r],C1[r+1]);b=MX3(b,C1[r+2],C1[r+3]);} \
      float rm=__builtin_fmaxf(a,b); { auto rr=__builtin_amdgcn_permlane32_swap(__float_as_uint(rm),__float_as_uint(rm),false,false); rm=__builtin_fmaxf(__uint_as_float(rr[0]),__uint_as_float(rr[1])); } \
      resc=false; \
      if(__builtin_expect(__any(rm>(float)THRL),0)){ const float dl=__builtin_fmaxf(rm,0.f); mhat+=dl; \
        _Pragma("unroll") for(int r=0;r<16;++r){C0[r]-=dl;C1[r]-=dl;} \
        _Pragma("unroll") for(int r=0;r<16;++r)negm[r]=-mhat; asm volatile("":"+v"(negm)); \
        const float f=__builtin_amdgcn_exp2f(-dl); l_reg*=f; if(hi==0)wsf[r32]=f; resc=true; } } \
    SBAR(); \
    GAPB(o[0]=__builtin_amdgcn_mfma_f32_32x32x16_bf16(PAF(0),VFR(0),o[0],0,0,0), C0,0); \
    GAPB(o[1]=__builtin_amdgcn_mfma_f32_32x32x16_bf16(PAF(0),VFR(4),o[1],0,0,0), C0,4); \
    KRD(GL,0); GAPB(o[0]=__builtin_amdgcn_mfma_f32_32x32x16_bf16(PAF(1),VFR(1),o[0],0,0,0), C0,8); \
    KRD(GL,1); GAPB(o[1]=__builtin_amdgcn_mfma_f32_32x32x16_bf16(PAF(1),VFR(5),o[1],0,0,0), C0,12); \
    KRD(GL,2); GAPB(o[0]=__builtin_amdgcn_mfma_f32_32x32x16_bf16(PAF(2),VFR(2),o[0],0,0,0), C1,0); \
    KRD(GL,3); GAPB(o[1]=__builtin_amdgcn_mfma_f32_32x32x16_bf16(PAF(2),VFR(6),o[1],0,0,0), C1,4); \
    GAPB(o[0]=__builtin_amdgcn_mfma_f32_32x32x16_bf16(PAF(3),VFR(3),o[0],0,0,0), C1,8); \
    GAPB(o[1]=__builtin_amdgcn_mfma_f32_32x32x16_bf16(PAF(3),VFR(7),o[1],0,0,0), C1,12); \
    }while(0)
  int t=1;
  #undef CMASK
  #define CMASK(P0,P1,t) do{}while(0)
  for(;t+5<NT;t+=2){
    STEP(pB0,pB1,pA0,pA1,t,true,true,true);     WAIT_BAR(2); RESC(); ROT();
    STEP(pA0,pA1,pB0,pB1,t+1,true,true,true);   WAIT_BAR(2); RESC(); ROT();
  }
  #undef CMASK
  #define CMASK(P0,P1,t) do{}while(0)
  #define ENDW(tt) do{ if((tt)+3<NT){WAIT_BAR(2);} else if((tt)+2<NT){WAIT_BAR(1);} else {WAIT_BAR(0);} }while(0)
  for(;t+1<NT;t+=2){
    STEP(pB0,pB1,pA0,pA1,t,(t+3<NT),(t+1<NT),(t+1<NT));       ENDW(t);   RESC(); ROT();
    STEP(pA0,pA1,pB0,pB1,t+1,(t+4<NT),(t+2<NT),(t+2<NT));     ENDW(t+1); RESC(); ROT();
  }
  STEP(pB0,pB1,pA0,pA1,NT-1,false,false,false); RESC();
  { float sacc=pB0[0]+pB0[1]; _Pragma("unroll") for(int r=2;r<16;++r)sacc+=pB0[r]; _Pragma("unroll") for(int r=0;r<16;++r)sacc+=pB1[r]; l_reg+=sacc;
    pw0=(u32x4){PKW(pB0,0),PKW(pB0,2),PKW(pB0,4),PKW(pB0,6)};pw1=(u32x4){PKW(pB0,8),PKW(pB0,10),PKW(pB0,12),PKW(pB0,14)};pw2=(u32x4){PKW(pB1,0),PKW(pB1,2),PKW(pB1,4),PKW(pB1,6)};pw3=(u32x4){PKW(pB1,8),PKW(pB1,10),PKW(pB1,12),PKW(pB1,14)};
    SBAR(); pv(o,vb0+sl_cur,PAF(0),PAF(1),PAF(2),PAF(3)); }
  #undef PKW
  #undef PAF
  #undef VFR
  #undef PIN
  #undef MX3
  #undef GAPA
  #undef GAPB
  #undef EX
  #undef VRD
  #undef KRD
  #undef STEP
  #undef ENDW
  {auto rr=__builtin_amdgcn_permlane32_swap(__float_as_uint(l_reg),__float_as_uint(l_reg),false,false);l_reg=__uint_as_float(rr[0])+__uint_as_float(rr[1]);}
  if(hi==0)wsf[32+r32]=l_reg;asm volatile("s_waitcnt lgkmcnt(0)":::"memory");
  float rli[16];
  #pragma unroll
  for(int r=0;r<16;++r)rli[r]=__builtin_amdgcn_rcpf(wsf[32+crow(r,hi)]);
  bf16*Ow=O+(rowbase+q0+wid*QBLK)*OPITCH+512+h*D; float*Sw=SSQA+(rowbase+q0+wid*QBLK)*16+h;
  { bf16*stg=(bf16*)(shm+LDS_OST)+wid*2048;
    #pragma unroll
    for(int r=0;r<16;++r){const int orow=crow(r,hi);
      #pragma unroll
      for(int d0=0;d0<2;++d0)stg[orow*64+d0*32+r32]=__float2bfloat16(o[d0][r]*rli[r]);}
    asm volatile("s_waitcnt lgkmcnt(0)":::"memory");
    #pragma unroll
    for(int i=0;i<4;++i){const int row=i*8+(lane>>3),ch=lane&7; const u32x4 v=*(const u32x4*)(stg+row*64+ch*8); ATTN_STORE16(Ow+(long)row*OPITCH+ch*8,v);
      float ss=0.f; for(int e=0;e<4;++e){const float lo_=__uint_as_float(v[e]<<16),hi_=__uint_as_float(v[e]&0xffff0000u); ss+=lo_*lo_+hi_*hi_;}
      ss+=__shfl_xor(ss,1); ss+=__shfl_xor(ss,2); ss+=__shfl_xor(ss,4); if(ch==0)Sw[(long)row*16]=ss; } }
  asm volatile("s_waitcnt lgkmcnt(0)\n\ts_barrier":::"memory");
  #undef DMA_K
  #undef DMA_V
  #undef CMASK
  #undef START
  #undef RESC
  #undef ROT
}
constexpr int ATTN_LDS_BYTES=LDS_BYTES;
#undef SBAR
#undef WAIT_BAR
}

#ifdef ATT_NAIVE
__device__ __forceinline__ void attn_naive_unit(const Ctx& c, const Args& a, int b, int h, int qblk) {
    const bf16_t* QR = (const bf16_t*)(a.ws + WS_QRAW); const bf16_t* KV = (const bf16_t*)(a.ws + WS_KV);
    bf16_t* Y = (bf16_t*)(a.ws + WS_Y); float* SSQA = (float*)(a.ws + WS_SSQA);
    float* Ks = (float*)c.lds; float* Vs = Ks + 64 * 64;
    const long row = (long)b * SEQ + qblk * 512 + c.tid; const int kvh = h >> 2;
    float q[64], o[64];
#pragma unroll
    for (int v = 0; v < 8; ++v) { const u32x4 w = *(const u32x4*)(QR + row * 512 + h * 64 + v * 8);
        q[v * 8 + 0] = bflo(w.x); q[v * 8 + 1] = bfhi(w.x); q[v * 8 + 2] = bflo(w.y); q[v * 8 + 3] = bfhi(w.y);
        q[v * 8 + 4] = bflo(w.z); q[v * 8 + 5] = bfhi(w.z); q[v * 8 + 6] = bflo(w.w); q[v * 8 + 7] = bfhi(w.w); }
#pragma unroll
    for (int dd = 0; dd < 64; ++dd) o[dd] = 0.f;
    float mrun = -1e30f, l = 0.f;
    const int lk = c.tid >> 3, lp = c.tid & 7;
    for (int t0 = 0; t0 < SEQ; t0 += 64) {
        __syncthreads();
        { const bf16_t* kp = KV + ((long)b * SEQ + t0 + lk) * 256 + kvh * 64 + lp * 8;
          const u32x4 kw = *(const u32x4*)kp, vw = *(const u32x4*)(kp + 128);
          float* kd = Ks + lk * 64 + lp * 8; float* vd = Vs + lk * 64 + lp * 8;
          kd[0] = bflo(kw.x); kd[1] = bfhi(kw.x); kd[2] = bflo(kw.y); kd[3] = bfhi(kw.y); kd[4] = bflo(kw.z); kd[5] = bfhi(kw.z); kd[6] = bflo(kw.w); kd[7] = bfhi(kw.w);
          vd[0] = bflo(vw.x); vd[1] = bfhi(vw.x); vd[2] = bflo(vw.y); vd[3] = bfhi(vw.y); vd[4] = bflo(vw.z); vd[5] = bfhi(vw.z); vd[6] = bflo(vw.w); vd[7] = bfhi(vw.w); }
        __syncthreads();
#pragma unroll 1
        for (int j = 0; j < 64; ++j) {
            float acc = 0.f; const float* kr = Ks + j * 64;
#pragma unroll
            for (int dd = 0; dd < 64; dd += 4) { const f32x4 kk = *(const f32x4*)(kr + dd); acc += q[dd] * kk[0] + q[dd + 1] * kk[1] + q[dd + 2] * kk[2] + q[dd + 3] * kk[3];
                if ((dd & 15) == 12) __builtin_amdgcn_sched_barrier(0); }
            if (acc > mrun) { const float sc = exp2f(mrun - acc); l *= sc; mrun = acc;
#pragma unroll
                for (int dd = 0; dd < 64; ++dd) o[dd] *= sc; }
            const float p = exp2f(acc - mrun); l += p; const float* vr = Vs + j * 64;
#pragma unroll
            for (int dd = 0; dd < 64; dd += 4) { const f32x4 vv = *(const f32x4*)(vr + dd); o[dd] += p * vv[0]; o[dd + 1] += p * vv[1]; o[dd + 2] += p * vv[2]; o[dd + 3] += p * vv[3];
                if ((dd & 15) == 12) __builtin_amdgcn_sched_barrier(0); }
        }
    }
    const float il = 1.f / l; float ss = 0.f;
#pragma unroll
    for (int v = 0; v < 8; ++v) { float t[8];
#pragma unroll
        for (int e = 0; e < 8; ++e) { t[e] = o[v * 8 + e] * il; ss += t[e] * t[e]; }
        u32x4 w; w.x = pk2(t[0], t[1]); w.y = pk2(t[2], t[3]); w.z = pk2(t[4], t[5]); w.w = pk2(t[6], t[7]);
        *(u32x4*)(Y + row * 1024 + 512 + h * 64 + v * 8) = w; }
    SSQA[row * 16 + h] = ss;
    __syncthreads();
}

#endif
template <int NV> __device__ __forceinline__ float top16(float (&v)[NV], int lane) {
    float res = -INFINITY;
    for (int it = 0; it < 16; ++it) {
        float m = v[0];
#pragma unroll
        for (int i = 1; i < NV; ++i) m = fmaxf(m, v[i]);
        m = wave_max(m);
#pragma unroll
        for (int i = 0; i < NV; ++i) if (v[i] == m) v[i] = -INFINITY;
        if (lane == it) res = m;
    }
    return res;
}
__device__ __forceinline__ float dot8(const u32x4 a, const u32x4 b) {
    return bflo(a.x) * bflo(b.x) + bfhi(a.x) * bfhi(b.x) + bflo(a.y) * bflo(b.y) + bfhi(a.y) * bfhi(b.y)
         + bflo(a.z) * bflo(b.z) + bfhi(a.z) * bfhi(b.z) + bflo(a.w) * bflo(b.w) + bfhi(a.w) * bfhi(b.w);
}
__device__ __forceinline__ void peer_topk(const Ctx& c, const Args& a, int layer, int widx, int nw) {
    const bf16_t* QP = (const bf16_t*)(a.ws + WS_QP);
    const bf16_t* SK1 = (const bf16_t*)(a.ws + WS_LW + (size_t)layer * LW_STRIDE + LW_SK1);
    const bf16_t* SK2 = (const bf16_t*)(a.ws + WS_LW + (size_t)layer * LW_STRIDE + LW_SK2);
    int* SELI = (int*)(a.ws + WS_SELI); float* SELW = (float*)(a.ws + WS_SELW);
    const int lane = c.lane;
    for (int it = widx; it < M * 8; it += nw) {
        const int t = it >> 3, h = it & 7;
        const bf16_t* qrow = QP + (size_t)t * 2048 + h * 256;
        const bf16_t* k1a = SK1 + ((size_t)(h * 128 + lane)) * 128; const bf16_t* k1b = k1a + 64 * 128;
        const bf16_t* k2a = SK2 + ((size_t)(h * 128 + lane)) * 128; const bf16_t* k2b = k2a + 64 * 128;
        float s1[2] = {0.f, 0.f}, s2[2] = {0.f, 0.f};
#pragma unroll 4
        for (int kk = 0; kk < 128; kk += 8) {
            const u32x4 q1 = *(const u32x4*)(qrow + kk), q2 = *(const u32x4*)(qrow + 128 + kk);
            s1[0] += dot8(q1, *(const u32x4*)(k1a + kk)); s1[1] += dot8(q1, *(const u32x4*)(k1b + kk));
            s2[0] += dot8(q2, *(const u32x4*)(k2a + kk)); s2[1] += dot8(q2, *(const u32x4*)(k2b + kk));
        }
        s1[0] = __uint_as_float((__float_as_uint(s1[0]) & ~127u) | (unsigned)lane); s1[1] = __uint_as_float((__float_as_uint(s1[1]) & ~127u) | (unsigned)(lane + 64));
        s2[0] = __uint_as_float((__float_as_uint(s2[0]) & ~127u) | (unsigned)lane); s2[1] = __uint_as_float((__float_as_uint(s2[1]) & ~127u) | (unsigned)(lane + 64));
        const float v1 = top16<2>(s1, lane), v2 = top16<2>(s2, lane);
        float cand[4];
#pragma unroll
        for (int mm = 0; mm < 4; ++mm) {
            const float va = __shfl(v1, (lane >> 4) + 4 * mm), vb = __shfl(v2, lane & 15);
            const unsigned ua = __float_as_uint(va), ub = __float_as_uint(vb);
            const float sum = __uint_as_float(ua & ~127u) + __uint_as_float(ub & ~127u);
            cand[mm] = __uint_as_float((__float_as_uint(sum) & ~16383u) | ((ua & 127u) << 7) | (ub & 127u));
        }
        const float best = top16<4>(cand, lane);
        const unsigned ub = __float_as_uint(best);
        const float sc = __uint_as_float(ub & ~16383u);
        const float mx = __shfl(sc, 0);
        const float e = lane < 16 ? __expf(sc - mx) : 0.f;
        const float sum = wave_sum(e);
        if (lane < 16) { SELI[(size_t)t * 128 + h * 16 + lane] = (int)(ub & 16383u); SELW[(size_t)t * 128 + h * 16 + lane] = e / sum; }
    }
}

typedef float f32x16 __attribute__((ext_vector_type(16)));
#define CE_DESC(x, y) do { const float hi__ = fmaxf(x, y), lo__ = fminf(x, y); x = hi__; y = lo__; } while (0)
__device__ __forceinline__ void sort16_desc(float (&v)[16]) {
#pragma unroll
    for (int k = 2; k <= 16; k <<= 1)
#pragma unroll
        for (int j = k >> 1; j > 0; j >>= 1)
#pragma unroll
            for (int i = 0; i < 16; ++i) { const int l = i ^ j; if (l > i) { if ((i & k) == 0) CE_DESC(v[i], v[l]); else CE_DESC(v[l], v[i]); } }
}
__device__ __forceinline__ void merge16_desc(float (&a)[16], const float (&b)[16]) {
#pragma unroll
    for (int i = 0; i < 16; ++i) a[i] = fmaxf(a[i], b[15 - i]);
#pragma unroll
    for (int j = 8; j > 0; j >>= 1)
#pragma unroll
        for (int i = 0; i < 16; ++i) { const int l = i ^ j; if (l > i) CE_DESC(a[i], a[l]); }
}
__device__ __forceinline__ void merge16_partner(float (&a)[16]) {
    float b[16];
#pragma unroll
    for (int i = 0; i < 16; ++i) b[i] = __shfl_xor(a[i], 32);
    merge16_desc(a, b);
}
__device__ __forceinline__ void peer_topk_fast(const Ctx& c, const Args& a, int layer, int widx, int nw, int only_unit = -1, const unsigned char* skl = nullptr) {
    const bf16_t* QP = (const bf16_t*)(a.ws + WS_QP);
    const bf16_t* SK1 = (const bf16_t*)(a.ws + WS_LW + (size_t)layer * LW_STRIDE + LW_SK1);
    const bf16_t* SK2 = (const bf16_t*)(a.ws + WS_LW + (size_t)layer * LW_STRIDE + LW_SK2);
    int* SELI = (int*)(a.ws + WS_SELI); float* SELW = (float*)(a.ws + WS_SELW);
    const int lane = c.lane, tl = lane & 31, hi = lane >> 5;
    for (int unit = only_unit >= 0 ? only_unit : widx; unit < (M / 32) * 8; unit += nw) {
        const int tg = unit >> 3, h = unit & 7; const long token = (long)tg * 32 + tl;
        float vv[2][16];
#pragma unroll
        for (int half = 0; half < 2; ++half) {
            f32x16 acc[4];
#pragma unroll
            for (int t = 0; t < 4; ++t)
#pragma unroll
                for (int r = 0; r < 16; ++r) acc[t][r] = 0.f;
            const bf16_t* qb = QP + token * 2048 + h * 256 + half * 128 + 8 * hi;
            const bf16_t* kb = (half ? SK2 : SK1) + ((long)(h * 128 + tl)) * 128 + 8 * hi;
            if (skl) {
                const bf16_t* qf = QP + ((((size_t)((tg >> 3) * 8 + h) * 8 + (tg & 7)) * 2 + half) * 8) * 512 + lane * 8;
                bf16x8 bq[8];
#pragma unroll
                for (int ks = 0; ks < 8; ++ks) bq[ks] = *(const bf16x8*)(qf + ks * 512);
                const unsigned char* kl = skl + half * 34816 + tl * 272 + 16 * hi;
#pragma unroll
                for (int ks = 0; ks < 8; ++ks)
#pragma unroll
                    for (int t = 0; t < 4; ++t) { const bf16x8 ak = *(const bf16x8*)(kl + t * 32 * 272 + ks * 32); acc[t] = __builtin_amdgcn_mfma_f32_32x32x16_bf16(ak, bq[ks], acc[t], 0, 0, 0); }
            } else
#pragma unroll 1
            for (int k4 = 0; k4 < 8; k4 += 4) {
                bf16x8 bq[4], ak[4][4];
#pragma unroll
                for (int u = 0; u < 4; ++u) { bq[u] = *(const bf16x8*)(qb + 16 * (k4 + u));
#pragma unroll
                    for (int t = 0; t < 4; ++t) ak[u][t] = *(const bf16x8*)(kb + (long)t * 32 * 128 + 16 * (k4 + u)); }
#pragma unroll
                for (int u = 0; u < 4; ++u)
#pragma unroll
                    for (int t = 0; t < 4; ++t) acc[t] = __builtin_amdgcn_mfma_f32_32x32x16_bf16(ak[u][t], bq[u], acc[t], 0, 0, 0);
            }
            float L[4][16];
#pragma unroll
            for (int t = 0; t < 4; ++t) {
#pragma unroll
                for (int r = 0; r < 16; ++r) L[t][r] = __uint_as_float((__float_as_uint(acc[t][r]) & ~127u) | (unsigned)(32 * t + (r & 3) + 8 * (r >> 2) + 4 * hi));
                sort16_desc(L[t]);
            }
            merge16_desc(L[0], L[1]); merge16_desc(L[2], L[3]); merge16_desc(L[0], L[2]);
            merge16_partner(L[0]);
#pragma unroll
            for (int i = 0; i < 16; ++i) vv[half][i] = L[0][i];
        }
        float f1[16], f2[16]; unsigned i1[16], i2[16];
#pragma unroll
        for (int i = 0; i < 16; ++i) { const unsigned u1 = __float_as_uint(vv[0][i]), u2 = __float_as_uint(vv[1][i]);
            f1[i] = __uint_as_float(u1 & ~127u); f2[i] = __uint_as_float(u2 & ~127u); i1[i] = (u1 & 127u) << 7; i2[i] = u2 & 127u; }
        float cA[16], cB[16];
#pragma unroll
        for (int i = 0; i < 16; ++i) { cA[i] = -INFINITY; cB[i] = -INFINITY; }
        {
            int n = 0;
#pragma unroll
            for (int aa = 0; aa < 16; ++aa)
#pragma unroll
                for (int bb = 0; bb < 16; ++bb) if ((aa + 1) * (bb + 1) <= 16) {
                    const float s = f1[aa] + f2[bb]; const float pk = __uint_as_float((__float_as_uint(s) & ~16383u) | i1[aa] | i2[bb]);
                    const int slot = n >> 1; const bool mine = ((n & 1) == hi);
                    if (slot < 16) cA[slot] = mine ? pk : cA[slot]; else cB[slot - 16] = mine ? pk : cB[slot - 16];
                    ++n;
                }
        }
        sort16_desc(cA); sort16_desc(cB); merge16_desc(cA, cB); merge16_partner(cA);
        float sc[16], e[16]; float sum = 0.f;
#pragma unroll
        for (int i = 0; i < 16; ++i) { sc[i] = __uint_as_float(__float_as_uint(cA[i]) & ~16383u); e[i] = __expf(sc[i] - sc[0]); sum += e[i]; }
        const float inv = 1.f / sum;
        u32x4 oi[2]; f32x4 ow[2];
#pragma unroll
        for (int i = 0; i < 8; ++i) { const float pk = hi ? cA[8 + i] : cA[i]; const float w = (hi ? e[8 + i] : e[i]) * inv;
            oi[i >> 2][i & 3] = __float_as_uint(pk) & 16383u; ow[i >> 2][i & 3] = w; }
        int* si = SELI + token * 128 + h * 16 + 8 * hi; float* sw = SELW + token * 128 + h * 16 + 8 * hi;
        *(u32x4*)si = oi[0]; *(u32x4*)(si + 4) = oi[1]; *(f32x4*)sw = ow[0]; *(f32x4*)(sw + 4) = ow[1];
        if (only_unit >= 0) break;
    }
}

__device__ __forceinline__ void dec16(const u32x4 w, float (&f)[16]) {
#pragma unroll
    for (int j = 0; j < 4; ++j) { const auto lo = __builtin_amdgcn_cvt_pk_f32_fp8((int)w[j], false); const auto hi = __builtin_amdgcn_cvt_pk_f32_fp8((int)w[j], true);
        f[4 * j + 0] = lo[0]; f[4 * j + 1] = lo[1]; f[4 * j + 2] = hi[0]; f[4 * j + 3] = hi[1]; }
}
__device__ __forceinline__ void peer_gather(const Ctx& c, const Args& a, int layer, int widx, int nw) {
    float* XR = a.out; bf16_t* XN2 = (bf16_t*)(a.ws + WS_XN2);
    const unsigned char* EU = a.ws + WS_EU + (size_t)layer * 16384 * 1024;
    const unsigned char* EV = a.ws + WS_EV + (size_t)layer * 16384 * 1024;
    const float* SCU = (const float*)(a.ws + WS_ESC) + layer * 16384; const float* SCV = SCU + 32768;
    const int* SELI = (const int*)(a.ws + WS_SELI); const float* SELW = (const float*)(a.ws + WS_SELW);
    const float* gf = a.in[I_NFFNG] + layer * D; const float* gp = a.in[I_NPLEG] + layer * D;
    const int lane = c.lane;
    for (int t = widx; t < M; t += nw) {
        float x[16], hh[16], acc[16];
        float* xr = XR + (size_t)t * D + 16 * lane;
        float ss = 0.f;
#pragma unroll
        for (int j = 0; j < 4; ++j) { const f32x4 u0 = *(const f32x4*)(xr + 4 * j);
#pragma unroll
            for (int e = 0; e < 4; ++e) x[4 * j + e] = u0[e]; }
#pragma unroll
        for (int e = 0; e < 16; ++e) { ss += x[e] * x[e]; acc[e] = 0.f; }
        ss = wave_sum(ss);
        const float rstd = rsqrtf(ss * (1.f / D) + EPS);
#pragma unroll
        for (int j = 0; j < 4; ++j) { const f32x4 g4 = *(const f32x4*)(gf + 16 * lane + 4 * j);
#pragma unroll
            for (int e = 0; e < 4; ++e) hh[4 * j + e] = x[4 * j + e] * rstd * g4[e]; }
        const int idxA = SELI[(size_t)t * 128 + lane], idxB = SELI[(size_t)t * 128 + 64 + lane];
        const float wA = SELW[(size_t)t * 128 + lane], wB = SELW[(size_t)t * 128 + 64 + lane];
        const float suA = SCU[idxA], suB = SCU[idxB], svA = SCV[idxA], svB = SCV[idxB];
#pragma unroll 1
        for (int hf = 0; hf < 2; ++hf) {
            const int idxv = hf ? idxB : idxA; const float wv = hf ? wB : wA, suv = hf ? suB : suA, svv = hf ? svB : svA;
#pragma unroll 1
            for (int k0 = 0; k0 < 64; k0 += 8) {
                u32x4 ur[8], vr[8]; float w[8], su[8], sv[8];
#pragma unroll
                for (int r = 0; r < 8; ++r) {
                    const int e = __builtin_amdgcn_readlane(idxv, k0 + r);
                    w[r] = __uint_as_float(__builtin_amdgcn_readlane(__float_as_uint(wv), k0 + r));
                    su[r] = __uint_as_float(__builtin_amdgcn_readlane(__float_as_uint(suv), k0 + r));
                    sv[r] = __uint_as_float(__builtin_amdgcn_readlane(__float_as_uint(svv), k0 + r));
                    ur[r] = *(const u32x4*)(EU + (size_t)e * D + 16 * lane); vr[r] = *(const u32x4*)(EV + (size_t)e * D + 16 * lane);
                }
#pragma unroll
                for (int r = 0; r < 8; ++r) {
                    float f[16]; dec16(ur[r], f);
                    float d = 0.f;
#pragma unroll
                    for (int e = 0; e < 16; ++e) d += hh[e] * f[e];
                    d = wave_sum(d) * su[r];
                    const float av = gelu_tanh(d) * w[r] * sv[r];
                    dec16(vr[r], f);
#pragma unroll
                    for (int e = 0; e < 16; ++e) acc[e] += av * f[e];
                }
            }
        }
        float s2 = 0.f;
#pragma unroll
        for (int e = 0; e < 16; ++e) { x[e] += acc[e]; s2 += x[e] * x[e]; }
        s2 = wave_sum(s2);
        const float rstd2 = rsqrtf(s2 * (1.f / D) + EPS);
#pragma unroll
        for (int j = 0; j < 4; ++j) *(f32x4*)(xr + 4 * j) = (f32x4){x[4 * j + 0], x[4 * j + 1], x[4 * j + 2], x[4 * j + 3]};
        float y[16];
#pragma unroll
        for (int j = 0; j < 4; ++j) { const f32x4 g4 = *(const f32x4*)(gp + 16 * lane + 4 * j);
#pragma unroll
            for (int e = 0; e < 4; ++e) y[4 * j + e] = x[4 * j + e] * rstd2 * g4[e]; }
        u32x4 o0, o1; o0.x = pk2(y[0], y[1]); o0.y = pk2(y[2], y[3]); o0.z = pk2(y[4], y[5]); o0.w = pk2(y[6], y[7]);
        o1.x = pk2(y[8], y[9]); o1.y = pk2(y[10], y[11]); o1.z = pk2(y[12], y[13]); o1.w = pk2(y[14], y[15]);
        *(u32x4*)(XN2 + (size_t)t * D + 16 * lane) = o0; *(u32x4*)(XN2 + (size_t)t * D + 16 * lane + 8) = o1;
    }
}

#define DPP_ADD(v, ctrl, rmask) v += __uint_as_float(__builtin_amdgcn_update_dpp(0u, __float_as_uint(v), ctrl, rmask, 0xf, true))
__device__ __forceinline__ float wave_sum_dpp(float v) {
    DPP_ADD(v, 0x111, 0xf); DPP_ADD(v, 0x112, 0xf); DPP_ADD(v, 0x114, 0xf); DPP_ADD(v, 0x118, 0xf); DPP_ADD(v, 0x142, 0xa); DPP_ADD(v, 0x143, 0xc);
    return __uint_as_float(__builtin_amdgcn_readlane(__float_as_uint(v), 63));
}
struct GrpSplit { int grp, G, gwave, nwave; };
__device__ __forceinline__ GrpSplit grp_split(const Ctx& c) { GrpSplit s; s.G = c.nblk < 8 ? c.nblk : 8; s.grp = c.blk % s.G; const int rank = c.blk / s.G, cnt = (c.nblk - s.grp + s.G - 1) / s.G;
    s.gwave = rank * 8 + c.wave; s.nwave = cnt * 8; return s; }
#define DPP_ADDC(v, ctrl) v += __uint_as_float(__builtin_amdgcn_update_dpp(0u, __float_as_uint(v), ctrl, 0xf, 0xf, true))
template <bool VSTEP, int MODE = 0>
__device__ __forceinline__ void peer_step(const Ctx& c, const Args& a, int layer, bf16_t* XB) {
    float* SSQ2 = (float*)(a.ws + WS_SSQS); const float* SSQ1 = (const float*)(a.ws + WS_SSQ1);
    const unsigned char* ET = a.ws + (VSTEP ? WS_EV : WS_EU) + (size_t)layer * 16384 * 1024;
    const int* SELI = (const int*)(a.ws + WS_SELI); const float* AOUT = (const float*)(a.ws + WS_AOUT); float* DP = (float*)(a.ws + WS_QP);
    const float* gf = a.in[I_NFFNG] + layer * D;
    const int lane = c.lane, sub = lane >> 3, ch = lane & 7; const GrpSplit gs = grp_split(c);
#define PS_LOADIX(ix_, tt) do { const u32x4* ip_ = (const u32x4*)(SELI + (size_t)(tt) * 128 + 16 * sub); ix_[0] = ip_[0]; ix_[1] = ip_[1]; ix_[2] = ip_[2]; ix_[3] = ip_[3]; } while (0)
#define PS_LOADOPS(raw_, q_, tt) do { \
        if (VSTEP) { const u32x4* ap_ = (const u32x4*)(AOUT + (size_t)(tt) * 128 + 16 * sub); raw_[0] = ap_[0]; raw_[1] = ap_[1]; raw_[2] = ap_[2]; raw_[3] = ap_[3]; } \
        else { raw_[0] = *(const u32x4*)(XB + (size_t)(tt) * D + 128 * p + 16 * ch); raw_[1] = *(const u32x4*)(XB + (size_t)(tt) * D + 128 * p + 16 * ch + 8); \
               const f32x4* sq_ = (const f32x4*)(SSQ1 + (size_t)(tt) * 16); q_[0] = sq_[0]; q_[1] = sq_[1]; q_[2] = sq_[2]; q_[3] = sq_[3]; } } while (0)
#define PS_SEG(ix_, j_) (*(const u32x4*)(ETp + (unsigned)((ix_)[(j_) >> 2][(j_) & 3] * 1024u + lane_off)))
    for (int p = gs.grp; p < 8; p += gs.G) {
        float g16[16];
        if (!VSTEP) {
#pragma unroll
            for (int j = 0; j < 4; ++j) { const f32x4 g4 = *(const f32x4*)(gf + 128 * p + 16 * ch + 4 * j); g16[4 * j] = g4[0]; g16[4 * j + 1] = g4[1]; g16[4 * j + 2] = g4[2]; g16[4 * j + 3] = g4[3]; }
        }
        int t = gs.gwave;
        if (t >= M) continue;
        const unsigned char* ETp = ET + 128 * p; const unsigned lane_off = 16u * (unsigned)ch;
        u32x4 ring[16], nix[4], nnix[4], craw[4], nraw[4]; f32x4 cq[4], nq[4];
        { u32x4 cix[4]; PS_LOADIX(cix, t); PS_LOADOPS(craw, cq, t);
#pragma unroll
          for (int j = 0; j < 16; ++j) ring[j] = PS_SEG(cix, j); }
        { const int t1 = t + gs.nwave < M ? t + gs.nwave : t; PS_LOADIX(nix, t1); }
#pragma unroll 1
        for (;;) {
            const int tn = t + gs.nwave, tnn = tn + gs.nwave; const bool has_next = tn < M;
            { const int tc = has_next ? tn : t, tcc = tnn < M ? tnn : t; PS_LOADOPS(nraw, nq, tc); PS_LOADIX(nnix, tcc); }
            unsigned xrw = 0u;
            if (VSTEP) xrw = *(const unsigned*)(XB + (size_t)t * D + 128 * p + 16 * ch + 2 * sub);
            float hx[16]; f32x4 cav[4];
            if (!VSTEP) {
                const float rstd = rsqrtf(((cq[0][0] + cq[0][1] + cq[0][2] + cq[0][3]) + (cq[1][0] + cq[1][1] + cq[1][2] + cq[1][3]) + (cq[2][0] + cq[2][1] + cq[2][2] + cq[2][3]) + (cq[3][0] + cq[3][1] + cq[3][2] + cq[3][3])) * (1.f / D) + EPS);
#pragma unroll
                for (int w = 0; w < 2; ++w)
#pragma unroll
                    for (int e = 0; e < 4; ++e) { hx[8 * w + 2 * e] = bflo(craw[w][e]) * rstd * g16[8 * w + 2 * e]; hx[8 * w + 2 * e + 1] = bfhi(craw[w][e]) * rstd * g16[8 * w + 2 * e + 1]; }
            } else {
#pragma unroll
                for (int j = 0; j < 4; ++j) cav[j] = __builtin_bit_cast(f32x4, craw[j]);
            }
            typedef float f32x2_ __attribute__((ext_vector_type(2)));
            float acc[16]; f32x2_ acc2[8];
#pragma unroll
            for (int e = 0; e < 16; ++e) acc[e] = 0.f;
#pragma unroll
            for (int e = 0; e < 8; ++e) acc2[e] = (f32x2_){0.f, 0.f};
#define PS_PIN() do { if (VSTEP) asm volatile("" : "+v"(acc2[0]), "+v"(acc2[1]), "+v"(acc2[2]), "+v"(acc2[3]), "+v"(acc2[4]), "+v"(acc2[5]), "+v"(acc2[6]), "+v"(acc2[7])); \
        else asm volatile("" : "+v"(acc[0]), "+v"(acc[1]), "+v"(acc[2]), "+v"(acc[3]), "+v"(acc[4]), "+v"(acc[5]), "+v"(acc[6]), "+v"(acc[7]), "+v"(acc[8]), "+v"(acc[9]), "+v"(acc[10]), "+v"(acc[11]), "+v"(acc[12]), "+v"(acc[13]), "+v"(acc[14]), "+v"(acc[15])); __builtin_amdgcn_sched_barrier(0); } while (0)
#pragma unroll
            for (int j = 0; j < 16; ++j) {
                if (MODE == 1) { acc[j] += __uint_as_float((ring[j][0] ^ ring[j][1] ^ ring[j][2] ^ ring[j][3]) & 0x3fffffffu); }
                else {
                f32x2_ f2[8];
#pragma unroll
                for (int w = 0; w < 4; ++w) { f2[2 * w] = __builtin_amdgcn_cvt_pk_f32_fp8((int)ring[j][w], false); f2[2 * w + 1] = __builtin_amdgcn_cvt_pk_f32_fp8((int)ring[j][w], true); }
                if (VSTEP) { const float av_ = cav[j >> 2][j & 3]; const f32x2_ av2 = (f32x2_){av_, av_};
#pragma unroll
                    for (int i = 0; i < 8; ++i) acc2[i] = __builtin_elementwise_fma(av2, f2[i], acc2[i]); }
                else { f32x2_ d0 = (f32x2_){hx[0], hx[1]} * f2[0], d1 = (f32x2_){hx[2], hx[3]} * f2[1];
#pragma unroll
                    for (int i = 2; i < 8; i += 2) { d0 = __builtin_elementwise_fma((f32x2_){hx[2 * i], hx[2 * i + 1]}, f2[i], d0); d1 = __builtin_elementwise_fma((f32x2_){hx[2 * i + 2], hx[2 * i + 3]}, f2[i + 1], d1); }
                    const f32x2_ ds = d0 + d1; float d = ds[0] + ds[1];
                    DPP_ADDC(d, 0xB1); DPP_ADDC(d, 0x4E); DPP_ADDC(d, 0x141); acc[j] = d; } }
                if (MODE != 2) ring[j] = PS_SEG(nix, j);
                if ((j & 1) == 1) PS_PIN();
            }
            if (!VSTEP) {
                if (ch == 0) { u32x4* dp = (u32x4*)((bf16_t*)DP + ((size_t)t * 8 + p) * 128 + 16 * sub);
                    u32x4 o0, o1; o0.x = pk2(acc[0], acc[1]); o0.y = pk2(acc[2], acc[3]); o0.z = pk2(acc[4], acc[5]); o0.w = pk2(acc[6], acc[7]);
                    o1.x = pk2(acc[8], acc[9]); o1.y = pk2(acc[10], acc[11]); o1.z = pk2(acc[12], acc[13]); o1.w = pk2(acc[14], acc[15]); dp[0] = o0; dp[1] = o1; }
            } else {
#pragma unroll
                for (int i = 0; i < 8; ++i) { acc[2 * i] = acc2[i][0]; acc[2 * i + 1] = acc2[i][1]; }
                float r8[8], r4[4], r2[2];
#pragma unroll
                for (int i = 0; i < 8; ++i) { const auto rr = __builtin_amdgcn_permlane32_swap(__float_as_uint(acc[i]), __float_as_uint(acc[i + 8]), false, false); r8[i] = __uint_as_float(rr[0]) + __uint_as_float(rr[1]); }
#pragma unroll
                for (int i = 0; i < 4; ++i) { const auto rr = __builtin_amdgcn_permlane16_swap(__float_as_uint(r8[i]), __float_as_uint(r8[i + 4]), false, false); r4[i] = __uint_as_float(rr[0]) + __uint_as_float(rr[1]); }
                const bool b3 = (lane & 8) != 0;
#pragma unroll
                for (int i = 0; i < 2; ++i) { const float keep = b3 ? r4[i + 2] : r4[i], send = b3 ? r4[i] : r4[i + 2];
                    r2[i] = keep + __uint_as_float(__builtin_amdgcn_update_dpp(0u, __float_as_uint(send), 0x128, 0xf, 0xf, true)); }
                const unsigned ow = pk2(r2[0] + bflo(xrw), r2[1] + bfhi(xrw));
                const float y0 = bflo(ow), y1 = bfhi(ow);
                const float s2 = wave_sum_dpp(y0 * y0 + y1 * y1);
                *(unsigned*)(XB + (size_t)t * D + 128 * p + 16 * ch + 2 * sub) = ow;
                if (lane == 0) SSQ2[(size_t)t * 16 + p] = s2;
            }
            if (!has_next) break;
#pragma unroll
            for (int j = 0; j < 4; ++j) { nix[j] = nnix[j]; craw[j] = nraw[j]; if (!VSTEP) cq[j] = nq[j]; }
            t = tn;
        }
    }
#undef PS_LOADIX
#undef PS_LOADOPS
#undef PS_SEG
#undef PS_PIN
}
__device__ __forceinline__ void peer_combine(const Ctx& c, const Args& a, int layer) {
    const float* SCU = (const float*)(a.ws + WS_ESC) + layer * 16384; const float* SCV = SCU + 32768;
    const int* SELI = (const int*)(a.ws + WS_SELI); const float* SELW = (const float*)(a.ws + WS_SELW); float* AOUT = (float*)(a.ws + WS_AOUT); const float* DP = (const float*)(a.ws + WS_QP);
    const bf16_t* DPB = (const bf16_t*)DP;
    const size_t n8 = (size_t)M * 16, stride = (size_t)c.nblk * 512;
    constexpr int CMB_N = 2;
    for (size_t v0 = (size_t)c.blk * 512 + c.tid; v0 < n8; v0 += CMB_N * stride) {
        f32x4 s0[CMB_N], s1[CMB_N]; u32x4 ix0[CMB_N], ix1[CMB_N]; f32x4 w0[CMB_N], w1[CMB_N];
#pragma unroll
        for (int u = 0; u < CMB_N; ++u) { const size_t v = v0 + u * stride < n8 ? v0 + u * stride : v0; const size_t t = v >> 4; const int q = (int)(v & 15) * 8;
            ix0[u] = *(const u32x4*)(SELI + t * 128 + q); ix1[u] = *(const u32x4*)(SELI + t * 128 + q + 4); w0[u] = *(const f32x4*)(SELW + t * 128 + q); w1[u] = *(const f32x4*)(SELW + t * 128 + q + 4);
            s0[u] = (f32x4){0.f, 0.f, 0.f, 0.f}; s1[u] = s0[u];
#pragma unroll
            for (int p = 0; p < 8; ++p) { f32x4 a0, a1; unpack8(*(const u32x4*)(DPB + (t * 8 + p) * 128 + q), a0, a1); s0[u] += a0; s1[u] += a1; } }
#pragma unroll
        for (int u = 0; u < CMB_N; ++u) { const size_t v = v0 + u * stride; if (v >= n8) break; const size_t t = v >> 4; const int q = (int)(v & 15) * 8;
            f32x4 o0, o1;
#pragma unroll
            for (int e = 0; e < 4; ++e) { o0[e] = gelu_tanh(s0[u][e] * SCU[ix0[u][e]]) * w0[u][e] * SCV[ix0[u][e]]; o1[e] = gelu_tanh(s1[u][e] * SCU[ix1[u][e]]) * w1[u][e] * SCV[ix1[u][e]]; }
            *(f32x4*)(AOUT + t * 128 + q) = o0; *(f32x4*)(AOUT + t * 128 + q + 4) = o1; }
    }
}

__device__ __forceinline__ void final_norm(const Ctx& c, const Args& a, int widx, int nw) {
    const float* gfin = a.in[I_FING]; const bf16_t* XB = (const bf16_t*)(a.ws + WS_XB);
    for (int m0 = widx; m0 < M; m0 += 4 * nw) {
        u32x4 w[4][2];
#pragma unroll
        for (int u = 0; u < 4; ++u) { const int m = m0 + u * nw < M ? m0 + u * nw : m0; const u32x4* xr = (const u32x4*)(XB + (size_t)m * D + 16 * c.lane); w[u][0] = xr[0]; w[u][1] = xr[1]; }
#pragma unroll
        for (int u = 0; u < 4; ++u) { const int m = m0 + u * nw; if (m >= M) break;
            float x[16]; float s = 0.f;
#pragma unroll
            for (int j = 0; j < 2; ++j)
#pragma unroll
                for (int e = 0; e < 4; ++e) { x[8 * j + 2 * e] = bflo(w[u][j][e]); x[8 * j + 2 * e + 1] = bfhi(w[u][j][e]); }
#pragma unroll
            for (int e = 0; e < 16; ++e) s += x[e] * x[e];
            s = wave_sum(s); const float rstd = rsqrtf(s * (1.f / D) + EPS);
            f32x4* orow = (f32x4*)(a.out + (size_t)m * D + 16 * c.lane);
#pragma unroll
            for (int j = 0; j < 4; ++j) { const f32x4 gg = *(const f32x4*)(gfin + 16 * c.lane + 4 * j); orow[j] = (f32x4){x[4 * j] * rstd * gg[0], x[4 * j + 1] * rstd * gg[1], x[4 * j + 2] * rstd * gg[2], x[4 * j + 3] * rstd * gg[3]}; } }
    }
}

__global__ void __launch_bounds__(512, 2) mk_fwd(Args a) {
    extern __shared__ __attribute__((aligned(16))) unsigned char lds[];
    Ctx c0; c0.tid = threadIdx.x; c0.lane = c0.tid & 63; c0.wave = __builtin_amdgcn_readfirstlane(c0.tid >> 6); c0.blk = blockIdx.x; c0.nblk = gridDim.x; c0.lds = lds;
    const Ctx& c = c0;
    volatile LAS unsigned* MISC = (volatile LAS unsigned*)((LAS unsigned char*)lds + MISC_OFF);
    for (int u = c.tid; u < (LDS_BYTES - LDSCTL_OFF) / 4; u += 512) ((LAS unsigned*)((LAS unsigned char*)lds + LDSCTL_OFF))[u] = 0u;
    __syncthreads();
    const bool multi = (a.ph_hi - a.ph_lo) > 1;
    XcdBarrier bar; bar.bar = (unsigned*)(a.ws + WS_CTL) + CW_BAR; bar.x = 0; bar.st = nullptr;
    if (multi) bar = xcd_barrier_post((unsigned*)(a.ws + WS_CTL) + CW_BAR, MISC + 8);
    const int gw = c.blk * 8 + c.wave, NGW = c.nblk * 8;

#define IN(k) (lo <= (k) && (k) < hi)
#define FRESH() Ctx c = c0; { int t_ = c0.tid; asm volatile("" : "+v"(t_)); c.tid = t_; c.lane = t_ & 63; int w_ = c0.wave; asm volatile("" : "+s"(w_)); c.wave = w_; int b_ = c0.blk; asm volatile("" : "+s"(b_)); c.blk = b_; int n_ = c0.nblk; asm volatile("" : "+s"(n_)); c.nblk = n_; }
#define GRIDBAR() do { XcdBarrier b_ = bar; unsigned* p_ = b_.bar; asm volatile("" : "+s"(p_)); b_.bar = p_; xcd_barrier(b_); } while (0)
#ifdef PROBE_PH
#define PROBE_STAMP(slot) do { if (blockIdx.x == 0 && threadIdx.x == 0) ((unsigned long long*)(a.ws + WS_CTL + 48 * 1024))[slot] = __builtin_amdgcn_s_memrealtime(); } while (0)
#define SEAM(k) do { if ((k) == PROBE_PH - 1) { if (IN(k) && IN((k) + 1)) GRIDBAR(); PROBE_STAMP(0); } else if ((k) == PROBE_PH) { if (IN(k) && IN((k) + 1)) GRIDBAR(); PROBE_STAMP(1); } else { if (IN(k) && IN((k) + 1)) GRIDBAR(); } } while (0)
#else
#define SEAM(k) do { if (IN(k) && IN((k) + 1)) GRIDBAR(); } while (0)
#endif
    const int lo = a.ph_lo, hi = a.ph_hi;
#ifdef PROBE_PH
    if (PROBE_PH == 0) PROBE_STAMP(0);
#endif
    if (IN(0)) {
        FRESH();
        p0_prologue(c, a);
    }
    SEAM(0);
#pragma unroll 1
    for (int layer = 0; layer < 2; ++layer) {
        const int pb = 1 + 11 * layer;
        unsigned char* lw = a.ws + WS_LW + (size_t)layer * LW_STRIDE;
        unsigned char* xbc = a.ws + (layer & 1 ? WS_XB2 : WS_XB); unsigned char* xbn = a.ws + (layer & 1 ? WS_XB : WS_XB2);
        if (IN(pb + 0)) {
            FRESH();
            GemmD g; g.A = (const bf16_t*)xbc; g.lda = D; g.Bt = (const bf16_t*)(lw + LW_WIN); g.ldb = D; g.K = D; g.kmid = -1;
            float* RSX = (float*)(a.ws + WS_RSX);
            rstd_rows(c, (const float*)(a.ws + WS_SSQ0), 16, RSX, c.nblk == 256 ? 4 : DIN / 256, c.nblk, c.blk);
            EpiInproj E; E.ssq0 = RSX; E.ucat = (bf16_t*)(a.ws + WS_UCAT); E.qraw = (bf16_t*)(a.ws + WS_QRAW); E.kv = (bf16_t*)(a.ws + WS_KV);
            gemm_phase_dense(c, g, M / 256, c.nblk == 256 ? 4 : DIN / 256, E);
            if (layer == 0 && c.nblk != 256) {}
        }
        SEAM(pb + 0);
        if (IN(pb + 1)) {
            FRESH();
            if (c.nblk == 256) {
                if (c.blk < 64) s1_unit(c, a, layer, c.blk);
                else if (c.blk < 128) {
                    GemmD g; g.A = (const bf16_t*)xbc; g.lda = D; g.Bt = (const bf16_t*)(lw + LW_WIN); g.ldb = D; g.K = D; g.kmid = -1;
                    float* RSX = (float*)(a.ws + WS_RSX);
                    if (c.tid < 256) { const int row = (c.blk - 64) * 256 + c.tid; RSX[row] = rsqrtf(sumn((const float*)(a.ws + WS_SSQ0) + (long)row * 16, 16) * (1.f / D) + EPS); }
                    VM_WAIT(); __syncthreads();
                    EpiInproj E; E.ssq0 = RSX; E.ucat = (bf16_t*)(a.ws + WS_UCAT); E.qraw = (bf16_t*)(a.ws + WS_QRAW); E.kv = (bf16_t*)(a.ws + WS_KV);
                    pg8::OneUnit S; S.u.pm = c.blk - 64; S.u.pn = 4; run_gemm(c.lds, g, S, E, c.tid);
                    VM_WAIT(); __syncthreads();
                    qkprep(c, a, layer, c.wave, 8, 2, (c.blk - 64) * 256);
                    if (layer == 0) cvt_fp8_layer(c, a, 1, (c.blk - 64) * 8 + c.wave, 192 * 8);
                } else {
                    qkprep(c, a, layer, (c.blk - 128) * 8 + c.wave, 128 * 8, 1);
                    if (layer == 0) cvt_fp8_layer(c, a, 1, (c.blk - 64) * 8 + c.wave, 192 * 8);
                }
            } else if (c.nblk > 64) {
                if (c.blk < 64) s1_unit(c, a, layer, c.blk);
                else qkprep(c, a, layer, (c.blk - 64) * 8 + c.wave, (c.nblk - 64) * 8);
            } else {
                for (int u = c.blk; u < 64; u += c.nblk) s1_unit(c, a, layer, u);
                qkprep(c, a, layer, gw, NGW);
            }
        }
        SEAM(pb + 1);
        if (IN(pb + 2)) {
            FRESH();
            GemmD g; g.A = (const bf16_t*)(a.ws + WS_UCAT); g.lda = KCAT; g.Bt = (const bf16_t*)(lw + LW_WY); g.ldb = KCAT; g.K = KCAT; g.kmid = -1;
            EpiS2 E; E.G = (bf16_t*)(a.ws + WS_G);
#ifdef USE_SGEMM
            for (int ui = c.blk; ui < 128; ui += c.nblk) { Unit u; u.pm = ui >> 1; u.pn = (ui >> 2) * 2 + (ui & 1); sgemm_unit(g, u, E, c.wave, c.lane); }
#else
            { pg8::S2Order S; S.blk = c.blk; S.nblk = c.nblk; run_gemm(c.lds, g, S, E, c.tid); }
#endif
#ifdef ATT_NAIVE
            for (int ui = c.blk; ui < 256; ui += c.nblk) attn_naive_unit(c, a, ui >> 7, (ui >> 4) & 7, ui & 15);
#else
            float mfix = 0.f;
            {
                float gq = 0.f, gk = 0.f;
                for (int d = 0; d < 64; ++d) { gq = fmaxf(gq, fabsf(a.in[I_QNG][layer * 64 + d])); gk = fmaxf(gk, fabsf(a.in[I_KNG][layer * 64 + d])); }
                mfix = 64.f * gq * gk * C2 * 1.02f;
            }
            for (int ui = c.blk; ui < 512; ui += c.nblk) {
                int ab, ah, aq;
                if (c.nblk == 256) { const int bl = ui & 255, vcu = (bl & 7) * 32 + (bl >> 3), combo = (ui >> 8) * 2 + (vcu >> 7), w = vcu & 127; ab = combo >> 1; ah = (combo & 1) * 4 + (w >> 5); aq = w & 31; }
                else { ab = ui >> 8; ah = (ui >> 5) & 7; aq = ui & 31; }
                attn_body::attn_unit<ATT_THRL>(ab, ah, aq, (const attn_body::bf16*)(a.ws + WS_QRAW), (const attn_body::bf16*)(a.ws + WS_KV), (attn_body::bf16*)(a.ws + WS_Y), (float*)(a.ws + WS_SSQA), (char*)lds, c.tid, mfix);
            }
#endif
        }
        SEAM(pb + 2);
        if (IN(pb + 3)) {
            FRESH();
            GemmD g; g.A = (const bf16_t*)(a.ws + WS_G); g.lda = 512; g.Bt = (const bf16_t*)(lw + LW_WGLU); g.ldb = 512; g.K = 512; g.kmid = -1;
            EpiGlu E; E.G = (const bf16_t*)(a.ws + WS_G); E.bglu = a.in[I_BGLU] + layer * 512; E.Y = (bf16_t*)(a.ws + WS_Y); E.ssqs = (float*)(a.ws + WS_SSQS);
            GemmD g1; g1.A = (const bf16_t*)(a.ws + WS_PB) + (size_t)layer * M * 256; g1.lda = 256; g1.Bt = (const bf16_t*)(lw + LW_WPROJ); g1.ldb = 256; g1.K = 256; g1.kmid = -1;
            EpiProj E1; E1.pr = (bf16_t*)(a.ws + WS_PRB);
            if (c.nblk >= 256) { if (c.blk < 128) gemm_phase_sub(c, g, M / 256, 2, E, 128, c.blk); else if (c.blk < 256) gemm_phase_sub(c, g1, M / 256, 4, E1, 128, c.blk - 128); }
            else { gemm_phase_dense(c, g, M / 256, 2, E); gemm_phase_dense(c, g1, M / 256, 4, E1); }
        }
        SEAM(pb + 3);
        if (IN(pb + 4)) {
            FRESH();
            GemmD g; g.A = (const bf16_t*)(a.ws + WS_Y); g.lda = D; g.Bt = (const bf16_t*)(lw + LW_WOUT); g.ldb = D; g.K = D; g.kmid = 512;
            float* RS = (float*)(a.ws + WS_RS);
            { const float* ssqs = (const float*)(a.ws + WS_SSQS); const float* ssqa = (const float*)(a.ws + WS_SSQA);
              pg8::StaticOrder S0; S0.init(M, D, c.nblk, c.blk); Unit u0;
              for (int i = 0; S0.next(i, u0); ++i) if (c.tid < 256) { const int row = u0.pm * 256 + c.tid;
                  const float s = rsqrtf(sumn(ssqs + (long)row * 16, 8) * (1.f / 512.f) + EPS), t = rsqrtf(sumn(ssqa + (long)row * 16, 8) * (1.f / 512.f) + EPS);
                  RS[(long)row * 2] = s / t; RS[(long)row * 2 + 1] = t; }
              VM_WAIT(); __syncthreads(); }
            EpiOut E; E.rs = RS; E.xb = (bf16_t*)xbc; E.ssq1 = (float*)(a.ws + WS_SSQ1);
            gemm_phase_dense(c, g, M / 256, 4, E);
        }
        SEAM(pb + 4);
        if (IN(pb + 5)) {
            FRESH();
            GemmD g; g.A = (const bf16_t*)xbc; g.lda = D; g.Bt = (const bf16_t*)(lw + LW_WQ); g.ldb = D; g.K = D; g.kmid = -1;
            float* RSX = (float*)(a.ws + WS_RSX);
            rstd_rows(c, (const float*)(a.ws + WS_SSQ1), 16, RSX, 8, c.nblk, c.blk);
            EpiQ E; E.ssq1 = RSX; E.qp = (bf16_t*)(a.ws + WS_QP);
            gemm_phase_dense(c, g, M / 256, 8, E);
            VM_WAIT(); __syncthreads();
            { pg8::StaticOrder S0; S0.init(M, 2048, c.nblk, c.blk); Unit u0;
              for (int i = 0; S0.next(i, u0); ++i) {
                  __syncthreads();
                  {
                      u32x4 sv[8];
#pragma unroll
                      for (int k = 0; k < 8; ++k) { const int hf = k >> 2, idx = (k & 3) * 512 + c.tid, row = idx >> 4, ch = idx & 15;
                          sv[k] = *(const u32x4*)((const bf16_t*)(lw + (hf ? LW_SK2 : LW_SK1)) + ((size_t)(u0.pn * 128 + row)) * 128 + ch * 8); }
#pragma unroll
                      for (int k = 0; k < 8; ++k) { const int hf = k >> 2, idx = (k & 3) * 512 + c.tid, row = idx >> 4, ch = idx & 15;
                          *(u32x4*)(c.lds + hf * 34816 + row * 272 + ch * 16) = sv[k]; }
                  }
                  __syncthreads();
                  peer_topk_fast(c, a, layer, 0, 1 << 30, (u0.pm * 8 + c.wave) * 8 + u0.pn, c.lds);
              } }
        }
        SEAM(pb + 5);
        if (IN(pb + 7)) {
            FRESH();
#ifdef EXP_MODE
            peer_step<false, EXP_MODE>(c, a, layer, (bf16_t*)xbc);
            VM_WAIT(); __syncthreads();
#endif
            peer_step<false>(c, a, layer, (bf16_t*)xbc);
        }
        SEAM(pb + 7);
        if (IN(pb + 8)) {
            FRESH();
            peer_combine(c, a, layer);
        }
        SEAM(pb + 8);
        if (IN(pb + 9)) {
            FRESH();
            peer_step<true>(c, a, layer, (bf16_t*)xbc);
        }
        SEAM(pb + 9);
        if (IN(pb + 10)) {
            FRESH();
            GemmD g2; g2.A = (const bf16_t*)xbc; g2.lda = D; g2.Bt = (const bf16_t*)(lw + LW_WGATE); g2.ldb = D; g2.K = D; g2.kmid = -1;
            float* RSX = (float*)(a.ws + WS_RSX);
            rstd_rows(c, (const float*)(a.ws + WS_SSQS), 8, RSX, 4, c.nblk, c.blk);
            EpiGate E2; E2.pr = (const bf16_t*)(a.ws + WS_PRB); E2.xin = (const bf16_t*)xbc; E2.xout = (bf16_t*)xbn; E2.ssq0 = (float*)(a.ws + WS_SSQ0); E2.ssq2 = RSX;
            gemm_phase_dense(c, g2, M / 256, 4, E2);
        }
        SEAM(pb + 10);
    }
    if (IN(NPHASE - 1)) { FRESH(); final_norm(c, a, gw, NGW); }
#ifdef PROBE_RGN
    if (blockIdx.x == 0 && threadIdx.x == 0) {
        VM_WAIT();
        const unsigned long long* st = (const unsigned long long*)(a.ws + WS_CTL + 48 * 1024);
        const unsigned long long t0 = __hip_atomic_load(st, __ATOMIC_RELAXED, __HIP_MEMORY_SCOPE_AGENT), t1 = __hip_atomic_load(st + 1, __ATOMIC_RELAXED, __HIP_MEMORY_SCOPE_AGENT);
        const unsigned long long span = (t1 > t0 ? t1 - t0 : 0) * PROBE_MULT, s0 = __builtin_amdgcn_s_memrealtime();
        while (__builtin_amdgcn_s_memrealtime() - s0 < span) __builtin_amdgcn_s_sleep(8);
    }
#endif
#ifdef PROBE_PH
    if (blockIdx.x == 0 && threadIdx.x == 0) {
        VM_WAIT();
        const unsigned long long* st = (const unsigned long long*)(a.ws + WS_CTL + 48 * 1024);
        const unsigned long long t0 = __hip_atomic_load(st, __ATOMIC_RELAXED, __HIP_MEMORY_SCOPE_AGENT), t1 = __hip_atomic_load(st + 1, __ATOMIC_RELAXED, __HIP_MEMORY_SCOPE_AGENT);
        const unsigned long long span = (t1 > t0 ? t1 - t0 : 0) * PROBE_MULT, s0 = __builtin_amdgcn_s_memrealtime();
        while (__builtin_amdgcn_s_memrealtime() - s0 < span) __builtin_amdgcn_s_sleep(8);
    }
#endif
#undef IN
#undef SEAM
}

extern "C" void kernel_launch(void* const* d_in, const int* in_sizes, int n_in, void* d_out, int out_size, void* d_ws, size_t ws_size, hipStream_t stream) {
    static int grid = 0;
    if (grid == 0) {
        if (n_in != 29 || in_sizes[0] != M * D || out_size != M * D || in_sizes[3] != 2 * D * DIN || ws_size < WS_END) {
            fprintf(stderr, "kernel_launch: unexpected problem: n_in %d in0 %d in3 %d out %d ws %zu (need %zu); nothing launched\n", n_in, n_in > 0 ? in_sizes[0] : -1, n_in > 3 ? in_sizes[3] : -1, out_size, ws_size, (size_t)WS_END);
            grid = -1; return; }
        int dev = 0, cus = 0, per_cu = 0;
        if (hipGetDevice(&dev) != hipSuccess || hipDeviceGetAttribute(&cus, hipDeviceAttributeMultiprocessorCount, dev) != hipSuccess) { grid = -1; return; }
        if (hipFuncSetAttribute((const void*)mk_fwd, hipFuncAttributeMaxDynamicSharedMemorySize, LDS_BYTES) != hipSuccess) { fprintf(stderr, "kernel_launch: hipFuncSetAttribute failed\n"); grid = -1; return; }
        if (hipOccupancyMaxActiveBlocksPerMultiprocessor(&per_cu, (const void*)mk_fwd, 512, LDS_BYTES) != hipSuccess || per_cu < 1)
            fprintf(stderr, "kernel_launch: note: occupancy query reports %d workgroups per CU\n", per_cu);
        (void)hipGetLastError();
        grid = cus;
    }
    if (grid < 0) return;
    (void)hipMemsetAsync((char*)d_ws + WS_CTL, 0, CTL_ZERO_BYTES, stream);
    Args a{};
    for (int i = 0; i < 29; ++i) a.in[i] = (const float*)d_in[i];
    a.out = (float*)d_out; a.ws = (unsigned char*)d_ws;
    constexpr int NL = MK_N_LAUNCHES;
    for (int li = 0; li < NL; ++li) {
        a.ph_lo = (NPHASE * li) / NL; a.ph_hi = (NPHASE * (li + 1)) / NL;
        hipLaunchKernelGGL(mk_fwd, dim3(grid), dim3(512), LDS_BYTES, stream, a);
    }
}
```

```cpp
#include <hip/hip_runtime.h>
#include <type_traits>
#include <cstdio>
#include <cstdint>

#ifndef ATT_THRL
#define ATT_THRL -1
#endif
#ifndef MK_N_LAUNCHES
#define MK_N_LAUNCHES 1
#endif

#define LAS __attribute__((address_space(3)))
typedef unsigned short bf16_t;
typedef short bf16x8 __attribute__((ext_vector_type(8)));
typedef float f32x4 __attribute__((ext_vector_type(4)));
typedef unsigned u32x4 __attribute__((ext_vector_type(4)));
typedef unsigned u32x2 __attribute__((ext_vector_type(2)));

constexpr int NB = 2, SEQ = 8192, M = NB * SEQ, D = 1024, DIN = 1280;
constexpr int NG = 32, LCH = 32, NCH = SEQ / LCH, KCAT = 768;
constexpr float EPS = 1e-6f;
constexpr float C2 = 0.125f * 1.4426950408889634f;
constexpr int NPHASE = 24;

constexpr size_t MiB = 1u << 20;
constexpr size_t WS_CTL = 0, CTL_ZERO_BYTES = 64 * 1024;
constexpr size_t WS_EU = 1 * MiB, WS_EV = 65 * MiB;
constexpr size_t WS_ESC = 241 * MiB + 256 * 1024;
constexpr size_t WS_LW = 129 * MiB, LW_STRIDE = 48 * MiB;
constexpr size_t LW_WIN = 0, LW_WGLU = 3 * MiB, LW_WOUT = 4 * MiB, LW_WQ = 6 * MiB, LW_SK1 = 10 * MiB, LW_SK2 = 10 * MiB + 512 * 1024,
                 LW_WGATE = 11 * MiB, LW_WPROJ = 13 * MiB, LW_AL = 13 * MiB + 512 * 1024, LW_WE = 14 * MiB, LW_WY = 22 * MiB;
constexpr size_t WS_PB = 225 * MiB, WS_ROPE = 241 * MiB, WS_XB = 242 * MiB, WS_UCAT = 274 * MiB, WS_QRAW = 300 * MiB, WS_KV = 316 * MiB,
                 WS_EBUF = 324 * MiB, WS_G = 340 * MiB, WS_Y = 356 * MiB, WS_SSQS = 388 * MiB, WS_SSQA = 389 * MiB, WS_SSQ0 = 390 * MiB, WS_SSQ1 = 391 * MiB, WS_RS = 241 * MiB + 512 * 1024, WS_RSX = 241 * MiB + 768 * 1024  , WS_PRB = 33 * MiB  ,
                 WS_QP = 392 * MiB  , WS_SELI = 456 * MiB, WS_SELW = 464 * MiB, WS_XN2 = 472 * MiB, WS_AOUT = 472 * MiB  , WS_XB2 = 480 * MiB  , WS_END = 512 * MiB;
constexpr int CW_BAR = 4096;

constexpr int RING_BYTES = 131072, LDSCTL_OFF = RING_BYTES, MISC_OFF = LDSCTL_OFF + 320, LDS_BYTES = 147456;

__device__ __forceinline__ unsigned f2bf(float f) { unsigned u = __float_as_uint(f); return (u + 0x7fffu + ((u >> 16) & 1u)) >> 16; }
__device__ __forceinline__ unsigned pk2(float lo, float hi) { return f2bf(lo) | (f2bf(hi) << 16); }
__device__ __forceinline__ float bflo(unsigned w) { return __uint_as_float(w << 16); }
__device__ __forceinline__ float bfhi(unsigned w) { return __uint_as_float(w & 0xffff0000u); }
__device__ __forceinline__ float bf1(bf16_t h) { return __uint_as_float((unsigned)h << 16); }
__device__ __forceinline__ float wave_sum(float v) {
#pragma unroll
    for (int o = 1; o < 64; o <<= 1) v += __shfl_xor(v, o);
    return v;
}
__device__ __forceinline__ float wave_max(float v) {
#pragma unroll
    for (int o = 1; o < 64; o <<= 1) v = fmaxf(v, __shfl_xor(v, o));
    return v;
}
__device__ __forceinline__ float sigmoidf_(float x) { return 1.f / (1.f + __expf(-x)); }
__device__ __forceinline__ float gelu_tanh(float x) {
    const float z = 0.7978845608028654f * (x + 0.044715f * x * x * x);
    const float e = __expf(2.f * z);
    const float th = 1.f - 2.f / (e + 1.f);
    return 0.5f * x * (1.f + th);
}
__device__ __forceinline__ float sumn(const float* p, int n) { float s = 0.f; for (int i = 0; i < n; ++i) s += p[i]; return s; }
#define LDS_WAIT() asm volatile("s_waitcnt lgkmcnt(0)" ::: "memory")
#define VM_WAIT() asm volatile("s_waitcnt vmcnt(0)" ::: "memory")

#define XB_TMO      128
#define XB_XCNT(j)  (256  + 64 * (j))
#define XB_XSUB(j)  (1280 + 64 * (j))
#define XB_XGEN(j)  (2304 + 64 * (j))
#define XB_TOP      3328
#define XB_TOPGEN   3392
#define XCD_BAR_WORDS 3456
#define XB_SPIN_CAP (1u << 18)
__device__ __forceinline__ unsigned xb_ld(unsigned* p)              { return __hip_atomic_load(p, __ATOMIC_RELAXED, __HIP_MEMORY_SCOPE_AGENT); }
__device__ __forceinline__ unsigned xb_add(unsigned* p, unsigned v) { return __hip_atomic_fetch_add(p, v, __ATOMIC_RELAXED, __HIP_MEMORY_SCOPE_AGENT); }
__device__ __forceinline__ unsigned xb_xcc_id() { return (unsigned)__builtin_amdgcn_s_getreg((3 << 11) | 20) & 0xFu; }
#define XB_SPIN(cond, bar) do { unsigned _sp = 0; while (cond) { __builtin_amdgcn_s_sleep(1); \
    if ((++_sp & 255u) == 0u) { if (xb_ld(&(bar)[XB_TMO])) break; if (_sp > XB_SPIN_CAP) { atomicAdd(&(bar)[XB_TMO], 1u); break; } } } } while (0)
struct XcdBarrier { unsigned* bar; unsigned x; volatile LAS unsigned* st; };
__device__ __forceinline__ XcdBarrier xcd_barrier_post(unsigned* bar, volatile LAS unsigned* st) {
    XcdBarrier b; b.bar = bar; b.x = xb_xcc_id(); b.st = st;
    if (threadIdx.x == 0) (void)xb_add(&bar[XB_XCNT(b.x)], 1u);
    return b;
}
__device__ __forceinline__ void xcd_barrier_complete(unsigned* bar, unsigned x, unsigned& nloc, unsigned& nx) {
    const unsigned G = gridDim.x * gridDim.y * gridDim.z;
    unsigned sum, cnt, mine, sp = 0u;
    for (;;) {
        sum = 0u; cnt = 0u; mine = 0u;
#pragma unroll
        for (unsigned j = 0; j < 16; ++j) { const unsigned c = xb_ld(&bar[XB_XCNT(j)]); sum += c; cnt += (c > 0u) ? 1u : 0u; mine = (j == x) ? c : mine; }
        if (sum == G) break;
        __builtin_amdgcn_s_sleep(1);
        if ((++sp & 255u) == 0u) { if (xb_ld(&bar[XB_TMO])) break; if (sp > XB_SPIN_CAP) { atomicAdd(&bar[XB_TMO], 1u); break; } }
    }
    nloc = mine > 0u ? mine : 1u; nx = cnt > 0u ? cnt : 1u;
}
__device__ __forceinline__ void xcd_barrier(const XcdBarrier& b) {
    asm volatile("s_waitcnt vmcnt(0)" ::: "memory");
    __syncthreads();
    if (threadIdx.x == 0) {
        unsigned* bar = b.bar;
        __builtin_amdgcn_s_waitcnt(0);
        unsigned nloc = b.st[0], nx = b.st[1];
        if (nloc == 0u) { xcd_barrier_complete(bar, b.x, nloc, nx); b.st[0] = nloc; b.st[1] = nx; }
        const unsigned old = xb_add(&bar[XB_XSUB(b.x)], 1u);
        const unsigned gen = old / nloc;
        if (old + 1u == (gen + 1u) * nloc) {
            __builtin_amdgcn_fence(__ATOMIC_RELEASE, "agent");
            asm volatile("s_waitcnt vmcnt(0)" ::: "memory");
            const unsigned og = xb_add(&bar[XB_TOP], 1u);
            const unsigned tg = og / nx;
            if (og + 1u == (tg + 1u) * nx) xb_add(&bar[XB_TOPGEN], 1u);
            else XB_SPIN(xb_ld(&bar[XB_TOPGEN]) == tg, bar);
            __builtin_amdgcn_fence(__ATOMIC_ACQUIRE, "agent");
            xb_add(&bar[XB_XGEN(b.x)], 1u);
            asm volatile("s_waitcnt vmcnt(0)" ::: "memory");
        } else {
            XB_SPIN(xb_ld(&bar[XB_XGEN(b.x)]) == gen, bar);
            __builtin_amdgcn_fence(__ATOMIC_ACQUIRE, "agent");
            asm volatile("s_waitcnt vmcnt(0)" ::: "memory");
        }
    }
    __syncthreads();
}

#ifdef PROBE_RGN
#define RGN(n, e) do { if ((n) == PROBE_RGN && blockIdx.x == PROBE_BLK && threadIdx.x == 0) { asm volatile("s_waitcnt vmcnt(0) lgkmcnt(0)" ::: "memory"); ((unsigned long long*)(rgn_ws + 48 * 1024))[e] = __builtin_amdgcn_s_memrealtime(); } } while (0)
#else
#define RGN(n, e) do {} while (0)
#endif
struct Args { const float* in[29]; float* out; unsigned char* ws; int ph_lo, ph_hi; };
enum { I_X = 0, I_P, I_NMIXG, I_WIN, I_LRE, I_LIM, I_LOGDT, I_BRE, I_BIM, I_CRE, I_CIM, I_DSKIP, I_WGLU, I_BGLU, I_QNG, I_KNG, I_SSMG, I_ATTG, I_WOUT,
       I_NFFNG, I_WQ, I_SK1, I_SK2, I_EU, I_EV, I_NPLEG, I_WGATE, I_WPROJ, I_FING };

struct Ctx { int tid, lane, wave, blk, nblk; unsigned char* lds; };

struct GemmD { const bf16_t* A; long lda; const bf16_t* Bt; long ldb; int K; int kmid; };
struct Unit { int pm, pn; };

template <class Epi>
__device__ __forceinline__ void sgemm_unit(const GemmD& g, const Unit u, const Epi& E, int wave, int lane) {
    const int i = lane & 15, q = lane >> 4;
    const bf16_t* Ab = g.A + (long)(u.pm * 256 + wave * 32) * g.lda;
    const bf16_t* Bb = g.Bt + (long)(u.pn * 256) * g.ldb;
    const int row0 = u.pm * 256 + wave * 32 + i;
    float ssq[2] = {0.f, 0.f};
    float rs[2] = {1.f, 1.f};
    if constexpr (Epi::ROWSCALE) { rs[0] = E.rscale(row0); rs[1] = E.rscale(row0 + 16); }
    for (int cg = 0; cg < 4; ++cg) {
        f32x4 acc[2][4];
#pragma unroll
        for (int mi = 0; mi < 2; ++mi)
#pragma unroll
            for (int ni = 0; ni < 4; ++ni) acc[mi][ni] = (f32x4){0.f, 0.f, 0.f, 0.f};
        for (int k0 = 0; k0 < g.K; k0 += 32) {
            if constexpr (Epi::MID) { if (k0 == g.kmid) {
#pragma unroll
                for (int mi = 0; mi < 2; ++mi) { const float f = E.mid(row0 + 16 * mi);
#pragma unroll
                    for (int ni = 0; ni < 4; ++ni) acc[mi][ni] *= f; } } }
            bf16x8 a[2], b[4];
#pragma unroll
            for (int mi = 0; mi < 2; ++mi) a[mi] = *(const bf16x8*)(Ab + (long)(16 * mi + i) * g.lda + k0 + 8 * q);
#pragma unroll
            for (int ni = 0; ni < 4; ++ni) b[ni] = *(const bf16x8*)(Bb + (long)(cg * 64 + 16 * ni + i) * g.ldb + k0 + 8 * q);
#pragma unroll
            for (int mi = 0; mi < 2; ++mi)
#pragma unroll
                for (int ni = 0; ni < 4; ++ni) acc[mi][ni] = __builtin_amdgcn_mfma_f32_16x16x32_bf16(b[ni], a[mi], acc[mi][ni], 0, 0, 0);
        }
#pragma unroll
        for (int mi = 0; mi < 2; ++mi)
#pragma unroll
            for (int ni = 0; ni < 4; ++ni) {
                const f32x4 v = acc[mi][ni] * rs[mi];
                const f32x4 w = E.put(row0 + 16 * mi, u.pn * 256 + cg * 64 + 16 * ni + 4 * q, v);
                ssq[mi] += w[0] * w[0] + w[1] * w[1] + w[2] * w[2] + w[3] * w[3];
            }
    }
    if constexpr (Epi::SSQ) {
#pragma unroll
        for (int mi = 0; mi < 2; ++mi) { float s = ssq[mi]; s += __shfl_xor(s, 16); s += __shfl_xor(s, 32);
            if (q == 0) { E.ssq(row0 + 16 * mi, u.pn * 4 + 0, s); E.ssq(row0 + 16 * mi, u.pn * 4 + 1, 0.f); E.ssq(row0 + 16 * mi, u.pn * 4 + 2, 0.f); E.ssq(row0 + 16 * mi, u.pn * 4 + 3, 0.f); } }
    }
}

__device__ __forceinline__ u32x2 pack4(f32x4 v) { u32x2 w; w.x = pk2(v[0], v[1]); w.y = pk2(v[2], v[3]); return w; }
__device__ __forceinline__ u32x4 pack8(f32x4 a, f32x4 b) { u32x4 w; w.x = pk2(a[0], a[1]); w.y = pk2(a[2], a[3]); w.z = pk2(b[0], b[1]); w.w = pk2(b[2], b[3]); return w; }
__device__ __forceinline__ void unpack8(u32x4 w, f32x4& a, f32x4& b) { a = (f32x4){bflo(w.x), bfhi(w.x), bflo(w.y), bfhi(w.y)}; b = (f32x4){bflo(w.z), bfhi(w.z), bflo(w.w), bfhi(w.w)}; }

struct EpiInproj {
    static constexpr bool MID = false, ROWSCALE = true, SSQ = false;
    const float* ssq0; bf16_t* ucat; bf16_t* qraw; bf16_t* kv;
    __device__ __forceinline__ float rscale(int row) const { return ssq0[row]; }
    __device__ __forceinline__ f32x4 put(int row, int col, f32x4 v) const {
        const u32x2 w = pack4(v);
        if (col < 512) { const int g = col >> 4, qq = col & 15, b = row >> 13, s = row & (SEQ - 1), c = s >> 5, j = s & 31;
            *(u32x2*)(ucat + ((long)((g * 2 + b) * NCH + c) * KCAT + j * 16 + qq)) = w; }
        else if (col < 1024) *(u32x2*)(qraw + (long)row * 512 + (col - 512)) = w;
        else *(u32x2*)(kv + (long)row * 256 + (col - 1024)) = w;
        return v;
    }
    __device__ __forceinline__ void put8(int row, int col, f32x4 v0, f32x4 v1, f32x4& w0, f32x4& w1) const {
        const u32x4 w = pack8(v0, v1); w0 = v0; w1 = v1;
        if (col < 512) { const int g = col >> 4, qq = col & 15, b = row >> 13, s = row & (SEQ - 1), c = s >> 5, j = s & 31;
            *(u32x4*)(ucat + ((long)((g * 2 + b) * NCH + c) * KCAT + j * 16 + qq)) = w; }
        else if (col < 1024) *(u32x4*)(qraw + (long)row * 512 + (col - 512)) = w;
        else *(u32x4*)(kv + (long)row * 256 + (col - 1024)) = w;
    }
    __device__ __forceinline__ void ssq(int, int, float) const {}
};
struct EpiS1 {
    static constexpr bool MID = false, ROWSCALE = false, SSQ = false;
    float* ebuf;
    __device__ __forceinline__ f32x4 put(int row, int col, f32x4 v) const { *(f32x4*)(ebuf + ((long)row * 256 + (col & 255))) = v; return v; }
    __device__ __forceinline__ void put8(int row, int col, f32x4 v0, f32x4 v1, f32x4& w0, f32x4& w1) const { float* p = ebuf + ((long)row * 256 + (col & 255)); *(f32x4*)p = v0; *(f32x4*)(p + 4) = v1; w0 = v0; w1 = v1; }
    __device__ __forceinline__ void ssq(int, int, float) const {}
};
struct EpiS2 {
    static constexpr bool MID = false, ROWSCALE = false, SSQ = false;
    bf16_t* G;
    __device__ __forceinline__ f32x4 put(int row, int col, f32x4 v) const {
        const int pm = row >> 8, c = row & 255, g = pm >> 1, b = pm & 1, nout = col & 511, j = nout >> 4, p = nout & 15;
        const long tok = (long)b * SEQ + c * LCH + j;
        f32x4 y; y[0] = gelu_tanh(v[0]); y[1] = gelu_tanh(v[1]); y[2] = gelu_tanh(v[2]); y[3] = gelu_tanh(v[3]);
        *(u32x2*)(G + tok * 512 + 16 * g + p) = pack4(y); return v;
    }
    __device__ __forceinline__ void put8(int row, int col, f32x4 v0, f32x4 v1, f32x4& w0, f32x4& w1) const {
        const int pm = row >> 8, c = row & 255, g = pm >> 1, b = pm & 1, nout = col & 511, j = nout >> 4, p = nout & 15;
        const long tok = (long)b * SEQ + c * LCH + j;
        f32x4 y0, y1;
#pragma unroll
        for (int e = 0; e < 4; ++e) { y0[e] = gelu_tanh(v0[e]); y1[e] = gelu_tanh(v1[e]); }
        *(u32x4*)(G + tok * 512 + 16 * g + p) = pack8(y0, y1); w0 = v0; w1 = v1;
    }
    __device__ __forceinline__ void ssq(int, int, float) const {}
};
struct EpiGlu {
    static constexpr bool MID = false, ROWSCALE = false, SSQ = true;
    const bf16_t* G; const float* bglu; bf16_t* Y; float* ssqs;
    __device__ __forceinline__ f32x4 put(int row, int col, f32x4 v) const {
        const u32x2 gw = *(const u32x2*)(G + (long)row * 512 + col);
        const f32x4 bb = *(const f32x4*)(bglu + col);
        f32x4 ys; ys[0] = bflo(gw.x) * sigmoidf_(v[0] + bb[0]); ys[1] = bfhi(gw.x) * sigmoidf_(v[1] + bb[1]);
        ys[2] = bflo(gw.y) * sigmoidf_(v[2] + bb[2]); ys[3] = bfhi(gw.y) * sigmoidf_(v[3] + bb[3]);
        *(u32x2*)(Y + (long)row * 1024 + col) = pack4(ys); return ys;
    }
    __device__ __forceinline__ void put8(int row, int col, f32x4 v0, f32x4 v1, f32x4& w0, f32x4& w1) const {
        f32x4 g0, g1; unpack8(*(const u32x4*)(G + (long)row * 512 + col), g0, g1);
        const f32x4 b0 = *(const f32x4*)(bglu + col), b1 = *(const f32x4*)(bglu + col + 4);
#pragma unroll
        for (int e = 0; e < 4; ++e) { w0[e] = g0[e] * sigmoidf_(v0[e] + b0[e]); w1[e] = g1[e] * sigmoidf_(v1[e] + b1[e]); }
        *(u32x4*)(Y + (long)row * 1024 + col) = pack8(w0, w1);
    }
    static constexpr int PRE_DEPTH = 6; struct Pre { u32x4 g; };
    __device__ __forceinline__ void pre8(int row, int col, Pre& q) const { q.g = *(const u32x4*)(G + (long)row * 512 + col); }
    __device__ __forceinline__ void fin8(int row, int col, f32x4 v0, f32x4 v1, const Pre& q, f32x4& w0, f32x4& w1) const {
        f32x4 g0, g1; unpack8(q.g, g0, g1);
        const f32x4 b0 = *(const f32x4*)(bglu + col), b1 = *(const f32x4*)(bglu + col + 4);
#pragma unroll
        for (int e = 0; e < 4; ++e) { w0[e] = g0[e] * sigmoidf_(v0[e] + b0[e]); w1[e] = g1[e] * sigmoidf_(v1[e] + b1[e]); }
        *(u32x4*)(Y + (long)row * 1024 + col) = pack8(w0, w1);
    }
    __device__ __forceinline__ void ssq(int row, int slot, float s) const { ssqs[(long)row * 16 + slot] = s; }
};
struct EpiOut {
    static constexpr bool MID = true, ROWSCALE = true, SSQ = true;
    const float* rs; bf16_t* xb; float* ssq1;
    __device__ __forceinline__ float mid(int row) const { return rs[(long)row * 2]; }
    __device__ __forceinline__ float rscale(int row) const { return rs[(long)row * 2 + 1]; }
    __device__ __forceinline__ f32x4 put(int row, int col, f32x4 v) const {
        const long o = (long)row * D + col; const u32x2 xw = *(const u32x2*)(xb + o); const f32x4 x1 = (f32x4){bflo(xw.x), bfhi(xw.x), bflo(xw.y), bfhi(xw.y)} + v;
        const u32x2 ow = pack4(x1); *(u32x2*)(xb + o) = ow; return (f32x4){bflo(ow.x), bfhi(ow.x), bflo(ow.y), bfhi(ow.y)};
    }
    __device__ __forceinline__ void put8(int row, int col, f32x4 v0, f32x4 v1, f32x4& w0, f32x4& w1) const {
        const long o = (long)row * D + col; f32x4 x0, x1; unpack8(*(const u32x4*)(xb + o), x0, x1);
        const u32x4 ow = pack8(x0 + v0, x1 + v1); *(u32x4*)(xb + o) = ow; unpack8(ow, w0, w1);
    }
    static constexpr int PRE_DEPTH = 6; struct Pre { u32x4 x; };
    __device__ __forceinline__ void pre8(int row, int col, Pre& q) const { q.x = *(const u32x4*)(xb + (long)row * D + col); }
    __device__ __forceinline__ void fin8(int row, int col, f32x4 v0, f32x4 v1, const Pre& q, f32x4& w0, f32x4& w1) const {
        const long o = (long)row * D + col; f32x4 x0, x1; unpack8(q.x, x0, x1);
        const u32x4 ow = pack8(x0 + v0, x1 + v1); *(u32x4*)(xb + o) = ow; unpack8(ow, w0, w1);
    }
    __device__ __forceinline__ void ssq(int row, int slot, float s) const { ssq1[(long)row * 16 + slot] = s; }
};
struct EpiQ {
    static constexpr bool MID = false, ROWSCALE = true, SSQ = false;
    const float* ssq1; bf16_t* qp;
    __device__ __forceinline__ float rscale(int row) const { return ssq1[row]; }
    __device__ __forceinline__ f32x4 put(int row, int col, f32x4 v) const { *(u32x2*)(qp + (long)row * 2048 + col) = pack4(v); return v; }
    __device__ __forceinline__ void put8(int row, int col, f32x4 v0, f32x4 v1, f32x4& w0, f32x4& w1) const {
        const int pm = row >> 8, tgl = (row >> 5) & 7, tl = row & 31, h = col >> 8, half = (col >> 7) & 1, d = col & 127, ks = d >> 4, hi = (d >> 3) & 1;
        const size_t off = ((((((size_t)(pm * 8 + h) * 8 + tgl) * 2 + half) * 8 + ks) * 64) + (hi * 32 + tl)) * 8;
        *(u32x4*)(qp + off) = pack8(v0, v1); w0 = v0; w1 = v1; }
    __device__ __forceinline__ void ssq(int, int, float) const {}
};
struct EpiProj {
    static constexpr bool MID = false, ROWSCALE = false, SSQ = false;
    bf16_t* pr;
    __device__ __forceinline__ f32x4 put(int row, int col, f32x4 v) const { *(u32x2*)(pr + (long)row * D + col) = pack4(v); return v; }
    __device__ __forceinline__ void put8(int row, int col, f32x4 v0, f32x4 v1, f32x4& w0, f32x4& w1) const { *(u32x4*)(pr + (long)row * D + col) = pack8(v0, v1); w0 = v0; w1 = v1; }
    __device__ __forceinline__ void ssq(int, int, float) const {}
};
struct EpiGate {
    static constexpr bool MID = false, ROWSCALE = true, SSQ = true;
    const bf16_t* pr; const bf16_t* xin; bf16_t* xout; float* ssq0; const float* ssq2;
    __device__ __forceinline__ float rscale(int row) const { return ssq2[row]; }
    __device__ __forceinline__ f32x4 put(int row, int col, f32x4 v) const {
        const long o = (long)row * D + col; const u32x2 pw = *(const u32x2*)(pr + o); const f32x4 pv = (f32x4){bflo(pw.x), bfhi(pw.x), bflo(pw.y), bfhi(pw.y)}; const u32x2 xw = *(const u32x2*)(xin + o); f32x4 x3 = (f32x4){bflo(xw.x), bfhi(xw.x), bflo(xw.y), bfhi(xw.y)};
        x3[0] += sigmoidf_(v[0]) * pv[0]; x3[1] += sigmoidf_(v[1]) * pv[1]; x3[2] += sigmoidf_(v[2]) * pv[2]; x3[3] += sigmoidf_(v[3]) * pv[3];
        const u32x2 ow = pack4(x3); *(u32x2*)(xout + o) = ow; return (f32x4){bflo(ow.x), bfhi(ow.x), bflo(ow.y), bfhi(ow.y)};
    }
    __device__ __forceinline__ void put8(int row, int col, f32x4 v0, f32x4 v1, f32x4& w0, f32x4& w1) const {
        const long o = (long)row * D + col; f32x4 p0, p1, x0, x1; unpack8(*(const u32x4*)(pr + o), p0, p1); unpack8(*(const u32x4*)(xin + o), x0, x1);
#pragma unroll
        for (int e = 0; e < 4; ++e) { x0[e] += sigmoidf_(v0[e]) * p0[e]; x1[e] += sigmoidf_(v1[e]) * p1[e]; }
        const u32x4 ow = pack8(x0, x1); *(u32x4*)(xout + o) = ow; unpack8(ow, w0, w1);
    }
    static constexpr int PRE_DEPTH = 3; struct Pre { u32x4 p, x; };
    __device__ __forceinline__ void pre8(int row, int col, Pre& q) const { const long o = (long)row * D + col; q.p = *(const u32x4*)(pr + o); q.x = *(const u32x4*)(xin + o); }
    __device__ __forceinline__ void fin8(int row, int col, f32x4 v0, f32x4 v1, const Pre& q, f32x4& w0, f32x4& w1) const {
        const long o = (long)row * D + col; f32x4 p0, p1, x0, x1; unpack8(q.p, p0, p1); unpack8(q.x, x0, x1);
#pragma unroll
        for (int e = 0; e < 4; ++e) { x0[e] += sigmoidf_(v0[e]) * p0[e]; x1[e] += sigmoidf_(v1[e]) * p1[e]; }
        const u32x4 ow = pack8(x0, x1); *(u32x4*)(xout + o) = ow; unpack8(ow, w0, w1);
    }
    __device__ __forceinline__ void ssq(int row, int slot, float s) const { ssq0[(long)row * 16 + slot] = s; }
};


namespace pg8 {
#define PG8_LAS __attribute__((address_space(3)))
constexpr int BM = 256, BK = 64, HALF = 128, HTB = HALF * BK * 2, STAGE_BYTES = 8 * HTB, NXCD = 8, WGM = 8;
__host__ __device__ __forceinline__ int lds_byte(int r, int c) { const int st = (r >> 4) * 2 + (c >> 5), rr = r & 15, cc = c & 31, ob = rr * 64 + cc * 2; return st * 1024 + (ob ^ (((ob >> 9) & 1) << 5)); }
__host__ __device__ __forceinline__ void stage_rc(int b, int& R, int& C) { const int st = b / 1024, sb = b % 1024, swz = sb ^ (((sb >> 9) & 1) << 5); R = (st >> 1) * 16 + swz / 64; C = (st & 1) * 32 + (swz % 64) / 2; }
__host__ __device__ __forceinline__ int perm32(int rho) { const int n = rho >> 4, i = rho & 15; return 8 * (i >> 2) + 4 * n + (i & 3); }
using ::Unit;
struct Gemm { const bf16_t* A; const bf16_t* Bt; int K, lda, ldb, kmid; };
struct StaticOrder {
    int nM, nN, nwg, G, c;
    __host__ __device__ __forceinline__ void init(int M_, int N_, int G_, int c_) { nM = M_ / BM; nN = N_ / BM; nwg = nM * nN; G = G_; c = c_; }
    __host__ __device__ __forceinline__ bool next(int i, Unit& u) const {
        const long L = (long)i * G + c; if (L >= nwg) return false;
        int wgid = (int)L; { const int q = nwg / NXCD, r = nwg % NXCD, xcd = wgid % NXCD, off = wgid / NXCD; wgid = (xcd < r ? xcd * (q + 1) : r * (q + 1) + (xcd - r) * q) + off; }
        const int nig = WGM * nN, gid = wgid / nig, fm = gid * WGM, gsz = (nM - fm) < WGM ? (nM - fm) : WGM;
        u.pm = fm + ((wgid % nig) % gsz); u.pn = (wgid % nig) / gsz; return true;
    }
    __device__ __forceinline__ void a_ready(const Unit&) const {}
    __device__ __forceinline__ void done(const Unit&) const {}
};
struct OneUnit { Unit u;
    __device__ __forceinline__ bool next(int i, Unit& o) const { if (i) return false; o = u; return true; }
    __device__ __forceinline__ void a_ready(const Unit&) const {}
    __device__ __forceinline__ void done(const Unit&) const {} };
struct S2Order { int blk, nblk;
    __device__ __forceinline__ bool next(int i, Unit& o) const { const int ui = blk + i * nblk; if (ui >= 128) return false; o.pm = ui >> 1; o.pn = (ui >> 2) * 2 + (ui & 1); return true; }
    __device__ __forceinline__ void a_ready(const Unit&) const {}
    __device__ __forceinline__ void done(const Unit&) const {} };
template <class F, class = void> struct has_pre { static constexpr bool value = false; };
template <class F> struct has_pre<F, std::void_t<typename F::Pre>> { static constexpr bool value = true; };
template <class F> struct Epi {
    static constexpr bool PERM = true, AFTER_DRAIN = false, MID = F::MID;
    F f;
    __device__ __forceinline__ void operator()(const f32x4 (&acc)[2][2][4][2], const Unit& u, int wr, int wc, int fr, int fq) const {
        asm volatile("" : "+v"(fr), "+v"(fq));
        const int rowb = u.pm * BM + wr * 64 + fr, colb = u.pn * BM + wc * 32 + 8 * fq;
        float rsv[8];
#pragma unroll
        for (int i = 0; i < 8; ++i) { rsv[i] = 1.f; if constexpr (F::ROWSCALE) rsv[i] = f.rscale(rowb + (i >> 2) * HALF + (i & 3) * 16); }
        if constexpr (has_pre<F>::value) {
            constexpr int DP = F::PRE_DEPTH;
            typename F::Pre pre[DP][2];
#pragma unroll
            for (int k = 0; k < DP; ++k)
#pragma unroll
                for (int bj = 0; bj < 2; ++bj) f.pre8(rowb + (k >> 2) * HALF + (k & 3) * 16, colb + bj * HALF, pre[k][bj]);
            asm volatile("" ::: "memory");
#pragma unroll
            for (int k = 0; k < 8; ++k) {
                const int row = rowb + (k >> 2) * HALF + (k & 3) * 16; const float rs = rsv[k];
                float ss = 0.f;
#pragma unroll
                for (int bj = 0; bj < 2; ++bj) { f32x4 w0, w1; f.fin8(row, colb + bj * HALF, acc[k >> 2][bj][k & 3][0] * rs, acc[k >> 2][bj][k & 3][1] * rs, pre[k % DP][bj], w0, w1);
                    ss += (w0[0] * w0[0] + w0[1] * w0[1] + w0[2] * w0[2] + w0[3] * w0[3]) + (w1[0] * w1[0] + w1[1] * w1[1] + w1[2] * w1[2] + w1[3] * w1[3]); }
                if constexpr (F::SSQ) { ss += __shfl_xor(ss, 16); ss += __shfl_xor(ss, 32); if (fq == 0) f.ssq(row, u.pn * 4 + wc, ss); }
                if (k + DP < 8) {
#pragma unroll
                    for (int bj = 0; bj < 2; ++bj) f.pre8(rowb + ((k + DP) >> 2) * HALF + ((k + DP) & 3) * 16, colb + bj * HALF, pre[k % DP][bj]);
                }
                asm volatile("" ::: "memory");
            }
            return;
        }
#pragma unroll
        for (int ai = 0; ai < 2; ++ai)
#pragma unroll
            for (int m = 0; m < 4; ++m) {
                const int row = rowb + ai * HALF + m * 16; const float rs = rsv[ai * 4 + m];
                float ss = 0.f;
#pragma unroll
                for (int bj = 0; bj < 2; ++bj) { f32x4 w0, w1; f.put8(row, colb + bj * HALF, acc[ai][bj][m][0] * rs, acc[ai][bj][m][1] * rs, w0, w1);
                    ss += (w0[0] * w0[0] + w0[1] * w0[1] + w0[2] * w0[2] + w0[3] * w0[3]) + (w1[0] * w1[0] + w1[1] * w1[1] + w1[2] * w1[2] + w1[3] * w1[3]); }
                if constexpr (F::SSQ) { ss += __shfl_xor(ss, 16); ss += __shfl_xor(ss, 32); if (fq == 0) f.ssq(row, u.pn * 4 + wc, ss); }
                asm volatile("" ::: "memory");
            }
    }
    __device__ __forceinline__ void midscale(f32x4 (&acc)[2][2][4][2], const Unit& u, int wr, int wc, int fr, int fq) const {
        if constexpr (F::MID) {
            asm volatile("" : "+v"(fr));
            const int rowb = u.pm * BM + wr * 64 + fr;
#pragma unroll
            for (int ai = 0; ai < 2; ++ai)
#pragma unroll
                for (int m = 0; m < 4; ++m) { const float s = f.mid(rowb + ai * HALF + m * 16);
#pragma unroll
                    for (int bj = 0; bj < 2; ++bj)
#pragma unroll
                        for (int n = 0; n < 2; ++n) acc[ai][bj][m][n] *= s; }
        }
    }
};
template <class Epi, class Sched, bool ALIGN_EPI = false, bool SP2 = false>
__device__ __forceinline__ void gemm_phase(PG8_LAS unsigned char* lds, const Gemm g, const Sched& S, const Epi& E, const int tid) {
    const int wid = __builtin_amdgcn_readfirstlane(tid >> 6), lane = tid & 63, wr = wid >> 2, wc = wid & 3, fr = lane & 15, fq = lane >> 4;
    const int K = g.K, nt = K / BK;
    unsigned voffA[2], voffB[2];
#pragma unroll
    for (int i = 0; i < 2; ++i) { int R, C; stage_rc(tid * 16 + i * 8192, R, C); const int Rb = Epi::PERM ? ((R & ~31) + perm32(R & 31)) : R;
        voffA[i] = (unsigned)(R * g.lda + C) * 2u; voffB[i] = (unsigned)(Rb * g.ldb + C) * 2u; }
    const size_t kstep = (size_t)(BK * 2);
    const size_t hstepA = (size_t)HALF * g.lda * 2, hstepB = (size_t)HALF * g.ldb * 2;
    const size_t tstepA = 2 * hstepA, tstepB = 2 * hstepB;
    const unsigned ldsw = (unsigned)wid * 1024u;
    const int aoff = lds_byte(wr * 64 + fr, fq * 8), boff = lds_byte(wc * 32 + fr, fq * 8);
#define PG8_SA(b, h) (((b) * 2 + (h)) * HTB)
#define PG8_SB(b, h) ((4 + (b) * 2 + (h)) * HTB)
#define PG8_STAGE(bufoff, gbase, voff) do { _Pragma("unroll") for (int _i = 0; _i < 2; ++_i) \
        __builtin_amdgcn_global_load_lds((const unsigned*)((const char*)(gbase) + (voff)[_i]), (PG8_LAS unsigned*)(lds + (bufoff) + ldsw + _i * 8192), 16, 0, 0); } while (0)
#define PG8_LDA(dst, b, h) do { _Pragma("unroll") for (int m = 0; m < 4; ++m) _Pragma("unroll") for (int k = 0; k < 2; ++k) dst[m][k] = *(const PG8_LAS bf16x8*)(lds + PG8_SA(b, h) + aoff + m * 2048 + k * 1024); } while (0)
#define PG8_LDB(dst, b, h) do { _Pragma("unroll") for (int n = 0; n < 2; ++n) _Pragma("unroll") for (int k = 0; k < 2; ++k) dst[n][k] = *(const PG8_LAS bf16x8*)(lds + PG8_SB(b, h) + boff + n * 2048 + k * 1024); } while (0)
#define PG8_MMA(ai, bj, At, Bt) do { __builtin_amdgcn_s_setprio(1); _Pragma("unroll") for (int m = 0; m < 4; ++m) _Pragma("unroll") for (int n = 0; n < 2; ++n) _Pragma("unroll") for (int k = 0; k < 2; ++k) \
        acc[ai][bj][m][n] = __builtin_amdgcn_mfma_f32_16x16x32_bf16(Bt[n][k], At[m][k], acc[ai][bj][m][n], 0, 0, 0); __builtin_amdgcn_s_setprio(0); } while (0)
#define PG8_WAIT_V(n) asm volatile("s_waitcnt vmcnt(" #n ")" ::: "memory")
#define PG8_WAIT_L(n) asm volatile("s_waitcnt lgkmcnt(" #n ")" ::: "memory")
#define PG8_BAR __builtin_amdgcn_s_barrier()
#define PG8_SCHED __builtin_amdgcn_sched_barrier(0)
    Unit cur, nxt; int ui = 0;
    if (!S.next(0, cur)) return;
    f32x4 acc[2][2][4][2];
#pragma unroll
    for (int a = 0; a < 2; ++a)
#pragma unroll
        for (int b = 0; b < 2; ++b)
#pragma unroll
            for (int m = 0; m < 4; ++m)
#pragma unroll
                for (int n = 0; n < 2; ++n) acc[a][b][m][n] = (f32x4){0.f, 0.f, 0.f, 0.f};
    bf16x8 At[4][2], B0[2][2], B1[2][2];
    const char* cA = (const char*)g.A + (size_t)cur.pm * tstepA; const char* cB = (const char*)g.Bt + (size_t)cur.pn * tstepB;
    S.a_ready(cur);
    if constexpr (SP2) {
        PG8_STAGE(PG8_SB(0, 0), cB, voffB); PG8_STAGE(PG8_SB(0, 1), cB + hstepB, voffB); PG8_STAGE(PG8_SA(0, 0), cA, voffA); PG8_STAGE(PG8_SA(0, 1), cA + hstepA, voffA);
        if (wr == 1) PG8_BAR;
        PG8_WAIT_V(2); PG8_BAR;
        PG8_STAGE(PG8_SB(1, 0), cB + kstep, voffB); PG8_STAGE(PG8_SA(1, 0), cA + kstep, voffA); PG8_STAGE(PG8_SB(1, 1), cB + hstepB + kstep, voffB);
        PG8_WAIT_V(6); PG8_BAR;
    } else {
        PG8_STAGE(PG8_SB(0, 0), cB, voffB); PG8_STAGE(PG8_SA(0, 0), cA, voffA); PG8_STAGE(PG8_SB(0, 1), cB + hstepB, voffB); PG8_STAGE(PG8_SA(0, 1), cA + hstepA, voffA);
        if (wr == 1) PG8_BAR;
        PG8_WAIT_V(4); PG8_BAR;
        PG8_STAGE(PG8_SB(1, 0), cB + kstep, voffB); PG8_STAGE(PG8_SA(1, 0), cA + kstep, voffA); PG8_STAGE(PG8_SB(1, 1), cB + hstepB + kstep, voffB);
        PG8_WAIT_V(6); PG8_BAR;
    }
    for (;;) {
        const bool has_next = S.next(ui + 1, nxt);
        const char* nA = has_next ? (const char*)g.A + (size_t)nxt.pm * tstepA : cA; const char* nB = has_next ? (const char*)g.Bt + (size_t)nxt.pn * tstepB : cB;
        for (int t = 0; t < nt; t += 2) {
            const bool last = (t == nt - 2);
            if constexpr (Epi::MID) { if (t * BK == g.kmid) E.midscale(acc, cur, wr, wc, fr, fq); }
            const char* a1 = cA + (size_t)(t + 1) * kstep;
            const char* a2 = last ? nA : cA + (size_t)(t + 2) * kstep; const char* b2 = last ? nB : cB + (size_t)(t + 2) * kstep;
            const char* a3 = a2 + kstep; const char* b3 = b2 + kstep;
            if (last && has_next) S.a_ready(nxt);
            if constexpr (SP2) {
            PG8_LDB(B0, 0, 0); PG8_LDB(B1, 0, 1); PG8_SCHED; PG8_LDA(At, 0, 0); PG8_STAGE(PG8_SA(1, 1), a1 + hstepA, voffA);
            PG8_WAIT_V(8); PG8_WAIT_L(0); PG8_BAR; PG8_MMA(0, 0, At, B0); PG8_MMA(0, 1, At, B1); PG8_BAR; PG8_SCHED;
            PG8_LDA(At, 0, 1); PG8_STAGE(PG8_SB(0, 0), b2, voffB); PG8_STAGE(PG8_SB(0, 1), b2 + hstepB, voffB); PG8_STAGE(PG8_SA(0, 0), a2, voffA);
            PG8_WAIT_V(8); PG8_WAIT_L(0); PG8_BAR; PG8_MMA(1, 0, At, B0); PG8_MMA(1, 1, At, B1); PG8_BAR; PG8_SCHED;
            PG8_LDB(B0, 1, 0); PG8_LDB(B1, 1, 1); PG8_SCHED; PG8_LDA(At, 1, 0); PG8_STAGE(PG8_SA(0, 1), a2 + hstepA, voffA);
            PG8_WAIT_V(8); PG8_WAIT_L(0); PG8_BAR; PG8_MMA(0, 0, At, B0); PG8_MMA(0, 1, At, B1); PG8_BAR; PG8_SCHED;
            PG8_LDA(At, 1, 1); PG8_STAGE(PG8_SB(1, 0), b3, voffB); PG8_STAGE(PG8_SB(1, 1), b3 + hstepB, voffB); PG8_STAGE(PG8_SA(1, 0), a3, voffA);
            PG8_WAIT_V(8); PG8_WAIT_L(0); PG8_BAR; PG8_MMA(1, 0, At, B0); PG8_MMA(1, 1, At, B1); PG8_BAR; PG8_SCHED;
            } else {
            PG8_LDB(B0, 0, 0); PG8_SCHED; PG8_LDA(At, 0, 0); PG8_STAGE(PG8_SA(1, 1), a1 + hstepA, voffA);
            PG8_WAIT_L(8); PG8_BAR; PG8_WAIT_L(0); PG8_MMA(0, 0, At, B0); PG8_BAR; PG8_SCHED;
            PG8_LDB(B1, 0, 1); PG8_STAGE(PG8_SB(0, 0), b2, voffB);
            PG8_BAR; PG8_WAIT_L(0); PG8_MMA(0, 1, At, B1); PG8_BAR;
            PG8_LDA(At, 0, 1); PG8_STAGE(PG8_SA(0, 0), a2, voffA);
            PG8_BAR; PG8_WAIT_L(0); PG8_MMA(1, 0, At, B0); PG8_BAR; PG8_SCHED;
            PG8_STAGE(PG8_SB(0, 1), b2 + hstepB, voffB);
            PG8_WAIT_V(6); PG8_BAR; PG8_MMA(1, 1, At, B1); PG8_BAR;
            PG8_LDB(B0, 1, 0); PG8_SCHED; PG8_LDA(At, 1, 0); PG8_STAGE(PG8_SA(0, 1), a2 + hstepA, voffA);
            PG8_WAIT_L(8); PG8_BAR; PG8_WAIT_L(0); PG8_MMA(0, 0, At, B0); PG8_BAR; PG8_SCHED;
            PG8_LDB(B1, 1, 1); PG8_STAGE(PG8_SB(1, 0), b3, voffB);
            PG8_BAR; PG8_WAIT_L(0); PG8_MMA(0, 1, At, B1); PG8_BAR;
            PG8_LDA(At, 1, 1); PG8_STAGE(PG8_SA(1, 0), a3, voffA);
            PG8_BAR; PG8_WAIT_L(0); PG8_MMA(1, 0, At, B0); PG8_BAR; PG8_SCHED;
            PG8_STAGE(PG8_SB(1, 1), b3 + hstepB, voffB);
            PG8_WAIT_V(6); PG8_BAR; PG8_MMA(1, 1, At, B1); PG8_BAR;
            }
        }
        if constexpr (ALIGN_EPI) { if (wr == 0) PG8_BAR; }
        if constexpr (!Epi::AFTER_DRAIN) { E(acc, cur, wr, wc, fr, fq); S.done(cur); }
        if (!has_next) break;
#pragma unroll
        for (int a = 0; a < 2; ++a)
#pragma unroll
            for (int b = 0; b < 2; ++b)
#pragma unroll
                for (int m = 0; m < 4; ++m)
#pragma unroll
                    for (int n = 0; n < 2; ++n) acc[a][b][m][n] = (f32x4){0.f, 0.f, 0.f, 0.f};
        cur = nxt; cA = nA; cB = nB; ++ui;
        if constexpr (ALIGN_EPI) { if (wr == 1) PG8_BAR; }
    }
    PG8_WAIT_V(0);
    if constexpr (!ALIGN_EPI) { if (wr == 0) PG8_BAR; }
    PG8_BAR;
    if constexpr (Epi::AFTER_DRAIN) { E.fused(acc, cur, wr, wc, fr, fq, lds, wid, lane); S.done(cur); }
#undef PG8_SA
#undef PG8_SB
#undef PG8_STAGE
#undef PG8_LDA
#undef PG8_LDB
#undef PG8_MMA
#undef PG8_WAIT_V
#undef PG8_WAIT_L
#undef PG8_BAR
#undef PG8_SCHED
}

}

template <class F, class Sched>
__device__ __forceinline__ void run_gemm(unsigned char* lds, const GemmD& g, const Sched& S, const F& f, const int tid) {
    pg8::Gemm pg; pg.A = g.A; pg.Bt = g.Bt; pg.K = g.K; pg.lda = (int)g.lda; pg.ldb = (int)g.ldb; pg.kmid = g.kmid;
    pg8::Epi<F> E; E.f = f;
    pg8::gemm_phase<pg8::Epi<F>, Sched, true, true>((PG8_LAS unsigned char*)lds, pg, S, E, tid);
}
__device__ __forceinline__ void rstd_rows(const Ctx& c, const float* ssq, int nslot, float* rsx, int nN, int G, int cidx) {
    pg8::StaticOrder S0; S0.init(M, nN * 256, G, cidx); Unit u0;
    for (int i = 0; S0.next(i, u0); ++i) if (c.tid < 256) { const int row = u0.pm * 256 + c.tid; rsx[row] = rsqrtf(sumn(ssq + (long)row * 16, nslot) * (1.f / D) + EPS); }
    VM_WAIT(); __syncthreads();
}
template <class Epi>
__device__ __forceinline__ void gemm_phase_sub(const Ctx& c, const GemmD& g, int nM, int nN, const Epi& E, int G, int cidx) {
    pg8::StaticOrder S; S.init(nM * 256, nN * 256, G, cidx);
    run_gemm(c.lds, g, S, E, c.tid);
}
template <class Epi>
__device__ __forceinline__ void gemm_phase_dense(const Ctx& c, const GemmD& g, int nM, int nN, const Epi& E) {
#ifdef USE_SGEMM
    const int nU = nM * nN;
    for (int ui = c.blk; ui < nU; ui += c.nblk) { Unit u; u.pn = ui % nN; u.pm = ui / nN; sgemm_unit(g, u, E, c.wave, c.lane); }
#else
    pg8::StaticOrder S; S.init(nM * 256, nN * 256, c.nblk, c.blk);
    run_gemm(c.lds, g, S, E, c.tid);
#endif
}

constexpr int L1CVT_KV = 2048, L1CVT_SPLIT = 26624;
__device__ __forceinline__ void transpose_item(const float* W, int K, int N, bf16_t* WT, const float* gain, float* scr, int item, int lane) {
    const int nblk = N / 32, kb = item / nblk, nb = item % nblk, k0 = 64 * kb, n0 = 32 * nb;
    { f32x4 v[8];
#pragma unroll
      for (int i = 0; i < 8; ++i) v[i] = *(const f32x4*)(W + (size_t)(k0 + 8 * i + (lane >> 3)) * N + n0 + 4 * (lane & 7));
#pragma unroll
      for (int i = 0; i < 8; ++i) { const int kk = 8 * i + (lane >> 3); const float gg = gain ? gain[k0 + kk] : 1.f; float* s = scr + kk * 33 + 4 * (lane & 7);
          s[0] = v[i][0] * gg; s[1] = v[i][1] * gg; s[2] = v[i][2] * gg; s[3] = v[i][3] * gg; } }
    LDS_WAIT(); asm volatile("" ::: "memory");
    const int cc = lane & 7;
#pragma unroll
    for (int j = 0; j < 4; ++j) { const int n = (lane >> 3) + 8 * j; const float* s = scr + (8 * cc) * 33 + n;
        u32x4 o; o.x = pk2(s[0 * 33], s[1 * 33]); o.y = pk2(s[2 * 33], s[3 * 33]); o.z = pk2(s[4 * 33], s[5 * 33]); o.w = pk2(s[6 * 33], s[7 * 33]);
        *(u32x4*)(WT + (size_t)(n0 + n) * K + k0 + 8 * cc) = o; }
    LDS_WAIT(); asm volatile("" ::: "memory");
}
struct TItem { const float* W; bf16_t* WT; const float* gain; int K, N, item; };
__device__ __forceinline__ void tw_load(const Ctx& c, const TItem& t, f32x4 (&v)[8]) {
    const int nblk = t.N / 256, kb = t.item / nblk, nb = t.item % nblk, k0 = 64 * kb, n0 = 256 * nb;
#pragma unroll
    for (int i = 0; i < 8; ++i) { const int idx = i * 512 + c.tid, row = idx >> 6, c4 = idx & 63; v[i] = *(const f32x4*)(t.W + (size_t)(k0 + row) * t.N + n0 + 4 * c4); }
}
__device__ __forceinline__ void tw_lds_write(const Ctx& c, const TItem& t, const f32x4 (&v)[8]) {
    const int nblk = t.N / 256, kb = t.item / nblk, k0 = 64 * kb;
    float* T = (float*)c.lds;
#pragma unroll
    for (int i = 0; i < 8; ++i) { const int idx = i * 512 + c.tid, row = idx >> 6, c4 = idx & 63; const float gg = t.gain ? t.gain[k0 + row] : 1.f; float* s = T + row * 257 + 4 * c4;
        s[0] = v[i][0] * gg; s[1] = v[i][1] * gg; s[2] = v[i][2] * gg; s[3] = v[i][3] * gg; }
}
__device__ __forceinline__ void tw_store(const Ctx& c, const TItem& t) {
    const int nblk = t.N / 256, kb = t.item / nblk, nb = t.item % nblk, k0 = 64 * kb, n0 = 256 * nb;
    const float* T = (const float*)c.lds;
#pragma unroll
    for (int j = 0; j < 4; ++j) { const int id = j * 512 + c.tid, n = id >> 3, cc = id & 7; const float* s = T + (8 * cc) * 257 + n;
        u32x4 o; o.x = pk2(s[0 * 257], s[1 * 257]); o.y = pk2(s[2 * 257], s[3 * 257]); o.z = pk2(s[4 * 257], s[5 * 257]); o.w = pk2(s[6 * 257], s[7 * 257]);
        *(u32x4*)(t.WT + (size_t)(n0 + n) * t.K + k0 + 8 * cc) = o; }
}
__device__ __forceinline__ void cvt_range(const Ctx& c, const float* src, bf16_t* dst, size_t n) {
    const size_t nv = n / 8, stride = (size_t)c.nblk * 512;
    for (size_t v0 = (size_t)c.blk * 512 + c.tid; v0 < nv; v0 += 4 * stride) {
        f32x4 a[4], b[4];
#pragma unroll
        for (int u = 0; u < 4; ++u) { const size_t v = v0 + u * stride < nv ? v0 + u * stride : v0; a[u] = *(const f32x4*)(src + v * 8); b[u] = *(const f32x4*)(src + v * 8 + 4); }
#pragma unroll
        for (int u = 0; u < 4; ++u) { const size_t v = v0 + u * stride; if (v < nv) { u32x4 o; o.x = pk2(a[u][0], a[u][1]); o.y = pk2(a[u][2], a[u][3]); o.z = pk2(b[u][0], b[u][1]); o.w = pk2(b[u][2], b[u][3]);
            *(u32x4*)(dst + v * 8) = o; } }
    }
}
__device__ __forceinline__ void ssm_tables_unit(const Ctx& c, const Args& a, int layer, int g, int part, int nparts) {
    float* Apow = (float*)c.lds;
    float* Bre = Apow + 2 * 33 * 64 * 2;
    float* Bim = Bre + 2 * 64 * 16;
    float* Cre = Bim + 2 * 64 * 16;
    float* Cim = Cre + 2 * 16 * 64;
    float* Tt = Cim + 2 * 16 * 64;
    unsigned char* lw = a.ws + WS_LW + (size_t)layer * LW_STRIDE;
    float* AL = (float*)(lw + LW_AL);
    bf16_t* WE = (bf16_t*)(lw + LW_WE) + (size_t)g * 256 * 512;
    bf16_t* WY = (bf16_t*)(lw + LW_WY) + (size_t)g * 512 * KCAT;
    const int tid = c.tid;
    unsigned char* rgn_ws = a.ws; (void)rgn_ws;
    __syncthreads();
    RGN(11, 0);
    if (tid < 128) {
        const int dir = tid >> 6, n = tid & 63; const int ldg = (layer * 2 + dir) * NG + g;
        f32x4 brv[4], biv[4]; float crv[16], civ[16];
        { const f32x4* brp = (const f32x4*)(a.in[I_BRE] + (size_t)(ldg * 64 + n) * 16); const f32x4* bip = (const f32x4*)(a.in[I_BIM] + (size_t)(ldg * 64 + n) * 16);
#pragma unroll
          for (int j = 0; j < 4; ++j) { brv[j] = brp[j]; biv[j] = bip[j]; }
#pragma unroll
          for (int p = 0; p < 16; ++p) { crv[p] = a.in[I_CRE][(ldg * 16 + p) * 64 + n]; civ[p] = a.in[I_CIM][(ldg * 16 + p) * 64 + n]; } }
        const float lre = a.in[I_LRE][ldg * 64 + n], lim = a.in[I_LIM][ldg * 64 + n];
        const float dt = expf(a.in[I_LOGDT][ldg]);
        { const float dec = expf(lre * dt); float sn, cs; sincosf(lim * dt, &sn, &cs); const float a1r = dec * cs, a1i = dec * sn;
          float pr = 1.f, pi = 0.f;
          for (int k = 0; k <= 32; ++k) { Apow[((dir * 33 + k) * 64 + n) * 2 + 0] = pr; Apow[((dir * 33 + k) * 64 + n) * 2 + 1] = pi;
              const float nr_ = pr * a1r - pi * a1i, ni_ = pr * a1i + pi * a1r; pr = nr_; pi = ni_; } }
        const float abr = Apow[((dir * 33 + 1) * 64 + n) * 2 + 0], abi = Apow[((dir * 33 + 1) * 64 + n) * 2 + 1];
        const float den = lre * lre + lim * lim, nr = abr - 1.f;
        const float fre = (nr * lre + abi * lim) / den, fim = (abi * lre - nr * lim) / den;
#pragma unroll
        for (int q = 0; q < 16; ++q) { const float br = brv[q >> 2][q & 3], bi = biv[q >> 2][q & 3];
            Bre[(dir * 64 + n) * 16 + q] = fre * br - fim * bi; Bim[(dir * 64 + n) * 16 + q] = fre * bi + fim * br; }
#pragma unroll
        for (int p = 0; p < 16; ++p) { Cre[(dir * 64 + n) * 16 + p] = crv[p]; Cim[(dir * 64 + n) * 16 + p] = civ[p]; }
        if (part == 0) { AL[((dir * NG + g) * 64 + n) * 2 + 0] = Apow[((dir * 33 + 32) * 64 + n) * 2 + 0];
        AL[((dir * NG + g) * 64 + n) * 2 + 1] = Apow[((dir * 33 + 32) * 64 + n) * 2 + 1]; }
    }
    __syncthreads();
    RGN(11, 1); RGN(12, 0);
    const int kk_lo = nparts == 4 ? 8 * part : 0, nkk = nparts == 4 ? 39 : 63;
    {
        const int l15 = c.lane & 15, l4 = c.lane >> 4;
      for (int kb0 = 0; kb0 < nkk; kb0 += 40) {
        f32x4 accs[5]; int ks[5]; bool val[5]; const float* pA[5];
#pragma unroll
        for (int i = 0; i < 5; ++i) { const int kx = kb0 + c.wave + 8 * i; val[i] = kx < nkk; ks[i] = kk_lo + (val[i] ? kx : 0) - 31; accs[i] = (f32x4){0.f, 0.f, 0.f, 0.f};
            const int dir = ks[i] < 0 ? 1 : 0, e = ks[i] < 0 ? -ks[i] : ks[i]; pA[i] = Apow + ((dir * 33 + e) * 64 + l4) * 2; }
        const float* pC0 = Cre + l4 * 16 + l15; const float* pB0 = Bre + l4 * 16 + l15;
#pragma unroll
        for (int half = 0; half < 2; ++half) {
#pragma unroll 4
            for (int st = 0; st < 16; ++st) {
                const int o = st * 64;
                const float cr0 = pC0[o], cr1 = pC0[1024 + o], ci0 = pC0[2048 + o], ci1 = pC0[3072 + o];
                const float b0 = pB0[half * 2048 + o], b1 = pB0[half * 2048 + 1024 + o];
#pragma unroll
                for (int i = 0; i < 5; ++i) {
                    const bool d = ks[i] < 0; const float ar = pA[i][st * 8], ai = pA[i][st * 8 + 1];
                    const float cr = d ? cr1 : cr0, ci = d ? ci1 : ci0;
                    const float av = half == 0 ? (cr * ar - ci * ai) : -(cr * ai + ci * ar);
                    accs[i] = __builtin_amdgcn_mfma_f32_16x16x4f32(av, d ? b1 : b0, accs[i], 0, 0, 0);
                }
            }
        }
#pragma unroll
        for (int i = 0; i < 5; ++i) if (val[i] && ks[i] == 0) {
#pragma unroll
            for (int half = 0; half < 2; ++half) {
#pragma unroll 4
                for (int st = 0; st < 16; ++st) {
                    const int o = st * 64;
                    const float av = half == 0 ? pC0[1024 + o] : -pC0[3072 + o];
                    accs[i] = __builtin_amdgcn_mfma_f32_16x16x4f32(av, pB0[half * 2048 + 1024 + o], accs[i], 0, 0, 0);
                }
            }
        }
#pragma unroll
        for (int i = 0; i < 5; ++i) if (val[i]) { const int kk = ks[i] + 31;
#pragma unroll
            for (int r = 0; r < 4; ++r) { const int p = 4 * l4 + r;
                Tt[(p * 63 + kk) * 16 + l15] = accs[i][r] + ((ks[i] == 0 && l15 == p) ? a.in[I_DSKIP][layer * 512 + 16 * g + p] : 0.f); } }
      }
    }
    __syncthreads();
    RGN(12, 1); RGN(13, 0);
    const int no_cnt = 512 / nparts, no_lo = no_cnt * part, we_lo = (256 * 64 / nparts) * part, we_hi = we_lo + 256 * 64 / nparts;
    for (int idx = tid; idx < no_cnt * 64; idx += 512) {
        const int nout = no_lo + (idx >> 6), kv = idx & 63, kin0 = kv * 8, s = kv >> 1, q0 = (kv & 1) * 8, j = nout >> 4, p = nout & 15, kk = j - s + 31;
        const f32x4 t0 = *(const f32x4*)(Tt + (p * 63 + kk) * 16 + q0), t1 = *(const f32x4*)(Tt + (p * 63 + kk) * 16 + q0 + 4);
        u32x4 o; o.x = pk2(t0[0], t0[1]); o.y = pk2(t0[2], t0[3]); o.z = pk2(t1[0], t1[1]); o.w = pk2(t1[2], t1[3]);
        *(u32x4*)(WY + (size_t)nout * KCAT + kin0) = o;
    }
    for (int idx = tid; idx < no_cnt * 32; idx += 512) {
        const int nout = no_lo + (idx >> 5), cv = idx & 31, dir = cv >> 4, reim = (cv >> 3) & 1, n0 = (cv & 7) * 8, j = nout >> 4, p = nout & 15, e = dir == 0 ? j + 1 : 32 - j;
        const f32x4* ap = (const f32x4*)(Apow + ((dir * 33 + e) * 64 + n0) * 2);
        f32x4 a4[4];
#pragma unroll
        for (int i = 0; i < 4; ++i) a4[i] = ap[i];
        float v[8];
#pragma unroll
        for (int i = 0; i < 8; ++i) { const int n = n0 + i; const float cr = Cre[(dir * 64 + n) * 16 + p], ci = Cim[(dir * 64 + n) * 16 + p];
            const float ar = a4[i >> 1][(i & 1) * 2], ai = a4[i >> 1][(i & 1) * 2 + 1];
            v[i] = reim == 0 ? (cr * ar - ci * ai) : -(cr * ai + ci * ar); }
        u32x4 o; o.x = pk2(v[0], v[1]); o.y = pk2(v[2], v[3]); o.z = pk2(v[4], v[5]); o.w = pk2(v[6], v[7]);
        *(u32x4*)(WY + (size_t)nout * KCAT + 512 + cv * 8) = o;
    }
    for (int it = we_lo + tid; it < we_hi; it += 512) {
        const int comp = it >> 6, kin0 = (it & 63) * 8, j = kin0 >> 4, q0 = kin0 & 15, dir = comp >> 7, reim = (comp >> 6) & 1, n = comp & 63, e = dir == 0 ? 31 - j : j;
        const float ar = Apow[((dir * 33 + e) * 64 + n) * 2 + 0], ai = Apow[((dir * 33 + e) * 64 + n) * 2 + 1];
        float v[8];
#pragma unroll
        for (int i = 0; i < 8; ++i) { const float br = Bre[(dir * 64 + n) * 16 + q0 + i], bi = Bim[(dir * 64 + n) * 16 + q0 + i]; v[i] = reim == 0 ? (ar * br - ai * bi) : (ar * bi + ai * br); }
        u32x4 o; o.x = pk2(v[0], v[1]); o.y = pk2(v[2], v[3]); o.z = pk2(v[4], v[5]); o.w = pk2(v[6], v[7]);
        *(u32x4*)(WE + (size_t)comp * 512 + kin0) = o;
    }
    __syncthreads();
    RGN(13, 1);
}
__device__ __forceinline__ void cvt_fp8_layer(const Ctx& c, const Args& a, int layer, int widx, int nw, int q_lo = 0, int q_hi = 2 * 16384) {
    constexpr int NR = 8;
    for (int r0 = q_lo + widx; r0 < q_hi; r0 += NR * nw) {
      f32x4 vq[NR][4];
#pragma unroll
      for (int u = 0; u < NR; ++u) { const int q = r0 + u * nw < q_hi ? r0 + u * nw : r0; const int tab = q >> 14, rr = layer * 16384 + (q & 16383);
          const float* srcp = (tab ? a.in[I_EV] : a.in[I_EU]) + (size_t)rr * D + 16 * c.lane;
#pragma unroll
          for (int j = 0; j < 4; ++j) vq[u][j] = *(const f32x4*)(srcp + 4 * j); }
#pragma unroll
      for (int u = 0; u < NR; ++u) {
        const int q = r0 + u * nw; if (q >= q_hi) break;
        const int tab = q >> 14, rr = layer * 16384 + (q & 16383), r = tab * 32768 + rr;
        f32x4 v[4]; float mx = 0.f;
#pragma unroll
        for (int j = 0; j < 4; ++j) { v[j] = vq[u][j]; mx = fmaxf(mx, fmaxf(fmaxf(fabsf(v[j][0]), fabsf(v[j][1])), fmaxf(fabsf(v[j][2]), fabsf(v[j][3])))); }
        mx = wave_max(mx);
        const float sc = mx > 0.f ? 448.f / mx : 1.f;
        u32x4 o;
#pragma unroll
        for (int j = 0; j < 4; ++j) { int w = 0;
            w = __builtin_amdgcn_cvt_pk_fp8_f32(fminf(fmaxf(v[j][0] * sc, -448.f), 448.f), fminf(fmaxf(v[j][1] * sc, -448.f), 448.f), w, false);
            w = __builtin_amdgcn_cvt_pk_fp8_f32(fminf(fmaxf(v[j][2] * sc, -448.f), 448.f), fminf(fmaxf(v[j][3] * sc, -448.f), 448.f), w, true);
            o[j] = (unsigned)w; }
        *(u32x4*)(a.ws + (tab ? WS_EV : WS_EU) + (size_t)rr * D + 16 * c.lane) = o;
        if (c.lane == 0) ((float*)(a.ws + WS_ESC))[r] = mx > 0.f ? mx * (1.f / 448.f) : 1.f;
      }
    }
}
__device__ __forceinline__ void p0_prologue(const Ctx& c, const Args& a) {
    unsigned char* rgn_ws = a.ws; (void)rgn_ws; RGN(4, 0);
    const bool ssm_first = (c.blk & 1) == 0;
#define P0_SSM() do { const int np = c.nblk >= 256 ? 4 : 1;     \
      for (int u = c.blk; u < 2 * NG * np; u += c.nblk) ssm_tables_unit(c, a, (u / np) / NG, (u / np) % NG, u % np, np); } while (0)
    if (ssm_first) P0_SSM();
    RGN(4, 1); RGN(5, 0);
    const int gw = c.blk * 8 + c.wave, NGW = c.nblk * 8;
    {
        constexpr int I0 = 80, I1 = 16, I2 = 64, I3 = 128, I4 = 64, I5 = 16, IL = I0 + I1 + I2 + I3 + I4 + I5;
        __syncthreads();
        auto titem = [&](int it) { TItem t; const int L = it / IL; int r = it % IL; unsigned char* lw = a.ws + WS_LW + (size_t)L * LW_STRIDE;
            if (r < I0) { t.W = a.in[I_WIN] + (size_t)L * D * DIN; t.K = D; t.N = DIN; t.WT = (bf16_t*)(lw + LW_WIN); t.gain = a.in[I_NMIXG] + L * D; t.item = r; return t; } r -= I0;
            if (r < I1) { t.W = a.in[I_WGLU] + (size_t)L * 512 * 512; t.K = 512; t.N = 512; t.WT = (bf16_t*)(lw + LW_WGLU); t.gain = nullptr; t.item = r; return t; } r -= I1;
            if (r < I2) { const int k0 = 64 * (r / 4); t.W = a.in[I_WOUT] + (size_t)L * D * D; t.K = D; t.N = D; t.WT = (bf16_t*)(lw + LW_WOUT); t.gain = k0 < 512 ? a.in[I_SSMG] + L * 512 : a.in[I_ATTG] + L * 512 - 512; t.item = r; return t; } r -= I2;
            if (r < I3) { t.W = a.in[I_WQ] + (size_t)L * D * 2048; t.K = D; t.N = 2048; t.WT = (bf16_t*)(lw + LW_WQ); t.gain = a.in[I_NFFNG] + L * D; t.item = r; return t; } r -= I3;
            if (r < I4) { t.W = a.in[I_WGATE] + (size_t)L * D * D; t.K = D; t.N = D; t.WT = (bf16_t*)(lw + LW_WGATE); t.gain = a.in[I_NPLEG] + L * D; t.item = r; return t; } r -= I4;
            t.W = a.in[I_WPROJ] + (size_t)L * 256 * D; t.K = 256; t.N = D; t.WT = (bf16_t*)(lw + LW_WPROJ); t.gain = nullptr; t.item = r; return t; };
        int it = c.blk;
        if (it < 2 * IL) {
            TItem cur = titem(it); f32x4 v[8]; tw_load(c, cur, v);
            for (;;) {
                tw_lds_write(c, cur, v);
                const int itn = it + c.nblk; const bool more = itn < 2 * IL; TItem nxt = cur;
                if (more) { nxt = titem(itn); tw_load(c, nxt, v); }
                __syncthreads(); tw_store(c, cur); __syncthreads();
                if (!more) break;
                cur = nxt; it = itn;
            }
        }
    }
    RGN(5, 1); RGN(6, 0);
    if (c.nblk != 256) { cvt_fp8_layer(c, a, 0, gw, NGW); cvt_fp8_layer(c, a, 1, gw, NGW); }
    RGN(6, 1); RGN(7, 0);
    cvt_range(c, a.in[I_P], (bf16_t*)(a.ws + WS_PB), (size_t)2 * M * 256);
    for (int L = 0; L < 2; ++L) {
        cvt_range(c, a.in[I_SK1] + (size_t)L * 8 * 128 * 128, (bf16_t*)(a.ws + WS_LW + (size_t)L * LW_STRIDE + LW_SK1), (size_t)8 * 128 * 128);
        cvt_range(c, a.in[I_SK2] + (size_t)L * 8 * 128 * 128, (bf16_t*)(a.ws + WS_LW + (size_t)L * LW_STRIDE + LW_SK2), (size_t)8 * 128 * 128);
    }
    RGN(7, 1); RGN(8, 0);
    {
        bf16_t* XB = (bf16_t*)(a.ws + WS_XB); float* SSQ0 = (float*)(a.ws + WS_SSQ0);
        for (int m0 = gw; m0 < M; m0 += 4 * NGW) {
            f32x4 v[4][4];
#pragma unroll
            for (int u = 0; u < 4; ++u) { const int m = m0 + u * NGW < M ? m0 + u * NGW : m0; const f32x4* xr = (const f32x4*)(a.in[I_X] + (size_t)m * D) + c.lane;
#pragma unroll
                for (int j = 0; j < 4; ++j) v[u][j] = xr[64 * j]; }
#pragma unroll
            for (int u = 0; u < 4; ++u) { const int m = m0 + u * NGW; if (m >= M) break; float s = 0.f;
#pragma unroll
                for (int j = 0; j < 4; ++j) { const f32x4 w = v[u][j]; const u32x2 o = pack4(w); *(u32x2*)(XB + (size_t)m * D + 256 * j + 4 * c.lane) = o;
                    const float y0 = bflo(o.x), y1 = bfhi(o.x), y2 = bflo(o.y), y3 = bfhi(o.y); s += y0 * y0 + y1 * y1 + y2 * y2 + y3 * y3; }
                s = wave_sum(s);
                if (c.lane < 16) SSQ0[(size_t)m * 16 + c.lane] = c.lane == 0 ? s : 0.f; }
        }
    }
    RGN(8, 1);
    if (!ssm_first) P0_SSM();
#undef P0_SSM
    if (c.blk == c.nblk - 1) {
        float* R = (float*)(a.ws + WS_ROPE);
        for (int e = c.tid; e < 3072; e += 512) {
            const bool isr = e < 2048; const int pos = isr ? (e >> 4) : ((e - 2048) >> 4), f = e & 15;
            const float inv = powf(10000.f, -(float)f / 16.f), ang = (float)pos * inv; float sn, cs; sincosf(ang, &sn, &cs);
            if (isr) { R[e] = cs; R[2048 + e] = sn; } else { R[4096 + (e - 2048)] = cs; R[5120 + (e - 2048)] = sn; }
        }
    }
}

__device__ __forceinline__ void s1_unit(const Ctx& c, const Args& a, int layer, int gb  ) {
    unsigned char* lw = a.ws + WS_LW + (size_t)layer * LW_STRIDE;
    bf16_t* UC = (bf16_t*)(a.ws + WS_UCAT); float* EB = (float*)(a.ws + WS_EBUF);
    const int g = gb >> 1;
    GemmD gd; gd.A = UC; gd.lda = KCAT; gd.Bt = (const bf16_t*)(lw + LW_WE); gd.ldb = 512; gd.K = 512; gd.kmid = -1;
    EpiS1 E; E.ebuf = EB;
    Unit u; u.pm = gb; u.pn = g;
    unsigned char* rgn_ws = a.ws; (void)rgn_ws; if (layer == 0) RGN(1, 0);
#ifdef USE_SGEMM
    sgemm_unit(gd, u, E, c.wave, c.lane);
#else
    { pg8::OneUnit S; S.u = u; run_gemm(c.lds, gd, S, E, c.tid); }
#endif
    VM_WAIT(); __syncthreads();
    if (layer == 0) { RGN(1, 1); RGN(2, 0); }
    {
        const float* AL = (const float*)(lw + LW_AL);
        f32x4* Es4 = (f32x4*)c.lds; const float* Es = (const float*)c.lds;
        float* SEG = (float*)(c.lds + LDSCTL_OFF + 1024);
        const int n = c.lane, sg = c.wave;
        for (int dir = 0; dir < 2; ++dir) {
            {
#pragma unroll 1
                for (int k0 = 0; k0 < 16; k0 += 8) { f32x4 ev[8];
#pragma unroll
                    for (int k = 0; k < 8; ++k) { const int i = c.tid + 512 * (k0 + k), ch = i >> 5, q4 = i & 31; ev[k] = *(const f32x4*)(EB + ((size_t)gb * NCH + ch) * 256 + dir * 128 + q4 * 4); }
#pragma unroll
                    for (int k = 0; k < 8; ++k) Es4[c.tid + 512 * (k0 + k)] = ev[k]; }
            }
            __syncthreads();
            const float alr = AL[((dir * NG + g) * 64 + n) * 2 + 0], ali = AL[((dir * NG + g) * 64 + n) * 2 + 1];
            float hr = 0.f, hi = 0.f, pr = 1.f, pi = 0.f;
#pragma unroll 8
            for (int s = 0; s < 32; ++s) {
                const int st = sg * 32 + s, ch = dir == 0 ? st : NCH - 1 - st;
                const float er = Es[ch * 128 + n], ei = Es[ch * 128 + 64 + n];
                const float nr = alr * hr - ali * hi + er, ni = alr * hi + ali * hr + ei; hr = nr; hi = ni;
                const float qr = pr * alr - pi * ali, qi = pr * ali + pi * alr; pr = qr; pi = qi;
            }
            SEG[(sg * 64 + n) * 2] = hr; SEG[(sg * 64 + n) * 2 + 1] = hi;
            __syncthreads();
            float sr = 0.f, si = 0.f;
            for (int j = 0; j < sg; ++j) { const float er = SEG[(j * 64 + n) * 2], ei = SEG[(j * 64 + n) * 2 + 1];
                const float nr = pr * sr - pi * si + er, ni = pr * si + pi * sr + ei; sr = nr; si = ni; }
            hr = sr; hi = si;
            bf16_t* hc = UC + (size_t)gb * NCH * KCAT + 512 + dir * 128 + n;
#pragma unroll 8
            for (int s = 0; s < 32; ++s) {
                const int st = sg * 32 + s, ch = dir == 0 ? st : NCH - 1 - st;
                hc[(size_t)ch * KCAT] = (bf16_t)f2bf(hr); hc[(size_t)ch * KCAT + 64] = (bf16_t)f2bf(hi);
                const float er = Es[ch * 128 + n], ei = Es[ch * 128 + 64 + n];
                const float nr = alr * hr - ali * hi + er, ni = alr * hi + ali * hr + ei; hr = nr; hi = ni;
            }
            __syncthreads();
        }
    }
    if (layer == 0) RGN(2, 1);
}
constexpr int QKP_N = 8;
__device__ __forceinline__ void qkprep(const Ctx& c, const Args& a, int layer, int widx, int nw, int mode = 0, int tok0 = 0) {
    bf16_t* QR = (bf16_t*)(a.ws + WS_QRAW); bf16_t* KV = (bf16_t*)(a.ws + WS_KV); const float* R = (const float*)(a.ws + WS_ROPE);
    const int half = c.lane >> 5, i = c.lane & 31, f = i & 15;
    const int d = i < 16 ? i : 32 + (i - 16);
    unsigned char* rgn_ws = a.ws; (void)rgn_ws; if (layer == 0) RGN(3, 0);
    const float gq1 = a.in[I_QNG][layer * 64 + d], gq2 = a.in[I_QNG][layer * 64 + d + 16], gk1 = a.in[I_KNG][layer * 64 + d], gk2 = a.in[I_KNG][layer * 64 + d + 16];
    const int nitems = mode == 0 ? M * 5 : mode == 1 ? M * 4 : 256;
    for (int base = widx; base < nitems; base += QKP_N * nw) {
        bf16_t* p[QKP_N]; float x1[QKP_N], x2[QKP_N], cs[QKP_N], sn[QKP_N]; int hh[QKP_N]; bool ok[QKP_N];
#pragma unroll
        for (int u = 0; u < QKP_N; ++u) {
            int it = base + u * nw; ok[u] = it < nitems; if (!ok[u]) it = base;
            const int m = mode == 0 ? it / 5 : mode == 1 ? it >> 2 : tok0 + it; hh[u] = (mode == 0 ? it % 5 : mode == 1 ? (it & 3) : 4) * 2 + half;
            p[u] = hh[u] < 8 ? QR + (size_t)m * 512 + hh[u] * 64 : KV + (size_t)m * 256 + (hh[u] - 8) * 64;
            x1[u] = bf1(p[u][d]); x2[u] = bf1(p[u][d + 16]);
            const int s = m & (SEQ - 1);
            if (i < 16) { const int pos = s >> 6; cs[u] = R[pos * 16 + f]; sn[u] = R[2048 + pos * 16 + f]; }
            else { const int pos = s & 63; cs[u] = R[4096 + pos * 16 + f]; sn[u] = R[5120 + pos * 16 + f]; }
        }
#pragma unroll
        for (int u = 0; u < QKP_N; ++u) {
            float ss = x1[u] * x1[u] + x2[u] * x2[u];
#pragma unroll
            for (int o = 1; o < 32; o <<= 1) ss += __shfl_xor(ss, o);
            const float rstd = rsqrtf(ss * (1.f / 64.f) + EPS);
            const float y1 = x1[u] * rstd * (hh[u] < 8 ? gq1 : gk1), y2 = x2[u] * rstd * (hh[u] < 8 ? gq2 : gk2);
            float o1 = y1 * cs[u] - y2 * sn[u], o2 = y2 * cs[u] + y1 * sn[u];
            if (hh[u] < 8) { o1 *= C2; o2 *= C2; }
            if (ok[u]) { p[u][d] = (bf16_t)f2bf(o1); p[u][d + 16] = (bf16_t)f2bf(o2); }
        }
    }
    if (layer == 0) RGN(3, 1);
}

template <bool QMODE>
__device__ __forceinline__ void qkprep_rows(const Ctx& c, const Args& a, int layer, int widx, int nw, int nitems, int tok0) {
    bf16_t* QR = (bf16_t*)(a.ws + WS_QRAW); bf16_t* KV = (bf16_t*)(a.ws + WS_KV); const float* R = (const float*)(a.ws + WS_ROPE);
    const int l = c.lane, c8 = l & 7, d0 = 8 * c8, f0 = d0 & 15; const bool first = (c8 & 2) == 0, rowtab = c8 < 4;
    float g8[8];
    { const float* gp = (QMODE ? a.in[I_QNG] : a.in[I_KNG]) + layer * 64 + d0; const f32x4 ga = *(const f32x4*)gp, gb = *(const f32x4*)(gp + 4);
#pragma unroll
      for (int e = 0; e < 4; ++e) { g8[e] = ga[e] * (QMODE ? C2 : 1.f); g8[4 + e] = gb[e] * (QMODE ? C2 : 1.f); } }
    constexpr int NI = 4;
    for (int base = widx; base < nitems; base += NI * nw) {
        u32x4 xw[NI]; f32x4 cs0[NI], cs1[NI], sn0[NI], sn1[NI]; bf16_t* pp[NI];
#pragma unroll
        for (int u = 0; u < NI; ++u) {
            const int it = base + u * nw < nitems ? base + u * nw : base;
            const int m = QMODE ? it : tok0 + it * 4 + (l >> 4);
            pp[u] = QMODE ? QR + (size_t)m * 512 + (l >> 3) * 64 + d0 : KV + (size_t)m * 256 + ((l >> 3) & 1) * 64 + d0;
            xw[u] = *(const u32x4*)pp[u];
            const int s = m & (SEQ - 1); const float* rc = R + (rowtab ? (s >> 6) * 16 : 4096 + (s & 63) * 16) + f0; const float* rs = rc + (rowtab ? 2048 : 1024);
            cs0[u] = *(const f32x4*)rc; cs1[u] = *(const f32x4*)(rc + 4); sn0[u] = *(const f32x4*)rs; sn1[u] = *(const f32x4*)(rs + 4);
        }
#pragma unroll
        for (int u = 0; u < NI; ++u) {
            f32x4 x0, x1; unpack8(xw[u], x0, x1);
            float ss = (x0[0] * x0[0] + x0[1] * x0[1] + x0[2] * x0[2] + x0[3] * x0[3]) + (x1[0] * x1[0] + x1[1] * x1[1] + x1[2] * x1[2] + x1[3] * x1[3]);
#define QK_DPPADD(v, ctrl) v += __uint_as_float(__builtin_amdgcn_update_dpp(0u, __float_as_uint(v), ctrl, 0xf, 0xf, true))
            QK_DPPADD(ss, 0xB1); QK_DPPADD(ss, 0x4E); QK_DPPADD(ss, 0x141);
#undef QK_DPPADD
            const float rstd = rsqrtf(ss * (1.f / 64.f) + EPS);
            float y[8], o[8];
#pragma unroll
            for (int e = 0; e < 4; ++e) { y[e] = x0[e] * rstd * g8[e]; y[4 + e] = x1[e] * rstd * g8[4 + e]; }
#pragma unroll
            for (int e = 0; e < 8; ++e) { const float yp = __uint_as_float(__builtin_amdgcn_update_dpp(0u, __float_as_uint(y[e]), 0x4E, 0xf, 0xf, true));
                const float cse = e < 4 ? cs0[u][e] : cs1[u][e - 4], sne = e < 4 ? sn0[u][e] : sn1[u][e - 4];
                o[e] = first ? y[e] * cse - yp * sne : y[e] * cse + yp * sne; }
            if (base + u * nw < nitems) { u32x4 ow; ow.x = pk2(o[0], o[1]); ow.y = pk2(o[2], o[3]); ow.z = pk2(o[4], o[5]); ow.w = pk2(o[6], o[7]); *(u32x4*)pp[u] = ow; }
        }
    }
}
#include <hip/hip_bf16.h>
#include <cmath>
namespace attn_body {
using bf16=__hip_bfloat16;
using bf16x8=__attribute__((ext_vector_type(8)))short;
using s16x4=__attribute__((ext_vector_type(4)))short;
using f32x16=__attribute__((ext_vector_type(16)))float;
using u32x4=__attribute__((ext_vector_type(4)))unsigned;
constexpr int SEQ=8192,D=64,QPITCH=512,KVPITCH=256,OPITCH=1024;
constexpr int NW=8,QBLK=32,QB=QBLK*NW,KVBLK=64,NQB=SEQ/QB;
__device__ __forceinline__ int crow(int r,int hi){return (r&3)+8*(r>>2)+4*hi;}
#define SBAR() __builtin_amdgcn_sched_barrier(0)
__device__ __forceinline__ void cmask(f32x16&p0,f32x16&p1,int jb,int qrel,int hi){
  const float NEG=-INFINITY; int kb=64*jb+4*hi;
  #pragma unroll
  for(int r=0;r<16;++r){int kv=kb+(r&3)+8*(r>>2); if(kv>qrel)p0[r]=NEG; if(kv+32>qrel)p1[r]=NEG;}
}

constexpr int NSLOT=3, SLOTB=8192;
constexpr int LDS_K=0, LDS_V=NSLOT*SLOTB, LDS_WS=2*NSLOT*SLOTB, LDS_OST=LDS_WS+NW*64*4, LDS_BYTES=LDS_OST+NW*4096;
constexpr float C2=0.125f*1.4426950408889634f;
__device__ __forceinline__ void glds16(const void*gsrc,unsigned lds_dst){unsigned keep;
  asm volatile("s_mov_b32 %0, m0\n\ts_mov_b32 m0, %2\n\ts_nop 0\n\tglobal_load_lds_dwordx4 %1, off\n\ts_mov_b32 m0, %0":"=&s"(keep):"v"(gsrc),"s"(lds_dst):"memory");}
__device__ __forceinline__ float max3f(float a,float b,float c){float r;asm("v_max3_f32 %0, %1, %2, %3":"=v"(r):"v"(a),"v"(b),"v"(c));return r;}
__device__ __forceinline__ float max2f(float a,float b){float r;asm("v_max_f32_e32 %0, %1, %2":"=v"(r):"v"(a),"v"(b));return r;}
__device__ __forceinline__ float fadd_s(float a,float b){float r;asm("v_add_f32_e32 %0, %1, %2":"=v"(r):"v"(a),"v"(b));return r;}
__device__ __forceinline__ float fsub_s(float a,float b){float r;asm("v_sub_f32_e32 %0, %1, %2":"=v"(r):"v"(a),"v"(b));return r;}
typedef float f32x2_t __attribute__((ext_vector_type(2))); typedef __bf16 bf16x2_t __attribute__((ext_vector_type(2)));
__device__ __forceinline__ unsigned cvtpk_s(float lo,float hi){f32x2_t v={lo,hi};bf16x2_t b=__builtin_convertvector(v,bf16x2_t);return __builtin_bit_cast(unsigned,b);}
#define WAIT_BAR(N) asm volatile("s_waitcnt vmcnt(" #N ") lgkmcnt(0)\n\ts_barrier":::"memory")

__device__ __forceinline__ void qkt(f32x16&p0,f32x16&p1,const char*Kslot,const bf16x8*qr,const f32x16&negm,int r32,int hi){
  const char*kb=Kslot+hi*1024+r32*16;
  #pragma unroll
  for(int d0=0;d0<4;++d0){
    const bf16x8 b0=*reinterpret_cast<const bf16x8*>(kb+d0*2048);
    const bf16x8 b1=*reinterpret_cast<const bf16x8*>(kb+d0*2048+512);
    if(d0==0){p0=__builtin_amdgcn_mfma_f32_32x32x16_bf16(b0,qr[0],negm,0,0,0);p1=__builtin_amdgcn_mfma_f32_32x32x16_bf16(b1,qr[0],negm,0,0,0);}
    else{p0=__builtin_amdgcn_mfma_f32_32x32x16_bf16(b0,qr[d0],p0,0,0,0);p1=__builtin_amdgcn_mfma_f32_32x32x16_bf16(b1,qr[d0],p1,0,0,0);}}
}
typedef __attribute__((address_space(3))) const char* lds_cptr;
typedef short v4i16_t __attribute__((ext_vector_type(4)));
__device__ __forceinline__ void kload8(bf16x8*kf,lds_cptr kp){
  kf[0]=*(const __attribute__((address_space(3))) bf16x8*)(kp);      kf[1]=*(const __attribute__((address_space(3))) bf16x8*)(kp+512);
  kf[2]=*(const __attribute__((address_space(3))) bf16x8*)(kp+2048); kf[3]=*(const __attribute__((address_space(3))) bf16x8*)(kp+2560);
  kf[4]=*(const __attribute__((address_space(3))) bf16x8*)(kp+4096); kf[5]=*(const __attribute__((address_space(3))) bf16x8*)(kp+4608);
  kf[6]=*(const __attribute__((address_space(3))) bf16x8*)(kp+6144); kf[7]=*(const __attribute__((address_space(3))) bf16x8*)(kp+6656);
}
__device__ __forceinline__ void kload2(bf16x8*kf,lds_cptr kp,int j){ kf[2*j]=*(const __attribute__((address_space(3))) bf16x8*)(kp+j*2048); kf[2*j+1]=*(const __attribute__((address_space(3))) bf16x8*)(kp+j*2048+512); }
__device__ __forceinline__ s16x4 vtr(lds_cptr p){ return __builtin_bit_cast(s16x4,__builtin_amdgcn_ds_read_tr16_b64_v4i16((__attribute__((address_space(3))) v4i16_t*)p)); }
__device__ __forceinline__ float rowmax(const f32x16&p0,const f32x16&p1){
  float a=max3f(p0[0],p0[1],p1[0]),b=max3f(p0[2],p0[3],p1[1]);a=max3f(a,p1[2],p1[3]);
  #pragma unroll
  for(int r=4;r<16;r+=4){a=max3f(a,p0[r],p0[r+1]);b=max3f(b,p0[r+2],p0[r+3]);a=max3f(a,p1[r],p1[r+1]);b=max3f(b,p1[r+2],p1[r+3]);}
  const float m=max2f(a,b);
  auto rr=__builtin_amdgcn_permlane32_swap(__float_as_uint(m),__float_as_uint(m),false,false);
  return max2f(__uint_as_float(rr[0]),__uint_as_float(rr[1]));
}
__device__ __forceinline__ void pv(f32x16*o,int vb,bf16x8 pa0,bf16x8 pa1,bf16x8 pa2,bf16x8 pa3){
  #pragma unroll
  for(int d0=0;d0<2;++d0){s16x4 lo[4],hi[4];
    #pragma unroll
    for(int ks=0;ks<4;++ks){
      asm volatile("ds_read_b64_tr_b16 %0,%1 offset:%c2":"=&v"(lo[ks]):"v"(vb),"i"(d0*4096+ks*1024):"memory");
      asm volatile("ds_read_b64_tr_b16 %0,%1 offset:%c2":"=&v"(hi[ks]):"v"(vb),"i"(d0*4096+ks*1024+512):"memory");}
    asm volatile("s_waitcnt lgkmcnt(0)":::"memory");SBAR();
    #define PK(k) (bf16x8){lo[k][0],lo[k][1],lo[k][2],lo[k][3],hi[k][0],hi[k][1],hi[k][2],hi[k][3]}
    o[d0]=__builtin_amdgcn_mfma_f32_32x32x16_bf16(pa0,PK(0),o[d0],0,0,0);
    o[d0]=__builtin_amdgcn_mfma_f32_32x32x16_bf16(pa1,PK(1),o[d0],0,0,0);
    o[d0]=__builtin_amdgcn_mfma_f32_32x32x16_bf16(pa2,PK(2),o[d0],0,0,0);
    o[d0]=__builtin_amdgcn_mfma_f32_32x32x16_bf16(pa3,PK(3),o[d0],0,0,0);
    #undef PK
  }
}

#ifndef ATTN_STORE16
#define ATTN_STORE16(p,v) (*(u32x4*)(p)=(v))
#endif
template<int THRL> __device__ __forceinline__ void attn_unit(int b,int h,int qb,const bf16*Q,const bf16*KV,bf16*O,float*SSQA,char*shm,const int tid,const float mfix){
  const int lane=tid&63,r32=lane&31,hi=lane>>5; const int wid=__builtin_amdgcn_readfirstlane(tid>>6);
  const long rowbase=(long)b*SEQ; const int q0=qb*QB;
  const bf16*Qw=Q+(rowbase+q0+wid*QBLK)*QPITCH+h*D;
  const bf16*Kh=KV+rowbase*KVPITCH+(h>>2)*D,*Vh=Kh+128;
  const unsigned lds0=(unsigned)(uintptr_t)shm;
  float*wsf=(float*)(shm+LDS_WS)+wid*64;
  const bf16*ksrc=Kh+(long)lane*KVPITCH+wid*8;
  const bf16*vsrc=Vh+(long)(16*(wid&3)+(lane>>2))*KVPITCH+(wid>>2)*32+(lane&3)*8;
  const unsigned kdst=lds0+LDS_K+wid*1024, vdst=lds0+LDS_V+wid*1024;
  #define DMA_K(t,slot) glds16(ksrc+(long)(t)*KVBLK*KVPITCH,(unsigned)__builtin_amdgcn_readfirstlane(kdst+(slot)))
  #define DMA_V(t,slot) glds16(vsrc+(long)(t)*KVBLK*KVPITCH,(unsigned)__builtin_amdgcn_readfirstlane(vdst+(slot)))
  const int vb0=(int)(lds0+LDS_V)+((lane>>4)&1)*32+(lane&3)*8+(4*hi+((lane&15)>>2))*64;
  const char*Kbase=shm+LDS_K; bf16x8 kf[8];
  const lds_cptr shm3=(lds_cptr)shm; const lds_cptr kp0=shm3+LDS_K+hi*1024+r32*16; const lds_cptr vp0=shm3+LDS_V+((lane>>4)&1)*32+(lane&3)*8+(4*hi+((lane&15)>>2))*64;
  const int NT=SEQ/KVBLK;
  DMA_K(0,0);DMA_V(0,0);DMA_K(1,SLOTB);
  bf16x8 qr[4];
  #pragma unroll
  for(int d0=0;d0<4;++d0)qr[d0]=*reinterpret_cast<const bf16x8*>(&Qw[(long)r32*QPITCH+d0*16+hi*8]);
  float mhat=0.f,l_reg=0.f;f32x16 o[2];f32x16 negm;{float z_=0.f;asm volatile("":"+v"(z_));
  #pragma unroll
  for(int r=0;r<16;++r){o[0][r]=z_;o[1][r]=z_;negm[r]=(THRL<0)?(z_-mfix):z_;}}asm volatile("":"+v"(negm)); if(THRL<0)mhat=mfix;
  #define CMASK(P0,P1,t) do{}while(0)
  bool resc=false;
  #define START(P0,P1) do{ resc=false; \
    if constexpr(THRL>=0){ const float rm=rowmax(P0,P1); const float dl=rm; mhat=fadd_s(mhat,dl); \
      _Pragma("unroll") for(int r=0;r<16;++r){P0[r]=fsub_s(P0[r],dl);P1[r]=fsub_s(P1[r],dl);} \
      _Pragma("unroll") for(int r=0;r<16;++r)negm[r]=-mhat; asm volatile("":"+v"(negm)); } \
    _Pragma("unroll") for(int r=0;r<16;++r)P0[r]=__builtin_amdgcn_exp2f(P0[r]); }while(0)
  #define RESC() do{ if(resc){ asm volatile("s_waitcnt lgkmcnt(0)":::"memory"); \
      _Pragma("unroll") for(int d_=0;d_<2;++d_) _Pragma("unroll") for(int r=0;r<16;++r)o[d_][r]*=wsf[crow(r,hi)]; } }while(0)
  f32x16 pA0,pA1,pB0,pB1;
  int sl_prev=0,sl_cur=0,sl_next=SLOTB;
  #define ROT() do{sl_prev=sl_cur;sl_cur=sl_next;sl_next=(sl_next==(NSLOT-1)*SLOTB)?0:sl_next+SLOTB;}while(0)
  DMA_K(2,2*SLOTB);
  WAIT_BAR(3);
  qkt(pA0,pA1,Kbase,qr,negm,r32,hi);asm volatile("s_nop 15\n\ts_nop 7":"+v"(pA0),"+v"(pA1));CMASK(pA0,pA1,0);
  START(pA0,pA1);
  _Pragma("unroll") for(int r=0;r<16;++r)pA1[r]=__builtin_amdgcn_exp2f(pA1[r]);
  WAIT_BAR(0);
  DMA_K(3,0);DMA_V(1,SLOTB);
  ROT();
  kload8(kf,kp0+sl_cur);
  WAIT_BAR(2);
  s16x4 vlo[8],vhi[8]; u32x4 pw0,pw1,pw2,pw3;
  #define PKW(P,B) cvtpk_s(P[B],P[B+1])
  #define PAF(k) __builtin_bit_cast(bf16x8,pw##k)
  #define VFR(i) (bf16x8){vlo[i][0],vlo[i][1],vlo[i][2],vlo[i][3],vhi[i][0],vhi[i][1],vhi[i][2],vhi[i][3]}
  #define PIN(x) asm volatile("":"+v"(x))
  #define MX3(a,b,c) __builtin_fmaxf(__builtin_fmaxf((a),(b)),(c))
  #define GAPA(MF,A0,A1,A2,A3,W0,W1,PW) do{ MF; sacc+=A0; sacc+=A1; sacc+=A2; sacc+=A3; PIN(sacc); W0; W1; PIN(PW); SBAR(); }while(0)
  #define EX(v) __builtin_amdgcn_exp2f(v)
  #define GAPB(MF,X,B) do{ MF; X[B]=EX(X[B]); X[B+1]=EX(X[B+1]); X[B+2]=EX(X[B+2]); X[B+3]=EX(X[B+3]); PIN(X); SBAR(); }while(0)
  #define VRD(i) do{ vlo[i]=vtr(vp_+(((i)>>2)*4096+((i)&3)*1024)); vhi[i]=vtr(vp_+(((i)>>2)*4096+((i)&3)*1024+512)); }while(0)
  #define KRD(G,j) do{ if(G){ kload2(kf,kp0+sl_next,j); SBAR(); } }while(0)
  #define STEP(C0,C1,P0,P1,t,GK,GV,GL) do{ SBAR(); \
    const lds_cptr vp_=vp0+sl_prev; \
    VRD(0); SBAR(); float sacc=(P0[0]+P0[1]); \
    GAPA(C0=__builtin_amdgcn_mfma_f32_32x32x16_bf16(kf[0],qr[0],negm,0,0,0), P0[2],P0[3],P0[4],P0[5],     pw0[0]=PKW(P0,0), pw0[1]=PKW(P0,2), pw0); \
    VRD(4); SBAR(); GAPA(C1=__builtin_amdgcn_mfma_f32_32x32x16_bf16(kf[1],qr[0],negm,0,0,0), P0[6],P0[7],P0[8],P0[9],     pw0[2]=PKW(P0,4), pw0[3]=PKW(P0,6), pw0); \
    VRD(1); SBAR(); GAPA(C0=__builtin_amdgcn_mfma_f32_32x32x16_bf16(kf[2],qr[1],C0,0,0,0),   P0[10],P0[11],P0[12],P0[13], pw1[0]=PKW(P0,8), pw1[1]=PKW(P0,10), pw1); \
    VRD(5); SBAR(); GAPA(C1=__builtin_amdgcn_mfma_f32_32x32x16_bf16(kf[3],qr[1],C1,0,0,0),   P0[14],P0[15],P1[0],P1[1],   pw1[2]=PKW(P0,12),pw1[3]=PKW(P0,14), pw1); \
    VRD(2); SBAR(); GAPA(C0=__builtin_amdgcn_mfma_f32_32x32x16_bf16(kf[4],qr[2],C0,0,0,0),   P1[2],P1[3],P1[4],P1[5],     pw2[0]=PKW(P1,0), pw2[1]=PKW(P1,2), pw2); \
    VRD(6); SBAR(); GAPA(C1=__builtin_amdgcn_mfma_f32_32x32x16_bf16(kf[5],qr[2],C1,0,0,0),   P1[6],P1[7],P1[8],P1[9],     pw2[2]=PKW(P1,4), pw2[3]=PKW(P1,6), pw2); \
    VRD(3); SBAR(); GAPA(C0=__builtin_amdgcn_mfma_f32_32x32x16_bf16(kf[6],qr[3],C0,0,0,0),   P1[10],P1[11],P1[12],P1[13], pw3[0]=PKW(P1,8), pw3[1]=PKW(P1,10), pw3); \
    VRD(7); SBAR(); GAPA(C1=__builtin_amdgcn_mfma_f32_32x32x16_bf16(kf[7],qr[3],C1,0,0,0),   P1[14],P1[15],0.f,0.f,       pw3[2]=PKW(P1,12),pw3[3]=PKW(P1,14), pw3); \
    l_reg+=sacc; \
    if(GK){DMA_K((t)+3,sl_cur);} if(GV){DMA_V((t)+1,sl_next);} \
    CMASK(C0,C1,t); \
    if constexpr(THRL>=0){ float a=MX3(C0[0],C0[1],C1[0]),b=MX3(C0[2],C0[3],C1[1]); a=MX3(a,C1[2],C1[3]); \
      _Pragma("unroll") for(int r=4;r<16;r+=4){a=MX3(a,C0[r],C0[r+1]);b=MX3(b,C0[r+2],C0[r+3]);a=MX3(a,C1[r],C1[r+1]);b=MX3(b,C1[r+2],C1[r+3]);} \
      float rm=__builtin_fmaxf(a,b); { auto rr=__builtin_amdgcn_permlane32_swap(__float_as_uint(rm),__float_as_uint(rm),false,false); rm=__builtin_fmaxf(__uint_as_float(rr[0]),__uint_as_float(rr[1])); } \
      resc=false; \
      if(__builtin_expect(__any(rm>(float)THRL),0)){ const float dl=__builtin_fmaxf(rm,0.f); mhat+=dl; \
        _Pragma("unroll") for(int r=0;r<16;++r){C0[r]-=dl;C1[r]-=dl;} \
        _Pragma("unroll") for(int r=0;r<16;++r)negm[r]=-mhat; asm volatile("":"+v"(negm)); \
        const float f=__builtin_amdgcn_exp2f(-dl); l_reg*=f; if(hi==0)wsf[r32]=f; resc=true; } } \
    SBAR(); \
    GAPB(o[0]=__builtin_amdgcn_mfma_f32_32x32x16_bf16(PAF(0),VFR(0),o[0],0,0,0), C0,0); \
    GAPB(o[1]=__builtin_amdgcn_mfma_f32_32x32x16_bf16(PAF(0),VFR(4),o[1],0,0,0), C0,4); \
    KRD(GL,0); GAPB(o[0]=__builtin_amdgcn_mfma_f32_32x32x16_bf16(PAF(1),VFR(1),o[0],0,0,0), C0,8); \
    KRD(GL,1); GAPB(o[1]=__builtin_amdgcn_mfma_f32_32x32x16_bf16(PAF(1),VFR(5),o[1],0,0,0), C0,12); \
    KRD(GL,2); GAPB(o[0]=__builtin_amdgcn_mfma_f32_32x32x16_bf16(PAF(2),VFR(2),o[0],0,0,0), C1,0); \
    KRD(GL,3); GAPB(o[1]=__builtin_amdgcn_mfma_f32_32x32x16_bf16(PAF(2),VFR(6),o[1],0,0,0), C1,4); \
    GAPB(o[0]=__builtin_amdgcn_mfma_f32_32x32x16_bf16(PAF(3),VFR(3),o[0],0,0,0), C1,8); \
    GAPB(o[1]=__builtin_amdgcn_mfma_f32_32x32x16_bf16(PAF(3),VFR(7),o[1],0,0,0), C1,12); \
    }while(0)
  int t=1;
  #undef CMASK
  #define CMASK(P0,P1,t) do{}while(0)
  for(;t+5<NT;t+=2){
    STEP(pB0,pB1,pA0,pA1,t,true,true,true);     WAIT_BAR(2); RESC(); ROT();
    STEP(pA0,pA1,pB0,pB1,t+1,true,true,true);   WAIT_BAR(2); RESC(); ROT();
  }
  #undef CMASK
  #define CMASK(P0,P1,t) do{}while(0)
  #define ENDW(tt) do{ if((tt)+3<NT){WAIT_BAR(2);} else if((tt)+2<NT){WAIT_BAR(1);} else {WAIT_BAR(0);} }while(0)
  for(;t+1<NT;t+=2){
    STEP(pB0,pB1,pA0,pA1,t,(t+3<NT),(t+1<NT),(t+1<NT));       ENDW(t);   RESC(); ROT();
    STEP(pA0,pA1,pB0,pB1,t+1,(t+4<NT),(t+2<NT),(t+2<NT));     ENDW(t+1); RESC(); ROT();
  }
  STEP(pB0,pB1,pA0,pA1,NT-1,false,false,false); RESC();
  { float sacc=pB0[0]+pB0[1]; _Pragma("unroll") for(int r=2;r<16;++r)sacc+=pB0[r]; _Pragma("unroll") for(int r=0;r<16;++r)sacc+=pB1[r]; l_reg+=sacc;
    pw0=(u32x4){PKW(pB0,0),PKW(pB0,2),PKW(pB0,4),PKW(pB0,6)};pw1=(u32x4){PKW(pB0,8),PKW(pB0,10),PKW(pB0,12),PKW(pB0,14)};pw2=(u32x4){PKW(pB1,0),PKW(pB1,2),PKW(pB1,4),PKW(pB1,6)};pw3=(u32x4){PKW(pB1,8),PKW(pB1,10),PKW(pB1,12),PKW(pB1,14)};
    SBAR(); pv(o,vb0+sl_cur,PAF(0),PAF(1),PAF(2),PAF(3)); }
  #undef PKW
  #undef PAF
  #undef VFR
  #undef PIN
  #undef MX3
  #undef GAPA
  #undef GAPB
  #undef EX
  #undef VRD
  #undef KRD
  #undef STEP
  #undef ENDW
  {auto rr=__builtin_amdgcn_permlane32_swap(__float_as_uint(l_reg),__float_as_uint(l_reg),false,false);l_reg=__uint_as_float(rr[0])+__uint_as_float(rr[1]);}
  if(hi==0)wsf[32+r32]=l_reg;asm volatile("s_waitcnt lgkmcnt(0)":::"memory");
  float rli[16];
  #pragma unroll
  for(int r=0;r<16;++r)rli[r]=__builtin_amdgcn_rcpf(wsf[32+crow(r,hi)]);
  bf16*Ow=O+(rowbase+q0+wid*QBLK)*OPITCH+512+h*D; float*Sw=SSQA+(rowbase+q0+wid*QBLK)*16+h;
  { bf16*stg=(bf16*)(shm+LDS_OST)+wid*2048;
    #pragma unroll
    for(int r=0;r<16;++r){const int orow=crow(r,hi);
      #pragma unroll
      for(int d0=0;d0<2;++d0)stg[orow*64+d0*32+r32]=__float2bfloat16(o[d0][r]*rli[r]);}
    asm volatile("s_waitcnt lgkmcnt(0)":::"memory");
    #pragma unroll
    for(int i=0;i<4;++i){const int row=i*8+(lane>>3),ch=lane&7; const u32x4 v=*(const u32x4*)(stg+row*64+ch*8); ATTN_STORE16(Ow+(long)row*OPITCH+ch*8,v);
      float ss=0.f; for(int e=0;e<4;++e){const float lo_=__uint_as_float(v[e]<<16),hi_=__uint_as_float(v[e]&0xffff0000u); ss+=lo_*lo_+hi_*hi_;}
      ss+=__shfl_xor(ss,1); ss+=__shfl_xor(ss,2); ss+=__shfl_xor(ss,4); if(ch==0)Sw[(long)row*16]=ss; } }
  asm volatile("s_waitcnt lgkmcnt(0)\n\ts_barrier":::"memory");
  #undef DMA_K
  #undef DMA_V
  #undef CMASK
  #undef START
  #undef RESC
  #undef ROT
}
constexpr int ATTN_LDS_BYTES=LDS_BYTES;
#undef SBAR
#undef WAIT_BAR
}

#ifdef ATT_NAIVE
__device__ __forceinline__ void attn_naive_unit(const Ctx& c, const Args& a, int b, int h, int qblk) {
    const bf16_t* QR = (const bf16_t*)(a.ws + WS_QRAW); const bf16_t* KV = (const bf16_t*)(a.ws + WS_KV);
    bf16_t* Y = (bf16_t*)(a.ws + WS_Y); float* SSQA = (float*)(a.ws + WS_SSQA);
    float* Ks = (float*)c.lds; float* Vs = Ks + 64 * 64;
    const long row = (long)b * SEQ + qblk * 512 + c.tid; const int kvh = h >> 2;
    float q[64], o[64];
#pragma unroll
    for (int v = 0; v < 8; ++v) { const u32x4 w = *(const u32x4*)(QR + row * 512 + h * 64 + v * 8);
        q[v * 8 + 0] = bflo(w.x); q[v * 8 + 1] = bfhi(w.x); q[v * 8 + 2] = bflo(w.y); q[v * 8 + 3] = bfhi(w.y);
        q[v * 8 + 4] = bflo(w.z); q[v * 8 + 5] = bfhi(w.z); q[v * 8 + 6] = bflo(w.w); q[v * 8 + 7] = bfhi(w.w); }
#pragma unroll
    for (int dd = 0; dd < 64; ++dd) o[dd] = 0.f;
    float mrun = -1e30f, l = 0.f;
    const int lk = c.tid >> 3, lp = c.tid & 7;
    for (int t0 = 0; t0 < SEQ; t0 += 64) {
        __syncthreads();
        { const bf16_t* kp = KV + ((long)b * SEQ + t0 + lk) * 256 + kvh * 64 + lp * 8;
          const u32x4 kw = *(const u32x4*)kp, vw = *(const u32x4*)(kp + 128);
          float* kd = Ks + lk * 64 + lp * 8; float* vd = Vs + lk * 64 + lp * 8;
          kd[0] = bflo(kw.x); kd[1] = bfhi(kw.x); kd[2] = bflo(kw.y); kd[3] = bfhi(kw.y); kd[4] = bflo(kw.z); kd[5] = bfhi(kw.z); kd[6] = bflo(kw.w); kd[7] = bfhi(kw.w);
          vd[0] = bflo(vw.x); vd[1] = bfhi(vw.x); vd[2] = bflo(vw.y); vd[3] = bfhi(vw.y); vd[4] = bflo(vw.z); vd[5] = bfhi(vw.z); vd[6] = bflo(vw.w); vd[7] = bfhi(vw.w); }
        __syncthreads();
#pragma unroll 1
        for (int j = 0; j < 64; ++j) {
            float acc = 0.f; const float* kr = Ks + j * 64;
#pragma unroll
            for (int dd = 0; dd < 64; dd += 4) { const f32x4 kk = *(const f32x4*)(kr + dd); acc += q[dd] * kk[0] + q[dd + 1] * kk[1] + q[dd + 2] * kk[2] + q[dd + 3] * kk[3];
                if ((dd & 15) == 12) __builtin_amdgcn_sched_barrier(0); }
            if (acc > mrun) { const float sc = exp2f(mrun - acc); l *= sc; mrun = acc;
#pragma unroll
                for (int dd = 0; dd < 64; ++dd) o[dd] *= sc; }
            const float p = exp2f(acc - mrun); l += p; const float* vr = Vs + j * 64;
#pragma unroll
            for (int dd = 0; dd < 64; dd += 4) { const f32x4 vv = *(const f32x4*)(vr + dd); o[dd] += p * vv[0]; o[dd + 1] += p * vv[1]; o[dd + 2] += p * vv[2]; o[dd + 3] += p * vv[3];
                if ((dd & 15) == 12) __builtin_amdgcn_sched_barrier(0); }
        }
    }
    const float il = 1.f / l; float ss = 0.f;
#pragma unroll
    for (int v = 0; v < 8; ++v) { float t[8];
#pragma unroll
        for (int e = 0; e < 8; ++e) { t[e] = o[v * 8 + e] * il; ss += t[e] * t[e]; }
        u32x4 w; w.x = pk2(t[0], t[1]); w.y = pk2(t[2], t[3]); w.z = pk2(t[4], t[5]); w.w = pk2(t[6], t[7]);
        *(u32x4*)(Y + row * 1024 + 512 + h * 64 + v * 8) = w; }
    SSQA[row * 16 + h] = ss;
    __syncthreads();
}

#endif
template <int NV> __device__ __forceinline__ float top16(float (&v)[NV], int lane) {
    float res = -INFINITY;
    for (int it = 0; it < 16; ++it) {
        float m = v[0];
#pragma unroll
        for (int i = 1; i < NV; ++i) m = fmaxf(m, v[i]);
        m = wave_max(m);
#pragma unroll
        for (int i = 0; i < NV; ++i) if (v[i] == m) v[i] = -INFINITY;
        if (lane == it) res = m;
    }
    return res;
}
__device__ __forceinline__ float dot8(const u32x4 a, const u32x4 b) {
    return bflo(a.x) * bflo(b.x) + bfhi(a.x) * bfhi(b.x) + bflo(a.y) * bflo(b.y) + bfhi(a.y) * bfhi(b.y)
         + bflo(a.z) * bflo(b.z) + bfhi(a.z) * bfhi(b.z) + bflo(a.w) * bflo(b.w) + bfhi(a.w) * bfhi(b.w);
}
__device__ __forceinline__ void peer_topk(const Ctx& c, const Args& a, int layer, int widx, int nw) {
    const bf16_t* QP = (const bf16_t*)(a.ws + WS_QP);
    const bf16_t* SK1 = (const bf16_t*)(a.ws + WS_LW + (size_t)layer * LW_STRIDE + LW_SK1);
    const bf16_t* SK2 = (const bf16_t*)(a.ws + WS_LW + (size_t)layer * LW_STRIDE + LW_SK2);
    int* SELI = (int*)(a.ws + WS_SELI); float* SELW = (float*)(a.ws + WS_SELW);
    const int lane = c.lane;
    for (int it = widx; it < M * 8; it += nw) {
        const int t = it >> 3, h = it & 7;
        const bf16_t* qrow = QP + (size_t)t * 2048 + h * 256;
        const bf16_t* k1a = SK1 + ((size_t)(h * 128 + lane)) * 128; const bf16_t* k1b = k1a + 64 * 128;
        const bf16_t* k2a = SK2 + ((size_t)(h * 128 + lane)) * 128; const bf16_t* k2b = k2a + 64 * 128;
        float s1[2] = {0.f, 0.f}, s2[2] = {0.f, 0.f};
#pragma unroll 4
        for (int kk = 0; kk < 128; kk += 8) {
            const u32x4 q1 = *(const u32x4*)(qrow + kk), q2 = *(const u32x4*)(qrow + 128 + kk);
            s1[0] += dot8(q1, *(const u32x4*)(k1a + kk)); s1[1] += dot8(q1, *(const u32x4*)(k1b + kk));
            s2[0] += dot8(q2, *(const u32x4*)(k2a + kk)); s2[1] += dot8(q2, *(const u32x4*)(k2b + kk));
        }
        s1[0] = __uint_as_float((__float_as_uint(s1[0]) & ~127u) | (unsigned)lane); s1[1] = __uint_as_float((__float_as_uint(s1[1]) & ~127u) | (unsigned)(lane + 64));
        s2[0] = __uint_as_float((__float_as_uint(s2[0]) & ~127u) | (unsigned)lane); s2[1] = __uint_as_float((__float_as_uint(s2[1]) & ~127u) | (unsigned)(lane + 64));
        const float v1 = top16<2>(s1, lane), v2 = top16<2>(s2, lane);
        float cand[4];
#pragma unroll
        for (int mm = 0; mm < 4; ++mm) {
            const float va = __shfl(v1, (lane >> 4) + 4 * mm), vb = __shfl(v2, lane & 15);
            const unsigned ua = __float_as_uint(va), ub = __float_as_uint(vb);
            const float sum = __uint_as_float(ua & ~127u) + __uint_as_float(ub & ~127u);
            cand[mm] = __uint_as_float((__float_as_uint(sum) & ~16383u) | ((ua & 127u) << 7) | (ub & 127u));
        }
        const float best = top16<4>(cand, lane);
        const unsigned ub = __float_as_uint(best);
        const float sc = __uint_as_float(ub & ~16383u);
        const float mx = __shfl(sc, 0);
        const float e = lane < 16 ? __expf(sc - mx) : 0.f;
        const float sum = wave_sum(e);
        if (lane < 16) { SELI[(size_t)t * 128 + h * 16 + lane] = (int)(ub & 16383u); SELW[(size_t)t * 128 + h * 16 + lane] = e / sum; }
    }
}

typedef float f32x16 __attribute__((ext_vector_type(16)));
#define CE_DESC(x, y) do { const float hi__ = fmaxf(x, y), lo__ = fminf(x, y); x = hi__; y = lo__; } while (0)
__device__ __forceinline__ void sort16_desc(float (&v)[16]) {
#pragma unroll
    for (int g = 0; g < 16; g += 4) {
        const float a_ = v[g], b_ = v[g + 1], c_ = v[g + 2], d_ = v[g + 3];
        const float h_ = fmaxf(fmaxf(a_, b_), c_), m_ = __builtin_amdgcn_fmed3f(a_, b_, c_), l_ = fminf(fminf(a_, b_), c_);
        v[g] = fmaxf(h_, d_); v[g + 1] = __builtin_amdgcn_fmed3f(h_, m_, d_); v[g + 2] = __builtin_amdgcn_fmed3f(m_, l_, d_); v[g + 3] = fminf(l_, d_);
    }
#pragma unroll
    for (int p = 4; p < 16; p <<= 1)
#pragma unroll
        for (int k = p; k >= 1; k >>= 1)
#pragma unroll
            for (int j = k % p; j <= 15 - k; j += 2 * k)
#pragma unroll
                for (int i = 0; i < k; ++i) if (i + j + k <= 15 && (i + j) / (2 * p) == (i + j + k) / (2 * p)) CE_DESC(v[i + j], v[i + j + k]);
}
__device__ __forceinline__ void merge16_desc(float (&a)[16], const float (&b)[16]) {
#pragma unroll
    for (int i = 0; i < 16; ++i) a[i] = fmaxf(a[i], b[15 - i]);
#pragma unroll
    for (int j = 8; j > 0; j >>= 1)
#pragma unroll
        for (int i = 0; i < 16; ++i) { const int l = i ^ j; if (l > i) CE_DESC(a[i], a[l]); }
}
__device__ __forceinline__ void merge16_partner(float (&a)[16]) {
    float b[16];
#pragma unroll
    for (int i = 0; i < 16; ++i) b[i] = __shfl_xor(a[i], 32);
    merge16_desc(a, b);
}
__device__ __forceinline__ void peer_topk_fast(const Ctx& c, const Args& a, int layer, int widx, int nw, int only_unit = -1, const unsigned char* skl = nullptr) {
    const bf16_t* QP = (const bf16_t*)(a.ws + WS_QP);
    const bf16_t* SK1 = (const bf16_t*)(a.ws + WS_LW + (size_t)layer * LW_STRIDE + LW_SK1);
    const bf16_t* SK2 = (const bf16_t*)(a.ws + WS_LW + (size_t)layer * LW_STRIDE + LW_SK2);
    int* SELI = (int*)(a.ws + WS_SELI); float* SELW = (float*)(a.ws + WS_SELW);
    const int lane = c.lane, tl = lane & 31, hi = lane >> 5;
    for (int unit = only_unit >= 0 ? only_unit : widx; unit < (M / 32) * 8; unit += nw) {
        const int tg = unit >> 3, h = unit & 7; const long token = (long)tg * 32 + tl;
        float vv[2][16];
#pragma unroll
        for (int half = 0; half < 2; ++half) {
            f32x16 acc[4];
#pragma unroll
            for (int t = 0; t < 4; ++t)
#pragma unroll
                for (int r = 0; r < 16; ++r) acc[t][r] = 0.f;
            const bf16_t* qb = QP + token * 2048 + h * 256 + half * 128 + 8 * hi;
            const bf16_t* kb = (half ? SK2 : SK1) + ((long)(h * 128 + tl)) * 128 + 8 * hi;
            if (skl) {
                const bf16_t* qf = QP + ((((size_t)((tg >> 3) * 8 + h) * 8 + (tg & 7)) * 2 + half) * 8) * 512 + lane * 8;
                bf16x8 bq[8];
#pragma unroll
                for (int ks = 0; ks < 8; ++ks) bq[ks] = *(const bf16x8*)(qf + ks * 512);
                const unsigned char* kl = skl + half * 34816 + tl * 272 + 16 * hi;
#pragma unroll
                for (int ks = 0; ks < 8; ++ks)
#pragma unroll
                    for (int t = 0; t < 4; ++t) { const bf16x8 ak = *(const bf16x8*)(kl + t * 32 * 272 + ks * 32); acc[t] = __builtin_amdgcn_mfma_f32_32x32x16_bf16(ak, bq[ks], acc[t], 0, 0, 0); }
            } else
#pragma unroll 1
            for (int k4 = 0; k4 < 8; k4 += 4) {
                bf16x8 bq[4], ak[4][4];
#pragma unroll
                for (int u = 0; u < 4; ++u) { bq[u] = *(const bf16x8*)(qb + 16 * (k4 + u));
#pragma unroll
                    for (int t = 0; t < 4; ++t) ak[u][t] = *(const bf16x8*)(kb + (long)t * 32 * 128 + 16 * (k4 + u)); }
#pragma unroll
                for (int u = 0; u < 4; ++u)
#pragma unroll
                    for (int t = 0; t < 4; ++t) acc[t] = __builtin_amdgcn_mfma_f32_32x32x16_bf16(ak[u][t], bq[u], acc[t], 0, 0, 0);
            }
            float L[4][16];
#pragma unroll
            for (int t = 0; t < 4; ++t) {
#pragma unroll
                for (int r = 0; r < 16; ++r) L[t][r] = __uint_as_float((__float_as_uint(acc[t][r]) & ~127u) | (unsigned)(32 * t + (r & 3) + 8 * (r >> 2) + 4 * hi));
                sort16_desc(L[t]);
            }
            merge16_desc(L[0], L[1]); merge16_desc(L[2], L[3]); merge16_desc(L[0], L[2]);
            merge16_partner(L[0]);
#pragma unroll
            for (int i = 0; i < 16; ++i) vv[half][i] = L[0][i];
        }
        float f1[16], f2[16]; unsigned i1[16], i2[16];
#pragma unroll
        for (int i = 0; i < 16; ++i) { const unsigned u1 = __float_as_uint(vv[0][i]), u2 = __float_as_uint(vv[1][i]);
            f1[i] = __uint_as_float(u1 & ~127u); f2[i] = __uint_as_float(u2 & ~127u); i1[i] = (u1 & 127u) << 7; i2[i] = u2 & 127u; }
        float cA[16], cB[16];
#pragma unroll
        for (int i = 0; i < 16; ++i) { cA[i] = -INFINITY; cB[i] = -INFINITY; }
        {
            int n = 0;
#pragma unroll
            for (int aa = 0; aa < 16; ++aa)
#pragma unroll
                for (int bb = 0; bb < 16; ++bb) if ((aa + 1) * (bb + 1) <= 16) {
                    const float s = f1[aa] + f2[bb]; const float pk = __uint_as_float((__float_as_uint(s) & ~16383u) | i1[aa] | i2[bb]);
                    const int slot = n >> 1; const bool mine = ((n & 1) == hi);
                    if (slot < 16) cA[slot] = mine ? pk : cA[slot]; else cB[slot - 16] = mine ? pk : cB[slot - 16];
                    ++n;
                }
        }
        sort16_desc(cA); sort16_desc(cB); merge16_desc(cA, cB); merge16_partner(cA);
        float sc[16], e[16]; float sum = 0.f;
#pragma unroll
        for (int i = 0; i < 16; ++i) { sc[i] = __uint_as_float(__float_as_uint(cA[i]) & ~16383u); e[i] = __expf(sc[i] - sc[0]); sum += e[i]; }
        const float inv = 1.f / sum;
        u32x4 oi[2]; f32x4 ow[2];
#pragma unroll
        for (int i = 0; i < 8; ++i) { const float pk = hi ? cA[8 + i] : cA[i]; const float w = (hi ? e[8 + i] : e[i]) * inv;
            oi[i >> 2][i & 3] = __float_as_uint(pk) & 16383u; ow[i >> 2][i & 3] = w; }
        int* si = SELI + token * 128 + h * 16 + 8 * hi; float* sw = SELW + token * 128 + h * 16 + 8 * hi;
        *(u32x4*)si = oi[0]; *(u32x4*)(si + 4) = oi[1]; *(f32x4*)sw = ow[0]; *(f32x4*)(sw + 4) = ow[1];
        if (only_unit >= 0) break;
    }
}

__device__ __forceinline__ void dec16(const u32x4 w, float (&f)[16]) {
#pragma unroll
    for (int j = 0; j < 4; ++j) { const auto lo = __builtin_amdgcn_cvt_pk_f32_fp8((int)w[j], false); const auto hi = __builtin_amdgcn_cvt_pk_f32_fp8((int)w[j], true);
        f[4 * j + 0] = lo[0]; f[4 * j + 1] = lo[1]; f[4 * j + 2] = hi[0]; f[4 * j + 3] = hi[1]; }
}
__device__ __forceinline__ void peer_gather(const Ctx& c, const Args& a, int layer, int widx, int nw) {
    float* XR = a.out; bf16_t* XN2 = (bf16_t*)(a.ws + WS_XN2);
    const unsigned char* EU = a.ws + WS_EU + (size_t)layer * 16384 * 1024;
    const unsigned char* EV = a.ws + WS_EV + (size_t)layer * 16384 * 1024;
    const float* SCU = (const float*)(a.ws + WS_ESC) + layer * 16384; const float* SCV = SCU + 32768;
    const int* SELI = (const int*)(a.ws + WS_SELI); const float* SELW = (const float*)(a.ws + WS_SELW);
    const float* gf = a.in[I_NFFNG] + layer * D; const float* gp = a.in[I_NPLEG] + layer * D;
    const int lane = c.lane;
    for (int t = widx; t < M; t += nw) {
        float x[16], hh[16], acc[16];
        float* xr = XR + (size_t)t * D + 16 * lane;
        float ss = 0.f;
#pragma unroll
        for (int j = 0; j < 4; ++j) { const f32x4 u0 = *(const f32x4*)(xr + 4 * j);
#pragma unroll
            for (int e = 0; e < 4; ++e) x[4 * j + e] = u0[e]; }
#pragma unroll
        for (int e = 0; e < 16; ++e) { ss += x[e] * x[e]; acc[e] = 0.f; }
        ss = wave_sum(ss);
        const float rstd = rsqrtf(ss * (1.f / D) + EPS);
#pragma unroll
        for (int j = 0; j < 4; ++j) { const f32x4 g4 = *(const f32x4*)(gf + 16 * lane + 4 * j);
#pragma unroll
            for (int e = 0; e < 4; ++e) hh[4 * j + e] = x[4 * j + e] * rstd * g4[e]; }
        const int idxA = SELI[(size_t)t * 128 + lane], idxB = SELI[(size_t)t * 128 + 64 + lane];
        const float wA = SELW[(size_t)t * 128 + lane], wB = SELW[(size_t)t * 128 + 64 + lane];
        const float suA = SCU[idxA], suB = SCU[idxB], svA = SCV[idxA], svB = SCV[idxB];
#pragma unroll 1
        for (int hf = 0; hf < 2; ++hf) {
            const int idxv = hf ? idxB : idxA; const float wv = hf ? wB : wA, suv = hf ? suB : suA, svv = hf ? svB : svA;
#pragma unroll 1
            for (int k0 = 0; k0 < 64; k0 += 8) {
                u32x4 ur[8], vr[8]; float w[8], su[8], sv[8];
#pragma unroll
                for (int r = 0; r < 8; ++r) {
                    const int e = __builtin_amdgcn_readlane(idxv, k0 + r);
                    w[r] = __uint_as_float(__builtin_amdgcn_readlane(__float_as_uint(wv), k0 + r));
                    su[r] = __uint_as_float(__builtin_amdgcn_readlane(__float_as_uint(suv), k0 + r));
                    sv[r] = __uint_as_float(__builtin_amdgcn_readlane(__float_as_uint(svv), k0 + r));
                    ur[r] = *(const u32x4*)(EU + (size_t)e * D + 16 * lane); vr[r] = *(const u32x4*)(EV + (size_t)e * D + 16 * lane);
                }
#pragma unroll
                for (int r = 0; r < 8; ++r) {
                    float f[16]; dec16(ur[r], f);
                    float d = 0.f;
#pragma unroll
                    for (int e = 0; e < 16; ++e) d += hh[e] * f[e];
                    d = wave_sum(d) * su[r];
                    const float av = gelu_tanh(d) * w[r] * sv[r];
                    dec16(vr[r], f);
#pragma unroll
                    for (int e = 0; e < 16; ++e) acc[e] += av * f[e];
                }
            }
        }
        float s2 = 0.f;
#pragma unroll
        for (int e = 0; e < 16; ++e) { x[e] += acc[e]; s2 += x[e] * x[e]; }
        s2 = wave_sum(s2);
        const float rstd2 = rsqrtf(s2 * (1.f / D) + EPS);
#pragma unroll
        for (int j = 0; j < 4; ++j) *(f32x4*)(xr + 4 * j) = (f32x4){x[4 * j + 0], x[4 * j + 1], x[4 * j + 2], x[4 * j + 3]};
        float y[16];
#pragma unroll
        for (int j = 0; j < 4; ++j) { const f32x4 g4 = *(const f32x4*)(gp + 16 * lane + 4 * j);
#pragma unroll
            for (int e = 0; e < 4; ++e) y[4 * j + e] = x[4 * j + e] * rstd2 * g4[e]; }
        u32x4 o0, o1; o0.x = pk2(y[0], y[1]); o0.y = pk2(y[2], y[3]); o0.z = pk2(y[4], y[5]); o0.w = pk2(y[6], y[7]);
        o1.x = pk2(y[8], y[9]); o1.y = pk2(y[10], y[11]); o1.z = pk2(y[12], y[13]); o1.w = pk2(y[14], y[15]);
        *(u32x4*)(XN2 + (size_t)t * D + 16 * lane) = o0; *(u32x4*)(XN2 + (size_t)t * D + 16 * lane + 8) = o1;
    }
}

#define DPP_ADD(v, ctrl, rmask) v += __uint_as_float(__builtin_amdgcn_update_dpp(0u, __float_as_uint(v), ctrl, rmask, 0xf, true))
__device__ __forceinline__ float wave_sum_dpp(float v) {
    DPP_ADD(v, 0x111, 0xf); DPP_ADD(v, 0x112, 0xf); DPP_ADD(v, 0x114, 0xf); DPP_ADD(v, 0x118, 0xf); DPP_ADD(v, 0x142, 0xa); DPP_ADD(v, 0x143, 0xc);
    return __uint_as_float(__builtin_amdgcn_readlane(__float_as_uint(v), 63));
}
struct GrpSplit { int grp, G, gwave, nwave; };
__device__ __forceinline__ GrpSplit grp_split(const Ctx& c) { GrpSplit s; s.G = c.nblk < 8 ? c.nblk : 8; s.grp = c.blk % s.G; const int rank = c.blk / s.G, cnt = (c.nblk - s.grp + s.G - 1) / s.G;
    s.gwave = rank * 8 + c.wave; s.nwave = cnt * 8; return s; }
#define DPP_ADDC(v, ctrl) v += __uint_as_float(__builtin_amdgcn_update_dpp(0u, __float_as_uint(v), ctrl, 0xf, 0xf, true))
template <bool VSTEP, int MODE = 0>
__device__ __forceinline__ void peer_step(const Ctx& c, const Args& a, int layer, bf16_t* XB) {
    float* SSQ2 = (float*)(a.ws + WS_SSQS); const float* SSQ1 = (const float*)(a.ws + WS_SSQ1);
    const unsigned char* ET = a.ws + (VSTEP ? WS_EV : WS_EU) + (size_t)layer * 16384 * 1024;
    const int* SELI = (const int*)(a.ws + WS_SELI); const float* AOUT = (const float*)(a.ws + WS_AOUT); float* DP = (float*)(a.ws + WS_QP);
    const float* gf = a.in[I_NFFNG] + layer * D;
    const int lane = c.lane, sub = lane >> 3, ch = lane & 7; const GrpSplit gs = grp_split(c);
#define PS_LOADIX(ix_, tt) do { const u32x4* ip_ = (const u32x4*)(SELI + (size_t)(tt) * 128 + 16 * sub); ix_[0] = ip_[0]; ix_[1] = ip_[1]; ix_[2] = ip_[2]; ix_[3] = ip_[3]; } while (0)
    LAS unsigned char* wl = (LAS unsigned char*)c.lds + 4096 + c.wave * 1024;
#define PS_RAWIX(tt) (*(const u32x4*)(SELI + (size_t)(tt) * 128 + 4 * (lane & 31)))
#define PS_STAGEIX(ix_, raw_) do { *(LAS u32x4*)(wl + 16 * (lane & 31)) = (raw_); const LAS u32x4* lp_ = (const LAS u32x4*)(wl + 64 * sub); ix_[0] = lp_[0]; ix_[1] = lp_[1]; ix_[2] = lp_[2]; ix_[3] = lp_[3]; } while (0)
    const float* RSXp = (const float*)(a.ws + WS_RSX);
#define PS_LOADOPS(raw_, q_, tt) do { \
        if (VSTEP) { raw_[0] = *(const u32x4*)(AOUT + (size_t)(tt) * 128 + 4 * (lane & 31)); } \
        else { raw_[0] = *(const u32x4*)(XB + (size_t)(tt) * D + 128 * p + 16 * ch); raw_[1] = *(const u32x4*)(XB + (size_t)(tt) * D + 128 * p + 16 * ch + 8); q_ = RSXp[(tt)]; } } while (0)
#define PS_STAGEA(dst_, raw_) do { *(LAS u32x4*)(wl + 512 + 16 * (lane & 31)) = (raw_); const LAS u32x4* lp_ = (const LAS u32x4*)(wl + 512 + 64 * sub); dst_[0] = lp_[0]; dst_[1] = lp_[1]; dst_[2] = lp_[2]; dst_[3] = lp_[3]; } while (0)
#define PS_SEG(ix_, j_) (*(const u32x4*)(ETp + (unsigned)((ix_)[(j_) >> 2][(j_) & 3] * 1024u + lane_off)))
    for (int p = gs.grp; p < 8; p += gs.G) {
        float g16[16];
        if (!VSTEP) {
#pragma unroll
            for (int j = 0; j < 4; ++j) { const f32x4 g4 = *(const f32x4*)(gf + 128 * p + 16 * ch + 4 * j); g16[4 * j] = g4[0]; g16[4 * j + 1] = g4[1]; g16[4 * j + 2] = g4[2]; g16[4 * j + 3] = g4[3]; }
        }
        int t = gs.gwave;
        if (t >= M) continue;
        const unsigned char* ETp = ET + 128 * p; const unsigned lane_off = 16u * (unsigned)ch;
        u32x4 ring[16], nix[4], gn, gnn, craw[4], nraw[4]; float cq = 0.f, nq = 0.f;
        { u32x4 cix[4]; PS_LOADIX(cix, t); PS_LOADOPS(craw, cq, t);
#pragma unroll
          for (int j = 0; j < 16; ++j) ring[j] = PS_SEG(cix, j); }
        { const int t1 = t + gs.nwave < M ? t + gs.nwave : t; gn = PS_RAWIX(t1); }
        __builtin_amdgcn_s_waitcnt(0);
#pragma unroll 1
        for (;;) {
            const int tn = t + gs.nwave, tnn = tn + gs.nwave; const bool has_next = tn < M;
            { const int tc = has_next ? tn : t, tcc = tnn < M ? tnn : t; PS_LOADOPS(nraw, nq, tc); gnn = PS_RAWIX(tcc); }
            PS_STAGEIX(nix, gn);
            unsigned xrw = 0u;
            if (VSTEP) xrw = *(const unsigned*)(XB + (size_t)t * D + 128 * p + 2 * lane);
            float hx[16]; f32x4 cav[4];
            if (!VSTEP) {
                const float rstd = cq;
#pragma unroll
                for (int w = 0; w < 2; ++w)
#pragma unroll
                    for (int e = 0; e < 4; ++e) { hx[8 * w + 2 * e] = bflo(craw[w][e]) * rstd * g16[8 * w + 2 * e]; hx[8 * w + 2 * e + 1] = bfhi(craw[w][e]) * rstd * g16[8 * w + 2 * e + 1]; }
            } else {
                { u32x4 cst[4]; PS_STAGEA(cst, craw[0]);
#pragma unroll
                  for (int j = 0; j < 4; ++j) cav[j] = __builtin_bit_cast(f32x4, cst[j]); }
            }
            typedef float f32x2_ __attribute__((ext_vector_type(2)));
            float acc[16]; f32x2_ acc2[8];
#pragma unroll
            for (int e = 0; e < 16; ++e) acc[e] = 0.f;
#pragma unroll
            for (int e = 0; e < 8; ++e) acc2[e] = (f32x2_){0.f, 0.f};
#define PS_PIN() do { if (VSTEP) asm volatile("" : "+v"(acc2[0]), "+v"(acc2[1]), "+v"(acc2[2]), "+v"(acc2[3]), "+v"(acc2[4]), "+v"(acc2[5]), "+v"(acc2[6]), "+v"(acc2[7])); \
        else asm volatile("" : "+v"(acc[0]), "+v"(acc[1]), "+v"(acc[2]), "+v"(acc[3]), "+v"(acc[4]), "+v"(acc[5]), "+v"(acc[6]), "+v"(acc[7]), "+v"(acc[8]), "+v"(acc[9]), "+v"(acc[10]), "+v"(acc[11]), "+v"(acc[12]), "+v"(acc[13]), "+v"(acc[14]), "+v"(acc[15])); __builtin_amdgcn_sched_barrier(0); } while (0)
#pragma unroll
            for (int j = 0; j < 16; ++j) {
                if (MODE == 1) { acc[j] += __uint_as_float((ring[j][0] ^ ring[j][1] ^ ring[j][2] ^ ring[j][3]) & 0x3fffffffu); }
                else {
                f32x2_ f2[8];
#pragma unroll
                for (int w = 0; w < 4; ++w) { f2[2 * w] = __builtin_amdgcn_cvt_pk_f32_fp8((int)ring[j][w], false); f2[2 * w + 1] = __builtin_amdgcn_cvt_pk_f32_fp8((int)ring[j][w], true); }
                if (VSTEP) { const float av_ = cav[j >> 2][j & 3]; const f32x2_ av2 = (f32x2_){av_, av_};
#pragma unroll
                    for (int i = 0; i < 8; ++i) acc2[i] = __builtin_elementwise_fma(av2, f2[i], acc2[i]); }
                else { f32x2_ d0 = (f32x2_){hx[0], hx[1]} * f2[0], d1 = (f32x2_){hx[2], hx[3]} * f2[1];
#pragma unroll
                    for (int i = 2; i < 8; i += 2) { d0 = __builtin_elementwise_fma((f32x2_){hx[2 * i], hx[2 * i + 1]}, f2[i], d0); d1 = __builtin_elementwise_fma((f32x2_){hx[2 * i + 2], hx[2 * i + 3]}, f2[i + 1], d1); }
                    const f32x2_ ds = d0 + d1; float d = ds[0] + ds[1];
                    DPP_ADDC(d, 0xB1); DPP_ADDC(d, 0x4E); DPP_ADDC(d, 0x141); acc[j] = d; } }
                if (MODE != 2) ring[j] = PS_SEG(nix, j);
                if (VSTEP || (j & 1) == 1) PS_PIN();
            }
            if (!VSTEP) {
                if (ch == 0) { u32x4* dp = (u32x4*)((bf16_t*)DP + ((size_t)t * 8 + p) * 128 + 16 * sub);
                    u32x4 o0, o1; o0.x = pk2(acc[0], acc[1]); o0.y = pk2(acc[2], acc[3]); o0.z = pk2(acc[4], acc[5]); o0.w = pk2(acc[6], acc[7]);
                    o1.x = pk2(acc[8], acc[9]); o1.y = pk2(acc[10], acc[11]); o1.z = pk2(acc[12], acc[13]); o1.w = pk2(acc[14], acc[15]); dp[0] = o0; dp[1] = o1; }
            } else {
#pragma unroll
                for (int i = 0; i < 8; ++i) { acc[2 * i] = acc2[i][0]; acc[2 * i + 1] = acc2[i][1]; }
                float r8[8], r4[4], r2[2];
#pragma unroll
                for (int i = 0; i < 8; ++i) { const auto rr = __builtin_amdgcn_permlane32_swap(__float_as_uint(acc[i]), __float_as_uint(acc[i + 8]), false, false); r8[i] = __uint_as_float(rr[0]) + __uint_as_float(rr[1]); }
#pragma unroll
                for (int i = 0; i < 4; ++i) { const auto rr = __builtin_amdgcn_permlane16_swap(__float_as_uint(r8[i]), __float_as_uint(r8[i + 4]), false, false); r4[i] = __uint_as_float(rr[0]) + __uint_as_float(rr[1]); }
                const bool b3 = (lane & 8) != 0;
#pragma unroll
                for (int i = 0; i < 2; ++i) { const float keep = b3 ? r4[i + 2] : r4[i], send = b3 ? r4[i] : r4[i + 2];
                    r2[i] = keep + __uint_as_float(__builtin_amdgcn_update_dpp(0u, __float_as_uint(send), 0x128, 0xf, 0xf, true)); }
                typedef float f32x2s_ __attribute__((ext_vector_type(2)));
                LAS float* wsc = (LAS float*)(LAS unsigned char*)c.lds + c.wave * 128;
                *(LAS f32x2s_*)(wsc + 2 * (8 * ch + sub)) = (f32x2s_){r2[0], r2[1]};
                const f32x2s_ rt = *(LAS f32x2s_*)(wsc + 2 * lane);
                const unsigned ow = pk2(rt[0] + bflo(xrw), rt[1] + bfhi(xrw));
                const float y0 = bflo(ow), y1 = bfhi(ow);
                const float s2 = wave_sum_dpp(y0 * y0 + y1 * y1);
                *(unsigned*)(XB + (size_t)t * D + 128 * p + 2 * lane) = ow;
                if (lane == 0) SSQ2[(size_t)t * 16 + p] = s2;
            }
            if (!has_next) break;
#pragma unroll
            for (int j = 0; j < (VSTEP ? 1 : 2); ++j) craw[j] = nraw[j];
            cq = nq; gn = gnn;
            t = tn;
        }
    }
#undef PS_LOADIX
#undef PS_RAWIX
#undef PS_STAGEIX
#undef PS_LOADOPS
#undef PS_STAGEA
#undef PS_SEG
#undef PS_PIN
}
__device__ __forceinline__ void peer_combine(const Ctx& c, const Args& a, int layer) {
    const float* SCU = (const float*)(a.ws + WS_ESC) + layer * 16384; const float* SCV = SCU + 32768;
    const int* SELI = (const int*)(a.ws + WS_SELI); const float* SELW = (const float*)(a.ws + WS_SELW); float* AOUT = (float*)(a.ws + WS_AOUT); const float* DP = (const float*)(a.ws + WS_QP);
    const bf16_t* DPB = (const bf16_t*)DP;
    const size_t n8 = (size_t)M * 16, stride = (size_t)c.nblk * 512;
    constexpr int CMB_N = 2;
    LAS float* LSU = (LAS float*)(LAS unsigned char*)c.lds; LAS float* LSV = LSU + 16384;
    __syncthreads();
    u32x4 sv0[8], sv1[8];
#pragma unroll
    for (int k = 0; k < 8; ++k) { sv0[k] = *(const u32x4*)(SCU + (size_t)(k * 512 + c.tid) * 4); sv1[k] = *(const u32x4*)(SCV + (size_t)(k * 512 + c.tid) * 4); }
    bool staged = false;
    for (size_t v0 = (size_t)c.blk * 512 + c.tid; v0 < n8; v0 += CMB_N * stride) {
        f32x4 s0[CMB_N], s1[CMB_N]; u32x4 ix0[CMB_N], ix1[CMB_N]; f32x4 w0[CMB_N], w1[CMB_N];
#pragma unroll
        for (int u = 0; u < CMB_N; ++u) { const size_t v = v0 + u * stride < n8 ? v0 + u * stride : v0; const size_t t = v >> 4; const int q = (int)(v & 15) * 8;
            ix0[u] = *(const u32x4*)(SELI + t * 128 + q); ix1[u] = *(const u32x4*)(SELI + t * 128 + q + 4); w0[u] = *(const f32x4*)(SELW + t * 128 + q); w1[u] = *(const f32x4*)(SELW + t * 128 + q + 4);
            s0[u] = (f32x4){0.f, 0.f, 0.f, 0.f}; s1[u] = s0[u];
#pragma unroll
            for (int p = 0; p < 8; ++p) { f32x4 a0, a1; unpack8(*(const u32x4*)(DPB + (t * 8 + p) * 128 + q), a0, a1); s0[u] += a0; s1[u] += a1; } }
        if (!staged) {
#pragma unroll
            for (int k = 0; k < 8; ++k) { *(LAS u32x4*)(LSU + (k * 512 + c.tid) * 4) = sv0[k]; *(LAS u32x4*)(LSV + (k * 512 + c.tid) * 4) = sv1[k]; }
            __syncthreads(); staged = true;
        }
#pragma unroll
        for (int u = 0; u < CMB_N; ++u) { const size_t v = v0 + u * stride; if (v >= n8) break; const size_t t = v >> 4; const int q = (int)(v & 15) * 8;
            f32x4 o0, o1;
#pragma unroll
            for (int e = 0; e < 4; ++e) { o0[e] = gelu_tanh(s0[u][e] * LSU[ix0[u][e]]) * w0[u][e] * LSV[ix0[u][e]]; o1[e] = gelu_tanh(s1[u][e] * LSU[ix1[u][e]]) * w1[u][e] * LSV[ix1[u][e]]; }
            *(f32x4*)(AOUT + t * 128 + q) = o0; *(f32x4*)(AOUT + t * 128 + q + 4) = o1; }
    }
    __syncthreads();
}

__device__ __forceinline__ void final_norm(const Ctx& c, const Args& a, int widx, int nw) {
    const float* gfin = a.in[I_FING]; const bf16_t* XB = (const bf16_t*)(a.ws + WS_XB);
    for (int m0 = widx; m0 < M; m0 += 8 * nw) {
        u32x4 w[8][2];
#pragma unroll
        for (int u = 0; u < 8; ++u) { const int m = m0 + u * nw < M ? m0 + u * nw : m0; const u32x4* xr = (const u32x4*)(XB + (size_t)m * D + 16 * c.lane); w[u][0] = xr[0]; w[u][1] = xr[1]; }
#pragma unroll
        for (int u = 0; u < 8; ++u) { const int m = m0 + u * nw; if (m >= M) break;
            float x[16]; float s = 0.f;
#pragma unroll
            for (int j = 0; j < 2; ++j)
#pragma unroll
                for (int e = 0; e < 4; ++e) { x[8 * j + 2 * e] = bflo(w[u][j][e]); x[8 * j + 2 * e + 1] = bfhi(w[u][j][e]); }
#pragma unroll
            for (int e = 0; e < 16; ++e) s += x[e] * x[e];
            s = wave_sum(s); const float rstd = rsqrtf(s * (1.f / D) + EPS);
            f32x4* orow = (f32x4*)(a.out + (size_t)m * D + 16 * c.lane);
#pragma unroll
            for (int j = 0; j < 4; ++j) { const f32x4 gg = *(const f32x4*)(gfin + 16 * c.lane + 4 * j); orow[j] = (f32x4){x[4 * j] * rstd * gg[0], x[4 * j + 1] * rstd * gg[1], x[4 * j + 2] * rstd * gg[2], x[4 * j + 3] * rstd * gg[3]}; } }
    }
}

__global__ void __launch_bounds__(512, 2) mk_fwd(Args a) {
    extern __shared__ __attribute__((aligned(16))) unsigned char lds[];
    Ctx c0; c0.tid = threadIdx.x; c0.lane = c0.tid & 63; c0.wave = __builtin_amdgcn_readfirstlane(c0.tid >> 6); c0.blk = blockIdx.x; c0.nblk = gridDim.x; c0.lds = lds;
    const Ctx& c = c0;
    volatile LAS unsigned* MISC = (volatile LAS unsigned*)((LAS unsigned char*)lds + MISC_OFF);
    for (int u = c.tid; u < (LDS_BYTES - LDSCTL_OFF) / 4; u += 512) ((LAS unsigned*)((LAS unsigned char*)lds + LDSCTL_OFF))[u] = 0u;
    __syncthreads();
    const bool multi = (a.ph_hi - a.ph_lo) > 1;
    XcdBarrier bar; bar.bar = (unsigned*)(a.ws + WS_CTL) + CW_BAR; bar.x = 0; bar.st = nullptr;
    if (multi) bar = xcd_barrier_post((unsigned*)(a.ws + WS_CTL) + CW_BAR, MISC + 8);
    const int gw = c.blk * 8 + c.wave, NGW = c.nblk * 8;

#define IN(k) (lo <= (k) && (k) < hi)
#define FRESH() Ctx c = c0; { int t_ = c0.tid; asm volatile("" : "+v"(t_)); c.tid = t_; c.lane = t_ & 63; int w_ = c0.wave; asm volatile("" : "+s"(w_)); c.wave = w_; int b_ = c0.blk; asm volatile("" : "+s"(b_)); c.blk = b_; int n_ = c0.nblk; asm volatile("" : "+s"(n_)); c.nblk = n_; }
#define GRIDBAR() do { XcdBarrier b_ = bar; unsigned* p_ = b_.bar; asm volatile("" : "+s"(p_)); b_.bar = p_; xcd_barrier(b_); } while (0)
#ifdef PROBE_PH
#define PROBE_STAMP(slot) do { if (blockIdx.x == 0 && threadIdx.x == 0) ((unsigned long long*)(a.ws + WS_CTL + 48 * 1024))[slot] = __builtin_amdgcn_s_memrealtime(); } while (0)
#define SEAM(k) do { if ((k) == PROBE_PH - 1) { if (IN(k) && IN((k) + 1)) GRIDBAR(); PROBE_STAMP(0); } else if ((k) == PROBE_PH) { if (IN(k) && IN((k) + 1)) GRIDBAR(); PROBE_STAMP(1); } else { if (IN(k) && IN((k) + 1)) GRIDBAR(); } } while (0)
#else
#define SEAM(k) do { if (IN(k) && IN((k) + 1)) GRIDBAR(); } while (0)
#endif
    const int lo = a.ph_lo, hi = a.ph_hi;
#ifdef PROBE_PH
    if (PROBE_PH == 0) PROBE_STAMP(0);
#endif
    if (IN(0)) {
        FRESH();
        p0_prologue(c, a);
    }
    SEAM(0);
#pragma unroll 1
    for (int layer = 0; layer < 2; ++layer) {
        const int pb = 1 + 11 * layer;
        unsigned char* lw = a.ws + WS_LW + (size_t)layer * LW_STRIDE;
        unsigned char* xbc = a.ws + (layer & 1 ? WS_XB2 : WS_XB); unsigned char* xbn = a.ws + (layer & 1 ? WS_XB : WS_XB2);
        if (IN(pb + 0)) {
            FRESH();
            GemmD g; g.A = (const bf16_t*)xbc; g.lda = D; g.Bt = (const bf16_t*)(lw + LW_WIN); g.ldb = D; g.K = D; g.kmid = -1;
            float* RSX = (float*)(a.ws + WS_RSX);
            rstd_rows(c, (const float*)(a.ws + WS_SSQ0), 16, RSX, c.nblk == 256 ? 4 : DIN / 256, c.nblk, c.blk);
            EpiInproj E; E.ssq0 = RSX; E.ucat = (bf16_t*)(a.ws + WS_UCAT); E.qraw = (bf16_t*)(a.ws + WS_QRAW); E.kv = (bf16_t*)(a.ws + WS_KV);
            gemm_phase_dense(c, g, M / 256, c.nblk == 256 ? 4 : DIN / 256, E);
            if (layer == 0 && c.nblk != 256) {}
        }
        SEAM(pb + 0);
        if (IN(pb + 1)) {
            FRESH();
            if (c.nblk == 256) {
                if (c.blk < 64) s1_unit(c, a, layer, c.blk);
                else if (c.blk < 128) {
                    GemmD g; g.A = (const bf16_t*)xbc; g.lda = D; g.Bt = (const bf16_t*)(lw + LW_WIN); g.ldb = D; g.K = D; g.kmid = -1;
                    float* RSX = (float*)(a.ws + WS_RSX);
                    if (c.tid < 256) { const int row = (c.blk - 64) * 256 + c.tid; RSX[row] = rsqrtf(sumn((const float*)(a.ws + WS_SSQ0) + (long)row * 16, 16) * (1.f / D) + EPS); }
                    VM_WAIT(); __syncthreads();
                    EpiInproj E; E.ssq0 = RSX; E.ucat = (bf16_t*)(a.ws + WS_UCAT); E.qraw = (bf16_t*)(a.ws + WS_QRAW); E.kv = (bf16_t*)(a.ws + WS_KV);
                    pg8::OneUnit S; S.u.pm = c.blk - 64; S.u.pn = 4; run_gemm(c.lds, g, S, E, c.tid);
                    VM_WAIT(); __syncthreads();
                    qkprep_rows<false>(c, a, layer, c.wave, 8, 64, (c.blk - 64) * 256);
                    cvt_fp8_layer(c, a, layer, (c.blk - 64) * 8 + c.wave, 64 * 8, 0, L1CVT_KV);
                } else {
                    qkprep_rows<true>(c, a, layer, (c.blk - 128) * 8 + c.wave, 128 * 8, M, 0);
                    cvt_fp8_layer(c, a, layer, (c.blk - 128) * 8 + c.wave, 128 * 8, L1CVT_KV, L1CVT_SPLIT);
                }
            } else if (c.nblk > 64) {
                if (c.blk < 64) s1_unit(c, a, layer, c.blk);
                else qkprep(c, a, layer, (c.blk - 64) * 8 + c.wave, (c.nblk - 64) * 8);
            } else {
                for (int u = c.blk; u < 64; u += c.nblk) s1_unit(c, a, layer, u);
                qkprep(c, a, layer, gw, NGW);
            }
        }
        SEAM(pb + 1);
        if (IN(pb + 2)) {
            FRESH();
            GemmD g; g.A = (const bf16_t*)(a.ws + WS_UCAT); g.lda = KCAT; g.Bt = (const bf16_t*)(lw + LW_WY); g.ldb = KCAT; g.K = KCAT; g.kmid = -1;
            EpiS2 E; E.G = (bf16_t*)(a.ws + WS_G);
#ifdef USE_SGEMM
            for (int ui = c.blk; ui < 128; ui += c.nblk) { Unit u; u.pm = ui >> 1; u.pn = (ui >> 2) * 2 + (ui & 1); sgemm_unit(g, u, E, c.wave, c.lane); }
#else
            { pg8::S2Order S; S.blk = c.blk; S.nblk = c.nblk; run_gemm(c.lds, g, S, E, c.tid); }
            if (c.nblk == 256 && c.blk >= 128) cvt_fp8_layer(c, a, layer, (c.blk - 128) * 8 + c.wave, 128 * 8, L1CVT_SPLIT, 2 * 16384);
#endif
#ifdef ATT_NAIVE
            for (int ui = c.blk; ui < 256; ui += c.nblk) attn_naive_unit(c, a, ui >> 7, (ui >> 4) & 7, ui & 15);
#else
            float mfix = 0.f;
            {
                float gq = 0.f, gk = 0.f;
                for (int d = 0; d < 64; ++d) { gq = fmaxf(gq, fabsf(a.in[I_QNG][layer * 64 + d])); gk = fmaxf(gk, fabsf(a.in[I_KNG][layer * 64 + d])); }
                mfix = 64.f * gq * gk * C2 * 1.02f;
            }
            for (int ui = c.blk; ui < 512; ui += c.nblk) {
                int ab, ah, aq;
                if (c.nblk == 256) { const int bl = ui & 255, vcu = (bl & 7) * 32 + (bl >> 3), combo = (ui >> 8) * 2 + (vcu >> 7), w = vcu & 127; ab = combo >> 1; ah = (combo & 1) * 4 + (w >> 5); aq = w & 31; }
                else { ab = ui >> 8; ah = (ui >> 5) & 7; aq = ui & 31; }
                attn_body::attn_unit<ATT_THRL>(ab, ah, aq, (const attn_body::bf16*)(a.ws + WS_QRAW), (const attn_body::bf16*)(a.ws + WS_KV), (attn_body::bf16*)(a.ws + WS_Y), (float*)(a.ws + WS_SSQA), (char*)lds, c.tid, mfix);
            }
#endif
        }
        SEAM(pb + 2);
        if (IN(pb + 3)) {
            FRESH();
            GemmD g; g.A = (const bf16_t*)(a.ws + WS_G); g.lda = 512; g.Bt = (const bf16_t*)(lw + LW_WGLU); g.ldb = 512; g.K = 512; g.kmid = -1;
            EpiGlu E; E.G = (const bf16_t*)(a.ws + WS_G); E.bglu = a.in[I_BGLU] + layer * 512; E.Y = (bf16_t*)(a.ws + WS_Y); E.ssqs = (float*)(a.ws + WS_SSQS);
            GemmD g1; g1.A = (const bf16_t*)(a.ws + WS_PB) + (size_t)layer * M * 256; g1.lda = 256; g1.Bt = (const bf16_t*)(lw + LW_WPROJ); g1.ldb = 256; g1.K = 256; g1.kmid = -1;
            EpiProj E1; E1.pr = (bf16_t*)(a.ws + WS_PRB);
            if (c.nblk >= 256) { if (c.blk < 128) gemm_phase_sub(c, g, M / 256, 2, E, 128, c.blk); else if (c.blk < 256) gemm_phase_sub(c, g1, M / 256, 4, E1, 128, c.blk - 128); }
            else { gemm_phase_dense(c, g, M / 256, 2, E); gemm_phase_dense(c, g1, M / 256, 4, E1); }
        }
        SEAM(pb + 3);
        if (IN(pb + 4)) {
            FRESH();
            GemmD g; g.A = (const bf16_t*)(a.ws + WS_Y); g.lda = D; g.Bt = (const bf16_t*)(lw + LW_WOUT); g.ldb = D; g.K = D; g.kmid = 512;
            float* RS = (float*)(a.ws + WS_RS);
            { const float* ssqs = (const float*)(a.ws + WS_SSQS); const float* ssqa = (const float*)(a.ws + WS_SSQA);
              pg8::StaticOrder S0; S0.init(M, D, c.nblk, c.blk); Unit u0;
              for (int i = 0; S0.next(i, u0); ++i) if (c.tid < 256) { const int row = u0.pm * 256 + c.tid;
                  const float s = rsqrtf(sumn(ssqs + (long)row * 16, 8) * (1.f / 512.f) + EPS), t = rsqrtf(sumn(ssqa + (long)row * 16, 8) * (1.f / 512.f) + EPS);
                  RS[(long)row * 2] = s / t; RS[(long)row * 2 + 1] = t; }
              VM_WAIT(); __syncthreads(); }
            EpiOut E; E.rs = RS; E.xb = (bf16_t*)xbc; E.ssq1 = (float*)(a.ws + WS_SSQ1);
            gemm_phase_dense(c, g, M / 256, 4, E);
        }
        SEAM(pb + 4);
        if (IN(pb + 5)) {
            FRESH();
            GemmD g; g.A = (const bf16_t*)xbc; g.lda = D; g.Bt = (const bf16_t*)(lw + LW_WQ); g.ldb = D; g.K = D; g.kmid = -1;
            float* RSX = (float*)(a.ws + WS_RSX);
            rstd_rows(c, (const float*)(a.ws + WS_SSQ1), 16, RSX, 8, c.nblk, c.blk);
            EpiQ E; E.ssq1 = RSX; E.qp = (bf16_t*)(a.ws + WS_QP);
            gemm_phase_dense(c, g, M / 256, 8, E);
            VM_WAIT(); __syncthreads();
            { pg8::StaticOrder S0; S0.init(M, 2048, c.nblk, c.blk); Unit u0;
              for (int i = 0; S0.next(i, u0); ++i) {
                  __syncthreads();
                  {
                      u32x4 sv[8];
#pragma unroll
                      for (int k = 0; k < 8; ++k) { const int hf = k >> 2, idx = (k & 3) * 512 + c.tid, row = idx >> 4, ch = idx & 15;
                          sv[k] = *(const u32x4*)((const bf16_t*)(lw + (hf ? LW_SK2 : LW_SK1)) + ((size_t)(u0.pn * 128 + row)) * 128 + ch * 8); }
#pragma unroll
                      for (int k = 0; k < 8; ++k) { const int hf = k >> 2, idx = (k & 3) * 512 + c.tid, row = idx >> 4, ch = idx & 15;
                          *(u32x4*)(c.lds + hf * 34816 + row * 272 + ch * 16) = sv[k]; }
                  }
                  __syncthreads();
                  peer_topk_fast(c, a, layer, 0, 1 << 30, (u0.pm * 8 + c.wave) * 8 + u0.pn, c.lds);
              } }
        }
        SEAM(pb + 5);
        if (IN(pb + 7)) {
            FRESH();
#ifdef EXP_MODE
            peer_step<false, EXP_MODE>(c, a, layer, (bf16_t*)xbc);
            VM_WAIT(); __syncthreads();
#endif
            peer_step<false>(c, a, layer, (bf16_t*)xbc);
        }
        SEAM(pb + 7);
        if (IN(pb + 8)) {
            FRESH();
            peer_combine(c, a, layer);
        }
        SEAM(pb + 8);
        if (IN(pb + 9)) {
            FRESH();
            peer_step<true>(c, a, layer, (bf16_t*)xbc);
        }
        SEAM(pb + 9);
        if (IN(pb + 10)) {
            FRESH();
            GemmD g2; g2.A = (const bf16_t*)xbc; g2.lda = D; g2.Bt = (const bf16_t*)(lw + LW_WGATE); g2.ldb = D; g2.K = D; g2.kmid = -1;
            float* RSX = (float*)(a.ws + WS_RSX);
            rstd_rows(c, (const float*)(a.ws + WS_SSQS), 8, RSX, 4, c.nblk, c.blk);
            EpiGate E2; E2.pr = (const bf16_t*)(a.ws + WS_PRB); E2.xin = (const bf16_t*)xbc; E2.xout = (bf16_t*)xbn; E2.ssq0 = (float*)(a.ws + WS_SSQ0); E2.ssq2 = RSX;
            gemm_phase_dense(c, g2, M / 256, 4, E2);
        }
        SEAM(pb + 10);
    }
    if (IN(NPHASE - 1)) { FRESH(); final_norm(c, a, gw, NGW); }
#ifdef PROBE_RGN
    if (blockIdx.x == 0 && threadIdx.x == 0) {
        VM_WAIT();
        const unsigned long long* st = (const unsigned long long*)(a.ws + WS_CTL + 48 * 1024);
        const unsigned long long t0 = __hip_atomic_load(st, __ATOMIC_RELAXED, __HIP_MEMORY_SCOPE_AGENT), t1 = __hip_atomic_load(st + 1, __ATOMIC_RELAXED, __HIP_MEMORY_SCOPE_AGENT);
        const unsigned long long span = (t1 > t0 ? t1 - t0 : 0) * PROBE_MULT, s0 = __builtin_amdgcn_s_memrealtime();
        while (__builtin_amdgcn_s_memrealtime() - s0 < span) __builtin_amdgcn_s_sleep(8);
    }
#endif
#ifdef PROBE_PH
    if (blockIdx.x == 0 && threadIdx.x == 0) {
        VM_WAIT();
        const unsigned long long* st = (const unsigned long long*)(a.ws + WS_CTL + 48 * 1024);
        const unsigned long long t0 = __hip_atomic_load(st, __ATOMIC_RELAXED, __HIP_MEMORY_SCOPE_AGENT), t1 = __hip_atomic_load(st + 1, __ATOMIC_RELAXED, __HIP_MEMORY_SCOPE_AGENT);
        const unsigned long long span = (t1 > t0 ? t1 - t0 : 0) * PROBE_MULT, s0 = __builtin_amdgcn_s_memrealtime();
        while (__builtin_amdgcn_s_memrealtime() - s0 < span) __builtin_amdgcn_s_sleep(8);
    }
#endif
#undef IN
#undef SEAM
}

extern "C" void kernel_launch(void* const* d_in, const int* in_sizes, int n_in, void* d_out, int out_size, void* d_ws, size_t ws_size, hipStream_t stream) {
    static int grid = 0;
    if (grid == 0) {
        if (n_in != 29 || in_sizes[0] != M * D || out_size != M * D || in_sizes[3] != 2 * D * DIN || ws_size < WS_END) {
            fprintf(stderr, "kernel_launch: unexpected problem: n_in %d in0 %d in3 %d out %d ws %zu (need %zu); nothing launched\n", n_in, n_in > 0 ? in_sizes[0] : -1, n_in > 3 ? in_sizes[3] : -1, out_size, ws_size, (size_t)WS_END);
            grid = -1; return; }
        int dev = 0, cus = 0, per_cu = 0;
        if (hipGetDevice(&dev) != hipSuccess || hipDeviceGetAttribute(&cus, hipDeviceAttributeMultiprocessorCount, dev) != hipSuccess) { grid = -1; return; }
        if (hipFuncSetAttribute((const void*)mk_fwd, hipFuncAttributeMaxDynamicSharedMemorySize, LDS_BYTES) != hipSuccess) { fprintf(stderr, "kernel_launch: hipFuncSetAttribute failed\n"); grid = -1; return; }
        if (hipOccupancyMaxActiveBlocksPerMultiprocessor(&per_cu, (const void*)mk_fwd, 512, LDS_BYTES) != hipSuccess || per_cu < 1)
            fprintf(stderr, "kernel_launch: note: occupancy query reports %d workgroups per CU\n", per_cu);
        (void)hipGetLastError();
        grid = cus;
    }
    if (grid < 0) return;
    (void)hipMemsetAsync((char*)d_ws + WS_CTL, 0, CTL_ZERO_BYTES, stream);
    Args a{};
    for (int i = 0; i < 29; ++i) a.in[i] = (const float*)d_in[i];
    a.out = (float*)d_out; a.ws = (unsigned char*)d_ws;
    constexpr int NL = MK_N_LAUNCHES;
    for (int li = 0; li < NL; ++li) {
        a.ph_lo = (NPHASE * li) / NL; a.ph_hi = (NPHASE * (li + 1)) / NL;
        hipLaunchKernelGGL(mk_fwd, dim3(grid), dim3(512), LDS_BYTES, stream, a);
    }
}
```
